# Optimizing an MI355X kernel written in HIP

```python
import math
import jax, jax.numpy as jnp
from jax import lax
import numpy as np

D_MODEL = 2048
BATCH = 4
SEQ = 2048
DEPTH = 1
DEC_BATCH = 128
DEC_SEQ = 1
PAST_LEN = 16384
PAGE_SIZE = 128

RET_HEADS = 8
RET_DK = 128
RET_DV = 128
RET_QK = RET_HEADS * RET_DK
RET_WIDTH = RET_HEADS * RET_DV
RET_CHUNK = 128
GM_GROUPS = 8
GM_GROUP_DIM = 128
GM_WIDTH = GM_GROUPS * GM_GROUP_DIM
GM_CHUNK = 128
MIX_WIDTH = RET_WIDTH + GM_WIDTH
IN_COLS = 2 * RET_QK + 2 * RET_WIDTH + 2 * GM_WIDTH
D_FF = 5632
CONV_W = 3
PLE_DIM = 256
ROPE_THETA = 10000.0
EPS = 1e-6

kernel_name = "hybrid_retention_chunkgmlp_convffn_step"

_SPLITS = [RET_QK, 2 * RET_QK, 2 * RET_QK + RET_WIDTH, 2 * RET_QK + 2 * RET_WIDTH,
           2 * RET_QK + 2 * RET_WIDTH + GM_WIDTH]


def _rmsnorm(x, g):
    x32 = x.astype(jnp.float32)
    y = x32 * lax.rsqrt(jnp.mean(x32 * x32, axis=-1, keepdims=True) + EPS)
    return (y * g.astype(jnp.float32)).astype(x.dtype)


def _layernorm(x, g, b):
    x32 = x.astype(jnp.float32)
    mu = jnp.mean(x32, axis=-1, keepdims=True)
    xc = x32 - mu
    y = xc * lax.rsqrt(jnp.mean(xc * xc, axis=-1, keepdims=True) + EPS)
    return (y * g.astype(jnp.float32) + b.astype(jnp.float32)).astype(x.dtype)


def _rope(x, pos):
    dh = x.shape[-1]
    half = dh // 2
    inv = ROPE_THETA ** (-jnp.arange(0, dh, 2, dtype=jnp.float32) / dh)
    ang = pos.astype(jnp.float32)[:, None] * inv[None, :]
    cos = jnp.cos(ang)[None, :, None, :]
    sin = jnp.sin(ang)[None, :, None, :]
    x1, x2 = x[..., :half], x[..., half:]
    return jnp.concatenate([x1 * cos - x2 * sin, x2 * cos + x1 * sin], axis=-1)


def _ret_chunk_len(L):
    if L % RET_CHUNK == 0:
        return RET_CHUNK
    if L < RET_CHUNK:
        return L
    return math.gcd(L, RET_CHUNK)


def _retention(q, k, v, S0):
    B, L, H, _ = q.shape
    c = _ret_chunk_len(L)
    n = L // c
    log_g = jnp.log1p(-jnp.exp2(-5.0 - jnp.arange(H, dtype=jnp.float32)))
    idx = jnp.arange(c, dtype=jnp.float32)
    diff = idx[:, None] - idx[None, :]
    dmask = jnp.where(diff >= 0, jnp.exp(log_g[:, None, None] * jnp.maximum(diff, 0.0)), 0.0)
    q_dec = jnp.exp(log_g[:, None] * (idx + 1.0))[..., None]
    k_dec = jnp.exp(log_g[:, None] * (c - 1.0 - idx))[..., None]
    c_dec = jnp.exp(log_g * c)[:, None, None]

    def to_chunks(t):
        return t.reshape(B, n, c, H, t.shape[-1]).transpose(1, 0, 3, 2, 4)

    def step(S, xs):
        qc, kc, vc = xs
        sc = jnp.einsum('bhid,bhjd->bhij', qc, kc) * dmask
        o = (jnp.einsum('bhij,bhje->bhie', sc, vc)
             + jnp.einsum('bhid,bhde->bhie', qc * q_dec, S))
        S = S * c_dec + jnp.einsum('bhjd,bhje->bhde', kc * k_dec, vc)
        return S, o

    S, o = lax.scan(step, S0, (to_chunks(q), to_chunks(k), to_chunks(v)))
    o = o.transpose(1, 0, 3, 2, 4).reshape(B, L, H, -1)
    return o, S


def _chunk_spatial(vn, ws, bs):
    B, L, C = vn.shape
    c = L if L <= GM_CHUNK else GM_CHUNK
    Lp = -(-L // c) * c
    if Lp != L:
        vn = jnp.pad(vn, ((0, 0), (0, Lp - L), (0, 0)))
    n = Lp // c
    vr = vn.reshape(B, n, c, GM_GROUPS, GM_GROUP_DIM)
    mask = jnp.tril(jnp.ones((c, c), dtype=bool))
    wm = jnp.where(mask[None], ws[:, :c, :c], 0.0).astype(vn.dtype)
    out = jnp.einsum('gts,bnsgd->bntgd', wm, vr) + bs[:, :c].T.astype(vn.dtype)[None, None, :, :, None]
    return out.reshape(B, Lp, C)[:, :L]


def _layer(h, p, pos, S0, conv_buf, g_attn, w_in, gm_ln_g, gm_ln_b, gm_ws, gm_bs, w_o,
           g_ffn, w_up, conv_w, conv_b, w_down, g_ple, w_ple_gate, w_ple_proj):
    B, L, _ = h.shape
    dt = h.dtype
    xn = _rmsnorm(h, g_attn)
    z = xn @ w_in
    q, k, v, g, u, vg = jnp.split(z, _SPLITS, axis=-1)
    q = _rope(q.reshape(B, L, RET_HEADS, RET_DK).astype(jnp.float32), pos)
    k = _rope(k.reshape(B, L, RET_HEADS, RET_DK).astype(jnp.float32), pos) * (RET_DK ** -0.5)
    v = v.reshape(B, L, RET_HEADS, RET_DV).astype(jnp.float32)
    o, S_new = _retention(q, k, v, S0.astype(jnp.float32))
    o = o * lax.rsqrt(jnp.mean(o * o, axis=-1, keepdims=True) + EPS)
    ret_out = o.reshape(B, L, RET_WIDTH).astype(dt) * jax.nn.silu(g)
    u = jax.nn.gelu(u)
    vn = _layernorm(jax.nn.gelu(vg), gm_ln_g, gm_ln_b)
    gm_out = u * _chunk_spatial(vn, gm_ws, gm_bs)
    h = h + jnp.concatenate([ret_out, gm_out], axis=-1) @ w_o
    a = _rmsnorm(h, g_ffn) @ w_up
    a_ext = jnp.concatenate([conv_buf.astype(dt), a], axis=1)
    ac = (a_ext[:, 0:L] * conv_w[0] + a_ext[:, 1:L + 1] * conv_w[1]
          + a_ext[:, 2:L + 2] * conv_w[2] + conv_b)
    gate, up = jnp.split(ac, 2, axis=-1)
    h = h + (jax.nn.silu(gate) * up) @ w_down
    conv_new = a_ext[:, -(CONV_W - 1):]
    h = h + (p.astype(dt) @ w_ple_proj) * jax.nn.sigmoid(_rmsnorm(h, g_ple) @ w_ple_gate)
    return h, S_new, conv_new, vn


def setup_inputs(seed: int = 0) -> dict:
    key = jax.random.key(seed)
    ks = jax.random.split(key, 24)
    f32 = jnp.float32
    nrm = lambda k, shp, s: jax.random.normal(k, shp, f32) * s
    return {
        "x_prompt": nrm(ks[0], (BATCH, SEQ, D_MODEL), 1.0),
        "x_sample": nrm(ks[1], (DEC_BATCH, DEC_SEQ, D_MODEL), 1.0),
        "p_prompt": nrm(ks[2], (DEPTH, BATCH, SEQ, PLE_DIM), 1.0),
        "p_sample": nrm(ks[3], (DEPTH, DEC_BATCH, DEC_SEQ, PLE_DIM), 1.0),
        "state_ret": nrm(ks[4], (DEPTH, DEC_BATCH, RET_HEADS, RET_DK, RET_DV), 0.3),
        "state_conv": nrm(ks[5], (DEPTH, DEC_BATCH, CONV_W - 1, 2 * D_FF), 1.0),
        "g_attn": 1.0 + nrm(ks[6], (DEPTH, D_MODEL), 0.02),
        "w_in": nrm(ks[7], (DEPTH, D_MODEL, IN_COLS), D_MODEL ** -0.5),
        "gm_ln_g": 1.0 + nrm(ks[8], (DEPTH, GM_WIDTH), 0.02),
        "gm_ln_b": nrm(ks[9], (DEPTH, GM_WIDTH), 0.02),
        "gm_ws": nrm(ks[10], (DEPTH, GM_GROUPS, GM_CHUNK, GM_CHUNK), GM_CHUNK ** -0.5),
        "gm_bs": 1.0 + nrm(ks[11], (DEPTH, GM_GROUPS, GM_CHUNK), 0.02),
        "w_o": nrm(ks[12], (DEPTH, MIX_WIDTH, D_MODEL), MIX_WIDTH ** -0.5),
        "g_ffn": 1.0 + nrm(ks[13], (DEPTH, D_MODEL), 0.02),
        "w_up": nrm(ks[14], (DEPTH, D_MODEL, 2 * D_FF), D_MODEL ** -0.5),
        "conv_w": nrm(ks[15], (DEPTH, CONV_W, 2 * D_FF), CONV_W ** -0.5),
        "conv_b": nrm(ks[16], (DEPTH, 2 * D_FF), 0.02),
        "w_down": nrm(ks[17], (DEPTH, D_FF, D_MODEL), D_FF ** -0.5),
        "g_ple": 1.0 + nrm(ks[18], (DEPTH, D_MODEL), 0.02),
        "w_ple_gate": nrm(ks[19], (DEPTH, D_MODEL, D_MODEL), D_MODEL ** -0.5),
        "w_ple_proj": nrm(ks[20], (DEPTH, PLE_DIM, D_MODEL), PLE_DIM ** -0.5),
        "g_final": 1.0 + nrm(ks[21], (D_MODEL,), 0.02),
    }


def reference(x_prompt, x_sample, p_prompt, p_sample, state_ret, state_conv,
              g_attn, w_in, gm_ln_g, gm_ln_b, gm_ws, gm_bs, w_o, g_ffn, w_up, conv_w, conv_b,
              w_down, g_ple, w_ple_gate, w_ple_proj, g_final):
    Bp, Lp, _ = x_prompt.shape
    Bs, Ls, _ = x_sample.shape
    pos_p = jnp.arange(Lp, dtype=jnp.int32)
    pos_s = PAST_LEN + jnp.arange(Ls, dtype=jnp.int32)
    hp, hs = x_prompt, x_sample
    ret_p, conv_p, ret_s, conv_s, gmv_s = [], [], [], [], []
    for i in range(DEPTH):
        w = (g_attn[i], w_in[i], gm_ln_g[i], gm_ln_b[i], gm_ws[i], gm_bs[i], w_o[i],
             g_ffn[i], w_up[i], conv_w[i], conv_b[i], w_down[i], g_ple[i], w_ple_gate[i], w_ple_proj[i])
        S0p = jnp.zeros((Bp, RET_HEADS, RET_DK, RET_DV), jnp.float32)
        cb0p = jnp.zeros((Bp, CONV_W - 1, 2 * D_FF), x_prompt.dtype)
        hp, Sp, cp, _ = _layer(hp, p_prompt[i], pos_p, S0p, cb0p, *w)
        hs, Ss, cs, vs = _layer(hs, p_sample[i], pos_s, state_ret[i], state_conv[i], *w)
        ret_p.append(Sp.astype(state_ret.dtype))
        conv_p.append(cp.astype(state_conv.dtype))
        ret_s.append(Ss.astype(state_ret.dtype))
        conv_s.append(cs.astype(state_conv.dtype))
        gmv_s.append(vs)
    y_prompt = _rmsnorm(hp, g_final)
    y_sample = _rmsnorm(hs, g_final)
    return (y_prompt, y_sample, jnp.stack(ret_p), jnp.stack(conv_p),
            jnp.stack(ret_s), jnp.stack(conv_s), jnp.stack(gmv_s))
```

```cpp
#include <hip/hip_runtime.h>
#include <hip/hip_cooperative_groups.h>
#include <cstdio>
#include <cstdint>
#include <cmath>
namespace cg = cooperative_groups;

#ifndef MK_N_LAUNCHES
#define MK_N_LAUNCHES 10
#endif

namespace pg8 {
#define PG8_LAS __attribute__((address_space(3)))
typedef unsigned short bf16_t;
typedef short bf16x8 __attribute__((ext_vector_type(8)));
typedef float f32x4 __attribute__((ext_vector_type(4)));
typedef unsigned u32x4 __attribute__((ext_vector_type(4)));
constexpr int BM = 256, BK = 64, HALF = 128, HTB = HALF * BK * 2  , STAGE_BYTES = 8 * HTB, NXCD = 8, WGM = 8;

__host__ __device__ __forceinline__ int lds_byte(int r, int c) { const int st = (r >> 4) * 2 + (c >> 5), rr = r & 15, cc = c & 31, ob = rr * 64 + cc * 2; return st * 1024 + (ob ^ (((ob >> 9) & 1) << 5)); }
__host__ __device__ __forceinline__ void stage_rc(int b, int& R, int& C) { const int st = b / 1024, sb = b % 1024, swz = sb ^ (((sb >> 9) & 1) << 5); R = (st >> 1) * 16 + swz / 64; C = (st & 1) * 32 + (swz % 64) / 2; }
__host__ __device__ __forceinline__ int perm32(int rho) { const int n = rho >> 4, i = rho & 15; return 8 * (i >> 2) + 4 * n + (i & 3); }

struct Unit { int pm, pn; };
struct Gemm { const bf16_t* A; const bf16_t* Bt; int M, N, K; };

struct StaticOrder {
    int nM, nN, nwg, G, c;
    __host__ __device__ void init(int M, int N, int G_, int c_) { nM = M / BM; nN = N / BM; nwg = nM * nN; G = G_; c = c_; }
    __host__ __device__ bool next(int i, Unit& u) const {
        const long L = (long)i * G + c; if (L >= nwg) return false;
        int wgid = (int)L; { const int q = nwg / NXCD, r = nwg % NXCD, xcd = wgid % NXCD, off = wgid / NXCD; wgid = (xcd < r ? xcd * (q + 1) : r * (q + 1) + (xcd - r) * q) + off; }
        const int nig = WGM * nN, gid = wgid / nig, fm = gid * WGM, gsz = (nM - fm) < WGM ? (nM - fm) : WGM;
        u.pm = fm + ((wgid % nig) % gsz); u.pn = (wgid % nig) / gsz; return true;
    }
    __device__ __forceinline__ void a_ready(const Unit&) const {}
    __device__ __forceinline__ void done(const Unit&) const {}
};

__device__ __forceinline__ unsigned cvt_pk_bf16(float lo, float hi) { unsigned r; asm volatile("v_cvt_pk_bf16_f32 %0, %1, %2" : "=v"(r) : "v"(lo), "v"(hi)); return r; }
typedef float f32x2 __attribute__((ext_vector_type(2)));

template <class Epi, class Sched, bool ALIGN_EPI = false, bool SP2 = false>
__device__ __forceinline__ void gemm_phase(PG8_LAS unsigned char* lds, const Gemm g, const Sched& S, const Epi& E) {
    const int tid = threadIdx.x, wid = __builtin_amdgcn_readfirstlane(tid >> 6), lane = tid & 63, wr = wid >> 2, wc = wid & 3, fr = lane & 15, fq = lane >> 4;
    const int K = g.K, nt = K / BK;
    unsigned voffA[2], voffB[2];
#pragma unroll
    for (int i = 0; i < 2; ++i) { int R, C; stage_rc(tid * 16 + i * 8192, R, C); const int Rb = Epi::PERM ? ((R & ~31) + perm32(R & 31)) : R;
        voffA[i] = (unsigned)(R * K + C) * 2u; voffB[i] = (unsigned)(Rb * K + C) * 2u; }
    const size_t kstep = (size_t)(BK * 2);
    const size_t hstep = (size_t)HALF * K * 2;
    const size_t tstep = 2 * hstep;
    const unsigned ldsw = (unsigned)wid * 1024u;
    const int aoff = lds_byte(wr * 64 + fr, fq * 8), boff = lds_byte(wc * 32 + fr, fq * 8);
#define PG8_SA(b, h) (((b) * 2 + (h)) * HTB)
#define PG8_SB(b, h) ((4 + (b) * 2 + (h)) * HTB)
#define PG8_STAGE(bufoff, gbase, voff) do { _Pragma("unroll") for (int _i = 0; _i < 2; ++_i) \
        __builtin_amdgcn_global_load_lds((const unsigned*)((const char*)(gbase) + (voff)[_i]), (PG8_LAS unsigned*)(lds + (bufoff) + ldsw + _i * 8192), 16, 0, 0); } while (0)
#define PG8_LDA(dst, b, h) do { _Pragma("unroll") for (int m = 0; m < 4; ++m) _Pragma("unroll") for (int k = 0; k < 2; ++k) dst[m][k] = *(const PG8_LAS bf16x8*)(lds + PG8_SA(b, h) + aoff + m * 2048 + k * 1024); } while (0)
#define PG8_LDB(dst, b, h) do { _Pragma("unroll") for (int n = 0; n < 2; ++n) _Pragma("unroll") for (int k = 0; k < 2; ++k) dst[n][k] = *(const PG8_LAS bf16x8*)(lds + PG8_SB(b, h) + boff + n * 2048 + k * 1024); } while (0)
#define PG8_MMA(ai, bj, At, Bt) do { __builtin_amdgcn_s_setprio(1); _Pragma("unroll") for (int m = 0; m < 4; ++m) _Pragma("unroll") for (int n = 0; n < 2; ++n) _Pragma("unroll") for (int k = 0; k < 2; ++k) \
        acc[ai][bj][m][n] = __builtin_amdgcn_mfma_f32_16x16x32_bf16(Bt[n][k], At[m][k], acc[ai][bj][m][n], 0, 0, 0); __builtin_amdgcn_s_setprio(0); } while (0)
#define PG8_WAIT_V(n) asm volatile("s_waitcnt vmcnt(" #n ")" ::: "memory")
#define PG8_WAIT_L(n) asm volatile("s_waitcnt lgkmcnt(" #n ")" ::: "memory")
#define PG8_BAR __builtin_amdgcn_s_barrier()
#define PG8_SCHED __builtin_amdgcn_sched_barrier(0)
    Unit cur, nxt; int ui = 0;
    if (!S.next(0, cur)) return;
    f32x4 acc[2][2][4][2];
#pragma unroll
    for (int a = 0; a < 2; ++a)
#pragma unroll
        for (int b = 0; b < 2; ++b)
#pragma unroll
            for (int m = 0; m < 4; ++m)
#pragma unroll
                for (int n = 0; n < 2; ++n) acc[a][b][m][n] = (f32x4){0.f, 0.f, 0.f, 0.f};
    bf16x8 At[4][2], B0[2][2], B1[2][2];
    const char* cA = (const char*)g.A + (size_t)cur.pm * tstep; const char* cB = (const char*)g.Bt + (size_t)cur.pn * tstep;
    S.a_ready(cur);
    if constexpr (SP2) {
        PG8_STAGE(PG8_SB(0, 0), cB, voffB); PG8_STAGE(PG8_SB(0, 1), cB + hstep, voffB); PG8_STAGE(PG8_SA(0, 0), cA, voffA); PG8_STAGE(PG8_SA(0, 1), cA + hstep, voffA);
        if (wr == 1) PG8_BAR;
        PG8_WAIT_V(2); PG8_BAR;
        PG8_STAGE(PG8_SB(1, 0), cB + kstep, voffB); PG8_STAGE(PG8_SA(1, 0), cA + kstep, voffA); PG8_STAGE(PG8_SB(1, 1), cB + hstep + kstep, voffB);
        PG8_WAIT_V(6); PG8_BAR;
    } else {
        PG8_STAGE(PG8_SB(0, 0), cB, voffB); PG8_STAGE(PG8_SA(0, 0), cA, voffA); PG8_STAGE(PG8_SB(0, 1), cB + hstep, voffB); PG8_STAGE(PG8_SA(0, 1), cA + hstep, voffA);
        if (wr == 1) PG8_BAR;
        PG8_WAIT_V(4); PG8_BAR;
        PG8_STAGE(PG8_SB(1, 0), cB + kstep, voffB); PG8_STAGE(PG8_SA(1, 0), cA + kstep, voffA); PG8_STAGE(PG8_SB(1, 1), cB + hstep + kstep, voffB);
        PG8_WAIT_V(6); PG8_BAR;
    }
    for (;;) {
        const bool has_next = S.next(ui + 1, nxt);
        const char* nA = has_next ? (const char*)g.A + (size_t)nxt.pm * tstep : cA; const char* nB = has_next ? (const char*)g.Bt + (size_t)nxt.pn * tstep : cB;
        for (int t = 0; t < nt; t += 2) {
            const bool last = (t == nt - 2);
            const char* a1 = cA + (size_t)(t + 1) * kstep;
            const char* a2 = last ? nA : cA + (size_t)(t + 2) * kstep; const char* b2 = last ? nB : cB + (size_t)(t + 2) * kstep;
            const char* a3 = a2 + kstep; const char* b3 = b2 + kstep;
            if (last && has_next) S.a_ready(nxt);
            if constexpr (SP2) {
            PG8_LDB(B0, 0, 0); PG8_LDB(B1, 0, 1); PG8_SCHED; PG8_LDA(At, 0, 0); PG8_STAGE(PG8_SA(1, 1), a1 + hstep, voffA);
            PG8_WAIT_V(8); PG8_WAIT_L(0); PG8_BAR; PG8_MMA(0, 0, At, B0); PG8_MMA(0, 1, At, B1); PG8_BAR; PG8_SCHED;
            PG8_LDA(At, 0, 1); PG8_STAGE(PG8_SB(0, 0), b2, voffB); PG8_STAGE(PG8_SB(0, 1), b2 + hstep, voffB); PG8_STAGE(PG8_SA(0, 0), a2, voffA);
            PG8_WAIT_V(8); PG8_WAIT_L(0); PG8_BAR; PG8_MMA(1, 0, At, B0); PG8_MMA(1, 1, At, B1); PG8_BAR; PG8_SCHED;
            PG8_LDB(B0, 1, 0); PG8_LDB(B1, 1, 1); PG8_SCHED; PG8_LDA(At, 1, 0); PG8_STAGE(PG8_SA(0, 1), a2 + hstep, voffA);
            PG8_WAIT_V(8); PG8_WAIT_L(0); PG8_BAR; PG8_MMA(0, 0, At, B0); PG8_MMA(0, 1, At, B1); PG8_BAR; PG8_SCHED;
            PG8_LDA(At, 1, 1); PG8_STAGE(PG8_SB(1, 0), b3, voffB); PG8_STAGE(PG8_SB(1, 1), b3 + hstep, voffB); PG8_STAGE(PG8_SA(1, 0), a3, voffA);
            PG8_WAIT_V(8); PG8_WAIT_L(0); PG8_BAR; PG8_MMA(1, 0, At, B0); PG8_MMA(1, 1, At, B1); PG8_BAR; PG8_SCHED;
            } else {
            PG8_LDB(B0, 0, 0); PG8_SCHED; PG8_LDA(At, 0, 0); PG8_STAGE(PG8_SA(1, 1), a1 + hstep, voffA);
            PG8_WAIT_L(8); PG8_BAR; PG8_WAIT_L(0); PG8_MMA(0, 0, At, B0); PG8_BAR; PG8_SCHED;
            PG8_LDB(B1, 0, 1); PG8_STAGE(PG8_SB(0, 0), b2, voffB);
            PG8_BAR; PG8_WAIT_L(0); PG8_MMA(0, 1, At, B1); PG8_BAR;
            PG8_LDA(At, 0, 1); PG8_STAGE(PG8_SA(0, 0), a2, voffA);
            PG8_BAR; PG8_WAIT_L(0); PG8_MMA(1, 0, At, B0); PG8_BAR; PG8_SCHED;
            PG8_STAGE(PG8_SB(0, 1), b2 + hstep, voffB);
            PG8_WAIT_V(6); PG8_BAR; PG8_MMA(1, 1, At, B1); PG8_BAR;
            PG8_LDB(B0, 1, 0); PG8_SCHED; PG8_LDA(At, 1, 0); PG8_STAGE(PG8_SA(0, 1), a2 + hstep, voffA);
            PG8_WAIT_L(8); PG8_BAR; PG8_WAIT_L(0); PG8_MMA(0, 0, At, B0); PG8_BAR; PG8_SCHED;
            PG8_LDB(B1, 1, 1); PG8_STAGE(PG8_SB(1, 0), b3, voffB);
            PG8_BAR; PG8_WAIT_L(0); PG8_MMA(0, 1, At, B1); PG8_BAR;
            PG8_LDA(At, 1, 1); PG8_STAGE(PG8_SA(1, 0), a3, voffA);
            PG8_BAR; PG8_WAIT_L(0); PG8_MMA(1, 0, At, B0); PG8_BAR; PG8_SCHED;
            PG8_STAGE(PG8_SB(1, 1), b3 + hstep, voffB);
            PG8_WAIT_V(6); PG8_BAR; PG8_MMA(1, 1, At, B1); PG8_BAR;
            }
        }
        if constexpr (ALIGN_EPI) { if (wr == 0) PG8_BAR; }
        if constexpr (!Epi::AFTER_DRAIN) { E(acc, cur, wr, wc, fr, fq); S.done(cur); }
        if (!has_next) break;
#pragma unroll
        for (int a = 0; a < 2; ++a)
#pragma unroll
            for (int b = 0; b < 2; ++b)
#pragma unroll
                for (int m = 0; m < 4; ++m)
#pragma unroll
                    for (int n = 0; n < 2; ++n) acc[a][b][m][n] = (f32x4){0.f, 0.f, 0.f, 0.f};
        cur = nxt; cA = nA; cB = nB; ++ui;
        if constexpr (ALIGN_EPI) { if (wr == 1) PG8_BAR; }
    }
    PG8_WAIT_V(0);
    if constexpr (!ALIGN_EPI) { if (wr == 0) PG8_BAR; }
    PG8_BAR;
    if constexpr (Epi::AFTER_DRAIN) { E.fused(acc, cur, wr, wc, fr, fq, lds, wid, lane); S.done(cur); }
#undef PG8_SA
#undef PG8_SB
#undef PG8_STAGE
#undef PG8_LDA
#undef PG8_LDB
#undef PG8_MMA
#undef PG8_WAIT_V
#undef PG8_WAIT_L
#undef PG8_BAR
#undef PG8_SCHED
}
}

#define GAS __attribute__((address_space(1)))
#define LAS __attribute__((address_space(3)))
typedef unsigned short bf16;
typedef unsigned v4u __attribute__((ext_vector_type(4)));
typedef unsigned v2u __attribute__((ext_vector_type(2)));
typedef float f32x4 __attribute__((ext_vector_type(4)));
typedef float f32x2 __attribute__((ext_vector_type(2)));
typedef short bf16x8 __attribute__((ext_vector_type(8)));
#define XB_TMO      128
#define XB_XCNT(j)  (256  + 64 * (j))
#define XB_XSUB(j)  (1280 + 64 * (j))
#define XB_XGEN(j)  (2304 + 64 * (j))
#define XB_TOP      3328
#define XB_TOPGEN   3392
#define XCD_BAR_WORDS 3456
#define XB_SPIN_CAP (1u << 18)

__device__ __forceinline__ unsigned xb_ld(unsigned* p)              { return __hip_atomic_load(p, __ATOMIC_RELAXED, __HIP_MEMORY_SCOPE_AGENT); }
__device__ __forceinline__ unsigned xb_add(unsigned* p, unsigned v) { return __hip_atomic_fetch_add(p, v, __ATOMIC_RELAXED, __HIP_MEMORY_SCOPE_AGENT); }
__device__ __forceinline__ unsigned xb_xcc_id() { return (unsigned)__builtin_amdgcn_s_getreg((3 << 11) | 20) & 0xFu; }
#define XB_SPIN(cond, bar) do { unsigned _sp = 0; while (cond) { __builtin_amdgcn_s_sleep(1); \
    if ((++_sp & 255u) == 0u) { if (xb_ld(&(bar)[XB_TMO])) break; if (_sp > XB_SPIN_CAP) { atomicAdd(&(bar)[XB_TMO], 1u); break; } } } } while (0)

struct XcdBarrier {
    unsigned* bar; unsigned x;
    volatile LAS unsigned* st;
};

__device__ __forceinline__ XcdBarrier xcd_barrier_post(unsigned* bar, volatile LAS unsigned* st) {
    XcdBarrier b; b.bar = bar; b.x = xb_xcc_id(); b.st = st;
    if (threadIdx.x == 0) (void)xb_add(&bar[XB_XCNT(b.x)], 1u);
    return b;
}
__device__ __forceinline__ void xcd_barrier_complete(unsigned* bar, unsigned x, unsigned& nloc, unsigned& nx) {
    const unsigned G = gridDim.x * gridDim.y * gridDim.z;
    unsigned sum, cnt, mine, sp = 0u;
    for (;;) {
        sum = 0u; cnt = 0u; mine = 0u;
#pragma unroll
        for (unsigned j = 0; j < 16; ++j) { const unsigned c = xb_ld(&bar[XB_XCNT(j)]); sum += c; cnt += (c > 0u) ? 1u : 0u; mine = (j == x) ? c : mine; }
        if (sum == G) break;
        __builtin_amdgcn_s_sleep(1);
        if ((++sp & 255u) == 0u) { if (xb_ld(&bar[XB_TMO])) break; if (sp > XB_SPIN_CAP) { atomicAdd(&bar[XB_TMO], 1u); break; } }
    }
    nloc = mine > 0u ? mine : 1u; nx = cnt > 0u ? cnt : 1u;
}

__device__ __forceinline__ void xcd_barrier(const XcdBarrier& b) {
    asm volatile("s_waitcnt vmcnt(0)" ::: "memory");
    __syncthreads();
    if (threadIdx.x == 0) {
        unsigned* bar = b.bar;
        __builtin_amdgcn_s_waitcnt(0);
        unsigned nloc = b.st[0], nx = b.st[1];
        if (nloc == 0u) { xcd_barrier_complete(bar, b.x, nloc, nx); b.st[0] = nloc; b.st[1] = nx; }
        const unsigned old = xb_add(&bar[XB_XSUB(b.x)], 1u);
        const unsigned gen = old / nloc;
        if (old + 1u == (gen + 1u) * nloc) {
            __builtin_amdgcn_fence(__ATOMIC_RELEASE, "agent");
            asm volatile("s_waitcnt vmcnt(0)" ::: "memory");
            const unsigned og = xb_add(&bar[XB_TOP], 1u);
            const unsigned tg = og / nx;
            if (og + 1u == (tg + 1u) * nx) xb_add(&bar[XB_TOPGEN], 1u);
            else XB_SPIN(xb_ld(&bar[XB_TOPGEN]) == tg, bar);
            __builtin_amdgcn_fence(__ATOMIC_ACQUIRE, "agent");
            xb_add(&bar[XB_XGEN(b.x)], 1u);
            asm volatile("s_waitcnt vmcnt(0)" ::: "memory");
        } else {
            XB_SPIN(xb_ld(&bar[XB_XGEN(b.x)]) == gen, bar);
            __builtin_amdgcn_fence(__ATOMIC_ACQUIRE, "agent");
            asm volatile("s_waitcnt vmcnt(0)" ::: "memory");
        }
    }
    __syncthreads();
}

constexpr int MP = 8192, MS = 128, MT = MP + MS, D = 2048, NIN = 6144, NUP = 11264, DFF = 5632, PLE = 256, SEQ = 2048, NH = 8;
constexpr float EPS = 1e-6f;
constexpr int NPHASE = 10;
constexpr size_t MiB = 1u << 20;
constexpr size_t WS_BAR = 0, BAR_BYTES = 16384;
constexpr size_t WS_SS1 = 64 * 1024, WS_SS2 = 128 * 1024, WS_SS3 = 192 * 1024, WS_STATS = 256 * 1024;
constexpr size_t WS_ROPE = 1 * MiB, WS_ROPES = 2 * MiB;
constexpr size_t WS_WIN = 4 * MiB, WS_WO = 28 * MiB, WS_WUP = 36 * MiB, WS_WDN = 80 * MiB, WS_WG = 102 * MiB, WS_WP = 110 * MiB;
constexpr size_t WS_AB = 112 * MiB, WS_PB = 145 * MiB, WS_MIX = 150 * MiB, WS_Z = 183 * MiB, WS_ACT = 183 * MiB, WS_KV = 281 * MiB, WS_PP = 281 * MiB;
constexpr size_t WS_RAW = 313 * MiB, WS_AS = 335 * MiB, WS_END = 346 * MiB;
static_assert(WS_AB + (size_t)MT * D * 2 <= WS_PB && WS_PB + (size_t)MT * PLE * 2 <= WS_MIX && WS_MIX + (size_t)MT * D * 2 <= WS_Z, "ws map 1");
static_assert(WS_Z + (size_t)MT * NIN * 2 <= WS_KV && WS_ACT + (size_t)MT * DFF * 2 <= WS_KV && WS_KV + (size_t)512 * 16384 * 4 <= WS_RAW, "ws map 2");
static_assert(WS_RAW + (size_t)128 * 4 * NUP * 4 <= WS_AS && WS_AS + (size_t)MS * NUP * 4 <= WS_END && WS_PP + (size_t)MT * D * 4 <= WS_END, "ws map 3");
constexpr size_t O_RETP = 17039360, O_CONVP = 17563648, O_RETS = 17653760, O_CONVS = 34430976, O_GMV = 37314560, O_END = 37445632;
constexpr int LDS_BYTES = 147456, MISC_OFF = LDS_BYTES - 256;
constexpr int LDP = 136;
constexpr int TILE_B = 128 * LDP * 2;

struct Params { const float* in[22]; float* out; unsigned char* ws; float log2g[8]; float invf[64]; int ph_lo, ph_hi, use_cg, pad; };

#define LDS_WAIT() asm volatile("s_waitcnt lgkmcnt(0)" ::: "memory")
__device__ __forceinline__ float lo16(unsigned u) { return __uint_as_float(u << 16); }
__device__ __forceinline__ float hi16(unsigned u) { return __uint_as_float(u & 0xffff0000u); }
__device__ __forceinline__ float bf2f(bf16 b) { return __uint_as_float((unsigned)b << 16); }
__device__ __forceinline__ unsigned pk2(float lo, float hi) { return pg8::cvt_pk_bf16(lo, hi); }
__device__ __forceinline__ bf16 f2bf(float f) { return (bf16)(pg8::cvt_pk_bf16(f, 0.f) & 0xffffu); }
__device__ __forceinline__ float sigmoid_(float x) { return __builtin_amdgcn_rcpf(1.0f + __builtin_amdgcn_exp2f(-1.44269504089f * x)); }
__device__ __forceinline__ float silu_(float x) { return x * sigmoid_(x); }
__device__ __forceinline__ float gelu_(float x) { return x * sigmoid_(1.5957691216f * (x + 0.044715f * x * x * x)); }
__device__ __forceinline__ float wave_sum(float v) {
#pragma unroll
    for (int o = 1; o < 64; o <<= 1) v += __shfl_xor(v, o);
    return v;
}
__device__ __forceinline__ void atomic_addf(float* p, float v) { (void)__hip_atomic_fetch_add(p, v, __ATOMIC_RELAXED, __HIP_MEMORY_SCOPE_AGENT); }
template <int CTRL> __device__ __forceinline__ float dppf(float x) { return __int_as_float(__builtin_amdgcn_update_dpp(0, __float_as_int(x), CTRL, 0xf, 0xf, false)); }

using pg8::Unit;
struct EpiZ {
    static constexpr bool PERM = true, AFTER_DRAIN = false;
    bf16* Z;
    __device__ __forceinline__ void operator()(const f32x4 (&acc)[2][2][4][2], const Unit& u, int wr, int wc, int fr, int fq) const {
        const int row0 = u.pm * 256 + wr * 64 + fr, col0 = u.pn * 256 + wc * 32 + 8 * fq;
        const int mode = u.pn < 12 ? 0 : (u.pn < 16 ? 1 : 2);
#pragma unroll
        for (int ai = 0; ai < 2; ++ai)
#pragma unroll
            for (int m = 0; m < 4; ++m) { bf16* rowp = Z + (size_t)(row0 + ai * 128 + m * 16) * NIN + col0;
#pragma unroll
                for (int bj = 0; bj < 2; ++bj) { f32x4 v0 = acc[ai][bj][m][0], v1 = acc[ai][bj][m][1];
                    if (mode == 1) {
#pragma unroll
                        for (int j = 0; j < 4; ++j) { v0[j] = silu_(v0[j]); v1[j] = silu_(v1[j]); } }
                    else if (mode == 2) {
#pragma unroll
                        for (int j = 0; j < 4; ++j) { v0[j] = gelu_(v0[j]); v1[j] = gelu_(v1[j]); } }
                    v4u w; w.x = pk2(v0[0], v0[1]); w.y = pk2(v0[2], v0[3]); w.z = pk2(v1[0], v1[1]); w.w = pk2(v1[2], v1[3]);
                    *(v4u*)(rowp + bj * 128) = w; } }
    }
};
struct EpiRes {
    static constexpr bool PERM = false, AFTER_DRAIN = false;
    const float* base; float* out; bf16* hb; float* ss;
    __device__ __forceinline__ void operator()(const f32x4 (&acc)[2][2][4][2], const Unit& u, int wr, int wc, int fr, int fq) const {
        const int row0 = u.pm * 256 + wr * 64 + fr, col0 = u.pn * 256 + wc * 32 + 4 * fq;
#pragma unroll
        for (int ai = 0; ai < 2; ++ai)
#pragma unroll
            for (int m = 0; m < 4; ++m) { const int row = row0 + ai * 128 + m * 16; const size_t off = (size_t)row * D + col0; float s = 0.f;
#pragma unroll
                for (int bj = 0; bj < 2; ++bj)
#pragma unroll
                    for (int n = 0; n < 2; ++n) { const f32x4 o = *(const f32x4*)(base + off + bj * 128 + n * 16) + acc[ai][bj][m][n];
                        *(f32x4*)(out + off + bj * 128 + n * 16) = o; v2u w; w.x = pk2(o[0], o[1]); w.y = pk2(o[2], o[3]); *(v2u*)(hb + off + bj * 128 + n * 16) = w;
                        s += (o[0] * o[0] + o[1] * o[1]) + (o[2] * o[2] + o[3] * o[3]); }
                s += __shfl_xor(s, 16); s += __shfl_xor(s, 32);
                if (fq == 0) atomic_addf(ss + row, s);
                asm volatile("" ::: "memory"); }
    }
};
struct EpiPP {
    static constexpr bool PERM = false, AFTER_DRAIN = false;
    float* pp;
    __device__ __forceinline__ void operator()(const f32x4 (&acc)[2][2][4][2], const Unit& u, int wr, int wc, int fr, int fq) const {
        const int row0 = u.pm * 256 + wr * 64 + fr, col0 = u.pn * 256 + wc * 32 + 4 * fq;
#pragma unroll
        for (int ai = 0; ai < 2; ++ai)
#pragma unroll
            for (int m = 0; m < 4; ++m) { float* rowp = pp + (size_t)(row0 + ai * 128 + m * 16) * D + col0;
#pragma unroll
                for (int bj = 0; bj < 2; ++bj)
#pragma unroll
                    for (int n = 0; n < 2; ++n) *(f32x4*)(rowp + bj * 128 + n * 16) = acc[ai][bj][m][n]; }
    }
};
struct EpiGate {
    static constexpr bool PERM = false, AFTER_DRAIN = false;
    const float* pp; float* h; const float* ss2; float* ss3;
    __device__ __forceinline__ void operator()(const f32x4 (&acc)[2][2][4][2], const Unit& u, int wr, int wc, int fr, int fq) const {
        const int row0 = u.pm * 256 + wr * 64 + fr, col0 = u.pn * 256 + wc * 32 + 4 * fq;
#pragma unroll
        for (int ai = 0; ai < 2; ++ai)
#pragma unroll
            for (int m = 0; m < 4; ++m) { const int row = row0 + ai * 128 + m * 16; const size_t off = (size_t)row * D + col0; float s = 0.f;
                const float r2 = __builtin_amdgcn_rsqf(ss2[row] * (1.0f / D) + EPS);
#pragma unroll
                for (int bj = 0; bj < 2; ++bj)
#pragma unroll
                    for (int n = 0; n < 2; ++n) { const f32x4 hv = *(const f32x4*)(h + off + bj * 128 + n * 16), pv = *(const f32x4*)(pp + off + bj * 128 + n * 16); const f32x4 a = acc[ai][bj][m][n]; f32x4 o;
#pragma unroll
                        for (int j = 0; j < 4; ++j) o[j] = hv[j] + pv[j] * sigmoid_(r2 * a[j]);
                        *(f32x4*)(h + off + bj * 128 + n * 16) = o; s += (o[0] * o[0] + o[1] * o[1]) + (o[2] * o[2] + o[3] * o[3]); asm volatile("" ::: "memory"); }
                s += __shfl_xor(s, 16); s += __shfl_xor(s, 32);
                if (fq == 0) atomic_addf(ss3 + row, s);
                asm volatile("" ::: "memory"); }
    }
};
struct EpiUp {
    static constexpr bool PERM = false, AFTER_DRAIN = false;
    bf16* act; float* raw; const float* ss1; const float* cw; const float* cb;
    __device__ __forceinline__ void operator()(const f32x4 (&acc)[2][2][4][2], const Unit& u, int wr, int wc, int fr, int fq) const {
        const int row0 = u.pm * 256 + wr * 64 + fr;
        float rs[2][4];
#pragma unroll
        for (int ai = 0; ai < 2; ++ai)
#pragma unroll
            for (int m = 0; m < 4; ++m) rs[ai][m] = __builtin_amdgcn_rsqf(ss1[row0 + ai * 128 + m * 16] * (1.0f / D) + EPS);
#pragma unroll
        for (int n = 0; n < 2; ++n) {
            const int cg_ = u.pn * 128 + wc * 32 + 16 * n + 4 * fq;
            const f32x4 w0g = *(const f32x4*)(cw + cg_), w1g = *(const f32x4*)(cw + NUP + cg_), w2g = *(const f32x4*)(cw + 2 * NUP + cg_), bg = *(const f32x4*)(cb + cg_);
            const f32x4 w0u = *(const f32x4*)(cw + DFF + cg_), w1u = *(const f32x4*)(cw + NUP + DFF + cg_), w2u = *(const f32x4*)(cw + 2 * NUP + DFF + cg_), bu = *(const f32x4*)(cb + DFF + cg_);
#pragma unroll
            for (int ai = 0; ai < 2; ++ai) {
                f32x4 pg = {0.f, 0.f, 0.f, 0.f}, pu = {0.f, 0.f, 0.f, 0.f};
#pragma unroll
                for (int m = 0; m < 4; ++m) {
                    const int row = row0 + ai * 128 + m * 16;
                    const f32x4 g = acc[ai][0][m][n] * rs[ai][m], up = acc[ai][1][m][n] * rs[ai][m];
                    if (m == 0 && fr < 2) { float* rp = raw + ((size_t)(row >> 6) * 4 + 2 + fr) * NUP + cg_; *(f32x4*)rp = g; *(f32x4*)(rp + DFF) = up; }
                    if (m == 3 && fr >= 14) { float* rp = raw + ((size_t)(row >> 6) * 4 + (fr - 14)) * NUP + cg_; *(f32x4*)rp = g; *(f32x4*)(rp + DFF) = up; }
                    f32x4 o;
#pragma unroll
                    for (int j = 0; j < 4; ++j) {
                        const float g1 = dppf<0x121>(fr == 15 ? pg[j] : g[j]), g2 = dppf<0x122>(fr >= 14 ? pg[j] : g[j]);
                        const float u1 = dppf<0x121>(fr == 15 ? pu[j] : up[j]), u2 = dppf<0x122>(fr >= 14 ? pu[j] : up[j]);
                        const float ag = w0g[j] * g2 + w1g[j] * g1 + w2g[j] * g[j] + bg[j];
                        const float au = w0u[j] * u2 + w1u[j] * u1 + w2u[j] * up[j] + bu[j];
                        o[j] = silu_(ag) * au; }
                    v2u w; w.x = pk2(o[0], o[1]); w.y = pk2(o[2], o[3]);
                    *(v2u*)(act + (size_t)row * DFF + cg_) = w;
                    pg = g; pu = up; } } }
    }
};

template <int RT, class F>
__device__ __forceinline__ void skinny_gemm(LAS unsigned char* lds, const bf16* A, const bf16* Bt, int N, int K, int u0, int ustride, const F& f) {
    const int tid = threadIdx.x, lane = tid & 63, w = tid >> 6, fr = lane & 15, fq = lane >> 4;
    constexpr int nrb = 8 / RT, ROWS = 16 * RT;
    const int nunits = nrb * (N / 32), kw = K / 8;
    LAS float* red = (LAS float*)lds;
    for (int u = u0; u < nunits; u += ustride) {
        const int rb = u % nrb, cb = u / nrb, row0 = rb * ROWS, col0 = cb * 32;
        f32x4 acc[RT][2];
#pragma unroll
        for (int rt = 0; rt < RT; ++rt) { acc[rt][0] = (f32x4){0.f, 0.f, 0.f, 0.f}; acc[rt][1] = (f32x4){0.f, 0.f, 0.f, 0.f}; }
        const bf16* ap = A + (size_t)(row0 + fr) * K + w * kw + 8 * fq;
        const bf16* bp = Bt + (size_t)(col0 + fr) * K + w * kw + 8 * fq;
#pragma unroll 2
        for (int k = 0; k < kw; k += 32) {
            const bf16x8 b0 = *(const bf16x8*)(bp + k), b1 = *(const bf16x8*)(bp + (size_t)16 * K + k);
#pragma unroll
            for (int rt = 0; rt < RT; ++rt) { const bf16x8 av = *(const bf16x8*)(ap + (size_t)rt * 16 * K + k);
                acc[rt][0] = __builtin_amdgcn_mfma_f32_16x16x32_bf16(b0, av, acc[rt][0], 0, 0, 0);
                acc[rt][1] = __builtin_amdgcn_mfma_f32_16x16x32_bf16(b1, av, acc[rt][1], 0, 0, 0); }
        }
#pragma unroll
        for (int rt = 0; rt < RT; ++rt)
#pragma unroll
            for (int ct = 0; ct < 2; ++ct) *(LAS f32x4*)(red + (w * ROWS + 16 * rt + fr) * 32 + 16 * ct + 4 * fq) = acc[rt][ct];
        __syncthreads();
#pragma unroll
        for (int it = 0; it < RT; ++it) { const int e = tid + 512 * it, r = e >> 5, c = e & 31; float v = 0.f;
#pragma unroll
            for (int ww = 0; ww < 8; ++ww) v += red[(ww * ROWS + r) * 32 + c];
            f(row0 + r, col0 + c, v); }
        __syncthreads();
    }
}
__device__ __forceinline__ float half_wave_sum(float v) {
#pragma unroll
    for (int o = 1; o < 32; o <<= 1) v += __shfl_xor(v, o);
    return v;
}

__device__ __forceinline__ void transpose_item(const float* W, int K, int N, const float* g, bf16* WT, bool upmap, LAS float* scr, int item, int lane) {
    const int nblk = N / 64, kb = item / nblk, nb = item % nblk, k0 = 64 * kb, n0 = 64 * nb;
    const float* src = W + (size_t)k0 * N + n0 + lane;
#pragma unroll
    for (int h = 0; h < 2; ++h) {
        float v[32];
#pragma unroll
        for (int i = 0; i < 32; ++i) v[i] = src[(size_t)(32 * h + i) * N];
#pragma unroll
        for (int i = 0; i < 32; ++i) { float x = v[i]; if (g) x *= g[k0 + 32 * h + i]; scr[(32 * h + i) * 65 + lane] = x; }
    }
    LDS_WAIT(); asm volatile("" ::: "memory");
    const int c = lane & 7;
#pragma unroll
    for (int j = 0; j < 8; ++j) { const int n = (lane >> 3) + 8 * j; const LAS float* s = scr + (8 * c) * 65 + n;
        v4u o; o.x = pk2(s[0 * 65], s[1 * 65]); o.y = pk2(s[2 * 65], s[3 * 65]); o.z = pk2(s[4 * 65], s[5 * 65]); o.w = pk2(s[6 * 65], s[7 * 65]);
        int R = n0 + n; if (upmap) { const int half = R >= DFF ? 1 : 0, jj = R - half * DFF; R = 256 * (jj >> 7) + 128 * half + (jj & 127); }
        *(v4u*)(WT + (size_t)R * K + k0 + 8 * c) = o; }
    LDS_WAIT(); asm volatile("" ::: "memory");
}
__device__ __forceinline__ void rms_row_to_bf16(const float* xrow, bf16* orow, int lane) {
    const f32x4* xr = (const f32x4*)xrow + lane;
    f32x4 v[8]; float s = 0.f;
#pragma unroll
    for (int j = 0; j < 8; ++j) { v[j] = xr[64 * j]; s += (v[j][0] * v[j][0] + v[j][1] * v[j][1]) + (v[j][2] * v[j][2] + v[j][3] * v[j][3]); }
    const float r = __builtin_amdgcn_rsqf(wave_sum(s) * (1.0f / D) + EPS);
    v2u* o8 = (v2u*)orow + lane;
#pragma unroll
    for (int j = 0; j < 8; ++j) { v2u w; w.x = pk2(v[j][0] * r, v[j][1] * r); w.y = pk2(v[j][2] * r, v[j][3] * r); o8[64 * j] = w; }
}

__device__ __forceinline__ void mm128(f32x4 (&acc)[8], const LAS bf16* A, const LAS bf16* B, int wave, int fr, int fq) {
#pragma unroll
    for (int ks = 0; ks < 4; ++ks) {
        const bf16x8 a = *(const LAS bf16x8*)(A + (16 * wave + fr) * LDP + 32 * ks + 8 * fq);
#pragma unroll
        for (int ct = 0; ct < 8; ++ct) { const bf16x8 b = *(const LAS bf16x8*)(B + (16 * ct + fr) * LDP + 32 * ks + 8 * fq);
            acc[ct] = __builtin_amdgcn_mfma_f32_16x16x32_bf16(b, a, acc[ct], 0, 0, 0); }
    }
}
template <bool TRANS, bool DEC>
__device__ __forceinline__ void stage_rope(LAS bf16* dst, const bf16* zb, const float* rope, float scale, float l2g, int tid) {
#pragma unroll
    for (int it = 0; it < 2; ++it) { const int idx = tid + 512 * it, j = idx >> 3, d8 = idx & 7;
        const v4u x1 = *(const v4u*)(zb + (size_t)j * NIN + 8 * d8), x2 = *(const v4u*)(zb + (size_t)j * NIN + 64 + 8 * d8);
        const f32x4* rp = (const f32x4*)(rope + (size_t)(j * 64 + 8 * d8) * 2);
        float sc = scale; if (DEC) sc *= __builtin_amdgcn_exp2f(l2g * (float)(127 - j));
        float o1[8], o2[8];
#pragma unroll
        for (int p = 0; p < 4; ++p) { const f32x4 cs = rp[p]; const float a0 = lo16(x1[p]), a1 = hi16(x1[p]), b0 = lo16(x2[p]), b1 = hi16(x2[p]);
            o1[2 * p] = (a0 * cs[0] - b0 * cs[1]) * sc; o2[2 * p] = (b0 * cs[0] + a0 * cs[1]) * sc;
            o1[2 * p + 1] = (a1 * cs[2] - b1 * cs[3]) * sc; o2[2 * p + 1] = (b1 * cs[2] + a1 * cs[3]) * sc; }
        if (!TRANS) { v4u w1, w2;
#pragma unroll
            for (int p = 0; p < 4; ++p) { w1[p] = pk2(o1[2 * p], o1[2 * p + 1]); w2[p] = pk2(o2[2 * p], o2[2 * p + 1]); }
            *(LAS v4u*)(dst + j * LDP + 8 * d8) = w1; *(LAS v4u*)(dst + j * LDP + 64 + 8 * d8) = w2; }
        else {
#pragma unroll
            for (int i = 0; i < 8; ++i) { dst[(8 * d8 + i) * LDP + j] = f2bf(o1[i]); dst[(64 + 8 * d8 + i) * LDP + j] = f2bf(o2[i]); } }
    }
}
__device__ __forceinline__ void stage_T(LAS bf16* dst, const bf16* zb, int tid) {
#pragma unroll
    for (int it = 0; it < 4; ++it) { const int idx = tid + 512 * it, j = idx >> 4, c8 = idx & 15;
        const v4u x = *(const v4u*)(zb + (size_t)j * NIN + 8 * c8);
#pragma unroll
        for (int p = 0; p < 4; ++p) { dst[(8 * c8 + 2 * p) * LDP + j] = (bf16)(x[p] & 0xffffu); dst[(8 * c8 + 2 * p + 1) * LDP + j] = (bf16)(x[p] >> 16); } }
}

__global__ void __launch_bounds__(512, 2) mk_fwd(Params a) {
    extern __shared__ __attribute__((aligned(16))) unsigned char lds_raw[];
    LAS unsigned char* lds = (LAS unsigned char*)lds_raw;
    const int tid = threadIdx.x, lane = tid & 63, wave = __builtin_amdgcn_readfirstlane(tid >> 6), fr = lane & 15, fq = lane >> 4;
    const int G = gridDim.x, blk = blockIdx.x;
    const int gw = blk * 8 + wave, NGW = G * 8;
    const int gt = blk * 512 + tid, NGT = G * 512;
    unsigned char* ws = a.ws;
    const float* x_p = a.in[0]; const float* x_s = a.in[1]; const float* p_p = a.in[2]; const float* p_s = a.in[3];
    const float* state_ret = a.in[4]; const float* state_conv = a.in[5];
    const float* gm_ln_g = a.in[8]; const float* gm_ln_b = a.in[9]; const float* gm_ws = a.in[10]; const float* gm_bs = a.in[11];
    const float* conv_w = a.in[15]; const float* conv_b = a.in[16]; const float* g_final = a.in[21];
    float* out = a.out;
    float* SS1 = (float*)(ws + WS_SS1); float* SS2 = (float*)(ws + WS_SS2); float* SS3 = (float*)(ws + WS_SS3); float* STATS = (float*)(ws + WS_STATS);
    float* ROPE = (float*)(ws + WS_ROPE); float* ROPES = (float*)(ws + WS_ROPES);
    bf16* Win_t = (bf16*)(ws + WS_WIN); bf16* Wo_t = (bf16*)(ws + WS_WO); bf16* Wup_t = (bf16*)(ws + WS_WUP); bf16* Wdn_t = (bf16*)(ws + WS_WDN); bf16* Wg_t = (bf16*)(ws + WS_WG); bf16* Wp_t = (bf16*)(ws + WS_WP);
    bf16* AB = (bf16*)(ws + WS_AB); bf16* PB = (bf16*)(ws + WS_PB); bf16* MIX = (bf16*)(ws + WS_MIX); bf16* Z = (bf16*)(ws + WS_Z); bf16* ACT = (bf16*)(ws + WS_ACT);
    float* KV = (float*)(ws + WS_KV); float* PP = (float*)(ws + WS_PP); float* RAW = (float*)(ws + WS_RAW); float* AS = (float*)(ws + WS_AS);

    volatile LAS unsigned* MISC = (volatile LAS unsigned*)(lds + MISC_OFF);
    if (tid < 64) MISC[tid] = 0u;
    __syncthreads();
    XcdBarrier bar; bar.bar = (unsigned*)(ws + WS_BAR); bar.x = 0; bar.st = nullptr;
    if (MK_N_LAUNCHES == 1) bar = xcd_barrier_post((unsigned*)(ws + WS_BAR), MISC + 8);
    const int lo = a.ph_lo, hi = a.ph_hi;
#ifndef PHMASK
#define PHMASK 0xffff
#endif
#define IN(k) (((PHMASK >> (k)) & 1) && lo <= (k) && (k) < hi)
#define SEAM(k) do { if (IN(k) && IN((k) + 1)) { if (a.use_cg) cg::this_grid().sync(); else xcd_barrier(bar); } } while (0)

    if (IN(0)) {
        LAS float* scr = (LAS float*)(lds + wave * 16640);
        constexpr int I_IN = (D / 64) * (NIN / 64), I_O = (D / 64) * (D / 64), I_UP = (D / 64) * (NUP / 64), I_DN = (DFF / 64) * (D / 64), I_G = I_O, I_P = (PLE / 64) * (D / 64);
        constexpr int NITEMS = I_IN + I_O + I_UP + I_DN + I_G + I_P;
        for (int it = gw; it < NITEMS; it += NGW) {
            int r = it;
            if (r < I_UP) { transpose_item(a.in[14], D, NUP, a.in[13], Wup_t, true, scr, r, lane); continue; } r -= I_UP;
            if (r < I_IN) { transpose_item(a.in[7], D, NIN, a.in[6], Win_t, false, scr, r, lane); continue; } r -= I_IN;
            if (r < I_DN) { transpose_item(a.in[17], DFF, D, nullptr, Wdn_t, false, scr, r, lane); continue; } r -= I_DN;
            if (r < I_O) { transpose_item(a.in[12], D, D, nullptr, Wo_t, false, scr, r, lane); continue; } r -= I_O;
            if (r < I_G) { transpose_item(a.in[19], D, D, a.in[18], Wg_t, false, scr, r, lane); continue; } r -= I_G;
            transpose_item(a.in[20], PLE, D, nullptr, Wp_t, false, scr, r, lane);
        }
        for (int m = gw; m < MT; m += NGW) rms_row_to_bf16(m < MP ? x_p + (size_t)m * D : x_s + (size_t)(m - MP) * D, AB + (size_t)m * D, lane);
        for (int i = gt; i < MT * PLE / 4; i += NGT) { const f32x4 v = i < MP * PLE / 4 ? ((const f32x4*)p_p)[i] : ((const f32x4*)p_s)[i - MP * PLE / 4]; v2u w; w.x = pk2(v[0], v[1]); w.y = pk2(v[2], v[3]); ((v2u*)PB)[i] = w; }
        for (int i = gt; i < SEQ * 64 + 64; i += NGT) { const int pos = i < SEQ * 64 ? (i >> 6) : 16384, fi = i & 63;
            const float ang = (float)pos * a.invf[fi]; double t = (double)ang * 0.15915494309189535; t -= __builtin_rint(t); const float rev = (float)t;
            float* dst = i < SEQ * 64 ? ROPE + 2 * (size_t)i : ROPES + 2 * fi; dst[0] = __builtin_amdgcn_cosf(rev); dst[1] = __builtin_amdgcn_sinf(rev); }
        for (int i = gt; i < MT; i += NGT) { SS1[i] = 0.f; SS2[i] = 0.f; SS3[i] = 0.f; }
    }
    SEAM(0);

    if (IN(1)) {
        { pg8::Gemm g{AB, Win_t, MP, NIN, D}; pg8::StaticOrder S; S.init(MP, NIN, G, blk); EpiZ E{Z};
          pg8::gemm_phase<EpiZ, pg8::StaticOrder, true, true>(lds, g, S, E); }
        auto f = [&](int s, int n, float v) { const float o = n < 3072 ? v : (n < 4096 ? silu_(v) : gelu_(v)); Z[(size_t)(MP + s) * NIN + n] = f2bf(o); };
        skinny_gemm<2>(lds, AB + (size_t)MP * D, Win_t, NIN, D, blk, G, f);
    }
    SEAM(1);

    if (IN(2)) {
        { LAS float* qs = (LAS float*)lds; LAS float* ks = qs + 128; LAS float* vs = ks + 128; LAS float* red = vs + 128;
          for (int u = blk; u < MS * NH; u += G) { const int s = u >> 3, h = u & 7; const bf16* zr = Z + (size_t)(MP + s) * NIN;
            if (tid < 64) { const float c = ROPES[2 * tid], sn = ROPES[2 * tid + 1];
                const float q1 = bf2f(zr[128 * h + tid]), q2 = bf2f(zr[128 * h + 64 + tid]), k1 = bf2f(zr[1024 + 128 * h + tid]), k2 = bf2f(zr[1024 + 128 * h + 64 + tid]);
                qs[tid] = q1 * c - q2 * sn; qs[tid + 64] = q2 * c + q1 * sn; ks[tid] = (k1 * c - k2 * sn) * 0.08838834764831845f; ks[tid + 64] = (k2 * c + k1 * sn) * 0.08838834764831845f; }
            else if (tid < 192) vs[tid - 64] = bf2f(zr[2048 + 128 * h + tid - 64]);
            __syncthreads();
            const int e4 = tid & 31, dg = tid >> 5; const float gamma = 1.0f - __builtin_amdgcn_exp2f((float)(-5 - h));
            const f32x4 vv = *(const LAS f32x4*)(vs + 4 * e4); f32x4 o = {0.f, 0.f, 0.f, 0.f};
            const float* S0 = state_ret + (size_t)u * 16384 + 4 * e4; float* S1 = out + O_RETS + (size_t)u * 16384 + 4 * e4;
            f32x4 s0[8];
#pragma unroll
            for (int i = 0; i < 8; ++i) s0[i] = *(const f32x4*)(S0 + (dg + 16 * i) * 128);
#pragma unroll
            for (int i = 0; i < 8; ++i) { const int d = dg + 16 * i; const f32x4 sn = s0[i] * gamma + vv * ks[d]; *(f32x4*)(S1 + d * 128) = sn; o += sn * qs[d]; }
            *(LAS f32x4*)(red + dg * 128 + 4 * e4) = o;
            __syncthreads();
            if (tid < 64) { float o0 = 0.f, o1 = 0.f;
#pragma unroll
                for (int i = 0; i < 16; ++i) { o0 += red[i * 128 + 2 * tid]; o1 += red[i * 128 + 2 * tid + 1]; }
                const float r = __builtin_amdgcn_rsqf(wave_sum(o0 * o0 + o1 * o1) * (1.0f / 128.0f) + EPS);
                const unsigned gg = *(const unsigned*)(zr + 3072 + 128 * h + 2 * tid);
                *(unsigned*)(MIX + (size_t)(MP + s) * D + 128 * h + 2 * tid) = pk2(o0 * r * lo16(gg), o1 * r * hi16(gg)); }
            __syncthreads(); } }
        { LAS bf16* Kt = (LAS bf16*)lds; LAS bf16* Vt = (LAS bf16*)(lds + TILE_B);
          for (int u = blk; u < 512; u += G) { const int b = u >> 7, h = (u >> 4) & 7, c = u & 15; const size_t R0 = (size_t)b * SEQ + 128 * c;
            stage_rope<true, true>(Kt, Z + R0 * NIN + 1024 + 128 * h, ROPE + (size_t)(128 * c) * 128, 0.08838834764831845f, a.log2g[h], tid);
            stage_T(Vt, Z + R0 * NIN + 2048 + 128 * h, tid);
            __syncthreads();
            f32x4 acc[8];
#pragma unroll
            for (int ct = 0; ct < 8; ++ct) acc[ct] = (f32x4){0.f, 0.f, 0.f, 0.f};
            mm128(acc, Kt, Vt, wave, fr, fq);
            float* kv = KV + (size_t)u * 16384 + (16 * wave + fr) * 128 + 4 * fq;
#pragma unroll
            for (int ct = 0; ct < 8; ++ct) *(f32x4*)(kv + 16 * ct) = acc[ct];
            __syncthreads(); } }
        for (int row = gw; row < MT; row += NGW) { const bf16* p = Z + (size_t)row * NIN + 5120 + 16 * lane; const v4u x0 = *(const v4u*)p, x1 = *(const v4u*)(p + 8);
            float v[16];
#pragma unroll
            for (int j = 0; j < 4; ++j) { v[2 * j] = lo16(x0[j]); v[2 * j + 1] = hi16(x0[j]); v[8 + 2 * j] = lo16(x1[j]); v[8 + 2 * j + 1] = hi16(x1[j]); }
            float s = 0.f;
#pragma unroll
            for (int j = 0; j < 16; ++j) s += v[j];
            const float mean = wave_sum(s) * (1.0f / 1024.0f); float q = 0.f;
#pragma unroll
            for (int j = 0; j < 16; ++j) { v[j] -= mean; q += v[j] * v[j]; }
            const float rstd = __builtin_amdgcn_rsqf(wave_sum(q) * (1.0f / 1024.0f) + EPS);
            if (row < MP) { if (lane == 0) { STATS[2 * row] = mean; STATS[2 * row + 1] = rstd; } }
            else { const int s_ = row - MP, c0 = 16 * lane, grp = lane >> 3; const float w00 = gm_ws[grp * 16384], b0 = gm_bs[grp * 128];
                const bf16* up = Z + (size_t)row * NIN + 4096 + c0; const v4u u0 = *(const v4u*)up, u1 = *(const v4u*)(up + 8);
                float uu[16];
#pragma unroll
                for (int j = 0; j < 4; ++j) { uu[2 * j] = lo16(u0[j]); uu[2 * j + 1] = hi16(u0[j]); uu[8 + 2 * j] = lo16(u1[j]); uu[8 + 2 * j + 1] = hi16(u1[j]); }
                float vn[16], mo[16];
#pragma unroll
                for (int j = 0; j < 16; ++j) { vn[j] = v[j] * rstd * gm_ln_g[c0 + j] + gm_ln_b[c0 + j]; mo[j] = uu[j] * (w00 * vn[j] + b0); }
                float* gv = out + O_GMV + (size_t)s_ * 1024 + c0;
#pragma unroll
                for (int j = 0; j < 4; ++j) *(f32x4*)(gv + 4 * j) = (f32x4){vn[4 * j], vn[4 * j + 1], vn[4 * j + 2], vn[4 * j + 3]};
                v4u w0, w1;
#pragma unroll
                for (int j = 0; j < 4; ++j) { w0[j] = pk2(mo[2 * j], mo[2 * j + 1]); w1[j] = pk2(mo[8 + 2 * j], mo[8 + 2 * j + 1]); }
                bf16* mp = MIX + (size_t)row * D + 1024 + c0; *(v4u*)mp = w0; *(v4u*)(mp + 8) = w1; } }
    }
    SEAM(2);

    if (IN(3)) {
        LAS bf16* T0 = (LAS bf16*)lds; LAS bf16* T1 = (LAS bf16*)(lds + TILE_B); LAS bf16* T2 = (LAS bf16*)(lds + 2 * TILE_B); LAS bf16* T3 = (LAS bf16*)(lds + 3 * TILE_B);
        for (int u = blk; u < 512; u += G) { const int b = u >> 7, h = (u >> 4) & 7, c = u & 15; const size_t R0 = (size_t)b * SEQ + 128 * c; const float l2g = a.log2g[h];
            stage_rope<false, false>(T0, Z + R0 * NIN + 128 * h, ROPE + (size_t)(128 * c) * 128, 1.0f, 0.f, tid);
            stage_rope<false, false>(T1, Z + R0 * NIN + 1024 + 128 * h, ROPE + (size_t)(128 * c) * 128, 0.08838834764831845f, 0.f, tid);
            stage_T(T2, Z + R0 * NIN + 2048 + 128 * h, tid);
            { const float Gc = __builtin_amdgcn_exp2f(l2g * 128.0f); const float* kvb = KV + (size_t)(u - c) * 16384;
              f32x4 sp[8];
#pragma unroll
              for (int i = 0; i < 8; ++i) sp[i] = (f32x4){0.f, 0.f, 0.f, 0.f};
              for (int j = 0; j < c; ++j) {
#pragma unroll
                  for (int i = 0; i < 8; ++i) sp[i] = sp[i] * Gc + *(const f32x4*)(kvb + (size_t)j * 16384 + 4 * (tid + 512 * i)); }
              if (c == 15) {
#pragma unroll
                  for (int i = 0; i < 8; ++i) *(f32x4*)(out + O_RETP + (size_t)(b * 8 + h) * 16384 + 4 * (tid + 512 * i)) = sp[i] * Gc + *(const f32x4*)(kvb + (size_t)15 * 16384 + 4 * (tid + 512 * i)); }
#pragma unroll
              for (int i = 0; i < 8; ++i) { const int ch = tid + 512 * i, d = ch >> 5, e4 = ch & 31;
#pragma unroll
                  for (int t = 0; t < 4; ++t) T3[(4 * e4 + t) * LDP + d] = f2bf(sp[i][t]); } }
            __syncthreads();
            f32x4 acc2[8], acc1[8];
#pragma unroll
            for (int ct = 0; ct < 8; ++ct) { acc2[ct] = (f32x4){0.f, 0.f, 0.f, 0.f}; acc1[ct] = (f32x4){0.f, 0.f, 0.f, 0.f}; }
            mm128(acc2, T0, T3, wave, fr, fq);
            mm128(acc1, T0, T1, wave, fr, fq);
            __syncthreads();
            const int i_ = 16 * wave + fr;
#pragma unroll
            for (int ct = 0; ct < 8; ++ct) { float sv[4];
#pragma unroll
                for (int t = 0; t < 4; ++t) { const int j = 16 * ct + 4 * fq + t; sv[t] = i_ >= j ? acc1[ct][t] * __builtin_amdgcn_exp2f(l2g * (float)(i_ - j)) : 0.f; }
                v2u w; w.x = pk2(sv[0], sv[1]); w.y = pk2(sv[2], sv[3]); *(LAS v2u*)(T1 + i_ * LDP + 16 * ct + 4 * fq) = w; }
            __syncthreads();
#pragma unroll
            for (int ct = 0; ct < 8; ++ct) acc1[ct] = (f32x4){0.f, 0.f, 0.f, 0.f};
            mm128(acc1, T1, T2, wave, fr, fq);
            const float qd = __builtin_amdgcn_exp2f(l2g * (float)(i_ + 1)); float ssq = 0.f;
#pragma unroll
            for (int ct = 0; ct < 8; ++ct) { acc1[ct] = acc1[ct] + acc2[ct] * qd; ssq += (acc1[ct][0] * acc1[ct][0] + acc1[ct][1] * acc1[ct][1]) + (acc1[ct][2] * acc1[ct][2] + acc1[ct][3] * acc1[ct][3]); }
            ssq += __shfl_xor(ssq, 16); ssq += __shfl_xor(ssq, 32);
            const float rn = __builtin_amdgcn_rsqf(ssq * (1.0f / 128.0f) + EPS);
            const bf16* gp = Z + (R0 + i_) * NIN + 3072 + 128 * h + 4 * fq; bf16* mp = MIX + (R0 + i_) * D + 128 * h + 4 * fq;
#pragma unroll
            for (int ct = 0; ct < 8; ++ct) { const v2u gg = *(const v2u*)(gp + 16 * ct); v2u w;
                w.x = pk2(acc1[ct][0] * rn * lo16(gg.x), acc1[ct][1] * rn * hi16(gg.x)); w.y = pk2(acc1[ct][2] * rn * lo16(gg.y), acc1[ct][3] * rn * hi16(gg.y)); *(v2u*)(mp + 16 * ct) = w; }
            __syncthreads(); }
        for (int u = blk; u < 512; u += G) { const int b = u >> 7, c = (u >> 3) & 15, grp = u & 7; const size_t R0 = (size_t)b * SEQ + 128 * c;
#pragma unroll
            for (int it = 0; it < 4; ++it) { const int idx = tid + 512 * it, t = idx >> 4, s8 = idx & 15; const float* wp = gm_ws + (size_t)grp * 16384 + t * 128 + 8 * s8;
                const f32x4 w0 = *(const f32x4*)wp, w1 = *(const f32x4*)(wp + 4); float wv[8] = {w0[0], w0[1], w0[2], w0[3], w1[0], w1[1], w1[2], w1[3]};
#pragma unroll
                for (int j = 0; j < 8; ++j) if (8 * s8 + j > t) wv[j] = 0.f;
                v4u w; w.x = pk2(wv[0], wv[1]); w.y = pk2(wv[2], wv[3]); w.z = pk2(wv[4], wv[5]); w.w = pk2(wv[6], wv[7]); *(LAS v4u*)(T0 + t * LDP + 8 * s8) = w; }
#pragma unroll
            for (int it = 0; it < 4; ++it) { const int idx = tid + 512 * it, s = idx >> 4, d8 = idx & 15; const v4u x = *(const v4u*)(Z + (R0 + s) * NIN + 5120 + 128 * grp + 8 * d8);
                const float mean = STATS[2 * (R0 + s)], rstd = STATS[2 * (R0 + s) + 1]; const float* lg = gm_ln_g + 128 * grp + 8 * d8; const float* lb = gm_ln_b + 128 * grp + 8 * d8;
#pragma unroll
                for (int p = 0; p < 4; ++p) { T1[(8 * d8 + 2 * p) * LDP + s] = f2bf((lo16(x[p]) - mean) * rstd * lg[2 * p] + lb[2 * p]); T1[(8 * d8 + 2 * p + 1) * LDP + s] = f2bf((hi16(x[p]) - mean) * rstd * lg[2 * p + 1] + lb[2 * p + 1]); } }
            __syncthreads();
            f32x4 acc[8];
#pragma unroll
            for (int ct = 0; ct < 8; ++ct) acc[ct] = (f32x4){0.f, 0.f, 0.f, 0.f};
            mm128(acc, T0, T1, wave, fr, fq);
            const int t_ = 16 * wave + fr; const float bsv = gm_bs[grp * 128 + t_];
            const bf16* up = Z + (R0 + t_) * NIN + 4096 + 128 * grp + 4 * fq; bf16* mp = MIX + (R0 + t_) * D + 1024 + 128 * grp + 4 * fq;
#pragma unroll
            for (int ct = 0; ct < 8; ++ct) { const v2u uu = *(const v2u*)(up + 16 * ct); v2u w;
                w.x = pk2((acc[ct][0] + bsv) * lo16(uu.x), (acc[ct][1] + bsv) * hi16(uu.x)); w.y = pk2((acc[ct][2] + bsv) * lo16(uu.y), (acc[ct][3] + bsv) * hi16(uu.y)); *(v2u*)(mp + 16 * ct) = w; }
            __syncthreads(); }
    }
    SEAM(3);

    if (IN(4)) {
        { pg8::Gemm g{MIX, Wo_t, MP, D, D}; pg8::StaticOrder S; S.init(MP, D, G, blk); EpiRes E{x_p, out, AB, SS1};
          pg8::gemm_phase<EpiRes, pg8::StaticOrder, true, true>(lds, g, S, E); }
        auto f = [&](int s, int n, float v) { const float o = x_s[(size_t)s * D + n] + v; out[(size_t)(MP + s) * D + n] = o; AB[(size_t)(MP + s) * D + n] = f2bf(o);
            const float q = half_wave_sum(o * o); if ((lane & 31) == 0) atomic_addf(SS1 + MP + s, q); };
        skinny_gemm<2>(lds, MIX + (size_t)MP * D, Wo_t, D, D, blk, G, f);
    }
    SEAM(4);

    if (IN(5)) {
        { pg8::Gemm g{AB, Wup_t, MP, NUP, D}; pg8::StaticOrder S; S.init(MP, NUP, G, blk); EpiUp E{ACT, RAW, SS1, conv_w, conv_b};
          pg8::gemm_phase<EpiUp, pg8::StaticOrder, true, true>(lds, g, S, E); }
        auto f = [&](int s, int n, float v) { const int within = n & 255, col = (within >> 7) * DFF + 128 * (n >> 8) + (within & 127);
            AS[(size_t)s * NUP + col] = v * __builtin_amdgcn_rsqf(SS1[MP + s] * (1.0f / D) + EPS); };
        if (blk >= 128) skinny_gemm<8>(lds, AB + (size_t)MP * D, Wup_t, NUP, D, blk - 128, 128, f);
    }
    SEAM(5);

    if (IN(6)) {
        for (int i = gt; i < 128 * 2 * (DFF / 4); i += NGT) { const int c4 = i % (DFF / 4), gr = i / (DFF / 4), rr = gr & 1, Gp = gr >> 1, c = 4 * c4; const bool first = (Gp & 31) == 0;
            const float* rg = RAW + (size_t)Gp * 4 * NUP; const float* rp = rg - 4 * NUP; const f32x4 z4 = {0.f, 0.f, 0.f, 0.f};
            f32x4 a0g, a0u, a1g, a1u, a2g, a2u;
            a0g = *(const f32x4*)(rg + (2 + rr) * NUP + c); a0u = *(const f32x4*)(rg + (2 + rr) * NUP + DFF + c);
            if (rr) { a1g = *(const f32x4*)(rg + 2 * NUP + c); a1u = *(const f32x4*)(rg + 2 * NUP + DFF + c); a2g = first ? z4 : *(const f32x4*)(rp + NUP + c); a2u = first ? z4 : *(const f32x4*)(rp + NUP + DFF + c); }
            else { a1g = first ? z4 : *(const f32x4*)(rp + NUP + c); a1u = first ? z4 : *(const f32x4*)(rp + NUP + DFF + c); a2g = first ? z4 : *(const f32x4*)(rp + c); a2u = first ? z4 : *(const f32x4*)(rp + DFF + c); }
            const f32x4 ag = *(const f32x4*)(conv_w + c) * a2g + *(const f32x4*)(conv_w + NUP + c) * a1g + *(const f32x4*)(conv_w + 2 * NUP + c) * a0g + *(const f32x4*)(conv_b + c);
            const f32x4 au = *(const f32x4*)(conv_w + DFF + c) * a2u + *(const f32x4*)(conv_w + NUP + DFF + c) * a1u + *(const f32x4*)(conv_w + 2 * NUP + DFF + c) * a0u + *(const f32x4*)(conv_b + DFF + c);
            v2u w; w.x = pk2(silu_(ag[0]) * au[0], silu_(ag[1]) * au[1]); w.y = pk2(silu_(ag[2]) * au[2], silu_(ag[3]) * au[3]);
            *(v2u*)(ACT + (size_t)(64 * Gp + rr) * DFF + c) = w; }
        for (int i = gt; i < MS * (DFF / 4); i += NGT) { const int c4 = i % (DFF / 4), s = i / (DFF / 4), c = 4 * c4;
            const float* sc0 = state_conv + (size_t)s * 2 * NUP; const float* sc1 = sc0 + NUP; const float* as = AS + (size_t)s * NUP;
            const f32x4 a0g = *(const f32x4*)(as + c), a0u = *(const f32x4*)(as + DFF + c), a1g = *(const f32x4*)(sc1 + c), a1u = *(const f32x4*)(sc1 + DFF + c), a2g = *(const f32x4*)(sc0 + c), a2u = *(const f32x4*)(sc0 + DFF + c);
            const f32x4 ag = *(const f32x4*)(conv_w + c) * a2g + *(const f32x4*)(conv_w + NUP + c) * a1g + *(const f32x4*)(conv_w + 2 * NUP + c) * a0g + *(const f32x4*)(conv_b + c);
            const f32x4 au = *(const f32x4*)(conv_w + DFF + c) * a2u + *(const f32x4*)(conv_w + NUP + DFF + c) * a1u + *(const f32x4*)(conv_w + 2 * NUP + DFF + c) * a0u + *(const f32x4*)(conv_b + DFF + c);
            v2u w; w.x = pk2(silu_(ag[0]) * au[0], silu_(ag[1]) * au[1]); w.y = pk2(silu_(ag[2]) * au[2], silu_(ag[3]) * au[3]);
            *(v2u*)(ACT + (size_t)(MP + s) * DFF + c) = w;
            float* cs = out + O_CONVS + (size_t)s * 2 * NUP; *(f32x4*)(cs + c) = a1g; *(f32x4*)(cs + DFF + c) = a1u; *(f32x4*)(cs + NUP + c) = a0g; *(f32x4*)(cs + NUP + DFF + c) = a0u; }
        for (int i = gt; i < 4 * 2 * (NUP / 4); i += NGT) { const int c4 = i % (NUP / 4), bk = i / (NUP / 4), b = bk >> 1, k = bk & 1;
            *(f32x4*)(out + O_CONVP + (size_t)bk * NUP + 4 * c4) = *(const f32x4*)(RAW + ((size_t)(32 * b + 31) * 4 + k) * NUP + 4 * c4); }
    }
    SEAM(6);

    if (IN(7)) {
        { pg8::Gemm g{ACT, Wdn_t, MP, D, DFF}; pg8::StaticOrder S; S.init(MP, D, G, blk); EpiRes E{out, out, AB, SS2};
          pg8::gemm_phase<EpiRes, pg8::StaticOrder, true, true>(lds, g, S, E); }
        auto f = [&](int s, int n, float v) { const size_t o_ = (size_t)(MP + s) * D + n; const float o = out[o_] + v; out[o_] = o; AB[o_] = f2bf(o);
            const float q = half_wave_sum(o * o); if ((lane & 31) == 0) atomic_addf(SS2 + MP + s, q); };
        skinny_gemm<2>(lds, ACT + (size_t)MP * DFF, Wdn_t, D, DFF, blk, G, f);
    }
    SEAM(7);

    if (IN(8)) {
#ifndef T_A
        { int Kp = PLE; asm volatile("" : "+s"(Kp));
          pg8::Gemm g{PB, Wp_t, MP, D, Kp}; pg8::StaticOrder S; S.init(MP, D, G, blk); EpiPP E{PP};
          pg8::gemm_phase<EpiPP, pg8::StaticOrder, true, true>(lds, g, S, E); }
#endif
#ifndef T_B
        { pg8::Gemm g{AB, Wg_t, MP, D, D}; pg8::StaticOrder S; S.init(MP, D, G, blk); EpiGate E{PP, out, SS2, SS3};
          pg8::gemm_phase<EpiGate, pg8::StaticOrder, true, true>(lds, g, S, E); }
#endif
#ifndef T_C
        auto f1 = [&](int s, int n, float v) { PP[(size_t)(MP + s) * D + n] = v; };
        skinny_gemm<2>(lds, PB + (size_t)MP * PLE, Wp_t, D, PLE, blk, G, f1);
#endif
#ifndef T_D
        auto f2 = [&](int s, int n, float v) { const size_t o_ = (size_t)(MP + s) * D + n; const float r2 = __builtin_amdgcn_rsqf(SS2[MP + s] * (1.0f / D) + EPS);
            const float o = out[o_] + PP[o_] * sigmoid_(r2 * v); out[o_] = o; const float q = half_wave_sum(o * o); if ((lane & 31) == 0) atomic_addf(SS3 + MP + s, q); };
        skinny_gemm<2>(lds, AB + (size_t)MP * D, Wg_t, D, D, blk, G, f2);
#endif
    }
    SEAM(8);

    if (IN(9)) {
        for (int m = gw; m < MT; m += NGW) { f32x4* hr = (f32x4*)(out + (size_t)m * D) + lane; const f32x4* gr = (const f32x4*)g_final + lane;
            const float r = __builtin_amdgcn_rsqf(SS3[m] * (1.0f / D) + EPS);
#pragma unroll
            for (int j = 0; j < 8; ++j) hr[64 * j] = hr[64 * j] * gr[64 * j] * r; }
    }
#undef IN
#undef SEAM
}

extern "C" void kernel_launch(void* const* d_in, const int* in_sizes, int n_in, void* d_out, int out_size, void* d_ws, size_t ws_size, hipStream_t stream) {
    static int grid = 0;
    if (grid == 0) {
        if (n_in != 22 || out_size != (int)O_END || ws_size < WS_END) { fprintf(stderr, "kernel_launch: unexpected shapes: n_in %d out %d ws %zu\n", n_in, out_size, ws_size); grid = -1; return; }
        int dev = 0, cus = 0, per_cu = 0;
        if (hipGetDevice(&dev) != hipSuccess || hipDeviceGetAttribute(&cus, hipDeviceAttributeMultiprocessorCount, dev) != hipSuccess) { grid = -1; return; }
        if (hipFuncSetAttribute((const void*)mk_fwd, hipFuncAttributeMaxDynamicSharedMemorySize, LDS_BYTES) != hipSuccess) { fprintf(stderr, "kernel_launch: hipFuncSetAttribute failed\n"); grid = -1; return; }
        if (hipOccupancyMaxActiveBlocksPerMultiprocessor(&per_cu, (const void*)mk_fwd, 512, LDS_BYTES) != hipSuccess || per_cu < 1) fprintf(stderr, "kernel_launch: occupancy query says %d\n", per_cu);
        (void)hipGetLastError();
        grid = cus;
        if (grid != 256) fprintf(stderr, "kernel_launch: %d CUs (built for 256)\n", grid);
    }
    if (grid < 0) return;
    if (hipMemsetAsync((char*)d_ws + WS_BAR, 0, BAR_BYTES, stream) != hipSuccess) { fprintf(stderr, "kernel_launch: memset failed\n"); return; }
    Params p{};
    for (int i = 0; i < 22; ++i) p.in[i] = (const float*)d_in[i];
    p.out = (float*)d_out; p.ws = (unsigned char*)d_ws;
    for (int h = 0; h < 8; ++h) p.log2g[h] = (float)std::log2(1.0 - std::exp2(-5.0 - (double)h));
    for (int i = 0; i < 64; ++i) p.invf[i] = powf(10000.0f, -(float)i / 64.0f);
    p.use_cg = 0; p.pad = 0;
#if MK_N_LAUNCHES == 1
    p.ph_lo = 0; p.ph_hi = NPHASE;
    void* args[] = {&p};
    hipError_t e = hipLaunchCooperativeKernel((const void*)mk_fwd, dim3(grid), dim3(512), args, LDS_BYTES, stream);
    if (e != hipSuccess) fprintf(stderr, "kernel_launch: cooperative launch failed: %s\n", hipGetErrorString(e));
#else
    for (int ph = 0; ph < NPHASE; ++ph) { p.ph_lo = ph; p.ph_hi = ph + 1; hipLaunchKernelGGL(mk_fwd, dim3(grid), dim3(512), LDS_BYTES, stream, p); }
#endif
}
```

```cpp
#include <hip/hip_runtime.h>
#include <hip/hip_cooperative_groups.h>
#include <cstdio>
#include <cstdint>
#include <cmath>
namespace cg = cooperative_groups;

#ifndef MK_N_LAUNCHES
#define MK_N_LAUNCHES 1
#endif

namespace pg8 {
#define PG8_LAS __attribute__((address_space(3)))
typedef unsigned short bf16_t;
typedef short bf16x8 __attribute__((ext_vector_type(8)));
typedef float f32x4 __attribute__((ext_vector_type(4)));
typedef unsigned u32x4 __attribute__((ext_vector_type(4)));
constexpr int BM = 256, BK = 64, HALF = 128, HTB = HALF * BK * 2  , STAGE_BYTES = 8 * HTB, NXCD = 8, WGM = 8;

__host__ __device__ __forceinline__ int lds_byte(int r, int c) { const int st = (r >> 4) * 2 + (c >> 5), rr = r & 15, cc = c & 31, ob = rr * 64 + cc * 2; return st * 1024 + (ob ^ (((ob >> 9) & 1) << 5)); }
__host__ __device__ __forceinline__ void stage_rc(int b, int& R, int& C) { const int st = b / 1024, sb = b % 1024, swz = sb ^ (((sb >> 9) & 1) << 5); R = (st >> 1) * 16 + swz / 64; C = (st & 1) * 32 + (swz % 64) / 2; }
__host__ __device__ __forceinline__ int perm32(int rho) { const int n = rho >> 4, i = rho & 15; return 8 * (i >> 2) + 4 * n + (i & 3); }

struct Unit { int pm, pn; };
struct Gemm { const bf16_t* A; const bf16_t* Bt; int M, N, K; };

struct StaticOrder {
    int nM, nN, nwg, G, c;
    __host__ __device__ void init(int M, int N, int G_, int c_) { nM = M / BM; nN = N / BM; nwg = nM * nN; G = G_; c = c_; }
    __host__ __device__ bool next(int i, Unit& u) const {
        const long L = (long)i * G + c; if (L >= nwg) return false;
        int wgid = (int)L; { const int q = nwg / NXCD, r = nwg % NXCD, xcd = wgid % NXCD, off = wgid / NXCD; wgid = (xcd < r ? xcd * (q + 1) : r * (q + 1) + (xcd - r) * q) + off; }
        const int nig = WGM * nN, gid = wgid / nig, fm = gid * WGM, gsz = (nM - fm) < WGM ? (nM - fm) : WGM;
        u.pm = fm + ((wgid % nig) % gsz); u.pn = (wgid % nig) / gsz; return true;
    }
    __device__ __forceinline__ void a_ready(const Unit&) const {}
    __device__ __forceinline__ void done(const Unit&) const {}
};

__device__ __forceinline__ unsigned cvt_pk_bf16(float lo, float hi) { unsigned r; asm volatile("v_cvt_pk_bf16_f32 %0, %1, %2" : "=v"(r) : "v"(lo), "v"(hi)); return r; }
typedef float f32x2 __attribute__((ext_vector_type(2)));

template <class Epi, class Sched, bool ALIGN_EPI = false, bool SP2 = false>
__device__ __forceinline__ void gemm_phase(PG8_LAS unsigned char* lds, const Gemm g, const Sched& S, const Epi& E) {
    const int tid = threadIdx.x, wid = __builtin_amdgcn_readfirstlane(tid >> 6), lane = tid & 63, wr = wid >> 2, wc = wid & 3, fr = lane & 15, fq = lane >> 4;
    const int K = g.K, nt = K / BK;
    unsigned voffA[2], voffB[2];
#pragma unroll
    for (int i = 0; i < 2; ++i) { int R, C; stage_rc(tid * 16 + i * 8192, R, C); const int Rb = Epi::PERM ? ((R & ~31) + perm32(R & 31)) : R;
        voffA[i] = (unsigned)(R * K + C) * 2u; voffB[i] = (unsigned)(Rb * K + C) * 2u; }
    const size_t kstep = (size_t)(BK * 2);
    const size_t hstep = (size_t)HALF * K * 2;
    const size_t tstep = 2 * hstep;
    const unsigned ldsw = (unsigned)wid * 1024u;
    const int aoff = lds_byte(wr * 64 + fr, fq * 8), boff = lds_byte(wc * 32 + fr, fq * 8);
#define PG8_SA(b, h) (((b) * 2 + (h)) * HTB)
#define PG8_SB(b, h) ((4 + (b) * 2 + (h)) * HTB)
#define PG8_STAGE(bufoff, gbase, voff) do { _Pragma("unroll") for (int _i = 0; _i < 2; ++_i) \
        __builtin_amdgcn_global_load_lds((const unsigned*)((const char*)(gbase) + (voff)[_i]), (PG8_LAS unsigned*)(lds + (bufoff) + ldsw + _i * 8192), 16, 0, 0); } while (0)
#define PG8_LDA(dst, b, h) do { _Pragma("unroll") for (int m = 0; m < 4; ++m) _Pragma("unroll") for (int k = 0; k < 2; ++k) dst[m][k] = *(const PG8_LAS bf16x8*)(lds + PG8_SA(b, h) + aoff + m * 2048 + k * 1024); } while (0)
#define PG8_LDB(dst, b, h) do { _Pragma("unroll") for (int n = 0; n < 2; ++n) _Pragma("unroll") for (int k = 0; k < 2; ++k) dst[n][k] = *(const PG8_LAS bf16x8*)(lds + PG8_SB(b, h) + boff + n * 2048 + k * 1024); } while (0)
#define PG8_MMA(ai, bj, At, Bt) do { __builtin_amdgcn_s_setprio(1); _Pragma("unroll") for (int m = 0; m < 4; ++m) _Pragma("unroll") for (int n = 0; n < 2; ++n) _Pragma("unroll") for (int k = 0; k < 2; ++k) \
        acc[ai][bj][m][n] = __builtin_amdgcn_mfma_f32_16x16x32_bf16(Bt[n][k], At[m][k], acc[ai][bj][m][n], 0, 0, 0); __builtin_amdgcn_s_setprio(0); } while (0)
#define PG8_WAIT_V(n) asm volatile("s_waitcnt vmcnt(" #n ")" ::: "memory")
#define PG8_WAIT_L(n) asm volatile("s_waitcnt lgkmcnt(" #n ")" ::: "memory")
#define PG8_BAR __builtin_amdgcn_s_barrier()
#define PG8_SCHED __builtin_amdgcn_sched_barrier(0)
    Unit cur, nxt; int ui = 0;
    if (!S.next(0, cur)) return;
    f32x4 acc[2][2][4][2];
#pragma unroll
    for (int a = 0; a < 2; ++a)
#pragma unroll
        for (int b = 0; b < 2; ++b)
#pragma unroll
            for (int m = 0; m < 4; ++m)
#pragma unroll
                for (int n = 0; n < 2; ++n) acc[a][b][m][n] = (f32x4){0.f, 0.f, 0.f, 0.f};
    bf16x8 At[4][2], B0[2][2], B1[2][2];
    const char* cA = (const char*)g.A + (size_t)cur.pm * tstep; const char* cB = (const char*)g.Bt + (size_t)cur.pn * tstep;
    S.a_ready(cur);
    if constexpr (SP2) {
        PG8_STAGE(PG8_SB(0, 0), cB, voffB); PG8_STAGE(PG8_SB(0, 1), cB + hstep, voffB); PG8_STAGE(PG8_SA(0, 0), cA, voffA); PG8_STAGE(PG8_SA(0, 1), cA + hstep, voffA);
        if (wr == 1) PG8_BAR;
        PG8_WAIT_V(2); PG8_BAR;
        PG8_STAGE(PG8_SB(1, 0), cB + kstep, voffB); PG8_STAGE(PG8_SA(1, 0), cA + kstep, voffA); PG8_STAGE(PG8_SB(1, 1), cB + hstep + kstep, voffB);
        PG8_WAIT_V(6); PG8_BAR;
    } else {
        PG8_STAGE(PG8_SB(0, 0), cB, voffB); PG8_STAGE(PG8_SA(0, 0), cA, voffA); PG8_STAGE(PG8_SB(0, 1), cB + hstep, voffB); PG8_STAGE(PG8_SA(0, 1), cA + hstep, voffA);
        if (wr == 1) PG8_BAR;
        PG8_WAIT_V(4); PG8_BAR;
        PG8_STAGE(PG8_SB(1, 0), cB + kstep, voffB); PG8_STAGE(PG8_SA(1, 0), cA + kstep, voffA); PG8_STAGE(PG8_SB(1, 1), cB + hstep + kstep, voffB);
        PG8_WAIT_V(6); PG8_BAR;
    }
    for (;;) {
        const bool has_next = S.next(ui + 1, nxt);
        const char* nA = has_next ? (const char*)g.A + (size_t)nxt.pm * tstep : cA; const char* nB = has_next ? (const char*)g.Bt + (size_t)nxt.pn * tstep : cB;
        for (int t = 0; t < nt; t += 2) {
            const bool last = (t == nt - 2);
            const char* a1 = cA + (size_t)(t + 1) * kstep;
            const char* a2 = last ? nA : cA + (size_t)(t + 2) * kstep; const char* b2 = last ? nB : cB + (size_t)(t + 2) * kstep;
            const char* a3 = a2 + kstep; const char* b3 = b2 + kstep;
            if (last && has_next) S.a_ready(nxt);
            if constexpr (SP2) {
            PG8_LDB(B0, 0, 0); PG8_LDB(B1, 0, 1); PG8_SCHED; PG8_LDA(At, 0, 0); PG8_STAGE(PG8_SA(1, 1), a1 + hstep, voffA);
            PG8_WAIT_V(8); PG8_WAIT_L(0); PG8_BAR; PG8_MMA(0, 0, At, B0); PG8_MMA(0, 1, At, B1); PG8_BAR; PG8_SCHED;
            PG8_LDA(At, 0, 1); PG8_STAGE(PG8_SB(0, 0), b2, voffB); PG8_STAGE(PG8_SB(0, 1), b2 + hstep, voffB); PG8_STAGE(PG8_SA(0, 0), a2, voffA);
            PG8_WAIT_V(8); PG8_WAIT_L(0); PG8_BAR; PG8_MMA(1, 0, At, B0); PG8_MMA(1, 1, At, B1); PG8_BAR; PG8_SCHED;
            PG8_LDB(B0, 1, 0); PG8_LDB(B1, 1, 1); PG8_SCHED; PG8_LDA(At, 1, 0); PG8_STAGE(PG8_SA(0, 1), a2 + hstep, voffA);
            PG8_WAIT_V(8); PG8_WAIT_L(0); PG8_BAR; PG8_MMA(0, 0, At, B0); PG8_MMA(0, 1, At, B1); PG8_BAR; PG8_SCHED;
            PG8_LDA(At, 1, 1); PG8_STAGE(PG8_SB(1, 0), b3, voffB); PG8_STAGE(PG8_SB(1, 1), b3 + hstep, voffB); PG8_STAGE(PG8_SA(1, 0), a3, voffA);
            PG8_WAIT_V(8); PG8_WAIT_L(0); PG8_BAR; PG8_MMA(1, 0, At, B0); PG8_MMA(1, 1, At, B1); PG8_BAR; PG8_SCHED;
            } else {
            PG8_LDB(B0, 0, 0); PG8_SCHED; PG8_LDA(At, 0, 0); PG8_STAGE(PG8_SA(1, 1), a1 + hstep, voffA);
            PG8_WAIT_L(8); PG8_BAR; PG8_WAIT_L(0); PG8_MMA(0, 0, At, B0); PG8_BAR; PG8_SCHED;
            PG8_LDB(B1, 0, 1); PG8_STAGE(PG8_SB(0, 0), b2, voffB);
            PG8_BAR; PG8_WAIT_L(0); PG8_MMA(0, 1, At, B1); PG8_BAR;
            PG8_LDA(At, 0, 1); PG8_STAGE(PG8_SA(0, 0), a2, voffA);
            PG8_BAR; PG8_WAIT_L(0); PG8_MMA(1, 0, At, B0); PG8_BAR; PG8_SCHED;
            PG8_STAGE(PG8_SB(0, 1), b2 + hstep, voffB);
            PG8_WAIT_V(6); PG8_BAR; PG8_MMA(1, 1, At, B1); PG8_BAR;
            PG8_LDB(B0, 1, 0); PG8_SCHED; PG8_LDA(At, 1, 0); PG8_STAGE(PG8_SA(0, 1), a2 + hstep, voffA);
            PG8_WAIT_L(8); PG8_BAR; PG8_WAIT_L(0); PG8_MMA(0, 0, At, B0); PG8_BAR; PG8_SCHED;
            PG8_LDB(B1, 1, 1); PG8_STAGE(PG8_SB(1, 0), b3, voffB);
            PG8_BAR; PG8_WAIT_L(0); PG8_MMA(0, 1, At, B1); PG8_BAR;
            PG8_LDA(At, 1, 1); PG8_STAGE(PG8_SA(1, 0), a3, voffA);
            PG8_BAR; PG8_WAIT_L(0); PG8_MMA(1, 0, At, B0); PG8_BAR; PG8_SCHED;
            PG8_STAGE(PG8_SB(1, 1), b3 + hstep, voffB);
            PG8_WAIT_V(6); PG8_BAR; PG8_MMA(1, 1, At, B1); PG8_BAR;
            }
        }
        if constexpr (ALIGN_EPI) { if (wr == 0) PG8_BAR; }
        if constexpr (!Epi::AFTER_DRAIN) { E(acc, cur, wr, wc, fr, fq); S.done(cur); }
        if (!has_next) break;
#pragma unroll
        for (int a = 0; a < 2; ++a)
#pragma unroll
            for (int b = 0; b < 2; ++b)
#pragma unroll
                for (int m = 0; m < 4; ++m)
#pragma unroll
                    for (int n = 0; n < 2; ++n) acc[a][b][m][n] = (f32x4){0.f, 0.f, 0.f, 0.f};
        cur = nxt; cA = nA; cB = nB; ++ui;
        if constexpr (ALIGN_EPI) { if (wr == 1) PG8_BAR; }
    }
    PG8_WAIT_V(0);
    if constexpr (!ALIGN_EPI) { if (wr == 0) PG8_BAR; }
    PG8_BAR;
    if constexpr (Epi::AFTER_DRAIN) { E.fused(acc, cur, wr, wc, fr, fq, lds, wid, lane); S.done(cur); }
#undef PG8_SA
#undef PG8_SB
#undef PG8_STAGE
#undef PG8_LDA
#undef PG8_LDB
#undef PG8_MMA
#undef PG8_WAIT_V
#undef PG8_WAIT_L
#undef PG8_BAR
#undef PG8_SCHED
}
}

#define GAS __attribute__((address_space(1)))
#define LAS __attribute__((address_space(3)))
typedef unsigned short bf16;
typedef unsigned v4u __attribute__((ext_vector_type(4)));
typedef unsigned v2u __attribute__((ext_vector_type(2)));
typedef float f32x4 __attribute__((ext_vector_type(4)));
typedef float f32x2 __attribute__((ext_vector_type(2)));
typedef short bf16x8 __attribute__((ext_vector_type(8)));
#define XB_TMO      128
#define XB_XCNT(j)  (256  + 64 * (j))
#define XB_XSUB(j)  (1280 + 64 * (j))
#define XB_XGEN(j)  (2304 + 64 * (j))
#define XB_TOP      3328
#define XB_TOPGEN   3392
#define XCD_BAR_WORDS 3456
#define XB_SPIN_CAP (1u << 18)

__device__ __forceinline__ unsigned xb_ld(unsigned* p)              { return __hip_atomic_load(p, __ATOMIC_RELAXED, __HIP_MEMORY_SCOPE_AGENT); }
__device__ __forceinline__ unsigned xb_add(unsigned* p, unsigned v) { return __hip_atomic_fetch_add(p, v, __ATOMIC_RELAXED, __HIP_MEMORY_SCOPE_AGENT); }
__device__ __forceinline__ unsigned xb_xcc_id() { return (unsigned)__builtin_amdgcn_s_getreg((3 << 11) | 20) & 0xFu; }
#define XB_SPIN(cond, bar) do { unsigned _sp = 0; while (cond) { __builtin_amdgcn_s_sleep(1); \
    if ((++_sp & 255u) == 0u) { if (xb_ld(&(bar)[XB_TMO])) break; if (_sp > XB_SPIN_CAP) { atomicAdd(&(bar)[XB_TMO], 1u); break; } } } } while (0)

struct XcdBarrier {
    unsigned* bar; unsigned x;
    volatile LAS unsigned* st;
};

__device__ __forceinline__ XcdBarrier xcd_barrier_post(unsigned* bar, volatile LAS unsigned* st) {
    XcdBarrier b; b.bar = bar; b.x = xb_xcc_id(); b.st = st;
    if (threadIdx.x == 0) (void)xb_add(&bar[XB_XCNT(b.x)], 1u);
    return b;
}
__device__ __forceinline__ void xcd_barrier_complete(unsigned* bar, unsigned x, unsigned& nloc, unsigned& nx) {
    const unsigned G = gridDim.x * gridDim.y * gridDim.z;
    unsigned sum, cnt, mine, sp = 0u;
    for (;;) {
        sum = 0u; cnt = 0u; mine = 0u;
#pragma unroll
        for (unsigned j = 0; j < 16; ++j) { const unsigned c = xb_ld(&bar[XB_XCNT(j)]); sum += c; cnt += (c > 0u) ? 1u : 0u; mine = (j == x) ? c : mine; }
        if (sum == G) break;
        __builtin_amdgcn_s_sleep(1);
        if ((++sp & 255u) == 0u) { if (xb_ld(&bar[XB_TMO])) break; if (sp > XB_SPIN_CAP) { atomicAdd(&bar[XB_TMO], 1u); break; } }
    }
    nloc = mine > 0u ? mine : 1u; nx = cnt > 0u ? cnt : 1u;
}

__device__ __forceinline__ void xcd_barrier(const XcdBarrier& b) {
    asm volatile("s_waitcnt vmcnt(0)" ::: "memory");
    __syncthreads();
    if (threadIdx.x == 0) {
        unsigned* bar = b.bar;
        __builtin_amdgcn_s_waitcnt(0);
        unsigned nloc = b.st[0], nx = b.st[1];
        if (nloc == 0u) { xcd_barrier_complete(bar, b.x, nloc, nx); b.st[0] = nloc; b.st[1] = nx; }
        const unsigned old = xb_add(&bar[XB_XSUB(b.x)], 1u);
        const unsigned gen = old / nloc;
        if (old + 1u == (gen + 1u) * nloc) {
            __builtin_amdgcn_fence(__ATOMIC_RELEASE, "agent");
            asm volatile("s_waitcnt vmcnt(0)" ::: "memory");
            const unsigned og = xb_add(&bar[XB_TOP], 1u);
            const unsigned tg = og / nx;
            if (og + 1u == (tg + 1u) * nx) xb_add(&bar[XB_TOPGEN], 1u);
            else XB_SPIN(xb_ld(&bar[XB_TOPGEN]) == tg, bar);
            __builtin_amdgcn_fence(__ATOMIC_ACQUIRE, "agent");
            xb_add(&bar[XB_XGEN(b.x)], 1u);
            asm volatile("s_waitcnt vmcnt(0)" ::: "memory");
        } else {
            XB_SPIN(xb_ld(&bar[XB_XGEN(b.x)]) == gen, bar);
            __builtin_amdgcn_fence(__ATOMIC_ACQUIRE, "agent");
            asm volatile("s_waitcnt vmcnt(0)" ::: "memory");
        }
    }
    __syncthreads();
}

constexpr int MP = 8192, MS = 128, MT = MP + MS, D = 2048, NIN = 6144, NUP = 11264, DFF = 5632, PLE = 256, SEQ = 2048, NH = 8;
constexpr float EPS = 1e-6f;
constexpr int NPHASE = 10;
constexpr size_t MiB = 1u << 20;
constexpr size_t WS_BAR = 0, BAR_BYTES = 16384;
constexpr size_t WS_SS1 = 64 * 1024, WS_SS2 = 128 * 1024, WS_SS3 = 192 * 1024, WS_STATS = 256 * 1024;
constexpr size_t WS_ROPE = 1 * MiB, WS_ROPES = 2 * MiB;
constexpr size_t WS_WIN = 4 * MiB, WS_WO = 28 * MiB, WS_WUP = 36 * MiB, WS_WDN = 80 * MiB, WS_WG = 102 * MiB, WS_WP = 110 * MiB;
constexpr size_t WS_AB = 112 * MiB, WS_PB = 145 * MiB, WS_MIX = 150 * MiB, WS_Z = 183 * MiB, WS_ACT = 183 * MiB, WS_KV = 281 * MiB, WS_PP = 281 * MiB;
constexpr size_t WS_RAW = 313 * MiB, WS_AS = 335 * MiB, WS_END = 346 * MiB;
static_assert(WS_AB + (size_t)MT * D * 2 <= WS_PB && WS_PB + (size_t)MT * PLE * 2 <= WS_MIX && WS_MIX + (size_t)MT * D * 2 <= WS_Z, "ws map 1");
static_assert(WS_Z + (size_t)MT * NIN * 2 <= WS_KV && WS_ACT + (size_t)MT * DFF * 2 <= WS_KV && WS_KV + (size_t)512 * 16384 * 4 <= WS_RAW, "ws map 2");
static_assert(WS_RAW + (size_t)128 * 4 * NUP * 4 <= WS_AS && WS_AS + (size_t)MS * NUP * 4 <= WS_END && WS_PP + (size_t)MT * D * 4 <= WS_END, "ws map 3");
constexpr size_t O_RETP = 17039360, O_CONVP = 17563648, O_RETS = 17653760, O_CONVS = 34430976, O_GMV = 37314560, O_END = 37445632;
constexpr int LDS_BYTES = 147456, MISC_OFF = LDS_BYTES - 256;
constexpr int LDP = 136;
constexpr int TILE_B = 128 * LDP * 2;

struct Params { const float* in[22]; float* out; unsigned char* ws; float log2g[8]; float invf[64]; int ph_lo, ph_hi, use_cg, pad; };

#define LDS_WAIT() asm volatile("s_waitcnt lgkmcnt(0)" ::: "memory")
__device__ __forceinline__ float lo16(unsigned u) { return __uint_as_float(u << 16); }
__device__ __forceinline__ float hi16(unsigned u) { return __uint_as_float(u & 0xffff0000u); }
__device__ __forceinline__ float bf2f(bf16 b) { return __uint_as_float((unsigned)b << 16); }
__device__ __forceinline__ unsigned pk2(float lo, float hi) { return pg8::cvt_pk_bf16(lo, hi); }
__device__ __forceinline__ bf16 f2bf(float f) { return (bf16)(pg8::cvt_pk_bf16(f, 0.f) & 0xffffu); }
__device__ __forceinline__ float sigmoid_(float x) { return __builtin_amdgcn_rcpf(1.0f + __builtin_amdgcn_exp2f(-1.44269504089f * x)); }
__device__ __forceinline__ float silu_(float x) { return x * sigmoid_(x); }
__device__ __forceinline__ float gelu_(float x) { return x * sigmoid_(1.5957691216f * (x + 0.044715f * x * x * x)); }
__device__ __forceinline__ float wave_sum(float v) {
#pragma unroll
    for (int o = 1; o < 64; o <<= 1) v += __shfl_xor(v, o);
    return v;
}
__device__ __forceinline__ void atomic_addf(float* p, float v) { (void)__hip_atomic_fetch_add(p, v, __ATOMIC_RELAXED, __HIP_MEMORY_SCOPE_AGENT); }
template <int CTRL> __device__ __forceinline__ float dppf(float x) { return __int_as_float(__builtin_amdgcn_update_dpp(0, __float_as_int(x), CTRL, 0xf, 0xf, false)); }

using pg8::Unit;
struct EpiZ {
    static constexpr bool PERM = true, AFTER_DRAIN = false;
    bf16* Z;
    __device__ __forceinline__ void operator()(const f32x4 (&acc)[2][2][4][2], const Unit& u, int wr, int wc, int fr, int fq) const {
        const int row0 = u.pm * 256 + wr * 64 + fr, col0 = u.pn * 256 + wc * 32 + 8 * fq;
        const int mode = u.pn < 12 ? 0 : (u.pn < 16 ? 1 : 2);
#pragma unroll
        for (int ai = 0; ai < 2; ++ai)
#pragma unroll
            for (int m = 0; m < 4; ++m) { bf16* rowp = Z + (size_t)(row0 + ai * 128 + m * 16) * NIN + col0;
#pragma unroll
                for (int bj = 0; bj < 2; ++bj) { f32x4 v0 = acc[ai][bj][m][0], v1 = acc[ai][bj][m][1];
                    if (mode == 1) {
#pragma unroll
                        for (int j = 0; j < 4; ++j) { v0[j] = silu_(v0[j]); v1[j] = silu_(v1[j]); } }
                    else if (mode == 2) {
#pragma unroll
                        for (int j = 0; j < 4; ++j) { v0[j] = gelu_(v0[j]); v1[j] = gelu_(v1[j]); } }
                    v4u w; w.x = pk2(v0[0], v0[1]); w.y = pk2(v0[2], v0[3]); w.z = pk2(v1[0], v1[1]); w.w = pk2(v1[2], v1[3]);
                    *(v4u*)(rowp + bj * 128) = w; } }
    }
};
struct EpiRes {
    static constexpr bool PERM = false, AFTER_DRAIN = false;
    const float* base; float* out; bf16* hb; float* ss;
    __device__ __forceinline__ void operator()(const f32x4 (&acc)[2][2][4][2], const Unit& u, int wr, int wc, int fr, int fq) const {
        const int row0 = u.pm * 256 + wr * 64 + fr, col0 = u.pn * 256 + wc * 32 + 4 * fq;
#pragma unroll
        for (int ai = 0; ai < 2; ++ai)
#pragma unroll
            for (int m = 0; m < 4; ++m) { const int row = row0 + ai * 128 + m * 16; const size_t off = (size_t)row * D + col0; float s = 0.f;
#pragma unroll
                for (int bj = 0; bj < 2; ++bj)
#pragma unroll
                    for (int n = 0; n < 2; ++n) { const f32x4 o = *(const f32x4*)(base + off + bj * 128 + n * 16) + acc[ai][bj][m][n];
                        *(f32x4*)(out + off + bj * 128 + n * 16) = o; v2u w; w.x = pk2(o[0], o[1]); w.y = pk2(o[2], o[3]); *(v2u*)(hb + off + bj * 128 + n * 16) = w;
                        s += (o[0] * o[0] + o[1] * o[1]) + (o[2] * o[2] + o[3] * o[3]); }
                s += __shfl_xor(s, 16); s += __shfl_xor(s, 32);
                if (fq == 0) atomic_addf(ss + row, s);
                asm volatile("" ::: "memory"); }
    }
};
struct EpiPP {
    static constexpr bool PERM = false, AFTER_DRAIN = false;
    float* pp;
    __device__ __forceinline__ void operator()(const f32x4 (&acc)[2][2][4][2], const Unit& u, int wr, int wc, int fr, int fq) const {
        const int row0 = u.pm * 256 + wr * 64 + fr, col0 = u.pn * 256 + wc * 32 + 4 * fq;
#pragma unroll
        for (int ai = 0; ai < 2; ++ai)
#pragma unroll
            for (int m = 0; m < 4; ++m) { float* rowp = pp + (size_t)(row0 + ai * 128 + m * 16) * D + col0;
#pragma unroll
                for (int bj = 0; bj < 2; ++bj)
#pragma unroll
                    for (int n = 0; n < 2; ++n) *(f32x4*)(rowp + bj * 128 + n * 16) = acc[ai][bj][m][n]; }
    }
};
struct EpiGate {
    static constexpr bool PERM = false, AFTER_DRAIN = false;
    const float* pp; float* h; const float* ss2; float* ss3;
    __device__ __forceinline__ void operator()(const f32x4 (&acc)[2][2][4][2], const Unit& u, int wr, int wc, int fr, int fq) const {
        const int row0 = u.pm * 256 + wr * 64 + fr, col0 = u.pn * 256 + wc * 32 + 4 * fq;
#pragma unroll
        for (int ai = 0; ai < 2; ++ai)
#pragma unroll
            for (int m = 0; m < 4; ++m) { const int row = row0 + ai * 128 + m * 16; const size_t off = (size_t)row * D + col0; float s = 0.f;
                const float r2 = __builtin_amdgcn_rsqf(ss2[row] * (1.0f / D) + EPS);
#pragma unroll
                for (int bj = 0; bj < 2; ++bj)
#pragma unroll
                    for (int n = 0; n < 2; ++n) { const f32x4 hv = *(const f32x4*)(h + off + bj * 128 + n * 16), pv = *(const f32x4*)(pp + off + bj * 128 + n * 16); const f32x4 a = acc[ai][bj][m][n]; f32x4 o;
#pragma unroll
                        for (int j = 0; j < 4; ++j) o[j] = hv[j] + pv[j] * sigmoid_(r2 * a[j]);
                        *(f32x4*)(h + off + bj * 128 + n * 16) = o; s += (o[0] * o[0] + o[1] * o[1]) + (o[2] * o[2] + o[3] * o[3]); asm volatile("" ::: "memory"); }
                s += __shfl_xor(s, 16); s += __shfl_xor(s, 32);
                if (fq == 0) atomic_addf(ss3 + row, s);
                asm volatile("" ::: "memory"); }
    }
};
struct EpiUp {
    static constexpr bool PERM = false, AFTER_DRAIN = false;
    bf16* act; float* raw; const float* ss1; const float* cw; const float* cb;
    __device__ __forceinline__ void operator()(const f32x4 (&acc)[2][2][4][2], const Unit& u, int wr, int wc, int fr, int fq) const {
        const int row0 = u.pm * 256 + wr * 64 + fr;
        float rs[2][4];
#pragma unroll
        for (int ai = 0; ai < 2; ++ai)
#pragma unroll
            for (int m = 0; m < 4; ++m) rs[ai][m] = __builtin_amdgcn_rsqf(ss1[row0 + ai * 128 + m * 16] * (1.0f / D) + EPS);
#pragma unroll
        for (int n = 0; n < 2; ++n) {
            const int cg_ = u.pn * 128 + wc * 32 + 16 * n + 4 * fq;
            const f32x4 w0g = *(const f32x4*)(cw + cg_), w1g = *(const f32x4*)(cw + NUP + cg_), w2g = *(const f32x4*)(cw + 2 * NUP + cg_), bg = *(const f32x4*)(cb + cg_);
            const f32x4 w0u = *(const f32x4*)(cw + DFF + cg_), w1u = *(const f32x4*)(cw + NUP + DFF + cg_), w2u = *(const f32x4*)(cw + 2 * NUP + DFF + cg_), bu = *(const f32x4*)(cb + DFF + cg_);
#pragma unroll
            for (int ai = 0; ai < 2; ++ai) {
                f32x4 pg = {0.f, 0.f, 0.f, 0.f}, pu = {0.f, 0.f, 0.f, 0.f};
#pragma unroll
                for (int m = 0; m < 4; ++m) {
                    const int row = row0 + ai * 128 + m * 16;
                    const f32x4 g = acc[ai][0][m][n] * rs[ai][m], up = acc[ai][1][m][n] * rs[ai][m];
                    if (m == 0 && fr < 2) { float* rp = raw + ((size_t)(row >> 6) * 4 + 2 + fr) * NUP + cg_; *(f32x4*)rp = g; *(f32x4*)(rp + DFF) = up; }
                    if (m == 3 && fr >= 14) { float* rp = raw + ((size_t)(row >> 6) * 4 + (fr - 14)) * NUP + cg_; *(f32x4*)rp = g; *(f32x4*)(rp + DFF) = up; }
                    f32x4 o;
#pragma unroll
                    for (int j = 0; j < 4; ++j) {
                        const float g1 = dppf<0x121>(fr == 15 ? pg[j] : g[j]), g2 = dppf<0x122>(fr >= 14 ? pg[j] : g[j]);
                        const float u1 = dppf<0x121>(fr == 15 ? pu[j] : up[j]), u2 = dppf<0x122>(fr >= 14 ? pu[j] : up[j]);
                        const float ag = w0g[j] * g2 + w1g[j] * g1 + w2g[j] * g[j] + bg[j];
                        const float au = w0u[j] * u2 + w1u[j] * u1 + w2u[j] * up[j] + bu[j];
                        o[j] = silu_(ag) * au; }
                    v2u w; w.x = pk2(o[0], o[1]); w.y = pk2(o[2], o[3]);
                    *(v2u*)(act + (size_t)row * DFF + cg_) = w;
                    pg = g; pu = up; } } }
    }
};

template <int RT, class F>
__device__ __forceinline__ void skinny_gemm(LAS unsigned char* lds, const bf16* A, const bf16* Bt, int N, int K, int u0, int ustride, const F& f) {
    const int tid = threadIdx.x, lane = tid & 63, w = tid >> 6, fr = lane & 15, fq = lane >> 4;
    constexpr int nrb = 8 / RT, ROWS = 16 * RT;
    const int nunits = nrb * (N / 32), kw = K / 8;
    LAS float* red = (LAS float*)lds;
    for (int u = u0; u < nunits; u += ustride) {
        const int rb = u % nrb, cb = u / nrb, row0 = rb * ROWS, col0 = cb * 32;
        f32x4 acc[RT][2];
#pragma unroll
        for (int rt = 0; rt < RT; ++rt) { acc[rt][0] = (f32x4){0.f, 0.f, 0.f, 0.f}; acc[rt][1] = (f32x4){0.f, 0.f, 0.f, 0.f}; }
        const bf16* ap = A + (size_t)(row0 + fr) * K + w * kw + 8 * fq;
        const bf16* bp = Bt + (size_t)(col0 + fr) * K + w * kw + 8 * fq;
#pragma unroll 2
        for (int k = 0; k < kw; k += 32) {
            const bf16x8 b0 = *(const bf16x8*)(bp + k), b1 = *(const bf16x8*)(bp + (size_t)16 * K + k);
#pragma unroll
            for (int rt = 0; rt < RT; ++rt) { const bf16x8 av = *(const bf16x8*)(ap + (size_t)rt * 16 * K + k);
                acc[rt][0] = __builtin_amdgcn_mfma_f32_16x16x32_bf16(b0, av, acc[rt][0], 0, 0, 0);
                acc[rt][1] = __builtin_amdgcn_mfma_f32_16x16x32_bf16(b1, av, acc[rt][1], 0, 0, 0); }
        }
#pragma unroll
        for (int rt = 0; rt < RT; ++rt)
#pragma unroll
            for (int ct = 0; ct < 2; ++ct) *(LAS f32x4*)(red + (w * ROWS + 16 * rt + fr) * 32 + 16 * ct + 4 * fq) = acc[rt][ct];
        __syncthreads();
#pragma unroll
        for (int it = 0; it < RT; ++it) { const int e = tid + 512 * it, r = e >> 5, c = e & 31; float v = 0.f;
#pragma unroll
            for (int ww = 0; ww < 8; ++ww) v += red[(ww * ROWS + r) * 32 + c];
            f(row0 + r, col0 + c, v); }
        __syncthreads();
    }
}
__device__ __forceinline__ float half_wave_sum(float v) {
#pragma unroll
    for (int o = 1; o < 32; o <<= 1) v += __shfl_xor(v, o);
    return v;
}

__device__ __forceinline__ void transpose_item(const float* W, int K, int N, const float* g, bf16* WT, bool upmap, LAS float* scr, int item, int lane) {
    const int nblk = N / 64, kb = item / nblk, nb = item % nblk, k0 = 64 * kb, n0 = 64 * nb;
    const float* src = W + (size_t)k0 * N + n0 + lane;
#pragma unroll
    for (int h = 0; h < 2; ++h) {
        float v[32];
#pragma unroll
        for (int i = 0; i < 32; ++i) v[i] = src[(size_t)(32 * h + i) * N];
#pragma unroll
        for (int i = 0; i < 32; ++i) { float x = v[i]; if (g) x *= g[k0 + 32 * h + i]; scr[(32 * h + i) * 65 + lane] = x; }
    }
    LDS_WAIT(); asm volatile("" ::: "memory");
    const int c = lane & 7;
#pragma unroll
    for (int j = 0; j < 8; ++j) { const int n = (lane >> 3) + 8 * j; const LAS float* s = scr + (8 * c) * 65 + n;
        v4u o; o.x = pk2(s[0 * 65], s[1 * 65]); o.y = pk2(s[2 * 65], s[3 * 65]); o.z = pk2(s[4 * 65], s[5 * 65]); o.w = pk2(s[6 * 65], s[7 * 65]);
        int R = n0 + n; if (upmap) { const int half = R >= DFF ? 1 : 0, jj = R - half * DFF; R = 256 * (jj >> 7) + 128 * half + (jj & 127); }
        *(v4u*)(WT + (size_t)R * K + k0 + 8 * c) = o; }
    LDS_WAIT(); asm volatile("" ::: "memory");
}
__device__ __forceinline__ void rms_row_to_bf16(const float* xrow, bf16* orow, int lane) {
    const f32x4* xr = (const f32x4*)xrow + lane;
    f32x4 v[8]; float s = 0.f;
#pragma unroll
    for (int j = 0; j < 8; ++j) { v[j] = xr[64 * j]; s += (v[j][0] * v[j][0] + v[j][1] * v[j][1]) + (v[j][2] * v[j][2] + v[j][3] * v[j][3]); }
    const float r = __builtin_amdgcn_rsqf(wave_sum(s) * (1.0f / D) + EPS);
    v2u* o8 = (v2u*)orow + lane;
#pragma unroll
    for (int j = 0; j < 8; ++j) { v2u w; w.x = pk2(v[j][0] * r, v[j][1] * r); w.y = pk2(v[j][2] * r, v[j][3] * r); o8[64 * j] = w; }
}

__device__ __forceinline__ void mm128(f32x4 (&acc)[8], const LAS bf16* A, const LAS bf16* B, int wave, int fr, int fq) {
#pragma unroll
    for (int ks = 0; ks < 4; ++ks) {
        const bf16x8 a = *(const LAS bf16x8*)(A + (16 * wave + fr) * LDP + 32 * ks + 8 * fq);
#pragma unroll
        for (int ct = 0; ct < 8; ++ct) { const bf16x8 b = *(const LAS bf16x8*)(B + (16 * ct + fr) * LDP + 32 * ks + 8 * fq);
            acc[ct] = __builtin_amdgcn_mfma_f32_16x16x32_bf16(b, a, acc[ct], 0, 0, 0); }
    }
}
template <bool TRANS, bool DEC>
__device__ __forceinline__ void stage_rope(LAS bf16* dst, const bf16* zb, const float* rope, float scale, float l2g, int tid) {
#pragma unroll
    for (int it = 0; it < 2; ++it) { const int idx = tid + 512 * it, j = idx >> 3, d8 = idx & 7;
        const v4u x1 = *(const v4u*)(zb + (size_t)j * NIN + 8 * d8), x2 = *(const v4u*)(zb + (size_t)j * NIN + 64 + 8 * d8);
        const f32x4* rp = (const f32x4*)(rope + (size_t)(j * 64 + 8 * d8) * 2);
        float sc = scale; if (DEC) sc *= __builtin_amdgcn_exp2f(l2g * (float)(127 - j));
        float o1[8], o2[8];
#pragma unroll
        for (int p = 0; p < 4; ++p) { const f32x4 cs = rp[p]; const float a0 = lo16(x1[p]), a1 = hi16(x1[p]), b0 = lo16(x2[p]), b1 = hi16(x2[p]);
            o1[2 * p] = (a0 * cs[0] - b0 * cs[1]) * sc; o2[2 * p] = (b0 * cs[0] + a0 * cs[1]) * sc;
            o1[2 * p + 1] = (a1 * cs[2] - b1 * cs[3]) * sc; o2[2 * p + 1] = (b1 * cs[2] + a1 * cs[3]) * sc; }
        if (!TRANS) { v4u w1, w2;
#pragma unroll
            for (int p = 0; p < 4; ++p) { w1[p] = pk2(o1[2 * p], o1[2 * p + 1]); w2[p] = pk2(o2[2 * p], o2[2 * p + 1]); }
            *(LAS v4u*)(dst + j * LDP + 8 * d8) = w1; *(LAS v4u*)(dst + j * LDP + 64 + 8 * d8) = w2; }
        else {
#pragma unroll
            for (int i = 0; i < 8; ++i) { dst[(8 * d8 + i) * LDP + j] = f2bf(o1[i]); dst[(64 + 8 * d8 + i) * LDP + j] = f2bf(o2[i]); } }
    }
}
__device__ __forceinline__ void stage_T(LAS bf16* dst, const bf16* zb, int tid) {
#pragma unroll
    for (int it = 0; it < 4; ++it) { const int idx = tid + 512 * it, j = idx >> 4, c8 = idx & 15;
        const v4u x = *(const v4u*)(zb + (size_t)j * NIN + 8 * c8);
#pragma unroll
        for (int p = 0; p < 4; ++p) { dst[(8 * c8 + 2 * p) * LDP + j] = (bf16)(x[p] & 0xffffu); dst[(8 * c8 + 2 * p + 1) * LDP + j] = (bf16)(x[p] >> 16); } }
}

__global__ void __launch_bounds__(512, 2) mk_fwd(Params a) {
    extern __shared__ __attribute__((aligned(16))) unsigned char lds_raw[];
    LAS unsigned char* lds = (LAS unsigned char*)lds_raw;
    const int tid = threadIdx.x, lane = tid & 63, wave = __builtin_amdgcn_readfirstlane(tid >> 6), fr = lane & 15, fq = lane >> 4;
    const int G = gridDim.x, blk = blockIdx.x;
    const int gw = blk * 8 + wave, NGW = G * 8;
    const int gt = blk * 512 + tid, NGT = G * 512;
    unsigned char* ws = a.ws;
    const float* x_p = a.in[0]; const float* x_s = a.in[1]; const float* p_p = a.in[2]; const float* p_s = a.in[3];
    const float* state_ret = a.in[4]; const float* state_conv = a.in[5];
    const float* gm_ln_g = a.in[8]; const float* gm_ln_b = a.in[9]; const float* gm_ws = a.in[10]; const float* gm_bs = a.in[11];
    const float* conv_w = a.in[15]; const float* conv_b = a.in[16]; const float* g_final = a.in[21];
    float* out = a.out;
    float* SS1 = (float*)(ws + WS_SS1); float* SS2 = (float*)(ws + WS_SS2); float* SS3 = (float*)(ws + WS_SS3); float* STATS = (float*)(ws + WS_STATS);
    float* ROPE = (float*)(ws + WS_ROPE); float* ROPES = (float*)(ws + WS_ROPES);
    bf16* Win_t = (bf16*)(ws + WS_WIN); bf16* Wo_t = (bf16*)(ws + WS_WO); bf16* Wup_t = (bf16*)(ws + WS_WUP); bf16* Wdn_t = (bf16*)(ws + WS_WDN); bf16* Wg_t = (bf16*)(ws + WS_WG); bf16* Wp_t = (bf16*)(ws + WS_WP);
    bf16* AB = (bf16*)(ws + WS_AB); bf16* PB = (bf16*)(ws + WS_PB); bf16* MIX = (bf16*)(ws + WS_MIX); bf16* Z = (bf16*)(ws + WS_Z); bf16* ACT = (bf16*)(ws + WS_ACT);
    float* KV = (float*)(ws + WS_KV); float* PP = (float*)(ws + WS_PP); float* RAW = (float*)(ws + WS_RAW); float* AS = (float*)(ws + WS_AS);

    volatile LAS unsigned* MISC = (volatile LAS unsigned*)(lds + MISC_OFF);
    if (tid < 64) MISC[tid] = 0u;
    __syncthreads();
    XcdBarrier bar; bar.bar = (unsigned*)(ws + WS_BAR); bar.x = 0; bar.st = nullptr;
    if (MK_N_LAUNCHES == 1) bar = xcd_barrier_post((unsigned*)(ws + WS_BAR), MISC + 8);
    const int lo = a.ph_lo, hi = a.ph_hi;
#ifndef PHMASK
#define PHMASK 0xffff
#endif
#define IN(k) (((PHMASK >> (k)) & 1) && lo <= (k) && (k) < hi)
#define SEAM(k) do { if (IN(k) && IN((k) + 1)) { if (a.use_cg) cg::this_grid().sync(); else xcd_barrier(bar); } } while (0)

    if (IN(0)) {
        LAS float* scr = (LAS float*)(lds + wave * 16640);
        constexpr int I_IN = (D / 64) * (NIN / 64), I_O = (D / 64) * (D / 64), I_UP = (D / 64) * (NUP / 64), I_DN = (DFF / 64) * (D / 64), I_G = I_O, I_P = (PLE / 64) * (D / 64);
        constexpr int NITEMS = I_IN + I_O + I_UP + I_DN + I_G + I_P;
        for (int it = gw; it < NITEMS; it += NGW) {
            int r = it;
            if (r < I_UP) { transpose_item(a.in[14], D, NUP, a.in[13], Wup_t, true, scr, r, lane); continue; } r -= I_UP;
            if (r < I_IN) { transpose_item(a.in[7], D, NIN, a.in[6], Win_t, false, scr, r, lane); continue; } r -= I_IN;
            if (r < I_DN) { transpose_item(a.in[17], DFF, D, nullptr, Wdn_t, false, scr, r, lane); continue; } r -= I_DN;
            if (r < I_O) { transpose_item(a.in[12], D, D, nullptr, Wo_t, false, scr, r, lane); continue; } r -= I_O;
            if (r < I_G) { transpose_item(a.in[19], D, D, a.in[18], Wg_t, false, scr, r, lane); continue; } r -= I_G;
            transpose_item(a.in[20], PLE, D, nullptr, Wp_t, false, scr, r, lane);
        }
        for (int m = gw; m < MT; m += NGW) rms_row_to_bf16(m < MP ? x_p + (size_t)m * D : x_s + (size_t)(m - MP) * D, AB + (size_t)m * D, lane);
        for (int i = gt; i < MT * PLE / 4; i += NGT) { const f32x4 v = i < MP * PLE / 4 ? ((const f32x4*)p_p)[i] : ((const f32x4*)p_s)[i - MP * PLE / 4]; v2u w; w.x = pk2(v[0], v[1]); w.y = pk2(v[2], v[3]); ((v2u*)PB)[i] = w; }
        for (int i = gt; i < SEQ * 64 + 64; i += NGT) { const int pos = i < SEQ * 64 ? (i >> 6) : 16384, fi = i & 63;
            const float ang = (float)pos * a.invf[fi]; double t = (double)ang * 0.15915494309189535; t -= __builtin_rint(t); const float rev = (float)t;
            float* dst = i < SEQ * 64 ? ROPE + 2 * (size_t)i : ROPES + 2 * fi; dst[0] = __builtin_amdgcn_cosf(rev); dst[1] = __builtin_amdgcn_sinf(rev); }
        for (int i = gt; i < MT; i += NGT) { SS1[i] = 0.f; SS2[i] = 0.f; SS3[i] = 0.f; }
    }
    SEAM(0);

    if (IN(1)) {
        { pg8::Gemm g{AB, Win_t, MP, NIN, D}; pg8::StaticOrder S; S.init(MP, NIN, G, blk); EpiZ E{Z};
          pg8::gemm_phase<EpiZ, pg8::StaticOrder, true, true>(lds, g, S, E); }
        auto f = [&](int s, int n, float v) { const float o = n < 3072 ? v : (n < 4096 ? silu_(v) : gelu_(v)); Z[(size_t)(MP + s) * NIN + n] = f2bf(o); };
        skinny_gemm<2>(lds, AB + (size_t)MP * D, Win_t, NIN, D, blk, G, f);
    }
    SEAM(1);

    if (IN(2)) {
        { LAS float* qs = (LAS float*)lds; LAS float* ks = qs + 128; LAS float* vs = ks + 128; LAS float* red = vs + 128;
          for (int u = blk; u < MS * NH; u += G) { const int s = u >> 3, h = u & 7; const bf16* zr = Z + (size_t)(MP + s) * NIN;
            if (tid < 64) { const float c = ROPES[2 * tid], sn = ROPES[2 * tid + 1];
                const float q1 = bf2f(zr[128 * h + tid]), q2 = bf2f(zr[128 * h + 64 + tid]), k1 = bf2f(zr[1024 + 128 * h + tid]), k2 = bf2f(zr[1024 + 128 * h + 64 + tid]);
                qs[tid] = q1 * c - q2 * sn; qs[tid + 64] = q2 * c + q1 * sn; ks[tid] = (k1 * c - k2 * sn) * 0.08838834764831845f; ks[tid + 64] = (k2 * c + k1 * sn) * 0.08838834764831845f; }
            else if (tid < 192) vs[tid - 64] = bf2f(zr[2048 + 128 * h + tid - 64]);
            __syncthreads();
            const int e4 = tid & 31, dg = tid >> 5; const float gamma = 1.0f - __builtin_amdgcn_exp2f((float)(-5 - h));
            const f32x4 vv = *(const LAS f32x4*)(vs + 4 * e4); f32x4 o = {0.f, 0.f, 0.f, 0.f};
            const float* S0 = state_ret + (size_t)u * 16384 + 4 * e4; float* S1 = out + O_RETS + (size_t)u * 16384 + 4 * e4;
            f32x4 s0[8];
#pragma unroll
            for (int i = 0; i < 8; ++i) s0[i] = *(const f32x4*)(S0 + (dg + 16 * i) * 128);
#pragma unroll
            for (int i = 0; i < 8; ++i) { const int d = dg + 16 * i; const f32x4 sn = s0[i] * gamma + vv * ks[d]; *(f32x4*)(S1 + d * 128) = sn; o += sn * qs[d]; }
            *(LAS f32x4*)(red + dg * 128 + 4 * e4) = o;
            __syncthreads();
            if (tid < 64) { float o0 = 0.f, o1 = 0.f;
#pragma unroll
                for (int i = 0; i < 16; ++i) { o0 += red[i * 128 + 2 * tid]; o1 += red[i * 128 + 2 * tid + 1]; }
                const float r = __builtin_amdgcn_rsqf(wave_sum(o0 * o0 + o1 * o1) * (1.0f / 128.0f) + EPS);
                const unsigned gg = *(const unsigned*)(zr + 3072 + 128 * h + 2 * tid);
                *(unsigned*)(MIX + (size_t)(MP + s) * D + 128 * h + 2 * tid) = pk2(o0 * r * lo16(gg), o1 * r * hi16(gg)); }
            __syncthreads(); } }
        { LAS bf16* Kt = (LAS bf16*)lds; LAS bf16* Vt = (LAS bf16*)(lds + TILE_B);
          for (int u = blk; u < 512; u += G) { const int b = u >> 7, h = (u >> 4) & 7, c = u & 15; const size_t R0 = (size_t)b * SEQ + 128 * c;
            stage_rope<true, true>(Kt, Z + R0 * NIN + 1024 + 128 * h, ROPE + (size_t)(128 * c) * 128, 0.08838834764831845f, a.log2g[h], tid);
            stage_T(Vt, Z + R0 * NIN + 2048 + 128 * h, tid);
            __syncthreads();
            f32x4 acc[8];
#pragma unroll
            for (int ct = 0; ct < 8; ++ct) acc[ct] = (f32x4){0.f, 0.f, 0.f, 0.f};
            mm128(acc, Kt, Vt, wave, fr, fq);
            float* kv = KV + (size_t)u * 16384 + (16 * wave + fr) * 128 + 4 * fq;
#pragma unroll
            for (int ct = 0; ct < 8; ++ct) *(f32x4*)(kv + 16 * ct) = acc[ct];
            __syncthreads(); } }
        for (int row = gw; row < MT; row += NGW) { const bf16* p = Z + (size_t)row * NIN + 5120 + 16 * lane; const v4u x0 = *(const v4u*)p, x1 = *(const v4u*)(p + 8);
            float v[16];
#pragma unroll
            for (int j = 0; j < 4; ++j) { v[2 * j] = lo16(x0[j]); v[2 * j + 1] = hi16(x0[j]); v[8 + 2 * j] = lo16(x1[j]); v[8 + 2 * j + 1] = hi16(x1[j]); }
            float s = 0.f;
#pragma unroll
            for (int j = 0; j < 16; ++j) s += v[j];
            const float mean = wave_sum(s) * (1.0f / 1024.0f); float q = 0.f;
#pragma unroll
            for (int j = 0; j < 16; ++j) { v[j] -= mean; q += v[j] * v[j]; }
            const float rstd = __builtin_amdgcn_rsqf(wave_sum(q) * (1.0f / 1024.0f) + EPS);
            if (row < MP) { if (lane == 0) { STATS[2 * row] = mean; STATS[2 * row + 1] = rstd; } }
            else { const int s_ = row - MP, c0 = 16 * lane, grp = lane >> 3; const float w00 = gm_ws[grp * 16384], b0 = gm_bs[grp * 128];
                const bf16* up = Z + (size_t)row * NIN + 4096 + c0; const v4u u0 = *(const v4u*)up, u1 = *(const v4u*)(up + 8);
                float uu[16];
#pragma unroll
                for (int j = 0; j < 4; ++j) { uu[2 * j] = lo16(u0[j]); uu[2 * j + 1] = hi16(u0[j]); uu[8 + 2 * j] = lo16(u1[j]); uu[8 + 2 * j + 1] = hi16(u1[j]); }
                float vn[16], mo[16];
#pragma unroll
                for (int j = 0; j < 16; ++j) { vn[j] = v[j] * rstd * gm_ln_g[c0 + j] + gm_ln_b[c0 + j]; mo[j] = uu[j] * (w00 * vn[j] + b0); }
                float* gv = out + O_GMV + (size_t)s_ * 1024 + c0;
#pragma unroll
                for (int j = 0; j < 4; ++j) *(f32x4*)(gv + 4 * j) = (f32x4){vn[4 * j], vn[4 * j + 1], vn[4 * j + 2], vn[4 * j + 3]};
                v4u w0, w1;
#pragma unroll
                for (int j = 0; j < 4; ++j) { w0[j] = pk2(mo[2 * j], mo[2 * j + 1]); w1[j] = pk2(mo[8 + 2 * j], mo[8 + 2 * j + 1]); }
                bf16* mp = MIX + (size_t)row * D + 1024 + c0; *(v4u*)mp = w0; *(v4u*)(mp + 8) = w1; } }
    }
    SEAM(2);

    if (IN(3)) {
        LAS bf16* T0 = (LAS bf16*)lds; LAS bf16* T1 = (LAS bf16*)(lds + TILE_B); LAS bf16* T2 = (LAS bf16*)(lds + 2 * TILE_B); LAS bf16* T3 = (LAS bf16*)(lds + 3 * TILE_B);
        for (int u = blk; u < 512; u += G) { const int b = u >> 7, h = (u >> 4) & 7, c = u & 15; const size_t R0 = (size_t)b * SEQ + 128 * c; const float l2g = a.log2g[h];
            stage_rope<false, false>(T0, Z + R0 * NIN + 128 * h, ROPE + (size_t)(128 * c) * 128, 1.0f, 0.f, tid);
            stage_rope<false, false>(T1, Z + R0 * NIN + 1024 + 128 * h, ROPE + (size_t)(128 * c) * 128, 0.08838834764831845f, 0.f, tid);
            stage_T(T2, Z + R0 * NIN + 2048 + 128 * h, tid);
            { const float Gc = __builtin_amdgcn_exp2f(l2g * 128.0f); const float* kvb = KV + (size_t)(u - c) * 16384;
              f32x4 sp[8];
#pragma unroll
              for (int i = 0; i < 8; ++i) sp[i] = (f32x4){0.f, 0.f, 0.f, 0.f};
              for (int j = 0; j < c; ++j) {
#pragma unroll
                  for (int i = 0; i < 8; ++i) sp[i] = sp[i] * Gc + *(const f32x4*)(kvb + (size_t)j * 16384 + 4 * (tid + 512 * i)); }
              if (c == 15) {
#pragma unroll
                  for (int i = 0; i < 8; ++i) *(f32x4*)(out + O_RETP + (size_t)(b * 8 + h) * 16384 + 4 * (tid + 512 * i)) = sp[i] * Gc + *(const f32x4*)(kvb + (size_t)15 * 16384 + 4 * (tid + 512 * i)); }
#pragma unroll
              for (int i = 0; i < 8; ++i) { const int ch = tid + 512 * i, d = ch >> 5, e4 = ch & 31;
#pragma unroll
                  for (int t = 0; t < 4; ++t) T3[(4 * e4 + t) * LDP + d] = f2bf(sp[i][t]); } }
            __syncthreads();
            f32x4 acc2[8], acc1[8];
#pragma unroll
            for (int ct = 0; ct < 8; ++ct) { acc2[ct] = (f32x4){0.f, 0.f, 0.f, 0.f}; acc1[ct] = (f32x4){0.f, 0.f, 0.f, 0.f}; }
            mm128(acc2, T0, T3, wave, fr, fq);
            mm128(acc1, T0, T1, wave, fr, fq);
            __syncthreads();
            const int i_ = 16 * wave + fr;
#pragma unroll
            for (int ct = 0; ct < 8; ++ct) { float sv[4];
#pragma unroll
                for (int t = 0; t < 4; ++t) { const int j = 16 * ct + 4 * fq + t; sv[t] = i_ >= j ? acc1[ct][t] * __builtin_amdgcn_exp2f(l2g * (float)(i_ - j)) : 0.f; }
                v2u w; w.x = pk2(sv[0], sv[1]); w.y = pk2(sv[2], sv[3]); *(LAS v2u*)(T1 + i_ * LDP + 16 * ct + 4 * fq) = w; }
            __syncthreads();
#pragma unroll
            for (int ct = 0; ct < 8; ++ct) acc1[ct] = (f32x4){0.f, 0.f, 0.f, 0.f};
            mm128(acc1, T1, T2, wave, fr, fq);
            const float qd = __builtin_amdgcn_exp2f(l2g * (float)(i_ + 1)); float ssq = 0.f;
#pragma unroll
            for (int ct = 0; ct < 8; ++ct) { acc1[ct] = acc1[ct] + acc2[ct] * qd; ssq += (acc1[ct][0] * acc1[ct][0] + acc1[ct][1] * acc1[ct][1]) + (acc1[ct][2] * acc1[ct][2] + acc1[ct][3] * acc1[ct][3]); }
            ssq += __shfl_xor(ssq, 16); ssq += __shfl_xor(ssq, 32);
            const float rn = __builtin_amdgcn_rsqf(ssq * (1.0f / 128.0f) + EPS);
            const bf16* gp = Z + (R0 + i_) * NIN + 3072 + 128 * h + 4 * fq; bf16* mp = MIX + (R0 + i_) * D + 128 * h + 4 * fq;
#pragma unroll
            for (int ct = 0; ct < 8; ++ct) { const v2u gg = *(const v2u*)(gp + 16 * ct); v2u w;
                w.x = pk2(acc1[ct][0] * rn * lo16(gg.x), acc1[ct][1] * rn * hi16(gg.x)); w.y = pk2(acc1[ct][2] * rn * lo16(gg.y), acc1[ct][3] * rn * hi16(gg.y)); *(v2u*)(mp + 16 * ct) = w; }
            __syncthreads(); }
        for (int u = blk; u < 512; u += G) { const int b = u >> 7, c = (u >> 3) & 15, grp = u & 7; const size_t R0 = (size_t)b * SEQ + 128 * c;
#pragma unroll
            for (int it = 0; it < 4; ++it) { const int idx = tid + 512 * it, t = idx >> 4, s8 = idx & 15; const float* wp = gm_ws + (size_t)grp * 16384 + t * 128 + 8 * s8;
                const f32x4 w0 = *(const f32x4*)wp, w1 = *(const f32x4*)(wp + 4); float wv[8] = {w0[0], w0[1], w0[2], w0[3], w1[0], w1[1], w1[2], w1[3]};
#pragma unroll
                for (int j = 0; j < 8; ++j) if (8 * s8 + j > t) wv[j] = 0.f;
                v4u w; w.x = pk2(wv[0], wv[1]); w.y = pk2(wv[2], wv[3]); w.z = pk2(wv[4], wv[5]); w.w = pk2(wv[6], wv[7]); *(LAS v4u*)(T0 + t * LDP + 8 * s8) = w; }
#pragma unroll
            for (int it = 0; it < 4; ++it) { const int idx = tid + 512 * it, s = idx >> 4, d8 = idx & 15; const v4u x = *(const v4u*)(Z + (R0 + s) * NIN + 5120 + 128 * grp + 8 * d8);
                const float mean = STATS[2 * (R0 + s)], rstd = STATS[2 * (R0 + s) + 1]; const float* lg = gm_ln_g + 128 * grp + 8 * d8; const float* lb = gm_ln_b + 128 * grp + 8 * d8;
#pragma unroll
                for (int p = 0; p < 4; ++p) { T1[(8 * d8 + 2 * p) * LDP + s] = f2bf((lo16(x[p]) - mean) * rstd * lg[2 * p] + lb[2 * p]); T1[(8 * d8 + 2 * p + 1) * LDP + s] = f2bf((hi16(x[p]) - mean) * rstd * lg[2 * p + 1] + lb[2 * p + 1]); } }
            __syncthreads();
            f32x4 acc[8];
#pragma unroll
            for (int ct = 0; ct < 8; ++ct) acc[ct] = (f32x4){0.f, 0.f, 0.f, 0.f};
            mm128(acc, T0, T1, wave, fr, fq);
            const int t_ = 16 * wave + fr; const float bsv = gm_bs[grp * 128 + t_];
            const bf16* up = Z + (R0 + t_) * NIN + 4096 + 128 * grp + 4 * fq; bf16* mp = MIX + (R0 + t_) * D + 1024 + 128 * grp + 4 * fq;
#pragma unroll
            for (int ct = 0; ct < 8; ++ct) { const v2u uu = *(const v2u*)(up + 16 * ct); v2u w;
                w.x = pk2((acc[ct][0] + bsv) * lo16(uu.x), (acc[ct][1] + bsv) * hi16(uu.x)); w.y = pk2((acc[ct][2] + bsv) * lo16(uu.y), (acc[ct][3] + bsv) * hi16(uu.y)); *(v2u*)(mp + 16 * ct) = w; }
            __syncthreads(); }
    }
    SEAM(3);

    if (IN(4)) {
        { pg8::Gemm g{MIX, Wo_t, MP, D, D}; pg8::StaticOrder S; S.init(MP, D, G, blk); EpiRes E{x_p, out, AB, SS1};
          pg8::gemm_phase<EpiRes, pg8::StaticOrder, true, true>(lds, g, S, E); }
        auto f = [&](int s, int n, float v) { const float o = x_s[(size_t)s * D + n] + v; out[(size_t)(MP + s) * D + n] = o; AB[(size_t)(MP + s) * D + n] = f2bf(o);
            const float q = half_wave_sum(o * o); if ((lane & 31) == 0) atomic_addf(SS1 + MP + s, q); };
        skinny_gemm<2>(lds, MIX + (size_t)MP * D, Wo_t, D, D, blk, G, f);
    }
    SEAM(4);

    if (IN(5)) {
        { pg8::Gemm g{AB, Wup_t, MP, NUP, D}; pg8::StaticOrder S; S.init(MP, NUP, G, blk); EpiUp E{ACT, RAW, SS1, conv_w, conv_b};
          pg8::gemm_phase<EpiUp, pg8::StaticOrder, true, true>(lds, g, S, E); }
        auto f = [&](int s, int n, float v) { const int within = n & 255, col = (within >> 7) * DFF + 128 * (n >> 8) + (within & 127);
            AS[(size_t)s * NUP + col] = v * __builtin_amdgcn_rsqf(SS1[MP + s] * (1.0f / D) + EPS); };
        if (blk >= 128) skinny_gemm<8>(lds, AB + (size_t)MP * D, Wup_t, NUP, D, blk - 128, 128, f);
    }
    SEAM(5);

    if (IN(6)) {
        for (int i = gt; i < 128 * 2 * (DFF / 4); i += NGT) { const int c4 = i % (DFF / 4), gr = i / (DFF / 4), rr = gr & 1, Gp = gr >> 1, c = 4 * c4; const bool first = (Gp & 31) == 0;
            const float* rg = RAW + (size_t)Gp * 4 * NUP; const float* rp = rg - 4 * NUP; const f32x4 z4 = {0.f, 0.f, 0.f, 0.f};
            f32x4 a0g, a0u, a1g, a1u, a2g, a2u;
            a0g = *(const f32x4*)(rg + (2 + rr) * NUP + c); a0u = *(const f32x4*)(rg + (2 + rr) * NUP + DFF + c);
            if (rr) { a1g = *(const f32x4*)(rg + 2 * NUP + c); a1u = *(const f32x4*)(rg + 2 * NUP + DFF + c); a2g = first ? z4 : *(const f32x4*)(rp + NUP + c); a2u = first ? z4 : *(const f32x4*)(rp + NUP + DFF + c); }
            else { a1g = first ? z4 : *(const f32x4*)(rp + NUP + c); a1u = first ? z4 : *(const f32x4*)(rp + NUP + DFF + c); a2g = first ? z4 : *(const f32x4*)(rp + c); a2u = first ? z4 : *(const f32x4*)(rp + DFF + c); }
            const f32x4 ag = *(const f32x4*)(conv_w + c) * a2g + *(const f32x4*)(conv_w + NUP + c) * a1g + *(const f32x4*)(conv_w + 2 * NUP + c) * a0g + *(const f32x4*)(conv_b + c);
            const f32x4 au = *(const f32x4*)(conv_w + DFF + c) * a2u + *(const f32x4*)(conv_w + NUP + DFF + c) * a1u + *(const f32x4*)(conv_w + 2 * NUP + DFF + c) * a0u + *(const f32x4*)(conv_b + DFF + c);
            v2u w; w.x = pk2(silu_(ag[0]) * au[0], silu_(ag[1]) * au[1]); w.y = pk2(silu_(ag[2]) * au[2], silu_(ag[3]) * au[3]);
            *(v2u*)(ACT + (size_t)(64 * Gp + rr) * DFF + c) = w; }
        for (int i = gt; i < MS * (DFF / 4); i += NGT) { const int c4 = i % (DFF / 4), s = i / (DFF / 4), c = 4 * c4;
            const float* sc0 = state_conv + (size_t)s * 2 * NUP; const float* sc1 = sc0 + NUP; const float* as = AS + (size_t)s * NUP;
            const f32x4 a0g = *(const f32x4*)(as + c), a0u = *(const f32x4*)(as + DFF + c), a1g = *(const f32x4*)(sc1 + c), a1u = *(const f32x4*)(sc1 + DFF + c), a2g = *(const f32x4*)(sc0 + c), a2u = *(const f32x4*)(sc0 + DFF + c);
            const f32x4 ag = *(const f32x4*)(conv_w + c) * a2g + *(const f32x4*)(conv_w + NUP + c) * a1g + *(const f32x4*)(conv_w + 2 * NUP + c) * a0g + *(const f32x4*)(conv_b + c);
            const f32x4 au = *(const f32x4*)(conv_w + DFF + c) * a2u + *(const f32x4*)(conv_w + NUP + DFF + c) * a1u + *(const f32x4*)(conv_w + 2 * NUP + DFF + c) * a0u + *(const f32x4*)(conv_b + DFF + c);
            v2u w; w.x = pk2(silu_(ag[0]) * au[0], silu_(ag[1]) * au[1]); w.y = pk2(silu_(ag[2]) * au[2], silu_(ag[3]) * au[3]);
            *(v2u*)(ACT + (size_t)(MP + s) * DFF + c) = w;
            float* cs = out + O_CONVS + (size_t)s * 2 * NUP; *(f32x4*)(cs + c) = a1g; *(f32x4*)(cs + DFF + c) = a1u; *(f32x4*)(cs + NUP + c) = a0g; *(f32x4*)(cs + NUP + DFF + c) = a0u; }
        for (int i = gt; i < 4 * 2 * (NUP / 4); i += NGT) { const int c4 = i % (NUP / 4), bk = i / (NUP / 4), b = bk >> 1, k = bk & 1;
            *(f32x4*)(out + O_CONVP + (size_t)bk * NUP + 4 * c4) = *(const f32x4*)(RAW + ((size_t)(32 * b + 31) * 4 + k) * NUP + 4 * c4); }
    }
    SEAM(6);

    if (IN(7)) {
        { pg8::Gemm g{ACT, Wdn_t, MP, D, DFF}; pg8::StaticOrder S; S.init(MP, D, G, blk); EpiRes E{out, out, AB, SS2};
          pg8::gemm_phase<EpiRes, pg8::StaticOrder, true, true>(lds, g, S, E); }
        auto f = [&](int s, int n, float v) { const size_t o_ = (size_t)(MP + s) * D + n; const float o = out[o_] + v; out[o_] = o; AB[o_] = f2bf(o);
            const float q = half_wave_sum(o * o); if ((lane & 31) == 0) atomic_addf(SS2 + MP + s, q); };
        skinny_gemm<2>(lds, ACT + (size_t)MP * DFF, Wdn_t, D, DFF, blk, G, f);
    }
    SEAM(7);

    if (IN(8)) {
#ifndef T_A
        { int Kp = PLE; asm volatile("" : "+s"(Kp));
          pg8::Gemm g{PB, Wp_t, MP, D, Kp}; pg8::StaticOrder S; S.init(MP, D, G, blk); EpiPP E{PP};
          pg8::gemm_phase<EpiPP, pg8::StaticOrder, true, true>(lds, g, S, E); }
#endif
#ifndef T_B
        { pg8::Gemm g{AB, Wg_t, MP, D, D}; pg8::StaticOrder S; S.init(MP, D, G, blk); EpiGate E{PP, out, SS2, SS3};
          pg8::gemm_phase<EpiGate, pg8::StaticOrder, true, true>(lds, g, S, E); }
#endif
#ifndef T_C
        auto f1 = [&](int s, int n, float v) { PP[(size_t)(MP + s) * D + n] = v; };
        skinny_gemm<2>(lds, PB + (size_t)MP * PLE, Wp_t, D, PLE, blk, G, f1);
#endif
#ifndef T_D
        auto f2 = [&](int s, int n, float v) { const size_t o_ = (size_t)(MP + s) * D + n; const float r2 = __builtin_amdgcn_rsqf(SS2[MP + s] * (1.0f / D) + EPS);
            const float o = out[o_] + PP[o_] * sigmoid_(r2 * v); out[o_] = o; const float q = half_wave_sum(o * o); if ((lane & 31) == 0) atomic_addf(SS3 + MP + s, q); };
        skinny_gemm<2>(lds, AB + (size_t)MP * D, Wg_t, D, D, blk, G, f2);
#endif
    }
    SEAM(8);

    if (IN(9)) {
        for (int m = gw; m < MT; m += NGW) { f32x4* hr = (f32x4*)(out + (size_t)m * D) + lane; const f32x4* gr = (const f32x4*)g_final + lane;
            const float r = __builtin_amdgcn_rsqf(SS3[m] * (1.0f / D) + EPS);
#pragma unroll
            for (int j = 0; j < 8; ++j) hr[64 * j] = hr[64 * j] * gr[64 * j] * r; }
    }
#undef IN
#undef SEAM
}

extern "C" void kernel_launch(void* const* d_in, const int* in_sizes, int n_in, void* d_out, int out_size, void* d_ws, size_t ws_size, hipStream_t stream) {
    static int grid = 0;
    if (grid == 0) {
        if (n_in != 22 || out_size != (int)O_END || ws_size < WS_END) { fprintf(stderr, "kernel_launch: unexpected shapes: n_in %d out %d ws %zu\n", n_in, out_size, ws_size); grid = -1; return; }
        int dev = 0, cus = 0, per_cu = 0;
        if (hipGetDevice(&dev) != hipSuccess || hipDeviceGetAttribute(&cus, hipDeviceAttributeMultiprocessorCount, dev) != hipSuccess) { grid = -1; return; }
        if (hipFuncSetAttribute((const void*)mk_fwd, hipFuncAttributeMaxDynamicSharedMemorySize, LDS_BYTES) != hipSuccess) { fprintf(stderr, "kernel_launch: hipFuncSetAttribute failed\n"); grid = -1; return; }
        if (hipOccupancyMaxActiveBlocksPerMultiprocessor(&per_cu, (const void*)mk_fwd, 512, LDS_BYTES) != hipSuccess || per_cu < 1) fprintf(stderr, "kernel_launch: occupancy query says %d\n", per_cu);
        (void)hipGetLastError();
        grid = cus;
        if (grid != 256) fprintf(stderr, "kernel_launch: %d CUs (built for 256)\n", grid);
    }
    if (grid < 0) return;
    if (hipMemsetAsync((char*)d_ws + WS_BAR, 0, BAR_BYTES, stream) != hipSuccess) { fprintf(stderr, "kernel_launch: memset failed\n"); return; }
    Params p{};
    for (int i = 0; i < 22; ++i) p.in[i] = (const float*)d_in[i];
    p.out = (float*)d_out; p.ws = (unsigned char*)d_ws;
    for (int h = 0; h < 8; ++h) p.log2g[h] = (float)std::log2(1.0 - std::exp2(-5.0 - (double)h));
    for (int i = 0; i < 64; ++i) p.invf[i] = powf(10000.0f, -(float)i / 64.0f);
    p.use_cg = 0; p.pad = 0;
#if MK_N_LAUNCHES == 1
    p.ph_lo = 0; p.ph_hi = NPHASE;
    void* args[] = {&p};
    hipError_t e = hipLaunchCooperativeKernel((const void*)mk_fwd, dim3(grid), dim3(512), args, LDS_BYTES, stream);
    if (e != hipSuccess) fprintf(stderr, "kernel_launch: cooperative launch failed: %s\n", hipGetErrorString(e));
#else
    for (int ph = 0; ph < NPHASE; ++ph) { p.ph_lo = ph; p.ph_hi = ph + 1; hipLaunchKernelGGL(mk_fwd, dim3(grid), dim3(512), LDS_BYTES, stream, p); }
#endif
}
```

```cpp
#include <hip/hip_runtime.h>
#include <hip/hip_cooperative_groups.h>
#include <cstdio>
#include <cstdint>
#include <cmath>
namespace cg = cooperative_groups;

#ifndef MK_N_LAUNCHES
#define MK_N_LAUNCHES 1
#endif

namespace pg8 {
#define PG8_LAS __attribute__((address_space(3)))
typedef unsigned short bf16_t;
typedef short bf16x8 __attribute__((ext_vector_type(8)));
typedef float f32x4 __attribute__((ext_vector_type(4)));
typedef unsigned u32x4 __attribute__((ext_vector_type(4)));
constexpr int BM = 256, BK = 64, HALF = 128, HTB = HALF * BK * 2  , STAGE_BYTES = 8 * HTB, NXCD = 8, WGM = 8;

__host__ __device__ __forceinline__ int lds_byte(int r, int c) { const int st = (r >> 4) * 2 + (c >> 5), rr = r & 15, cc = c & 31, ob = rr * 64 + cc * 2; return st * 1024 + (ob ^ (((ob >> 9) & 1) << 5)); }
__host__ __device__ __forceinline__ void stage_rc(int b, int& R, int& C) { const int st = b / 1024, sb = b % 1024, swz = sb ^ (((sb >> 9) & 1) << 5); R = (st >> 1) * 16 + swz / 64; C = (st & 1) * 32 + (swz % 64) / 2; }
__host__ __device__ __forceinline__ int perm32(int rho) { const int n = rho >> 4, i = rho & 15; return 8 * (i >> 2) + 4 * n + (i & 3); }

struct Unit { int pm, pn; };
struct Gemm { const bf16_t* A; const bf16_t* Bt; int M, N, K; };

struct StaticOrder {
    int nM, nN, nwg, G, c;
    __host__ __device__ void init(int M, int N, int G_, int c_) { nM = M / BM; nN = N / BM; nwg = nM * nN; G = G_; c = c_; }
    __host__ __device__ bool next(int i, Unit& u) const {
        const long L = (long)i * G + c; if (L >= nwg) return false;
        int wgid = (int)L; { const int q = nwg / NXCD, r = nwg % NXCD, xcd = wgid % NXCD, off = wgid / NXCD; wgid = (xcd < r ? xcd * (q + 1) : r * (q + 1) + (xcd - r) * q) + off; }
        const int nig = WGM * nN, gid = wgid / nig, fm = gid * WGM, gsz = (nM - fm) < WGM ? (nM - fm) : WGM;
        u.pm = fm + ((wgid % nig) % gsz); u.pn = (wgid % nig) / gsz; return true;
    }
    __device__ __forceinline__ void a_ready(const Unit&) const {}
    __device__ __forceinline__ void done(const Unit&) const {}
};

__device__ __forceinline__ unsigned cvt_pk_bf16(float lo, float hi) { unsigned r; asm volatile("v_cvt_pk_bf16_f32 %0, %1, %2" : "=v"(r) : "v"(lo), "v"(hi)); return r; }
typedef float f32x2 __attribute__((ext_vector_type(2)));

template <class Epi, class Sched, bool ALIGN_EPI = false, bool SP2 = false>
__device__ __forceinline__ void gemm_phase(PG8_LAS unsigned char* lds, const Gemm g, const Sched& S, const Epi& E) {
    const int tid = threadIdx.x, wid = __builtin_amdgcn_readfirstlane(tid >> 6), lane = tid & 63, wr = wid >> 2, wc = wid & 3, fr = lane & 15, fq = lane >> 4;
    const int K = g.K, nt = K / BK;
    unsigned voffA[2], voffB[2];
#pragma unroll
    for (int i = 0; i < 2; ++i) { int R, C; stage_rc(tid * 16 + i * 8192, R, C); const int Rb = Epi::PERM ? ((R & ~31) + perm32(R & 31)) : R;
        voffA[i] = (unsigned)(R * K + C) * 2u; voffB[i] = (unsigned)(Rb * K + C) * 2u; }
    const size_t kstep = (size_t)(BK * 2);
    const size_t hstep = (size_t)HALF * K * 2;
    const size_t tstep = 2 * hstep;
    const unsigned ldsw = (unsigned)wid * 1024u;
    const int aoff = lds_byte(wr * 64 + fr, fq * 8), boff = lds_byte(wc * 32 + fr, fq * 8);
#define PG8_SA(b, h) (((b) * 2 + (h)) * HTB)
#define PG8_SB(b, h) ((4 + (b) * 2 + (h)) * HTB)
#define PG8_STAGE(bufoff, gbase, voff) do { _Pragma("unroll") for (int _i = 0; _i < 2; ++_i) \
        __builtin_amdgcn_global_load_lds((const unsigned*)((const char*)(gbase) + (voff)[_i]), (PG8_LAS unsigned*)(lds + (bufoff) + ldsw + _i * 8192), 16, 0, 0); } while (0)
#define PG8_LDA(dst, b, h) do { _Pragma("unroll") for (int m = 0; m < 4; ++m) _Pragma("unroll") for (int k = 0; k < 2; ++k) dst[m][k] = *(const PG8_LAS bf16x8*)(lds + PG8_SA(b, h) + aoff + m * 2048 + k * 1024); } while (0)
#define PG8_LDB(dst, b, h) do { _Pragma("unroll") for (int n = 0; n < 2; ++n) _Pragma("unroll") for (int k = 0; k < 2; ++k) dst[n][k] = *(const PG8_LAS bf16x8*)(lds + PG8_SB(b, h) + boff + n * 2048 + k * 1024); } while (0)
#define PG8_MMA(ai, bj, At, Bt) do { __builtin_amdgcn_s_setprio(1); _Pragma("unroll") for (int m = 0; m < 4; ++m) _Pragma("unroll") for (int n = 0; n < 2; ++n) _Pragma("unroll") for (int k = 0; k < 2; ++k) \
        acc[ai][bj][m][n] = __builtin_amdgcn_mfma_f32_16x16x32_bf16(Bt[n][k], At[m][k], acc[ai][bj][m][n], 0, 0, 0); __builtin_amdgcn_s_setprio(0); } while (0)
#define PG8_WAIT_V(n) asm volatile("s_waitcnt vmcnt(" #n ")" ::: "memory")
#define PG8_WAIT_L(n) asm volatile("s_waitcnt lgkmcnt(" #n ")" ::: "memory")
#define PG8_BAR __builtin_amdgcn_s_barrier()
#define PG8_SCHED __builtin_amdgcn_sched_barrier(0)
    Unit cur, nxt; int ui = 0;
    if (!S.next(0, cur)) return;
    f32x4 acc[2][2][4][2];
#pragma unroll
    for (int a = 0; a < 2; ++a)
#pragma unroll
        for (int b = 0; b < 2; ++b)
#pragma unroll
            for (int m = 0; m < 4; ++m)
#pragma unroll
                for (int n = 0; n < 2; ++n) acc[a][b][m][n] = (f32x4){0.f, 0.f, 0.f, 0.f};
    bf16x8 At[4][2], B0[2][2], B1[2][2];
    const char* cA = (const char*)g.A + (size_t)cur.pm * tstep; const char* cB = (const char*)g.Bt + (size_t)cur.pn * tstep;
    S.a_ready(cur);
    if constexpr (SP2) {
        PG8_STAGE(PG8_SB(0, 0), cB, voffB); PG8_STAGE(PG8_SB(0, 1), cB + hstep, voffB); PG8_STAGE(PG8_SA(0, 0), cA, voffA); PG8_STAGE(PG8_SA(0, 1), cA + hstep, voffA);
        if (wr == 1) PG8_BAR;
        PG8_WAIT_V(2); PG8_BAR;
        PG8_STAGE(PG8_SB(1, 0), cB + kstep, voffB); PG8_STAGE(PG8_SA(1, 0), cA + kstep, voffA); PG8_STAGE(PG8_SB(1, 1), cB + hstep + kstep, voffB);
        PG8_WAIT_V(6); PG8_BAR;
    } else {
        PG8_STAGE(PG8_SB(0, 0), cB, voffB); PG8_STAGE(PG8_SA(0, 0), cA, voffA); PG8_STAGE(PG8_SB(0, 1), cB + hstep, voffB); PG8_STAGE(PG8_SA(0, 1), cA + hstep, voffA);
        if (wr == 1) PG8_BAR;
        PG8_WAIT_V(4); PG8_BAR;
        PG8_STAGE(PG8_SB(1, 0), cB + kstep, voffB); PG8_STAGE(PG8_SA(1, 0), cA + kstep, voffA); PG8_STAGE(PG8_SB(1, 1), cB + hstep + kstep, voffB);
        PG8_WAIT_V(6); PG8_BAR;
    }
    for (;;) {
        const bool has_next = S.next(ui + 1, nxt);
        const char* nA = has_next ? (const char*)g.A + (size_t)nxt.pm * tstep : cA; const char* nB = has_next ? (const char*)g.Bt + (size_t)nxt.pn * tstep : cB;
        for (int t = 0; t < nt; t += 2) {
            const bool last = (t == nt - 2);
            const char* a1 = cA + (size_t)(t + 1) * kstep;
            const char* a2 = last ? nA : cA + (size_t)(t + 2) * kstep; const char* b2 = last ? nB : cB + (size_t)(t + 2) * kstep;
            const char* a3 = a2 + kstep; const char* b3 = b2 + kstep;
            if (last && has_next) S.a_ready(nxt);
            if constexpr (SP2) {
            PG8_LDB(B0, 0, 0); PG8_LDB(B1, 0, 1); PG8_SCHED; PG8_LDA(At, 0, 0); PG8_STAGE(PG8_SA(1, 1), a1 + hstep, voffA);
            PG8_WAIT_V(8); PG8_WAIT_L(0); PG8_BAR; PG8_MMA(0, 0, At, B0); PG8_MMA(0, 1, At, B1); PG8_BAR; PG8_SCHED;
            PG8_LDA(At, 0, 1); PG8_STAGE(PG8_SB(0, 0), b2, voffB); PG8_STAGE(PG8_SB(0, 1), b2 + hstep, voffB); PG8_STAGE(PG8_SA(0, 0), a2, voffA);
            PG8_WAIT_V(8); PG8_WAIT_L(0); PG8_BAR; PG8_MMA(1, 0, At, B0); PG8_MMA(1, 1, At, B1); PG8_BAR; PG8_SCHED;
            PG8_LDB(B0, 1, 0); PG8_LDB(B1, 1, 1); PG8_SCHED; PG8_LDA(At, 1, 0); PG8_STAGE(PG8_SA(0, 1), a2 + hstep, voffA);
            PG8_WAIT_V(8); PG8_WAIT_L(0); PG8_BAR; PG8_MMA(0, 0, At, B0); PG8_MMA(0, 1, At, B1); PG8_BAR; PG8_SCHED;
            PG8_LDA(At, 1, 1); PG8_STAGE(PG8_SB(1, 0), b3, voffB); PG8_STAGE(PG8_SB(1, 1), b3 + hstep, voffB); PG8_STAGE(PG8_SA(1, 0), a3, voffA);
            PG8_WAIT_V(8); PG8_WAIT_L(0); PG8_BAR; PG8_MMA(1, 0, At, B0); PG8_MMA(1, 1, At, B1); PG8_BAR; PG8_SCHED;
            } else {
            PG8_LDB(B0, 0, 0); PG8_SCHED; PG8_LDA(At, 0, 0); PG8_STAGE(PG8_SA(1, 1), a1 + hstep, voffA);
            PG8_WAIT_L(8); PG8_BAR; PG8_WAIT_L(0); PG8_MMA(0, 0, At, B0); PG8_BAR; PG8_SCHED;
            PG8_LDB(B1, 0, 1); PG8_STAGE(PG8_SB(0, 0), b2, voffB);
            PG8_BAR; PG8_WAIT_L(0); PG8_MMA(0, 1, At, B1); PG8_BAR;
            PG8_LDA(At, 0, 1); PG8_STAGE(PG8_SA(0, 0), a2, voffA);
            PG8_BAR; PG8_WAIT_L(0); PG8_MMA(1, 0, At, B0); PG8_BAR; PG8_SCHED;
            PG8_STAGE(PG8_SB(0, 1), b2 + hstep, voffB);
            PG8_WAIT_V(6); PG8_BAR; PG8_MMA(1, 1, At, B1); PG8_BAR;
            PG8_LDB(B0, 1, 0); PG8_SCHED; PG8_LDA(At, 1, 0); PG8_STAGE(PG8_SA(0, 1), a2 + hstep, voffA);
            PG8_WAIT_L(8); PG8_BAR; PG8_WAIT_L(0); PG8_MMA(0, 0, At, B0); PG8_BAR; PG8_SCHED;
            PG8_LDB(B1, 1, 1); PG8_STAGE(PG8_SB(1, 0), b3, voffB);
            PG8_BAR; PG8_WAIT_L(0); PG8_MMA(0, 1, At, B1); PG8_BAR;
            PG8_LDA(At, 1, 1); PG8_STAGE(PG8_SA(1, 0), a3, voffA);
            PG8_BAR; PG8_WAIT_L(0); PG8_MMA(1, 0, At, B0); PG8_BAR; PG8_SCHED;
            PG8_STAGE(PG8_SB(1, 1), b3 + hstep, voffB);
            PG8_WAIT_V(6); PG8_BAR; PG8_MMA(1, 1, At, B1); PG8_BAR;
            }
        }
        if constexpr (ALIGN_EPI) { if (wr == 0) PG8_BAR; }
        if constexpr (!Epi::AFTER_DRAIN) { E(acc, cur, wr, wc, fr, fq); S.done(cur); }
        if (!has_next) break;
#pragma unroll
        for (int a = 0; a < 2; ++a)
#pragma unroll
            for (int b = 0; b < 2; ++b)
#pragma unroll
                for (int m = 0; m < 4; ++m)
#pragma unroll
                    for (int n = 0; n < 2; ++n) acc[a][b][m][n] = (f32x4){0.f, 0.f, 0.f, 0.f};
        cur = nxt; cA = nA; cB = nB; ++ui;
        if constexpr (ALIGN_EPI) { if (wr == 1) PG8_BAR; }
    }
    PG8_WAIT_V(0);
    if constexpr (!ALIGN_EPI) { if (wr == 0) PG8_BAR; }
    PG8_BAR;
    if constexpr (Epi::AFTER_DRAIN) { E.fused(acc, cur, wr, wc, fr, fq, lds, wid, lane); S.done(cur); }
#undef PG8_SA
#undef PG8_SB
#undef PG8_STAGE
#undef PG8_LDA
#undef PG8_LDB
#undef PG8_MMA
#undef PG8_WAIT_V
#undef PG8_WAIT_L
#undef PG8_BAR
#undef PG8_SCHED
}
}

#define GAS __attribute__((address_space(1)))
#define LAS __attribute__((address_space(3)))
typedef unsigned short bf16;
typedef unsigned v4u __attribute__((ext_vector_type(4)));
typedef unsigned v2u __attribute__((ext_vector_type(2)));
typedef float f32x4 __attribute__((ext_vector_type(4)));
typedef float f32x2 __attribute__((ext_vector_type(2)));
typedef short bf16x8 __attribute__((ext_vector_type(8)));
#define XB_TMO      128
#define XB_XCNT(j)  (256  + 64 * (j))
#define XB_XSUB(j)  (1280 + 64 * (j))
#define XB_XGEN(j)  (2304 + 64 * (j))
#define XB_TOP      3328
#define XB_TOPGEN   3392
#define XCD_BAR_WORDS 3456
#define XB_SPIN_CAP (1u << 18)

__device__ __forceinline__ unsigned xb_ld(unsigned* p)              { return __hip_atomic_load(p, __ATOMIC_RELAXED, __HIP_MEMORY_SCOPE_AGENT); }
__device__ __forceinline__ unsigned xb_add(unsigned* p, unsigned v) { return __hip_atomic_fetch_add(p, v, __ATOMIC_RELAXED, __HIP_MEMORY_SCOPE_AGENT); }
__device__ __forceinline__ unsigned xb_xcc_id() { return (unsigned)__builtin_amdgcn_s_getreg((3 << 11) | 20) & 0xFu; }
#define XB_SPIN(cond, bar) do { unsigned _sp = 0; while (cond) { __builtin_amdgcn_s_sleep(1); \
    if ((++_sp & 255u) == 0u) { if (xb_ld(&(bar)[XB_TMO])) break; if (_sp > XB_SPIN_CAP) { atomicAdd(&(bar)[XB_TMO], 1u); break; } } } } while (0)

struct XcdBarrier {
    unsigned* bar; unsigned x;
    volatile LAS unsigned* st;
};

__device__ __forceinline__ XcdBarrier xcd_barrier_post(unsigned* bar, volatile LAS unsigned* st) {
    XcdBarrier b; b.bar = bar; b.x = xb_xcc_id(); b.st = st;
    if (threadIdx.x == 0) (void)xb_add(&bar[XB_XCNT(b.x)], 1u);
    return b;
}
__device__ __forceinline__ void xcd_barrier_complete(unsigned* bar, unsigned x, unsigned& nloc, unsigned& nx) {
    const unsigned G = gridDim.x * gridDim.y * gridDim.z;
    unsigned sum, cnt, mine, sp = 0u;
    for (;;) {
        sum = 0u; cnt = 0u; mine = 0u;
#pragma unroll
        for (unsigned j = 0; j < 16; ++j) { const unsigned c = xb_ld(&bar[XB_XCNT(j)]); sum += c; cnt += (c > 0u) ? 1u : 0u; mine = (j == x) ? c : mine; }
        if (sum == G) break;
        __builtin_amdgcn_s_sleep(1);
        if ((++sp & 255u) == 0u) { if (xb_ld(&bar[XB_TMO])) break; if (sp > XB_SPIN_CAP) { atomicAdd(&bar[XB_TMO], 1u); break; } }
    }
    nloc = mine > 0u ? mine : 1u; nx = cnt > 0u ? cnt : 1u;
}

__device__ __forceinline__ void xcd_barrier(const XcdBarrier& b) {
    asm volatile("s_waitcnt vmcnt(0)" ::: "memory");
    __syncthreads();
    if (threadIdx.x == 0) {
        unsigned* bar = b.bar;
        __builtin_amdgcn_s_waitcnt(0);
        unsigned nloc = b.st[0], nx = b.st[1];
        if (nloc == 0u) { xcd_barrier_complete(bar, b.x, nloc, nx); b.st[0] = nloc; b.st[1] = nx; }
        const unsigned old = xb_add(&bar[XB_XSUB(b.x)], 1u);
        const unsigned gen = old / nloc;
        if (old + 1u == (gen + 1u) * nloc) {
            __builtin_amdgcn_fence(__ATOMIC_RELEASE, "agent");
            asm volatile("s_waitcnt vmcnt(0)" ::: "memory");
            const unsigned og = xb_add(&bar[XB_TOP], 1u);
            const unsigned tg = og / nx;
            if (og + 1u == (tg + 1u) * nx) xb_add(&bar[XB_TOPGEN], 1u);
            else XB_SPIN(xb_ld(&bar[XB_TOPGEN]) == tg, bar);
            __builtin_amdgcn_fence(__ATOMIC_ACQUIRE, "agent");
            xb_add(&bar[XB_XGEN(b.x)], 1u);
            asm volatile("s_waitcnt vmcnt(0)" ::: "memory");
        } else {
            XB_SPIN(xb_ld(&bar[XB_XGEN(b.x)]) == gen, bar);
            __builtin_amdgcn_fence(__ATOMIC_ACQUIRE, "agent");
            asm volatile("s_waitcnt vmcnt(0)" ::: "memory");
        }
    }
    __syncthreads();
}

constexpr int MP = 8192, MS = 128, MT = MP + MS, D = 2048, NIN = 6144, NUP = 11264, DFF = 5632, PLE = 256, SEQ = 2048, NH = 8;
constexpr float EPS = 1e-6f;
constexpr int NPHASE = 10;
constexpr size_t MiB = 1u << 20;
constexpr size_t WS_BAR = 0, BAR_BYTES = 16384;
constexpr size_t WS_SS1 = 64 * 1024, WS_SS2 = 128 * 1024, WS_SS3 = 192 * 1024, WS_STATS = 256 * 1024;
constexpr size_t WS_ROPE = 1 * MiB, WS_ROPES = 2 * MiB;
constexpr size_t WS_WIN = 4 * MiB, WS_WO = 28 * MiB, WS_WUP = 36 * MiB, WS_WDN = 80 * MiB, WS_WG = 102 * MiB, WS_WP = 110 * MiB;
constexpr size_t WS_AB = 112 * MiB, WS_PB = 145 * MiB, WS_MIX = 150 * MiB, WS_Z = 183 * MiB, WS_ACT = 183 * MiB, WS_KV = 281 * MiB, WS_PP = 281 * MiB;
constexpr size_t WS_RAW = 313 * MiB, WS_AS = 335 * MiB, WS_END = 346 * MiB;
static_assert(WS_AB + (size_t)MT * D * 2 <= WS_PB && WS_PB + (size_t)MT * PLE * 2 <= WS_MIX && WS_MIX + (size_t)MT * D * 2 <= WS_Z, "ws map 1");
static_assert(WS_Z + (size_t)MT * NIN * 2 <= WS_KV && WS_ACT + (size_t)MT * DFF * 2 <= WS_KV && WS_KV + (size_t)512 * 16384 * 4 <= WS_RAW, "ws map 2");
static_assert(WS_RAW + (size_t)128 * 4 * NUP * 4 <= WS_AS && WS_AS + (size_t)MS * NUP * 4 <= WS_END && WS_PP + (size_t)MT * D * 4 <= WS_END, "ws map 3");
constexpr size_t O_RETP = 17039360, O_CONVP = 17563648, O_RETS = 17653760, O_CONVS = 34430976, O_GMV = 37314560, O_END = 37445632;
constexpr int LDS_BYTES = 147456, MISC_OFF = LDS_BYTES - 256;
constexpr int LDP = 136;
constexpr int TILE_B = 128 * LDP * 2;

struct Params { const float* in[22]; float* out; unsigned char* ws; float log2g[8]; float invf[64]; int ph_lo, ph_hi, use_cg, pad; };

#define LDS_WAIT() asm volatile("s_waitcnt lgkmcnt(0)" ::: "memory")
__device__ __forceinline__ float lo16(unsigned u) { return __uint_as_float(u << 16); }
__device__ __forceinline__ float hi16(unsigned u) { return __uint_as_float(u & 0xffff0000u); }
__device__ __forceinline__ float bf2f(bf16 b) { return __uint_as_float((unsigned)b << 16); }
__device__ __forceinline__ unsigned pk2(float lo, float hi) { return pg8::cvt_pk_bf16(lo, hi); }
__device__ __forceinline__ bf16 f2bf(float f) { return (bf16)(pg8::cvt_pk_bf16(f, 0.f) & 0xffffu); }
__device__ __forceinline__ float sigmoid_(float x) { return __builtin_amdgcn_rcpf(1.0f + __builtin_amdgcn_exp2f(-1.44269504089f * x)); }
__device__ __forceinline__ float silu_(float x) { return x * sigmoid_(x); }
__device__ __forceinline__ float gelu_(float x) { return x * sigmoid_(1.5957691216f * (x + 0.044715f * x * x * x)); }
__device__ __forceinline__ float wave_sum(float v) {
#pragma unroll
    for (int o = 1; o < 64; o <<= 1) v += __shfl_xor(v, o);
    return v;
}
__device__ __forceinline__ void atomic_addf(float* p, float v) { (void)__hip_atomic_fetch_add(p, v, __ATOMIC_RELAXED, __HIP_MEMORY_SCOPE_AGENT); }
template <int CTRL> __device__ __forceinline__ float dppf(float x) { return __int_as_float(__builtin_amdgcn_update_dpp(0, __float_as_int(x), CTRL, 0xf, 0xf, false)); }

using pg8::Unit;
struct EpiZ {
    static constexpr bool PERM = true, AFTER_DRAIN = false;
    bf16* Z;
    __device__ __forceinline__ void operator()(const f32x4 (&acc)[2][2][4][2], const Unit& u, int wr, int wc, int fr, int fq) const {
        const int row0 = u.pm * 256 + wr * 64 + fr, col0 = u.pn * 256 + wc * 32 + 8 * fq;
        const int mode = u.pn < 12 ? 0 : (u.pn < 16 ? 1 : 2);
#pragma unroll
        for (int ai = 0; ai < 2; ++ai)
#pragma unroll
            for (int m = 0; m < 4; ++m) { bf16* rowp = Z + (size_t)(row0 + ai * 128 + m * 16) * NIN + col0;
#pragma unroll
                for (int bj = 0; bj < 2; ++bj) { f32x4 v0 = acc[ai][bj][m][0], v1 = acc[ai][bj][m][1];
                    if (mode == 1) {
#pragma unroll
                        for (int j = 0; j < 4; ++j) { v0[j] = silu_(v0[j]); v1[j] = silu_(v1[j]); } }
                    else if (mode == 2) {
#pragma unroll
                        for (int j = 0; j < 4; ++j) { v0[j] = gelu_(v0[j]); v1[j] = gelu_(v1[j]); } }
                    v4u w; w.x = pk2(v0[0], v0[1]); w.y = pk2(v0[2], v0[3]); w.z = pk2(v1[0], v1[1]); w.w = pk2(v1[2], v1[3]);
                    *(v4u*)(rowp + bj * 128) = w; } }
    }
};
struct EpiRes {
    static constexpr bool PERM = false, AFTER_DRAIN = false;
    const float* base; float* out; bf16* hb; float* ss;
    __device__ __forceinline__ void operator()(const f32x4 (&acc)[2][2][4][2], const Unit& u, int wr, int wc, int fr, int fq) const {
        const int row0 = u.pm * 256 + wr * 64 + fr, col0 = u.pn * 256 + wc * 32 + 4 * fq;
        float sacc[2][4];
#pragma unroll
        for (int ai = 0; ai < 2; ++ai) {
            f32x4 bs[4][2][2];
#pragma unroll
            for (int m = 0; m < 4; ++m)
#pragma unroll
                for (int bj = 0; bj < 2; ++bj)
#pragma unroll
                    for (int n = 0; n < 2; ++n) bs[m][bj][n] = *(const f32x4*)(base + (size_t)(row0 + ai * 128 + m * 16) * D + col0 + bj * 128 + n * 16);
#pragma unroll
            for (int m = 0; m < 4; ++m) { const size_t off = (size_t)(row0 + ai * 128 + m * 16) * D + col0; float s = 0.f;
#pragma unroll
                for (int bj = 0; bj < 2; ++bj)
#pragma unroll
                    for (int n = 0; n < 2; ++n) { const f32x4 o = bs[m][bj][n] + acc[ai][bj][m][n];
                        *(f32x4*)(out + off + bj * 128 + n * 16) = o; v2u w; w.x = pk2(o[0], o[1]); w.y = pk2(o[2], o[3]); *(v2u*)(hb + off + bj * 128 + n * 16) = w;
                        s += (o[0] * o[0] + o[1] * o[1]) + (o[2] * o[2] + o[3] * o[3]); }
                s += __shfl_xor(s, 16); s += __shfl_xor(s, 32); sacc[ai][m] = s; }
            asm volatile("" ::: "memory"); }
        if (fq == 0) {
#pragma unroll
            for (int ai = 0; ai < 2; ++ai)
#pragma unroll
                for (int m = 0; m < 4; ++m) atomic_addf(ss + row0 + ai * 128 + m * 16, sacc[ai][m]); }
    }
};
struct EpiPP {
    static constexpr bool PERM = false, AFTER_DRAIN = false;
    bf16* pp;
    __device__ __forceinline__ void operator()(const f32x4 (&acc)[2][2][4][2], const Unit& u, int wr, int wc, int fr, int fq) const {
        const int row0 = u.pm * 256 + wr * 64 + fr, col0 = u.pn * 256 + wc * 32 + 4 * fq;
#pragma unroll
        for (int ai = 0; ai < 2; ++ai)
#pragma unroll
            for (int m = 0; m < 4; ++m) { bf16* rowp = pp + (size_t)(row0 + ai * 128 + m * 16) * D + col0;
#pragma unroll
                for (int bj = 0; bj < 2; ++bj)
#pragma unroll
                    for (int n = 0; n < 2; ++n) { const f32x4 v = acc[ai][bj][m][n]; v2u w; w.x = pk2(v[0], v[1]); w.y = pk2(v[2], v[3]); *(v2u*)(rowp + bj * 128 + n * 16) = w; } }
    }
};
struct EpiGate {
    static constexpr bool PERM = false, AFTER_DRAIN = false;
    const bf16* pp; float* h; const float* ss2; float* ss3;
    __device__ __forceinline__ void operator()(const f32x4 (&acc)[2][2][4][2], const Unit& u, int wr, int wc, int fr, int fq) const {
        const int row0 = u.pm * 256 + wr * 64 + fr, col0 = u.pn * 256 + wc * 32 + 4 * fq;
        float sacc[2][4];
#pragma unroll
        for (int ai = 0; ai < 2; ++ai)
#pragma unroll
            for (int mp = 0; mp < 2; ++mp) {
                f32x4 hv[2][2][2]; v2u pw[2][2][2]; float r2[2];
#pragma unroll
                for (int mm = 0; mm < 2; ++mm) { const int row = row0 + ai * 128 + (2 * mp + mm) * 16; r2[mm] = ss2[row];
#pragma unroll
                    for (int bj = 0; bj < 2; ++bj)
#pragma unroll
                        for (int n = 0; n < 2; ++n) { hv[mm][bj][n] = *(const f32x4*)(h + (size_t)row * D + col0 + bj * 128 + n * 16); pw[mm][bj][n] = *(const v2u*)(pp + (size_t)row * D + col0 + bj * 128 + n * 16); } }
#pragma unroll
                for (int mm = 0; mm < 2; ++mm) { const int m = 2 * mp + mm; const size_t off = (size_t)(row0 + ai * 128 + m * 16) * D + col0; float s = 0.f;
                    const float rr = __builtin_amdgcn_rsqf(r2[mm] * (1.0f / D) + EPS);
#pragma unroll
                    for (int bj = 0; bj < 2; ++bj)
#pragma unroll
                        for (int n = 0; n < 2; ++n) { const v2u p2 = pw[mm][bj][n]; const f32x4 pv = {lo16(p2.x), hi16(p2.x), lo16(p2.y), hi16(p2.y)}; const f32x4 a = acc[ai][bj][m][n]; f32x4 o;
#pragma unroll
                            for (int j = 0; j < 4; ++j) o[j] = hv[mm][bj][n][j] + pv[j] * sigmoid_(rr * a[j]);
                            *(f32x4*)(h + off + bj * 128 + n * 16) = o; s += (o[0] * o[0] + o[1] * o[1]) + (o[2] * o[2] + o[3] * o[3]); }
                    s += __shfl_xor(s, 16); s += __shfl_xor(s, 32); sacc[ai][m] = s; }
                asm volatile("" ::: "memory"); }
        if (fq == 0) {
#pragma unroll
            for (int ai = 0; ai < 2; ++ai)
#pragma unroll
                for (int m = 0; m < 4; ++m) atomic_addf(ss3 + row0 + ai * 128 + m * 16, sacc[ai][m]); }
    }
};
struct EpiUp {
    static constexpr bool PERM = false, AFTER_DRAIN = false;
    bf16* act; float* raw; const float* ss1; const float* cw; const float* cb;
    __device__ __forceinline__ void operator()(const f32x4 (&acc)[2][2][4][2], const Unit& u, int wr, int wc, int fr, int fq) const {
        const int row0 = u.pm * 256 + wr * 64 + fr;
        float rs[2][4];
#pragma unroll
        for (int ai = 0; ai < 2; ++ai)
#pragma unroll
            for (int m = 0; m < 4; ++m) rs[ai][m] = __builtin_amdgcn_rsqf(ss1[row0 + ai * 128 + m * 16] * (1.0f / D) + EPS);
#pragma unroll
        for (int n = 0; n < 2; ++n) {
            const int cg_ = u.pn * 128 + wc * 32 + 16 * n + 4 * fq;
            const f32x4 w0g = *(const f32x4*)(cw + cg_), w1g = *(const f32x4*)(cw + NUP + cg_), w2g = *(const f32x4*)(cw + 2 * NUP + cg_), bg = *(const f32x4*)(cb + cg_);
            const f32x4 w0u = *(const f32x4*)(cw + DFF + cg_), w1u = *(const f32x4*)(cw + NUP + DFF + cg_), w2u = *(const f32x4*)(cw + 2 * NUP + DFF + cg_), bu = *(const f32x4*)(cb + DFF + cg_);
#pragma unroll
            for (int ai = 0; ai < 2; ++ai) {
                f32x4 pg = {0.f, 0.f, 0.f, 0.f}, pu = {0.f, 0.f, 0.f, 0.f};
#pragma unroll
                for (int m = 0; m < 4; ++m) {
                    const int row = row0 + ai * 128 + m * 16;
                    const f32x4 g = acc[ai][0][m][n] * rs[ai][m], up = acc[ai][1][m][n] * rs[ai][m];
                    if (m == 0 && fr < 2) { float* rp = raw + ((size_t)(row >> 6) * 4 + 2 + fr) * NUP + cg_; *(f32x4*)rp = g; *(f32x4*)(rp + DFF) = up; }
                    if (m == 3 && fr >= 14) { float* rp = raw + ((size_t)(row >> 6) * 4 + (fr - 14)) * NUP + cg_; *(f32x4*)rp = g; *(f32x4*)(rp + DFF) = up; }
                    f32x4 o;
#pragma unroll
                    for (int j = 0; j < 4; ++j) {
                        const float g1 = dppf<0x121>(fr == 15 ? pg[j] : g[j]), g2 = dppf<0x122>(fr >= 14 ? pg[j] : g[j]);
                        const float u1 = dppf<0x121>(fr == 15 ? pu[j] : up[j]), u2 = dppf<0x122>(fr >= 14 ? pu[j] : up[j]);
                        const float ag = w0g[j] * g2 + w1g[j] * g1 + w2g[j] * g[j] + bg[j];
                        const float au = w0u[j] * u2 + w1u[j] * u1 + w2u[j] * up[j] + bu[j];
                        o[j] = silu_(ag) * au; }
                    v2u w; w.x = pk2(o[0], o[1]); w.y = pk2(o[2], o[3]);
                    *(v2u*)(act + (size_t)row * DFF + cg_) = w;
                    pg = g; pu = up; } } }
    }
};

template <int RT, class F>
__device__ __forceinline__ void skinny_gemm(LAS unsigned char* lds, const bf16* A, const bf16* Bt, int N, int K, int u0, int ustride, const F& f) {
    const int tid = threadIdx.x, lane = tid & 63, w = tid >> 6, fr = lane & 15, fq = lane >> 4;
    constexpr int nrb = 8 / RT, ROWS = 16 * RT;
    const int nunits = nrb * (N / 32), kw = K / 8;
    LAS float* red = (LAS float*)lds;
    for (int u = u0; u < nunits; u += ustride) {
        const int rb = u % nrb, cb = u / nrb, row0 = rb * ROWS, col0 = cb * 32;
        f32x4 acc[RT][2];
#pragma unroll
        for (int rt = 0; rt < RT; ++rt) { acc[rt][0] = (f32x4){0.f, 0.f, 0.f, 0.f}; acc[rt][1] = (f32x4){0.f, 0.f, 0.f, 0.f}; }
        const bf16* ap = A + (size_t)(row0 + fr) * K + w * kw + 8 * fq;
        const bf16* bp = Bt + (size_t)(col0 + fr) * K + w * kw + 8 * fq;
#pragma unroll (RT <= 2 ? 8 : 2)
        for (int k = 0; k < kw; k += 32) {
            const bf16x8 b0 = *(const bf16x8*)(bp + k), b1 = *(const bf16x8*)(bp + (size_t)16 * K + k);
#pragma unroll
            for (int rt = 0; rt < RT; ++rt) { const bf16x8 av = *(const bf16x8*)(ap + (size_t)rt * 16 * K + k);
                acc[rt][0] = __builtin_amdgcn_mfma_f32_16x16x32_bf16(b0, av, acc[rt][0], 0, 0, 0);
                acc[rt][1] = __builtin_amdgcn_mfma_f32_16x16x32_bf16(b1, av, acc[rt][1], 0, 0, 0); }
        }
#pragma unroll
        for (int rt = 0; rt < RT; ++rt)
#pragma unroll
            for (int ct = 0; ct < 2; ++ct) *(LAS f32x4*)(red + (w * ROWS + 16 * rt + fr) * 32 + 16 * ct + 4 * fq) = acc[rt][ct];
        __syncthreads();
#pragma unroll
        for (int it = 0; it < RT; ++it) { const int e = tid + 512 * it, r = e >> 5, c = e & 31; float v = 0.f;
#pragma unroll
            for (int ww = 0; ww < 8; ++ww) v += red[(ww * ROWS + r) * 32 + c];
            f(row0 + r, col0 + c, v); }
        __syncthreads();
    }
}
__device__ __forceinline__ float half_wave_sum(float v) {
#pragma unroll
    for (int o = 1; o < 32; o <<= 1) v += __shfl_xor(v, o);
    return v;
}

__device__ __forceinline__ void transpose_item(const float* W, int K, int N, const float* g, bf16* WT, bool upmap, LAS float* scr, int item, int lane) {
    const int nblk = N / 64, kb = item / nblk, nb = item % nblk, k0 = 64 * kb, n0 = 64 * nb;
    const float* src = W + (size_t)k0 * N + n0 + lane;
#pragma unroll
    for (int h = 0; h < 2; ++h) {
        float v[32];
#pragma unroll
        for (int i = 0; i < 32; ++i) v[i] = src[(size_t)(32 * h + i) * N];
#pragma unroll
        for (int i = 0; i < 32; ++i) { float x = v[i]; if (g) x *= g[k0 + 32 * h + i]; scr[(32 * h + i) * 65 + lane] = x; }
    }
    LDS_WAIT(); asm volatile("" ::: "memory");
    const int c = lane & 7;
#pragma unroll
    for (int j = 0; j < 8; ++j) { const int n = (lane >> 3) + 8 * j; const LAS float* s = scr + (8 * c) * 65 + n;
        v4u o; o.x = pk2(s[0 * 65], s[1 * 65]); o.y = pk2(s[2 * 65], s[3 * 65]); o.z = pk2(s[4 * 65], s[5 * 65]); o.w = pk2(s[6 * 65], s[7 * 65]);
        int R = n0 + n; if (upmap) { const int half = R >= DFF ? 1 : 0, jj = R - half * DFF; R = 256 * (jj >> 7) + 128 * half + (jj & 127); }
        *(v4u*)(WT + (size_t)R * K + k0 + 8 * c) = o; }
    LDS_WAIT(); asm volatile("" ::: "memory");
}
__device__ __forceinline__ void rms_row_to_bf16(const float* xrow, bf16* orow, int lane) {
    const f32x4* xr = (const f32x4*)xrow + lane;
    f32x4 v[8]; float s = 0.f;
#pragma unroll
    for (int j = 0; j < 8; ++j) { v[j] = xr[64 * j]; s += (v[j][0] * v[j][0] + v[j][1] * v[j][1]) + (v[j][2] * v[j][2] + v[j][3] * v[j][3]); }
    const float r = __builtin_amdgcn_rsqf(wave_sum(s) * (1.0f / D) + EPS);
    v2u* o8 = (v2u*)orow + lane;
#pragma unroll
    for (int j = 0; j < 8; ++j) { v2u w; w.x = pk2(v[j][0] * r, v[j][1] * r); w.y = pk2(v[j][2] * r, v[j][3] * r); o8[64 * j] = w; }
}

__device__ __forceinline__ void mm128(f32x4 (&acc)[8], const LAS bf16* A, const LAS bf16* B, int wave, int fr, int fq) {
#pragma unroll
    for (int ks = 0; ks < 4; ++ks) {
        const bf16x8 a = *(const LAS bf16x8*)(A + (16 * wave + fr) * LDP + 32 * ks + 8 * fq);
#pragma unroll
        for (int ct = 0; ct < 8; ++ct) { const bf16x8 b = *(const LAS bf16x8*)(B + (16 * ct + fr) * LDP + 32 * ks + 8 * fq);
            acc[ct] = __builtin_amdgcn_mfma_f32_16x16x32_bf16(b, a, acc[ct], 0, 0, 0); }
    }
}
template <bool TRANS, bool DEC>
__device__ __forceinline__ void stage_rope(LAS bf16* dst, const bf16* zb, const float* rope, float scale, float l2g, int tid) {
#pragma unroll
    for (int it = 0; it < 2; ++it) { const int idx = tid + 512 * it, j = idx >> 3, d8 = idx & 7;
        const v4u x1 = *(const v4u*)(zb + (size_t)j * NIN + 8 * d8), x2 = *(const v4u*)(zb + (size_t)j * NIN + 64 + 8 * d8);
        const f32x4* rp = (const f32x4*)(rope + (size_t)(j * 64 + 8 * d8) * 2);
        float sc = scale; if (DEC) sc *= __builtin_amdgcn_exp2f(l2g * (float)(127 - j));
        float o1[8], o2[8];
#pragma unroll
        for (int p = 0; p < 4; ++p) { const f32x4 cs = rp[p]; const float a0 = lo16(x1[p]), a1 = hi16(x1[p]), b0 = lo16(x2[p]), b1 = hi16(x2[p]);
            o1[2 * p] = (a0 * cs[0] - b0 * cs[1]) * sc; o2[2 * p] = (b0 * cs[0] + a0 * cs[1]) * sc;
            o1[2 * p + 1] = (a1 * cs[2] - b1 * cs[3]) * sc; o2[2 * p + 1] = (b1 * cs[2] + a1 * cs[3]) * sc; }
        if (!TRANS) { v4u w1, w2;
#pragma unroll
            for (int p = 0; p < 4; ++p) { w1[p] = pk2(o1[2 * p], o1[2 * p + 1]); w2[p] = pk2(o2[2 * p], o2[2 * p + 1]); }
            *(LAS v4u*)(dst + j * LDP + 8 * d8) = w1; *(LAS v4u*)(dst + j * LDP + 64 + 8 * d8) = w2; }
        else {
#pragma unroll
            for (int i = 0; i < 8; ++i) { dst[(8 * d8 + i) * LDP + j] = f2bf(o1[i]); dst[(64 + 8 * d8 + i) * LDP + j] = f2bf(o2[i]); } }
    }
}
__device__ __forceinline__ void stage_T(LAS bf16* dst, const bf16* zb, int tid) {
#pragma unroll
    for (int it = 0; it < 4; ++it) { const int idx = tid + 512 * it, j = idx >> 4, c8 = idx & 15;
        const v4u x = *(const v4u*)(zb + (size_t)j * NIN + 8 * c8);
#pragma unroll
        for (int p = 0; p < 4; ++p) { dst[(8 * c8 + 2 * p) * LDP + j] = (bf16)(x[p] & 0xffffu); dst[(8 * c8 + 2 * p + 1) * LDP + j] = (bf16)(x[p] >> 16); } }
}


struct RopeX { v4u x1[2], x2[2]; };
struct RopeCS { f32x4 cs[2][4]; };
struct TileX { v4u x[4]; };
__device__ __forceinline__ void rope_load(RopeX& r, const bf16* zb, int tid) {
#pragma unroll
    for (int it = 0; it < 2; ++it) { const int idx = tid + 512 * it, j = idx >> 3, d8 = idx & 7; r.x1[it] = *(const v4u*)(zb + (size_t)j * NIN + 8 * d8); r.x2[it] = *(const v4u*)(zb + (size_t)j * NIN + 64 + 8 * d8); }
}
__device__ __forceinline__ void rope_cs_load(RopeCS& c, const float* rope, int tid) {
#pragma unroll
    for (int it = 0; it < 2; ++it) { const int idx = tid + 512 * it, j = idx >> 3, d8 = idx & 7; const f32x4* rp = (const f32x4*)(rope + (size_t)(j * 64 + 8 * d8) * 2);
#pragma unroll
        for (int p = 0; p < 4; ++p) c.cs[it][p] = rp[p]; }
}
template <bool TRANS, bool DEC>
__device__ __forceinline__ void rope_commit(LAS bf16* dst, const RopeX& r, const RopeCS& c, float scale, float l2g, int tid) {
#pragma unroll
    for (int it = 0; it < 2; ++it) { const int idx = tid + 512 * it, j = idx >> 3, d8 = idx & 7;
        float sc = scale; if (DEC) sc *= __builtin_amdgcn_exp2f(l2g * (float)(127 - j));
        float o1[8], o2[8];
#pragma unroll
        for (int p = 0; p < 4; ++p) { const f32x4 cs = c.cs[it][p]; const float a0 = lo16(r.x1[it][p]), a1 = hi16(r.x1[it][p]), b0 = lo16(r.x2[it][p]), b1 = hi16(r.x2[it][p]);
            o1[2 * p] = (a0 * cs[0] - b0 * cs[1]) * sc; o2[2 * p] = (b0 * cs[0] + a0 * cs[1]) * sc;
            o1[2 * p + 1] = (a1 * cs[2] - b1 * cs[3]) * sc; o2[2 * p + 1] = (b1 * cs[2] + a1 * cs[3]) * sc; }
        if (!TRANS) { v4u w1, w2;
#pragma unroll
            for (int p = 0; p < 4; ++p) { w1[p] = pk2(o1[2 * p], o1[2 * p + 1]); w2[p] = pk2(o2[2 * p], o2[2 * p + 1]); }
            *(LAS v4u*)(dst + j * LDP + 8 * d8) = w1; *(LAS v4u*)(dst + j * LDP + 64 + 8 * d8) = w2; }
        else {
#pragma unroll
            for (int i = 0; i < 8; ++i) { dst[(8 * d8 + i) * LDP + j] = f2bf(o1[i]); dst[(64 + 8 * d8 + i) * LDP + j] = f2bf(o2[i]); } }
    }
}
__device__ __forceinline__ void tile_load(TileX& t, const bf16* zb, int tid) {
#pragma unroll
    for (int it = 0; it < 4; ++it) { const int idx = tid + 512 * it, j = idx >> 4, c8 = idx & 15; t.x[it] = *(const v4u*)(zb + (size_t)j * NIN + 8 * c8); }
}
__device__ __forceinline__ void tile_commit_T(LAS bf16* dst, const TileX& t, int tid) {
#pragma unroll
    for (int it = 0; it < 4; ++it) { const int idx = tid + 512 * it, j = idx >> 4, c8 = idx & 15;
#pragma unroll
        for (int p = 0; p < 4; ++p) { dst[(8 * c8 + 2 * p) * LDP + j] = (bf16)(t.x[it][p] & 0xffffu); dst[(8 * c8 + 2 * p + 1) * LDP + j] = (bf16)(t.x[it][p] >> 16); } }
}

__global__ void __launch_bounds__(512, 2) mk_fwd(Params a) {
    extern __shared__ __attribute__((aligned(16))) unsigned char lds_raw[];
    LAS unsigned char* lds = (LAS unsigned char*)lds_raw;
    const int tid = threadIdx.x, lane = tid & 63, wave = __builtin_amdgcn_readfirstlane(tid >> 6), fr = lane & 15, fq = lane >> 4;
    const int G = gridDim.x, blk = blockIdx.x;
    const int gw = blk * 8 + wave, NGW = G * 8;
    const int gt = blk * 512 + tid, NGT = G * 512;
    unsigned char* ws = a.ws;
    const float* x_p = a.in[0]; const float* x_s = a.in[1]; const float* p_p = a.in[2]; const float* p_s = a.in[3];
    const float* state_ret = a.in[4]; const float* state_conv = a.in[5];
    const float* gm_ln_g = a.in[8]; const float* gm_ln_b = a.in[9]; const float* gm_ws = a.in[10]; const float* gm_bs = a.in[11];
    const float* conv_w = a.in[15]; const float* conv_b = a.in[16]; const float* g_final = a.in[21];
    float* out = a.out;
    float* SS1 = (float*)(ws + WS_SS1); float* SS2 = (float*)(ws + WS_SS2); float* SS3 = (float*)(ws + WS_SS3); float* STATS = (float*)(ws + WS_STATS);
    float* ROPE = (float*)(ws + WS_ROPE); float* ROPES = (float*)(ws + WS_ROPES);
    bf16* Win_t = (bf16*)(ws + WS_WIN); bf16* Wo_t = (bf16*)(ws + WS_WO); bf16* Wup_t = (bf16*)(ws + WS_WUP); bf16* Wdn_t = (bf16*)(ws + WS_WDN); bf16* Wg_t = (bf16*)(ws + WS_WG); bf16* Wp_t = (bf16*)(ws + WS_WP);
    bf16* AB = (bf16*)(ws + WS_AB); bf16* PB = (bf16*)(ws + WS_PB); bf16* MIX = (bf16*)(ws + WS_MIX); bf16* Z = (bf16*)(ws + WS_Z); bf16* ACT = (bf16*)(ws + WS_ACT);
    float* KV = (float*)(ws + WS_KV); bf16* PP = (bf16*)(ws + WS_PP); float* RAW = (float*)(ws + WS_RAW); float* AS = (float*)(ws + WS_AS);

    volatile LAS unsigned* MISC = (volatile LAS unsigned*)(lds + MISC_OFF);
    if (tid < 64) MISC[tid] = 0u;
    __syncthreads();
    XcdBarrier bar; bar.bar = (unsigned*)(ws + WS_BAR); bar.x = 0; bar.st = nullptr;
    if (MK_N_LAUNCHES == 1) bar = xcd_barrier_post((unsigned*)(ws + WS_BAR), MISC + 8);
    const int lo = a.ph_lo, hi = a.ph_hi;
#ifndef PHMASK
#define PHMASK 0xffff
#endif
#define IN(k) (((PHMASK >> (k)) & 1) && lo <= (k) && (k) < hi)
#define SEAM(k) do { if (IN(k) && IN((k) + 1)) { if (a.use_cg) cg::this_grid().sync(); else xcd_barrier(bar); } } while (0)

    if (IN(0)) {
        LAS float* scr = (LAS float*)(lds + wave * 16640);
        constexpr int I_IN = (D / 64) * (NIN / 64), I_O = (D / 64) * (D / 64), I_UP = (D / 64) * (NUP / 64), I_DN = (DFF / 64) * (D / 64), I_G = I_O, I_P = (PLE / 64) * (D / 64);
        constexpr int NITEMS = I_IN + I_O + I_UP + I_DN + I_G + I_P;
        for (int it = gw; it < NITEMS; it += NGW) {
            int r = it;
            if (r < I_UP) { transpose_item(a.in[14], D, NUP, a.in[13], Wup_t, true, scr, r, lane); continue; } r -= I_UP;
            if (r < I_IN) { transpose_item(a.in[7], D, NIN, a.in[6], Win_t, false, scr, r, lane); continue; } r -= I_IN;
            if (r < I_DN) { transpose_item(a.in[17], DFF, D, nullptr, Wdn_t, false, scr, r, lane); continue; } r -= I_DN;
            if (r < I_O) { transpose_item(a.in[12], D, D, nullptr, Wo_t, false, scr, r, lane); continue; } r -= I_O;
            if (r < I_G) { transpose_item(a.in[19], D, D, a.in[18], Wg_t, false, scr, r, lane); continue; } r -= I_G;
            transpose_item(a.in[20], PLE, D, nullptr, Wp_t, false, scr, r, lane);
        }
        for (int m = gw; m < MT; m += NGW) rms_row_to_bf16(m < MP ? x_p + (size_t)m * D : x_s + (size_t)(m - MP) * D, AB + (size_t)m * D, lane);
        for (int i = gt; i < MT * PLE / 4; i += NGT) { const f32x4 v = i < MP * PLE / 4 ? ((const f32x4*)p_p)[i] : ((const f32x4*)p_s)[i - MP * PLE / 4]; v2u w; w.x = pk2(v[0], v[1]); w.y = pk2(v[2], v[3]); ((v2u*)PB)[i] = w; }
        for (int i = gt; i < SEQ * 64 + 64; i += NGT) { const int pos = i < SEQ * 64 ? (i >> 6) : 16384, fi = i & 63;
            const float ang = (float)pos * a.invf[fi]; double t = (double)ang * 0.15915494309189535; t -= __builtin_rint(t); const float rev = (float)t;
            float* dst = i < SEQ * 64 ? ROPE + 2 * (size_t)i : ROPES + 2 * fi; dst[0] = __builtin_amdgcn_cosf(rev); dst[1] = __builtin_amdgcn_sinf(rev); }
        for (int i = gt; i < MT; i += NGT) { SS1[i] = 0.f; SS2[i] = 0.f; SS3[i] = 0.f; }
    }
    SEAM(0);

    if (IN(1)) {
        { pg8::Gemm g{AB, Win_t, MP, NIN, D}; pg8::StaticOrder S; S.init(MP, NIN, G, blk); EpiZ E{Z};
          pg8::gemm_phase<EpiZ, pg8::StaticOrder, true, true>(lds, g, S, E); }
        auto f = [&](int s, int n, float v) { const float o = n < 3072 ? v : (n < 4096 ? silu_(v) : gelu_(v)); Z[(size_t)(MP + s) * NIN + n] = f2bf(o); };
        skinny_gemm<2>(lds, AB + (size_t)MP * D, Win_t, NIN, D, blk, G, f);
    }
    SEAM(1);

    if (IN(2)) {
        { LAS float* qs = (LAS float*)lds; LAS float* ks = qs + 128; LAS float* vs = ks + 128; LAS float* red = vs + 128;
          const int e4 = tid & 31, dg = tid >> 5;
          for (int u = blk; u < MS * NH; u += G) { const int s = u >> 3, h = u & 7; const bf16* zr = Z + (size_t)(MP + s) * NIN;
            const float* S0 = state_ret + (size_t)u * 16384 + 4 * e4; float* S1 = out + O_RETS + (size_t)u * 16384 + 4 * e4;
            f32x4 s0[8];
#pragma unroll
            for (int i = 0; i < 8; ++i) s0[i] = __builtin_nontemporal_load((const f32x4*)(S0 + (dg + 16 * i) * 128));
            if (tid < 64) { const float c = ROPES[2 * tid], sn = ROPES[2 * tid + 1];
                const float q1 = bf2f(zr[128 * h + tid]), q2 = bf2f(zr[128 * h + 64 + tid]), k1 = bf2f(zr[1024 + 128 * h + tid]), k2 = bf2f(zr[1024 + 128 * h + 64 + tid]);
                qs[tid] = q1 * c - q2 * sn; qs[tid + 64] = q2 * c + q1 * sn; ks[tid] = (k1 * c - k2 * sn) * 0.08838834764831845f; ks[tid + 64] = (k2 * c + k1 * sn) * 0.08838834764831845f; }
            else if (tid < 192) vs[tid - 64] = bf2f(zr[2048 + 128 * h + tid - 64]);
            unsigned gg = 0u; if (tid < 64) gg = *(const unsigned*)(zr + 3072 + 128 * h + 2 * tid);
            __syncthreads();
            const float gamma = 1.0f - __builtin_amdgcn_exp2f((float)(-5 - h));
            const f32x4 vv = *(const LAS f32x4*)(vs + 4 * e4); f32x4 o = {0.f, 0.f, 0.f, 0.f};
#pragma unroll
            for (int i = 0; i < 8; ++i) { const int d = dg + 16 * i; const f32x4 sn = s0[i] * gamma + vv * ks[d]; __builtin_nontemporal_store(sn, (f32x4*)(S1 + d * 128)); o += sn * qs[d]; }
            *(LAS f32x4*)(red + dg * 128 + 4 * e4) = o;
            __syncthreads();
            if (tid < 64) { float o0 = 0.f, o1 = 0.f;
#pragma unroll
                for (int i = 0; i < 16; ++i) { o0 += red[i * 128 + 2 * tid]; o1 += red[i * 128 + 2 * tid + 1]; }
                const float r = __builtin_amdgcn_rsqf(wave_sum(o0 * o0 + o1 * o1) * (1.0f / 128.0f) + EPS);
                *(unsigned*)(MIX + (size_t)(MP + s) * D + 128 * h + 2 * tid) = pk2(o0 * r * lo16(gg), o1 * r * hi16(gg)); }
            __syncthreads(); } }
        { LAS bf16* Kt = (LAS bf16*)lds; LAS bf16* Vt = (LAS bf16*)(lds + TILE_B);
          for (int u = blk; u < 512; u += G) { const int b = u >> 7, h = (u >> 4) & 7, c = u & 15; const size_t R0 = (size_t)b * SEQ + 128 * c;
            RopeX kx; RopeCS cs; TileX vx;
            rope_load(kx, Z + R0 * NIN + 1024 + 128 * h, tid); rope_cs_load(cs, ROPE + (size_t)(128 * c) * 128, tid); tile_load(vx, Z + R0 * NIN + 2048 + 128 * h, tid);
            rope_commit<true, true>(Kt, kx, cs, 0.08838834764831845f, a.log2g[h], tid);
            tile_commit_T(Vt, vx, tid);
            __syncthreads();
            f32x4 acc[8];
#pragma unroll
            for (int ct = 0; ct < 8; ++ct) acc[ct] = (f32x4){0.f, 0.f, 0.f, 0.f};
            mm128(acc, Kt, Vt, wave, fr, fq);
            float* kv = KV + (size_t)u * 16384 + (16 * wave + fr) * 128 + 4 * fq;
#pragma unroll
            for (int ct = 0; ct < 8; ++ct) *(f32x4*)(kv + 16 * ct) = acc[ct];
            __syncthreads(); } }
        for (int r0 = gw; r0 < MP; r0 += 2 * NGW) { const int r1 = r0 + NGW;
            const bf16* p0 = Z + (size_t)r0 * NIN + 5120 + 16 * lane; const bf16* p1 = Z + (size_t)(r1 < MP ? r1 : r0) * NIN + 5120 + 16 * lane;
            const v4u xa0 = *(const v4u*)p0, xa1 = *(const v4u*)(p0 + 8), xb0 = *(const v4u*)p1, xb1 = *(const v4u*)(p1 + 8);
            float va[16], vb[16];
#pragma unroll
            for (int j = 0; j < 4; ++j) { va[2 * j] = lo16(xa0[j]); va[2 * j + 1] = hi16(xa0[j]); va[8 + 2 * j] = lo16(xa1[j]); va[8 + 2 * j + 1] = hi16(xa1[j]);
                                          vb[2 * j] = lo16(xb0[j]); vb[2 * j + 1] = hi16(xb0[j]); vb[8 + 2 * j] = lo16(xb1[j]); vb[8 + 2 * j + 1] = hi16(xb1[j]); }
            float sa = 0.f, sb = 0.f;
#pragma unroll
            for (int j = 0; j < 16; ++j) { sa += va[j]; sb += vb[j]; }
            const float ma = wave_sum(sa) * (1.0f / 1024.0f), mb = wave_sum(sb) * (1.0f / 1024.0f); float qa = 0.f, qb = 0.f;
#pragma unroll
            for (int j = 0; j < 16; ++j) { const float da = va[j] - ma, db = vb[j] - mb; qa += da * da; qb += db * db; }
            const float ra = __builtin_amdgcn_rsqf(wave_sum(qa) * (1.0f / 1024.0f) + EPS), rb = __builtin_amdgcn_rsqf(wave_sum(qb) * (1.0f / 1024.0f) + EPS);
            if (lane == 0) { STATS[2 * r0] = ma; STATS[2 * r0 + 1] = ra; if (r1 < MP) { STATS[2 * r1] = mb; STATS[2 * r1 + 1] = rb; } } }
        for (int row = MP + gw; row < MT; row += NGW) { const bf16* p = Z + (size_t)row * NIN + 5120 + 16 * lane; const v4u x0 = *(const v4u*)p, x1 = *(const v4u*)(p + 8);
            const int s_ = row - MP, c0 = 16 * lane, grp = lane >> 3; const float w00 = gm_ws[grp * 16384], b0 = gm_bs[grp * 128];
            const bf16* up = Z + (size_t)row * NIN + 4096 + c0; const v4u u0 = *(const v4u*)up, u1 = *(const v4u*)(up + 8);
            float v[16];
#pragma unroll
            for (int j = 0; j < 4; ++j) { v[2 * j] = lo16(x0[j]); v[2 * j + 1] = hi16(x0[j]); v[8 + 2 * j] = lo16(x1[j]); v[8 + 2 * j + 1] = hi16(x1[j]); }
            float s = 0.f;
#pragma unroll
            for (int j = 0; j < 16; ++j) s += v[j];
            const float mean = wave_sum(s) * (1.0f / 1024.0f); float q = 0.f;
#pragma unroll
            for (int j = 0; j < 16; ++j) { v[j] -= mean; q += v[j] * v[j]; }
            const float rstd = __builtin_amdgcn_rsqf(wave_sum(q) * (1.0f / 1024.0f) + EPS);
            float uu[16];
#pragma unroll
            for (int j = 0; j < 4; ++j) { uu[2 * j] = lo16(u0[j]); uu[2 * j + 1] = hi16(u0[j]); uu[8 + 2 * j] = lo16(u1[j]); uu[8 + 2 * j + 1] = hi16(u1[j]); }
            float vn[16], mo[16];
#pragma unroll
            for (int j = 0; j < 16; ++j) { vn[j] = v[j] * rstd * gm_ln_g[c0 + j] + gm_ln_b[c0 + j]; mo[j] = uu[j] * (w00 * vn[j] + b0); }
            float* gv = out + O_GMV + (size_t)s_ * 1024 + c0;
#pragma unroll
            for (int j = 0; j < 4; ++j) *(f32x4*)(gv + 4 * j) = (f32x4){vn[4 * j], vn[4 * j + 1], vn[4 * j + 2], vn[4 * j + 3]};
            v4u w0, w1;
#pragma unroll
            for (int j = 0; j < 4; ++j) { w0[j] = pk2(mo[2 * j], mo[2 * j + 1]); w1[j] = pk2(mo[8 + 2 * j], mo[8 + 2 * j + 1]); }
            bf16* mp = MIX + (size_t)row * D + 1024 + c0; *(v4u*)mp = w0; *(v4u*)(mp + 8) = w1; }
    }
    SEAM(2);

    if (IN(3)) {
        LAS bf16* T0 = (LAS bf16*)lds; LAS bf16* T1 = (LAS bf16*)(lds + TILE_B); LAS bf16* T2 = (LAS bf16*)(lds + 2 * TILE_B); LAS bf16* T3 = (LAS bf16*)(lds + 3 * TILE_B);
        for (int u = blk; u < 512; u += G) { const int bh = u >> 4, b = bh >> 3, h = bh & 7, c = u < 256 ? (u & 15) : 15 - (u & 15); const size_t R0 = (size_t)b * SEQ + 128 * c; const float l2g = a.log2g[h];
            const int i_ = 16 * wave + fr;
            RopeX qx, kx; RopeCS cs; TileX vx; v2u gg[8];
            const float* kvb = KV + (size_t)bh * 16 * 16384;
            f32x4 tc[8];
#pragma unroll
            for (int i = 0; i < 8; ++i) tc[i] = *(const f32x4*)(kvb + 4 * (tid + 512 * i));
            rope_load(qx, Z + R0 * NIN + 128 * h, tid); rope_load(kx, Z + R0 * NIN + 1024 + 128 * h, tid); rope_cs_load(cs, ROPE + (size_t)(128 * c) * 128, tid); tile_load(vx, Z + R0 * NIN + 2048 + 128 * h, tid);
            rope_commit<false, false>(T0, qx, cs, 1.0f, 0.f, tid);
            rope_commit<false, false>(T1, kx, cs, 0.08838834764831845f, 0.f, tid);
            asm volatile("" ::: "memory");
            { const float Gc = __builtin_amdgcn_exp2f(l2g * 128.0f);
              f32x4 sp[8];
#pragma unroll
              for (int i = 0; i < 8; ++i) sp[i] = (f32x4){0.f, 0.f, 0.f, 0.f};
              for (int j = 0; j < c; ++j) { f32x4 tn[8];
#pragma unroll
                  for (int i = 0; i < 8; ++i) tn[i] = *(const f32x4*)(kvb + (size_t)(j + 1) * 16384 + 4 * (tid + 512 * i));
#pragma unroll
                  for (int i = 0; i < 8; ++i) { sp[i] = sp[i] * Gc + tc[i]; tc[i] = tn[i]; } }
              if (c == 15) {
#pragma unroll
                  for (int i = 0; i < 8; ++i) *(f32x4*)(out + O_RETP + (size_t)bh * 16384 + 4 * (tid + 512 * i)) = sp[i] * Gc + tc[i]; }
#pragma unroll
              for (int i = 0; i < 8; ++i) { const int ch = tid + 512 * i, d = ch >> 5, e4 = ch & 31;
#pragma unroll
                  for (int t = 0; t < 4; ++t) T3[(4 * e4 + t) * LDP + d] = f2bf(sp[i][t]); } }
            tile_commit_T(T2, vx, tid);
            __syncthreads();
            { const bf16* gp = Z + (R0 + i_) * NIN + 3072 + 128 * h + 4 * fq;
#pragma unroll
              for (int ct = 0; ct < 8; ++ct) gg[ct] = *(const v2u*)(gp + 16 * ct); }
            f32x4 acc2[8], acc1[8];
#pragma unroll
            for (int ct = 0; ct < 8; ++ct) { acc2[ct] = (f32x4){0.f, 0.f, 0.f, 0.f}; acc1[ct] = (f32x4){0.f, 0.f, 0.f, 0.f}; }
            mm128(acc2, T0, T3, wave, fr, fq);
            mm128(acc1, T0, T1, wave, fr, fq);
            __syncthreads();
#pragma unroll
            for (int ct = 0; ct < 8; ++ct) { float sv[4];
#pragma unroll
                for (int t = 0; t < 4; ++t) { const int j = 16 * ct + 4 * fq + t; sv[t] = i_ >= j ? acc1[ct][t] * __builtin_amdgcn_exp2f(l2g * (float)(i_ - j)) : 0.f; }
                v2u w; w.x = pk2(sv[0], sv[1]); w.y = pk2(sv[2], sv[3]); *(LAS v2u*)(T1 + i_ * LDP + 16 * ct + 4 * fq) = w; }
            __syncthreads();
#pragma unroll
            for (int ct = 0; ct < 8; ++ct) acc1[ct] = (f32x4){0.f, 0.f, 0.f, 0.f};
            mm128(acc1, T1, T2, wave, fr, fq);
            const float qd = __builtin_amdgcn_exp2f(l2g * (float)(i_ + 1)); float ssq = 0.f;
#pragma unroll
            for (int ct = 0; ct < 8; ++ct) { acc1[ct] = acc1[ct] + acc2[ct] * qd; ssq += (acc1[ct][0] * acc1[ct][0] + acc1[ct][1] * acc1[ct][1]) + (acc1[ct][2] * acc1[ct][2] + acc1[ct][3] * acc1[ct][3]); }
            ssq += __shfl_xor(ssq, 16); ssq += __shfl_xor(ssq, 32);
            const float rn = __builtin_amdgcn_rsqf(ssq * (1.0f / 128.0f) + EPS);
            bf16* mp = MIX + (R0 + i_) * D + 128 * h + 4 * fq;
#pragma unroll
            for (int ct = 0; ct < 8; ++ct) { v2u w;
                w.x = pk2(acc1[ct][0] * rn * lo16(gg[ct].x), acc1[ct][1] * rn * hi16(gg[ct].x)); w.y = pk2(acc1[ct][2] * rn * lo16(gg[ct].y), acc1[ct][3] * rn * hi16(gg[ct].y)); *(v2u*)(mp + 16 * ct) = w; }
            __syncthreads(); }
        for (int u = blk; u < 512; u += G) { const int b = u >> 7, c = (u >> 3) & 15, grp = u & 7; const size_t R0 = (size_t)b * SEQ + 128 * c;
            const int t_ = 16 * wave + fr, d8 = tid & 15;
            f32x4 wl[4][2]; v4u xv[4]; float st[4][2]; v2u uu[8]; float lg[8], lb[8];
#pragma unroll
            for (int it = 0; it < 4; ++it) { const int idx = tid + 512 * it, t = idx >> 4; const float* wp = gm_ws + (size_t)grp * 16384 + t * 128 + 8 * d8;
                wl[it][0] = *(const f32x4*)wp; wl[it][1] = *(const f32x4*)(wp + 4);
                xv[it] = *(const v4u*)(Z + (R0 + t) * NIN + 5120 + 128 * grp + 8 * d8); st[it][0] = STATS[2 * (R0 + t)]; st[it][1] = STATS[2 * (R0 + t) + 1]; }
#pragma unroll
            for (int j = 0; j < 8; ++j) { lg[j] = gm_ln_g[128 * grp + 8 * d8 + j]; lb[j] = gm_ln_b[128 * grp + 8 * d8 + j]; }
            const float bsv = gm_bs[grp * 128 + t_];
#pragma unroll
            for (int it = 0; it < 4; ++it) { const int idx = tid + 512 * it, t = idx >> 4;
                float wv[8] = {wl[it][0][0], wl[it][0][1], wl[it][0][2], wl[it][0][3], wl[it][1][0], wl[it][1][1], wl[it][1][2], wl[it][1][3]};
#pragma unroll
                for (int j = 0; j < 8; ++j) if (8 * d8 + j > t) wv[j] = 0.f;
                v4u w; w.x = pk2(wv[0], wv[1]); w.y = pk2(wv[2], wv[3]); w.z = pk2(wv[4], wv[5]); w.w = pk2(wv[6], wv[7]); *(LAS v4u*)(T0 + t * LDP + 8 * d8) = w;
                const float mean = st[it][0], rstd = st[it][1];
#pragma unroll
                for (int p = 0; p < 4; ++p) { T1[(8 * d8 + 2 * p) * LDP + t] = f2bf((lo16(xv[it][p]) - mean) * rstd * lg[2 * p] + lb[2 * p]); T1[(8 * d8 + 2 * p + 1) * LDP + t] = f2bf((hi16(xv[it][p]) - mean) * rstd * lg[2 * p + 1] + lb[2 * p + 1]); } }
            __syncthreads();
            { const bf16* up = Z + (R0 + t_) * NIN + 4096 + 128 * grp + 4 * fq;
#pragma unroll
              for (int ct = 0; ct < 8; ++ct) uu[ct] = *(const v2u*)(up + 16 * ct); }
            f32x4 acc[8];
#pragma unroll
            for (int ct = 0; ct < 8; ++ct) acc[ct] = (f32x4){0.f, 0.f, 0.f, 0.f};
            mm128(acc, T0, T1, wave, fr, fq);
            bf16* mp = MIX + (R0 + t_) * D + 1024 + 128 * grp + 4 * fq;
#pragma unroll
            for (int ct = 0; ct < 8; ++ct) { v2u w;
                w.x = pk2((acc[ct][0] + bsv) * lo16(uu[ct].x), (acc[ct][1] + bsv) * hi16(uu[ct].x)); w.y = pk2((acc[ct][2] + bsv) * lo16(uu[ct].y), (acc[ct][3] + bsv) * hi16(uu[ct].y)); *(v2u*)(mp + 16 * ct) = w; }
            __syncthreads(); }
    }
    SEAM(3);

    if (IN(4)) {
        { pg8::Gemm g{MIX, Wo_t, MP, D, D}; pg8::StaticOrder S; S.init(MP, D, G, blk); EpiRes E{x_p, out, AB, SS1};
          pg8::gemm_phase<EpiRes, pg8::StaticOrder, true, true>(lds, g, S, E); }
        auto f = [&](int s, int n, float v) { const float o = x_s[(size_t)s * D + n] + v; out[(size_t)(MP + s) * D + n] = o; AB[(size_t)(MP + s) * D + n] = f2bf(o);
            const float q = half_wave_sum(o * o); if ((lane & 31) == 0) atomic_addf(SS1 + MP + s, q); };
        skinny_gemm<2>(lds, MIX + (size_t)MP * D, Wo_t, D, D, blk, G, f);
    }
    SEAM(4);

    if (IN(5)) {
        { pg8::Gemm g{AB, Wup_t, MP, NUP, D}; pg8::StaticOrder S; S.init(MP, NUP, G, blk); EpiUp E{ACT, RAW, SS1, conv_w, conv_b};
          pg8::gemm_phase<EpiUp, pg8::StaticOrder, true, true>(lds, g, S, E); }
        auto f = [&](int s, int n, float v) { const int within = n & 255, col = (within >> 7) * DFF + 128 * (n >> 8) + (within & 127);
            AS[(size_t)s * NUP + col] = v * __builtin_amdgcn_rsqf(SS1[MP + s] * (1.0f / D) + EPS); };
        if (blk >= 128) skinny_gemm<8>(lds, AB + (size_t)MP * D, Wup_t, NUP, D, blk - 128, 128, f);
    }
    SEAM(5);

    if (IN(6)) {
        for (int i = gt; i < 128 * 2 * (DFF / 4); i += NGT) { const int c4 = i % (DFF / 4), gr = i / (DFF / 4), rr = gr & 1, Gp = gr >> 1, c = 4 * c4; const bool first = (Gp & 31) == 0;
            const float* rg = RAW + (size_t)Gp * 4 * NUP; const float* rp = rg - 4 * NUP; const f32x4 z4 = {0.f, 0.f, 0.f, 0.f};
            f32x4 a0g, a0u, a1g, a1u, a2g, a2u;
            a0g = *(const f32x4*)(rg + (2 + rr) * NUP + c); a0u = *(const f32x4*)(rg + (2 + rr) * NUP + DFF + c);
            if (rr) { a1g = *(const f32x4*)(rg + 2 * NUP + c); a1u = *(const f32x4*)(rg + 2 * NUP + DFF + c); a2g = first ? z4 : *(const f32x4*)(rp + NUP + c); a2u = first ? z4 : *(const f32x4*)(rp + NUP + DFF + c); }
            else { a1g = first ? z4 : *(const f32x4*)(rp + NUP + c); a1u = first ? z4 : *(const f32x4*)(rp + NUP + DFF + c); a2g = first ? z4 : *(const f32x4*)(rp + c); a2u = first ? z4 : *(const f32x4*)(rp + DFF + c); }
            const f32x4 ag = *(const f32x4*)(conv_w + c) * a2g + *(const f32x4*)(conv_w + NUP + c) * a1g + *(const f32x4*)(conv_w + 2 * NUP + c) * a0g + *(const f32x4*)(conv_b + c);
            const f32x4 au = *(const f32x4*)(conv_w + DFF + c) * a2u + *(const f32x4*)(conv_w + NUP + DFF + c) * a1u + *(const f32x4*)(conv_w + 2 * NUP + DFF + c) * a0u + *(const f32x4*)(conv_b + DFF + c);
            v2u w; w.x = pk2(silu_(ag[0]) * au[0], silu_(ag[1]) * au[1]); w.y = pk2(silu_(ag[2]) * au[2], silu_(ag[3]) * au[3]);
            *(v2u*)(ACT + (size_t)(64 * Gp + rr) * DFF + c) = w; }
        for (int i = gt; i < MS * (DFF / 4); i += NGT) { const int c4 = i % (DFF / 4), s = i / (DFF / 4), c = 4 * c4;
            const float* sc0 = state_conv + (size_t)s * 2 * NUP; const float* sc1 = sc0 + NUP; const float* as = AS + (size_t)s * NUP;
            const f32x4 a0g = *(const f32x4*)(as + c), a0u = *(const f32x4*)(as + DFF + c), a1g = *(const f32x4*)(sc1 + c), a1u = *(const f32x4*)(sc1 + DFF + c), a2g = *(const f32x4*)(sc0 + c), a2u = *(const f32x4*)(sc0 + DFF + c);
            const f32x4 ag = *(const f32x4*)(conv_w + c) * a2g + *(const f32x4*)(conv_w + NUP + c) * a1g + *(const f32x4*)(conv_w + 2 * NUP + c) * a0g + *(const f32x4*)(conv_b + c);
            const f32x4 au = *(const f32x4*)(conv_w + DFF + c) * a2u + *(const f32x4*)(conv_w + NUP + DFF + c) * a1u + *(const f32x4*)(conv_w + 2 * NUP + DFF + c) * a0u + *(const f32x4*)(conv_b + DFF + c);
            v2u w; w.x = pk2(silu_(ag[0]) * au[0], silu_(ag[1]) * au[1]); w.y = pk2(silu_(ag[2]) * au[2], silu_(ag[3]) * au[3]);
            *(v2u*)(ACT + (size_t)(MP + s) * DFF + c) = w;
            float* cs = out + O_CONVS + (size_t)s * 2 * NUP; *(f32x4*)(cs + c) = a1g; *(f32x4*)(cs + DFF + c) = a1u; *(f32x4*)(cs + NUP + c) = a0g; *(f32x4*)(cs + NUP + DFF + c) = a0u; }
        for (int i = gt; i < 4 * 2 * (NUP / 4); i += NGT) { const int c4 = i % (NUP / 4), bk = i / (NUP / 4), b = bk >> 1, k = bk & 1;
            *(f32x4*)(out + O_CONVP + (size_t)bk * NUP + 4 * c4) = *(const f32x4*)(RAW + ((size_t)(32 * b + 31) * 4 + k) * NUP + 4 * c4); }
    }
    SEAM(6);

    if (IN(7)) {
        { pg8::Gemm g{ACT, Wdn_t, MP, D, DFF}; pg8::StaticOrder S; S.init(MP, D, G, blk); EpiRes E{out, out, AB, SS2};
          pg8::gemm_phase<EpiRes, pg8::StaticOrder, true, true>(lds, g, S, E); }
        auto f = [&](int s, int n, float v) { const size_t o_ = (size_t)(MP + s) * D + n; const float o = out[o_] + v; out[o_] = o; AB[o_] = f2bf(o);
            const float q = half_wave_sum(o * o); if ((lane & 31) == 0) atomic_addf(SS2 + MP + s, q); };
        skinny_gemm<2>(lds, ACT + (size_t)MP * DFF, Wdn_t, D, DFF, blk, G, f);
    }
    SEAM(7);

    if (IN(8)) {
#ifndef T_A
        { int Kp = PLE; asm volatile("" : "+s"(Kp));
          pg8::Gemm g{PB, Wp_t, MP, D, Kp}; pg8::StaticOrder S; S.init(MP, D, G, blk); EpiPP E{PP};
          pg8::gemm_phase<EpiPP, pg8::StaticOrder, true, true>(lds, g, S, E); }
#endif
#ifndef T_B
        { pg8::Gemm g{AB, Wg_t, MP, D, D}; pg8::StaticOrder S; S.init(MP, D, G, blk); EpiGate E{PP, out, SS2, SS3};
          pg8::gemm_phase<EpiGate, pg8::StaticOrder, true, true>(lds, g, S, E); }
#endif
#ifndef T_C
        auto f1 = [&](int s, int n, float v) { PP[(size_t)(MP + s) * D + n] = f2bf(v); };
        skinny_gemm<2>(lds, PB + (size_t)MP * PLE, Wp_t, D, PLE, blk, G, f1);
#endif
#ifndef T_D
        auto f2 = [&](int s, int n, float v) { const size_t o_ = (size_t)(MP + s) * D + n; const float r2 = __builtin_amdgcn_rsqf(SS2[MP + s] * (1.0f / D) + EPS);
            const float o = out[o_] + bf2f(PP[o_]) * sigmoid_(r2 * v); out[o_] = o; const float q = half_wave_sum(o * o); if ((lane & 31) == 0) atomic_addf(SS3 + MP + s, q); };
        skinny_gemm<2>(lds, AB + (size_t)MP * D, Wg_t, D, D, blk, G, f2);
#endif
    }
    SEAM(8);

    if (IN(9)) {
        for (int m = gw; m < MT; m += NGW) { f32x4* hr = (f32x4*)(out + (size_t)m * D) + lane; const f32x4* gr = (const f32x4*)g_final + lane;
            const float r = __builtin_amdgcn_rsqf(SS3[m] * (1.0f / D) + EPS);
#pragma unroll
            for (int j = 0; j < 8; ++j) hr[64 * j] = hr[64 * j] * gr[64 * j] * r; }
    }
#undef IN
#undef SEAM
}

extern "C" void kernel_launch(void* const* d_in, const int* in_sizes, int n_in, void* d_out, int out_size, void* d_ws, size_t ws_size, hipStream_t stream) {
    static int grid = 0;
    if (grid == 0) {
        if (n_in != 22 || out_size != (int)O_END || ws_size < WS_END) { fprintf(stderr, "kernel_launch: unexpected shapes: n_in %d out %d ws %zu\n", n_in, out_size, ws_size); grid = -1; return; }
        int dev = 0, cus = 0, per_cu = 0;
        if (hipGetDevice(&dev) != hipSuccess || hipDeviceGetAttribute(&cus, hipDeviceAttributeMultiprocessorCount, dev) != hipSuccess) { grid = -1; return; }
        if (hipFuncSetAttribute((const void*)mk_fwd, hipFuncAttributeMaxDynamicSharedMemorySize, LDS_BYTES) != hipSuccess) { fprintf(stderr, "kernel_launch: hipFuncSetAttribute failed\n"); grid = -1; return; }
        if (hipOccupancyMaxActiveBlocksPerMultiprocessor(&per_cu, (const void*)mk_fwd, 512, LDS_BYTES) != hipSuccess || per_cu < 1) fprintf(stderr, "kernel_launch: occupancy query says %d\n", per_cu);
        (void)hipGetLastError();
        grid = cus;
        if (grid != 256) fprintf(stderr, "kernel_launch: %d CUs (built for 256)\n", grid);
    }
    if (grid < 0) return;
    if (hipMemsetAsync((char*)d_ws + WS_BAR, 0, BAR_BYTES, stream) != hipSuccess) { fprintf(stderr, "kernel_launch: memset failed\n"); return; }
    Params p{};
    for (int i = 0; i < 22; ++i) p.in[i] = (const float*)d_in[i];
    p.out = (float*)d_out; p.ws = (unsigned char*)d_ws;
    for (int h = 0; h < 8; ++h) p.log2g[h] = (float)std::log2(1.0 - std::exp2(-5.0 - (double)h));
    for (int i = 0; i < 64; ++i) p.invf[i] = powf(10000.0f, -(float)i / 64.0f);
    p.use_cg = 0; p.pad = 0;
#if MK_N_LAUNCHES == 1
    void* args[] = {&p};
#ifdef PROBE_K
    p.ph_lo = 0; p.ph_hi = PROBE_K + 1;
    (void)hipLaunchCooperativeKernel((const void*)mk_fwd, dim3(grid), dim3(512), args, LDS_BYTES, stream);
    if (hipMemsetAsync((char*)d_ws + WS_BAR, 0, BAR_BYTES, stream) != hipSuccess) return;
#endif
    p.ph_lo = 0; p.ph_hi = NPHASE;
    hipError_t e = hipLaunchCooperativeKernel((const void*)mk_fwd, dim3(grid), dim3(512), args, LDS_BYTES, stream);
    if (e != hipSuccess) fprintf(stderr, "kernel_launch: cooperative launch failed: %s\n", hipGetErrorString(e));
#else
    for (int ph = 0; ph < NPHASE; ++ph) { p.ph_lo = ph; p.ph_hi = ph + 1; hipLaunchKernelGGL(mk_fwd, dim3(grid), dim3(512), LDS_BYTES, stream, p); }
#endif
}
```

```cpp
#include <hip/hip_runtime.h>
#include <hip/hip_cooperative_groups.h>
#include <cstdio>
#include <cstdint>
#include <cmath>
namespace cg = cooperative_groups;

#ifndef MK_N_LAUNCHES
#define MK_N_LAUNCHES 1
#endif

namespace pg8 {
#define PG8_LAS __attribute__((address_space(3)))
typedef unsigned short bf16_t;
typedef short bf16x8 __attribute__((ext_vector_type(8)));
typedef float f32x4 __attribute__((ext_vector_type(4)));
typedef unsigned u32x4 __attribute__((ext_vector_type(4)));
constexpr int BM = 256, BK = 64, HALF = 128, HTB = HALF * BK * 2  , STAGE_BYTES = 8 * HTB, NXCD = 8, WGM = 8;

__host__ __device__ __forceinline__ int lds_byte(int r, int c) { const int st = (r >> 4) * 2 + (c >> 5), rr = r & 15, cc = c & 31, ob = rr * 64 + cc * 2; return st * 1024 + (ob ^ (((ob >> 9) & 1) << 5)); }
__host__ __device__ __forceinline__ void stage_rc(int b, int& R, int& C) { const int st = b / 1024, sb = b % 1024, swz = sb ^ (((sb >> 9) & 1) << 5); R = (st >> 1) * 16 + swz / 64; C = (st & 1) * 32 + (swz % 64) / 2; }
__host__ __device__ __forceinline__ int perm32(int rho) { const int n = rho >> 4, i = rho & 15; return 8 * (i >> 2) + 4 * n + (i & 3); }

struct Unit { int pm, pn; };
struct Gemm { const bf16_t* A; const bf16_t* Bt; int M, N, K; };

struct StaticOrder {
    int nM, nN, nwg, G, c;
    __host__ __device__ void init(int M, int N, int G_, int c_) { nM = M / BM; nN = N / BM; nwg = nM * nN; G = G_; c = c_; }
    __host__ __device__ bool next(int i, Unit& u) const {
        const long L = (long)i * G + c; if (L >= nwg) return false;
        int wgid = (int)L; { const int q = nwg / NXCD, r = nwg % NXCD, xcd = wgid % NXCD, off = wgid / NXCD; wgid = (xcd < r ? xcd * (q + 1) : r * (q + 1) + (xcd - r) * q) + off; }
        const int nig = WGM * nN, gid = wgid / nig, fm = gid * WGM, gsz = (nM - fm) < WGM ? (nM - fm) : WGM;
        u.pm = fm + ((wgid % nig) % gsz); u.pn = (wgid % nig) / gsz; return true;
    }
    __device__ __forceinline__ void a_ready(const Unit&) const {}
    __device__ __forceinline__ void done(const Unit&) const {}
};

__device__ __forceinline__ unsigned cvt_pk_bf16(float lo, float hi) { unsigned r; asm volatile("v_cvt_pk_bf16_f32 %0, %1, %2" : "=v"(r) : "v"(lo), "v"(hi)); return r; }
typedef float f32x2 __attribute__((ext_vector_type(2)));

template <class Epi, class Sched, bool ALIGN_EPI = false, bool SP2 = false>
__device__ __forceinline__ void gemm_phase(PG8_LAS unsigned char* lds, const Gemm g, const Sched& S, const Epi& E) {
    const int tid = threadIdx.x, wid = __builtin_amdgcn_readfirstlane(tid >> 6), lane = tid & 63, wr = wid >> 2, wc = wid & 3, fr = lane & 15, fq = lane >> 4;
    const int K = g.K, nt = K / BK;
    unsigned voffA[2], voffB[2];
#pragma unroll
    for (int i = 0; i < 2; ++i) { int R, C; stage_rc(tid * 16 + i * 8192, R, C); const int Rb = Epi::PERM ? ((R & ~31) + perm32(R & 31)) : R;
        voffA[i] = (unsigned)(R * K + C) * 2u; voffB[i] = (unsigned)(Rb * K + C) * 2u; }
    const size_t kstep = (size_t)(BK * 2);
    const size_t hstep = (size_t)HALF * K * 2;
    const size_t tstep = 2 * hstep;
    const unsigned ldsw = (unsigned)wid * 1024u;
    const int aoff = lds_byte(wr * 64 + fr, fq * 8), boff = lds_byte(wc * 32 + fr, fq * 8);
#define PG8_SA(b, h) (((b) * 2 + (h)) * HTB)
#define PG8_SB(b, h) ((4 + (b) * 2 + (h)) * HTB)
#define PG8_STAGE(bufoff, gbase, voff) do { _Pragma("unroll") for (int _i = 0; _i < 2; ++_i) \
        __builtin_amdgcn_global_load_lds((const unsigned*)((const char*)(gbase) + (voff)[_i]), (PG8_LAS unsigned*)(lds + (bufoff) + ldsw + _i * 8192), 16, 0, 0); } while (0)
#define PG8_LDA(dst, b, h) do { _Pragma("unroll") for (int m = 0; m < 4; ++m) _Pragma("unroll") for (int k = 0; k < 2; ++k) dst[m][k] = *(const PG8_LAS bf16x8*)(lds + PG8_SA(b, h) + aoff + m * 2048 + k * 1024); } while (0)
#define PG8_LDB(dst, b, h) do { _Pragma("unroll") for (int n = 0; n < 2; ++n) _Pragma("unroll") for (int k = 0; k < 2; ++k) dst[n][k] = *(const PG8_LAS bf16x8*)(lds + PG8_SB(b, h) + boff + n * 2048 + k * 1024); } while (0)
#define PG8_MMA(ai, bj, At, Bt) do { __builtin_amdgcn_s_setprio(1); _Pragma("unroll") for (int m = 0; m < 4; ++m) _Pragma("unroll") for (int n = 0; n < 2; ++n) _Pragma("unroll") for (int k = 0; k < 2; ++k) \
        acc[ai][bj][m][n] = __builtin_amdgcn_mfma_f32_16x16x32_bf16(Bt[n][k], At[m][k], acc[ai][bj][m][n], 0, 0, 0); __builtin_amdgcn_s_setprio(0); } while (0)
#define PG8_WAIT_V(n) asm volatile("s_waitcnt vmcnt(" #n ")" ::: "memory")
#define PG8_WAIT_L(n) asm volatile("s_waitcnt lgkmcnt(" #n ")" ::: "memory")
#define PG8_BAR __builtin_amdgcn_s_barrier()
#define PG8_SCHED __builtin_amdgcn_sched_barrier(0)
    Unit cur, nxt; int ui = 0;
    if (!S.next(0, cur)) return;
    f32x4 acc[2][2][4][2];
#pragma unroll
    for (int a = 0; a < 2; ++a)
#pragma unroll
        for (int b = 0; b < 2; ++b)
#pragma unroll
            for (int m = 0; m < 4; ++m)
#pragma unroll
                for (int n = 0; n < 2; ++n) acc[a][b][m][n] = (f32x4){0.f, 0.f, 0.f, 0.f};
    bf16x8 At[4][2], B0[2][2], B1[2][2];
    const char* cA = (const char*)g.A + (size_t)cur.pm * tstep; const char* cB = (const char*)g.Bt + (size_t)cur.pn * tstep;
    S.a_ready(cur);
    if constexpr (SP2) {
        PG8_STAGE(PG8_SB(0, 0), cB, voffB); PG8_STAGE(PG8_SB(0, 1), cB + hstep, voffB); PG8_STAGE(PG8_SA(0, 0), cA, voffA); PG8_STAGE(PG8_SA(0, 1), cA + hstep, voffA);
        if (wr == 1) PG8_BAR;
        PG8_WAIT_V(2); PG8_BAR;
        PG8_STAGE(PG8_SB(1, 0), cB + kstep, voffB); PG8_STAGE(PG8_SA(1, 0), cA + kstep, voffA); PG8_STAGE(PG8_SB(1, 1), cB + hstep + kstep, voffB);
        PG8_WAIT_V(6); PG8_BAR;
    } else {
        PG8_STAGE(PG8_SB(0, 0), cB, voffB); PG8_STAGE(PG8_SA(0, 0), cA, voffA); PG8_STAGE(PG8_SB(0, 1), cB + hstep, voffB); PG8_STAGE(PG8_SA(0, 1), cA + hstep, voffA);
        if (wr == 1) PG8_BAR;
        PG8_WAIT_V(4); PG8_BAR;
        PG8_STAGE(PG8_SB(1, 0), cB + kstep, voffB); PG8_STAGE(PG8_SA(1, 0), cA + kstep, voffA); PG8_STAGE(PG8_SB(1, 1), cB + hstep + kstep, voffB);
        PG8_WAIT_V(6); PG8_BAR;
    }
    for (;;) {
        const bool has_next = S.next(ui + 1, nxt);
        const char* nA = has_next ? (const char*)g.A + (size_t)nxt.pm * tstep : cA; const char* nB = has_next ? (const char*)g.Bt + (size_t)nxt.pn * tstep : cB;
        for (int t = 0; t < nt; t += 2) {
            const bool last = (t == nt - 2);
            const char* a1 = cA + (size_t)(t + 1) * kstep;
            const char* a2 = last ? nA : cA + (size_t)(t + 2) * kstep; const char* b2 = last ? nB : cB + (size_t)(t + 2) * kstep;
            const char* a3 = a2 + kstep; const char* b3 = b2 + kstep;
            if (last && has_next) S.a_ready(nxt);
            if constexpr (SP2) {
            PG8_LDB(B0, 0, 0); PG8_LDB(B1, 0, 1); PG8_SCHED; PG8_LDA(At, 0, 0); PG8_STAGE(PG8_SA(1, 1), a1 + hstep, voffA);
            PG8_WAIT_V(8); PG8_WAIT_L(0); PG8_BAR; PG8_MMA(0, 0, At, B0); PG8_MMA(0, 1, At, B1); PG8_BAR; PG8_SCHED;
            PG8_LDA(At, 0, 1); PG8_STAGE(PG8_SB(0, 0), b2, voffB); PG8_STAGE(PG8_SB(0, 1), b2 + hstep, voffB); PG8_STAGE(PG8_SA(0, 0), a2, voffA);
            PG8_WAIT_V(8); PG8_WAIT_L(0); PG8_BAR; PG8_MMA(1, 0, At, B0); PG8_MMA(1, 1, At, B1); PG8_BAR; PG8_SCHED;
            PG8_LDB(B0, 1, 0); PG8_LDB(B1, 1, 1); PG8_SCHED; PG8_LDA(At, 1, 0); PG8_STAGE(PG8_SA(0, 1), a2 + hstep, voffA);
            PG8_WAIT_V(8); PG8_WAIT_L(0); PG8_BAR; PG8_MMA(0, 0, At, B0); PG8_MMA(0, 1, At, B1); PG8_BAR; PG8_SCHED;
            PG8_LDA(At, 1, 1); PG8_STAGE(PG8_SB(1, 0), b3, voffB); PG8_STAGE(PG8_SB(1, 1), b3 + hstep, voffB); PG8_STAGE(PG8_SA(1, 0), a3, voffA);
            PG8_WAIT_V(8); PG8_WAIT_L(0); PG8_BAR; PG8_MMA(1, 0, At, B0); PG8_MMA(1, 1, At, B1); PG8_BAR; PG8_SCHED;
            } else {
            PG8_LDB(B0, 0, 0); PG8_SCHED; PG8_LDA(At, 0, 0); PG8_STAGE(PG8_SA(1, 1), a1 + hstep, voffA);
            PG8_WAIT_L(8); PG8_BAR; PG8_WAIT_L(0); PG8_MMA(0, 0, At, B0); PG8_BAR; PG8_SCHED;
            PG8_LDB(B1, 0, 1); PG8_STAGE(PG8_SB(0, 0), b2, voffB);
            PG8_BAR; PG8_WAIT_L(0); PG8_MMA(0, 1, At, B1); PG8_BAR;
            PG8_LDA(At, 0, 1); PG8_STAGE(PG8_SA(0, 0), a2, voffA);
            PG8_BAR; PG8_WAIT_L(0); PG8_MMA(1, 0, At, B0); PG8_BAR; PG8_SCHED;
            PG8_STAGE(PG8_SB(0, 1), b2 + hstep, voffB);
            PG8_WAIT_V(6); PG8_BAR; PG8_MMA(1, 1, At, B1); PG8_BAR;
            PG8_LDB(B0, 1, 0); PG8_SCHED; PG8_LDA(At, 1, 0); PG8_STAGE(PG8_SA(0, 1), a2 + hstep, voffA);
            PG8_WAIT_L(8); PG8_BAR; PG8_WAIT_L(0); PG8_MMA(0, 0, At, B0); PG8_BAR; PG8_SCHED;
            PG8_LDB(B1, 1, 1); PG8_STAGE(PG8_SB(1, 0), b3, voffB);
            PG8_BAR; PG8_WAIT_L(0); PG8_MMA(0, 1, At, B1); PG8_BAR;
            PG8_LDA(At, 1, 1); PG8_STAGE(PG8_SA(1, 0), a3, voffA);
            PG8_BAR; PG8_WAIT_L(0); PG8_MMA(1, 0, At, B0); PG8_BAR; PG8_SCHED;
            PG8_STAGE(PG8_SB(1, 1), b3 + hstep, voffB);
            PG8_WAIT_V(6); PG8_BAR; PG8_MMA(1, 1, At, B1); PG8_BAR;
            }
        }
        if constexpr (ALIGN_EPI) { if (wr == 0) PG8_BAR; }
        if constexpr (!Epi::AFTER_DRAIN) { E(acc, cur, wr, wc, fr, fq); S.done(cur); }
        if (!has_next) break;
#pragma unroll
        for (int a = 0; a < 2; ++a)
#pragma unroll
            for (int b = 0; b < 2; ++b)
#pragma unroll
                for (int m = 0; m < 4; ++m)
#pragma unroll
                    for (int n = 0; n < 2; ++n) acc[a][b][m][n] = (f32x4){0.f, 0.f, 0.f, 0.f};
        cur = nxt; cA = nA; cB = nB; ++ui;
        if constexpr (ALIGN_EPI) { if (wr == 1) PG8_BAR; }
    }
    PG8_WAIT_V(0);
    if constexpr (!ALIGN_EPI) { if (wr == 0) PG8_BAR; }
    PG8_BAR;
    if constexpr (Epi::AFTER_DRAIN) { E.fused(acc, cur, wr, wc, fr, fq, lds, wid, lane); S.done(cur); }
#undef PG8_SA
#undef PG8_SB
#undef PG8_STAGE
#undef PG8_LDA
#undef PG8_LDB
#undef PG8_MMA
#undef PG8_WAIT_V
#undef PG8_WAIT_L
#undef PG8_BAR
#undef PG8_SCHED
}
}

#define GAS __attribute__((address_space(1)))
#define LAS __attribute__((address_space(3)))
typedef unsigned short bf16;
typedef unsigned v4u __attribute__((ext_vector_type(4)));
typedef unsigned v2u __attribute__((ext_vector_type(2)));
typedef float f32x4 __attribute__((ext_vector_type(4)));
typedef float f32x2 __attribute__((ext_vector_type(2)));
typedef short bf16x8 __attribute__((ext_vector_type(8)));
#define XB_TMO      128
#define XB_XCNT(j)  (256  + 64 * (j))
#define XB_XSUB(j)  (1280 + 64 * (j))
#define XB_XGEN(j)  (2304 + 64 * (j))
#define XB_TOP      3328
#define XB_TOPGEN   3392
#define XCD_BAR_WORDS 3456
#define XB_SPIN_CAP (1u << 18)

__device__ __forceinline__ unsigned xb_ld(unsigned* p)              { return __hip_atomic_load(p, __ATOMIC_RELAXED, __HIP_MEMORY_SCOPE_AGENT); }
__device__ __forceinline__ unsigned xb_add(unsigned* p, unsigned v) { return __hip_atomic_fetch_add(p, v, __ATOMIC_RELAXED, __HIP_MEMORY_SCOPE_AGENT); }
__device__ __forceinline__ unsigned xb_xcc_id() { return (unsigned)__builtin_amdgcn_s_getreg((3 << 11) | 20) & 0xFu; }
#define XB_SPIN(cond, bar) do { unsigned _sp = 0; while (cond) { __builtin_amdgcn_s_sleep(1); \
    if ((++_sp & 255u) == 0u) { if (xb_ld(&(bar)[XB_TMO])) break; if (_sp > XB_SPIN_CAP) { atomicAdd(&(bar)[XB_TMO], 1u); break; } } } } while (0)

struct XcdBarrier {
    unsigned* bar; unsigned x;
    volatile LAS unsigned* st;
};

__device__ __forceinline__ XcdBarrier xcd_barrier_post(unsigned* bar, volatile LAS unsigned* st) {
    XcdBarrier b; b.bar = bar; b.x = xb_xcc_id(); b.st = st;
    if (threadIdx.x == 0) (void)xb_add(&bar[XB_XCNT(b.x)], 1u);
    return b;
}
__device__ __forceinline__ void xcd_barrier_complete(unsigned* bar, unsigned x, unsigned& nloc, unsigned& nx) {
    const unsigned G = gridDim.x * gridDim.y * gridDim.z;
    unsigned sum, cnt, mine, sp = 0u;
    for (;;) {
        sum = 0u; cnt = 0u; mine = 0u;
#pragma unroll
        for (unsigned j = 0; j < 16; ++j) { const unsigned c = xb_ld(&bar[XB_XCNT(j)]); sum += c; cnt += (c > 0u) ? 1u : 0u; mine = (j == x) ? c : mine; }
        if (sum == G) break;
        __builtin_amdgcn_s_sleep(1);
        if ((++sp & 255u) == 0u) { if (xb_ld(&bar[XB_TMO])) break; if (sp > XB_SPIN_CAP) { atomicAdd(&bar[XB_TMO], 1u); break; } }
    }
    nloc = mine > 0u ? mine : 1u; nx = cnt > 0u ? cnt : 1u;
}

__device__ __forceinline__ void xcd_barrier(const XcdBarrier& b) {
    asm volatile("s_waitcnt vmcnt(0)" ::: "memory");
    __syncthreads();
    if (threadIdx.x == 0) {
        unsigned* bar = b.bar;
        __builtin_amdgcn_s_waitcnt(0);
        unsigned nloc = b.st[0], nx = b.st[1];
        if (nloc == 0u) { xcd_barrier_complete(bar, b.x, nloc, nx); b.st[0] = nloc; b.st[1] = nx; }
        const unsigned old = xb_add(&bar[XB_XSUB(b.x)], 1u);
        const unsigned gen = old / nloc;
        if (old + 1u == (gen + 1u) * nloc) {
            __builtin_amdgcn_fence(__ATOMIC_RELEASE, "agent");
            asm volatile("s_waitcnt vmcnt(0)" ::: "memory");
            const unsigned og = xb_add(&bar[XB_TOP], 1u);
            const unsigned tg = og / nx;
            if (og + 1u == (tg + 1u) * nx) xb_add(&bar[XB_TOPGEN], 1u);
            else XB_SPIN(xb_ld(&bar[XB_TOPGEN]) == tg, bar);
            __builtin_amdgcn_fence(__ATOMIC_ACQUIRE, "agent");
            xb_add(&bar[XB_XGEN(b.x)], 1u);
            asm volatile("s_waitcnt vmcnt(0)" ::: "memory");
        } else {
            XB_SPIN(xb_ld(&bar[XB_XGEN(b.x)]) == gen, bar);
            __builtin_amdgcn_fence(__ATOMIC_ACQUIRE, "agent");
            asm volatile("s_waitcnt vmcnt(0)" ::: "memory");
        }
    }
    __syncthreads();
}

constexpr int MP = 8192, MS = 128, MT = MP + MS, D = 2048, NIN = 6144, NUP = 11264, DFF = 5632, PLE = 256, SEQ = 2048, NH = 8;
constexpr float EPS = 1e-6f;
constexpr int NPHASE = 10;
constexpr size_t MiB = 1u << 20;
constexpr size_t WS_BAR = 0, BAR_BYTES = 16384;
constexpr size_t WS_SS1 = 64 * 1024, WS_SS2 = 128 * 1024, WS_SS3 = 192 * 1024, WS_STATS = 256 * 1024;
constexpr size_t WS_ROPE = 1 * MiB, WS_ROPES = 2 * MiB;
constexpr size_t WS_WIN = 4 * MiB, WS_WO = 28 * MiB, WS_WUP = 36 * MiB, WS_WDN = 80 * MiB, WS_WG = 102 * MiB, WS_WP = 110 * MiB;
constexpr size_t WS_AB = 112 * MiB, WS_PB = 145 * MiB, WS_MIX = 150 * MiB, WS_Z = 183 * MiB, WS_ACT = 183 * MiB, WS_KV = 281 * MiB, WS_PP = 281 * MiB;
constexpr size_t WS_RAW = 313 * MiB, WS_AS = 335 * MiB, WS_END = 346 * MiB;
static_assert(WS_AB + (size_t)MT * D * 2 <= WS_PB && WS_PB + (size_t)MT * PLE * 2 <= WS_MIX && WS_MIX + (size_t)MT * D * 2 <= WS_Z, "ws map 1");
static_assert(WS_Z + (size_t)MT * NIN * 2 <= WS_KV && WS_ACT + (size_t)MT * DFF * 2 <= WS_KV && WS_KV + (size_t)512 * 16384 * 4 <= WS_RAW, "ws map 2");
static_assert(WS_RAW + (size_t)128 * 4 * NUP * 4 <= WS_AS && WS_AS + (size_t)MS * NUP * 4 <= WS_END && WS_PP + (size_t)MT * D * 4 <= WS_END, "ws map 3");
constexpr size_t O_RETP = 17039360, O_CONVP = 17563648, O_RETS = 17653760, O_CONVS = 34430976, O_GMV = 37314560, O_END = 37445632;
constexpr int LDS_BYTES = 147456, MISC_OFF = LDS_BYTES - 256;
constexpr int LDP = 136;
constexpr int TILE_B = 128 * LDP * 2;

struct Params { const float* in[22]; float* out; unsigned char* ws; float log2g[8]; float invf[64]; int ph_lo, ph_hi, use_cg, pad; };

#define LDS_WAIT() asm volatile("s_waitcnt lgkmcnt(0)" ::: "memory")
__device__ __forceinline__ float lo16(unsigned u) { return __uint_as_float(u << 16); }
__device__ __forceinline__ float hi16(unsigned u) { return __uint_as_float(u & 0xffff0000u); }
__device__ __forceinline__ float bf2f(bf16 b) { return __uint_as_float((unsigned)b << 16); }
__device__ __forceinline__ unsigned pk2(float lo, float hi) { return pg8::cvt_pk_bf16(lo, hi); }
__device__ __forceinline__ bf16 f2bf(float f) { return (bf16)(pg8::cvt_pk_bf16(f, 0.f) & 0xffffu); }
__device__ __forceinline__ float sigmoid_(float x) { return __builtin_amdgcn_rcpf(1.0f + __builtin_amdgcn_exp2f(-1.44269504089f * x)); }
__device__ __forceinline__ float silu_(float x) { return x * sigmoid_(x); }
__device__ __forceinline__ float gelu_(float x) { return x * sigmoid_(1.5957691216f * (x + 0.044715f * x * x * x)); }
__device__ __forceinline__ float wave_sum(float v) {
#pragma unroll
    for (int o = 1; o < 64; o <<= 1) v += __shfl_xor(v, o);
    return v;
}
__device__ __forceinline__ void atomic_addf(float* p, float v) { (void)__hip_atomic_fetch_add(p, v, __ATOMIC_RELAXED, __HIP_MEMORY_SCOPE_AGENT); }
template <int CTRL> __device__ __forceinline__ float dppf(float x) { return __int_as_float(__builtin_amdgcn_update_dpp(0, __float_as_int(x), CTRL, 0xf, 0xf, false)); }

using pg8::Unit;
struct EpiZ {
    static constexpr bool PERM = true, AFTER_DRAIN = false;
    bf16* Z;
    __device__ __forceinline__ void operator()(const f32x4 (&acc)[2][2][4][2], const Unit& u, int wr, int wc, int fr, int fq) const {
        const int row0 = u.pm * 256 + wr * 64 + fr, col0 = u.pn * 256 + wc * 32 + 8 * fq;
        const int mode = u.pn < 12 ? 0 : (u.pn < 16 ? 1 : 2);
#pragma unroll
        for (int ai = 0; ai < 2; ++ai)
#pragma unroll
            for (int m = 0; m < 4; ++m) { bf16* rowp = Z + (size_t)(row0 + ai * 128 + m * 16) * NIN + col0;
#pragma unroll
                for (int bj = 0; bj < 2; ++bj) { f32x4 v0 = acc[ai][bj][m][0], v1 = acc[ai][bj][m][1];
                    if (mode == 1) {
#pragma unroll
                        for (int j = 0; j < 4; ++j) { v0[j] = silu_(v0[j]); v1[j] = silu_(v1[j]); } }
                    else if (mode == 2) {
#pragma unroll
                        for (int j = 0; j < 4; ++j) { v0[j] = gelu_(v0[j]); v1[j] = gelu_(v1[j]); } }
                    v4u w; w.x = pk2(v0[0], v0[1]); w.y = pk2(v0[2], v0[3]); w.z = pk2(v1[0], v1[1]); w.w = pk2(v1[2], v1[3]);
                    *(v4u*)(rowp + bj * 128) = w; } }
    }
};
template <bool BASE_BF16> struct EpiRes {
    static constexpr bool PERM = false, AFTER_DRAIN = false;
    const float* base; bf16* hb; float* ss;
    __device__ __forceinline__ void operator()(const f32x4 (&acc)[2][2][4][2], const Unit& u, int wr, int wc, int fr, int fq) const {
        const int row0 = u.pm * 256 + wr * 64 + fr, col0 = u.pn * 256 + wc * 32 + 4 * fq;
        float sacc[2][4];
#pragma unroll
        for (int ai = 0; ai < 2; ++ai) {
            f32x4 bs[4][2][2];
#pragma unroll
            for (int m = 0; m < 4; ++m)
#pragma unroll
                for (int bj = 0; bj < 2; ++bj)
#pragma unroll
                    for (int n = 0; n < 2; ++n) { const size_t o_ = (size_t)(row0 + ai * 128 + m * 16) * D + col0 + bj * 128 + n * 16;
                        if (BASE_BF16) { const v2u w = *(const v2u*)(hb + o_); bs[m][bj][n] = (f32x4){lo16(w.x), hi16(w.x), lo16(w.y), hi16(w.y)}; }
                        else bs[m][bj][n] = *(const f32x4*)(base + o_); }
#pragma unroll
            for (int m = 0; m < 4; ++m) { const size_t off = (size_t)(row0 + ai * 128 + m * 16) * D + col0; float s = 0.f;
#pragma unroll
                for (int bj = 0; bj < 2; ++bj)
#pragma unroll
                    for (int n = 0; n < 2; ++n) { const f32x4 o = bs[m][bj][n] + acc[ai][bj][m][n];
                        v2u w; w.x = pk2(o[0], o[1]); w.y = pk2(o[2], o[3]); *(v2u*)(hb + off + bj * 128 + n * 16) = w;
                        s += (o[0] * o[0] + o[1] * o[1]) + (o[2] * o[2] + o[3] * o[3]); }
                s += __shfl_xor(s, 16); s += __shfl_xor(s, 32); sacc[ai][m] = s; }
            asm volatile("" ::: "memory"); }
        if (fq == 0) {
#pragma unroll
            for (int ai = 0; ai < 2; ++ai)
#pragma unroll
                for (int m = 0; m < 4; ++m) atomic_addf(ss + row0 + ai * 128 + m * 16, sacc[ai][m]); }
    }
};
struct EpiPP {
    static constexpr bool PERM = false, AFTER_DRAIN = false;
    bf16* pp;
    __device__ __forceinline__ void operator()(const f32x4 (&acc)[2][2][4][2], const Unit& u, int wr, int wc, int fr, int fq) const {
        const int row0 = u.pm * 256 + wr * 64 + fr, col0 = u.pn * 256 + wc * 32 + 4 * fq;
#pragma unroll
        for (int ai = 0; ai < 2; ++ai)
#pragma unroll
            for (int m = 0; m < 4; ++m) { bf16* rowp = pp + (size_t)(row0 + ai * 128 + m * 16) * D + col0;
#pragma unroll
                for (int bj = 0; bj < 2; ++bj)
#pragma unroll
                    for (int n = 0; n < 2; ++n) { const f32x4 v = acc[ai][bj][m][n]; v2u w; w.x = pk2(v[0], v[1]); w.y = pk2(v[2], v[3]); *(v2u*)(rowp + bj * 128 + n * 16) = w; } }
    }
};
struct EpiGate {
    static constexpr bool PERM = false, AFTER_DRAIN = false;
    const bf16* pp; const bf16* hb; float* h; const float* ss2; float* ss3;
    __device__ __forceinline__ void operator()(const f32x4 (&acc)[2][2][4][2], const Unit& u, int wr, int wc, int fr, int fq) const {
        const int row0 = u.pm * 256 + wr * 64 + fr, col0 = u.pn * 256 + wc * 32 + 4 * fq;
        float sacc[2][4];
#pragma unroll
        for (int ai = 0; ai < 2; ++ai)
#pragma unroll
            for (int mp = 0; mp < 2; ++mp) {
                f32x4 hv[2][2][2]; v2u pw[2][2][2]; float r2[2];
#pragma unroll
                for (int mm = 0; mm < 2; ++mm) { const int row = row0 + ai * 128 + (2 * mp + mm) * 16; r2[mm] = ss2[row];
#pragma unroll
                    for (int bj = 0; bj < 2; ++bj)
#pragma unroll
                        for (int n = 0; n < 2; ++n) { { const v2u hw = *(const v2u*)(hb + (size_t)row * D + col0 + bj * 128 + n * 16); hv[mm][bj][n] = (f32x4){lo16(hw.x), hi16(hw.x), lo16(hw.y), hi16(hw.y)}; } pw[mm][bj][n] = *(const v2u*)(pp + (size_t)row * D + col0 + bj * 128 + n * 16); } }
#pragma unroll
                for (int mm = 0; mm < 2; ++mm) { const int m = 2 * mp + mm; const size_t off = (size_t)(row0 + ai * 128 + m * 16) * D + col0; float s = 0.f;
                    const float rr = __builtin_amdgcn_rsqf(r2[mm] * (1.0f / D) + EPS);
#pragma unroll
                    for (int bj = 0; bj < 2; ++bj)
#pragma unroll
                        for (int n = 0; n < 2; ++n) { const v2u p2 = pw[mm][bj][n]; const f32x4 pv = {lo16(p2.x), hi16(p2.x), lo16(p2.y), hi16(p2.y)}; const f32x4 a = acc[ai][bj][m][n]; f32x4 o;
#pragma unroll
                            for (int j = 0; j < 4; ++j) o[j] = hv[mm][bj][n][j] + pv[j] * sigmoid_(rr * a[j]);
                            *(f32x4*)(h + off + bj * 128 + n * 16) = o; s += (o[0] * o[0] + o[1] * o[1]) + (o[2] * o[2] + o[3] * o[3]); }
                    s += __shfl_xor(s, 16); s += __shfl_xor(s, 32); sacc[ai][m] = s; }
                asm volatile("" ::: "memory"); }
        if (fq == 0) {
#pragma unroll
            for (int ai = 0; ai < 2; ++ai)
#pragma unroll
                for (int m = 0; m < 4; ++m) atomic_addf(ss3 + row0 + ai * 128 + m * 16, sacc[ai][m]); }
    }
};
struct EpiUp {
    static constexpr bool PERM = false, AFTER_DRAIN = false;
    bf16* act; float* raw; const float* ss1; const float* cw; const float* cb;
    __device__ __forceinline__ void operator()(const f32x4 (&acc)[2][2][4][2], const Unit& u, int wr, int wc, int fr, int fq) const {
        const int row0 = u.pm * 256 + wr * 64 + fr;
        float rs[2][4];
#pragma unroll
        for (int ai = 0; ai < 2; ++ai)
#pragma unroll
            for (int m = 0; m < 4; ++m) rs[ai][m] = __builtin_amdgcn_rsqf(ss1[row0 + ai * 128 + m * 16] * (1.0f / D) + EPS);
#pragma unroll
        for (int n = 0; n < 2; ++n) {
            const int cg_ = u.pn * 128 + wc * 32 + 16 * n + 4 * fq;
            const f32x4 w0g = *(const f32x4*)(cw + cg_), w1g = *(const f32x4*)(cw + NUP + cg_), w2g = *(const f32x4*)(cw + 2 * NUP + cg_), bg = *(const f32x4*)(cb + cg_);
            const f32x4 w0u = *(const f32x4*)(cw + DFF + cg_), w1u = *(const f32x4*)(cw + NUP + DFF + cg_), w2u = *(const f32x4*)(cw + 2 * NUP + DFF + cg_), bu = *(const f32x4*)(cb + DFF + cg_);
#pragma unroll
            for (int ai = 0; ai < 2; ++ai) {
                f32x4 pg = {0.f, 0.f, 0.f, 0.f}, pu = {0.f, 0.f, 0.f, 0.f};
#pragma unroll
                for (int m = 0; m < 4; ++m) {
                    const int row = row0 + ai * 128 + m * 16;
                    const f32x4 g = acc[ai][0][m][n] * rs[ai][m], up = acc[ai][1][m][n] * rs[ai][m];
                    if (m == 0 && fr < 2) { float* rp = raw + ((size_t)(row >> 6) * 4 + 2 + fr) * NUP + cg_; *(f32x4*)rp = g; *(f32x4*)(rp + DFF) = up; }
                    if (m == 3 && fr >= 14) { float* rp = raw + ((size_t)(row >> 6) * 4 + (fr - 14)) * NUP + cg_; *(f32x4*)rp = g; *(f32x4*)(rp + DFF) = up; }
                    f32x4 o;
#pragma unroll
                    for (int j = 0; j < 4; ++j) {
                        const float g1 = dppf<0x121>(fr == 15 ? pg[j] : g[j]), g2 = dppf<0x122>(fr >= 14 ? pg[j] : g[j]);
                        const float u1 = dppf<0x121>(fr == 15 ? pu[j] : up[j]), u2 = dppf<0x122>(fr >= 14 ? pu[j] : up[j]);
                        const float ag = w0g[j] * g2 + w1g[j] * g1 + w2g[j] * g[j] + bg[j];
                        const float au = w0u[j] * u2 + w1u[j] * u1 + w2u[j] * up[j] + bu[j];
                        o[j] = silu_(ag) * au; }
                    v2u w; w.x = pk2(o[0], o[1]); w.y = pk2(o[2], o[3]);
                    *(v2u*)(act + (size_t)row * DFF + cg_) = w;
                    pg = g; pu = up; } } }
    }
};

template <int RT, class F>
__device__ __forceinline__ void skinny_gemm(LAS unsigned char* lds, const bf16* A, const bf16* Bt, int N, int K, int u0, int ustride, const F& f) {
    const int tid = threadIdx.x, lane = tid & 63, w = tid >> 6, fr = lane & 15, fq = lane >> 4;
    constexpr int nrb = 8 / RT, ROWS = 16 * RT;
    const int nunits = nrb * (N / 32), kw = K / 8;
    LAS float* red = (LAS float*)lds;
    for (int u = u0; u < nunits; u += ustride) {
        const int rb = u % nrb, cb = u / nrb, row0 = rb * ROWS, col0 = cb * 32;
        f32x4 acc[RT][2];
#pragma unroll
        for (int rt = 0; rt < RT; ++rt) { acc[rt][0] = (f32x4){0.f, 0.f, 0.f, 0.f}; acc[rt][1] = (f32x4){0.f, 0.f, 0.f, 0.f}; }
        const bf16* ap = A + (size_t)(row0 + fr) * K + w * kw + 8 * fq;
        const bf16* bp = Bt + (size_t)(col0 + fr) * K + w * kw + 8 * fq;
#pragma unroll (RT <= 2 ? 8 : 2)
        for (int k = 0; k < kw; k += 32) {
            const bf16x8 b0 = *(const bf16x8*)(bp + k), b1 = *(const bf16x8*)(bp + (size_t)16 * K + k);
#pragma unroll
            for (int rt = 0; rt < RT; ++rt) { const bf16x8 av = *(const bf16x8*)(ap + (size_t)rt * 16 * K + k);
                acc[rt][0] = __builtin_amdgcn_mfma_f32_16x16x32_bf16(b0, av, acc[rt][0], 0, 0, 0);
                acc[rt][1] = __builtin_amdgcn_mfma_f32_16x16x32_bf16(b1, av, acc[rt][1], 0, 0, 0); }
        }
#pragma unroll
        for (int rt = 0; rt < RT; ++rt)
#pragma unroll
            for (int ct = 0; ct < 2; ++ct) *(LAS f32x4*)(red + (w * ROWS + 16 * rt + fr) * 32 + 16 * ct + 4 * fq) = acc[rt][ct];
        __syncthreads();
#pragma unroll
        for (int it = 0; it < RT; ++it) { const int e = tid + 512 * it, r = e >> 5, c = e & 31; float v = 0.f;
#pragma unroll
            for (int ww = 0; ww < 8; ++ww) v += red[(ww * ROWS + r) * 32 + c];
            f(row0 + r, col0 + c, v); }
        __syncthreads();
    }
}
__device__ __forceinline__ float half_wave_sum(float v) {
#pragma unroll
    for (int o = 1; o < 32; o <<= 1) v += __shfl_xor(v, o);
    return v;
}

__device__ __forceinline__ void transpose_item(const float* W, int K, int N, const float* g, bf16* WT, bool upmap, LAS float* scr, int item, int lane) {
    const int nblk = N / 64, kb = item / nblk, nb = item % nblk, k0 = 64 * kb, n0 = 64 * nb;
    const float* src = W + (size_t)k0 * N + n0 + lane;
#pragma unroll
    for (int h = 0; h < 2; ++h) {
        float v[32];
#pragma unroll
        for (int i = 0; i < 32; ++i) v[i] = src[(size_t)(32 * h + i) * N];
#pragma unroll
        for (int i = 0; i < 32; ++i) { float x = v[i]; if (g) x *= g[k0 + 32 * h + i]; scr[(32 * h + i) * 65 + lane] = x; }
    }
    LDS_WAIT(); asm volatile("" ::: "memory");
    const int c = lane & 7;
#pragma unroll
    for (int j = 0; j < 8; ++j) { const int n = (lane >> 3) + 8 * j; const LAS float* s = scr + (8 * c) * 65 + n;
        v4u o; o.x = pk2(s[0 * 65], s[1 * 65]); o.y = pk2(s[2 * 65], s[3 * 65]); o.z = pk2(s[4 * 65], s[5 * 65]); o.w = pk2(s[6 * 65], s[7 * 65]);
        int R = n0 + n; if (upmap) { const int half = R >= DFF ? 1 : 0, jj = R - half * DFF; R = 256 * (jj >> 7) + 128 * half + (jj & 127); }
        *(v4u*)(WT + (size_t)R * K + k0 + 8 * c) = o; }
    LDS_WAIT(); asm volatile("" ::: "memory");
}
__device__ __forceinline__ void rms_row_to_bf16(const float* xrow, bf16* orow, int lane) {
    const f32x4* xr = (const f32x4*)xrow + lane;
    f32x4 v[8]; float s = 0.f;
#pragma unroll
    for (int j = 0; j < 8; ++j) { v[j] = xr[64 * j]; s += (v[j][0] * v[j][0] + v[j][1] * v[j][1]) + (v[j][2] * v[j][2] + v[j][3] * v[j][3]); }
    const float r = __builtin_amdgcn_rsqf(wave_sum(s) * (1.0f / D) + EPS);
    v2u* o8 = (v2u*)orow + lane;
#pragma unroll
    for (int j = 0; j < 8; ++j) { v2u w; w.x = pk2(v[j][0] * r, v[j][1] * r); w.y = pk2(v[j][2] * r, v[j][3] * r); o8[64 * j] = w; }
}

__device__ __forceinline__ void mm128(f32x4 (&acc)[8], const LAS bf16* A, const LAS bf16* B, int wave, int fr, int fq) {
#pragma unroll
    for (int ks = 0; ks < 4; ++ks) {
        const bf16x8 a = *(const LAS bf16x8*)(A + (16 * wave + fr) * LDP + 32 * ks + 8 * fq);
#pragma unroll
        for (int ct = 0; ct < 8; ++ct) { const bf16x8 b = *(const LAS bf16x8*)(B + (16 * ct + fr) * LDP + 32 * ks + 8 * fq);
            acc[ct] = __builtin_amdgcn_mfma_f32_16x16x32_bf16(b, a, acc[ct], 0, 0, 0); }
    }
}
template <bool TRANS, bool DEC>
__device__ __forceinline__ void stage_rope(LAS bf16* dst, const bf16* zb, const float* rope, float scale, float l2g, int tid) {
#pragma unroll
    for (int it = 0; it < 2; ++it) { const int idx = tid + 512 * it, j = idx >> 3, d8 = idx & 7;
        const v4u x1 = *(const v4u*)(zb + (size_t)j * NIN + 8 * d8), x2 = *(const v4u*)(zb + (size_t)j * NIN + 64 + 8 * d8);
        const f32x4* rp = (const f32x4*)(rope + (size_t)(j * 64 + 8 * d8) * 2);
        float sc = scale; if (DEC) sc *= __builtin_amdgcn_exp2f(l2g * (float)(127 - j));
        float o1[8], o2[8];
#pragma unroll
        for (int p = 0; p < 4; ++p) { const f32x4 cs = rp[p]; const float a0 = lo16(x1[p]), a1 = hi16(x1[p]), b0 = lo16(x2[p]), b1 = hi16(x2[p]);
            o1[2 * p] = (a0 * cs[0] - b0 * cs[1]) * sc; o2[2 * p] = (b0 * cs[0] + a0 * cs[1]) * sc;
            o1[2 * p + 1] = (a1 * cs[2] - b1 * cs[3]) * sc; o2[2 * p + 1] = (b1 * cs[2] + a1 * cs[3]) * sc; }
        if (!TRANS) { v4u w1, w2;
#pragma unroll
            for (int p = 0; p < 4; ++p) { w1[p] = pk2(o1[2 * p], o1[2 * p + 1]); w2[p] = pk2(o2[2 * p], o2[2 * p + 1]); }
            *(LAS v4u*)(dst + j * LDP + 8 * d8) = w1; *(LAS v4u*)(dst + j * LDP + 64 + 8 * d8) = w2; }
        else {
#pragma unroll
            for (int i = 0; i < 8; ++i) { dst[(8 * d8 + i) * LDP + j] = f2bf(o1[i]); dst[(64 + 8 * d8 + i) * LDP + j] = f2bf(o2[i]); } }
    }
}
__device__ __forceinline__ void stage_T(LAS bf16* dst, const bf16* zb, int tid) {
#pragma unroll
    for (int it = 0; it < 4; ++it) { const int idx = tid + 512 * it, j = idx >> 4, c8 = idx & 15;
        const v4u x = *(const v4u*)(zb + (size_t)j * NIN + 8 * c8);
#pragma unroll
        for (int p = 0; p < 4; ++p) { dst[(8 * c8 + 2 * p) * LDP + j] = (bf16)(x[p] & 0xffffu); dst[(8 * c8 + 2 * p + 1) * LDP + j] = (bf16)(x[p] >> 16); } }
}


struct RopeX { v4u x1[2], x2[2]; };
struct RopeCS { f32x4 cs[2][4]; };
struct TileX { v4u x[4]; };
__device__ __forceinline__ void rope_load(RopeX& r, const bf16* zb, int tid) {
#pragma unroll
    for (int it = 0; it < 2; ++it) { const int idx = tid + 512 * it, j = idx >> 3, d8 = idx & 7; r.x1[it] = *(const v4u*)(zb + (size_t)j * NIN + 8 * d8); r.x2[it] = *(const v4u*)(zb + (size_t)j * NIN + 64 + 8 * d8); }
}
__device__ __forceinline__ void rope_cs_load(RopeCS& c, const float* rope, int tid) {
#pragma unroll
    for (int it = 0; it < 2; ++it) { const int idx = tid + 512 * it, j = idx >> 3, d8 = idx & 7; const f32x4* rp = (const f32x4*)(rope + (size_t)(j * 64 + 8 * d8) * 2);
#pragma unroll
        for (int p = 0; p < 4; ++p) c.cs[it][p] = rp[p]; }
}
template <bool TRANS, bool DEC>
__device__ __forceinline__ void rope_commit(LAS bf16* dst, const RopeX& r, const RopeCS& c, float scale, float l2g, int tid) {
#pragma unroll
    for (int it = 0; it < 2; ++it) { const int idx = tid + 512 * it, j = idx >> 3, d8 = idx & 7;
        float sc = scale; if (DEC) sc *= __builtin_amdgcn_exp2f(l2g * (float)(127 - j));
        float o1[8], o2[8];
#pragma unroll
        for (int p = 0; p < 4; ++p) { const f32x4 cs = c.cs[it][p]; const float a0 = lo16(r.x1[it][p]), a1 = hi16(r.x1[it][p]), b0 = lo16(r.x2[it][p]), b1 = hi16(r.x2[it][p]);
            o1[2 * p] = (a0 * cs[0] - b0 * cs[1]) * sc; o2[2 * p] = (b0 * cs[0] + a0 * cs[1]) * sc;
            o1[2 * p + 1] = (a1 * cs[2] - b1 * cs[3]) * sc; o2[2 * p + 1] = (b1 * cs[2] + a1 * cs[3]) * sc; }
        if (!TRANS) { v4u w1, w2;
#pragma unroll
            for (int p = 0; p < 4; ++p) { w1[p] = pk2(o1[2 * p], o1[2 * p + 1]); w2[p] = pk2(o2[2 * p], o2[2 * p + 1]); }
            *(LAS v4u*)(dst + j * LDP + 8 * d8) = w1; *(LAS v4u*)(dst + j * LDP + 64 + 8 * d8) = w2; }
        else {
#pragma unroll
            for (int i = 0; i < 8; ++i) { dst[(8 * d8 + i) * LDP + j] = f2bf(o1[i]); dst[(64 + 8 * d8 + i) * LDP + j] = f2bf(o2[i]); } }
    }
}
__device__ __forceinline__ void tile_load(TileX& t, const bf16* zb, int tid) {
#pragma unroll
    for (int it = 0; it < 4; ++it) { const int idx = tid + 512 * it, j = idx >> 4, c8 = idx & 15; t.x[it] = *(const v4u*)(zb + (size_t)j * NIN + 8 * c8); }
}
__device__ __forceinline__ void tile_commit_T(LAS bf16* dst, const TileX& t, int tid) {
#pragma unroll
    for (int it = 0; it < 4; ++it) { const int idx = tid + 512 * it, j = idx >> 4, c8 = idx & 15;
#pragma unroll
        for (int p = 0; p < 4; ++p) { dst[(8 * c8 + 2 * p) * LDP + j] = (bf16)(t.x[it][p] & 0xffffu); dst[(8 * c8 + 2 * p + 1) * LDP + j] = (bf16)(t.x[it][p] >> 16); } }
}

__global__ void __launch_bounds__(512, 2) mk_fwd(Params a) {
    extern __shared__ __attribute__((aligned(16))) unsigned char lds_raw[];
    LAS unsigned char* lds = (LAS unsigned char*)lds_raw;
    const int tid = threadIdx.x, lane = tid & 63, wave = __builtin_amdgcn_readfirstlane(tid >> 6), fr = lane & 15, fq = lane >> 4;
    const int G = gridDim.x, blk = blockIdx.x;
    const int gw = blk * 8 + wave, NGW = G * 8;
    const int gt = blk * 512 + tid, NGT = G * 512;
    unsigned char* ws = a.ws;
    const float* x_p = a.in[0]; const float* x_s = a.in[1]; const float* p_p = a.in[2]; const float* p_s = a.in[3];
    const float* state_ret = a.in[4]; const float* state_conv = a.in[5];
    const float* gm_ln_g = a.in[8]; const float* gm_ln_b = a.in[9]; const float* gm_ws = a.in[10]; const float* gm_bs = a.in[11];
    const float* conv_w = a.in[15]; const float* conv_b = a.in[16]; const float* g_final = a.in[21];
    float* out = a.out;
    float* SS1 = (float*)(ws + WS_SS1); float* SS2 = (float*)(ws + WS_SS2); float* SS3 = (float*)(ws + WS_SS3); float* STATS = (float*)(ws + WS_STATS);
    float* ROPE = (float*)(ws + WS_ROPE); float* ROPES = (float*)(ws + WS_ROPES);
    bf16* Win_t = (bf16*)(ws + WS_WIN); bf16* Wo_t = (bf16*)(ws + WS_WO); bf16* Wup_t = (bf16*)(ws + WS_WUP); bf16* Wdn_t = (bf16*)(ws + WS_WDN); bf16* Wg_t = (bf16*)(ws + WS_WG); bf16* Wp_t = (bf16*)(ws + WS_WP);
    bf16* AB = (bf16*)(ws + WS_AB); bf16* PB = (bf16*)(ws + WS_PB); bf16* MIX = (bf16*)(ws + WS_MIX); bf16* Z = (bf16*)(ws + WS_Z); bf16* ACT = (bf16*)(ws + WS_ACT);
    float* KV = (float*)(ws + WS_KV); bf16* PP = (bf16*)(ws + WS_PP); float* RAW = (float*)(ws + WS_RAW); float* AS = (float*)(ws + WS_AS);

    volatile LAS unsigned* MISC = (volatile LAS unsigned*)(lds + MISC_OFF);
    if (tid < 64) MISC[tid] = 0u;
    __syncthreads();
    XcdBarrier bar; bar.bar = (unsigned*)(ws + WS_BAR); bar.x = 0; bar.st = nullptr;
    if (MK_N_LAUNCHES == 1) bar = xcd_barrier_post((unsigned*)(ws + WS_BAR), MISC + 8);
    const int lo = a.ph_lo, hi = a.ph_hi;
#ifndef PHMASK
#define PHMASK 0xffff
#endif
#define IN(k) (((PHMASK >> (k)) & 1) && lo <= (k) && (k) < hi)
#define SEAM(k) do { if (IN(k) && IN((k) + 1)) { if (a.use_cg) cg::this_grid().sync(); else xcd_barrier(bar); } } while (0)

    if (IN(0)) {
        LAS float* scr = (LAS float*)(lds + wave * 16640);
        constexpr int I_IN = (D / 64) * (NIN / 64), I_O = (D / 64) * (D / 64), I_UP = (D / 64) * (NUP / 64), I_DN = (DFF / 64) * (D / 64), I_G = I_O, I_P = (PLE / 64) * (D / 64);
        constexpr int NITEMS = I_IN + I_O + I_UP + I_DN + I_G + I_P;
        for (int it = gw; it < NITEMS; it += NGW) {
            int r = it;
            if (r < I_UP) { transpose_item(a.in[14], D, NUP, a.in[13], Wup_t, true, scr, r, lane); continue; } r -= I_UP;
            if (r < I_IN) { transpose_item(a.in[7], D, NIN, a.in[6], Win_t, false, scr, r, lane); continue; } r -= I_IN;
            if (r < I_DN) { transpose_item(a.in[17], DFF, D, nullptr, Wdn_t, false, scr, r, lane); continue; } r -= I_DN;
            if (r < I_O) { transpose_item(a.in[12], D, D, nullptr, Wo_t, false, scr, r, lane); continue; } r -= I_O;
            if (r < I_G) { transpose_item(a.in[19], D, D, a.in[18], Wg_t, false, scr, r, lane); continue; } r -= I_G;
            transpose_item(a.in[20], PLE, D, nullptr, Wp_t, false, scr, r, lane);
        }
        for (int m = gw; m < MT; m += NGW) rms_row_to_bf16(m < MP ? x_p + (size_t)m * D : x_s + (size_t)(m - MP) * D, AB + (size_t)m * D, lane);
        for (int i = gt; i < MT * PLE / 4; i += NGT) { const f32x4 v = i < MP * PLE / 4 ? ((const f32x4*)p_p)[i] : ((const f32x4*)p_s)[i - MP * PLE / 4]; v2u w; w.x = pk2(v[0], v[1]); w.y = pk2(v[2], v[3]); ((v2u*)PB)[i] = w; }
        for (int i = gt; i < SEQ * 64 + 64; i += NGT) { const int pos = i < SEQ * 64 ? (i >> 6) : 16384, fi = i & 63;
            const float ang = (float)pos * a.invf[fi]; double t = (double)ang * 0.15915494309189535; t -= __builtin_rint(t); const float rev = (float)t;
            float* dst = i < SEQ * 64 ? ROPE + 2 * (size_t)i : ROPES + 2 * fi; dst[0] = __builtin_amdgcn_cosf(rev); dst[1] = __builtin_amdgcn_sinf(rev); }
        for (int i = gt; i < MT; i += NGT) { SS1[i] = 0.f; SS2[i] = 0.f; SS3[i] = 0.f; }
    }
    SEAM(0);

    if (IN(1)) {
        { pg8::Gemm g{AB, Win_t, MP, NIN, D}; pg8::StaticOrder S; S.init(MP, NIN, G, blk); EpiZ E{Z};
          pg8::gemm_phase<EpiZ, pg8::StaticOrder, true, true>(lds, g, S, E); }
        auto f = [&](int s, int n, float v) { const float o = n < 3072 ? v : (n < 4096 ? silu_(v) : gelu_(v)); Z[(size_t)(MP + s) * NIN + n] = f2bf(o); };
        skinny_gemm<8>(lds, AB + (size_t)MP * D, Win_t, NIN, D, blk, G, f);
    }
    SEAM(1);

    if (IN(2)) {
        { LAS float* qs = (LAS float*)lds; LAS float* ks = qs + 128; LAS float* vs = ks + 128; LAS float* red = vs + 128;
          const int e4 = tid & 31, dg = tid >> 5;
          for (int u = blk; u < MS * NH; u += G) { const int s = u >> 3, h = u & 7; const bf16* zr = Z + (size_t)(MP + s) * NIN;
            const float* S0 = state_ret + (size_t)u * 16384 + 4 * e4; float* S1 = out + O_RETS + (size_t)u * 16384 + 4 * e4;
            f32x4 s0[8];
#pragma unroll
            for (int i = 0; i < 8; ++i) s0[i] = __builtin_nontemporal_load((const f32x4*)(S0 + (dg + 16 * i) * 128));
            if (tid < 64) { const float c = ROPES[2 * tid], sn = ROPES[2 * tid + 1];
                const float q1 = bf2f(zr[128 * h + tid]), q2 = bf2f(zr[128 * h + 64 + tid]), k1 = bf2f(zr[1024 + 128 * h + tid]), k2 = bf2f(zr[1024 + 128 * h + 64 + tid]);
                qs[tid] = q1 * c - q2 * sn; qs[tid + 64] = q2 * c + q1 * sn; ks[tid] = (k1 * c - k2 * sn) * 0.08838834764831845f; ks[tid + 64] = (k2 * c + k1 * sn) * 0.08838834764831845f; }
            else if (tid < 192) vs[tid - 64] = bf2f(zr[2048 + 128 * h + tid - 64]);
            unsigned gg = 0u; if (tid < 64) gg = *(const unsigned*)(zr + 3072 + 128 * h + 2 * tid);
            __syncthreads();
            const float gamma = 1.0f - __builtin_amdgcn_exp2f((float)(-5 - h));
            const f32x4 vv = *(const LAS f32x4*)(vs + 4 * e4); f32x4 o = {0.f, 0.f, 0.f, 0.f};
#pragma unroll
            for (int i = 0; i < 8; ++i) { const int d = dg + 16 * i; const f32x4 sn = s0[i] * gamma + vv * ks[d]; __builtin_nontemporal_store(sn, (f32x4*)(S1 + d * 128)); o += sn * qs[d]; }
            *(LAS f32x4*)(red + dg * 128 + 4 * e4) = o;
            __syncthreads();
            if (tid < 64) { float o0 = 0.f, o1 = 0.f;
#pragma unroll
                for (int i = 0; i < 16; ++i) { o0 += red[i * 128 + 2 * tid]; o1 += red[i * 128 + 2 * tid + 1]; }
                const float r = __builtin_amdgcn_rsqf(wave_sum(o0 * o0 + o1 * o1) * (1.0f / 128.0f) + EPS);
                *(unsigned*)(MIX + (size_t)(MP + s) * D + 128 * h + 2 * tid) = pk2(o0 * r * lo16(gg), o1 * r * hi16(gg)); }
            __syncthreads(); } }
        { LAS bf16* Kt = (LAS bf16*)lds; LAS bf16* Vt = (LAS bf16*)(lds + TILE_B);
          for (int u = blk; u < 512; u += G) { const int b = u >> 7, h = (u >> 4) & 7, c = u & 15; const size_t R0 = (size_t)b * SEQ + 128 * c;
            RopeX kx; RopeCS cs; TileX vx;
            rope_load(kx, Z + R0 * NIN + 1024 + 128 * h, tid); rope_cs_load(cs, ROPE + (size_t)(128 * c) * 128, tid); tile_load(vx, Z + R0 * NIN + 2048 + 128 * h, tid);
            rope_commit<true, true>(Kt, kx, cs, 0.08838834764831845f, a.log2g[h], tid);
            tile_commit_T(Vt, vx, tid);
            __syncthreads();
            f32x4 acc[8];
#pragma unroll
            for (int ct = 0; ct < 8; ++ct) acc[ct] = (f32x4){0.f, 0.f, 0.f, 0.f};
            mm128(acc, Kt, Vt, wave, fr, fq);
            float* kv = KV + (size_t)u * 16384 + (16 * wave + fr) * 128 + 4 * fq;
#pragma unroll
            for (int ct = 0; ct < 8; ++ct) *(f32x4*)(kv + 16 * ct) = acc[ct];
            __syncthreads(); } }
        for (int r0 = gw; r0 < MP; r0 += 2 * NGW) { const int r1 = r0 + NGW;
            const bf16* p0 = Z + (size_t)r0 * NIN + 5120 + 16 * lane; const bf16* p1 = Z + (size_t)(r1 < MP ? r1 : r0) * NIN + 5120 + 16 * lane;
            const v4u xa0 = *(const v4u*)p0, xa1 = *(const v4u*)(p0 + 8), xb0 = *(const v4u*)p1, xb1 = *(const v4u*)(p1 + 8);
            float va[16], vb[16];
#pragma unroll
            for (int j = 0; j < 4; ++j) { va[2 * j] = lo16(xa0[j]); va[2 * j + 1] = hi16(xa0[j]); va[8 + 2 * j] = lo16(xa1[j]); va[8 + 2 * j + 1] = hi16(xa1[j]);
                                          vb[2 * j] = lo16(xb0[j]); vb[2 * j + 1] = hi16(xb0[j]); vb[8 + 2 * j] = lo16(xb1[j]); vb[8 + 2 * j + 1] = hi16(xb1[j]); }
            float sa = 0.f, sb = 0.f;
#pragma unroll
            for (int j = 0; j < 16; ++j) { sa += va[j]; sb += vb[j]; }
            const float ma = wave_sum(sa) * (1.0f / 1024.0f), mb = wave_sum(sb) * (1.0f / 1024.0f); float qa = 0.f, qb = 0.f;
#pragma unroll
            for (int j = 0; j < 16; ++j) { const float da = va[j] - ma, db = vb[j] - mb; qa += da * da; qb += db * db; }
            const float ra = __builtin_amdgcn_rsqf(wave_sum(qa) * (1.0f / 1024.0f) + EPS), rb = __builtin_amdgcn_rsqf(wave_sum(qb) * (1.0f / 1024.0f) + EPS);
            if (lane == 0) { STATS[2 * r0] = ma; STATS[2 * r0 + 1] = ra; if (r1 < MP) { STATS[2 * r1] = mb; STATS[2 * r1 + 1] = rb; } } }
        for (int row = MP + gw; row < MT; row += NGW) { const bf16* p = Z + (size_t)row * NIN + 5120 + 16 * lane; const v4u x0 = *(const v4u*)p, x1 = *(const v4u*)(p + 8);
            const int s_ = row - MP, c0 = 16 * lane, grp = lane >> 3; const float w00 = gm_ws[grp * 16384], b0 = gm_bs[grp * 128];
            const bf16* up = Z + (size_t)row * NIN + 4096 + c0; const v4u u0 = *(const v4u*)up, u1 = *(const v4u*)(up + 8);
            float v[16];
#pragma unroll
            for (int j = 0; j < 4; ++j) { v[2 * j] = lo16(x0[j]); v[2 * j + 1] = hi16(x0[j]); v[8 + 2 * j] = lo16(x1[j]); v[8 + 2 * j + 1] = hi16(x1[j]); }
            float s = 0.f;
#pragma unroll
            for (int j = 0; j < 16; ++j) s += v[j];
            const float mean = wave_sum(s) * (1.0f / 1024.0f); float q = 0.f;
#pragma unroll
            for (int j = 0; j < 16; ++j) { v[j] -= mean; q += v[j] * v[j]; }
            const float rstd = __builtin_amdgcn_rsqf(wave_sum(q) * (1.0f / 1024.0f) + EPS);
            float uu[16];
#pragma unroll
            for (int j = 0; j < 4; ++j) { uu[2 * j] = lo16(u0[j]); uu[2 * j + 1] = hi16(u0[j]); uu[8 + 2 * j] = lo16(u1[j]); uu[8 + 2 * j + 1] = hi16(u1[j]); }
            float vn[16], mo[16];
#pragma unroll
            for (int j = 0; j < 16; ++j) { vn[j] = v[j] * rstd * gm_ln_g[c0 + j] + gm_ln_b[c0 + j]; mo[j] = uu[j] * (w00 * vn[j] + b0); }
            float* gv = out + O_GMV + (size_t)s_ * 1024 + c0;
#pragma unroll
            for (int j = 0; j < 4; ++j) *(f32x4*)(gv + 4 * j) = (f32x4){vn[4 * j], vn[4 * j + 1], vn[4 * j + 2], vn[4 * j + 3]};
            v4u w0, w1;
#pragma unroll
            for (int j = 0; j < 4; ++j) { w0[j] = pk2(mo[2 * j], mo[2 * j + 1]); w1[j] = pk2(mo[8 + 2 * j], mo[8 + 2 * j + 1]); }
            bf16* mp = MIX + (size_t)row * D + 1024 + c0; *(v4u*)mp = w0; *(v4u*)(mp + 8) = w1; }
    }
    SEAM(2);

    if (IN(3)) {
        LAS bf16* T0 = (LAS bf16*)lds; LAS bf16* T1 = (LAS bf16*)(lds + TILE_B); LAS bf16* T2 = (LAS bf16*)(lds + 2 * TILE_B); LAS bf16* T3 = (LAS bf16*)(lds + 3 * TILE_B);
        for (int u = blk; u < 512; u += G) { const int bh = u >> 4, b = bh >> 3, h = bh & 7, c = u < 256 ? (u & 15) : 15 - (u & 15); const size_t R0 = (size_t)b * SEQ + 128 * c; const float l2g = a.log2g[h];
            const int i_ = 16 * wave + fr;
            RopeX qx, kx; RopeCS cs; TileX vx; v2u gg[8];
            const float* kvb = KV + (size_t)bh * 16 * 16384;
            f32x4 tc[8];
#pragma unroll
            for (int i = 0; i < 8; ++i) tc[i] = *(const f32x4*)(kvb + 4 * (tid + 512 * i));
            rope_load(qx, Z + R0 * NIN + 128 * h, tid); rope_load(kx, Z + R0 * NIN + 1024 + 128 * h, tid); rope_cs_load(cs, ROPE + (size_t)(128 * c) * 128, tid); tile_load(vx, Z + R0 * NIN + 2048 + 128 * h, tid);
            rope_commit<false, false>(T0, qx, cs, 1.0f, 0.f, tid);
            rope_commit<false, false>(T1, kx, cs, 0.08838834764831845f, 0.f, tid);
            asm volatile("" ::: "memory");
            { const float Gc = __builtin_amdgcn_exp2f(l2g * 128.0f);
              f32x4 sp[8];
#pragma unroll
              for (int i = 0; i < 8; ++i) sp[i] = (f32x4){0.f, 0.f, 0.f, 0.f};
              for (int j = 0; j < c; ++j) { f32x4 tn[8];
#pragma unroll
                  for (int i = 0; i < 8; ++i) tn[i] = *(const f32x4*)(kvb + (size_t)(j + 1) * 16384 + 4 * (tid + 512 * i));
#pragma unroll
                  for (int i = 0; i < 8; ++i) { sp[i] = sp[i] * Gc + tc[i]; tc[i] = tn[i]; } }
              if (c == 15) {
#pragma unroll
                  for (int i = 0; i < 8; ++i) *(f32x4*)(out + O_RETP + (size_t)bh * 16384 + 4 * (tid + 512 * i)) = sp[i] * Gc + tc[i]; }
#pragma unroll
              for (int i = 0; i < 8; ++i) { const int ch = tid + 512 * i, d = ch >> 5, e4 = ch & 31;
#pragma unroll
                  for (int t = 0; t < 4; ++t) T3[(4 * e4 + t) * LDP + d] = f2bf(sp[i][t]); } }
            tile_commit_T(T2, vx, tid);
            __syncthreads();
            { const bf16* gp = Z + (R0 + i_) * NIN + 3072 + 128 * h + 4 * fq;
#pragma unroll
              for (int ct = 0; ct < 8; ++ct) gg[ct] = *(const v2u*)(gp + 16 * ct); }
            f32x4 acc2[8], acc1[8];
#pragma unroll
            for (int ct = 0; ct < 8; ++ct) { acc2[ct] = (f32x4){0.f, 0.f, 0.f, 0.f}; acc1[ct] = (f32x4){0.f, 0.f, 0.f, 0.f}; }
            mm128(acc2, T0, T3, wave, fr, fq);
            mm128(acc1, T0, T1, wave, fr, fq);
            __syncthreads();
#pragma unroll
            for (int ct = 0; ct < 8; ++ct) { float sv[4];
#pragma unroll
                for (int t = 0; t < 4; ++t) { const int j = 16 * ct + 4 * fq + t; sv[t] = i_ >= j ? acc1[ct][t] * __builtin_amdgcn_exp2f(l2g * (float)(i_ - j)) : 0.f; }
                v2u w; w.x = pk2(sv[0], sv[1]); w.y = pk2(sv[2], sv[3]); *(LAS v2u*)(T1 + i_ * LDP + 16 * ct + 4 * fq) = w; }
            __syncthreads();
#pragma unroll
            for (int ct = 0; ct < 8; ++ct) acc1[ct] = (f32x4){0.f, 0.f, 0.f, 0.f};
            mm128(acc1, T1, T2, wave, fr, fq);
            const float qd = __builtin_amdgcn_exp2f(l2g * (float)(i_ + 1)); float ssq = 0.f;
#pragma unroll
            for (int ct = 0; ct < 8; ++ct) { acc1[ct] = acc1[ct] + acc2[ct] * qd; ssq += (acc1[ct][0] * acc1[ct][0] + acc1[ct][1] * acc1[ct][1]) + (acc1[ct][2] * acc1[ct][2] + acc1[ct][3] * acc1[ct][3]); }
            ssq += __shfl_xor(ssq, 16); ssq += __shfl_xor(ssq, 32);
            const float rn = __builtin_amdgcn_rsqf(ssq * (1.0f / 128.0f) + EPS);
            bf16* mp = MIX + (R0 + i_) * D + 128 * h + 4 * fq;
#pragma unroll
            for (int ct = 0; ct < 8; ++ct) { v2u w;
                w.x = pk2(acc1[ct][0] * rn * lo16(gg[ct].x), acc1[ct][1] * rn * hi16(gg[ct].x)); w.y = pk2(acc1[ct][2] * rn * lo16(gg[ct].y), acc1[ct][3] * rn * hi16(gg[ct].y)); *(v2u*)(mp + 16 * ct) = w; }
            __syncthreads(); }
        for (int u = blk; u < 512; u += G) { const int b = u >> 7, c = (u >> 3) & 15, grp = u & 7; const size_t R0 = (size_t)b * SEQ + 128 * c;
            const int t_ = 16 * wave + fr, d8 = tid & 15;
            f32x4 wl[4][2]; v4u xv[4]; float st[4][2]; v2u uu[8]; float lg[8], lb[8];
#pragma unroll
            for (int it = 0; it < 4; ++it) { const int idx = tid + 512 * it, t = idx >> 4; const float* wp = gm_ws + (size_t)grp * 16384 + t * 128 + 8 * d8;
                wl[it][0] = *(const f32x4*)wp; wl[it][1] = *(const f32x4*)(wp + 4);
                xv[it] = *(const v4u*)(Z + (R0 + t) * NIN + 5120 + 128 * grp + 8 * d8); st[it][0] = STATS[2 * (R0 + t)]; st[it][1] = STATS[2 * (R0 + t) + 1]; }
#pragma unroll
            for (int j = 0; j < 8; ++j) { lg[j] = gm_ln_g[128 * grp + 8 * d8 + j]; lb[j] = gm_ln_b[128 * grp + 8 * d8 + j]; }
            const float bsv = gm_bs[grp * 128 + t_];
#pragma unroll
            for (int it = 0; it < 4; ++it) { const int idx = tid + 512 * it, t = idx >> 4;
                float wv[8] = {wl[it][0][0], wl[it][0][1], wl[it][0][2], wl[it][0][3], wl[it][1][0], wl[it][1][1], wl[it][1][2], wl[it][1][3]};
#pragma unroll
                for (int j = 0; j < 8; ++j) if (8 * d8 + j > t) wv[j] = 0.f;
                v4u w; w.x = pk2(wv[0], wv[1]); w.y = pk2(wv[2], wv[3]); w.z = pk2(wv[4], wv[5]); w.w = pk2(wv[6], wv[7]); *(LAS v4u*)(T0 + t * LDP + 8 * d8) = w;
                const float mean = st[it][0], rstd = st[it][1];
#pragma unroll
                for (int p = 0; p < 4; ++p) { T1[(8 * d8 + 2 * p) * LDP + t] = f2bf((lo16(xv[it][p]) - mean) * rstd * lg[2 * p] + lb[2 * p]); T1[(8 * d8 + 2 * p + 1) * LDP + t] = f2bf((hi16(xv[it][p]) - mean) * rstd * lg[2 * p + 1] + lb[2 * p + 1]); } }
            __syncthreads();
            { const bf16* up = Z + (R0 + t_) * NIN + 4096 + 128 * grp + 4 * fq;
#pragma unroll
              for (int ct = 0; ct < 8; ++ct) uu[ct] = *(const v2u*)(up + 16 * ct); }
            f32x4 acc[8];
#pragma unroll
            for (int ct = 0; ct < 8; ++ct) acc[ct] = (f32x4){0.f, 0.f, 0.f, 0.f};
            mm128(acc, T0, T1, wave, fr, fq);
            bf16* mp = MIX + (R0 + t_) * D + 1024 + 128 * grp + 4 * fq;
#pragma unroll
            for (int ct = 0; ct < 8; ++ct) { v2u w;
                w.x = pk2((acc[ct][0] + bsv) * lo16(uu[ct].x), (acc[ct][1] + bsv) * hi16(uu[ct].x)); w.y = pk2((acc[ct][2] + bsv) * lo16(uu[ct].y), (acc[ct][3] + bsv) * hi16(uu[ct].y)); *(v2u*)(mp + 16 * ct) = w; }
            __syncthreads(); }
    }
    SEAM(3);

    if (IN(4)) {
        { pg8::Gemm g{MIX, Wo_t, MP, D, D}; pg8::StaticOrder S; S.init(MP, D, G, blk); EpiRes<false> E{x_p, AB, SS1};
          pg8::gemm_phase<EpiRes<false>, pg8::StaticOrder, true, true>(lds, g, S, E); }
        auto f = [&](int s, int n, float v) { const float o = x_s[(size_t)s * D + n] + v; AB[(size_t)(MP + s) * D + n] = f2bf(o);
            const float q = half_wave_sum(o * o); if ((lane & 31) == 0) atomic_addf(SS1 + MP + s, q); };
        skinny_gemm<2>(lds, MIX + (size_t)MP * D, Wo_t, D, D, blk, G, f);
    }
    SEAM(4);

    if (IN(5)) {
        { pg8::Gemm g{AB, Wup_t, MP, NUP, D}; pg8::StaticOrder S; S.init(MP, NUP, G, blk); EpiUp E{ACT, RAW, SS1, conv_w, conv_b};
          pg8::gemm_phase<EpiUp, pg8::StaticOrder, true, true>(lds, g, S, E); }
        auto f = [&](int s, int n, float v) { const int within = n & 255, col = (within >> 7) * DFF + 128 * (n >> 8) + (within & 127);
            AS[(size_t)s * NUP + col] = v * __builtin_amdgcn_rsqf(SS1[MP + s] * (1.0f / D) + EPS); };
        if (blk >= 128) skinny_gemm<8>(lds, AB + (size_t)MP * D, Wup_t, NUP, D, blk - 128, 128, f);
    }
    SEAM(5);

    if (IN(6)) {
        for (int i = gt; i < 128 * 2 * (DFF / 4); i += NGT) { const int c4 = i % (DFF / 4), gr = i / (DFF / 4), rr = gr & 1, Gp = gr >> 1, c = 4 * c4; const bool first = (Gp & 31) == 0;
            const float* rg = RAW + (size_t)Gp * 4 * NUP; const float* rp = rg - 4 * NUP; const f32x4 z4 = {0.f, 0.f, 0.f, 0.f};
            f32x4 a0g, a0u, a1g, a1u, a2g, a2u;
            a0g = *(const f32x4*)(rg + (2 + rr) * NUP + c); a0u = *(const f32x4*)(rg + (2 + rr) * NUP + DFF + c);
            if (rr) { a1g = *(const f32x4*)(rg + 2 * NUP + c); a1u = *(const f32x4*)(rg + 2 * NUP + DFF + c); a2g = first ? z4 : *(const f32x4*)(rp + NUP + c); a2u = first ? z4 : *(const f32x4*)(rp + NUP + DFF + c); }
            else { a1g = first ? z4 : *(const f32x4*)(rp + NUP + c); a1u = first ? z4 : *(const f32x4*)(rp + NUP + DFF + c); a2g = first ? z4 : *(const f32x4*)(rp + c); a2u = first ? z4 : *(const f32x4*)(rp + DFF + c); }
            const f32x4 ag = *(const f32x4*)(conv_w + c) * a2g + *(const f32x4*)(conv_w + NUP + c) * a1g + *(const f32x4*)(conv_w + 2 * NUP + c) * a0g + *(const f32x4*)(conv_b + c);
            const f32x4 au = *(const f32x4*)(conv_w + DFF + c) * a2u + *(const f32x4*)(conv_w + NUP + DFF + c) * a1u + *(const f32x4*)(conv_w + 2 * NUP + DFF + c) * a0u + *(const f32x4*)(conv_b + DFF + c);
            v2u w; w.x = pk2(silu_(ag[0]) * au[0], silu_(ag[1]) * au[1]); w.y = pk2(silu_(ag[2]) * au[2], silu_(ag[3]) * au[3]);
            *(v2u*)(ACT + (size_t)(64 * Gp + rr) * DFF + c) = w; }
        for (int i = gt; i < MS * (DFF / 4); i += NGT) { const int c4 = i % (DFF / 4), s = i / (DFF / 4), c = 4 * c4;
            const float* sc0 = state_conv + (size_t)s * 2 * NUP; const float* sc1 = sc0 + NUP; const float* as = AS + (size_t)s * NUP;
            const f32x4 a0g = *(const f32x4*)(as + c), a0u = *(const f32x4*)(as + DFF + c), a1g = *(const f32x4*)(sc1 + c), a1u = *(const f32x4*)(sc1 + DFF + c), a2g = *(const f32x4*)(sc0 + c), a2u = *(const f32x4*)(sc0 + DFF + c);
            const f32x4 ag = *(const f32x4*)(conv_w + c) * a2g + *(const f32x4*)(conv_w + NUP + c) * a1g + *(const f32x4*)(conv_w + 2 * NUP + c) * a0g + *(const f32x4*)(conv_b + c);
            const f32x4 au = *(const f32x4*)(conv_w + DFF + c) * a2u + *(const f32x4*)(conv_w + NUP + DFF + c) * a1u + *(const f32x4*)(conv_w + 2 * NUP + DFF + c) * a0u + *(const f32x4*)(conv_b + DFF + c);
            v2u w; w.x = pk2(silu_(ag[0]) * au[0], silu_(ag[1]) * au[1]); w.y = pk2(silu_(ag[2]) * au[2], silu_(ag[3]) * au[3]);
            *(v2u*)(ACT + (size_t)(MP + s) * DFF + c) = w;
            float* cs = out + O_CONVS + (size_t)s * 2 * NUP; *(f32x4*)(cs + c) = a1g; *(f32x4*)(cs + DFF + c) = a1u; *(f32x4*)(cs + NUP + c) = a0g; *(f32x4*)(cs + NUP + DFF + c) = a0u; }
        for (int i = gt; i < 4 * 2 * (NUP / 4); i += NGT) { const int c4 = i % (NUP / 4), bk = i / (NUP / 4), b = bk >> 1, k = bk & 1;
            *(f32x4*)(out + O_CONVP + (size_t)bk * NUP + 4 * c4) = *(const f32x4*)(RAW + ((size_t)(32 * b + 31) * 4 + k) * NUP + 4 * c4); }
    }
    SEAM(6);

    if (IN(7)) {
        { pg8::Gemm g{ACT, Wdn_t, MP, D, DFF}; pg8::StaticOrder S; S.init(MP, D, G, blk); EpiRes<true> E{nullptr, AB, SS2};
          pg8::gemm_phase<EpiRes<true>, pg8::StaticOrder, true, true>(lds, g, S, E); }
        auto f = [&](int s, int n, float v) { const size_t o_ = (size_t)(MP + s) * D + n; const float o = bf2f(AB[o_]) + v; AB[o_] = f2bf(o);
            const float q = half_wave_sum(o * o); if ((lane & 31) == 0) atomic_addf(SS2 + MP + s, q); };
        skinny_gemm<2>(lds, ACT + (size_t)MP * DFF, Wdn_t, D, DFF, blk, G, f);
    }
    SEAM(7);

    if (IN(8)) {
#ifndef T_A
        { int Kp = PLE; asm volatile("" : "+s"(Kp));
          pg8::Gemm g{PB, Wp_t, MP, D, Kp}; pg8::StaticOrder S; S.init(MP, D, G, blk); EpiPP E{PP};
          pg8::gemm_phase<EpiPP, pg8::StaticOrder, true, true>(lds, g, S, E); }
#endif
#ifndef T_B
        { pg8::Gemm g{AB, Wg_t, MP, D, D}; pg8::StaticOrder S; S.init(MP, D, G, blk); EpiGate E{PP, AB, out, SS2, SS3};
          pg8::gemm_phase<EpiGate, pg8::StaticOrder, true, true>(lds, g, S, E); }
#endif
#ifndef T_C
        auto f1 = [&](int s, int n, float v) { PP[(size_t)(MP + s) * D + n] = f2bf(v); };
        skinny_gemm<2>(lds, PB + (size_t)MP * PLE, Wp_t, D, PLE, blk, G, f1);
#endif
#ifndef T_D
        auto f2 = [&](int s, int n, float v) { const size_t o_ = (size_t)(MP + s) * D + n; const float r2 = __builtin_amdgcn_rsqf(SS2[MP + s] * (1.0f / D) + EPS);
            const float o = bf2f(AB[o_]) + bf2f(PP[o_]) * sigmoid_(r2 * v); out[o_] = o; const float q = half_wave_sum(o * o); if ((lane & 31) == 0) atomic_addf(SS3 + MP + s, q); };
        skinny_gemm<2>(lds, AB + (size_t)MP * D, Wg_t, D, D, blk, G, f2);
#endif
    }
    SEAM(8);

    if (IN(9)) {
        for (int m = gw; m < MT; m += NGW) { f32x4* hr = (f32x4*)(out + (size_t)m * D) + lane; const f32x4* gr = (const f32x4*)g_final + lane;
            const float r = __builtin_amdgcn_rsqf(SS3[m] * (1.0f / D) + EPS);
#pragma unroll
            for (int j = 0; j < 8; ++j) hr[64 * j] = hr[64 * j] * gr[64 * j] * r; }
    }
#undef IN
#undef SEAM
}

extern "C" void kernel_launch(void* const* d_in, const int* in_sizes, int n_in, void* d_out, int out_size, void* d_ws, size_t ws_size, hipStream_t stream) {
    static int grid = 0;
    if (grid == 0) {
        if (n_in != 22 || out_size != (int)O_END || ws_size < WS_END) { fprintf(stderr, "kernel_launch: unexpected shapes: n_in %d out %d ws %zu\n", n_in, out_size, ws_size); grid = -1; return; }
        int dev = 0, cus = 0, per_cu = 0;
        if (hipGetDevice(&dev) != hipSuccess || hipDeviceGetAttribute(&cus, hipDeviceAttributeMultiprocessorCount, dev) != hipSuccess) { grid = -1; return; }
        if (hipFuncSetAttribute((const void*)mk_fwd, hipFuncAttributeMaxDynamicSharedMemorySize, LDS_BYTES) != hipSuccess) { fprintf(stderr, "kernel_launch: hipFuncSetAttribute failed\n"); grid = -1; return; }
        if (hipOccupancyMaxActiveBlocksPerMultiprocessor(&per_cu, (const void*)mk_fwd, 512, LDS_BYTES) != hipSuccess || per_cu < 1) fprintf(stderr, "kernel_launch: occupancy query says %d\n", per_cu);
        (void)hipGetLastError();
        grid = cus;
        if (grid != 256) fprintf(stderr, "kernel_launch: %d CUs (built for 256)\n", grid);
    }
    if (grid < 0) return;
    if (hipMemsetAsync((char*)d_ws + WS_BAR, 0, BAR_BYTES, stream) != hipSuccess) { fprintf(stderr, "kernel_launch: memset failed\n"); return; }
    Params p{};
    for (int i = 0; i < 22; ++i) p.in[i] = (const float*)d_in[i];
    p.out = (float*)d_out; p.ws = (unsigned char*)d_ws;
    for (int h = 0; h < 8; ++h) p.log2g[h] = (float)std::log2(1.0 - std::exp2(-5.0 - (double)h));
    for (int i = 0; i < 64; ++i) p.invf[i] = powf(10000.0f, -(float)i / 64.0f);
    p.use_cg = 0; p.pad = 0;
#if MK_N_LAUNCHES == 1
    void* args[] = {&p};
#ifdef PROBE_K
    p.ph_lo = 0; p.ph_hi = PROBE_K + 1;
    (void)hipLaunchCooperativeKernel((const void*)mk_fwd, dim3(grid), dim3(512), args, LDS_BYTES, stream);
    if (hipMemsetAsync((char*)d_ws + WS_BAR, 0, BAR_BYTES, stream) != hipSuccess) return;
#endif
    p.ph_lo = 0; p.ph_hi = NPHASE;
    hipError_t e = hipLaunchCooperativeKernel((const void*)mk_fwd, dim3(grid), dim3(512), args, LDS_BYTES, stream);
    if (e != hipSuccess) fprintf(stderr, "kernel_launch: cooperative launch failed: %s\n", hipGetErrorString(e));
#else
    for (int ph = 0; ph < NPHASE; ++ph) { p.ph_lo = ph; p.ph_hi = ph + 1; hipLaunchKernelGGL(mk_fwd, dim3(grid), dim3(512), LDS_BYTES, stream, p); }
#endif
}
```

```cpp
#include <hip/hip_runtime.h>
#include <hip/hip_cooperative_groups.h>
#include <cstdio>
#include <cstdint>
#include <cmath>
namespace cg = cooperative_groups;

#ifndef MK_N_LAUNCHES
#define MK_N_LAUNCHES 1
#endif

namespace pg8 {
#define PG8_LAS __attribute__((address_space(3)))
typedef unsigned short bf16_t;
typedef short bf16x8 __attribute__((ext_vector_type(8)));
typedef float f32x4 __attribute__((ext_vector_type(4)));
typedef unsigned u32x4 __attribute__((ext_vector_type(4)));
constexpr int BM = 256, BK = 64, HALF = 128, HTB = HALF * BK * 2  , STAGE_BYTES = 8 * HTB, NXCD = 8, WGM = 8;

__host__ __device__ __forceinline__ int lds_byte(int r, int c) { const int st = (r >> 4) * 2 + (c >> 5), rr = r & 15, cc = c & 31, ob = rr * 64 + cc * 2; return st * 1024 + (ob ^ (((ob >> 9) & 1) << 5)); }
__host__ __device__ __forceinline__ void stage_rc(int b, int& R, int& C) { const int st = b / 1024, sb = b % 1024, swz = sb ^ (((sb >> 9) & 1) << 5); R = (st >> 1) * 16 + swz / 64; C = (st & 1) * 32 + (swz % 64) / 2; }
__host__ __device__ __forceinline__ int perm32(int rho) { const int n = rho >> 4, i = rho & 15; return 8 * (i >> 2) + 4 * n + (i & 3); }

struct Unit { int pm, pn; };
struct Gemm { const bf16_t* A; const bf16_t* Bt; int M, N, K; };

struct StaticOrder {
    int nM, nN, nwg, G, c;
    __host__ __device__ void init(int M, int N, int G_, int c_) { nM = M / BM; nN = N / BM; nwg = nM * nN; G = G_; c = c_; }
    __host__ __device__ bool next(int i, Unit& u) const {
        const long L = (long)i * G + c; if (L >= nwg) return false;
        int wgid = (int)L; { const int q = nwg / NXCD, r = nwg % NXCD, xcd = wgid % NXCD, off = wgid / NXCD; wgid = (xcd < r ? xcd * (q + 1) : r * (q + 1) + (xcd - r) * q) + off; }
        const int nig = WGM * nN, gid = wgid / nig, fm = gid * WGM, gsz = (nM - fm) < WGM ? (nM - fm) : WGM;
        u.pm = fm + ((wgid % nig) % gsz); u.pn = (wgid % nig) / gsz; return true;
    }
    __device__ __forceinline__ void a_ready(const Unit&) const {}
    __device__ __forceinline__ void done(const Unit&) const {}
};

__device__ __forceinline__ unsigned cvt_pk_bf16(float lo, float hi) { unsigned r; asm volatile("v_cvt_pk_bf16_f32 %0, %1, %2" : "=v"(r) : "v"(lo), "v"(hi)); return r; }
typedef float f32x2 __attribute__((ext_vector_type(2)));

template <class Epi, class Sched, bool ALIGN_EPI = false, bool SP2 = false>
__device__ __forceinline__ void gemm_phase(PG8_LAS unsigned char* lds, const Gemm g, const Sched& S, const Epi& E) {
    const int tid = threadIdx.x, wid = __builtin_amdgcn_readfirstlane(tid >> 6), lane = tid & 63, wr = wid >> 2, wc = wid & 3, fr = lane & 15, fq = lane >> 4;
    const int K = g.K, nt = K / BK;
    unsigned voffA[2], voffB[2];
#pragma unroll
    for (int i = 0; i < 2; ++i) { int R, C; stage_rc(tid * 16 + i * 8192, R, C); const int Rb = Epi::PERM ? ((R & ~31) + perm32(R & 31)) : R;
        voffA[i] = (unsigned)(R * K + C) * 2u; voffB[i] = (unsigned)(Rb * K + C) * 2u; }
    const size_t kstep = (size_t)(BK * 2);
    const size_t hstep = (size_t)HALF * K * 2;
    const size_t tstep = 2 * hstep;
    const unsigned ldsw = (unsigned)wid * 1024u;
    const int aoff = lds_byte(wr * 64 + fr, fq * 8), boff = lds_byte(wc * 32 + fr, fq * 8);
#define PG8_SA(b, h) (((b) * 2 + (h)) * HTB)
#define PG8_SB(b, h) ((4 + (b) * 2 + (h)) * HTB)
#define PG8_STAGE(bufoff, gbase, voff) do { _Pragma("unroll") for (int _i = 0; _i < 2; ++_i) \
        __builtin_amdgcn_global_load_lds((const unsigned*)((const char*)(gbase) + (voff)[_i]), (PG8_LAS unsigned*)(lds + (bufoff) + ldsw + _i * 8192), 16, 0, 0); } while (0)
#define PG8_LDA(dst, b, h) do { _Pragma("unroll") for (int m = 0; m < 4; ++m) _Pragma("unroll") for (int k = 0; k < 2; ++k) dst[m][k] = *(const PG8_LAS bf16x8*)(lds + PG8_SA(b, h) + aoff + m * 2048 + k * 1024); } while (0)
#define PG8_LDB(dst, b, h) do { _Pragma("unroll") for (int n = 0; n < 2; ++n) _Pragma("unroll") for (int k = 0; k < 2; ++k) dst[n][k] = *(const PG8_LAS bf16x8*)(lds + PG8_SB(b, h) + boff + n * 2048 + k * 1024); } while (0)
#define PG8_MMA(ai, bj, At, Bt) do { __builtin_amdgcn_s_setprio(1); _Pragma("unroll") for (int m = 0; m < 4; ++m) _Pragma("unroll") for (int n = 0; n < 2; ++n) _Pragma("unroll") for (int k = 0; k < 2; ++k) \
        acc[ai][bj][m][n] = __builtin_amdgcn_mfma_f32_16x16x32_bf16(Bt[n][k], At[m][k], acc[ai][bj][m][n], 0, 0, 0); __builtin_amdgcn_s_setprio(0); } while (0)
#define PG8_WAIT_V(n) asm volatile("s_waitcnt vmcnt(" #n ")" ::: "memory")
#define PG8_WAIT_L(n) asm volatile("s_waitcnt lgkmcnt(" #n ")" ::: "memory")
#define PG8_BAR __builtin_amdgcn_s_barrier()
#define PG8_SCHED __builtin_amdgcn_sched_barrier(0)
    Unit cur, nxt; int ui = 0;
    if (!S.next(0, cur)) return;
    f32x4 acc[2][2][4][2];
#pragma unroll
    for (int a = 0; a < 2; ++a)
#pragma unroll
        for (int b = 0; b < 2; ++b)
#pragma unroll
            for (int m = 0; m < 4; ++m)
#pragma unroll
                for (int n = 0; n < 2; ++n) acc[a][b][m][n] = (f32x4){0.f, 0.f, 0.f, 0.f};
    bf16x8 At[4][2], B0[2][2], B1[2][2];
    const char* cA = (const char*)g.A + (size_t)cur.pm * tstep; const char* cB = (const char*)g.Bt + (size_t)cur.pn * tstep;
    S.a_ready(cur);
    if constexpr (SP2) {
        PG8_STAGE(PG8_SB(0, 0), cB, voffB); PG8_STAGE(PG8_SB(0, 1), cB + hstep, voffB); PG8_STAGE(PG8_SA(0, 0), cA, voffA); PG8_STAGE(PG8_SA(0, 1), cA + hstep, voffA);
        if (wr == 1) PG8_BAR;
        PG8_WAIT_V(2); PG8_BAR;
        PG8_STAGE(PG8_SB(1, 0), cB + kstep, voffB); PG8_STAGE(PG8_SA(1, 0), cA + kstep, voffA); PG8_STAGE(PG8_SB(1, 1), cB + hstep + kstep, voffB);
        PG8_WAIT_V(6); PG8_BAR;
    } else {
        PG8_STAGE(PG8_SB(0, 0), cB, voffB); PG8_STAGE(PG8_SA(0, 0), cA, voffA); PG8_STAGE(PG8_SB(0, 1), cB + hstep, voffB); PG8_STAGE(PG8_SA(0, 1), cA + hstep, voffA);
        if (wr == 1) PG8_BAR;
        PG8_WAIT_V(4); PG8_BAR;
        PG8_STAGE(PG8_SB(1, 0), cB + kstep, voffB); PG8_STAGE(PG8_SA(1, 0), cA + kstep, voffA); PG8_STAGE(PG8_SB(1, 1), cB + hstep + kstep, voffB);
        PG8_WAIT_V(6); PG8_BAR;
    }
    for (;;) {
        const bool has_next = S.next(ui + 1, nxt);
        const char* nA = has_next ? (const char*)g.A + (size_t)nxt.pm * tstep : cA; const char* nB = has_next ? (const char*)g.Bt + (size_t)nxt.pn * tstep : cB;
        for (int t = 0; t < nt; t += 2) {
            const bool last = (t == nt - 2);
            const char* a1 = cA + (size_t)(t + 1) * kstep;
            const char* a2 = last ? nA : cA + (size_t)(t + 2) * kstep; const char* b2 = last ? nB : cB + (size_t)(t + 2) * kstep;
            const char* a3 = a2 + kstep; const char* b3 = b2 + kstep;
            if (last && has_next) S.a_ready(nxt);
            if constexpr (SP2) {
            PG8_LDB(B0, 0, 0); PG8_LDB(B1, 0, 1); PG8_SCHED; PG8_LDA(At, 0, 0); PG8_STAGE(PG8_SA(1, 1), a1 + hstep, voffA);
            PG8_WAIT_V(8); PG8_WAIT_L(0); PG8_BAR; PG8_MMA(0, 0, At, B0); PG8_MMA(0, 1, At, B1); PG8_BAR; PG8_SCHED;
            PG8_LDA(At, 0, 1); PG8_STAGE(PG8_SB(0, 0), b2, voffB); PG8_STAGE(PG8_SB(0, 1), b2 + hstep, voffB); PG8_STAGE(PG8_SA(0, 0), a2, voffA);
            PG8_WAIT_V(8); PG8_WAIT_L(0); PG8_BAR; PG8_MMA(1, 0, At, B0); PG8_MMA(1, 1, At, B1); PG8_BAR; PG8_SCHED;
            PG8_LDB(B0, 1, 0); PG8_LDB(B1, 1, 1); PG8_SCHED; PG8_LDA(At, 1, 0); PG8_STAGE(PG8_SA(0, 1), a2 + hstep, voffA);
            PG8_WAIT_V(8); PG8_WAIT_L(0); PG8_BAR; PG8_MMA(0, 0, At, B0); PG8_MMA(0, 1, At, B1); PG8_BAR; PG8_SCHED;
            PG8_LDA(At, 1, 1); PG8_STAGE(PG8_SB(1, 0), b3, voffB); PG8_STAGE(PG8_SB(1, 1), b3 + hstep, voffB); PG8_STAGE(PG8_SA(1, 0), a3, voffA);
            PG8_WAIT_V(8); PG8_WAIT_L(0); PG8_BAR; PG8_MMA(1, 0, At, B0); PG8_MMA(1, 1, At, B1); PG8_BAR; PG8_SCHED;
            } else {
            PG8_LDB(B0, 0, 0); PG8_SCHED; PG8_LDA(At, 0, 0); PG8_STAGE(PG8_SA(1, 1), a1 + hstep, voffA);
            PG8_WAIT_L(8); PG8_BAR; PG8_WAIT_L(0); PG8_MMA(0, 0, At, B0); PG8_BAR; PG8_SCHED;
            PG8_LDB(B1, 0, 1); PG8_STAGE(PG8_SB(0, 0), b2, voffB);
            PG8_BAR; PG8_WAIT_L(0); PG8_MMA(0, 1, At, B1); PG8_BAR;
            PG8_LDA(At, 0, 1); PG8_STAGE(PG8_SA(0, 0), a2, voffA);
            PG8_BAR; PG8_WAIT_L(0); PG8_MMA(1, 0, At, B0); PG8_BAR; PG8_SCHED;
            PG8_STAGE(PG8_SB(0, 1), b2 + hstep, voffB);
            PG8_WAIT_V(6); PG8_BAR; PG8_MMA(1, 1, At, B1); PG8_BAR;
            PG8_LDB(B0, 1, 0); PG8_SCHED; PG8_LDA(At, 1, 0); PG8_STAGE(PG8_SA(0, 1), a2 + hstep, voffA);
            PG8_WAIT_L(8); PG8_BAR; PG8_WAIT_L(0); PG8_MMA(0, 0, At, B0); PG8_BAR; PG8_SCHED;
            PG8_LDB(B1, 1, 1); PG8_STAGE(PG8_SB(1, 0), b3, voffB);
            PG8_BAR; PG8_WAIT_L(0); PG8_MMA(0, 1, At, B1); PG8_BAR;
            PG8_LDA(At, 1, 1); PG8_STAGE(PG8_SA(1, 0), a3, voffA);
            PG8_BAR; PG8_WAIT_L(0); PG8_MMA(1, 0, At, B0); PG8_BAR; PG8_SCHED;
            PG8_STAGE(PG8_SB(1, 1), b3 + hstep, voffB);
            PG8_WAIT_V(6); PG8_BAR; PG8_MMA(1, 1, At, B1); PG8_BAR;
            }
        }
        if constexpr (ALIGN_EPI) { if (wr == 0) PG8_BAR; }
        if constexpr (!Epi::AFTER_DRAIN) { E(acc, cur, wr, wc, fr, fq); S.done(cur); }
        if (!has_next) break;
#pragma unroll
        for (int a = 0; a < 2; ++a)
#pragma unroll
            for (int b = 0; b < 2; ++b)
#pragma unroll
                for (int m = 0; m < 4; ++m)
#pragma unroll
                    for (int n = 0; n < 2; ++n) acc[a][b][m][n] = (f32x4){0.f, 0.f, 0.f, 0.f};
        cur = nxt; cA = nA; cB = nB; ++ui;
        if constexpr (ALIGN_EPI) { if (wr == 1) PG8_BAR; }
    }
    PG8_WAIT_V(0);
    if constexpr (!ALIGN_EPI) { if (wr == 0) PG8_BAR; }
    PG8_BAR;
    if constexpr (Epi::AFTER_DRAIN) { E.fused(acc, cur, wr, wc, fr, fq, lds, wid, lane); S.done(cur); }
#undef PG8_SA
#undef PG8_SB
#undef PG8_STAGE
#undef PG8_LDA
#undef PG8_LDB
#undef PG8_MMA
#undef PG8_WAIT_V
#undef PG8_WAIT_L
#undef PG8_BAR
#undef PG8_SCHED
}
}

#define GAS __attribute__((address_space(1)))
#define LAS __attribute__((address_space(3)))
typedef unsigned short bf16;
typedef unsigned v4u __attribute__((ext_vector_type(4)));
typedef unsigned v2u __attribute__((ext_vector_type(2)));
typedef float f32x4 __attribute__((ext_vector_type(4)));
typedef float f32x2 __attribute__((ext_vector_type(2)));
typedef short bf16x8 __attribute__((ext_vector_type(8)));
#define XB_TMO      128
#define XB_XCNT(j)  (256  + 64 * (j))
#define XB_XSUB(j)  (1280 + 64 * (j))
#define XB_XGEN(j)  (2304 + 64 * (j))
#define XB_TOP      3328
#define XB_TOPGEN   3392
#define XCD_BAR_WORDS 3456
#define XB_SPIN_CAP (1u << 18)

__device__ __forceinline__ unsigned xb_ld(unsigned* p)              { return __hip_atomic_load(p, __ATOMIC_RELAXED, __HIP_MEMORY_SCOPE_AGENT); }
__device__ __forceinline__ unsigned xb_add(unsigned* p, unsigned v) { return __hip_atomic_fetch_add(p, v, __ATOMIC_RELAXED, __HIP_MEMORY_SCOPE_AGENT); }
__device__ __forceinline__ unsigned xb_xcc_id() { return (unsigned)__builtin_amdgcn_s_getreg((3 << 11) | 20) & 0xFu; }
#define XB_SPIN(cond, bar) do { unsigned _sp = 0; while (cond) { __builtin_amdgcn_s_sleep(1); \
    if ((++_sp & 255u) == 0u) { if (xb_ld(&(bar)[XB_TMO])) break; if (_sp > XB_SPIN_CAP) { atomicAdd(&(bar)[XB_TMO], 1u); break; } } } } while (0)

struct XcdBarrier {
    unsigned* bar; unsigned x;
    volatile LAS unsigned* st;
};

__device__ __forceinline__ XcdBarrier xcd_barrier_post(unsigned* bar, volatile LAS unsigned* st) {
    XcdBarrier b; b.bar = bar; b.x = xb_xcc_id(); b.st = st;
    if (threadIdx.x == 0) (void)xb_add(&bar[XB_XCNT(b.x)], 1u);
    return b;
}
__device__ __forceinline__ void xcd_barrier_complete(unsigned* bar, unsigned x, unsigned& nloc, unsigned& nx) {
    const unsigned G = gridDim.x * gridDim.y * gridDim.z;
    unsigned sum, cnt, mine, sp = 0u;
    for (;;) {
        sum = 0u; cnt = 0u; mine = 0u;
#pragma unroll
        for (unsigned j = 0; j < 16; ++j) { const unsigned c = xb_ld(&bar[XB_XCNT(j)]); sum += c; cnt += (c > 0u) ? 1u : 0u; mine = (j == x) ? c : mine; }
        if (sum == G) break;
        __builtin_amdgcn_s_sleep(1);
        if ((++sp & 255u) == 0u) { if (xb_ld(&bar[XB_TMO])) break; if (sp > XB_SPIN_CAP) { atomicAdd(&bar[XB_TMO], 1u); break; } }
    }
    nloc = mine > 0u ? mine : 1u; nx = cnt > 0u ? cnt : 1u;
}

__device__ __forceinline__ void xcd_barrier(const XcdBarrier& b) {
    asm volatile("s_waitcnt vmcnt(0)" ::: "memory");
    __syncthreads();
    if (threadIdx.x == 0) {
        unsigned* bar = b.bar;
        __builtin_amdgcn_s_waitcnt(0);
        unsigned nloc = b.st[0], nx = b.st[1];
        if (nloc == 0u) { xcd_barrier_complete(bar, b.x, nloc, nx); b.st[0] = nloc; b.st[1] = nx; }
        const unsigned old = xb_add(&bar[XB_XSUB(b.x)], 1u);
        const unsigned gen = old / nloc;
        if (old + 1u == (gen + 1u) * nloc) {
            __builtin_amdgcn_fence(__ATOMIC_RELEASE, "agent");
            asm volatile("s_waitcnt vmcnt(0)" ::: "memory");
            const unsigned og = xb_add(&bar[XB_TOP], 1u);
            const unsigned tg = og / nx;
            if (og + 1u == (tg + 1u) * nx) xb_add(&bar[XB_TOPGEN], 1u);
            else XB_SPIN(xb_ld(&bar[XB_TOPGEN]) == tg, bar);
            __builtin_amdgcn_fence(__ATOMIC_ACQUIRE, "agent");
            xb_add(&bar[XB_XGEN(b.x)], 1u);
            asm volatile("s_waitcnt vmcnt(0)" ::: "memory");
        } else {
            XB_SPIN(xb_ld(&bar[XB_XGEN(b.x)]) == gen, bar);
            __builtin_amdgcn_fence(__ATOMIC_ACQUIRE, "agent");
            asm volatile("s_waitcnt vmcnt(0)" ::: "memory");
        }
    }
    __syncthreads();
}

constexpr int MP = 8192, MS = 128, MT = MP + MS, D = 2048, NIN = 6144, NUP = 11264, DFF = 5632, PLE = 256, SEQ = 2048, NH = 8;
constexpr float EPS = 1e-6f;
constexpr int NPHASE = 10;
constexpr size_t MiB = 1u << 20;
constexpr size_t WS_BAR = 0, BAR_BYTES = 16384;
constexpr size_t WS_SS1 = 64 * 1024, WS_SS2 = 128 * 1024, WS_SS3 = 192 * 1024, WS_STATS = 256 * 1024;
constexpr size_t WS_ROPE = 1 * MiB, WS_ROPES = 2 * MiB;
constexpr size_t WS_WIN = 4 * MiB, WS_WO = 28 * MiB, WS_WUP = 36 * MiB, WS_WDN = 80 * MiB, WS_WG = 102 * MiB, WS_WP = 110 * MiB;
constexpr size_t WS_AB = 112 * MiB, WS_PB = 145 * MiB, WS_MIX = 150 * MiB, WS_Z = 183 * MiB, WS_ACT = 183 * MiB, WS_KV = 281 * MiB, WS_PP = 281 * MiB;
constexpr size_t WS_RAW = 313 * MiB, WS_AS = 335 * MiB, WS_END = 346 * MiB;
static_assert(WS_AB + (size_t)MT * D * 2 <= WS_PB && WS_PB + (size_t)MT * PLE * 2 <= WS_MIX && WS_MIX + (size_t)MT * D * 2 <= WS_Z, "ws map 1");
static_assert(WS_Z + (size_t)MT * NIN * 2 <= WS_KV && WS_ACT + (size_t)MT * DFF * 2 <= WS_KV && WS_KV + (size_t)512 * 16384 * 4 <= WS_RAW, "ws map 2");
static_assert(WS_RAW + (size_t)128 * 4 * NUP * 4 <= WS_AS && WS_AS + (size_t)MS * NUP * 4 <= WS_END && WS_PP + (size_t)MT * D * 4 <= WS_END, "ws map 3");
constexpr size_t O_RETP = 17039360, O_CONVP = 17563648, O_RETS = 17653760, O_CONVS = 34430976, O_GMV = 37314560, O_END = 37445632;
constexpr int LDS_BYTES = 147456, MISC_OFF = LDS_BYTES - 256;
constexpr int LDP = 136;
constexpr int TILE_B = 128 * LDP * 2;

struct Params { const float* in[22]; float* out; unsigned char* ws; float log2g[8]; float invf[64]; int ph_lo, ph_hi, use_cg, pad; };

#define LDS_WAIT() asm volatile("s_waitcnt lgkmcnt(0)" ::: "memory")
__device__ __forceinline__ float lo16(unsigned u) { return __uint_as_float(u << 16); }
__device__ __forceinline__ float hi16(unsigned u) { return __uint_as_float(u & 0xffff0000u); }
__device__ __forceinline__ float bf2f(bf16 b) { return __uint_as_float((unsigned)b << 16); }
__device__ __forceinline__ unsigned pk2(float lo, float hi) { return pg8::cvt_pk_bf16(lo, hi); }
__device__ __forceinline__ bf16 f2bf(float f) { return (bf16)(pg8::cvt_pk_bf16(f, 0.f) & 0xffffu); }
__device__ __forceinline__ float sigmoid_(float x) { return __builtin_amdgcn_rcpf(1.0f + __builtin_amdgcn_exp2f(-1.44269504089f * x)); }
__device__ __forceinline__ float silu_(float x) { return x * sigmoid_(x); }
__device__ __forceinline__ float gelu_(float x) { return x * sigmoid_(1.5957691216f * (x + 0.044715f * x * x * x)); }
__device__ __forceinline__ float wave_sum(float v) {
#pragma unroll
    for (int o = 1; o < 64; o <<= 1) v += __shfl_xor(v, o);
    return v;
}
__device__ __forceinline__ void atomic_addf(float* p, float v) { (void)__hip_atomic_fetch_add(p, v, __ATOMIC_RELAXED, __HIP_MEMORY_SCOPE_AGENT); }
template <int CTRL> __device__ __forceinline__ float dppf(float x) { return __int_as_float(__builtin_amdgcn_update_dpp(0, __float_as_int(x), CTRL, 0xf, 0xf, false)); }

using pg8::Unit;
struct EpiZ {
    static constexpr bool PERM = true, AFTER_DRAIN = false;
    bf16* Z;
    __device__ __forceinline__ void operator()(const f32x4 (&acc)[2][2][4][2], const Unit& u, int wr, int wc, int fr, int fq) const {
        const int row0 = u.pm * 256 + wr * 64 + fr, col0 = u.pn * 256 + wc * 32 + 8 * fq;
        const int mode = u.pn < 12 ? 0 : (u.pn < 16 ? 1 : 2);
#pragma unroll
        for (int ai = 0; ai < 2; ++ai)
#pragma unroll
            for (int m = 0; m < 4; ++m) { bf16* rowp = Z + (size_t)(row0 + ai * 128 + m * 16) * NIN + col0;
#pragma unroll
                for (int bj = 0; bj < 2; ++bj) { f32x4 v0 = acc[ai][bj][m][0], v1 = acc[ai][bj][m][1];
                    if (mode == 1) {
#pragma unroll
                        for (int j = 0; j < 4; ++j) { v0[j] = silu_(v0[j]); v1[j] = silu_(v1[j]); } }
                    else if (mode == 2) {
#pragma unroll
                        for (int j = 0; j < 4; ++j) { v0[j] = gelu_(v0[j]); v1[j] = gelu_(v1[j]); } }
                    v4u w; w.x = pk2(v0[0], v0[1]); w.y = pk2(v0[2], v0[3]); w.z = pk2(v1[0], v1[1]); w.w = pk2(v1[2], v1[3]);
                    *(v4u*)(rowp + bj * 128) = w; } }
    }
};
template <bool BASE_BF16> struct EpiRes {
    static constexpr bool PERM = true, AFTER_DRAIN = false;
    const float* base; bf16* hb; float* ss;
    __device__ __forceinline__ void operator()(const f32x4 (&acc)[2][2][4][2], const Unit& u, int wr, int wc, int fr, int fq) const {
        const int row0 = u.pm * 256 + wr * 64 + fr, col0 = u.pn * 256 + wc * 32 + 8 * fq;
        float sacc[2][4];
#pragma unroll
        for (int ai = 0; ai < 2; ++ai) {
            f32x4 bs[4][2][2];
#pragma unroll
            for (int m = 0; m < 4; ++m)
#pragma unroll
                for (int bj = 0; bj < 2; ++bj) { const size_t o_ = (size_t)(row0 + ai * 128 + m * 16) * D + col0 + bj * 128;
                    if (BASE_BF16) { const v4u w = *(const v4u*)(hb + o_); bs[m][bj][0] = (f32x4){lo16(w.x), hi16(w.x), lo16(w.y), hi16(w.y)}; bs[m][bj][1] = (f32x4){lo16(w.z), hi16(w.z), lo16(w.w), hi16(w.w)}; }
                    else { bs[m][bj][0] = *(const f32x4*)(base + o_); bs[m][bj][1] = *(const f32x4*)(base + o_ + 4); } }
#pragma unroll
            for (int m = 0; m < 4; ++m) { const size_t off = (size_t)(row0 + ai * 128 + m * 16) * D + col0; float s = 0.f;
#pragma unroll
                for (int bj = 0; bj < 2; ++bj) { const f32x4 o0 = bs[m][bj][0] + acc[ai][bj][m][0], o1 = bs[m][bj][1] + acc[ai][bj][m][1];
                    v4u w; w.x = pk2(o0[0], o0[1]); w.y = pk2(o0[2], o0[3]); w.z = pk2(o1[0], o1[1]); w.w = pk2(o1[2], o1[3]); *(v4u*)(hb + off + bj * 128) = w;
                    s += ((o0[0] * o0[0] + o0[1] * o0[1]) + (o0[2] * o0[2] + o0[3] * o0[3])) + ((o1[0] * o1[0] + o1[1] * o1[1]) + (o1[2] * o1[2] + o1[3] * o1[3])); }
                s += __shfl_xor(s, 16); s += __shfl_xor(s, 32); sacc[ai][m] = s; }
            asm volatile("" ::: "memory"); }
        if (fq == 0) {
#pragma unroll
            for (int ai = 0; ai < 2; ++ai)
#pragma unroll
                for (int m = 0; m < 4; ++m) atomic_addf(ss + row0 + ai * 128 + m * 16, sacc[ai][m]); }
    }
};
struct EpiPP {
    static constexpr bool PERM = true, AFTER_DRAIN = false;
    bf16* pp;
    __device__ __forceinline__ void operator()(const f32x4 (&acc)[2][2][4][2], const Unit& u, int wr, int wc, int fr, int fq) const {
        const int row0 = u.pm * 256 + wr * 64 + fr, col0 = u.pn * 256 + wc * 32 + 8 * fq;
#pragma unroll
        for (int ai = 0; ai < 2; ++ai)
#pragma unroll
            for (int m = 0; m < 4; ++m) { bf16* rowp = pp + (size_t)(row0 + ai * 128 + m * 16) * D + col0;
#pragma unroll
                for (int bj = 0; bj < 2; ++bj) { const f32x4 v0 = acc[ai][bj][m][0], v1 = acc[ai][bj][m][1]; v4u w; w.x = pk2(v0[0], v0[1]); w.y = pk2(v0[2], v0[3]); w.z = pk2(v1[0], v1[1]); w.w = pk2(v1[2], v1[3]); *(v4u*)(rowp + bj * 128) = w; } }
    }
};
struct EpiGate {
    static constexpr bool PERM = true, AFTER_DRAIN = false;
    const bf16* pp; const bf16* hb; float* h; const float* ss2; float* ss3;
    __device__ __forceinline__ void operator()(const f32x4 (&acc)[2][2][4][2], const Unit& u, int wr, int wc, int fr, int fq) const {
        const int row0 = u.pm * 256 + wr * 64 + fr, col0 = u.pn * 256 + wc * 32 + 8 * fq;
        float sacc[2][4];
#pragma unroll
        for (int ai = 0; ai < 2; ++ai) {
            v4u hw[4][2], pw[4][2]; float r2[4];
#pragma unroll
            for (int m = 0; m < 4; ++m) { const int row = row0 + ai * 128 + m * 16; r2[m] = ss2[row];
#pragma unroll
                for (int bj = 0; bj < 2; ++bj) { hw[m][bj] = *(const v4u*)(hb + (size_t)row * D + col0 + bj * 128); pw[m][bj] = *(const v4u*)(pp + (size_t)row * D + col0 + bj * 128); } }
#pragma unroll
            for (int m = 0; m < 4; ++m) { const size_t off = (size_t)(row0 + ai * 128 + m * 16) * D + col0; float s = 0.f;
                const float rr = __builtin_amdgcn_rsqf(r2[m] * (1.0f / D) + EPS);
#pragma unroll
                for (int bj = 0; bj < 2; ++bj) { const v4u h4 = hw[m][bj], p4 = pw[m][bj];
                    const f32x4 hv0 = {lo16(h4.x), hi16(h4.x), lo16(h4.y), hi16(h4.y)}, hv1 = {lo16(h4.z), hi16(h4.z), lo16(h4.w), hi16(h4.w)};
                    const f32x4 pv0 = {lo16(p4.x), hi16(p4.x), lo16(p4.y), hi16(p4.y)}, pv1 = {lo16(p4.z), hi16(p4.z), lo16(p4.w), hi16(p4.w)};
                    const f32x4 a0 = acc[ai][bj][m][0], a1 = acc[ai][bj][m][1]; f32x4 o0, o1;
#pragma unroll
                    for (int j = 0; j < 4; ++j) { o0[j] = hv0[j] + pv0[j] * sigmoid_(rr * a0[j]); o1[j] = hv1[j] + pv1[j] * sigmoid_(rr * a1[j]); }
                    *(f32x4*)(h + off + bj * 128) = o0; *(f32x4*)(h + off + bj * 128 + 4) = o1;
                    s += ((o0[0] * o0[0] + o0[1] * o0[1]) + (o0[2] * o0[2] + o0[3] * o0[3])) + ((o1[0] * o1[0] + o1[1] * o1[1]) + (o1[2] * o1[2] + o1[3] * o1[3])); }
                s += __shfl_xor(s, 16); s += __shfl_xor(s, 32); sacc[ai][m] = s; }
            asm volatile("" ::: "memory"); }
        if (fq == 0) {
#pragma unroll
            for (int ai = 0; ai < 2; ++ai)
#pragma unroll
                for (int m = 0; m < 4; ++m) atomic_addf(ss3 + row0 + ai * 128 + m * 16, sacc[ai][m]); }
    }
};
struct EpiUp {
    static constexpr bool PERM = false, AFTER_DRAIN = false;
    bf16* act; float* raw; const float* ss1; const float* cw; const float* cb;
    __device__ __forceinline__ void operator()(const f32x4 (&acc)[2][2][4][2], const Unit& u, int wr, int wc, int fr, int fq) const {
        const int row0 = u.pm * 256 + wr * 64 + fr;
        float rs[2][4];
#pragma unroll
        for (int ai = 0; ai < 2; ++ai)
#pragma unroll
            for (int m = 0; m < 4; ++m) rs[ai][m] = __builtin_amdgcn_rsqf(ss1[row0 + ai * 128 + m * 16] * (1.0f / D) + EPS);
#pragma unroll
        for (int n = 0; n < 2; ++n) {
            const int cg_ = u.pn * 128 + wc * 32 + 16 * n + 4 * fq;
            const f32x4 w0g = *(const f32x4*)(cw + cg_), w1g = *(const f32x4*)(cw + NUP + cg_), w2g = *(const f32x4*)(cw + 2 * NUP + cg_), bg = *(const f32x4*)(cb + cg_);
            const f32x4 w0u = *(const f32x4*)(cw + DFF + cg_), w1u = *(const f32x4*)(cw + NUP + DFF + cg_), w2u = *(const f32x4*)(cw + 2 * NUP + DFF + cg_), bu = *(const f32x4*)(cb + DFF + cg_);
#pragma unroll
            for (int ai = 0; ai < 2; ++ai) {
                f32x4 pg = {0.f, 0.f, 0.f, 0.f}, pu = {0.f, 0.f, 0.f, 0.f};
#pragma unroll
                for (int m = 0; m < 4; ++m) {
                    const int row = row0 + ai * 128 + m * 16;
                    const f32x4 g = acc[ai][0][m][n] * rs[ai][m], up = acc[ai][1][m][n] * rs[ai][m];
                    if (m == 0 && fr < 2) { float* rp = raw + ((size_t)(row >> 6) * 4 + 2 + fr) * NUP + cg_; *(f32x4*)rp = g; *(f32x4*)(rp + DFF) = up; }
                    if (m == 3 && fr >= 14) { float* rp = raw + ((size_t)(row >> 6) * 4 + (fr - 14)) * NUP + cg_; *(f32x4*)rp = g; *(f32x4*)(rp + DFF) = up; }
                    f32x4 o;
#pragma unroll
                    for (int j = 0; j < 4; ++j) {
                        const float g1 = dppf<0x121>(fr == 15 ? pg[j] : g[j]), g2 = dppf<0x122>(fr >= 14 ? pg[j] : g[j]);
                        const float u1 = dppf<0x121>(fr == 15 ? pu[j] : up[j]), u2 = dppf<0x122>(fr >= 14 ? pu[j] : up[j]);
                        const float ag = w0g[j] * g2 + w1g[j] * g1 + w2g[j] * g[j] + bg[j];
                        const float au = w0u[j] * u2 + w1u[j] * u1 + w2u[j] * up[j] + bu[j];
                        o[j] = silu_(ag) * au; }
                    v2u w; w.x = pk2(o[0], o[1]); w.y = pk2(o[2], o[3]);
                    *(v2u*)(act + (size_t)row * DFF + cg_) = w;
                    pg = g; pu = up; } } }
    }
};

template <int RT, class F>
__device__ __forceinline__ void skinny_gemm(LAS unsigned char* lds, const bf16* A, const bf16* Bt, int N, int K, int u0, int ustride, const F& f) {
    const int tid = threadIdx.x, lane = tid & 63, w = tid >> 6, fr = lane & 15, fq = lane >> 4;
    constexpr int nrb = 8 / RT, ROWS = 16 * RT;
    const int nunits = nrb * (N / 32), kw = K / 8;
    LAS float* red = (LAS float*)lds;
    for (int u = u0; u < nunits; u += ustride) {
        const int rb = u % nrb, cb = u / nrb, row0 = rb * ROWS, col0 = cb * 32;
        f32x4 acc[RT][2];
#pragma unroll
        for (int rt = 0; rt < RT; ++rt) { acc[rt][0] = (f32x4){0.f, 0.f, 0.f, 0.f}; acc[rt][1] = (f32x4){0.f, 0.f, 0.f, 0.f}; }
        const bf16* ap = A + (size_t)(row0 + fr) * K + w * kw + 8 * fq;
        const bf16* bp = Bt + (size_t)(col0 + fr) * K + w * kw + 8 * fq;
        if constexpr (RT <= 2) {
            int k = 0;
            for (; k + 256 <= kw; k += 256) { bf16x8 bq[8][2], aq[8][RT];
#pragma unroll
                for (int kk = 0; kk < 8; ++kk) { bq[kk][0] = *(const bf16x8*)(bp + k + 32 * kk); bq[kk][1] = *(const bf16x8*)(bp + (size_t)16 * K + k + 32 * kk);
#pragma unroll
                    for (int rt = 0; rt < RT; ++rt) aq[kk][rt] = *(const bf16x8*)(ap + (size_t)rt * 16 * K + k + 32 * kk); }
#pragma unroll
                for (int kk = 0; kk < 8; ++kk)
#pragma unroll
                    for (int rt = 0; rt < RT; ++rt) { acc[rt][0] = __builtin_amdgcn_mfma_f32_16x16x32_bf16(bq[kk][0], aq[kk][rt], acc[rt][0], 0, 0, 0); acc[rt][1] = __builtin_amdgcn_mfma_f32_16x16x32_bf16(bq[kk][1], aq[kk][rt], acc[rt][1], 0, 0, 0); } }
            for (; k < kw; k += 32) { const bf16x8 b0 = *(const bf16x8*)(bp + k), b1 = *(const bf16x8*)(bp + (size_t)16 * K + k);
#pragma unroll
                for (int rt = 0; rt < RT; ++rt) { const bf16x8 av = *(const bf16x8*)(ap + (size_t)rt * 16 * K + k);
                    acc[rt][0] = __builtin_amdgcn_mfma_f32_16x16x32_bf16(b0, av, acc[rt][0], 0, 0, 0); acc[rt][1] = __builtin_amdgcn_mfma_f32_16x16x32_bf16(b1, av, acc[rt][1], 0, 0, 0); } }
        } else {
#pragma unroll 2
        for (int k = 0; k < kw; k += 32) {
            const bf16x8 b0 = *(const bf16x8*)(bp + k), b1 = *(const bf16x8*)(bp + (size_t)16 * K + k);
#pragma unroll
            for (int rt = 0; rt < RT; ++rt) { const bf16x8 av = *(const bf16x8*)(ap + (size_t)rt * 16 * K + k);
                acc[rt][0] = __builtin_amdgcn_mfma_f32_16x16x32_bf16(b0, av, acc[rt][0], 0, 0, 0);
                acc[rt][1] = __builtin_amdgcn_mfma_f32_16x16x32_bf16(b1, av, acc[rt][1], 0, 0, 0); }
        }
        }
#pragma unroll
        for (int rt = 0; rt < RT; ++rt)
#pragma unroll
            for (int ct = 0; ct < 2; ++ct) *(LAS f32x4*)(red + (w * ROWS + 16 * rt + fr) * 32 + 16 * ct + 4 * fq) = acc[rt][ct];
        __syncthreads();
#pragma unroll
        for (int it = 0; it < RT; ++it) { const int e = tid + 512 * it, r = e >> 5, c = e & 31; float v = 0.f;
#pragma unroll
            for (int ww = 0; ww < 8; ++ww) v += red[(ww * ROWS + r) * 32 + c];
            f(row0 + r, col0 + c, v); }
        __syncthreads();
    }
}
__device__ __forceinline__ float half_wave_sum(float v) {
#pragma unroll
    for (int o = 1; o < 32; o <<= 1) v += __shfl_xor(v, o);
    return v;
}

__device__ __forceinline__ void transpose_item(const float* W, int K, int N, const float* g, bf16* WT, bool upmap, LAS float* scr, int item, int lane) {
    const int nblk = N / 64, kb = item / nblk, nb = item % nblk, k0 = 64 * kb, n0 = 64 * nb;
    const float* src = W + (size_t)k0 * N + n0 + lane;
#pragma unroll
    for (int h = 0; h < 2; ++h) {
        float v[32];
#pragma unroll
        for (int i = 0; i < 32; ++i) v[i] = __builtin_nontemporal_load(src + (size_t)(32 * h + i) * N);
#pragma unroll
        for (int i = 0; i < 32; ++i) { float x = v[i]; if (g) x *= g[k0 + 32 * h + i]; scr[(32 * h + i) * 65 + lane] = x; }
    }
    LDS_WAIT(); asm volatile("" ::: "memory");
    const int c = lane & 7;
#pragma unroll
    for (int j = 0; j < 8; ++j) { const int n = (lane >> 3) + 8 * j; const LAS float* s = scr + (8 * c) * 65 + n;
        v4u o; o.x = pk2(s[0 * 65], s[1 * 65]); o.y = pk2(s[2 * 65], s[3 * 65]); o.z = pk2(s[4 * 65], s[5 * 65]); o.w = pk2(s[6 * 65], s[7 * 65]);
        int R = n0 + n; if (upmap) { const int half = R >= DFF ? 1 : 0, jj = R - half * DFF; R = 256 * (jj >> 7) + 128 * half + (jj & 127); }
        *(v4u*)(WT + (size_t)R * K + k0 + 8 * c) = o; }
    LDS_WAIT(); asm volatile("" ::: "memory");
}
__device__ __forceinline__ void rms_row_to_bf16(const float* xrow, bf16* orow, int lane) {
    const f32x4* xr = (const f32x4*)xrow + lane;
    f32x4 v[8]; float s = 0.f;
#pragma unroll
    for (int j = 0; j < 8; ++j) { v[j] = xr[64 * j]; s += (v[j][0] * v[j][0] + v[j][1] * v[j][1]) + (v[j][2] * v[j][2] + v[j][3] * v[j][3]); }
    const float r = __builtin_amdgcn_rsqf(wave_sum(s) * (1.0f / D) + EPS);
    v2u* o8 = (v2u*)orow + lane;
#pragma unroll
    for (int j = 0; j < 8; ++j) { v2u w; w.x = pk2(v[j][0] * r, v[j][1] * r); w.y = pk2(v[j][2] * r, v[j][3] * r); o8[64 * j] = w; }
}

__device__ __forceinline__ void mm128(f32x4 (&acc)[8], const LAS bf16* A, const LAS bf16* B, int wave, int fr, int fq) {
#pragma unroll
    for (int ks = 0; ks < 4; ++ks) {
        const bf16x8 a = *(const LAS bf16x8*)(A + (16 * wave + fr) * LDP + 32 * ks + 8 * fq);
#pragma unroll
        for (int ct = 0; ct < 8; ++ct) { const bf16x8 b = *(const LAS bf16x8*)(B + (16 * ct + fr) * LDP + 32 * ks + 8 * fq);
            acc[ct] = __builtin_amdgcn_mfma_f32_16x16x32_bf16(b, a, acc[ct], 0, 0, 0); }
    }
}
template <bool TRANS, bool DEC>
__device__ __forceinline__ void stage_rope(LAS bf16* dst, const bf16* zb, const float* rope, float scale, float l2g, int tid) {
#pragma unroll
    for (int it = 0; it < 2; ++it) { const int idx = tid + 512 * it, j = idx >> 3, d8 = idx & 7;
        const v4u x1 = *(const v4u*)(zb + (size_t)j * NIN + 8 * d8), x2 = *(const v4u*)(zb + (size_t)j * NIN + 64 + 8 * d8);
        const f32x4* rp = (const f32x4*)(rope + (size_t)(j * 64 + 8 * d8) * 2);
        float sc = scale; if (DEC) sc *= __builtin_amdgcn_exp2f(l2g * (float)(127 - j));
        float o1[8], o2[8];
#pragma unroll
        for (int p = 0; p < 4; ++p) { const f32x4 cs = rp[p]; const float a0 = lo16(x1[p]), a1 = hi16(x1[p]), b0 = lo16(x2[p]), b1 = hi16(x2[p]);
            o1[2 * p] = (a0 * cs[0] - b0 * cs[1]) * sc; o2[2 * p] = (b0 * cs[0] + a0 * cs[1]) * sc;
            o1[2 * p + 1] = (a1 * cs[2] - b1 * cs[3]) * sc; o2[2 * p + 1] = (b1 * cs[2] + a1 * cs[3]) * sc; }
        if (!TRANS) { v4u w1, w2;
#pragma unroll
            for (int p = 0; p < 4; ++p) { w1[p] = pk2(o1[2 * p], o1[2 * p + 1]); w2[p] = pk2(o2[2 * p], o2[2 * p + 1]); }
            *(LAS v4u*)(dst + j * LDP + 8 * d8) = w1; *(LAS v4u*)(dst + j * LDP + 64 + 8 * d8) = w2; }
        else {
#pragma unroll
            for (int i = 0; i < 8; ++i) { dst[(8 * d8 + i) * LDP + j] = f2bf(o1[i]); dst[(64 + 8 * d8 + i) * LDP + j] = f2bf(o2[i]); } }
    }
}
__device__ __forceinline__ void stage_T(LAS bf16* dst, const bf16* zb, int tid) {
#pragma unroll
    for (int it = 0; it < 4; ++it) { const int idx = tid + 512 * it, j = idx >> 4, c8 = idx & 15;
        const v4u x = *(const v4u*)(zb + (size_t)j * NIN + 8 * c8);
#pragma unroll
        for (int p = 0; p < 4; ++p) { dst[(8 * c8 + 2 * p) * LDP + j] = (bf16)(x[p] & 0xffffu); dst[(8 * c8 + 2 * p + 1) * LDP + j] = (bf16)(x[p] >> 16); } }
}


struct RopeX { v4u x1[2], x2[2]; };
struct RopeCS { f32x4 cs[2][4]; };
struct TileX { v4u x[4]; };
__device__ __forceinline__ void rope_load(RopeX& r, const bf16* zb, int tid) {
#pragma unroll
    for (int it = 0; it < 2; ++it) { const int idx = tid + 512 * it, j = idx >> 3, d8 = idx & 7; r.x1[it] = *(const v4u*)(zb + (size_t)j * NIN + 8 * d8); r.x2[it] = *(const v4u*)(zb + (size_t)j * NIN + 64 + 8 * d8); }
}
__device__ __forceinline__ void rope_cs_load(RopeCS& c, const float* rope, int tid) {
#pragma unroll
    for (int it = 0; it < 2; ++it) { const int idx = tid + 512 * it, j = idx >> 3, d8 = idx & 7; const f32x4* rp = (const f32x4*)(rope + (size_t)(j * 64 + 8 * d8) * 2);
#pragma unroll
        for (int p = 0; p < 4; ++p) c.cs[it][p] = rp[p]; }
}
template <bool TRANS, bool DEC>
__device__ __forceinline__ void rope_commit(LAS bf16* dst, const RopeX& r, const RopeCS& c, float scale, float l2g, int tid) {
#pragma unroll
    for (int it = 0; it < 2; ++it) { const int idx = tid + 512 * it, j = idx >> 3, d8 = idx & 7;
        float sc = scale; if (DEC) sc *= __builtin_amdgcn_exp2f(l2g * (float)(127 - j));
        float o1[8], o2[8];
#pragma unroll
        for (int p = 0; p < 4; ++p) { const f32x4 cs = c.cs[it][p]; const float a0 = lo16(r.x1[it][p]), a1 = hi16(r.x1[it][p]), b0 = lo16(r.x2[it][p]), b1 = hi16(r.x2[it][p]);
            o1[2 * p] = (a0 * cs[0] - b0 * cs[1]) * sc; o2[2 * p] = (b0 * cs[0] + a0 * cs[1]) * sc;
            o1[2 * p + 1] = (a1 * cs[2] - b1 * cs[3]) * sc; o2[2 * p + 1] = (b1 * cs[2] + a1 * cs[3]) * sc; }
        if (!TRANS) { v4u w1, w2;
#pragma unroll
            for (int p = 0; p < 4; ++p) { w1[p] = pk2(o1[2 * p], o1[2 * p + 1]); w2[p] = pk2(o2[2 * p], o2[2 * p + 1]); }
            *(LAS v4u*)(dst + j * LDP + 8 * d8) = w1; *(LAS v4u*)(dst + j * LDP + 64 + 8 * d8) = w2; }
        else {
#pragma unroll
            for (int i = 0; i < 8; ++i) { dst[(8 * d8 + i) * LDP + j] = f2bf(o1[i]); dst[(64 + 8 * d8 + i) * LDP + j] = f2bf(o2[i]); } }
    }
}
__device__ __forceinline__ void tile_load(TileX& t, const bf16* zb, int tid) {
#pragma unroll
    for (int it = 0; it < 4; ++it) { const int idx = tid + 512 * it, j = idx >> 4, c8 = idx & 15; t.x[it] = *(const v4u*)(zb + (size_t)j * NIN + 8 * c8); }
}
__device__ __forceinline__ void tile_commit_T(LAS bf16* dst, const TileX& t, int tid) {
#pragma unroll
    for (int it = 0; it < 4; ++it) { const int idx = tid + 512 * it, j = idx >> 4, c8 = idx & 15;
#pragma unroll
        for (int p = 0; p < 4; ++p) { dst[(8 * c8 + 2 * p) * LDP + j] = (bf16)(t.x[it][p] & 0xffffu); dst[(8 * c8 + 2 * p + 1) * LDP + j] = (bf16)(t.x[it][p] >> 16); } }
}

__global__ void __launch_bounds__(512, 2) mk_fwd(Params a) {
    extern __shared__ __attribute__((aligned(16))) unsigned char lds_raw[];
    LAS unsigned char* lds = (LAS unsigned char*)lds_raw;
    const int tid = threadIdx.x, lane = tid & 63, wave = __builtin_amdgcn_readfirstlane(tid >> 6), fr = lane & 15, fq = lane >> 4;
    const int G = gridDim.x, blk = blockIdx.x;
    const int gw = blk * 8 + wave, NGW = G * 8;
    const int gt = blk * 512 + tid, NGT = G * 512;
    unsigned char* ws = a.ws;
    const float* x_p = a.in[0]; const float* x_s = a.in[1]; const float* p_p = a.in[2]; const float* p_s = a.in[3];
    const float* state_ret = a.in[4]; const float* state_conv = a.in[5];
    const float* gm_ln_g = a.in[8]; const float* gm_ln_b = a.in[9]; const float* gm_ws = a.in[10]; const float* gm_bs = a.in[11];
    const float* conv_w = a.in[15]; const float* conv_b = a.in[16]; const float* g_final = a.in[21];
    float* out = a.out;
    float* SS1 = (float*)(ws + WS_SS1); float* SS2 = (float*)(ws + WS_SS2); float* SS3 = (float*)(ws + WS_SS3); float* STATS = (float*)(ws + WS_STATS);
    float* ROPE = (float*)(ws + WS_ROPE); float* ROPES = (float*)(ws + WS_ROPES);
    bf16* Win_t = (bf16*)(ws + WS_WIN); bf16* Wo_t = (bf16*)(ws + WS_WO); bf16* Wup_t = (bf16*)(ws + WS_WUP); bf16* Wdn_t = (bf16*)(ws + WS_WDN); bf16* Wg_t = (bf16*)(ws + WS_WG); bf16* Wp_t = (bf16*)(ws + WS_WP);
    bf16* AB = (bf16*)(ws + WS_AB); bf16* PB = (bf16*)(ws + WS_PB); bf16* MIX = (bf16*)(ws + WS_MIX); bf16* Z = (bf16*)(ws + WS_Z); bf16* ACT = (bf16*)(ws + WS_ACT);
    float* KV = (float*)(ws + WS_KV); bf16* PP = (bf16*)(ws + WS_PP); float* RAW = (float*)(ws + WS_RAW); float* AS = (float*)(ws + WS_AS);

    volatile LAS unsigned* MISC = (volatile LAS unsigned*)(lds + MISC_OFF);
    if (tid < 64) MISC[tid] = 0u;
    __syncthreads();
    XcdBarrier bar; bar.bar = (unsigned*)(ws + WS_BAR); bar.x = 0; bar.st = nullptr;
    if (MK_N_LAUNCHES == 1) bar = xcd_barrier_post((unsigned*)(ws + WS_BAR), MISC + 8);
    const int lo = a.ph_lo, hi = a.ph_hi;
#ifndef PHMASK
#define PHMASK 0xffff
#endif
#define IN(k) (((PHMASK >> (k)) & 1) && lo <= (k) && (k) < hi)
#define SEAM(k) do { if (IN(k) && IN((k) + 1)) { if (a.use_cg) cg::this_grid().sync(); else xcd_barrier(bar); } } while (0)

    if (IN(0)) {
        LAS float* scr = (LAS float*)(lds + wave * 16640);
        constexpr int I_IN = (D / 64) * (NIN / 64), I_O = (D / 64) * (D / 64), I_UP = (D / 64) * (NUP / 64), I_DN = (DFF / 64) * (D / 64), I_G = I_O, I_P = (PLE / 64) * (D / 64);
        constexpr int NITEMS = I_IN + I_O + I_UP + I_DN + I_G + I_P;
        for (int it = gw; it < NITEMS; it += NGW) {
            int r = it;
            if (r < I_UP) { transpose_item(a.in[14], D, NUP, a.in[13], Wup_t, true, scr, r, lane); continue; } r -= I_UP;
            if (r < I_IN) { transpose_item(a.in[7], D, NIN, a.in[6], Win_t, false, scr, r, lane); continue; } r -= I_IN;
            if (r < I_DN) { transpose_item(a.in[17], DFF, D, nullptr, Wdn_t, false, scr, r, lane); continue; } r -= I_DN;
            if (r < I_O) { transpose_item(a.in[12], D, D, nullptr, Wo_t, false, scr, r, lane); continue; } r -= I_O;
            if (r < I_G) { transpose_item(a.in[19], D, D, a.in[18], Wg_t, false, scr, r, lane); continue; } r -= I_G;
            transpose_item(a.in[20], PLE, D, nullptr, Wp_t, false, scr, r, lane);
        }
        for (int m = gw; m < MT; m += NGW) rms_row_to_bf16(m < MP ? x_p + (size_t)m * D : x_s + (size_t)(m - MP) * D, AB + (size_t)m * D, lane);
        for (int i = gt; i < MT * PLE / 4; i += NGT) { const f32x4 v = i < MP * PLE / 4 ? ((const f32x4*)p_p)[i] : ((const f32x4*)p_s)[i - MP * PLE / 4]; v2u w; w.x = pk2(v[0], v[1]); w.y = pk2(v[2], v[3]); ((v2u*)PB)[i] = w; }
        for (int i = gt; i < SEQ * 64 + 64; i += NGT) { const int pos = i < SEQ * 64 ? (i >> 6) : 16384, fi = i & 63;
            const float ang = (float)pos * a.invf[fi]; double t = (double)ang * 0.15915494309189535; t -= __builtin_rint(t); const float rev = (float)t;
            float* dst = i < SEQ * 64 ? ROPE + 2 * (size_t)i : ROPES + 2 * fi; dst[0] = __builtin_amdgcn_cosf(rev); dst[1] = __builtin_amdgcn_sinf(rev); }
        for (int i = gt; i < MT; i += NGT) { SS1[i] = 0.f; SS2[i] = 0.f; SS3[i] = 0.f; }
    }
    SEAM(0);

    if (IN(1)) {
        { pg8::Gemm g{AB, Win_t, MP, NIN, D}; pg8::StaticOrder S; S.init(MP, NIN, G, blk); EpiZ E{Z};
          pg8::gemm_phase<EpiZ, pg8::StaticOrder, true, true>(lds, g, S, E); }
        auto f = [&](int s, int n, float v) { const float o = n < 3072 ? v : (n < 4096 ? silu_(v) : gelu_(v)); Z[(size_t)(MP + s) * NIN + n] = f2bf(o); };
        skinny_gemm<8>(lds, AB + (size_t)MP * D, Win_t, NIN, D, blk, G, f);
    }
    SEAM(1);

    if (IN(2)) {
        { LAS float* qs = (LAS float*)lds; LAS float* ks = qs + 128; LAS float* vs = ks + 128; LAS float* red = vs + 128;
          const int e4 = tid & 31, dg = tid >> 5;
          for (int u = blk; u < MS * NH; u += G) { const int s = u >> 3, h = u & 7; const bf16* zr = Z + (size_t)(MP + s) * NIN;
            const float* S0 = state_ret + (size_t)u * 16384 + 4 * e4; float* S1 = out + O_RETS + (size_t)u * 16384 + 4 * e4;
            f32x4 s0[8];
#pragma unroll
            for (int i = 0; i < 8; ++i) s0[i] = __builtin_nontemporal_load((const f32x4*)(S0 + (dg + 16 * i) * 128));
            if (tid < 64) { const float c = ROPES[2 * tid], sn = ROPES[2 * tid + 1];
                const float q1 = bf2f(zr[128 * h + tid]), q2 = bf2f(zr[128 * h + 64 + tid]), k1 = bf2f(zr[1024 + 128 * h + tid]), k2 = bf2f(zr[1024 + 128 * h + 64 + tid]);
                qs[tid] = q1 * c - q2 * sn; qs[tid + 64] = q2 * c + q1 * sn; ks[tid] = (k1 * c - k2 * sn) * 0.08838834764831845f; ks[tid + 64] = (k2 * c + k1 * sn) * 0.08838834764831845f; }
            else if (tid < 192) vs[tid - 64] = bf2f(zr[2048 + 128 * h + tid - 64]);
            unsigned gg = 0u; if (tid < 64) gg = *(const unsigned*)(zr + 3072 + 128 * h + 2 * tid);
            __syncthreads();
            const float gamma = 1.0f - __builtin_amdgcn_exp2f((float)(-5 - h));
            const f32x4 vv = *(const LAS f32x4*)(vs + 4 * e4); f32x4 o = {0.f, 0.f, 0.f, 0.f};
#pragma unroll
            for (int i = 0; i < 8; ++i) { const int d = dg + 16 * i; const f32x4 sn = s0[i] * gamma + vv * ks[d]; __builtin_nontemporal_store(sn, (f32x4*)(S1 + d * 128)); o += sn * qs[d]; }
            *(LAS f32x4*)(red + dg * 128 + 4 * e4) = o;
            __syncthreads();
            if (tid < 64) { float o0 = 0.f, o1 = 0.f;
#pragma unroll
                for (int i = 0; i < 16; ++i) { o0 += red[i * 128 + 2 * tid]; o1 += red[i * 128 + 2 * tid + 1]; }
                const float r = __builtin_amdgcn_rsqf(wave_sum(o0 * o0 + o1 * o1) * (1.0f / 128.0f) + EPS);
                *(unsigned*)(MIX + (size_t)(MP + s) * D + 128 * h + 2 * tid) = pk2(o0 * r * lo16(gg), o1 * r * hi16(gg)); }
            __syncthreads(); } }
        { LAS bf16* Kt = (LAS bf16*)lds; LAS bf16* Vt = (LAS bf16*)(lds + TILE_B);
          for (int u = blk; u < 512; u += G) { const int b = u >> 7, h = (u >> 4) & 7, c = u & 15; const size_t R0 = (size_t)b * SEQ + 128 * c;
            RopeX kx; RopeCS cs; TileX vx;
            rope_load(kx, Z + R0 * NIN + 1024 + 128 * h, tid); rope_cs_load(cs, ROPE + (size_t)(128 * c) * 128, tid); tile_load(vx, Z + R0 * NIN + 2048 + 128 * h, tid);
            rope_commit<true, true>(Kt, kx, cs, 0.08838834764831845f, a.log2g[h], tid);
            tile_commit_T(Vt, vx, tid);
            __syncthreads();
            f32x4 acc[8];
#pragma unroll
            for (int ct = 0; ct < 8; ++ct) acc[ct] = (f32x4){0.f, 0.f, 0.f, 0.f};
            mm128(acc, Kt, Vt, wave, fr, fq);
            float* kv = KV + (size_t)u * 16384 + (16 * wave + fr) * 128 + 4 * fq;
#pragma unroll
            for (int ct = 0; ct < 8; ++ct) *(f32x4*)(kv + 16 * ct) = acc[ct];
            __syncthreads(); } }
        for (int r0 = gw; r0 < MP; r0 += 2 * NGW) { const int r1 = r0 + NGW;
            const bf16* p0 = Z + (size_t)r0 * NIN + 5120 + 16 * lane; const bf16* p1 = Z + (size_t)(r1 < MP ? r1 : r0) * NIN + 5120 + 16 * lane;
            const v4u xa0 = *(const v4u*)p0, xa1 = *(const v4u*)(p0 + 8), xb0 = *(const v4u*)p1, xb1 = *(const v4u*)(p1 + 8);
            float va[16], vb[16];
#pragma unroll
            for (int j = 0; j < 4; ++j) { va[2 * j] = lo16(xa0[j]); va[2 * j + 1] = hi16(xa0[j]); va[8 + 2 * j] = lo16(xa1[j]); va[8 + 2 * j + 1] = hi16(xa1[j]);
                                          vb[2 * j] = lo16(xb0[j]); vb[2 * j + 1] = hi16(xb0[j]); vb[8 + 2 * j] = lo16(xb1[j]); vb[8 + 2 * j + 1] = hi16(xb1[j]); }
            float sa = 0.f, sb = 0.f;
#pragma unroll
            for (int j = 0; j < 16; ++j) { sa += va[j]; sb += vb[j]; }
            const float ma = wave_sum(sa) * (1.0f / 1024.0f), mb = wave_sum(sb) * (1.0f / 1024.0f); float qa = 0.f, qb = 0.f;
#pragma unroll
            for (int j = 0; j < 16; ++j) { const float da = va[j] - ma, db = vb[j] - mb; qa += da * da; qb += db * db; }
            const float ra = __builtin_amdgcn_rsqf(wave_sum(qa) * (1.0f / 1024.0f) + EPS), rb = __builtin_amdgcn_rsqf(wave_sum(qb) * (1.0f / 1024.0f) + EPS);
            if (lane == 0) { STATS[2 * r0] = ma; STATS[2 * r0 + 1] = ra; if (r1 < MP) { STATS[2 * r1] = mb; STATS[2 * r1 + 1] = rb; } } }
        for (int row = MP + gw; row < MT; row += NGW) { const bf16* p = Z + (size_t)row * NIN + 5120 + 16 * lane; const v4u x0 = *(const v4u*)p, x1 = *(const v4u*)(p + 8);
            const int s_ = row - MP, c0 = 16 * lane, grp = lane >> 3; const float w00 = gm_ws[grp * 16384], b0 = gm_bs[grp * 128];
            const bf16* up = Z + (size_t)row * NIN + 4096 + c0; const v4u u0 = *(const v4u*)up, u1 = *(const v4u*)(up + 8);
            float v[16];
#pragma unroll
            for (int j = 0; j < 4; ++j) { v[2 * j] = lo16(x0[j]); v[2 * j + 1] = hi16(x0[j]); v[8 + 2 * j] = lo16(x1[j]); v[8 + 2 * j + 1] = hi16(x1[j]); }
            float s = 0.f;
#pragma unroll
            for (int j = 0; j < 16; ++j) s += v[j];
            const float mean = wave_sum(s) * (1.0f / 1024.0f); float q = 0.f;
#pragma unroll
            for (int j = 0; j < 16; ++j) { v[j] -= mean; q += v[j] * v[j]; }
            const float rstd = __builtin_amdgcn_rsqf(wave_sum(q) * (1.0f / 1024.0f) + EPS);
            float uu[16];
#pragma unroll
            for (int j = 0; j < 4; ++j) { uu[2 * j] = lo16(u0[j]); uu[2 * j + 1] = hi16(u0[j]); uu[8 + 2 * j] = lo16(u1[j]); uu[8 + 2 * j + 1] = hi16(u1[j]); }
            float vn[16], mo[16];
#pragma unroll
            for (int j = 0; j < 16; ++j) { vn[j] = v[j] * rstd * gm_ln_g[c0 + j] + gm_ln_b[c0 + j]; mo[j] = uu[j] * (w00 * vn[j] + b0); }
            float* gv = out + O_GMV + (size_t)s_ * 1024 + c0;
#pragma unroll
            for (int j = 0; j < 4; ++j) *(f32x4*)(gv + 4 * j) = (f32x4){vn[4 * j], vn[4 * j + 1], vn[4 * j + 2], vn[4 * j + 3]};
            v4u w0, w1;
#pragma unroll
            for (int j = 0; j < 4; ++j) { w0[j] = pk2(mo[2 * j], mo[2 * j + 1]); w1[j] = pk2(mo[8 + 2 * j], mo[8 + 2 * j + 1]); }
            bf16* mp = MIX + (size_t)row * D + 1024 + c0; *(v4u*)mp = w0; *(v4u*)(mp + 8) = w1; }
    }
    SEAM(2);

    if (IN(3)) {
        LAS bf16* T0 = (LAS bf16*)lds; LAS bf16* T1 = (LAS bf16*)(lds + TILE_B); LAS bf16* T2 = (LAS bf16*)(lds + 2 * TILE_B); LAS bf16* T3 = (LAS bf16*)(lds + 3 * TILE_B);
        for (int u = blk; u < 512; u += G) { const int bh = u >> 4, b = bh >> 3, h = bh & 7, c = u < 256 ? (u & 15) : 15 - (u & 15); const size_t R0 = (size_t)b * SEQ + 128 * c; const float l2g = a.log2g[h];
            const int i_ = 16 * wave + fr;
            RopeX qx, kx; RopeCS cs; TileX vx; v2u gg[8];
            const float* kvb = KV + (size_t)bh * 16 * 16384;
            f32x4 tc[8];
#pragma unroll
            for (int i = 0; i < 8; ++i) tc[i] = *(const f32x4*)(kvb + 4 * (tid + 512 * i));
            rope_load(qx, Z + R0 * NIN + 128 * h, tid); rope_load(kx, Z + R0 * NIN + 1024 + 128 * h, tid); rope_cs_load(cs, ROPE + (size_t)(128 * c) * 128, tid); tile_load(vx, Z + R0 * NIN + 2048 + 128 * h, tid);
            rope_commit<false, false>(T0, qx, cs, 1.0f, 0.f, tid);
            rope_commit<false, false>(T1, kx, cs, 0.08838834764831845f, 0.f, tid);
            asm volatile("" ::: "memory");
            { const float Gc = __builtin_amdgcn_exp2f(l2g * 128.0f);
              f32x4 sp[8];
#pragma unroll
              for (int i = 0; i < 8; ++i) sp[i] = (f32x4){0.f, 0.f, 0.f, 0.f};
              for (int j = 0; j < c; ++j) { f32x4 tn[8];
#pragma unroll
                  for (int i = 0; i < 8; ++i) tn[i] = *(const f32x4*)(kvb + (size_t)(j + 1) * 16384 + 4 * (tid + 512 * i));
#pragma unroll
                  for (int i = 0; i < 8; ++i) { sp[i] = sp[i] * Gc + tc[i]; tc[i] = tn[i]; } }
              if (c == 15) {
#pragma unroll
                  for (int i = 0; i < 8; ++i) *(f32x4*)(out + O_RETP + (size_t)bh * 16384 + 4 * (tid + 512 * i)) = sp[i] * Gc + tc[i]; }
#pragma unroll
              for (int i = 0; i < 8; ++i) { const int ch = tid + 512 * i, d = ch >> 5, e4 = ch & 31;
#pragma unroll
                  for (int t = 0; t < 4; ++t) T3[(4 * e4 + t) * LDP + d] = f2bf(sp[i][t]); } }
            tile_commit_T(T2, vx, tid);
            __syncthreads();
            { const bf16* gp = Z + (R0 + i_) * NIN + 3072 + 128 * h + 4 * fq;
#pragma unroll
              for (int ct = 0; ct < 8; ++ct) gg[ct] = *(const v2u*)(gp + 16 * ct); }
            f32x4 acc2[8], acc1[8];
#pragma unroll
            for (int ct = 0; ct < 8; ++ct) { acc2[ct] = (f32x4){0.f, 0.f, 0.f, 0.f}; acc1[ct] = (f32x4){0.f, 0.f, 0.f, 0.f}; }
            mm128(acc2, T0, T3, wave, fr, fq);
            mm128(acc1, T0, T1, wave, fr, fq);
            __syncthreads();
#pragma unroll
            for (int ct = 0; ct < 8; ++ct) { float sv[4];
#pragma unroll
                for (int t = 0; t < 4; ++t) { const int j = 16 * ct + 4 * fq + t; sv[t] = i_ >= j ? acc1[ct][t] * __builtin_amdgcn_exp2f(l2g * (float)(i_ - j)) : 0.f; }
                v2u w; w.x = pk2(sv[0], sv[1]); w.y = pk2(sv[2], sv[3]); *(LAS v2u*)(T1 + i_ * LDP + 16 * ct + 4 * fq) = w; }
            __syncthreads();
#pragma unroll
            for (int ct = 0; ct < 8; ++ct) acc1[ct] = (f32x4){0.f, 0.f, 0.f, 0.f};
            mm128(acc1, T1, T2, wave, fr, fq);
            const float qd = __builtin_amdgcn_exp2f(l2g * (float)(i_ + 1)); float ssq = 0.f;
#pragma unroll
            for (int ct = 0; ct < 8; ++ct) { acc1[ct] = acc1[ct] + acc2[ct] * qd; ssq += (acc1[ct][0] * acc1[ct][0] + acc1[ct][1] * acc1[ct][1]) + (acc1[ct][2] * acc1[ct][2] + acc1[ct][3] * acc1[ct][3]); }
            ssq += __shfl_xor(ssq, 16); ssq += __shfl_xor(ssq, 32);
            const float rn = __builtin_amdgcn_rsqf(ssq * (1.0f / 128.0f) + EPS);
            bf16* mp = MIX + (R0 + i_) * D + 128 * h + 4 * fq;
#pragma unroll
            for (int ct = 0; ct < 8; ++ct) { v2u w;
                w.x = pk2(acc1[ct][0] * rn * lo16(gg[ct].x), acc1[ct][1] * rn * hi16(gg[ct].x)); w.y = pk2(acc1[ct][2] * rn * lo16(gg[ct].y), acc1[ct][3] * rn * hi16(gg[ct].y)); *(v2u*)(mp + 16 * ct) = w; }
            __syncthreads(); }
        for (int u = blk; u < 512; u += G) { const int b = u >> 7, c = (u >> 3) & 15, grp = u & 7; const size_t R0 = (size_t)b * SEQ + 128 * c;
            const int t_ = 16 * wave + fr, d8 = tid & 15;
            f32x4 wl[4][2]; v4u xv[4]; float st[4][2]; v2u uu[8]; float lg[8], lb[8];
#pragma unroll
            for (int it = 0; it < 4; ++it) { const int idx = tid + 512 * it, t = idx >> 4; const float* wp = gm_ws + (size_t)grp * 16384 + t * 128 + 8 * d8;
                wl[it][0] = *(const f32x4*)wp; wl[it][1] = *(const f32x4*)(wp + 4);
                xv[it] = *(const v4u*)(Z + (R0 + t) * NIN + 5120 + 128 * grp + 8 * d8); st[it][0] = STATS[2 * (R0 + t)]; st[it][1] = STATS[2 * (R0 + t) + 1]; }
#pragma unroll
            for (int j = 0; j < 8; ++j) { lg[j] = gm_ln_g[128 * grp + 8 * d8 + j]; lb[j] = gm_ln_b[128 * grp + 8 * d8 + j]; }
            const float bsv = gm_bs[grp * 128 + t_];
#pragma unroll
            for (int it = 0; it < 4; ++it) { const int idx = tid + 512 * it, t = idx >> 4;
                float wv[8] = {wl[it][0][0], wl[it][0][1], wl[it][0][2], wl[it][0][3], wl[it][1][0], wl[it][1][1], wl[it][1][2], wl[it][1][3]};
#pragma unroll
                for (int j = 0; j < 8; ++j) if (8 * d8 + j > t) wv[j] = 0.f;
                v4u w; w.x = pk2(wv[0], wv[1]); w.y = pk2(wv[2], wv[3]); w.z = pk2(wv[4], wv[5]); w.w = pk2(wv[6], wv[7]); *(LAS v4u*)(T0 + t * LDP + 8 * d8) = w;
                const float mean = st[it][0], rstd = st[it][1];
#pragma unroll
                for (int p = 0; p < 4; ++p) { T1[(8 * d8 + 2 * p) * LDP + t] = f2bf((lo16(xv[it][p]) - mean) * rstd * lg[2 * p] + lb[2 * p]); T1[(8 * d8 + 2 * p + 1) * LDP + t] = f2bf((hi16(xv[it][p]) - mean) * rstd * lg[2 * p + 1] + lb[2 * p + 1]); } }
            __syncthreads();
            { const bf16* up = Z + (R0 + t_) * NIN + 4096 + 128 * grp + 4 * fq;
#pragma unroll
              for (int ct = 0; ct < 8; ++ct) uu[ct] = *(const v2u*)(up + 16 * ct); }
            f32x4 acc[8];
#pragma unroll
            for (int ct = 0; ct < 8; ++ct) acc[ct] = (f32x4){0.f, 0.f, 0.f, 0.f};
            mm128(acc, T0, T1, wave, fr, fq);
            bf16* mp = MIX + (R0 + t_) * D + 1024 + 128 * grp + 4 * fq;
#pragma unroll
            for (int ct = 0; ct < 8; ++ct) { v2u w;
                w.x = pk2((acc[ct][0] + bsv) * lo16(uu[ct].x), (acc[ct][1] + bsv) * hi16(uu[ct].x)); w.y = pk2((acc[ct][2] + bsv) * lo16(uu[ct].y), (acc[ct][3] + bsv) * hi16(uu[ct].y)); *(v2u*)(mp + 16 * ct) = w; }
            __syncthreads(); }
    }
    SEAM(3);

    if (IN(4)) {
        { pg8::Gemm g{MIX, Wo_t, MP, D, D}; pg8::StaticOrder S; S.init(MP, D, G, blk); EpiRes<false> E{x_p, AB, SS1};
          pg8::gemm_phase<EpiRes<false>, pg8::StaticOrder, true, true>(lds, g, S, E); }
        auto f = [&](int s, int n, float v) { const float o = x_s[(size_t)s * D + n] + v; AB[(size_t)(MP + s) * D + n] = f2bf(o);
            const float q = half_wave_sum(o * o); if ((lane & 31) == 0) atomic_addf(SS1 + MP + s, q); };
        skinny_gemm<2>(lds, MIX + (size_t)MP * D, Wo_t, D, D, blk, G, f);
    }
    SEAM(4);

    if (IN(5)) {
        { pg8::Gemm g{AB, Wup_t, MP, NUP, D}; pg8::StaticOrder S; S.init(MP, NUP, G, blk); EpiUp E{ACT, RAW, SS1, conv_w, conv_b};
          pg8::gemm_phase<EpiUp, pg8::StaticOrder, true, true>(lds, g, S, E); }
        auto f = [&](int s, int n, float v) { const int within = n & 255, col = (within >> 7) * DFF + 128 * (n >> 8) + (within & 127);
            AS[(size_t)s * NUP + col] = v * __builtin_amdgcn_rsqf(SS1[MP + s] * (1.0f / D) + EPS); };
        if (blk >= 128) skinny_gemm<8>(lds, AB + (size_t)MP * D, Wup_t, NUP, D, blk - 128, 128, f);
    }
    SEAM(5);

    if (IN(6)) {
        for (int i = gt; i < 128 * 2 * (DFF / 4); i += NGT) { const int c4 = i % (DFF / 4), gr = i / (DFF / 4), rr = gr & 1, Gp = gr >> 1, c = 4 * c4; const bool first = (Gp & 31) == 0;
            const float* rg = RAW + (size_t)Gp * 4 * NUP; const float* rp = rg - 4 * NUP; const f32x4 z4 = {0.f, 0.f, 0.f, 0.f};
            f32x4 a0g, a0u, a1g, a1u, a2g, a2u;
            a0g = *(const f32x4*)(rg + (2 + rr) * NUP + c); a0u = *(const f32x4*)(rg + (2 + rr) * NUP + DFF + c);
            if (rr) { a1g = *(const f32x4*)(rg + 2 * NUP + c); a1u = *(const f32x4*)(rg + 2 * NUP + DFF + c); a2g = first ? z4 : *(const f32x4*)(rp + NUP + c); a2u = first ? z4 : *(const f32x4*)(rp + NUP + DFF + c); }
            else { a1g = first ? z4 : *(const f32x4*)(rp + NUP + c); a1u = first ? z4 : *(const f32x4*)(rp + NUP + DFF + c); a2g = first ? z4 : *(const f32x4*)(rp + c); a2u = first ? z4 : *(const f32x4*)(rp + DFF + c); }
            const f32x4 ag = *(const f32x4*)(conv_w + c) * a2g + *(const f32x4*)(conv_w + NUP + c) * a1g + *(const f32x4*)(conv_w + 2 * NUP + c) * a0g + *(const f32x4*)(conv_b + c);
            const f32x4 au = *(const f32x4*)(conv_w + DFF + c) * a2u + *(const f32x4*)(conv_w + NUP + DFF + c) * a1u + *(const f32x4*)(conv_w + 2 * NUP + DFF + c) * a0u + *(const f32x4*)(conv_b + DFF + c);
            v2u w; w.x = pk2(silu_(ag[0]) * au[0], silu_(ag[1]) * au[1]); w.y = pk2(silu_(ag[2]) * au[2], silu_(ag[3]) * au[3]);
            *(v2u*)(ACT + (size_t)(64 * Gp + rr) * DFF + c) = w; }
        for (int i = gt; i < MS * (DFF / 4); i += NGT) { const int c4 = i % (DFF / 4), s = i / (DFF / 4), c = 4 * c4;
            const float* sc0 = state_conv + (size_t)s * 2 * NUP; const float* sc1 = sc0 + NUP; const float* as = AS + (size_t)s * NUP;
            const f32x4 a0g = *(const f32x4*)(as + c), a0u = *(const f32x4*)(as + DFF + c), a1g = *(const f32x4*)(sc1 + c), a1u = *(const f32x4*)(sc1 + DFF + c), a2g = *(const f32x4*)(sc0 + c), a2u = *(const f32x4*)(sc0 + DFF + c);
            const f32x4 ag = *(const f32x4*)(conv_w + c) * a2g + *(const f32x4*)(conv_w + NUP + c) * a1g + *(const f32x4*)(conv_w + 2 * NUP + c) * a0g + *(const f32x4*)(conv_b + c);
            const f32x4 au = *(const f32x4*)(conv_w + DFF + c) * a2u + *(const f32x4*)(conv_w + NUP + DFF + c) * a1u + *(const f32x4*)(conv_w + 2 * NUP + DFF + c) * a0u + *(const f32x4*)(conv_b + DFF + c);
            v2u w; w.x = pk2(silu_(ag[0]) * au[0], silu_(ag[1]) * au[1]); w.y = pk2(silu_(ag[2]) * au[2], silu_(ag[3]) * au[3]);
            *(v2u*)(ACT + (size_t)(MP + s) * DFF + c) = w;
            float* cs = out + O_CONVS + (size_t)s * 2 * NUP; *(f32x4*)(cs + c) = a1g; *(f32x4*)(cs + DFF + c) = a1u; *(f32x4*)(cs + NUP + c) = a0g; *(f32x4*)(cs + NUP + DFF + c) = a0u; }
        for (int i = gt; i < 4 * 2 * (NUP / 4); i += NGT) { const int c4 = i % (NUP / 4), bk = i / (NUP / 4), b = bk >> 1, k = bk & 1;
            *(f32x4*)(out + O_CONVP + (size_t)bk * NUP + 4 * c4) = *(const f32x4*)(RAW + ((size_t)(32 * b + 31) * 4 + k) * NUP + 4 * c4); }
    }
    SEAM(6);

    if (IN(7)) {
        { pg8::Gemm g{ACT, Wdn_t, MP, D, DFF}; pg8::StaticOrder S; S.init(MP, D, G, blk); EpiRes<true> E{nullptr, AB, SS2};
          pg8::gemm_phase<EpiRes<true>, pg8::StaticOrder, true, true>(lds, g, S, E); }
        auto f = [&](int s, int n, float v) { const size_t o_ = (size_t)(MP + s) * D + n; const float o = bf2f(AB[o_]) + v; AB[o_] = f2bf(o);
            const float q = half_wave_sum(o * o); if ((lane & 31) == 0) atomic_addf(SS2 + MP + s, q); };
        skinny_gemm<2>(lds, ACT + (size_t)MP * DFF, Wdn_t, D, DFF, blk, G, f);
    }
    SEAM(7);

    if (IN(8)) {
#ifndef T_A
        { int Kp = PLE; asm volatile("" : "+s"(Kp));
          pg8::Gemm g{PB, Wp_t, MP, D, Kp}; pg8::StaticOrder S; S.init(MP, D, G, blk); EpiPP E{PP};
          pg8::gemm_phase<EpiPP, pg8::StaticOrder, true, true>(lds, g, S, E); }
#endif
#ifndef T_B
        { pg8::Gemm g{AB, Wg_t, MP, D, D}; pg8::StaticOrder S; S.init(MP, D, G, blk); EpiGate E{PP, AB, out, SS2, SS3};
          pg8::gemm_phase<EpiGate, pg8::StaticOrder, true, true>(lds, g, S, E); }
#endif
#ifndef T_C
        auto f1 = [&](int s, int n, float v) { PP[(size_t)(MP + s) * D + n] = f2bf(v); };
        skinny_gemm<2>(lds, PB + (size_t)MP * PLE, Wp_t, D, PLE, blk, G, f1);
#endif
#ifndef T_D
        auto f2 = [&](int s, int n, float v) { const size_t o_ = (size_t)(MP + s) * D + n; const float r2 = __builtin_amdgcn_rsqf(SS2[MP + s] * (1.0f / D) + EPS);
            const float o = bf2f(AB[o_]) + bf2f(PP[o_]) * sigmoid_(r2 * v); out[o_] = o; const float q = half_wave_sum(o * o); if ((lane & 31) == 0) atomic_addf(SS3 + MP + s, q); };
        skinny_gemm<2>(lds, AB + (size_t)MP * D, Wg_t, D, D, blk, G, f2);
#endif
    }
    SEAM(8);

    if (IN(9)) {
        for (int m = gw; m < MT; m += NGW) { f32x4* hr = (f32x4*)(out + (size_t)m * D) + lane; const f32x4* gr = (const f32x4*)g_final + lane;
            const float r = __builtin_amdgcn_rsqf(SS3[m] * (1.0f / D) + EPS);
#pragma unroll
            for (int j = 0; j < 8; ++j) hr[64 * j] = hr[64 * j] * gr[64 * j] * r; }
    }
#undef IN
#undef SEAM
}

extern "C" void kernel_launch(void* const* d_in, const int* in_sizes, int n_in, void* d_out, int out_size, void* d_ws, size_t ws_size, hipStream_t stream) {
    static int grid = 0;
    if (grid == 0) {
        if (n_in != 22 || out_size != (int)O_END || ws_size < WS_END) { fprintf(stderr, "kernel_launch: unexpected shapes: n_in %d out %d ws %zu\n", n_in, out_size, ws_size); grid = -1; return; }
        int dev = 0, cus = 0, per_cu = 0;
        if (hipGetDevice(&dev) != hipSuccess || hipDeviceGetAttribute(&cus, hipDeviceAttributeMultiprocessorCount, dev) != hipSuccess) { grid = -1; return; }
        if (hipFuncSetAttribute((const void*)mk_fwd, hipFuncAttributeMaxDynamicSharedMemorySize, LDS_BYTES) != hipSuccess) { fprintf(stderr, "kernel_launch: hipFuncSetAttribute failed\n"); grid = -1; return; }
        if (hipOccupancyMaxActiveBlocksPerMultiprocessor(&per_cu, (const void*)mk_fwd, 512, LDS_BYTES) != hipSuccess || per_cu < 1) fprintf(stderr, "kernel_launch: occupancy query says %d\n", per_cu);
        (void)hipGetLastError();
        grid = cus;
        if (grid != 256) fprintf(stderr, "kernel_launch: %d CUs (built for 256)\n", grid);
    }
    if (grid < 0) return;
    if (hipMemsetAsync((char*)d_ws + WS_BAR, 0, BAR_BYTES, stream) != hipSuccess) { fprintf(stderr, "kernel_launch: memset failed\n"); return; }
    Params p{};
    for (int i = 0; i < 22; ++i) p.in[i] = (const float*)d_in[i];
    p.out = (float*)d_out; p.ws = (unsigned char*)d_ws;
    for (int h = 0; h < 8; ++h) p.log2g[h] = (float)std::log2(1.0 - std::exp2(-5.0 - (double)h));
    for (int i = 0; i < 64; ++i) p.invf[i] = powf(10000.0f, -(float)i / 64.0f);
    p.use_cg = 0; p.pad = 0;
#if MK_N_LAUNCHES == 1
    void* args[] = {&p};
#ifdef PROBE_K
    p.ph_lo = 0; p.ph_hi = PROBE_K + 1;
    (void)hipLaunchCooperativeKernel((const void*)mk_fwd, dim3(grid), dim3(512), args, LDS_BYTES, stream);
    if (hipMemsetAsync((char*)d_ws + WS_BAR, 0, BAR_BYTES, stream) != hipSuccess) return;
#endif
    p.ph_lo = 0; p.ph_hi = NPHASE;
    hipError_t e = hipLaunchCooperativeKernel((const void*)mk_fwd, dim3(grid), dim3(512), args, LDS_BYTES, stream);
    if (e != hipSuccess) fprintf(stderr, "kernel_launch: cooperative launch failed: %s\n", hipGetErrorString(e));
#else
    for (int ph = 0; ph < NPHASE; ++ph) { p.ph_lo = ph; p.ph_hi = ph + 1; hipLaunchKernelGGL(mk_fwd, dim3(grid), dim3(512), LDS_BYTES, stream, p); }
#endif
}
```

```cpp
#include <hip/hip_runtime.h>
#include <hip/hip_cooperative_groups.h>
#include <cstdio>
#include <cstdint>
#include <cmath>
namespace cg = cooperative_groups;

#ifndef MK_N_LAUNCHES
#define MK_N_LAUNCHES 1
#endif

namespace pg8 {
#define PG8_LAS __attribute__((address_space(3)))
typedef unsigned short bf16_t;
typedef short bf16x8 __attribute__((ext_vector_type(8)));
typedef float f32x4 __attribute__((ext_vector_type(4)));
typedef unsigned u32x4 __attribute__((ext_vector_type(4)));
constexpr int BM = 256, BK = 64, HALF = 128, HTB = HALF * BK * 2  , STAGE_BYTES = 8 * HTB, NXCD = 8, WGM = 8;

__host__ __device__ __forceinline__ int lds_byte(int r, int c) { const int st = (r >> 4) * 2 + (c >> 5), rr = r & 15, cc = c & 31, ob = rr * 64 + cc * 2; return st * 1024 + (ob ^ (((ob >> 9) & 1) << 5)); }
__host__ __device__ __forceinline__ void stage_rc(int b, int& R, int& C) { const int st = b / 1024, sb = b % 1024, swz = sb ^ (((sb >> 9) & 1) << 5); R = (st >> 1) * 16 + swz / 64; C = (st & 1) * 32 + (swz % 64) / 2; }
__host__ __device__ __forceinline__ int perm32(int rho) { const int n = rho >> 4, i = rho & 15; return 8 * (i >> 2) + 4 * n + (i & 3); }

struct Unit { int pm, pn; };
struct Gemm { const bf16_t* A; const bf16_t* Bt; int M, N, K; };

struct StaticOrder {
    int nM, nN, nwg, G, c;
    __host__ __device__ void init(int M, int N, int G_, int c_) { nM = M / BM; nN = N / BM; nwg = nM * nN; G = G_; c = c_; }
    __host__ __device__ bool next(int i, Unit& u) const {
        const long L = (long)i * G + c; if (L >= nwg) return false;
        int wgid = (int)L; { const int q = nwg / NXCD, r = nwg % NXCD, xcd = wgid % NXCD, off = wgid / NXCD; wgid = (xcd < r ? xcd * (q + 1) : r * (q + 1) + (xcd - r) * q) + off; }
        const int nig = WGM * nN, gid = wgid / nig, fm = gid * WGM, gsz = (nM - fm) < WGM ? (nM - fm) : WGM;
        u.pm = fm + ((wgid % nig) % gsz); u.pn = (wgid % nig) / gsz; return true;
    }
    __device__ __forceinline__ void a_ready(const Unit&) const {}
    __device__ __forceinline__ void done(const Unit&) const {}
};

__device__ __forceinline__ unsigned cvt_pk_bf16(float lo, float hi) { unsigned r; asm volatile("v_cvt_pk_bf16_f32 %0, %1, %2" : "=v"(r) : "v"(lo), "v"(hi)); return r; }
typedef float f32x2 __attribute__((ext_vector_type(2)));

template <class Epi, class Sched, bool ALIGN_EPI = false, bool SP2 = false>
__device__ __forceinline__ void gemm_phase(PG8_LAS unsigned char* lds, const Gemm g, const Sched& S, const Epi& E) {
    const int tid = threadIdx.x, wid = __builtin_amdgcn_readfirstlane(tid >> 6), lane = tid & 63, wr = wid >> 2, wc = wid & 3, fr = lane & 15, fq = lane >> 4;
    const int K = g.K, nt = K / BK;
    unsigned voffA[2], voffB[2];
#pragma unroll
    for (int i = 0; i < 2; ++i) { int R, C; stage_rc(tid * 16 + i * 8192, R, C); const int Rb = Epi::PERM ? ((R & ~31) + perm32(R & 31)) : R;
        voffA[i] = (unsigned)(R * K + C) * 2u; voffB[i] = (unsigned)(Rb * K + C) * 2u; }
    const size_t kstep = (size_t)(BK * 2);
    const size_t hstep = (size_t)HALF * K * 2;
    const size_t tstep = 2 * hstep;
    const unsigned ldsw = (unsigned)wid * 1024u;
    const int aoff = lds_byte(wr * 64 + fr, fq * 8), boff = lds_byte(wc * 32 + fr, fq * 8);
#define PG8_SA(b, h) (((b) * 2 + (h)) * HTB)
#define PG8_SB(b, h) ((4 + (b) * 2 + (h)) * HTB)
#define PG8_STAGE(bufoff, gbase, voff) do { _Pragma("unroll") for (int _i = 0; _i < 2; ++_i) \
        __builtin_amdgcn_global_load_lds((const unsigned*)((const char*)(gbase) + (voff)[_i]), (PG8_LAS unsigned*)(lds + (bufoff) + ldsw + _i * 8192), 16, 0, 0); } while (0)
#define PG8_LDA(dst, b, h) do { _Pragma("unroll") for (int m = 0; m < 4; ++m) _Pragma("unroll") for (int k = 0; k < 2; ++k) dst[m][k] = *(const PG8_LAS bf16x8*)(lds + PG8_SA(b, h) + aoff + m * 2048 + k * 1024); } while (0)
#define PG8_LDB(dst, b, h) do { _Pragma("unroll") for (int n = 0; n < 2; ++n) _Pragma("unroll") for (int k = 0; k < 2; ++k) dst[n][k] = *(const PG8_LAS bf16x8*)(lds + PG8_SB(b, h) + boff + n * 2048 + k * 1024); } while (0)
#define PG8_MMA(ai, bj, At, Bt) do { __builtin_amdgcn_s_setprio(1); _Pragma("unroll") for (int m = 0; m < 4; ++m) _Pragma("unroll") for (int n = 0; n < 2; ++n) _Pragma("unroll") for (int k = 0; k < 2; ++k) \
        acc[ai][bj][m][n] = __builtin_amdgcn_mfma_f32_16x16x32_bf16(Bt[n][k], At[m][k], acc[ai][bj][m][n], 0, 0, 0); __builtin_amdgcn_s_setprio(0); } while (0)
#define PG8_WAIT_V(n) asm volatile("s_waitcnt vmcnt(" #n ")" ::: "memory")
#define PG8_WAIT_L(n) asm volatile("s_waitcnt lgkmcnt(" #n ")" ::: "memory")
#define PG8_BAR __builtin_amdgcn_s_barrier()
#define PG8_SCHED __builtin_amdgcn_sched_barrier(0)
    Unit cur, nxt; int ui = 0;
    if (!S.next(0, cur)) return;
    f32x4 acc[2][2][4][2];
#pragma unroll
    for (int a = 0; a < 2; ++a)
#pragma unroll
        for (int b = 0; b < 2; ++b)
#pragma unroll
            for (int m = 0; m < 4; ++m)
#pragma unroll
                for (int n = 0; n < 2; ++n) acc[a][b][m][n] = (f32x4){0.f, 0.f, 0.f, 0.f};
    bf16x8 At[4][2], B0[2][2], B1[2][2];
    const char* cA = (const char*)g.A + (size_t)cur.pm * tstep; const char* cB = (const char*)g.Bt + (size_t)cur.pn * tstep;
    S.a_ready(cur);
    if constexpr (SP2) {
        PG8_STAGE(PG8_SB(0, 0), cB, voffB); PG8_STAGE(PG8_SB(0, 1), cB + hstep, voffB); PG8_STAGE(PG8_SA(0, 0), cA, voffA); PG8_STAGE(PG8_SA(0, 1), cA + hstep, voffA);
        if (wr == 1) PG8_BAR;
        PG8_WAIT_V(2); PG8_BAR;
        PG8_STAGE(PG8_SB(1, 0), cB + kstep, voffB); PG8_STAGE(PG8_SA(1, 0), cA + kstep, voffA); PG8_STAGE(PG8_SB(1, 1), cB + hstep + kstep, voffB);
        PG8_WAIT_V(6); PG8_BAR;
    } else {
        PG8_STAGE(PG8_SB(0, 0), cB, voffB); PG8_STAGE(PG8_SA(0, 0), cA, voffA); PG8_STAGE(PG8_SB(0, 1), cB + hstep, voffB); PG8_STAGE(PG8_SA(0, 1), cA + hstep, voffA);
        if (wr == 1) PG8_BAR;
        PG8_WAIT_V(4); PG8_BAR;
        PG8_STAGE(PG8_SB(1, 0), cB + kstep, voffB); PG8_STAGE(PG8_SA(1, 0), cA + kstep, voffA); PG8_STAGE(PG8_SB(1, 1), cB + hstep + kstep, voffB);
        PG8_WAIT_V(6); PG8_BAR;
    }
    for (;;) {
        const bool has_next = S.next(ui + 1, nxt);
        const char* nA = has_next ? (const char*)g.A + (size_t)nxt.pm * tstep : cA; const char* nB = has_next ? (const char*)g.Bt + (size_t)nxt.pn * tstep : cB;
        for (int t = 0; t < nt; t += 2) {
            const bool last = (t == nt - 2);
            const char* a1 = cA + (size_t)(t + 1) * kstep;
            const char* a2 = last ? nA : cA + (size_t)(t + 2) * kstep; const char* b2 = last ? nB : cB + (size_t)(t + 2) * kstep;
            const char* a3 = a2 + kstep; const char* b3 = b2 + kstep;
            if (last && has_next) S.a_ready(nxt);
            if constexpr (SP2) {
            PG8_LDB(B0, 0, 0); PG8_LDB(B1, 0, 1); PG8_SCHED; PG8_LDA(At, 0, 0); PG8_STAGE(PG8_SA(1, 1), a1 + hstep, voffA);
            PG8_WAIT_V(8); PG8_WAIT_L(0); PG8_BAR; PG8_MMA(0, 0, At, B0); PG8_MMA(0, 1, At, B1); PG8_BAR; PG8_SCHED;
            PG8_LDA(At, 0, 1); PG8_STAGE(PG8_SB(0, 0), b2, voffB); PG8_STAGE(PG8_SB(0, 1), b2 + hstep, voffB); PG8_STAGE(PG8_SA(0, 0), a2, voffA);
            PG8_WAIT_V(8); PG8_WAIT_L(0); PG8_BAR; PG8_MMA(1, 0, At, B0); PG8_MMA(1, 1, At, B1); PG8_BAR; PG8_SCHED;
            PG8_LDB(B0, 1, 0); PG8_LDB(B1, 1, 1); PG8_SCHED; PG8_LDA(At, 1, 0); PG8_STAGE(PG8_SA(0, 1), a2 + hstep, voffA);
            PG8_WAIT_V(8); PG8_WAIT_L(0); PG8_BAR; PG8_MMA(0, 0, At, B0); PG8_MMA(0, 1, At, B1); PG8_BAR; PG8_SCHED;
            PG8_LDA(At, 1, 1); PG8_STAGE(PG8_SB(1, 0), b3, voffB); PG8_STAGE(PG8_SB(1, 1), b3 + hstep, voffB); PG8_STAGE(PG8_SA(1, 0), a3, voffA);
            PG8_WAIT_V(8); PG8_WAIT_L(0); PG8_BAR; PG8_MMA(1, 0, At, B0); PG8_MMA(1, 1, At, B1); PG8_BAR; PG8_SCHED;
            } else {
            PG8_LDB(B0, 0, 0); PG8_SCHED; PG8_LDA(At, 0, 0); PG8_STAGE(PG8_SA(1, 1), a1 + hstep, voffA);
            PG8_WAIT_L(8); PG8_BAR; PG8_WAIT_L(0); PG8_MMA(0, 0, At, B0); PG8_BAR; PG8_SCHED;
            PG8_LDB(B1, 0, 1); PG8_STAGE(PG8_SB(0, 0), b2, voffB);
            PG8_BAR; PG8_WAIT_L(0); PG8_MMA(0, 1, At, B1); PG8_BAR;
            PG8_LDA(At, 0, 1); PG8_STAGE(PG8_SA(0, 0), a2, voffA);
            PG8_BAR; PG8_WAIT_L(0); PG8_MMA(1, 0, At, B0); PG8_BAR; PG8_SCHED;
            PG8_STAGE(PG8_SB(0, 1), b2 + hstep, voffB);
            PG8_WAIT_V(6); PG8_BAR; PG8_MMA(1, 1, At, B1); PG8_BAR;
            PG8_LDB(B0, 1, 0); PG8_SCHED; PG8_LDA(At, 1, 0); PG8_STAGE(PG8_SA(0, 1), a2 + hstep, voffA);
            PG8_WAIT_L(8); PG8_BAR; PG8_WAIT_L(0); PG8_MMA(0, 0, At, B0); PG8_BAR; PG8_SCHED;
            PG8_LDB(B1, 1, 1); PG8_STAGE(PG8_SB(1, 0), b3, voffB);
            PG8_BAR; PG8_WAIT_L(0); PG8_MMA(0, 1, At, B1); PG8_BAR;
            PG8_LDA(At, 1, 1); PG8_STAGE(PG8_SA(1, 0), a3, voffA);
            PG8_BAR; PG8_WAIT_L(0); PG8_MMA(1, 0, At, B0); PG8_BAR; PG8_SCHED;
            PG8_STAGE(PG8_SB(1, 1), b3 + hstep, voffB);
            PG8_WAIT_V(6); PG8_BAR; PG8_MMA(1, 1, At, B1); PG8_BAR;
            }
        }
        if constexpr (ALIGN_EPI) { if (wr == 0) PG8_BAR; }
        if constexpr (!Epi::AFTER_DRAIN) { E(acc, cur, wr, wc, fr, fq); S.done(cur); }
        if (!has_next) break;
#pragma unroll
        for (int a = 0; a < 2; ++a)
#pragma unroll
            for (int b = 0; b < 2; ++b)
#pragma unroll
                for (int m = 0; m < 4; ++m)
#pragma unroll
                    for (int n = 0; n < 2; ++n) acc[a][b][m][n] = (f32x4){0.f, 0.f, 0.f, 0.f};
        cur = nxt; cA = nA; cB = nB; ++ui;
        if constexpr (ALIGN_EPI) { if (wr == 1) PG8_BAR; }
    }
    PG8_WAIT_V(0);
    if constexpr (!ALIGN_EPI) { if (wr == 0) PG8_BAR; }
    PG8_BAR;
    if constexpr (Epi::AFTER_DRAIN) { E.fused(acc, cur, wr, wc, fr, fq, lds, wid, lane); S.done(cur); }
#undef PG8_SA
#undef PG8_SB
#undef PG8_STAGE
#undef PG8_LDA
#undef PG8_LDB
#undef PG8_MMA
#undef PG8_WAIT_V
#undef PG8_WAIT_L
#undef PG8_BAR
#undef PG8_SCHED
}
}

#define GAS __attribute__((address_space(1)))
#define LAS __attribute__((address_space(3)))
typedef unsigned short bf16;
typedef unsigned v4u __attribute__((ext_vector_type(4)));
typedef unsigned v2u __attribute__((ext_vector_type(2)));
typedef float f32x4 __attribute__((ext_vector_type(4)));
typedef float f32x2 __attribute__((ext_vector_type(2)));
typedef short bf16x8 __attribute__((ext_vector_type(8)));
#define XB_TMO      128
#define XB_XCNT(j)  (256  + 64 * (j))
#define XB_XSUB(j)  (1280 + 64 * (j))
#define XB_XGEN(j)  (2304 + 64 * (j))
#define XB_TOP      3328
#define XB_TOPGEN   3392
#define XCD_BAR_WORDS 3456
#define XB_SPIN_CAP (1u << 18)

__device__ __forceinline__ unsigned xb_ld(unsigned* p)              { return __hip_atomic_load(p, __ATOMIC_RELAXED, __HIP_MEMORY_SCOPE_AGENT); }
__device__ __forceinline__ unsigned xb_add(unsigned* p, unsigned v) { return __hip_atomic_fetch_add(p, v, __ATOMIC_RELAXED, __HIP_MEMORY_SCOPE_AGENT); }
__device__ __forceinline__ unsigned xb_xcc_id() { return (unsigned)__builtin_amdgcn_s_getreg((3 << 11) | 20) & 0xFu; }
#define XB_SPIN(cond, bar) do { unsigned _sp = 0; while (cond) { __builtin_amdgcn_s_sleep(1); \
    if ((++_sp & 255u) == 0u) { if (xb_ld(&(bar)[XB_TMO])) break; if (_sp > XB_SPIN_CAP) { atomicAdd(&(bar)[XB_TMO], 1u); break; } } } } while (0)

struct XcdBarrier {
    unsigned* bar; unsigned x;
    volatile LAS unsigned* st;
};

__device__ __forceinline__ XcdBarrier xcd_barrier_post(unsigned* bar, volatile LAS unsigned* st) {
    XcdBarrier b; b.bar = bar; b.x = xb_xcc_id(); b.st = st;
    if (threadIdx.x == 0) (void)xb_add(&bar[XB_XCNT(b.x)], 1u);
    return b;
}
__device__ __forceinline__ void xcd_barrier_complete(unsigned* bar, unsigned x, unsigned& nloc, unsigned& nx) {
    const unsigned G = gridDim.x * gridDim.y * gridDim.z;
    unsigned sum, cnt, mine, sp = 0u;
    for (;;) {
        sum = 0u; cnt = 0u; mine = 0u;
#pragma unroll
        for (unsigned j = 0; j < 16; ++j) { const unsigned c = xb_ld(&bar[XB_XCNT(j)]); sum += c; cnt += (c > 0u) ? 1u : 0u; mine = (j == x) ? c : mine; }
        if (sum == G) break;
        __builtin_amdgcn_s_sleep(1);
        if ((++sp & 255u) == 0u) { if (xb_ld(&bar[XB_TMO])) break; if (sp > XB_SPIN_CAP) { atomicAdd(&bar[XB_TMO], 1u); break; } }
    }
    nloc = mine > 0u ? mine : 1u; nx = cnt > 0u ? cnt : 1u;
}

__device__ __forceinline__ void xcd_barrier(const XcdBarrier& b) {
    asm volatile("s_waitcnt vmcnt(0)" ::: "memory");
    __syncthreads();
    if (threadIdx.x == 0) {
        unsigned* bar = b.bar;
        __builtin_amdgcn_s_waitcnt(0);
        unsigned nloc = b.st[0], nx = b.st[1];
        if (nloc == 0u) { xcd_barrier_complete(bar, b.x, nloc, nx); b.st[0] = nloc; b.st[1] = nx; }
        const unsigned old = xb_add(&bar[XB_XSUB(b.x)], 1u);
        const unsigned gen = old / nloc;
        if (old + 1u == (gen + 1u) * nloc) {
            __builtin_amdgcn_fence(__ATOMIC_RELEASE, "agent");
            asm volatile("s_waitcnt vmcnt(0)" ::: "memory");
            const unsigned og = xb_add(&bar[XB_TOP], 1u);
            const unsigned tg = og / nx;
            if (og + 1u == (tg + 1u) * nx) xb_add(&bar[XB_TOPGEN], 1u);
            else XB_SPIN(xb_ld(&bar[XB_TOPGEN]) == tg, bar);
            __builtin_amdgcn_fence(__ATOMIC_ACQUIRE, "agent");
            xb_add(&bar[XB_XGEN(b.x)], 1u);
            asm volatile("s_waitcnt vmcnt(0)" ::: "memory");
        } else {
            XB_SPIN(xb_ld(&bar[XB_XGEN(b.x)]) == gen, bar);
            __builtin_amdgcn_fence(__ATOMIC_ACQUIRE, "agent");
            asm volatile("s_waitcnt vmcnt(0)" ::: "memory");
        }
    }
    __syncthreads();
}

constexpr int MP = 8192, MS = 128, MT = MP + MS, D = 2048, NIN = 6144, NUP = 11264, DFF = 5632, PLE = 256, SEQ = 2048, NH = 8;
constexpr float EPS = 1e-6f;
constexpr int NPHASE = 10;
constexpr size_t MiB = 1u << 20;
constexpr size_t WS_BAR = 0, BAR_BYTES = 16384;
constexpr size_t WS_SS1 = 64 * 1024, WS_SS2 = 128 * 1024, WS_SS3 = 192 * 1024, WS_STATS = 256 * 1024;
constexpr size_t WS_ROPE = 1 * MiB, WS_ROPES = 2 * MiB;
constexpr size_t WS_WIN = 4 * MiB, WS_WO = 28 * MiB, WS_WUP = 36 * MiB, WS_WDN = 80 * MiB, WS_WG = 102 * MiB, WS_WP = 110 * MiB;
constexpr size_t WS_AB = 112 * MiB, WS_PB = 145 * MiB, WS_MIX = 150 * MiB, WS_Z = 183 * MiB, WS_ACT = 183 * MiB, WS_KV = 281 * MiB, WS_PP = 281 * MiB;
constexpr size_t WS_RAW = 313 * MiB, WS_AS = 335 * MiB, WS_END = 346 * MiB;
static_assert(WS_AB + (size_t)MT * D * 2 <= WS_PB && WS_PB + (size_t)MT * PLE * 2 <= WS_MIX && WS_MIX + (size_t)MT * D * 2 <= WS_Z, "ws map 1");
static_assert(WS_Z + (size_t)MT * NIN * 2 <= WS_KV && WS_ACT + (size_t)MT * DFF * 2 <= WS_KV && WS_KV + (size_t)512 * 16384 * 4 <= WS_RAW, "ws map 2");
static_assert(WS_RAW + (size_t)128 * 4 * NUP * 4 <= WS_AS && WS_AS + (size_t)MS * NUP * 4 <= WS_END && WS_PP + (size_t)MT * D * 4 <= WS_END, "ws map 3");
constexpr size_t O_RETP = 17039360, O_CONVP = 17563648, O_RETS = 17653760, O_CONVS = 34430976, O_GMV = 37314560, O_END = 37445632;
constexpr int LDS_BYTES = 147456, MISC_OFF = LDS_BYTES - 256;
constexpr int LDP = 136;
constexpr int TILE_B = 128 * LDP * 2;

struct Params { const float* in[22]; float* out; unsigned char* ws; float log2g[8]; float invf[64]; int ph_lo, ph_hi, use_cg, pad; };

#define LDS_WAIT() asm volatile("s_waitcnt lgkmcnt(0)" ::: "memory")
__device__ __forceinline__ float lo16(unsigned u) { return __uint_as_float(u << 16); }
__device__ __forceinline__ float hi16(unsigned u) { return __uint_as_float(u & 0xffff0000u); }
__device__ __forceinline__ float bf2f(bf16 b) { return __uint_as_float((unsigned)b << 16); }
__device__ __forceinline__ unsigned pk2(float lo, float hi) { return pg8::cvt_pk_bf16(lo, hi); }
__device__ __forceinline__ bf16 f2bf(float f) { return (bf16)(pg8::cvt_pk_bf16(f, 0.f) & 0xffffu); }
__device__ __forceinline__ float sigmoid_(float x) { return __builtin_amdgcn_rcpf(1.0f + __builtin_amdgcn_exp2f(-1.44269504089f * x)); }
__device__ __forceinline__ float silu_(float x) { return x * sigmoid_(x); }
__device__ __forceinline__ float gelu_(float x) { return x * sigmoid_(1.5957691216f * (x + 0.044715f * x * x * x)); }
__device__ __forceinline__ float wave_sum(float v) {
#pragma unroll
    for (int o = 1; o < 64; o <<= 1) v += __shfl_xor(v, o);
    return v;
}
__device__ __forceinline__ void atomic_addf(float* p, float v) { (void)__hip_atomic_fetch_add(p, v, __ATOMIC_RELAXED, __HIP_MEMORY_SCOPE_AGENT); }
template <int CTRL> __device__ __forceinline__ float dppf(float x) { return __int_as_float(__builtin_amdgcn_mov_dpp(__float_as_int(x), CTRL, 0xf, 0xf, false)); }

using pg8::Unit;
struct EpiZ {
    static constexpr bool PERM = true, AFTER_DRAIN = false;
    bf16* Z;
    __device__ __forceinline__ void operator()(const f32x4 (&acc)[2][2][4][2], const Unit& u, int wr, int wc, int fr, int fq) const {
        const int row0 = u.pm * 256 + wr * 64 + fr, col0 = u.pn * 256 + wc * 32 + 8 * fq;
        const int mode = u.pn < 12 ? 0 : (u.pn < 16 ? 1 : 2);
#pragma unroll
        for (int ai = 0; ai < 2; ++ai)
#pragma unroll
            for (int m = 0; m < 4; ++m) { bf16* rowp = Z + (size_t)(row0 + ai * 128 + m * 16) * NIN + col0;
#pragma unroll
                for (int bj = 0; bj < 2; ++bj) { f32x4 v0 = acc[ai][bj][m][0], v1 = acc[ai][bj][m][1];
                    if (mode == 1) {
#pragma unroll
                        for (int j = 0; j < 4; ++j) { v0[j] = silu_(v0[j]); v1[j] = silu_(v1[j]); } }
                    else if (mode == 2) {
#pragma unroll
                        for (int j = 0; j < 4; ++j) { v0[j] = gelu_(v0[j]); v1[j] = gelu_(v1[j]); } }
                    v4u w; w.x = pk2(v0[0], v0[1]); w.y = pk2(v0[2], v0[3]); w.z = pk2(v1[0], v1[1]); w.w = pk2(v1[2], v1[3]);
                    *(v4u*)(rowp + bj * 128) = w; } }
    }
};
template <bool BASE_BF16> struct EpiRes {
    static constexpr bool PERM = true, AFTER_DRAIN = false;
    const float* base; bf16* hb; float* ss;
    __device__ __forceinline__ void operator()(const f32x4 (&acc)[2][2][4][2], const Unit& u, int wr, int wc, int fr, int fq) const {
        const int row0 = u.pm * 256 + wr * 64 + fr, col0 = u.pn * 256 + wc * 32 + 8 * fq;
        float sacc[2][4];
#pragma unroll
        for (int ai = 0; ai < 2; ++ai) {
            f32x4 bs[4][2][2];
#pragma unroll
            for (int m = 0; m < 4; ++m)
#pragma unroll
                for (int bj = 0; bj < 2; ++bj) { const size_t o_ = (size_t)(row0 + ai * 128 + m * 16) * D + col0 + bj * 128;
                    if (BASE_BF16) { const v4u w = *(const v4u*)(hb + o_); bs[m][bj][0] = (f32x4){lo16(w.x), hi16(w.x), lo16(w.y), hi16(w.y)}; bs[m][bj][1] = (f32x4){lo16(w.z), hi16(w.z), lo16(w.w), hi16(w.w)}; }
                    else { bs[m][bj][0] = *(const f32x4*)(base + o_); bs[m][bj][1] = *(const f32x4*)(base + o_ + 4); } }
#pragma unroll
            for (int m = 0; m < 4; ++m) { const size_t off = (size_t)(row0 + ai * 128 + m * 16) * D + col0; float s = 0.f;
#pragma unroll
                for (int bj = 0; bj < 2; ++bj) { const f32x4 o0 = bs[m][bj][0] + acc[ai][bj][m][0], o1 = bs[m][bj][1] + acc[ai][bj][m][1];
                    v4u w; w.x = pk2(o0[0], o0[1]); w.y = pk2(o0[2], o0[3]); w.z = pk2(o1[0], o1[1]); w.w = pk2(o1[2], o1[3]); *(v4u*)(hb + off + bj * 128) = w;
                    s += ((o0[0] * o0[0] + o0[1] * o0[1]) + (o0[2] * o0[2] + o0[3] * o0[3])) + ((o1[0] * o1[0] + o1[1] * o1[1]) + (o1[2] * o1[2] + o1[3] * o1[3])); }
                s += __shfl_xor(s, 16); s += __shfl_xor(s, 32); sacc[ai][m] = s; }
            asm volatile("" ::: "memory"); }
        if (fq == 0) {
#pragma unroll
            for (int ai = 0; ai < 2; ++ai)
#pragma unroll
                for (int m = 0; m < 4; ++m) atomic_addf(ss + row0 + ai * 128 + m * 16, sacc[ai][m]); }
    }
};
struct EpiPP {
    static constexpr bool PERM = true, AFTER_DRAIN = false;
    bf16* pp;
    __device__ __forceinline__ void operator()(const f32x4 (&acc)[2][2][4][2], const Unit& u, int wr, int wc, int fr, int fq) const {
        const int row0 = u.pm * 256 + wr * 64 + fr, col0 = u.pn * 256 + wc * 32 + 8 * fq;
#pragma unroll
        for (int ai = 0; ai < 2; ++ai)
#pragma unroll
            for (int m = 0; m < 4; ++m) { bf16* rowp = pp + (size_t)(row0 + ai * 128 + m * 16) * D + col0;
#pragma unroll
                for (int bj = 0; bj < 2; ++bj) { const f32x4 v0 = acc[ai][bj][m][0], v1 = acc[ai][bj][m][1]; v4u w; w.x = pk2(v0[0], v0[1]); w.y = pk2(v0[2], v0[3]); w.z = pk2(v1[0], v1[1]); w.w = pk2(v1[2], v1[3]); *(v4u*)(rowp + bj * 128) = w; } }
    }
};
struct EpiGate {
    static constexpr bool PERM = true, AFTER_DRAIN = false;
    const bf16* pp; const bf16* hb; float* h; const float* ss2; float* ss3;
    __device__ __forceinline__ void operator()(const f32x4 (&acc)[2][2][4][2], const Unit& u, int wr, int wc, int fr, int fq) const {
        const int row0 = u.pm * 256 + wr * 64 + fr, col0 = u.pn * 256 + wc * 32 + 8 * fq;
        float sacc[2][4];
#pragma unroll
        for (int ai = 0; ai < 2; ++ai) {
            v4u hw[4][2], pw[4][2]; float r2[4];
#pragma unroll
            for (int m = 0; m < 4; ++m) { const int row = row0 + ai * 128 + m * 16; r2[m] = ss2[row];
#pragma unroll
                for (int bj = 0; bj < 2; ++bj) { hw[m][bj] = *(const v4u*)(hb + (size_t)row * D + col0 + bj * 128); pw[m][bj] = *(const v4u*)(pp + (size_t)row * D + col0 + bj * 128); } }
#pragma unroll
            for (int m = 0; m < 4; ++m) { const size_t off = (size_t)(row0 + ai * 128 + m * 16) * D + col0; float s = 0.f;
                const float rr = __builtin_amdgcn_rsqf(r2[m] * (1.0f / D) + EPS);
#pragma unroll
                for (int bj = 0; bj < 2; ++bj) { const v4u h4 = hw[m][bj], p4 = pw[m][bj];
                    const f32x4 hv0 = {lo16(h4.x), hi16(h4.x), lo16(h4.y), hi16(h4.y)}, hv1 = {lo16(h4.z), hi16(h4.z), lo16(h4.w), hi16(h4.w)};
                    const f32x4 pv0 = {lo16(p4.x), hi16(p4.x), lo16(p4.y), hi16(p4.y)}, pv1 = {lo16(p4.z), hi16(p4.z), lo16(p4.w), hi16(p4.w)};
                    const f32x4 a0 = acc[ai][bj][m][0], a1 = acc[ai][bj][m][1]; f32x4 o0, o1;
#pragma unroll
                    for (int j = 0; j < 4; ++j) { o0[j] = hv0[j] + pv0[j] * sigmoid_(rr * a0[j]); o1[j] = hv1[j] + pv1[j] * sigmoid_(rr * a1[j]); }
                    *(f32x4*)(h + off + bj * 128) = o0; *(f32x4*)(h + off + bj * 128 + 4) = o1;
                    s += ((o0[0] * o0[0] + o0[1] * o0[1]) + (o0[2] * o0[2] + o0[3] * o0[3])) + ((o1[0] * o1[0] + o1[1] * o1[1]) + (o1[2] * o1[2] + o1[3] * o1[3])); }
                s += __shfl_xor(s, 16); s += __shfl_xor(s, 32); sacc[ai][m] = s; }
            asm volatile("" ::: "memory"); }
        if (fq == 0) {
#pragma unroll
            for (int ai = 0; ai < 2; ++ai)
#pragma unroll
                for (int m = 0; m < 4; ++m) atomic_addf(ss3 + row0 + ai * 128 + m * 16, sacc[ai][m]); }
    }
};
struct EpiUp {
    static constexpr bool PERM = false, AFTER_DRAIN = false;
    bf16* act; float* raw; const float* ss1; const float* cw; const float* cb; LAS float* wl;
    __device__ __forceinline__ void operator()(const f32x4 (&acc)[2][2][4][2], const Unit& u, int wr, int wc, int fr, int fq) const {
        const int row0 = u.pm * 256 + wr * 64 + fr;
        LAS float* wb = wl + (wr * 4 + wc) * 256;
        { const int l = fq * 16 + fr, v = l >> 3, c4 = l & 7;
          const float* src = ((v & 3) == 3 ? cb : cw + (v & 3) * NUP) + (v >> 2) * DFF + u.pn * 128 + wc * 32 + 4 * c4;
          *(LAS f32x4*)(wb + v * 32 + 4 * c4) = *(const f32x4*)src; }
        float rs[2][4];
#pragma unroll
        for (int ai = 0; ai < 2; ++ai)
#pragma unroll
            for (int m = 0; m < 4; ++m) rs[ai][m] = __builtin_amdgcn_rsqf(ss1[row0 + ai * 128 + m * 16] * (1.0f / D) + EPS);
#pragma unroll
        for (int n = 0; n < 2; ++n) {
            const int cg_ = u.pn * 128 + wc * 32 + 16 * n + 4 * fq;
            const volatile LAS f32x4* wv = (const volatile LAS f32x4*)(wb + 16 * n + 4 * fq);
#pragma unroll
            for (int ai = 0; ai < 2; ++ai) {
                f32x4 l1g = {0.f, 0.f, 0.f, 0.f}, l2g = l1g, l1u = l1g, l2u = l1g;
#pragma unroll
                for (int m = 0; m < 4; ++m) {
                    const int row = row0 + ai * 128 + m * 16;
                    f32x4 sg;
                    { const f32x4 g = acc[ai][0][m][n] * rs[ai][m];
                      if (m == 0 && fr < 2) *(f32x4*)(raw + ((size_t)(row >> 6) * 4 + 2 + fr) * NUP + cg_) = g;
                      if (m == 3 && fr >= 14) *(f32x4*)(raw + ((size_t)(row >> 6) * 4 + (fr - 14)) * NUP + cg_) = g;
                      f32x4 r1, r2, x1, x2;
#pragma unroll
                      for (int j = 0; j < 4; ++j) { r1[j] = dppf<0x121>(g[j]); r2[j] = dppf<0x122>(g[j]); }
#pragma unroll
                      for (int j = 0; j < 4; ++j) { x1[j] = fr == 0 ? l1g[j] : r1[j]; x2[j] = fr < 2 ? l2g[j] : r2[j]; }
                      l1g = r1; l2g = r2;
                      const f32x4 w0 = wv[0], w1 = wv[8], w2 = wv[16], bb = wv[24];
                      const f32x4 ag = w0 * x2 + w1 * x1 + w2 * g + bb;
#pragma unroll
                      for (int j = 0; j < 4; ++j) sg[j] = silu_(ag[j]);
                      asm volatile("" : "+v"(sg)); }
                    f32x4 o;
                    { const f32x4 up = acc[ai][1][m][n] * rs[ai][m];
                      if (m == 0 && fr < 2) *(f32x4*)(raw + ((size_t)(row >> 6) * 4 + 2 + fr) * NUP + DFF + cg_) = up;
                      if (m == 3 && fr >= 14) *(f32x4*)(raw + ((size_t)(row >> 6) * 4 + (fr - 14)) * NUP + DFF + cg_) = up;
                      f32x4 r1, r2, x1, x2;
#pragma unroll
                      for (int j = 0; j < 4; ++j) { r1[j] = dppf<0x121>(up[j]); r2[j] = dppf<0x122>(up[j]); }
#pragma unroll
                      for (int j = 0; j < 4; ++j) { x1[j] = fr == 0 ? l1u[j] : r1[j]; x2[j] = fr < 2 ? l2u[j] : r2[j]; }
                      l1u = r1; l2u = r2;
                      const f32x4 w0 = wv[32], w1 = wv[40], w2 = wv[48], bb = wv[56];
                      o = (w0 * x2 + w1 * x1 + w2 * up + bb) * sg; }
                    v2u w; w.x = pk2(o[0], o[1]); w.y = pk2(o[2], o[3]);
                    *(v2u*)(act + (size_t)row * DFF + cg_) = w; } } }
    }
};

struct EpiAS {
    static constexpr bool PERM = false, AFTER_DRAIN = false;
    float* as; const float* ss1;
    __device__ __forceinline__ void operator()(const f32x4 (&acc)[2][2][4][2], const Unit& u, int wr, int wc, int fr, int fq) const {
#pragma unroll
        for (int m = 0; m < 4; ++m) { const int s_ = wr * 64 + m * 16 + fr; const float r = __builtin_amdgcn_rsqf(ss1[MP + s_] * (1.0f / D) + EPS);
#pragma unroll
            for (int n = 0; n < 2; ++n) { const int cg_ = u.pn * 128 + wc * 32 + 16 * n + 4 * fq;
                *(f32x4*)(as + (size_t)s_ * NUP + cg_) = acc[0][0][m][n] * r; *(f32x4*)(as + (size_t)s_ * NUP + DFF + cg_) = acc[0][1][m][n] * r; } }
    }
};
struct SampleOrder {
    int idx;
    __device__ __forceinline__ bool next(int i, Unit& u) const { if (i != 0 || idx < 0) return false; u.pm = MP / 256; u.pn = idx; return true; }
    __device__ __forceinline__ void a_ready(const Unit&) const {}
    __device__ __forceinline__ void done(const Unit&) const {}
};

template <int RT, class F>
__device__ __forceinline__ void skinny_gemm(LAS unsigned char* lds, const bf16* A, const bf16* Bt, int N, int K, int u0, int ustride, const F& f) {
    const int tid = threadIdx.x, lane = tid & 63, w = tid >> 6, fr = lane & 15, fq = lane >> 4;
    constexpr int nrb = 8 / RT, ROWS = 16 * RT;
    const int nunits = nrb * (N / 32), kw = K / 8;
    LAS float* red = (LAS float*)lds;
    for (int u = u0; u < nunits; u += ustride) {
        const int rb = u % nrb, cb = u / nrb, row0 = rb * ROWS, col0 = cb * 32;
        f32x4 acc[RT][2];
#pragma unroll
        for (int rt = 0; rt < RT; ++rt) { acc[rt][0] = (f32x4){0.f, 0.f, 0.f, 0.f}; acc[rt][1] = (f32x4){0.f, 0.f, 0.f, 0.f}; }
        const bf16* ap = A + (size_t)(row0 + fr) * K + w * kw + 8 * fq;
        const bf16* bp = Bt + (size_t)(col0 + fr) * K + w * kw + 8 * fq;
        if constexpr (RT <= 2) {
            int k = 0;
            for (; k + 256 <= kw; k += 256) { bf16x8 bq[8][2], aq[8][RT];
#pragma unroll
                for (int kk = 0; kk < 8; ++kk) { bq[kk][0] = *(const bf16x8*)(bp + k + 32 * kk); bq[kk][1] = *(const bf16x8*)(bp + (size_t)16 * K + k + 32 * kk);
#pragma unroll
                    for (int rt = 0; rt < RT; ++rt) aq[kk][rt] = *(const bf16x8*)(ap + (size_t)rt * 16 * K + k + 32 * kk); }
#pragma unroll
                for (int kk = 0; kk < 8; ++kk)
#pragma unroll
                    for (int rt = 0; rt < RT; ++rt) { acc[rt][0] = __builtin_amdgcn_mfma_f32_16x16x32_bf16(bq[kk][0], aq[kk][rt], acc[rt][0], 0, 0, 0); acc[rt][1] = __builtin_amdgcn_mfma_f32_16x16x32_bf16(bq[kk][1], aq[kk][rt], acc[rt][1], 0, 0, 0); } }
            for (; k < kw; k += 32) { const bf16x8 b0 = *(const bf16x8*)(bp + k), b1 = *(const bf16x8*)(bp + (size_t)16 * K + k);
#pragma unroll
                for (int rt = 0; rt < RT; ++rt) { const bf16x8 av = *(const bf16x8*)(ap + (size_t)rt * 16 * K + k);
                    acc[rt][0] = __builtin_amdgcn_mfma_f32_16x16x32_bf16(b0, av, acc[rt][0], 0, 0, 0); acc[rt][1] = __builtin_amdgcn_mfma_f32_16x16x32_bf16(b1, av, acc[rt][1], 0, 0, 0); } }
        } else {
#pragma unroll 2
        for (int k = 0; k < kw; k += 32) {
            const bf16x8 b0 = *(const bf16x8*)(bp + k), b1 = *(const bf16x8*)(bp + (size_t)16 * K + k);
#pragma unroll
            for (int rt = 0; rt < RT; ++rt) { const bf16x8 av = *(const bf16x8*)(ap + (size_t)rt * 16 * K + k);
                acc[rt][0] = __builtin_amdgcn_mfma_f32_16x16x32_bf16(b0, av, acc[rt][0], 0, 0, 0);
                acc[rt][1] = __builtin_amdgcn_mfma_f32_16x16x32_bf16(b1, av, acc[rt][1], 0, 0, 0); }
        }
        }
#pragma unroll
        for (int rt = 0; rt < RT; ++rt)
#pragma unroll
            for (int ct = 0; ct < 2; ++ct) *(LAS f32x4*)(red + (w * ROWS + 16 * rt + fr) * 32 + 16 * ct + 4 * fq) = acc[rt][ct];
        __syncthreads();
#pragma unroll
        for (int it = 0; it < RT; ++it) { const int e = tid + 512 * it, r = e >> 5, c = e & 31; float v = 0.f;
#pragma unroll
            for (int ww = 0; ww < 8; ++ww) v += red[(ww * ROWS + r) * 32 + c];
            f(row0 + r, col0 + c, v); }
        __syncthreads();
    }
}
__device__ __forceinline__ float half_wave_sum(float v) {
#pragma unroll
    for (int o = 1; o < 32; o <<= 1) v += __shfl_xor(v, o);
    return v;
}

__device__ __forceinline__ void transpose_item(const float* W, int K, int N, const float* g, bf16* WT, bool upmap, LAS float* scr, int item, int lane) {
    const int nblk = N / 64, kb = item / nblk, nb = item % nblk, k0 = 64 * kb, n0 = 64 * nb;
    const float* src = W + (size_t)k0 * N + n0 + lane;
#pragma unroll
    for (int h = 0; h < 2; ++h) {
        float v[32];
#pragma unroll
        for (int i = 0; i < 32; ++i) v[i] = __builtin_nontemporal_load(src + (size_t)(32 * h + i) * N);
#pragma unroll
        for (int i = 0; i < 32; ++i) { float x = v[i]; if (g) x *= g[k0 + 32 * h + i]; scr[(32 * h + i) * 65 + lane] = x; }
    }
    LDS_WAIT(); asm volatile("" ::: "memory");
    const int c = lane & 7;
#pragma unroll
    for (int j = 0; j < 8; ++j) { const int n = (lane >> 3) + 8 * j; const LAS float* s = scr + (8 * c) * 65 + n;
        v4u o; o.x = pk2(s[0 * 65], s[1 * 65]); o.y = pk2(s[2 * 65], s[3 * 65]); o.z = pk2(s[4 * 65], s[5 * 65]); o.w = pk2(s[6 * 65], s[7 * 65]);
        int R = n0 + n; if (upmap) { const int half = R >= DFF ? 1 : 0, jj = R - half * DFF; R = 256 * (jj >> 7) + 128 * half + (jj & 127); }
        *(v4u*)(WT + (size_t)R * K + k0 + 8 * c) = o; }
    LDS_WAIT(); asm volatile("" ::: "memory");
}
__device__ __forceinline__ void rms_row_to_bf16(const float* xrow, bf16* orow, int lane) {
    const f32x4* xr = (const f32x4*)xrow + lane;
    f32x4 v[8]; float s = 0.f;
#pragma unroll
    for (int j = 0; j < 8; ++j) { v[j] = xr[64 * j]; s += (v[j][0] * v[j][0] + v[j][1] * v[j][1]) + (v[j][2] * v[j][2] + v[j][3] * v[j][3]); }
    const float r = __builtin_amdgcn_rsqf(wave_sum(s) * (1.0f / D) + EPS);
    v2u* o8 = (v2u*)orow + lane;
#pragma unroll
    for (int j = 0; j < 8; ++j) { v2u w; w.x = pk2(v[j][0] * r, v[j][1] * r); w.y = pk2(v[j][2] * r, v[j][3] * r); o8[64 * j] = w; }
}

__device__ __forceinline__ void mm128(f32x4 (&acc)[8], const LAS bf16* A, const LAS bf16* B, int wave, int fr, int fq) {
#pragma unroll
    for (int ks = 0; ks < 4; ++ks) {
        const bf16x8 a = *(const LAS bf16x8*)(A + (16 * wave + fr) * LDP + 32 * ks + 8 * fq);
#pragma unroll
        for (int ct = 0; ct < 8; ++ct) { const bf16x8 b = *(const LAS bf16x8*)(B + (16 * ct + fr) * LDP + 32 * ks + 8 * fq);
            acc[ct] = __builtin_amdgcn_mfma_f32_16x16x32_bf16(b, a, acc[ct], 0, 0, 0); }
    }
}
template <bool TRANS, bool DEC>
__device__ __forceinline__ void stage_rope(LAS bf16* dst, const bf16* zb, const float* rope, float scale, float l2g, int tid) {
#pragma unroll
    for (int it = 0; it < 2; ++it) { const int idx = tid + 512 * it, j = idx >> 3, d8 = idx & 7;
        const v4u x1 = *(const v4u*)(zb + (size_t)j * NIN + 8 * d8), x2 = *(const v4u*)(zb + (size_t)j * NIN + 64 + 8 * d8);
        const f32x4* rp = (const f32x4*)(rope + (size_t)(j * 64 + 8 * d8) * 2);
        float sc = scale; if (DEC) sc *= __builtin_amdgcn_exp2f(l2g * (float)(127 - j));
        float o1[8], o2[8];
#pragma unroll
        for (int p = 0; p < 4; ++p) { const f32x4 cs = rp[p]; const float a0 = lo16(x1[p]), a1 = hi16(x1[p]), b0 = lo16(x2[p]), b1 = hi16(x2[p]);
            o1[2 * p] = (a0 * cs[0] - b0 * cs[1]) * sc; o2[2 * p] = (b0 * cs[0] + a0 * cs[1]) * sc;
            o1[2 * p + 1] = (a1 * cs[2] - b1 * cs[3]) * sc; o2[2 * p + 1] = (b1 * cs[2] + a1 * cs[3]) * sc; }
        if (!TRANS) { v4u w1, w2;
#pragma unroll
            for (int p = 0; p < 4; ++p) { w1[p] = pk2(o1[2 * p], o1[2 * p + 1]); w2[p] = pk2(o2[2 * p], o2[2 * p + 1]); }
            *(LAS v4u*)(dst + j * LDP + 8 * d8) = w1; *(LAS v4u*)(dst + j * LDP + 64 + 8 * d8) = w2; }
        else {
#pragma unroll
            for (int i = 0; i < 8; ++i) { dst[(8 * d8 + i) * LDP + j] = f2bf(o1[i]); dst[(64 + 8 * d8 + i) * LDP + j] = f2bf(o2[i]); } }
    }
}
__device__ __forceinline__ void stage_T(LAS bf16* dst, const bf16* zb, int tid) {
#pragma unroll
    for (int it = 0; it < 4; ++it) { const int idx = tid + 512 * it, j = idx >> 4, c8 = idx & 15;
        const v4u x = *(const v4u*)(zb + (size_t)j * NIN + 8 * c8);
#pragma unroll
        for (int p = 0; p < 4; ++p) { dst[(8 * c8 + 2 * p) * LDP + j] = (bf16)(x[p] & 0xffffu); dst[(8 * c8 + 2 * p + 1) * LDP + j] = (bf16)(x[p] >> 16); } }
}


struct RopeX { v4u x1[2], x2[2]; };
struct RopeCS { f32x4 cs[2][4]; };
struct TileX { v4u x[4]; };
__device__ __forceinline__ void rope_load(RopeX& r, const bf16* zb, int tid) {
#pragma unroll
    for (int it = 0; it < 2; ++it) { const int idx = tid + 512 * it, j = idx >> 3, d8 = idx & 7; r.x1[it] = *(const v4u*)(zb + (size_t)j * NIN + 8 * d8); r.x2[it] = *(const v4u*)(zb + (size_t)j * NIN + 64 + 8 * d8); }
}
__device__ __forceinline__ void rope_cs_load(RopeCS& c, const float* rope, int tid) {
#pragma unroll
    for (int it = 0; it < 2; ++it) { const int idx = tid + 512 * it, j = idx >> 3, d8 = idx & 7; const f32x4* rp = (const f32x4*)(rope + (size_t)(j * 64 + 8 * d8) * 2);
#pragma unroll
        for (int p = 0; p < 4; ++p) c.cs[it][p] = rp[p]; }
}
template <bool TRANS, bool DEC>
__device__ __forceinline__ void rope_commit(LAS bf16* dst, const RopeX& r, const RopeCS& c, float scale, float l2g, int tid) {
#pragma unroll
    for (int it = 0; it < 2; ++it) { const int idx = tid + 512 * it, j = idx >> 3, d8 = idx & 7;
        float sc = scale; if (DEC) sc *= __builtin_amdgcn_exp2f(l2g * (float)(127 - j));
        float o1[8], o2[8];
#pragma unroll
        for (int p = 0; p < 4; ++p) { const f32x4 cs = c.cs[it][p]; const float a0 = lo16(r.x1[it][p]), a1 = hi16(r.x1[it][p]), b0 = lo16(r.x2[it][p]), b1 = hi16(r.x2[it][p]);
            o1[2 * p] = (a0 * cs[0] - b0 * cs[1]) * sc; o2[2 * p] = (b0 * cs[0] + a0 * cs[1]) * sc;
            o1[2 * p + 1] = (a1 * cs[2] - b1 * cs[3]) * sc; o2[2 * p + 1] = (b1 * cs[2] + a1 * cs[3]) * sc; }
        if (!TRANS) { v4u w1, w2;
#pragma unroll
            for (int p = 0; p < 4; ++p) { w1[p] = pk2(o1[2 * p], o1[2 * p + 1]); w2[p] = pk2(o2[2 * p], o2[2 * p + 1]); }
            *(LAS v4u*)(dst + j * LDP + 8 * d8) = w1; *(LAS v4u*)(dst + j * LDP + 64 + 8 * d8) = w2; }
        else {
#pragma unroll
            for (int i = 0; i < 8; ++i) { dst[(8 * d8 + i) * LDP + j] = f2bf(o1[i]); dst[(64 + 8 * d8 + i) * LDP + j] = f2bf(o2[i]); } }
    }
}
__device__ __forceinline__ void tile_load(TileX& t, const bf16* zb, int tid) {
#pragma unroll
    for (int it = 0; it < 4; ++it) { const int idx = tid + 512 * it, j = idx >> 4, c8 = idx & 15; t.x[it] = *(const v4u*)(zb + (size_t)j * NIN + 8 * c8); }
}
__device__ __forceinline__ void tile_commit_T(LAS bf16* dst, const TileX& t, int tid) {
#pragma unroll
    for (int it = 0; it < 4; ++it) { const int idx = tid + 512 * it, j = idx >> 4, c8 = idx & 15;
#pragma unroll
        for (int p = 0; p < 4; ++p) { dst[(8 * c8 + 2 * p) * LDP + j] = (bf16)(t.x[it][p] & 0xffffu); dst[(8 * c8 + 2 * p + 1) * LDP + j] = (bf16)(t.x[it][p] >> 16); } }
}

__global__ void __launch_bounds__(512, 2) mk_fwd(Params a) {
    extern __shared__ __attribute__((aligned(16))) unsigned char lds_raw[];
    LAS unsigned char* lds = (LAS unsigned char*)lds_raw;
    const int tid = threadIdx.x, lane = tid & 63, wave = __builtin_amdgcn_readfirstlane(tid >> 6), fr = lane & 15, fq = lane >> 4;
    const int G = gridDim.x, blk = blockIdx.x;
    const int gw = blk * 8 + wave, NGW = G * 8;
    const int gt = blk * 512 + tid, NGT = G * 512;
    unsigned char* ws = a.ws;
#define x_p (a.in[0])
#define x_s (a.in[1])
#define p_p (a.in[2])
#define p_s (a.in[3])
#define state_ret (a.in[4])
#define state_conv (a.in[5])
#define gm_ln_g (a.in[8])
#define gm_ln_b (a.in[9])
#define gm_ws (a.in[10])
#define gm_bs (a.in[11])
#define conv_w (a.in[15])
#define conv_b (a.in[16])
#define g_final (a.in[21])
#define out (a.out)
#define SS1 ((float*)(ws + WS_SS1))
#define SS2 ((float*)(ws + WS_SS2))
#define SS3 ((float*)(ws + WS_SS3))
#define STATS ((float*)(ws + WS_STATS))
#define ROPE ((float*)(ws + WS_ROPE))
#define ROPES ((float*)(ws + WS_ROPES))
#define Win_t ((bf16*)(ws + WS_WIN))
#define Wo_t ((bf16*)(ws + WS_WO))
#define Wup_t ((bf16*)(ws + WS_WUP))
#define Wdn_t ((bf16*)(ws + WS_WDN))
#define Wg_t ((bf16*)(ws + WS_WG))
#define Wp_t ((bf16*)(ws + WS_WP))
#define AB ((bf16*)(ws + WS_AB))
#define PB ((bf16*)(ws + WS_PB))
#define MIX ((bf16*)(ws + WS_MIX))
#define Z ((bf16*)(ws + WS_Z))
#define ACT ((bf16*)(ws + WS_ACT))
#define KV ((float*)(ws + WS_KV))
#define PP ((bf16*)(ws + WS_PP))
#define RAW ((float*)(ws + WS_RAW))
#define AS ((float*)(ws + WS_AS))

    volatile LAS unsigned* MISC = (volatile LAS unsigned*)(lds + MISC_OFF);
    if (tid < 64) MISC[tid] = 0u;
    __syncthreads();
    XcdBarrier bar; bar.bar = (unsigned*)(ws + WS_BAR); bar.x = 0; bar.st = nullptr;
    if (MK_N_LAUNCHES == 1) bar = xcd_barrier_post((unsigned*)(ws + WS_BAR), MISC + 8);
    const int lo = a.ph_lo, hi = a.ph_hi;
#ifndef PHMASK
#define PHMASK 0xffff
#endif
#define IN(k) (((PHMASK >> (k)) & 1) && lo <= (k) && (k) < hi)
#define SEAM(k) do { if (IN(k) && IN((k) + 1)) { if (a.use_cg) cg::this_grid().sync(); else xcd_barrier(bar); } } while (0)

    if (IN(0)) {
        LAS float* scr = (LAS float*)(lds + wave * 16640);
        constexpr int I_IN = (D / 64) * (NIN / 64), I_O = (D / 64) * (D / 64), I_UP = (D / 64) * (NUP / 64), I_DN = (DFF / 64) * (D / 64), I_G = I_O, I_P = (PLE / 64) * (D / 64);
        constexpr int NITEMS = I_IN + I_O + I_UP + I_DN + I_G + I_P;
        for (int it = gw; it < NITEMS; it += NGW) {
            int r = it;
            if (r < I_UP) { transpose_item(a.in[14], D, NUP, a.in[13], Wup_t, true, scr, r, lane); continue; } r -= I_UP;
            if (r < I_IN) { transpose_item(a.in[7], D, NIN, a.in[6], Win_t, false, scr, r, lane); continue; } r -= I_IN;
            if (r < I_DN) { transpose_item(a.in[17], DFF, D, nullptr, Wdn_t, false, scr, r, lane); continue; } r -= I_DN;
            if (r < I_O) { transpose_item(a.in[12], D, D, nullptr, Wo_t, false, scr, r, lane); continue; } r -= I_O;
            if (r < I_G) { transpose_item(a.in[19], D, D, a.in[18], Wg_t, false, scr, r, lane); continue; } r -= I_G;
            transpose_item(a.in[20], PLE, D, nullptr, Wp_t, false, scr, r, lane);
        }
        for (int m = gw; m < MT; m += NGW) rms_row_to_bf16(m < MP ? x_p + (size_t)m * D : x_s + (size_t)(m - MP) * D, AB + (size_t)m * D, lane);
        for (int i = gt; i < MT * PLE / 4; i += NGT) { const f32x4 v = i < MP * PLE / 4 ? ((const f32x4*)p_p)[i] : ((const f32x4*)p_s)[i - MP * PLE / 4]; v2u w; w.x = pk2(v[0], v[1]); w.y = pk2(v[2], v[3]); ((v2u*)PB)[i] = w; }
        for (int i = gt; i < SEQ * 64 + 64; i += NGT) { const int pos = i < SEQ * 64 ? (i >> 6) : 16384, fi = i & 63;
            const float ang = (float)pos * a.invf[fi]; double t = (double)ang * 0.15915494309189535; t -= __builtin_rint(t); const float rev = (float)t;
            float* dst = i < SEQ * 64 ? ROPE + 2 * (size_t)i : ROPES + 2 * fi; dst[0] = __builtin_amdgcn_cosf(rev); dst[1] = __builtin_amdgcn_sinf(rev); }
        for (int i = gt; i < MT; i += NGT) { SS1[i] = 0.f; SS2[i] = 0.f; SS3[i] = 0.f; }
    }
    SEAM(0);

    if (IN(1)) {
        { pg8::Gemm g{AB, Win_t, MP, NIN, D}; pg8::StaticOrder S; S.init(MP, NIN, G, blk); EpiZ E{Z};
          pg8::gemm_phase<EpiZ, pg8::StaticOrder, true, true>(lds, g, S, E); }
        auto f = [&](int s, int n, float v) { const float o = n < 3072 ? v : (n < 4096 ? silu_(v) : gelu_(v)); Z[(size_t)(MP + s) * NIN + n] = f2bf(o); };
        skinny_gemm<8>(lds, AB + (size_t)MP * D, Win_t, NIN, D, blk, G, f);
    }
    SEAM(1);

    if (IN(2)) {
        { LAS float* qs = (LAS float*)lds; LAS float* ks = qs + 128; LAS float* vs = ks + 128; LAS float* red = vs + 128;
          const int e4 = tid & 31, dg = tid >> 5;
          for (int u = blk; u < MS * NH; u += G) { const int s = u >> 3, h = u & 7; const bf16* zr = Z + (size_t)(MP + s) * NIN;
            const float* S0 = state_ret + (size_t)u * 16384 + 4 * e4; float* S1 = out + O_RETS + (size_t)u * 16384 + 4 * e4;
            f32x4 s0[8];
#pragma unroll
            for (int i = 0; i < 8; ++i) s0[i] = __builtin_nontemporal_load((const f32x4*)(S0 + (dg + 16 * i) * 128));
            if (tid < 64) { const float c = ROPES[2 * tid], sn = ROPES[2 * tid + 1];
                const float q1 = bf2f(zr[128 * h + tid]), q2 = bf2f(zr[128 * h + 64 + tid]), k1 = bf2f(zr[1024 + 128 * h + tid]), k2 = bf2f(zr[1024 + 128 * h + 64 + tid]);
                qs[tid] = q1 * c - q2 * sn; qs[tid + 64] = q2 * c + q1 * sn; ks[tid] = (k1 * c - k2 * sn) * 0.08838834764831845f; ks[tid + 64] = (k2 * c + k1 * sn) * 0.08838834764831845f; }
            else if (tid < 192) vs[tid - 64] = bf2f(zr[2048 + 128 * h + tid - 64]);
            unsigned gg = 0u; if (tid < 64) gg = *(const unsigned*)(zr + 3072 + 128 * h + 2 * tid);
            __syncthreads();
            const float gamma = 1.0f - __builtin_amdgcn_exp2f((float)(-5 - h));
            const f32x4 vv = *(const LAS f32x4*)(vs + 4 * e4); f32x4 o = {0.f, 0.f, 0.f, 0.f};
#pragma unroll
            for (int i = 0; i < 8; ++i) { const int d = dg + 16 * i; const f32x4 sn = s0[i] * gamma + vv * ks[d]; __builtin_nontemporal_store(sn, (f32x4*)(S1 + d * 128)); o += sn * qs[d]; }
            *(LAS f32x4*)(red + dg * 128 + 4 * e4) = o;
            __syncthreads();
            if (tid < 64) { float o0 = 0.f, o1 = 0.f;
#pragma unroll
                for (int i = 0; i < 16; ++i) { o0 += red[i * 128 + 2 * tid]; o1 += red[i * 128 + 2 * tid + 1]; }
                const float r = __builtin_amdgcn_rsqf(wave_sum(o0 * o0 + o1 * o1) * (1.0f / 128.0f) + EPS);
                *(unsigned*)(MIX + (size_t)(MP + s) * D + 128 * h + 2 * tid) = pk2(o0 * r * lo16(gg), o1 * r * hi16(gg)); }
            __syncthreads(); } }
        { LAS bf16* Kt = (LAS bf16*)lds; LAS bf16* Vt = (LAS bf16*)(lds + TILE_B);
          for (int u = blk; u < 512; u += G) { const int b = u >> 7, h = (u >> 4) & 7, c = u & 15; const size_t R0 = (size_t)b * SEQ + 128 * c;
            RopeX kx; RopeCS cs; TileX vx;
            rope_load(kx, Z + R0 * NIN + 1024 + 128 * h, tid); rope_cs_load(cs, ROPE + (size_t)(128 * c) * 128, tid); tile_load(vx, Z + R0 * NIN + 2048 + 128 * h, tid);
            rope_commit<true, true>(Kt, kx, cs, 0.08838834764831845f, a.log2g[h], tid);
            tile_commit_T(Vt, vx, tid);
            __syncthreads();
            f32x4 acc[8];
#pragma unroll
            for (int ct = 0; ct < 8; ++ct) acc[ct] = (f32x4){0.f, 0.f, 0.f, 0.f};
            mm128(acc, Kt, Vt, wave, fr, fq);
            float* kv = KV + (size_t)u * 16384 + (16 * wave + fr) * 128 + 4 * fq;
#pragma unroll
            for (int ct = 0; ct < 8; ++ct) *(f32x4*)(kv + 16 * ct) = acc[ct];
            __syncthreads(); } }
        for (int r0 = gw; r0 < MP; r0 += 2 * NGW) { const int r1 = r0 + NGW;
            const bf16* p0 = Z + (size_t)r0 * NIN + 5120 + 16 * lane; const bf16* p1 = Z + (size_t)(r1 < MP ? r1 : r0) * NIN + 5120 + 16 * lane;
            const v4u xa0 = *(const v4u*)p0, xa1 = *(const v4u*)(p0 + 8), xb0 = *(const v4u*)p1, xb1 = *(const v4u*)(p1 + 8);
            float va[16], vb[16];
#pragma unroll
            for (int j = 0; j < 4; ++j) { va[2 * j] = lo16(xa0[j]); va[2 * j + 1] = hi16(xa0[j]); va[8 + 2 * j] = lo16(xa1[j]); va[8 + 2 * j + 1] = hi16(xa1[j]);
                                          vb[2 * j] = lo16(xb0[j]); vb[2 * j + 1] = hi16(xb0[j]); vb[8 + 2 * j] = lo16(xb1[j]); vb[8 + 2 * j + 1] = hi16(xb1[j]); }
            float sa = 0.f, sb = 0.f;
#pragma unroll
            for (int j = 0; j < 16; ++j) { sa += va[j]; sb += vb[j]; }
            const float ma = wave_sum(sa) * (1.0f / 1024.0f), mb = wave_sum(sb) * (1.0f / 1024.0f); float qa = 0.f, qb = 0.f;
#pragma unroll
            for (int j = 0; j < 16; ++j) { const float da = va[j] - ma, db = vb[j] - mb; qa += da * da; qb += db * db; }
            const float ra = __builtin_amdgcn_rsqf(wave_sum(qa) * (1.0f / 1024.0f) + EPS), rb = __builtin_amdgcn_rsqf(wave_sum(qb) * (1.0f / 1024.0f) + EPS);
            if (lane == 0) { STATS[2 * r0] = ma; STATS[2 * r0 + 1] = ra; if (r1 < MP) { STATS[2 * r1] = mb; STATS[2 * r1 + 1] = rb; } } }
        for (int row = MP + gw; row < MT; row += NGW) { const bf16* p = Z + (size_t)row * NIN + 5120 + 16 * lane; const v4u x0 = *(const v4u*)p, x1 = *(const v4u*)(p + 8);
            const int s_ = row - MP, c0 = 16 * lane, grp = lane >> 3; const float w00 = gm_ws[grp * 16384], b0 = gm_bs[grp * 128];
            const bf16* up = Z + (size_t)row * NIN + 4096 + c0; const v4u u0 = *(const v4u*)up, u1 = *(const v4u*)(up + 8);
            float v[16];
#pragma unroll
            for (int j = 0; j < 4; ++j) { v[2 * j] = lo16(x0[j]); v[2 * j + 1] = hi16(x0[j]); v[8 + 2 * j] = lo16(x1[j]); v[8 + 2 * j + 1] = hi16(x1[j]); }
            float s = 0.f;
#pragma unroll
            for (int j = 0; j < 16; ++j) s += v[j];
            const float mean = wave_sum(s) * (1.0f / 1024.0f); float q = 0.f;
#pragma unroll
            for (int j = 0; j < 16; ++j) { v[j] -= mean; q += v[j] * v[j]; }
            const float rstd = __builtin_amdgcn_rsqf(wave_sum(q) * (1.0f / 1024.0f) + EPS);
            float uu[16];
#pragma unroll
            for (int j = 0; j < 4; ++j) { uu[2 * j] = lo16(u0[j]); uu[2 * j + 1] = hi16(u0[j]); uu[8 + 2 * j] = lo16(u1[j]); uu[8 + 2 * j + 1] = hi16(u1[j]); }
            float vn[16], mo[16];
#pragma unroll
            for (int j = 0; j < 16; ++j) { vn[j] = v[j] * rstd * gm_ln_g[c0 + j] + gm_ln_b[c0 + j]; mo[j] = uu[j] * (w00 * vn[j] + b0); }
            float* gv = out + O_GMV + (size_t)s_ * 1024 + c0;
#pragma unroll
            for (int j = 0; j < 4; ++j) *(f32x4*)(gv + 4 * j) = (f32x4){vn[4 * j], vn[4 * j + 1], vn[4 * j + 2], vn[4 * j + 3]};
            v4u w0, w1;
#pragma unroll
            for (int j = 0; j < 4; ++j) { w0[j] = pk2(mo[2 * j], mo[2 * j + 1]); w1[j] = pk2(mo[8 + 2 * j], mo[8 + 2 * j + 1]); }
            bf16* mp = MIX + (size_t)row * D + 1024 + c0; *(v4u*)mp = w0; *(v4u*)(mp + 8) = w1; }
    }
    SEAM(2);

    if (IN(3)) {
        LAS bf16* T0 = (LAS bf16*)lds; LAS bf16* T1 = (LAS bf16*)(lds + TILE_B); LAS bf16* T2 = (LAS bf16*)(lds + 2 * TILE_B); LAS bf16* T3 = (LAS bf16*)(lds + 3 * TILE_B);
        for (int u = blk; u < 512; u += G) { const int bh = u >> 4, b = bh >> 3, h = bh & 7, c = u < 256 ? (u & 15) : 15 - (u & 15); const size_t R0 = (size_t)b * SEQ + 128 * c; const float l2g = a.log2g[h];
            const int i_ = 16 * wave + fr;
            RopeX qx, kx; RopeCS cs; TileX vx; v2u gg[8];
            const float* kvb = KV + (size_t)bh * 16 * 16384;
            f32x4 tc[8];
#pragma unroll
            for (int i = 0; i < 8; ++i) tc[i] = *(const f32x4*)(kvb + 4 * (tid + 512 * i));
            rope_load(qx, Z + R0 * NIN + 128 * h, tid); rope_load(kx, Z + R0 * NIN + 1024 + 128 * h, tid); rope_cs_load(cs, ROPE + (size_t)(128 * c) * 128, tid); tile_load(vx, Z + R0 * NIN + 2048 + 128 * h, tid);
            rope_commit<false, false>(T0, qx, cs, 1.0f, 0.f, tid);
            rope_commit<false, false>(T1, kx, cs, 0.08838834764831845f, 0.f, tid);
            asm volatile("" ::: "memory");
            { const float Gc = __builtin_amdgcn_exp2f(l2g * 128.0f);
              f32x4 sp[8];
#pragma unroll
              for (int i = 0; i < 8; ++i) sp[i] = (f32x4){0.f, 0.f, 0.f, 0.f};
              for (int j = 0; j < c; ++j) { f32x4 tn[8];
#pragma unroll
                  for (int i = 0; i < 8; ++i) tn[i] = *(const f32x4*)(kvb + (size_t)(j + 1) * 16384 + 4 * (tid + 512 * i));
#pragma unroll
                  for (int i = 0; i < 8; ++i) { sp[i] = sp[i] * Gc + tc[i]; tc[i] = tn[i]; } }
              if (c == 15) {
#pragma unroll
                  for (int i = 0; i < 8; ++i) *(f32x4*)(out + O_RETP + (size_t)bh * 16384 + 4 * (tid + 512 * i)) = sp[i] * Gc + tc[i]; }
#pragma unroll
              for (int i = 0; i < 8; ++i) { const int ch = tid + 512 * i, d = ch >> 5, e4 = ch & 31;
#pragma unroll
                  for (int t = 0; t < 4; ++t) T3[(4 * e4 + t) * LDP + d] = f2bf(sp[i][t]); } }
            tile_commit_T(T2, vx, tid);
            __syncthreads();
            { const bf16* gp = Z + (R0 + i_) * NIN + 3072 + 128 * h + 4 * fq;
#pragma unroll
              for (int ct = 0; ct < 8; ++ct) gg[ct] = *(const v2u*)(gp + 16 * ct); }
            f32x4 acc2[8], acc1[8];
#pragma unroll
            for (int ct = 0; ct < 8; ++ct) { acc2[ct] = (f32x4){0.f, 0.f, 0.f, 0.f}; acc1[ct] = (f32x4){0.f, 0.f, 0.f, 0.f}; }
            mm128(acc2, T0, T3, wave, fr, fq);
            mm128(acc1, T0, T1, wave, fr, fq);
            __syncthreads();
#pragma unroll
            for (int ct = 0; ct < 8; ++ct) { float sv[4];
#pragma unroll
                for (int t = 0; t < 4; ++t) { const int j = 16 * ct + 4 * fq + t; sv[t] = i_ >= j ? acc1[ct][t] * __builtin_amdgcn_exp2f(l2g * (float)(i_ - j)) : 0.f; }
                v2u w; w.x = pk2(sv[0], sv[1]); w.y = pk2(sv[2], sv[3]); *(LAS v2u*)(T1 + i_ * LDP + 16 * ct + 4 * fq) = w; }
            __syncthreads();
#pragma unroll
            for (int ct = 0; ct < 8; ++ct) acc1[ct] = (f32x4){0.f, 0.f, 0.f, 0.f};
            mm128(acc1, T1, T2, wave, fr, fq);
            const float qd = __builtin_amdgcn_exp2f(l2g * (float)(i_ + 1)); float ssq = 0.f;
#pragma unroll
            for (int ct = 0; ct < 8; ++ct) { acc1[ct] = acc1[ct] + acc2[ct] * qd; ssq += (acc1[ct][0] * acc1[ct][0] + acc1[ct][1] * acc1[ct][1]) + (acc1[ct][2] * acc1[ct][2] + acc1[ct][3] * acc1[ct][3]); }
            ssq += __shfl_xor(ssq, 16); ssq += __shfl_xor(ssq, 32);
            const float rn = __builtin_amdgcn_rsqf(ssq * (1.0f / 128.0f) + EPS);
            bf16* mp = MIX + (R0 + i_) * D + 128 * h + 4 * fq;
#pragma unroll
            for (int ct = 0; ct < 8; ++ct) { v2u w;
                w.x = pk2(acc1[ct][0] * rn * lo16(gg[ct].x), acc1[ct][1] * rn * hi16(gg[ct].x)); w.y = pk2(acc1[ct][2] * rn * lo16(gg[ct].y), acc1[ct][3] * rn * hi16(gg[ct].y)); *(v2u*)(mp + 16 * ct) = w; }
            __syncthreads(); }
        for (int u = blk; u < 512; u += G) { const int b = u >> 7, c = (u >> 3) & 15, grp = u & 7; const size_t R0 = (size_t)b * SEQ + 128 * c;
            const int t_ = 16 * wave + fr, d8 = tid & 15;
            f32x4 wl[4][2]; v4u xv[4]; float st[4][2]; v2u uu[8]; float lg[8], lb[8];
#pragma unroll
            for (int it = 0; it < 4; ++it) { const int idx = tid + 512 * it, t = idx >> 4; const float* wp = gm_ws + (size_t)grp * 16384 + t * 128 + 8 * d8;
                wl[it][0] = *(const f32x4*)wp; wl[it][1] = *(const f32x4*)(wp + 4);
                xv[it] = *(const v4u*)(Z + (R0 + t) * NIN + 5120 + 128 * grp + 8 * d8); st[it][0] = STATS[2 * (R0 + t)]; st[it][1] = STATS[2 * (R0 + t) + 1]; }
#pragma unroll
            for (int j = 0; j < 8; ++j) { lg[j] = gm_ln_g[128 * grp + 8 * d8 + j]; lb[j] = gm_ln_b[128 * grp + 8 * d8 + j]; }
            const float bsv = gm_bs[grp * 128 + t_];
#pragma unroll
            for (int it = 0; it < 4; ++it) { const int idx = tid + 512 * it, t = idx >> 4;
                float wv[8] = {wl[it][0][0], wl[it][0][1], wl[it][0][2], wl[it][0][3], wl[it][1][0], wl[it][1][1], wl[it][1][2], wl[it][1][3]};
#pragma unroll
                for (int j = 0; j < 8; ++j) if (8 * d8 + j > t) wv[j] = 0.f;
                v4u w; w.x = pk2(wv[0], wv[1]); w.y = pk2(wv[2], wv[3]); w.z = pk2(wv[4], wv[5]); w.w = pk2(wv[6], wv[7]); *(LAS v4u*)(T0 + t * LDP + 8 * d8) = w;
                const float mean = st[it][0], rstd = st[it][1];
#pragma unroll
                for (int p = 0; p < 4; ++p) { T1[(8 * d8 + 2 * p) * LDP + t] = f2bf((lo16(xv[it][p]) - mean) * rstd * lg[2 * p] + lb[2 * p]); T1[(8 * d8 + 2 * p + 1) * LDP + t] = f2bf((hi16(xv[it][p]) - mean) * rstd * lg[2 * p + 1] + lb[2 * p + 1]); } }
            __syncthreads();
            { const bf16* up = Z + (R0 + t_) * NIN + 4096 + 128 * grp + 4 * fq;
#pragma unroll
              for (int ct = 0; ct < 8; ++ct) uu[ct] = *(const v2u*)(up + 16 * ct); }
            f32x4 acc[8];
#pragma unroll
            for (int ct = 0; ct < 8; ++ct) acc[ct] = (f32x4){0.f, 0.f, 0.f, 0.f};
            mm128(acc, T0, T1, wave, fr, fq);
            bf16* mp = MIX + (R0 + t_) * D + 1024 + 128 * grp + 4 * fq;
#pragma unroll
            for (int ct = 0; ct < 8; ++ct) { v2u w;
                w.x = pk2((acc[ct][0] + bsv) * lo16(uu[ct].x), (acc[ct][1] + bsv) * hi16(uu[ct].x)); w.y = pk2((acc[ct][2] + bsv) * lo16(uu[ct].y), (acc[ct][3] + bsv) * hi16(uu[ct].y)); *(v2u*)(mp + 16 * ct) = w; }
            __syncthreads(); }
    }
    SEAM(3);

    if (IN(4)) {
        { pg8::Gemm g{MIX, Wo_t, MP, D, D}; pg8::StaticOrder S; S.init(MP, D, G, blk); EpiRes<false> E{x_p, AB, SS1};
          pg8::gemm_phase<EpiRes<false>, pg8::StaticOrder, true, true>(lds, g, S, E); }
        auto f = [&](int s, int n, float v) { const float o = x_s[(size_t)s * D + n] + v; AB[(size_t)(MP + s) * D + n] = f2bf(o);
            const float q = half_wave_sum(o * o); if ((lane & 31) == 0) atomic_addf(SS1 + MP + s, q); };
        skinny_gemm<2>(lds, MIX + (size_t)MP * D, Wo_t, D, D, blk, G, f);
    }
    SEAM(4);

    if (IN(5)) {
        { pg8::Gemm g{AB, Wup_t, MP, NUP, D}; pg8::StaticOrder S; S.init(MP, NUP, G, blk); EpiUp E{ACT, RAW, SS1, conv_w, conv_b, (LAS float*)(lds + 131072)};
          pg8::gemm_phase<EpiUp, pg8::StaticOrder, true, true>(lds, g, S, E); }
        { pg8::Gemm g{AB, Wup_t, MP + 256, NUP, D}; SampleOrder S{(blk >= 128 && blk - 128 < NUP / 256) ? blk - 128 : -1}; EpiAS E{AS, SS1};
          pg8::gemm_phase<EpiAS, SampleOrder, true, true>(lds, g, S, E); }
    }
    SEAM(5);

    if (IN(6)) {
        for (int i = gt; i < 128 * 2 * (DFF / 4); i += NGT) { const int c4 = i % (DFF / 4), gr = i / (DFF / 4), rr = gr & 1, Gp = gr >> 1, c = 4 * c4; const bool first = (Gp & 31) == 0;
            const float* rg = RAW + (size_t)Gp * 4 * NUP; const float* rp = rg - 4 * NUP; const f32x4 z4 = {0.f, 0.f, 0.f, 0.f};
            f32x4 a0g, a0u, a1g, a1u, a2g, a2u;
            a0g = *(const f32x4*)(rg + (2 + rr) * NUP + c); a0u = *(const f32x4*)(rg + (2 + rr) * NUP + DFF + c);
            if (rr) { a1g = *(const f32x4*)(rg + 2 * NUP + c); a1u = *(const f32x4*)(rg + 2 * NUP + DFF + c); a2g = first ? z4 : *(const f32x4*)(rp + NUP + c); a2u = first ? z4 : *(const f32x4*)(rp + NUP + DFF + c); }
            else { a1g = first ? z4 : *(const f32x4*)(rp + NUP + c); a1u = first ? z4 : *(const f32x4*)(rp + NUP + DFF + c); a2g = first ? z4 : *(const f32x4*)(rp + c); a2u = first ? z4 : *(const f32x4*)(rp + DFF + c); }
            const f32x4 ag = *(const f32x4*)(conv_w + c) * a2g + *(const f32x4*)(conv_w + NUP + c) * a1g + *(const f32x4*)(conv_w + 2 * NUP + c) * a0g + *(const f32x4*)(conv_b + c);
            const f32x4 au = *(const f32x4*)(conv_w + DFF + c) * a2u + *(const f32x4*)(conv_w + NUP + DFF + c) * a1u + *(const f32x4*)(conv_w + 2 * NUP + DFF + c) * a0u + *(const f32x4*)(conv_b + DFF + c);
            v2u w; w.x = pk2(silu_(ag[0]) * au[0], silu_(ag[1]) * au[1]); w.y = pk2(silu_(ag[2]) * au[2], silu_(ag[3]) * au[3]);
            *(v2u*)(ACT + (size_t)(64 * Gp + rr) * DFF + c) = w; }
        for (int i = gt; i < MS * (DFF / 4); i += NGT) { const int c4 = i % (DFF / 4), s = i / (DFF / 4), c = 4 * c4;
            const float* sc0 = state_conv + (size_t)s * 2 * NUP; const float* sc1 = sc0 + NUP; const float* as = AS + (size_t)s * NUP;
            const f32x4 a0g = *(const f32x4*)(as + c), a0u = *(const f32x4*)(as + DFF + c), a1g = *(const f32x4*)(sc1 + c), a1u = *(const f32x4*)(sc1 + DFF + c), a2g = *(const f32x4*)(sc0 + c), a2u = *(const f32x4*)(sc0 + DFF + c);
            const f32x4 ag = *(const f32x4*)(conv_w + c) * a2g + *(const f32x4*)(conv_w + NUP + c) * a1g + *(const f32x4*)(conv_w + 2 * NUP + c) * a0g + *(const f32x4*)(conv_b + c);
            const f32x4 au = *(const f32x4*)(conv_w + DFF + c) * a2u + *(const f32x4*)(conv_w + NUP + DFF + c) * a1u + *(const f32x4*)(conv_w + 2 * NUP + DFF + c) * a0u + *(const f32x4*)(conv_b + DFF + c);
            v2u w; w.x = pk2(silu_(ag[0]) * au[0], silu_(ag[1]) * au[1]); w.y = pk2(silu_(ag[2]) * au[2], silu_(ag[3]) * au[3]);
            *(v2u*)(ACT + (size_t)(MP + s) * DFF + c) = w;
            float* cs = out + O_CONVS + (size_t)s * 2 * NUP; *(f32x4*)(cs + c) = a1g; *(f32x4*)(cs + DFF + c) = a1u; *(f32x4*)(cs + NUP + c) = a0g; *(f32x4*)(cs + NUP + DFF + c) = a0u; }
        for (int i = gt; i < 4 * 2 * (NUP / 4); i += NGT) { const int c4 = i % (NUP / 4), bk = i / (NUP / 4), b = bk >> 1, k = bk & 1;
            *(f32x4*)(out + O_CONVP + (size_t)bk * NUP + 4 * c4) = *(const f32x4*)(RAW + ((size_t)(32 * b + 31) * 4 + k) * NUP + 4 * c4); }
    }
    SEAM(6);

    if (IN(7)) {
        { pg8::Gemm g{ACT, Wdn_t, MP, D, DFF}; pg8::StaticOrder S; S.init(MP, D, G, blk); EpiRes<true> E{nullptr, AB, SS2};
          pg8::gemm_phase<EpiRes<true>, pg8::StaticOrder, true, true>(lds, g, S, E); }
        auto f = [&](int s, int n, float v) { const size_t o_ = (size_t)(MP + s) * D + n; const float o = bf2f(AB[o_]) + v; AB[o_] = f2bf(o);
            const float q = half_wave_sum(o * o); if ((lane & 31) == 0) atomic_addf(SS2 + MP + s, q); };
        skinny_gemm<2>(lds, ACT + (size_t)MP * DFF, Wdn_t, D, DFF, blk, G, f);
    }
    SEAM(7);

    if (IN(8)) {
#ifndef T_A
        { int Kp = PLE; asm volatile("" : "+s"(Kp));
          pg8::Gemm g{PB, Wp_t, MP, D, Kp}; pg8::StaticOrder S; S.init(MP, D, G, blk); EpiPP E{PP};
          pg8::gemm_phase<EpiPP, pg8::StaticOrder, true, true>(lds, g, S, E); }
#endif
#ifndef T_B
        { pg8::Gemm g{AB, Wg_t, MP, D, D}; pg8::StaticOrder S; S.init(MP, D, G, blk); EpiGate E{PP, AB, out, SS2, SS3};
          pg8::gemm_phase<EpiGate, pg8::StaticOrder, true, true>(lds, g, S, E); }
#endif
#ifndef T_C
        auto f1 = [&](int s, int n, float v) { PP[(size_t)(MP + s) * D + n] = f2bf(v); };
        skinny_gemm<2>(lds, PB + (size_t)MP * PLE, Wp_t, D, PLE, blk, G, f1);
#endif
#ifndef T_D
        auto f2 = [&](int s, int n, float v) { const size_t o_ = (size_t)(MP + s) * D + n; const float r2 = __builtin_amdgcn_rsqf(SS2[MP + s] * (1.0f / D) + EPS);
            const float o = bf2f(AB[o_]) + bf2f(PP[o_]) * sigmoid_(r2 * v); out[o_] = o; const float q = half_wave_sum(o * o); if ((lane & 31) == 0) atomic_addf(SS3 + MP + s, q); };
        skinny_gemm<2>(lds, AB + (size_t)MP * D, Wg_t, D, D, blk, G, f2);
#endif
    }
    SEAM(8);

    if (IN(9)) {
        for (int m = gw; m < MT; m += NGW) { f32x4* hr = (f32x4*)(out + (size_t)m * D) + lane; const f32x4* gr = (const f32x4*)g_final + lane;
            const float r = __builtin_amdgcn_rsqf(SS3[m] * (1.0f / D) + EPS);
#pragma unroll
            for (int j = 0; j < 8; ++j) hr[64 * j] = hr[64 * j] * gr[64 * j] * r; }
    }
#undef IN
#undef SEAM
}
#undef x_p
#undef x_s
#undef p_p
#undef p_s
#undef state_ret
#undef state_conv
#undef gm_ln_g
#undef gm_ln_b
#undef gm_ws
#undef gm_bs
#undef conv_w
#undef conv_b
#undef g_final
#undef out
#undef SS1
#undef SS2
#undef SS3
#undef STATS
#undef ROPE
#undef ROPES
#undef Win_t
#undef Wo_t
#undef Wup_t
#undef Wdn_t
#undef Wg_t
#undef Wp_t
#undef AB
#undef PB
#undef MIX
#undef Z
#undef ACT
#undef KV
#undef PP
#undef RAW
#undef AS

extern "C" void kernel_launch(void* const* d_in, const int* in_sizes, int n_in, void* d_out, int out_size, void* d_ws, size_t ws_size, hipStream_t stream) {
    static int grid = 0;
    if (grid == 0) {
        if (n_in != 22 || out_size != (int)O_END || ws_size < WS_END) { fprintf(stderr, "kernel_launch: unexpected shapes: n_in %d out %d ws %zu\n", n_in, out_size, ws_size); grid = -1; return; }
        int dev = 0, cus = 0, per_cu = 0;
        if (hipGetDevice(&dev) != hipSuccess || hipDeviceGetAttribute(&cus, hipDeviceAttributeMultiprocessorCount, dev) != hipSuccess) { grid = -1; return; }
        if (hipFuncSetAttribute((const void*)mk_fwd, hipFuncAttributeMaxDynamicSharedMemorySize, LDS_BYTES) != hipSuccess) { fprintf(stderr, "kernel_launch: hipFuncSetAttribute failed\n"); grid = -1; return; }
        if (hipOccupancyMaxActiveBlocksPerMultiprocessor(&per_cu, (const void*)mk_fwd, 512, LDS_BYTES) != hipSuccess || per_cu < 1) fprintf(stderr, "kernel_launch: occupancy query says %d\n", per_cu);
        (void)hipGetLastError();
        grid = cus;
        if (grid != 256) fprintf(stderr, "kernel_launch: %d CUs (built for 256)\n", grid);
    }
    if (grid < 0) return;
    if (hipMemsetAsync((char*)d_ws + WS_BAR, 0, BAR_BYTES, stream) != hipSuccess) { fprintf(stderr, "kernel_launch: memset failed\n"); return; }
    Params p{};
    for (int i = 0; i < 22; ++i) p.in[i] = (const float*)d_in[i];
    p.out = (float*)d_out; p.ws = (unsigned char*)d_ws;
    for (int h = 0; h < 8; ++h) p.log2g[h] = (float)std::log2(1.0 - std::exp2(-5.0 - (double)h));
    for (int i = 0; i < 64; ++i) p.invf[i] = powf(10000.0f, -(float)i / 64.0f);
    p.use_cg = 0; p.pad = 0;
#if MK_N_LAUNCHES == 1
    void* args[] = {&p};
#ifdef PROBE_K
    p.ph_lo = 0; p.ph_hi = PROBE_K + 1;
    (void)hipLaunchCooperativeKernel((const void*)mk_fwd, dim3(grid), dim3(512), args, LDS_BYTES, stream);
    if (hipMemsetAsync((char*)d_ws + WS_BAR, 0, BAR_BYTES, stream) != hipSuccess) return;
#endif
    p.ph_lo = 0; p.ph_hi = NPHASE;
    hipError_t e = hipLaunchCooperativeKernel((const void*)mk_fwd, dim3(grid), dim3(512), args, LDS_BYTES, stream);
    if (e != hipSuccess) fprintf(stderr, "kernel_launch: cooperative launch failed: %s\n", hipGetErrorString(e));
#else
    for (int ph = 0; ph < NPHASE; ++ph) { p.ph_lo = ph; p.ph_hi = ph + 1; hipLaunchKernelGGL(mk_fwd, dim3(grid), dim3(512), LDS_BYTES, stream, p); }
#endif
}
```

```cpp
#include <hip/hip_runtime.h>
#include <hip/hip_cooperative_groups.h>
#include <cstdio>
#include <cstdint>
#include <cmath>
namespace cg = cooperative_groups;

#ifndef MK_N_LAUNCHES
#define MK_N_LAUNCHES 1
#endif

namespace pg8 {
#define PG8_LAS __attribute__((address_space(3)))
typedef unsigned short bf16_t;
typedef short bf16x8 __attribute__((ext_vector_type(8)));
typedef float f32x4 __attribute__((ext_vector_type(4)));
typedef unsigned u32x4 __attribute__((ext_vector_type(4)));
constexpr int BM = 256, BK = 64, HALF = 128, HTB = HALF * BK * 2  , STAGE_BYTES = 8 * HTB, NXCD = 8, WGM = 8;

__host__ __device__ __forceinline__ int lds_byte(int r, int c) { const int st = (r >> 4) * 2 + (c >> 5), rr = r & 15, cc = c & 31, ob = rr * 64 + cc * 2; return st * 1024 + (ob ^ (((ob >> 9) & 1) << 5)); }
__host__ __device__ __forceinline__ void stage_rc(int b, int& R, int& C) { const int st = b / 1024, sb = b % 1024, swz = sb ^ (((sb >> 9) & 1) << 5); R = (st >> 1) * 16 + swz / 64; C = (st & 1) * 32 + (swz % 64) / 2; }
__host__ __device__ __forceinline__ int perm32(int rho) { const int n = rho >> 4, i = rho & 15; return 8 * (i >> 2) + 4 * n + (i & 3); }

struct Unit { int pm, pn; };
struct Gemm { const bf16_t* A; const bf16_t* Bt; int M, N, K; };

struct StaticOrder {
    int nM, nN, nwg, G, c;
    __host__ __device__ void init(int M, int N, int G_, int c_) { nM = M / BM; nN = N / BM; nwg = nM * nN; G = G_; c = c_; }
    __host__ __device__ bool next(int i, Unit& u) const {
        const long L = (long)i * G + c; if (L >= nwg) return false;
        int wgid = (int)L; { const int q = nwg / NXCD, r = nwg % NXCD, xcd = wgid % NXCD, off = wgid / NXCD; wgid = (xcd < r ? xcd * (q + 1) : r * (q + 1) + (xcd - r) * q) + off; }
        const int nig = WGM * nN, gid = wgid / nig, fm = gid * WGM, gsz = (nM - fm) < WGM ? (nM - fm) : WGM;
        u.pm = fm + ((wgid % nig) % gsz); u.pn = (wgid % nig) / gsz; return true;
    }
    __device__ __forceinline__ void a_ready(const Unit&) const {}
    __device__ __forceinline__ void done(const Unit&) const {}
};

__device__ __forceinline__ unsigned cvt_pk_bf16(float lo, float hi) { unsigned r; asm volatile("v_cvt_pk_bf16_f32 %0, %1, %2" : "=v"(r) : "v"(lo), "v"(hi)); return r; }
typedef float f32x2 __attribute__((ext_vector_type(2)));

template <class Epi, class Sched, bool ALIGN_EPI = false, bool SP2 = false>
__device__ __forceinline__ void gemm_phase(PG8_LAS unsigned char* lds, const Gemm g, const Sched& S, const Epi& E) {
    const int tid = threadIdx.x, wid = __builtin_amdgcn_readfirstlane(tid >> 6), lane = tid & 63, wr = wid >> 2, wc = wid & 3, fr = lane & 15, fq = lane >> 4;
    const int K = g.K, nt = K / BK;
    unsigned voffA[2], voffB[2];
#pragma unroll
    for (int i = 0; i < 2; ++i) { int R, C; stage_rc(tid * 16 + i * 8192, R, C); const int Rb = Epi::PERM ? ((R & ~31) + perm32(R & 31)) : R;
        voffA[i] = (unsigned)(R * K + C) * 2u; voffB[i] = (unsigned)(Rb * K + C) * 2u; }
    const size_t kstep = (size_t)(BK * 2);
    const size_t hstep = (size_t)HALF * K * 2;
    const size_t tstep = 2 * hstep;
    const unsigned ldsw = (unsigned)wid * 1024u;
    const int aoff = lds_byte(wr * 64 + fr, fq * 8), boff = lds_byte(wc * 32 + fr, fq * 8);
#define PG8_SA(b, h) (((b) * 2 + (h)) * HTB)
#define PG8_SB(b, h) ((4 + (b) * 2 + (h)) * HTB)
#define PG8_STAGE(bufoff, gbase, voff) do { _Pragma("unroll") for (int _i = 0; _i < 2; ++_i) \
        __builtin_amdgcn_global_load_lds((const unsigned*)((const char*)(gbase) + (voff)[_i]), (PG8_LAS unsigned*)(lds + (bufoff) + ldsw + _i * 8192), 16, 0, 0); } while (0)
#define PG8_LDA(dst, b, h) do { _Pragma("unroll") for (int m = 0; m < 4; ++m) _Pragma("unroll") for (int k = 0; k < 2; ++k) dst[m][k] = *(const PG8_LAS bf16x8*)(lds + PG8_SA(b, h) + aoff + m * 2048 + k * 1024); } while (0)
#define PG8_LDB(dst, b, h) do { _Pragma("unroll") for (int n = 0; n < 2; ++n) _Pragma("unroll") for (int k = 0; k < 2; ++k) dst[n][k] = *(const PG8_LAS bf16x8*)(lds + PG8_SB(b, h) + boff + n * 2048 + k * 1024); } while (0)
#define PG8_MMA(ai, bj, At, Bt) do { __builtin_amdgcn_s_setprio(1); _Pragma("unroll") for (int m = 0; m < 4; ++m) _Pragma("unroll") for (int n = 0; n < 2; ++n) _Pragma("unroll") for (int k = 0; k < 2; ++k) \
        acc[ai][bj][m][n] = __builtin_amdgcn_mfma_f32_16x16x32_bf16(Bt[n][k], At[m][k], acc[ai][bj][m][n], 0, 0, 0); __builtin_amdgcn_s_setprio(0); } while (0)
#define PG8_WAIT_V(n) asm volatile("s_waitcnt vmcnt(" #n ")" ::: "memory")
#define PG8_WAIT_L(n) asm volatile("s_waitcnt lgkmcnt(" #n ")" ::: "memory")
#define PG8_BAR __builtin_amdgcn_s_barrier()
#define PG8_SCHED __builtin_amdgcn_sched_barrier(0)
    Unit cur, nxt; int ui = 0;
    if (!S.next(0, cur)) return;
    f32x4 acc[2][2][4][2];
#pragma unroll
    for (int a = 0; a < 2; ++a)
#pragma unroll
        for (int b = 0; b < 2; ++b)
#pragma unroll
            for (int m = 0; m < 4; ++m)
#pragma unroll
                for (int n = 0; n < 2; ++n) acc[a][b][m][n] = (f32x4){0.f, 0.f, 0.f, 0.f};
    bf16x8 At[4][2], B0[2][2], B1[2][2];
    const char* cA = (const char*)g.A + (size_t)cur.pm * tstep; const char* cB = (const char*)g.Bt + (size_t)cur.pn * tstep;
    S.a_ready(cur);
    if constexpr (SP2) {
        PG8_STAGE(PG8_SB(0, 0), cB, voffB); PG8_STAGE(PG8_SB(0, 1), cB + hstep, voffB); PG8_STAGE(PG8_SA(0, 0), cA, voffA); PG8_STAGE(PG8_SA(0, 1), cA + hstep, voffA);
        if (wr == 1) PG8_BAR;
        PG8_WAIT_V(2); PG8_BAR;
        PG8_STAGE(PG8_SB(1, 0), cB + kstep, voffB); PG8_STAGE(PG8_SA(1, 0), cA + kstep, voffA); PG8_STAGE(PG8_SB(1, 1), cB + hstep + kstep, voffB);
        PG8_WAIT_V(6); PG8_BAR;
    } else {
        PG8_STAGE(PG8_SB(0, 0), cB, voffB); PG8_STAGE(PG8_SA(0, 0), cA, voffA); PG8_STAGE(PG8_SB(0, 1), cB + hstep, voffB); PG8_STAGE(PG8_SA(0, 1), cA + hstep, voffA);
        if (wr == 1) PG8_BAR;
        PG8_WAIT_V(4); PG8_BAR;
        PG8_STAGE(PG8_SB(1, 0), cB + kstep, voffB); PG8_STAGE(PG8_SA(1, 0), cA + kstep, voffA); PG8_STAGE(PG8_SB(1, 1), cB + hstep + kstep, voffB);
        PG8_WAIT_V(6); PG8_BAR;
    }
    for (;;) {
        const bool has_next = S.next(ui + 1, nxt);
        const char* nA = has_next ? (const char*)g.A + (size_t)nxt.pm * tstep : cA; const char* nB = has_next ? (const char*)g.Bt + (size_t)nxt.pn * tstep : cB;
        for (int t = 0; t < nt; t += 2) {
            const bool last = (t == nt - 2);
            const char* a1 = cA + (size_t)(t + 1) * kstep;
            const char* a2 = last ? nA : cA + (size_t)(t + 2) * kstep; const char* b2 = last ? nB : cB + (size_t)(t + 2) * kstep;
            const char* a3 = a2 + kstep; const char* b3 = b2 + kstep;
            if (last && has_next) S.a_ready(nxt);
            if constexpr (SP2) {
            PG8_LDB(B0, 0, 0); PG8_LDB(B1, 0, 1); PG8_SCHED; PG8_LDA(At, 0, 0); PG8_STAGE(PG8_SA(1, 1), a1 + hstep, voffA);
            PG8_WAIT_V(8); PG8_WAIT_L(0); PG8_BAR; PG8_MMA(0, 0, At, B0); PG8_MMA(0, 1, At, B1); PG8_BAR; PG8_SCHED;
            PG8_LDA(At, 0, 1); PG8_STAGE(PG8_SB(0, 0), b2, voffB); PG8_STAGE(PG8_SB(0, 1), b2 + hstep, voffB); PG8_STAGE(PG8_SA(0, 0), a2, voffA);
            PG8_WAIT_V(8); PG8_WAIT_L(0); PG8_BAR; PG8_MMA(1, 0, At, B0); PG8_MMA(1, 1, At, B1); PG8_BAR; PG8_SCHED;
            PG8_LDB(B0, 1, 0); PG8_LDB(B1, 1, 1); PG8_SCHED; PG8_LDA(At, 1, 0); PG8_STAGE(PG8_SA(0, 1), a2 + hstep, voffA);
            PG8_WAIT_V(8); PG8_WAIT_L(0); PG8_BAR; PG8_MMA(0, 0, At, B0); PG8_MMA(0, 1, At, B1); PG8_BAR; PG8_SCHED;
            PG8_LDA(At, 1, 1); PG8_STAGE(PG8_SB(1, 0), b3, voffB); PG8_STAGE(PG8_SB(1, 1), b3 + hstep, voffB); PG8_STAGE(PG8_SA(1, 0), a3, voffA);
            PG8_WAIT_V(8); PG8_WAIT_L(0); PG8_BAR; PG8_MMA(1, 0, At, B0); PG8_MMA(1, 1, At, B1); PG8_BAR; PG8_SCHED;
            } else {
            PG8_LDB(B0, 0, 0); PG8_SCHED; PG8_LDA(At, 0, 0); PG8_STAGE(PG8_SA(1, 1), a1 + hstep, voffA);
            PG8_WAIT_L(8); PG8_BAR; PG8_WAIT_L(0); PG8_MMA(0, 0, At, B0); PG8_BAR; PG8_SCHED;
            PG8_LDB(B1, 0, 1); PG8_STAGE(PG8_SB(0, 0), b2, voffB);
            PG8_BAR; PG8_WAIT_L(0); PG8_MMA(0, 1, At, B1); PG8_BAR;
            PG8_LDA(At, 0, 1); PG8_STAGE(PG8_SA(0, 0), a2, voffA);
            PG8_BAR; PG8_WAIT_L(0); PG8_MMA(1, 0, At, B0); PG8_BAR; PG8_SCHED;
            PG8_STAGE(PG8_SB(0, 1), b2 + hstep, voffB);
            PG8_WAIT_V(6); PG8_BAR; PG8_MMA(1, 1, At, B1); PG8_BAR;
            PG8_LDB(B0, 1, 0); PG8_SCHED; PG8_LDA(At, 1, 0); PG8_STAGE(PG8_SA(0, 1), a2 + hstep, voffA);
            PG8_WAIT_L(8); PG8_BAR; PG8_WAIT_L(0); PG8_MMA(0, 0, At, B0); PG8_BAR; PG8_SCHED;
            PG8_LDB(B1, 1, 1); PG8_STAGE(PG8_SB(1, 0), b3, voffB);
            PG8_BAR; PG8_WAIT_L(0); PG8_MMA(0, 1, At, B1); PG8_BAR;
            PG8_LDA(At, 1, 1); PG8_STAGE(PG8_SA(1, 0), a3, voffA);
            PG8_BAR; PG8_WAIT_L(0); PG8_MMA(1, 0, At, B0); PG8_BAR; PG8_SCHED;
            PG8_STAGE(PG8_SB(1, 1), b3 + hstep, voffB);
            PG8_WAIT_V(6); PG8_BAR; PG8_MMA(1, 1, At, B1); PG8_BAR;
            }
        }
        if constexpr (ALIGN_EPI) { if (wr == 0) PG8_BAR; }
        if constexpr (!Epi::AFTER_DRAIN) { E(acc, cur, wr, wc, fr, fq); S.done(cur); }
        if (!has_next) break;
#pragma unroll
        for (int a = 0; a < 2; ++a)
#pragma unroll
            for (int b = 0; b < 2; ++b)
#pragma unroll
                for (int m = 0; m < 4; ++m)
#pragma unroll
                    for (int n = 0; n < 2; ++n) acc[a][b][m][n] = (f32x4){0.f, 0.f, 0.f, 0.f};
        cur = nxt; cA = nA; cB = nB; ++ui;
        if constexpr (ALIGN_EPI) { if (wr == 1) PG8_BAR; }
    }
    PG8_WAIT_V(0);
    if constexpr (!ALIGN_EPI) { if (wr == 0) PG8_BAR; }
    PG8_BAR;
    if constexpr (Epi::AFTER_DRAIN) { E.fused(acc, cur, wr, wc, fr, fq, lds, wid, lane); S.done(cur); }
#undef PG8_SA
#undef PG8_SB
#undef PG8_STAGE
#undef PG8_LDA
#undef PG8_LDB
#undef PG8_MMA
#undef PG8_WAIT_V
#undef PG8_WAIT_L
#undef PG8_BAR
#undef PG8_SCHED
}
}

#define GAS __attribute__((address_space(1)))
#define LAS __attribute__((address_space(3)))
typedef unsigned short bf16;
typedef unsigned v4u __attribute__((ext_vector_type(4)));
typedef unsigned v2u __attribute__((ext_vector_type(2)));
typedef float f32x4 __attribute__((ext_vector_type(4)));
typedef float f32x2 __attribute__((ext_vector_type(2)));
typedef short bf16x8 __attribute__((ext_vector_type(8)));
#define XB_TMO      128
#define XB_XCNT(j)  (256  + 64 * (j))
#define XB_XSUB(j)  (1280 + 64 * (j))
#define XB_XGEN(j)  (2304 + 64 * (j))
#define XB_TOP      3328
#define XB_TOPGEN   3392
#define XCD_BAR_WORDS 3456
#define XB_SPIN_CAP (1u << 18)

__device__ __forceinline__ unsigned xb_ld(unsigned* p)              { return __hip_atomic_load(p, __ATOMIC_RELAXED, __HIP_MEMORY_SCOPE_AGENT); }
__device__ __forceinline__ unsigned xb_add(unsigned* p, unsigned v) { return __hip_atomic_fetch_add(p, v, __ATOMIC_RELAXED, __HIP_MEMORY_SCOPE_AGENT); }
__device__ __forceinline__ unsigned xb_xcc_id() { return (unsigned)__builtin_amdgcn_s_getreg((3 << 11) | 20) & 0xFu; }
#define XB_SPIN(cond, bar) do { unsigned _sp = 0; while (cond) { __builtin_amdgcn_s_sleep(1); \
    if ((++_sp & 255u) == 0u) { if (xb_ld(&(bar)[XB_TMO])) break; if (_sp > XB_SPIN_CAP) { atomicAdd(&(bar)[XB_TMO], 1u); break; } } } } while (0)

struct XcdBarrier {
    unsigned* bar; unsigned x;
    volatile LAS unsigned* st;
};

__device__ __forceinline__ XcdBarrier xcd_barrier_post(unsigned* bar, volatile LAS unsigned* st) {
    XcdBarrier b; b.bar = bar; b.x = xb_xcc_id(); b.st = st;
    if (threadIdx.x == 0) (void)xb_add(&bar[XB_XCNT(b.x)], 1u);
    return b;
}
__device__ __forceinline__ void xcd_barrier_complete(unsigned* bar, unsigned x, unsigned& nloc, unsigned& nx) {
    const unsigned G = gridDim.x * gridDim.y * gridDim.z;
    unsigned sum, cnt, mine, sp = 0u;
    for (;;) {
        sum = 0u; cnt = 0u; mine = 0u;
#pragma unroll
        for (unsigned j = 0; j < 16; ++j) { const unsigned c = xb_ld(&bar[XB_XCNT(j)]); sum += c; cnt += (c > 0u) ? 1u : 0u; mine = (j == x) ? c : mine; }
        if (sum == G) break;
        __builtin_amdgcn_s_sleep(1);
        if ((++sp & 255u) == 0u) { if (xb_ld(&bar[XB_TMO])) break; if (sp > XB_SPIN_CAP) { atomicAdd(&bar[XB_TMO], 1u); break; } }
    }
    nloc = mine > 0u ? mine : 1u; nx = cnt > 0u ? cnt : 1u;
}

__device__ __forceinline__ void xcd_barrier(const XcdBarrier& b) {
    asm volatile("s_waitcnt vmcnt(0)" ::: "memory");
    __syncthreads();
    if (threadIdx.x == 0) {
        unsigned* bar = b.bar;
        __builtin_amdgcn_s_waitcnt(0);
        unsigned nloc = b.st[0], nx = b.st[1];
        if (nloc == 0u) { xcd_barrier_complete(bar, b.x, nloc, nx); b.st[0] = nloc; b.st[1] = nx; }
        const unsigned old = xb_add(&bar[XB_XSUB(b.x)], 1u);
        const unsigned gen = old / nloc;
        if (old + 1u == (gen + 1u) * nloc) {
            __builtin_amdgcn_fence(__ATOMIC_RELEASE, "agent");
            asm volatile("s_waitcnt vmcnt(0)" ::: "memory");
            const unsigned og = xb_add(&bar[XB_TOP], 1u);
            const unsigned tg = og / nx;
            if (og + 1u == (tg + 1u) * nx) xb_add(&bar[XB_TOPGEN], 1u);
            else XB_SPIN(xb_ld(&bar[XB_TOPGEN]) == tg, bar);
            __builtin_amdgcn_fence(__ATOMIC_ACQUIRE, "agent");
            xb_add(&bar[XB_XGEN(b.x)], 1u);
            asm volatile("s_waitcnt vmcnt(0)" ::: "memory");
        } else {
            XB_SPIN(xb_ld(&bar[XB_XGEN(b.x)]) == gen, bar);
            __builtin_amdgcn_fence(__ATOMIC_ACQUIRE, "agent");
            asm volatile("s_waitcnt vmcnt(0)" ::: "memory");
        }
    }
    __syncthreads();
}

constexpr int MP = 8192, MS = 128, MT = MP + MS, D = 2048, NIN = 6144, NUP = 11264, DFF = 5632, PLE = 256, SEQ = 2048, NH = 8;
constexpr float EPS = 1e-6f;
constexpr int NPHASE = 10;
constexpr size_t MiB = 1u << 20;
constexpr size_t WS_BAR = 0, BAR_BYTES = 16384;
constexpr size_t WS_SS1 = 64 * 1024, WS_SS2 = 128 * 1024, WS_SS3 = 192 * 1024, WS_STATS = 256 * 1024;
constexpr size_t WS_ROPE = 1 * MiB, WS_ROPES = 2 * MiB;
constexpr size_t WS_WIN = 4 * MiB, WS_WO = 28 * MiB, WS_WUP = 36 * MiB, WS_WDN = 80 * MiB, WS_WG = 102 * MiB, WS_WP = 110 * MiB;
constexpr size_t WS_AB = 112 * MiB, WS_PB = 145 * MiB, WS_MIX = 150 * MiB, WS_Z = 183 * MiB, WS_ACT = 183 * MiB, WS_KV = 281 * MiB, WS_PP = 281 * MiB;
constexpr size_t WS_RAW = 313 * MiB, WS_AS = 335 * MiB, WS_END = 346 * MiB;
static_assert(WS_AB + (size_t)MT * D * 2 <= WS_PB && WS_PB + (size_t)MT * PLE * 2 <= WS_MIX && WS_MIX + (size_t)MT * D * 2 <= WS_Z, "ws map 1");
static_assert(WS_Z + (size_t)MT * NIN * 2 <= WS_KV && WS_ACT + (size_t)MT * DFF * 2 <= WS_KV && WS_KV + (size_t)512 * 16384 * 4 <= WS_RAW, "ws map 2");
static_assert(WS_RAW + (size_t)128 * 4 * NUP * 4 <= WS_AS && WS_AS + (size_t)MS * NUP * 4 <= WS_END && WS_PP + (size_t)MT * D * 4 <= WS_END, "ws map 3");
constexpr size_t O_RETP = 17039360, O_CONVP = 17563648, O_RETS = 17653760, O_CONVS = 34430976, O_GMV = 37314560, O_END = 37445632;
constexpr int LDS_BYTES = 147456, MISC_OFF = LDS_BYTES - 256;
constexpr int LDP = 136;
constexpr int TILE_B = 128 * LDP * 2;

struct Params { const float* in[22]; float* out; unsigned char* ws; float log2g[8]; float invf[64]; int ph_lo, ph_hi, use_cg, pad; };

#define LDS_WAIT() asm volatile("s_waitcnt lgkmcnt(0)" ::: "memory")
__device__ __forceinline__ float lo16(unsigned u) { return __uint_as_float(u << 16); }
__device__ __forceinline__ float hi16(unsigned u) { return __uint_as_float(u & 0xffff0000u); }
__device__ __forceinline__ float bf2f(bf16 b) { return __uint_as_float((unsigned)b << 16); }
__device__ __forceinline__ unsigned pk2(float lo, float hi) { return pg8::cvt_pk_bf16(lo, hi); }
__device__ __forceinline__ bf16 f2bf(float f) { return (bf16)(pg8::cvt_pk_bf16(f, 0.f) & 0xffffu); }
__device__ __forceinline__ float sigmoid_(float x) { return __builtin_amdgcn_rcpf(1.0f + __builtin_amdgcn_exp2f(-1.44269504089f * x)); }
__device__ __forceinline__ float silu_(float x) { return x * sigmoid_(x); }
__device__ __forceinline__ float gelu_(float x) { return x * sigmoid_(1.5957691216f * (x + 0.044715f * x * x * x)); }
__device__ __forceinline__ float wave_sum(float v) {
#pragma unroll
    for (int o = 1; o < 64; o <<= 1) v += __shfl_xor(v, o);
    return v;
}
__device__ __forceinline__ void atomic_addf(float* p, float v) { (void)__hip_atomic_fetch_add(p, v, __ATOMIC_RELAXED, __HIP_MEMORY_SCOPE_AGENT); }
template <int CTRL> __device__ __forceinline__ float dppf(float x) { return __int_as_float(__builtin_amdgcn_mov_dpp(__float_as_int(x), CTRL, 0xf, 0xf, false)); }

using pg8::Unit;
struct EpiZ {
    static constexpr bool PERM = true, AFTER_DRAIN = false;
    bf16* Z;
    __device__ __forceinline__ void operator()(const f32x4 (&acc)[2][2][4][2], const Unit& u, int wr, int wc, int fr, int fq) const {
        const int row0 = u.pm * 256 + wr * 64 + fr, col0 = u.pn * 256 + wc * 32 + 8 * fq;
        const int mode = u.pn < 12 ? 0 : (u.pn < 16 ? 1 : 2);
#pragma unroll
        for (int ai = 0; ai < 2; ++ai)
#pragma unroll
            for (int m = 0; m < 4; ++m) { bf16* rowp = Z + (size_t)(row0 + ai * 128 + m * 16) * NIN + col0;
#pragma unroll
                for (int bj = 0; bj < 2; ++bj) { f32x4 v0 = acc[ai][bj][m][0], v1 = acc[ai][bj][m][1];
                    if (mode == 1) {
#pragma unroll
                        for (int j = 0; j < 4; ++j) { v0[j] = silu_(v0[j]); v1[j] = silu_(v1[j]); } }
                    else if (mode == 2) {
#pragma unroll
                        for (int j = 0; j < 4; ++j) { v0[j] = gelu_(v0[j]); v1[j] = gelu_(v1[j]); } }
                    v4u w; w.x = pk2(v0[0], v0[1]); w.y = pk2(v0[2], v0[3]); w.z = pk2(v1[0], v1[1]); w.w = pk2(v1[2], v1[3]);
                    *(v4u*)(rowp + bj * 128) = w; } }
    }
};
template <bool BASE_BF16> struct EpiRes {
    static constexpr bool PERM = true, AFTER_DRAIN = false;
    const float* base; bf16* hb; float* ss;
    __device__ __forceinline__ void operator()(const f32x4 (&acc)[2][2][4][2], const Unit& u, int wr, int wc, int fr, int fq) const {
        const int row0 = u.pm * 256 + wr * 64 + fr, col0 = u.pn * 256 + wc * 32 + 8 * fq;
        float sacc[2][4];
#pragma unroll
        for (int ai = 0; ai < 2; ++ai) {
            f32x4 bs[4][2][2];
#pragma unroll
            for (int m = 0; m < 4; ++m)
#pragma unroll
                for (int bj = 0; bj < 2; ++bj) { const size_t o_ = (size_t)(row0 + ai * 128 + m * 16) * D + col0 + bj * 128;
                    if (BASE_BF16) { const v4u w = *(const v4u*)(hb + o_); bs[m][bj][0] = (f32x4){lo16(w.x), hi16(w.x), lo16(w.y), hi16(w.y)}; bs[m][bj][1] = (f32x4){lo16(w.z), hi16(w.z), lo16(w.w), hi16(w.w)}; }
                    else { bs[m][bj][0] = *(const f32x4*)(base + o_); bs[m][bj][1] = *(const f32x4*)(base + o_ + 4); } }
#pragma unroll
            for (int m = 0; m < 4; ++m) { const size_t off = (size_t)(row0 + ai * 128 + m * 16) * D + col0; float s = 0.f;
#pragma unroll
                for (int bj = 0; bj < 2; ++bj) { const f32x4 o0 = bs[m][bj][0] + acc[ai][bj][m][0], o1 = bs[m][bj][1] + acc[ai][bj][m][1];
                    v4u w; w.x = pk2(o0[0], o0[1]); w.y = pk2(o0[2], o0[3]); w.z = pk2(o1[0], o1[1]); w.w = pk2(o1[2], o1[3]); *(v4u*)(hb + off + bj * 128) = w;
                    s += ((o0[0] * o0[0] + o0[1] * o0[1]) + (o0[2] * o0[2] + o0[3] * o0[3])) + ((o1[0] * o1[0] + o1[1] * o1[1]) + (o1[2] * o1[2] + o1[3] * o1[3])); }
                s += __shfl_xor(s, 16); s += __shfl_xor(s, 32); sacc[ai][m] = s; }
            asm volatile("" ::: "memory"); }
        if (fq == 0) {
#pragma unroll
            for (int ai = 0; ai < 2; ++ai)
#pragma unroll
                for (int m = 0; m < 4; ++m) atomic_addf(ss + row0 + ai * 128 + m * 16, sacc[ai][m]); }
    }
};
struct EpiPP {
    static constexpr bool PERM = true, AFTER_DRAIN = false;
    bf16* pp;
    __device__ __forceinline__ void operator()(const f32x4 (&acc)[2][2][4][2], const Unit& u, int wr, int wc, int fr, int fq) const {
        const int row0 = u.pm * 256 + wr * 64 + fr, col0 = u.pn * 256 + wc * 32 + 8 * fq;
#pragma unroll
        for (int ai = 0; ai < 2; ++ai)
#pragma unroll
            for (int m = 0; m < 4; ++m) { if (row0 + ai * 128 + m * 16 >= MT) continue; bf16* rowp = pp + (size_t)(row0 + ai * 128 + m * 16) * D + col0;
#pragma unroll
                for (int bj = 0; bj < 2; ++bj) { const f32x4 v0 = acc[ai][bj][m][0], v1 = acc[ai][bj][m][1]; v4u w; w.x = pk2(v0[0], v0[1]); w.y = pk2(v0[2], v0[3]); w.z = pk2(v1[0], v1[1]); w.w = pk2(v1[2], v1[3]); *(v4u*)(rowp + bj * 128) = w; } }
    }
};
struct EpiGate {
    static constexpr bool PERM = true, AFTER_DRAIN = false;
    const bf16* pp; const bf16* hb; float* h; const float* ss2; float* ss3;
    __device__ __forceinline__ void operator()(const f32x4 (&acc)[2][2][4][2], const Unit& u, int wr, int wc, int fr, int fq) const {
        const int row0 = u.pm * 256 + wr * 64 + fr, col0 = u.pn * 256 + wc * 32 + 8 * fq;
        float sacc[2][4];
#pragma unroll
        for (int ai = 0; ai < 2; ++ai) {
            v4u hw[4][2], pw[4][2]; float r2[4];
#pragma unroll
            for (int m = 0; m < 4; ++m) { const int row = row0 + ai * 128 + m * 16; r2[m] = ss2[row];
#pragma unroll
                for (int bj = 0; bj < 2; ++bj) { hw[m][bj] = *(const v4u*)(hb + (size_t)row * D + col0 + bj * 128); pw[m][bj] = *(const v4u*)(pp + (size_t)row * D + col0 + bj * 128); } }
#pragma unroll
            for (int m = 0; m < 4; ++m) { const size_t off = (size_t)(row0 + ai * 128 + m * 16) * D + col0; float s = 0.f;
                const float rr = __builtin_amdgcn_rsqf(r2[m] * (1.0f / D) + EPS);
#pragma unroll
                for (int bj = 0; bj < 2; ++bj) { const v4u h4 = hw[m][bj], p4 = pw[m][bj];
                    const f32x4 hv0 = {lo16(h4.x), hi16(h4.x), lo16(h4.y), hi16(h4.y)}, hv1 = {lo16(h4.z), hi16(h4.z), lo16(h4.w), hi16(h4.w)};
                    const f32x4 pv0 = {lo16(p4.x), hi16(p4.x), lo16(p4.y), hi16(p4.y)}, pv1 = {lo16(p4.z), hi16(p4.z), lo16(p4.w), hi16(p4.w)};
                    const f32x4 a0 = acc[ai][bj][m][0], a1 = acc[ai][bj][m][1]; f32x4 o0, o1;
#pragma unroll
                    for (int j = 0; j < 4; ++j) { o0[j] = hv0[j] + pv0[j] * sigmoid_(rr * a0[j]); o1[j] = hv1[j] + pv1[j] * sigmoid_(rr * a1[j]); }
                    *(f32x4*)(h + off + bj * 128) = o0; *(f32x4*)(h + off + bj * 128 + 4) = o1;
                    s += ((o0[0] * o0[0] + o0[1] * o0[1]) + (o0[2] * o0[2] + o0[3] * o0[3])) + ((o1[0] * o1[0] + o1[1] * o1[1]) + (o1[2] * o1[2] + o1[3] * o1[3])); }
                s += __shfl_xor(s, 16); s += __shfl_xor(s, 32); sacc[ai][m] = s; }
            asm volatile("" ::: "memory"); }
        if (fq == 0) {
#pragma unroll
            for (int ai = 0; ai < 2; ++ai)
#pragma unroll
                for (int m = 0; m < 4; ++m) atomic_addf(ss3 + row0 + ai * 128 + m * 16, sacc[ai][m]); }
    }
};
struct EpiUp {
    static constexpr bool PERM = false, AFTER_DRAIN = false;
    bf16* act; float* raw; const float* ss1; const float* cw; const float* cb; LAS float* wl;
    __device__ __forceinline__ void operator()(const f32x4 (&acc)[2][2][4][2], const Unit& u, int wr, int wc, int fr, int fq) const {
        const int row0 = u.pm * 256 + wr * 64 + fr;
        LAS float* wb = wl + (wr * 4 + wc) * 256;
        { const int l = fq * 16 + fr, v = l >> 3, c4 = l & 7;
          const float* src = ((v & 3) == 3 ? cb : cw + (v & 3) * NUP) + (v >> 2) * DFF + u.pn * 128 + wc * 32 + 4 * c4;
          *(LAS f32x4*)(wb + v * 32 + 4 * c4) = *(const f32x4*)src; }
        float rs[2][4];
#pragma unroll
        for (int ai = 0; ai < 2; ++ai)
#pragma unroll
            for (int m = 0; m < 4; ++m) rs[ai][m] = __builtin_amdgcn_rsqf(ss1[row0 + ai * 128 + m * 16] * (1.0f / D) + EPS);
#pragma unroll
        for (int n = 0; n < 2; ++n) {
            const int cg_ = u.pn * 128 + wc * 32 + 16 * n + 4 * fq;
            const volatile LAS f32x4* wv = (const volatile LAS f32x4*)(wb + 16 * n + 4 * fq);
#pragma unroll
            for (int ai = 0; ai < 2; ++ai) {
                f32x4 l1g = {0.f, 0.f, 0.f, 0.f}, l2g = l1g, l1u = l1g, l2u = l1g;
#pragma unroll
                for (int m = 0; m < 4; ++m) {
                    const int row = row0 + ai * 128 + m * 16;
                    f32x4 sg;
                    { const f32x4 g = acc[ai][0][m][n] * rs[ai][m];
                      if (m == 0 && fr < 2) *(f32x4*)(raw + ((size_t)(row >> 6) * 4 + 2 + fr) * NUP + cg_) = g;
                      if (m == 3 && fr >= 14) *(f32x4*)(raw + ((size_t)(row >> 6) * 4 + (fr - 14)) * NUP + cg_) = g;
                      f32x4 r1, r2, x1, x2;
#pragma unroll
                      for (int j = 0; j < 4; ++j) { r1[j] = dppf<0x121>(g[j]); r2[j] = dppf<0x122>(g[j]); }
#pragma unroll
                      for (int j = 0; j < 4; ++j) { x1[j] = fr == 0 ? l1g[j] : r1[j]; x2[j] = fr < 2 ? l2g[j] : r2[j]; }
                      l1g = r1; l2g = r2;
                      const f32x4 w0 = wv[0], w1 = wv[8], w2 = wv[16], bb = wv[24];
                      const f32x4 ag = w0 * x2 + w1 * x1 + w2 * g + bb;
#pragma unroll
                      for (int j = 0; j < 4; ++j) sg[j] = silu_(ag[j]);
                      asm volatile("" : "+v"(sg)); }
                    f32x4 o;
                    { const f32x4 up = acc[ai][1][m][n] * rs[ai][m];
                      if (m == 0 && fr < 2) *(f32x4*)(raw + ((size_t)(row >> 6) * 4 + 2 + fr) * NUP + DFF + cg_) = up;
                      if (m == 3 && fr >= 14) *(f32x4*)(raw + ((size_t)(row >> 6) * 4 + (fr - 14)) * NUP + DFF + cg_) = up;
                      f32x4 r1, r2, x1, x2;
#pragma unroll
                      for (int j = 0; j < 4; ++j) { r1[j] = dppf<0x121>(up[j]); r2[j] = dppf<0x122>(up[j]); }
#pragma unroll
                      for (int j = 0; j < 4; ++j) { x1[j] = fr == 0 ? l1u[j] : r1[j]; x2[j] = fr < 2 ? l2u[j] : r2[j]; }
                      l1u = r1; l2u = r2;
                      const f32x4 w0 = wv[32], w1 = wv[40], w2 = wv[48], bb = wv[56];
                      o = (w0 * x2 + w1 * x1 + w2 * up + bb) * sg; }
                    v2u w; w.x = pk2(o[0], o[1]); w.y = pk2(o[2], o[3]);
                    *(v2u*)(act + (size_t)row * DFF + cg_) = w; } } }
    }
};

struct EpiAS {
    static constexpr bool PERM = false, AFTER_DRAIN = false;
    float* as; const float* ss1;
    __device__ __forceinline__ void operator()(const f32x4 (&acc)[2][2][4][2], const Unit& u, int wr, int wc, int fr, int fq) const {
#pragma unroll
        for (int m = 0; m < 4; ++m) { const int s_ = wr * 64 + m * 16 + fr; const float r = __builtin_amdgcn_rsqf(ss1[MP + s_] * (1.0f / D) + EPS);
#pragma unroll
            for (int n = 0; n < 2; ++n) { const int cg_ = u.pn * 128 + wc * 32 + 16 * n + 4 * fq;
                *(f32x4*)(as + (size_t)s_ * NUP + cg_) = acc[0][0][m][n] * r; *(f32x4*)(as + (size_t)s_ * NUP + DFF + cg_) = acc[0][1][m][n] * r; } }
    }
};
struct SampleOrder {
    int idx;
    __device__ __forceinline__ bool next(int i, Unit& u) const { if (i != 0 || idx < 0) return false; u.pm = MP / 256; u.pn = idx; return true; }
    __device__ __forceinline__ void a_ready(const Unit&) const {}
    __device__ __forceinline__ void done(const Unit&) const {}
};

struct ProjOrder {
    int first, nw;
    __device__ __forceinline__ bool next(int i, Unit& u) const { if (first < 0) return false; const int j = first + i * nw; if (j >= (MP / 256 + 1) * (D / 256)) return false; u.pm = j >> 3; u.pn = j & 7; return true; }
    __device__ __forceinline__ void a_ready(const Unit&) const {}
    __device__ __forceinline__ void done(const Unit&) const {}
};
template <int RT, class F>
__device__ __forceinline__ void skinny_gemm(LAS unsigned char* lds, const bf16* A, const bf16* Bt, int N, int K, int u0, int ustride, const F& f) {
    const int tid = threadIdx.x, lane = tid & 63, w = tid >> 6, fr = lane & 15, fq = lane >> 4;
    constexpr int nrb = 8 / RT, ROWS = 16 * RT;
    const int nunits = nrb * (N / 32), kw = K / 8;
    LAS float* red = (LAS float*)lds;
    for (int u = u0; u < nunits; u += ustride) {
        const int rb = u % nrb, cb = u / nrb, row0 = rb * ROWS, col0 = cb * 32;
        f32x4 acc[RT][2];
#pragma unroll
        for (int rt = 0; rt < RT; ++rt) { acc[rt][0] = (f32x4){0.f, 0.f, 0.f, 0.f}; acc[rt][1] = (f32x4){0.f, 0.f, 0.f, 0.f}; }
        const bf16* ap = A + (size_t)(row0 + fr) * K + w * kw + 8 * fq;
        const bf16* bp = Bt + (size_t)(col0 + fr) * K + w * kw + 8 * fq;
        if constexpr (RT <= 2) {
            int k = 0;
            for (; k + 256 <= kw; k += 256) { bf16x8 bq[8][2], aq[8][RT];
#pragma unroll
                for (int kk = 0; kk < 8; ++kk) { bq[kk][0] = *(const bf16x8*)(bp + k + 32 * kk); bq[kk][1] = *(const bf16x8*)(bp + (size_t)16 * K + k + 32 * kk);
#pragma unroll
                    for (int rt = 0; rt < RT; ++rt) aq[kk][rt] = *(const bf16x8*)(ap + (size_t)rt * 16 * K + k + 32 * kk); }
#pragma unroll
                for (int kk = 0; kk < 8; ++kk)
#pragma unroll
                    for (int rt = 0; rt < RT; ++rt) { acc[rt][0] = __builtin_amdgcn_mfma_f32_16x16x32_bf16(bq[kk][0], aq[kk][rt], acc[rt][0], 0, 0, 0); acc[rt][1] = __builtin_amdgcn_mfma_f32_16x16x32_bf16(bq[kk][1], aq[kk][rt], acc[rt][1], 0, 0, 0); } }
            for (; k < kw; k += 32) { const bf16x8 b0 = *(const bf16x8*)(bp + k), b1 = *(const bf16x8*)(bp + (size_t)16 * K + k);
#pragma unroll
                for (int rt = 0; rt < RT; ++rt) { const bf16x8 av = *(const bf16x8*)(ap + (size_t)rt * 16 * K + k);
                    acc[rt][0] = __builtin_amdgcn_mfma_f32_16x16x32_bf16(b0, av, acc[rt][0], 0, 0, 0); acc[rt][1] = __builtin_amdgcn_mfma_f32_16x16x32_bf16(b1, av, acc[rt][1], 0, 0, 0); } }
        } else {
#pragma unroll 2
        for (int k = 0; k < kw; k += 32) {
            const bf16x8 b0 = *(const bf16x8*)(bp + k), b1 = *(const bf16x8*)(bp + (size_t)16 * K + k);
#pragma unroll
            for (int rt = 0; rt < RT; ++rt) { const bf16x8 av = *(const bf16x8*)(ap + (size_t)rt * 16 * K + k);
                acc[rt][0] = __builtin_amdgcn_mfma_f32_16x16x32_bf16(b0, av, acc[rt][0], 0, 0, 0);
                acc[rt][1] = __builtin_amdgcn_mfma_f32_16x16x32_bf16(b1, av, acc[rt][1], 0, 0, 0); }
        }
        }
#pragma unroll
        for (int rt = 0; rt < RT; ++rt)
#pragma unroll
            for (int ct = 0; ct < 2; ++ct) *(LAS f32x4*)(red + (w * ROWS + 16 * rt + fr) * 32 + 16 * ct + 4 * fq) = acc[rt][ct];
        __syncthreads();
#pragma unroll
        for (int it = 0; it < RT; ++it) { const int e = tid + 512 * it, r = e >> 5, c = e & 31; float v = 0.f;
#pragma unroll
            for (int ww = 0; ww < 8; ++ww) v += red[(ww * ROWS + r) * 32 + c];
            f(row0 + r, col0 + c, v); }
        __syncthreads();
    }
}
__device__ __forceinline__ float half_wave_sum(float v) {
#pragma unroll
    for (int o = 1; o < 32; o <<= 1) v += __shfl_xor(v, o);
    return v;
}

__device__ __forceinline__ void transpose_item(const float* W, int K, int N, const float* g, bf16* WT, bool upmap, LAS float* scr, int item, int lane) {
    const int nblk = N / 64, kb = item / nblk, nb = item % nblk, k0 = 64 * kb, n0 = 64 * nb;
    const float* src = W + (size_t)k0 * N + n0 + lane;
#pragma unroll
    for (int h = 0; h < 2; ++h) {
        float v[32];
#pragma unroll
        for (int i = 0; i < 32; ++i) v[i] = __builtin_nontemporal_load(src + (size_t)(32 * h + i) * N);
#pragma unroll
        for (int i = 0; i < 32; ++i) { float x = v[i]; if (g) x *= g[k0 + 32 * h + i]; scr[(32 * h + i) * 65 + lane] = x; }
    }
    LDS_WAIT(); asm volatile("" ::: "memory");
    const int c = lane & 7;
#pragma unroll
    for (int j = 0; j < 8; ++j) { const int n = (lane >> 3) + 8 * j; const LAS float* s = scr + (8 * c) * 65 + n;
        v4u o; o.x = pk2(s[0 * 65], s[1 * 65]); o.y = pk2(s[2 * 65], s[3 * 65]); o.z = pk2(s[4 * 65], s[5 * 65]); o.w = pk2(s[6 * 65], s[7 * 65]);
        int R = n0 + n; if (upmap) { const int half = R >= DFF ? 1 : 0, jj = R - half * DFF; R = 256 * (jj >> 7) + 128 * half + (jj & 127); }
        *(v4u*)(WT + (size_t)R * K + k0 + 8 * c) = o; }
    LDS_WAIT(); asm volatile("" ::: "memory");
}
__device__ __forceinline__ void rms_row_to_bf16(const float* xrow, bf16* orow, int lane) {
    const f32x4* xr = (const f32x4*)xrow + lane;
    f32x4 v[8]; float s = 0.f;
#pragma unroll
    for (int j = 0; j < 8; ++j) { v[j] = xr[64 * j]; s += (v[j][0] * v[j][0] + v[j][1] * v[j][1]) + (v[j][2] * v[j][2] + v[j][3] * v[j][3]); }
    const float r = __builtin_amdgcn_rsqf(wave_sum(s) * (1.0f / D) + EPS);
    v2u* o8 = (v2u*)orow + lane;
#pragma unroll
    for (int j = 0; j < 8; ++j) { v2u w; w.x = pk2(v[j][0] * r, v[j][1] * r); w.y = pk2(v[j][2] * r, v[j][3] * r); o8[64 * j] = w; }
}

__device__ __forceinline__ void mm128(f32x4 (&acc)[8], const LAS bf16* A, const LAS bf16* B, int wave, int fr, int fq) {
#pragma unroll
    for (int ks = 0; ks < 4; ++ks) {
        const bf16x8 a = *(const LAS bf16x8*)(A + (16 * wave + fr) * LDP + 32 * ks + 8 * fq);
#pragma unroll
        for (int ct = 0; ct < 8; ++ct) { const bf16x8 b = *(const LAS bf16x8*)(B + (16 * ct + fr) * LDP + 32 * ks + 8 * fq);
            acc[ct] = __builtin_amdgcn_mfma_f32_16x16x32_bf16(b, a, acc[ct], 0, 0, 0); }
    }
}
template <bool TRANS, bool DEC>
__device__ __forceinline__ void stage_rope(LAS bf16* dst, const bf16* zb, const float* rope, float scale, float l2g, int tid) {
#pragma unroll
    for (int it = 0; it < 2; ++it) { const int idx = tid + 512 * it, j = idx >> 3, d8 = idx & 7;
        const v4u x1 = *(const v4u*)(zb + (size_t)j * NIN + 8 * d8), x2 = *(const v4u*)(zb + (size_t)j * NIN + 64 + 8 * d8);
        const f32x4* rp = (const f32x4*)(rope + (size_t)(j * 64 + 8 * d8) * 2);
        float sc = scale; if (DEC) sc *= __builtin_amdgcn_exp2f(l2g * (float)(127 - j));
        float o1[8], o2[8];
#pragma unroll
        for (int p = 0; p < 4; ++p) { const f32x4 cs = rp[p]; const float a0 = lo16(x1[p]), a1 = hi16(x1[p]), b0 = lo16(x2[p]), b1 = hi16(x2[p]);
            o1[2 * p] = (a0 * cs[0] - b0 * cs[1]) * sc; o2[2 * p] = (b0 * cs[0] + a0 * cs[1]) * sc;
            o1[2 * p + 1] = (a1 * cs[2] - b1 * cs[3]) * sc; o2[2 * p + 1] = (b1 * cs[2] + a1 * cs[3]) * sc; }
        if (!TRANS) { v4u w1, w2;
#pragma unroll
            for (int p = 0; p < 4; ++p) { w1[p] = pk2(o1[2 * p], o1[2 * p + 1]); w2[p] = pk2(o2[2 * p], o2[2 * p + 1]); }
            *(LAS v4u*)(dst + j * LDP + 8 * d8) = w1; *(LAS v4u*)(dst + j * LDP + 64 + 8 * d8) = w2; }
        else {
#pragma unroll
            for (int i = 0; i < 8; ++i) { dst[(8 * d8 + i) * LDP + j] = f2bf(o1[i]); dst[(64 + 8 * d8 + i) * LDP + j] = f2bf(o2[i]); } }
    }
}
__device__ __forceinline__ void stage_T(LAS bf16* dst, const bf16* zb, int tid) {
#pragma unroll
    for (int it = 0; it < 4; ++it) { const int idx = tid + 512 * it, j = idx >> 4, c8 = idx & 15;
        const v4u x = *(const v4u*)(zb + (size_t)j * NIN + 8 * c8);
#pragma unroll
        for (int p = 0; p < 4; ++p) { dst[(8 * c8 + 2 * p) * LDP + j] = (bf16)(x[p] & 0xffffu); dst[(8 * c8 + 2 * p + 1) * LDP + j] = (bf16)(x[p] >> 16); } }
}


struct RopeX { v4u x1[2], x2[2]; };
struct RopeCS { f32x4 cs[2][4]; };
struct TileX { v4u x[4]; };
__device__ __forceinline__ void rope_load(RopeX& r, const bf16* zb, int tid) {
#pragma unroll
    for (int it = 0; it < 2; ++it) { const int idx = tid + 512 * it, j = idx >> 3, d8 = idx & 7; r.x1[it] = *(const v4u*)(zb + (size_t)j * NIN + 8 * d8); r.x2[it] = *(const v4u*)(zb + (size_t)j * NIN + 64 + 8 * d8); }
}
__device__ __forceinline__ void rope_cs_load(RopeCS& c, const float* rope, int tid) {
#pragma unroll
    for (int it = 0; it < 2; ++it) { const int idx = tid + 512 * it, j = idx >> 3, d8 = idx & 7; const f32x4* rp = (const f32x4*)(rope + (size_t)(j * 64 + 8 * d8) * 2);
#pragma unroll
        for (int p = 0; p < 4; ++p) c.cs[it][p] = rp[p]; }
}
template <bool TRANS, bool DEC>
__device__ __forceinline__ void rope_commit(LAS bf16* dst, const RopeX& r, const RopeCS& c, float scale, float l2g, int tid) {
#pragma unroll
    for (int it = 0; it < 2; ++it) { const int idx = tid + 512 * it, j = idx >> 3, d8 = idx & 7;
        float sc = scale; if (DEC) sc *= __builtin_amdgcn_exp2f(l2g * (float)(127 - j));
        float o1[8], o2[8];
#pragma unroll
        for (int p = 0; p < 4; ++p) { const f32x4 cs = c.cs[it][p]; const float a0 = lo16(r.x1[it][p]), a1 = hi16(r.x1[it][p]), b0 = lo16(r.x2[it][p]), b1 = hi16(r.x2[it][p]);
            o1[2 * p] = (a0 * cs[0] - b0 * cs[1]) * sc; o2[2 * p] = (b0 * cs[0] + a0 * cs[1]) * sc;
            o1[2 * p + 1] = (a1 * cs[2] - b1 * cs[3]) * sc; o2[2 * p + 1] = (b1 * cs[2] + a1 * cs[3]) * sc; }
        if (!TRANS) { v4u w1, w2;
#pragma unroll
            for (int p = 0; p < 4; ++p) { w1[p] = pk2(o1[2 * p], o1[2 * p + 1]); w2[p] = pk2(o2[2 * p], o2[2 * p + 1]); }
            *(LAS v4u*)(dst + j * LDP + 8 * d8) = w1; *(LAS v4u*)(dst + j * LDP + 64 + 8 * d8) = w2; }
        else {
#pragma unroll
            for (int i = 0; i < 8; ++i) { dst[(8 * d8 + i) * LDP + j] = f2bf(o1[i]); dst[(64 + 8 * d8 + i) * LDP + j] = f2bf(o2[i]); } }
    }
}
__device__ __forceinline__ void tile_load(TileX& t, const bf16* zb, int tid) {
#pragma unroll
    for (int it = 0; it < 4; ++it) { const int idx = tid + 512 * it, j = idx >> 4, c8 = idx & 15; t.x[it] = *(const v4u*)(zb + (size_t)j * NIN + 8 * c8); }
}
__device__ __forceinline__ void tile_commit_T(LAS bf16* dst, const TileX& t, int tid) {
#pragma unroll
    for (int it = 0; it < 4; ++it) { const int idx = tid + 512 * it, j = idx >> 4, c8 = idx & 15;
#pragma unroll
        for (int p = 0; p < 4; ++p) { dst[(8 * c8 + 2 * p) * LDP + j] = (bf16)(t.x[it][p] & 0xffffu); dst[(8 * c8 + 2 * p + 1) * LDP + j] = (bf16)(t.x[it][p] >> 16); } }
}

__global__ void __launch_bounds__(512, 2) mk_fwd(Params a) {
    extern __shared__ __attribute__((aligned(16))) unsigned char lds_raw[];
    LAS unsigned char* lds = (LAS unsigned char*)lds_raw;
    const int tid = threadIdx.x, lane = tid & 63, wave = __builtin_amdgcn_readfirstlane(tid >> 6), fr = lane & 15, fq = lane >> 4;
    const int G = gridDim.x, blk = blockIdx.x;
    const int gw = blk * 8 + wave, NGW = G * 8;
    const int gt = blk * 512 + tid, NGT = G * 512;
    unsigned char* ws = a.ws;
#define x_p (a.in[0])
#define x_s (a.in[1])
#define p_p (a.in[2])
#define p_s (a.in[3])
#define state_ret (a.in[4])
#define state_conv (a.in[5])
#define gm_ln_g (a.in[8])
#define gm_ln_b (a.in[9])
#define gm_ws (a.in[10])
#define gm_bs (a.in[11])
#define conv_w (a.in[15])
#define conv_b (a.in[16])
#define g_final (a.in[21])
#define out (a.out)
#define SS1 ((float*)(ws + WS_SS1))
#define SS2 ((float*)(ws + WS_SS2))
#define SS3 ((float*)(ws + WS_SS3))
#define STATS ((float*)(ws + WS_STATS))
#define ROPE ((float*)(ws + WS_ROPE))
#define ROPES ((float*)(ws + WS_ROPES))
#define Win_t ((bf16*)(ws + WS_WIN))
#define Wo_t ((bf16*)(ws + WS_WO))
#define Wup_t ((bf16*)(ws + WS_WUP))
#define Wdn_t ((bf16*)(ws + WS_WDN))
#define Wg_t ((bf16*)(ws + WS_WG))
#define Wp_t ((bf16*)(ws + WS_WP))
#define AB ((bf16*)(ws + WS_AB))
#define PB ((bf16*)(ws + WS_PB))
#define MIX ((bf16*)(ws + WS_MIX))
#define Z ((bf16*)(ws + WS_Z))
#define ACT ((bf16*)(ws + WS_ACT))
#define KV ((float*)(ws + WS_KV))
#define PP ((bf16*)(ws + WS_MIX))
#define RAW ((float*)(ws + WS_RAW))
#define AS ((float*)(ws + WS_AS))

    volatile LAS unsigned* MISC = (volatile LAS unsigned*)(lds + MISC_OFF);
    if (tid < 64) MISC[tid] = 0u;
    __syncthreads();
    XcdBarrier bar; bar.bar = (unsigned*)(ws + WS_BAR); bar.x = 0; bar.st = nullptr;
    if (MK_N_LAUNCHES == 1) bar = xcd_barrier_post((unsigned*)(ws + WS_BAR), MISC + 8);
    const int lo = a.ph_lo, hi = a.ph_hi;
#ifndef PHMASK
#define PHMASK 0xffff
#endif
#define IN(k) (((PHMASK >> (k)) & 1) && lo <= (k) && (k) < hi)
#define SEAM(k) do { if (IN(k) && IN((k) + 1)) { if (a.use_cg) cg::this_grid().sync(); else xcd_barrier(bar); } } while (0)

    if (IN(0)) {
        LAS float* scr = (LAS float*)(lds + wave * 16640);
        constexpr int I_IN = (D / 64) * (NIN / 64), I_O = (D / 64) * (D / 64), I_UP = (D / 64) * (NUP / 64), I_DN = (DFF / 64) * (D / 64), I_G = I_O, I_P = (PLE / 64) * (D / 64);
        constexpr int NITEMS = I_IN + I_O + I_UP + I_DN + I_G + I_P;
        for (int it = gw; it < NITEMS; it += NGW) {
            int r = it;
            if (r < I_UP) { transpose_item(a.in[14], D, NUP, a.in[13], Wup_t, true, scr, r, lane); continue; } r -= I_UP;
            if (r < I_IN) { transpose_item(a.in[7], D, NIN, a.in[6], Win_t, false, scr, r, lane); continue; } r -= I_IN;
            if (r < I_DN) { transpose_item(a.in[17], DFF, D, nullptr, Wdn_t, false, scr, r, lane); continue; } r -= I_DN;
            if (r < I_O) { transpose_item(a.in[12], D, D, nullptr, Wo_t, false, scr, r, lane); continue; } r -= I_O;
            if (r < I_G) { transpose_item(a.in[19], D, D, a.in[18], Wg_t, false, scr, r, lane); continue; } r -= I_G;
            transpose_item(a.in[20], PLE, D, nullptr, Wp_t, false, scr, r, lane);
        }
        for (int m = gw; m < MT; m += NGW) rms_row_to_bf16(m < MP ? x_p + (size_t)m * D : x_s + (size_t)(m - MP) * D, AB + (size_t)m * D, lane);
        for (int i = gt; i < MT * PLE / 4; i += NGT) { const f32x4 v = i < MP * PLE / 4 ? ((const f32x4*)p_p)[i] : ((const f32x4*)p_s)[i - MP * PLE / 4]; v2u w; w.x = pk2(v[0], v[1]); w.y = pk2(v[2], v[3]); ((v2u*)PB)[i] = w; }
        for (int i = gt; i < SEQ * 64 + 64; i += NGT) { const int pos = i < SEQ * 64 ? (i >> 6) : 16384, fi = i & 63;
            const float ang = (float)pos * a.invf[fi]; double t = (double)ang * 0.15915494309189535; t -= __builtin_rint(t); const float rev = (float)t;
            float* dst = i < SEQ * 64 ? ROPE + 2 * (size_t)i : ROPES + 2 * fi; dst[0] = __builtin_amdgcn_cosf(rev); dst[1] = __builtin_amdgcn_sinf(rev); }
        for (int i = gt; i < MT; i += NGT) { SS1[i] = 0.f; SS2[i] = 0.f; SS3[i] = 0.f; }
    }
    SEAM(0);

    if (IN(1)) {
        { pg8::Gemm g{AB, Win_t, MP, NIN, D}; pg8::StaticOrder S; S.init(MP, NIN, G, blk); EpiZ E{Z};
          pg8::gemm_phase<EpiZ, pg8::StaticOrder, true, true>(lds, g, S, E); }
        auto f = [&](int s, int n, float v) { const float o = n < 3072 ? v : (n < 4096 ? silu_(v) : gelu_(v)); Z[(size_t)(MP + s) * NIN + n] = f2bf(o); };
        skinny_gemm<8>(lds, AB + (size_t)MP * D, Win_t, NIN, D, blk, G, f);
    }
    SEAM(1);

    if (IN(2)) {
        { LAS float* qs = (LAS float*)lds; LAS float* ks = qs + 128; LAS float* vs = ks + 128; LAS float* red = vs + 128;
          const int e4 = tid & 31, dg = tid >> 5;
          for (int u = blk; u < MS * NH; u += G) { const int s = u >> 3, h = u & 7; const bf16* zr = Z + (size_t)(MP + s) * NIN;
            const float* S0 = state_ret + (size_t)u * 16384 + 4 * e4; float* S1 = out + O_RETS + (size_t)u * 16384 + 4 * e4;
            f32x4 s0[8];
#pragma unroll
            for (int i = 0; i < 8; ++i) s0[i] = __builtin_nontemporal_load((const f32x4*)(S0 + (dg + 16 * i) * 128));
            if (tid < 64) { const float c = ROPES[2 * tid], sn = ROPES[2 * tid + 1];
                const float q1 = bf2f(zr[128 * h + tid]), q2 = bf2f(zr[128 * h + 64 + tid]), k1 = bf2f(zr[1024 + 128 * h + tid]), k2 = bf2f(zr[1024 + 128 * h + 64 + tid]);
                qs[tid] = q1 * c - q2 * sn; qs[tid + 64] = q2 * c + q1 * sn; ks[tid] = (k1 * c - k2 * sn) * 0.08838834764831845f; ks[tid + 64] = (k2 * c + k1 * sn) * 0.08838834764831845f; }
            else if (tid < 192) vs[tid - 64] = bf2f(zr[2048 + 128 * h + tid - 64]);
            unsigned gg = 0u; if (tid < 64) gg = *(const unsigned*)(zr + 3072 + 128 * h + 2 * tid);
            __syncthreads();
            const float gamma = 1.0f - __builtin_amdgcn_exp2f((float)(-5 - h));
            const f32x4 vv = *(const LAS f32x4*)(vs + 4 * e4); f32x4 o = {0.f, 0.f, 0.f, 0.f};
#pragma unroll
            for (int i = 0; i < 8; ++i) { const int d = dg + 16 * i; const f32x4 sn = s0[i] * gamma + vv * ks[d]; __builtin_nontemporal_store(sn, (f32x4*)(S1 + d * 128)); o += sn * qs[d]; }
            *(LAS f32x4*)(red + dg * 128 + 4 * e4) = o;
            __syncthreads();
            if (tid < 64) { float o0 = 0.f, o1 = 0.f;
#pragma unroll
                for (int i = 0; i < 16; ++i) { o0 += red[i * 128 + 2 * tid]; o1 += red[i * 128 + 2 * tid + 1]; }
                const float r = __builtin_amdgcn_rsqf(wave_sum(o0 * o0 + o1 * o1) * (1.0f / 128.0f) + EPS);
                *(unsigned*)(MIX + (size_t)(MP + s) * D + 128 * h + 2 * tid) = pk2(o0 * r * lo16(gg), o1 * r * hi16(gg)); }
            __syncthreads(); } }
        { LAS bf16* Kt = (LAS bf16*)lds; LAS bf16* Vt = (LAS bf16*)(lds + TILE_B);
          for (int u = blk; u < 512; u += G) { const int b = u >> 7, h = (u >> 4) & 7, c = u & 15; const size_t R0 = (size_t)b * SEQ + 128 * c;
            RopeX kx; RopeCS cs; TileX vx;
            rope_load(kx, Z + R0 * NIN + 1024 + 128 * h, tid); rope_cs_load(cs, ROPE + (size_t)(128 * c) * 128, tid); tile_load(vx, Z + R0 * NIN + 2048 + 128 * h, tid);
            rope_commit<true, true>(Kt, kx, cs, 0.08838834764831845f, a.log2g[h], tid);
            tile_commit_T(Vt, vx, tid);
            __syncthreads();
            f32x4 acc[8];
#pragma unroll
            for (int ct = 0; ct < 8; ++ct) acc[ct] = (f32x4){0.f, 0.f, 0.f, 0.f};
            mm128(acc, Kt, Vt, wave, fr, fq);
            float* kv = KV + (size_t)u * 16384 + (16 * wave + fr) * 128 + 4 * fq;
#pragma unroll
            for (int ct = 0; ct < 8; ++ct) *(f32x4*)(kv + 16 * ct) = acc[ct];
            __syncthreads(); } }
        for (int r0 = gw; r0 < MP; r0 += 2 * NGW) { const int r1 = r0 + NGW;
            const bf16* p0 = Z + (size_t)r0 * NIN + 5120 + 16 * lane; const bf16* p1 = Z + (size_t)(r1 < MP ? r1 : r0) * NIN + 5120 + 16 * lane;
            const v4u xa0 = *(const v4u*)p0, xa1 = *(const v4u*)(p0 + 8), xb0 = *(const v4u*)p1, xb1 = *(const v4u*)(p1 + 8);
            float va[16], vb[16];
#pragma unroll
            for (int j = 0; j < 4; ++j) { va[2 * j] = lo16(xa0[j]); va[2 * j + 1] = hi16(xa0[j]); va[8 + 2 * j] = lo16(xa1[j]); va[8 + 2 * j + 1] = hi16(xa1[j]);
                                          vb[2 * j] = lo16(xb0[j]); vb[2 * j + 1] = hi16(xb0[j]); vb[8 + 2 * j] = lo16(xb1[j]); vb[8 + 2 * j + 1] = hi16(xb1[j]); }
            float sa = 0.f, sb = 0.f;
#pragma unroll
            for (int j = 0; j < 16; ++j) { sa += va[j]; sb += vb[j]; }
            const float ma = wave_sum(sa) * (1.0f / 1024.0f), mb = wave_sum(sb) * (1.0f / 1024.0f); float qa = 0.f, qb = 0.f;
#pragma unroll
            for (int j = 0; j < 16; ++j) { const float da = va[j] - ma, db = vb[j] - mb; qa += da * da; qb += db * db; }
            const float ra = __builtin_amdgcn_rsqf(wave_sum(qa) * (1.0f / 1024.0f) + EPS), rb = __builtin_amdgcn_rsqf(wave_sum(qb) * (1.0f / 1024.0f) + EPS);
            if (lane == 0) { STATS[2 * r0] = ma; STATS[2 * r0 + 1] = ra; if (r1 < MP) { STATS[2 * r1] = mb; STATS[2 * r1 + 1] = rb; } } }
        for (int row = MP + gw; row < MT; row += NGW) { const bf16* p = Z + (size_t)row * NIN + 5120 + 16 * lane; const v4u x0 = *(const v4u*)p, x1 = *(const v4u*)(p + 8);
            const int s_ = row - MP, c0 = 16 * lane, grp = lane >> 3; const float w00 = gm_ws[grp * 16384], b0 = gm_bs[grp * 128];
            const bf16* up = Z + (size_t)row * NIN + 4096 + c0; const v4u u0 = *(const v4u*)up, u1 = *(const v4u*)(up + 8);
            float v[16];
#pragma unroll
            for (int j = 0; j < 4; ++j) { v[2 * j] = lo16(x0[j]); v[2 * j + 1] = hi16(x0[j]); v[8 + 2 * j] = lo16(x1[j]); v[8 + 2 * j + 1] = hi16(x1[j]); }
            float s = 0.f;
#pragma unroll
            for (int j = 0; j < 16; ++j) s += v[j];
            const float mean = wave_sum(s) * (1.0f / 1024.0f); float q = 0.f;
#pragma unroll
            for (int j = 0; j < 16; ++j) { v[j] -= mean; q += v[j] * v[j]; }
            const float rstd = __builtin_amdgcn_rsqf(wave_sum(q) * (1.0f / 1024.0f) + EPS);
            float uu[16];
#pragma unroll
            for (int j = 0; j < 4; ++j) { uu[2 * j] = lo16(u0[j]); uu[2 * j + 1] = hi16(u0[j]); uu[8 + 2 * j] = lo16(u1[j]); uu[8 + 2 * j + 1] = hi16(u1[j]); }
            float vn[16], mo[16];
#pragma unroll
            for (int j = 0; j < 16; ++j) { vn[j] = v[j] * rstd * gm_ln_g[c0 + j] + gm_ln_b[c0 + j]; mo[j] = uu[j] * (w00 * vn[j] + b0); }
            float* gv = out + O_GMV + (size_t)s_ * 1024 + c0;
#pragma unroll
            for (int j = 0; j < 4; ++j) *(f32x4*)(gv + 4 * j) = (f32x4){vn[4 * j], vn[4 * j + 1], vn[4 * j + 2], vn[4 * j + 3]};
            v4u w0, w1;
#pragma unroll
            for (int j = 0; j < 4; ++j) { w0[j] = pk2(mo[2 * j], mo[2 * j + 1]); w1[j] = pk2(mo[8 + 2 * j], mo[8 + 2 * j + 1]); }
            bf16* mp = MIX + (size_t)row * D + 1024 + c0; *(v4u*)mp = w0; *(v4u*)(mp + 8) = w1; }
    }
    SEAM(2);

    if (IN(3)) {
        LAS bf16* T0 = (LAS bf16*)lds; LAS bf16* T1 = (LAS bf16*)(lds + TILE_B); LAS bf16* T2 = (LAS bf16*)(lds + 2 * TILE_B); LAS bf16* T3 = (LAS bf16*)(lds + 3 * TILE_B);
        for (int u = blk; u < 512; u += G) { const int bh = u >> 4, b = bh >> 3, h = bh & 7, c = u < 256 ? (u & 15) : 15 - (u & 15); const size_t R0 = (size_t)b * SEQ + 128 * c; const float l2g = a.log2g[h];
            const int i_ = 16 * wave + fr;
            RopeX qx, kx; RopeCS cs; TileX vx; v2u gg[8];
            const float* kvb = KV + (size_t)bh * 16 * 16384;
            f32x4 tc[8];
#pragma unroll
            for (int i = 0; i < 8; ++i) tc[i] = *(const f32x4*)(kvb + 4 * (tid + 512 * i));
            rope_load(qx, Z + R0 * NIN + 128 * h, tid); rope_load(kx, Z + R0 * NIN + 1024 + 128 * h, tid); rope_cs_load(cs, ROPE + (size_t)(128 * c) * 128, tid); tile_load(vx, Z + R0 * NIN + 2048 + 128 * h, tid);
            rope_commit<false, false>(T0, qx, cs, 1.0f, 0.f, tid);
            rope_commit<false, false>(T1, kx, cs, 0.08838834764831845f, 0.f, tid);
            asm volatile("" ::: "memory");
            { const float Gc = __builtin_amdgcn_exp2f(l2g * 128.0f);
              f32x4 sp[8];
#pragma unroll
              for (int i = 0; i < 8; ++i) sp[i] = (f32x4){0.f, 0.f, 0.f, 0.f};
              for (int j = 0; j < c; ++j) { f32x4 tn[8];
#pragma unroll
                  for (int i = 0; i < 8; ++i) tn[i] = *(const f32x4*)(kvb + (size_t)(j + 1) * 16384 + 4 * (tid + 512 * i));
#pragma unroll
                  for (int i = 0; i < 8; ++i) { sp[i] = sp[i] * Gc + tc[i]; tc[i] = tn[i]; } }
              if (c == 15) {
#pragma unroll
                  for (int i = 0; i < 8; ++i) *(f32x4*)(out + O_RETP + (size_t)bh * 16384 + 4 * (tid + 512 * i)) = sp[i] * Gc + tc[i]; }
#pragma unroll
              for (int i = 0; i < 8; ++i) { const int ch = tid + 512 * i, d = ch >> 5, e4 = ch & 31;
#pragma unroll
                  for (int t = 0; t < 4; ++t) T3[(4 * e4 + t) * LDP + d] = f2bf(sp[i][t]); } }
            tile_commit_T(T2, vx, tid);
            __syncthreads();
            { const bf16* gp = Z + (R0 + i_) * NIN + 3072 + 128 * h + 4 * fq;
#pragma unroll
              for (int ct = 0; ct < 8; ++ct) gg[ct] = *(const v2u*)(gp + 16 * ct); }
            f32x4 acc2[8], acc1[8];
#pragma unroll
            for (int ct = 0; ct < 8; ++ct) { acc2[ct] = (f32x4){0.f, 0.f, 0.f, 0.f}; acc1[ct] = (f32x4){0.f, 0.f, 0.f, 0.f}; }
            mm128(acc2, T0, T3, wave, fr, fq);
            mm128(acc1, T0, T1, wave, fr, fq);
            __syncthreads();
#pragma unroll
            for (int ct = 0; ct < 8; ++ct) { float sv[4];
#pragma unroll
                for (int t = 0; t < 4; ++t) { const int j = 16 * ct + 4 * fq + t; sv[t] = i_ >= j ? acc1[ct][t] * __builtin_amdgcn_exp2f(l2g * (float)(i_ - j)) : 0.f; }
                v2u w; w.x = pk2(sv[0], sv[1]); w.y = pk2(sv[2], sv[3]); *(LAS v2u*)(T1 + i_ * LDP + 16 * ct + 4 * fq) = w; }
            __syncthreads();
#pragma unroll
            for (int ct = 0; ct < 8; ++ct) acc1[ct] = (f32x4){0.f, 0.f, 0.f, 0.f};
            mm128(acc1, T1, T2, wave, fr, fq);
            const float qd = __builtin_amdgcn_exp2f(l2g * (float)(i_ + 1)); float ssq = 0.f;
#pragma unroll
            for (int ct = 0; ct < 8; ++ct) { acc1[ct] = acc1[ct] + acc2[ct] * qd; ssq += (acc1[ct][0] * acc1[ct][0] + acc1[ct][1] * acc1[ct][1]) + (acc1[ct][2] * acc1[ct][2] + acc1[ct][3] * acc1[ct][3]); }
            ssq += __shfl_xor(ssq, 16); ssq += __shfl_xor(ssq, 32);
            const float rn = __builtin_amdgcn_rsqf(ssq * (1.0f / 128.0f) + EPS);
            bf16* mp = MIX + (R0 + i_) * D + 128 * h + 4 * fq;
#pragma unroll
            for (int ct = 0; ct < 8; ++ct) { v2u w;
                w.x = pk2(acc1[ct][0] * rn * lo16(gg[ct].x), acc1[ct][1] * rn * hi16(gg[ct].x)); w.y = pk2(acc1[ct][2] * rn * lo16(gg[ct].y), acc1[ct][3] * rn * hi16(gg[ct].y)); *(v2u*)(mp + 16 * ct) = w; }
            __syncthreads(); }
        for (int u = blk; u < 512; u += G) { const int b = u >> 7, c = (u >> 3) & 15, grp = u & 7; const size_t R0 = (size_t)b * SEQ + 128 * c;
            const int t_ = 16 * wave + fr, d8 = tid & 15;
            f32x4 wl[4][2]; v4u xv[4]; float st[4][2]; v2u uu[8]; float lg[8], lb[8];
#pragma unroll
            for (int it = 0; it < 4; ++it) { const int idx = tid + 512 * it, t = idx >> 4; const float* wp = gm_ws + (size_t)grp * 16384 + t * 128 + 8 * d8;
                wl[it][0] = *(const f32x4*)wp; wl[it][1] = *(const f32x4*)(wp + 4);
                xv[it] = *(const v4u*)(Z + (R0 + t) * NIN + 5120 + 128 * grp + 8 * d8); st[it][0] = STATS[2 * (R0 + t)]; st[it][1] = STATS[2 * (R0 + t) + 1]; }
#pragma unroll
            for (int j = 0; j < 8; ++j) { lg[j] = gm_ln_g[128 * grp + 8 * d8 + j]; lb[j] = gm_ln_b[128 * grp + 8 * d8 + j]; }
            const float bsv = gm_bs[grp * 128 + t_];
#pragma unroll
            for (int it = 0; it < 4; ++it) { const int idx = tid + 512 * it, t = idx >> 4;
                float wv[8] = {wl[it][0][0], wl[it][0][1], wl[it][0][2], wl[it][0][3], wl[it][1][0], wl[it][1][1], wl[it][1][2], wl[it][1][3]};
#pragma unroll
                for (int j = 0; j < 8; ++j) if (8 * d8 + j > t) wv[j] = 0.f;
                v4u w; w.x = pk2(wv[0], wv[1]); w.y = pk2(wv[2], wv[3]); w.z = pk2(wv[4], wv[5]); w.w = pk2(wv[6], wv[7]); *(LAS v4u*)(T0 + t * LDP + 8 * d8) = w;
                const float mean = st[it][0], rstd = st[it][1];
#pragma unroll
                for (int p = 0; p < 4; ++p) { T1[(8 * d8 + 2 * p) * LDP + t] = f2bf((lo16(xv[it][p]) - mean) * rstd * lg[2 * p] + lb[2 * p]); T1[(8 * d8 + 2 * p + 1) * LDP + t] = f2bf((hi16(xv[it][p]) - mean) * rstd * lg[2 * p + 1] + lb[2 * p + 1]); } }
            __syncthreads();
            { const bf16* up = Z + (R0 + t_) * NIN + 4096 + 128 * grp + 4 * fq;
#pragma unroll
              for (int ct = 0; ct < 8; ++ct) uu[ct] = *(const v2u*)(up + 16 * ct); }
            f32x4 acc[8];
#pragma unroll
            for (int ct = 0; ct < 8; ++ct) acc[ct] = (f32x4){0.f, 0.f, 0.f, 0.f};
            mm128(acc, T0, T1, wave, fr, fq);
            bf16* mp = MIX + (R0 + t_) * D + 1024 + 128 * grp + 4 * fq;
#pragma unroll
            for (int ct = 0; ct < 8; ++ct) { v2u w;
                w.x = pk2((acc[ct][0] + bsv) * lo16(uu[ct].x), (acc[ct][1] + bsv) * hi16(uu[ct].x)); w.y = pk2((acc[ct][2] + bsv) * lo16(uu[ct].y), (acc[ct][3] + bsv) * hi16(uu[ct].y)); *(v2u*)(mp + 16 * ct) = w; }
            __syncthreads(); }
    }
    SEAM(3);

    if (IN(4)) {
        { pg8::Gemm g{MIX, Wo_t, MP, D, D}; pg8::StaticOrder S; S.init(MP, D, G, blk); EpiRes<false> E{x_p, AB, SS1};
          pg8::gemm_phase<EpiRes<false>, pg8::StaticOrder, true, true>(lds, g, S, E); }
        auto f = [&](int s, int n, float v) { const float o = x_s[(size_t)s * D + n] + v; AB[(size_t)(MP + s) * D + n] = f2bf(o);
            const float q = half_wave_sum(o * o); if ((lane & 31) == 0) atomic_addf(SS1 + MP + s, q); };
        skinny_gemm<2>(lds, MIX + (size_t)MP * D, Wo_t, D, D, blk, G, f);
    }
    SEAM(4);

    if (IN(5)) {
        { pg8::Gemm g{AB, Wup_t, MP, NUP, D}; pg8::StaticOrder S; S.init(MP, NUP, G, blk); EpiUp E{ACT, RAW, SS1, conv_w, conv_b, (LAS float*)(lds + 131072)};
          pg8::gemm_phase<EpiUp, pg8::StaticOrder, true, true>(lds, g, S, E); }
        { pg8::Gemm g{AB, Wup_t, MP + 256, NUP, D}; SampleOrder S{(blk >= 128 && blk - 128 < NUP / 256) ? blk - 128 : -1}; EpiAS E{AS, SS1};
          pg8::gemm_phase<EpiAS, SampleOrder, true, true>(lds, g, S, E); }
        { int Kp = PLE; asm volatile("" : "+s"(Kp));
          constexpr int nbusy = (MP / 256 * (NUP / 256) + NUP / 256) - 5 * 256;
          pg8::Gemm g{PB, Wp_t, MP + 256, D, Kp}; ProjOrder S{blk >= nbusy ? blk - nbusy : -1, 256 - nbusy}; EpiPP E{PP};
          pg8::gemm_phase<EpiPP, ProjOrder, true, true>(lds, g, S, E); }
    }
    SEAM(5);

    if (IN(6)) {
        for (int i = gt; i < 128 * 2 * (DFF / 4); i += NGT) { const int c4 = i % (DFF / 4), gr = i / (DFF / 4), rr = gr & 1, Gp = gr >> 1, c = 4 * c4; const bool first = (Gp & 31) == 0;
            const float* rg = RAW + (size_t)Gp * 4 * NUP; const float* rp = rg - 4 * NUP; const f32x4 z4 = {0.f, 0.f, 0.f, 0.f};
            f32x4 a0g, a0u, a1g, a1u, a2g, a2u;
            a0g = *(const f32x4*)(rg + (2 + rr) * NUP + c); a0u = *(const f32x4*)(rg + (2 + rr) * NUP + DFF + c);
            if (rr) { a1g = *(const f32x4*)(rg + 2 * NUP + c); a1u = *(const f32x4*)(rg + 2 * NUP + DFF + c); a2g = first ? z4 : *(const f32x4*)(rp + NUP + c); a2u = first ? z4 : *(const f32x4*)(rp + NUP + DFF + c); }
            else { a1g = first ? z4 : *(const f32x4*)(rp + NUP + c); a1u = first ? z4 : *(const f32x4*)(rp + NUP + DFF + c); a2g = first ? z4 : *(const f32x4*)(rp + c); a2u = first ? z4 : *(const f32x4*)(rp + DFF + c); }
            const f32x4 ag = *(const f32x4*)(conv_w + c) * a2g + *(const f32x4*)(conv_w + NUP + c) * a1g + *(const f32x4*)(conv_w + 2 * NUP + c) * a0g + *(const f32x4*)(conv_b + c);
            const f32x4 au = *(const f32x4*)(conv_w + DFF + c) * a2u + *(const f32x4*)(conv_w + NUP + DFF + c) * a1u + *(const f32x4*)(conv_w + 2 * NUP + DFF + c) * a0u + *(const f32x4*)(conv_b + DFF + c);
            v2u w; w.x = pk2(silu_(ag[0]) * au[0], silu_(ag[1]) * au[1]); w.y = pk2(silu_(ag[2]) * au[2], silu_(ag[3]) * au[3]);
            *(v2u*)(ACT + (size_t)(64 * Gp + rr) * DFF + c) = w; }
        for (int i = gt; i < MS * (DFF / 4); i += NGT) { const int c4 = i % (DFF / 4), s = i / (DFF / 4), c = 4 * c4;
            const float* sc0 = state_conv + (size_t)s * 2 * NUP; const float* sc1 = sc0 + NUP; const float* as = AS + (size_t)s * NUP;
            const f32x4 a0g = *(const f32x4*)(as + c), a0u = *(const f32x4*)(as + DFF + c), a1g = *(const f32x4*)(sc1 + c), a1u = *(const f32x4*)(sc1 + DFF + c), a2g = *(const f32x4*)(sc0 + c), a2u = *(const f32x4*)(sc0 + DFF + c);
            const f32x4 ag = *(const f32x4*)(conv_w + c) * a2g + *(const f32x4*)(conv_w + NUP + c) * a1g + *(const f32x4*)(conv_w + 2 * NUP + c) * a0g + *(const f32x4*)(conv_b + c);
            const f32x4 au = *(const f32x4*)(conv_w + DFF + c) * a2u + *(const f32x4*)(conv_w + NUP + DFF + c) * a1u + *(const f32x4*)(conv_w + 2 * NUP + DFF + c) * a0u + *(const f32x4*)(conv_b + DFF + c);
            v2u w; w.x = pk2(silu_(ag[0]) * au[0], silu_(ag[1]) * au[1]); w.y = pk2(silu_(ag[2]) * au[2], silu_(ag[3]) * au[3]);
            *(v2u*)(ACT + (size_t)(MP + s) * DFF + c) = w;
            float* cs = out + O_CONVS + (size_t)s * 2 * NUP; *(f32x4*)(cs + c) = a1g; *(f32x4*)(cs + DFF + c) = a1u; *(f32x4*)(cs + NUP + c) = a0g; *(f32x4*)(cs + NUP + DFF + c) = a0u; }
        for (int i = gt; i < 4 * 2 * (NUP / 4); i += NGT) { const int c4 = i % (NUP / 4), bk = i / (NUP / 4), b = bk >> 1, k = bk & 1;
            *(f32x4*)(out + O_CONVP + (size_t)bk * NUP + 4 * c4) = *(const f32x4*)(RAW + ((size_t)(32 * b + 31) * 4 + k) * NUP + 4 * c4); }
    }
    SEAM(6);

    if (IN(7)) {
        { pg8::Gemm g{ACT, Wdn_t, MP, D, DFF}; pg8::StaticOrder S; S.init(MP, D, G, blk); EpiRes<true> E{nullptr, AB, SS2};
          pg8::gemm_phase<EpiRes<true>, pg8::StaticOrder, true, true>(lds, g, S, E); }
        auto f = [&](int s, int n, float v) { const size_t o_ = (size_t)(MP + s) * D + n; const float o = bf2f(AB[o_]) + v; AB[o_] = f2bf(o);
            const float q = half_wave_sum(o * o); if ((lane & 31) == 0) atomic_addf(SS2 + MP + s, q); };
        skinny_gemm<2>(lds, ACT + (size_t)MP * DFF, Wdn_t, D, DFF, blk, G, f);
    }
    SEAM(7);

    if (IN(8)) {
#ifndef T_B
        { pg8::Gemm g{AB, Wg_t, MP, D, D}; pg8::StaticOrder S; S.init(MP, D, G, blk); EpiGate E{PP, AB, out, SS2, SS3};
          pg8::gemm_phase<EpiGate, pg8::StaticOrder, true, true>(lds, g, S, E); }
#endif
#ifndef T_D
        auto f2 = [&](int s, int n, float v) { const size_t o_ = (size_t)(MP + s) * D + n; const float r2 = __builtin_amdgcn_rsqf(SS2[MP + s] * (1.0f / D) + EPS);
            const float o = bf2f(AB[o_]) + bf2f(PP[o_]) * sigmoid_(r2 * v); out[o_] = o; const float q = half_wave_sum(o * o); if ((lane & 31) == 0) atomic_addf(SS3 + MP + s, q); };
        skinny_gemm<2>(lds, AB + (size_t)MP * D, Wg_t, D, D, blk, G, f2);
#endif
    }
    SEAM(8);

    if (IN(9)) {
        for (int m = gw; m < MT; m += NGW) { f32x4* hr = (f32x4*)(out + (size_t)m * D) + lane; const f32x4* gr = (const f32x4*)g_final + lane;
            const float r = __builtin_amdgcn_rsqf(SS3[m] * (1.0f / D) + EPS);
#pragma unroll
            for (int j = 0; j < 8; ++j) hr[64 * j] = hr[64 * j] * gr[64 * j] * r; }
    }
#undef IN
#undef SEAM
}
#undef x_p
#undef x_s
#undef p_p
#undef p_s
#undef state_ret
#undef state_conv
#undef gm_ln_g
#undef gm_ln_b
#undef gm_ws
#undef gm_bs
#undef conv_w
#undef conv_b
#undef g_final
#undef out
#undef SS1
#undef SS2
#undef SS3
#undef STATS
#undef ROPE
#undef ROPES
#undef Win_t
#undef Wo_t
#undef Wup_t
#undef Wdn_t
#undef Wg_t
#undef Wp_t
#undef AB
#undef PB
#undef MIX
#undef Z
#undef ACT
#undef KV
#undef PP
#undef RAW
#undef AS

extern "C" void kernel_launch(void* const* d_in, const int* in_sizes, int n_in, void* d_out, int out_size, void* d_ws, size_t ws_size, hipStream_t stream) {
    static int grid = 0;
    if (grid == 0) {
        if (n_in != 22 || out_size != (int)O_END || ws_size < WS_END) { fprintf(stderr, "kernel_launch: unexpected shapes: n_in %d out %d ws %zu\n", n_in, out_size, ws_size); grid = -1; return; }
        int dev = 0, cus = 0, per_cu = 0;
        if (hipGetDevice(&dev) != hipSuccess || hipDeviceGetAttribute(&cus, hipDeviceAttributeMultiprocessorCount, dev) != hipSuccess) { grid = -1; return; }
        if (hipFuncSetAttribute((const void*)mk_fwd, hipFuncAttributeMaxDynamicSharedMemorySize, LDS_BYTES) != hipSuccess) { fprintf(stderr, "kernel_launch: hipFuncSetAttribute failed\n"); grid = -1; return; }
        if (hipOccupancyMaxActiveBlocksPerMultiprocessor(&per_cu, (const void*)mk_fwd, 512, LDS_BYTES) != hipSuccess || per_cu < 1) fprintf(stderr, "kernel_launch: occupancy query says %d\n", per_cu);
        (void)hipGetLastError();
        grid = cus;
        if (grid != 256) fprintf(stderr, "kernel_launch: %d CUs (built for 256)\n", grid);
    }
    if (grid < 0) return;
    if (hipMemsetAsync((char*)d_ws + WS_BAR, 0, BAR_BYTES, stream) != hipSuccess) { fprintf(stderr, "kernel_launch: memset failed\n"); return; }
    Params p{};
    for (int i = 0; i < 22; ++i) p.in[i] = (const float*)d_in[i];
    p.out = (float*)d_out; p.ws = (unsigned char*)d_ws;
    for (int h = 0; h < 8; ++h) p.log2g[h] = (float)std::log2(1.0 - std::exp2(-5.0 - (double)h));
    for (int i = 0; i < 64; ++i) p.invf[i] = powf(10000.0f, -(float)i / 64.0f);
    p.use_cg = 0; p.pad = 0;
#if MK_N_LAUNCHES == 1
    void* args[] = {&p};
#ifdef PROBE_K
    p.ph_lo = 0; p.ph_hi = PROBE_K + 1;
    (void)hipLaunchCooperativeKernel((const void*)mk_fwd, dim3(grid), dim3(512), args, LDS_BYTES, stream);
    if (hipMemsetAsync((char*)d_ws + WS_BAR, 0, BAR_BYTES, stream) != hipSuccess) return;
#endif
    p.ph_lo = 0; p.ph_hi = NPHASE;
    hipError_t e = hipLaunchCooperativeKernel((const void*)mk_fwd, dim3(grid), dim3(512), args, LDS_BYTES, stream);
    if (e != hipSuccess) fprintf(stderr, "kernel_launch: cooperative launch failed: %s\n", hipGetErrorString(e));
#else
    for (int ph = 0; ph < NPHASE; ++ph) { p.ph_lo = ph; p.ph_hi = ph + 1; hipLaunchKernelGGL(mk_fwd, dim3(grid), dim3(512), LDS_BYTES, stream, p); }
#endif
}
```

```cpp
#include <hip/hip_runtime.h>
#include <hip/hip_cooperative_groups.h>
#include <cstdio>
#include <cstdint>
#include <cmath>
namespace cg = cooperative_groups;

#ifndef MK_N_LAUNCHES
#define MK_N_LAUNCHES 1
#endif

namespace pg8 {
#define PG8_LAS __attribute__((address_space(3)))
typedef unsigned short bf16_t;
typedef short bf16x8 __attribute__((ext_vector_type(8)));
typedef float f32x4 __attribute__((ext_vector_type(4)));
typedef unsigned u32x4 __attribute__((ext_vector_type(4)));
constexpr int BM = 256, BK = 64, HALF = 128, HTB = HALF * BK * 2  , STAGE_BYTES = 8 * HTB, NXCD = 8, WGM = 8;

__host__ __device__ __forceinline__ int lds_byte(int r, int c) { const int st = (r >> 4) * 2 + (c >> 5), rr = r & 15, cc = c & 31, ob = rr * 64 + cc * 2; return st * 1024 + (ob ^ (((ob >> 9) & 1) << 5)); }
__host__ __device__ __forceinline__ void stage_rc(int b, int& R, int& C) { const int st = b / 1024, sb = b % 1024, swz = sb ^ (((sb >> 9) & 1) << 5); R = (st >> 1) * 16 + swz / 64; C = (st & 1) * 32 + (swz % 64) / 2; }
__host__ __device__ __forceinline__ int perm32(int rho) { const int n = rho >> 4, i = rho & 15; return 8 * (i >> 2) + 4 * n + (i & 3); }

struct Unit { int pm, pn; };
struct Gemm { const bf16_t* A; const bf16_t* Bt; int M, N, K; };

struct StaticOrder {
    int nM, nN, nwg, G, c;
    __host__ __device__ void init(int M, int N, int G_, int c_) { nM = M / BM; nN = N / BM; nwg = nM * nN; G = G_; c = c_; }
    __host__ __device__ bool next(int i, Unit& u) const {
        const long L = (long)i * G + c; if (L >= nwg) return false;
        int wgid = (int)L; { const int q = nwg / NXCD, r = nwg % NXCD, xcd = wgid % NXCD, off = wgid / NXCD; wgid = (xcd < r ? xcd * (q + 1) : r * (q + 1) + (xcd - r) * q) + off; }
        const int nig = WGM * nN, gid = wgid / nig, fm = gid * WGM, gsz = (nM - fm) < WGM ? (nM - fm) : WGM;
        u.pm = fm + ((wgid % nig) % gsz); u.pn = (wgid % nig) / gsz; return true;
    }
    __device__ __forceinline__ void a_ready(const Unit&) const {}
    __device__ __forceinline__ void done(const Unit&) const {}
};

__device__ __forceinline__ unsigned cvt_pk_bf16(float lo, float hi) { unsigned r; asm volatile("v_cvt_pk_bf16_f32 %0, %1, %2" : "=v"(r) : "v"(lo), "v"(hi)); return r; }
typedef float f32x2 __attribute__((ext_vector_type(2)));

template <class Epi, class Sched, bool ALIGN_EPI = false, bool SP2 = false>
__device__ __forceinline__ void gemm_phase(PG8_LAS unsigned char* lds, const Gemm g, const Sched& S, const Epi& E) {
    const int tid = threadIdx.x, wid = __builtin_amdgcn_readfirstlane(tid >> 6), lane = tid & 63, wr = wid >> 2, wc = wid & 3, fr = lane & 15, fq = lane >> 4;
    const int K = g.K, nt = K / BK;
    unsigned voffA[2], voffB[2];
#pragma unroll
    for (int i = 0; i < 2; ++i) { int R, C; stage_rc(tid * 16 + i * 8192, R, C); const int Rb = Epi::PERM ? ((R & ~31) + perm32(R & 31)) : R;
        voffA[i] = (unsigned)(R * K + C) * 2u; voffB[i] = (unsigned)(Rb * K + C) * 2u; }
    const size_t kstep = (size_t)(BK * 2);
    const size_t hstep = (size_t)HALF * K * 2;
    const size_t tstep = 2 * hstep;
    const unsigned ldsw = (unsigned)wid * 1024u;
    const int aoff = lds_byte(wr * 64 + fr, fq * 8), boff = lds_byte(wc * 32 + fr, fq * 8);
#define PG8_SA(b, h) (((b) * 2 + (h)) * HTB)
#define PG8_SB(b, h) ((4 + (b) * 2 + (h)) * HTB)
#define PG8_STAGE(bufoff, gbase, voff) do { _Pragma("unroll") for (int _i = 0; _i < 2; ++_i) \
        __builtin_amdgcn_global_load_lds((const unsigned*)((const char*)(gbase) + (voff)[_i]), (PG8_LAS unsigned*)(lds + (bufoff) + ldsw + _i * 8192), 16, 0, 0); } while (0)
#define PG8_LDA(dst, b, h) do { _Pragma("unroll") for (int m = 0; m < 4; ++m) _Pragma("unroll") for (int k = 0; k < 2; ++k) dst[m][k] = *(const PG8_LAS bf16x8*)(lds + PG8_SA(b, h) + aoff + m * 2048 + k * 1024); } while (0)
#define PG8_LDB(dst, b, h) do { _Pragma("unroll") for (int n = 0; n < 2; ++n) _Pragma("unroll") for (int k = 0; k < 2; ++k) dst[n][k] = *(const PG8_LAS bf16x8*)(lds + PG8_SB(b, h) + boff + n * 2048 + k * 1024); } while (0)
#define PG8_MMA(ai, bj, At, Bt) do { __builtin_amdgcn_s_setprio(1); _Pragma("unroll") for (int m = 0; m < 4; ++m) _Pragma("unroll") for (int n = 0; n < 2; ++n) _Pragma("unroll") for (int k = 0; k < 2; ++k) \
        acc[ai][bj][m][n] = __builtin_amdgcn_mfma_f32_16x16x32_bf16(Bt[n][k], At[m][k], acc[ai][bj][m][n], 0, 0, 0); __builtin_amdgcn_s_setprio(0); } while (0)
#define PG8_WAIT_V(n) asm volatile("s_waitcnt vmcnt(" #n ")" ::: "memory")
#define PG8_WAIT_L(n) asm volatile("s_waitcnt lgkmcnt(" #n ")" ::: "memory")
#define PG8_BAR __builtin_amdgcn_s_barrier()
#define PG8_SCHED __builtin_amdgcn_sched_barrier(0)
    Unit cur, nxt; int ui = 0;
    if (!S.next(0, cur)) return;
    f32x4 acc[2][2][4][2];
#pragma unroll
    for (int a = 0; a < 2; ++a)
#pragma unroll
        for (int b = 0; b < 2; ++b)
#pragma unroll
            for (int m = 0; m < 4; ++m)
#pragma unroll
                for (int n = 0; n < 2; ++n) acc[a][b][m][n] = (f32x4){0.f, 0.f, 0.f, 0.f};
    bf16x8 At[4][2], B0[2][2], B1[2][2];
    const char* cA = (const char*)g.A + (size_t)cur.pm * tstep; const char* cB = (const char*)g.Bt + (size_t)cur.pn * tstep;
    S.a_ready(cur);
    if constexpr (SP2) {
        PG8_STAGE(PG8_SB(0, 0), cB, voffB); PG8_STAGE(PG8_SB(0, 1), cB + hstep, voffB); PG8_STAGE(PG8_SA(0, 0), cA, voffA); PG8_STAGE(PG8_SA(0, 1), cA + hstep, voffA);
        if (wr == 1) PG8_BAR;
        PG8_WAIT_V(2); PG8_BAR;
        PG8_STAGE(PG8_SB(1, 0), cB + kstep, voffB); PG8_STAGE(PG8_SA(1, 0), cA + kstep, voffA); PG8_STAGE(PG8_SB(1, 1), cB + hstep + kstep, voffB);
        PG8_WAIT_V(6); PG8_BAR;
    } else {
        PG8_STAGE(PG8_SB(0, 0), cB, voffB); PG8_STAGE(PG8_SA(0, 0), cA, voffA); PG8_STAGE(PG8_SB(0, 1), cB + hstep, voffB); PG8_STAGE(PG8_SA(0, 1), cA + hstep, voffA);
        if (wr == 1) PG8_BAR;
        PG8_WAIT_V(4); PG8_BAR;
        PG8_STAGE(PG8_SB(1, 0), cB + kstep, voffB); PG8_STAGE(PG8_SA(1, 0), cA + kstep, voffA); PG8_STAGE(PG8_SB(1, 1), cB + hstep + kstep, voffB);
        PG8_WAIT_V(6); PG8_BAR;
    }
    for (;;) {
        const bool has_next = S.next(ui + 1, nxt);
        const char* nA = has_next ? (const char*)g.A + (size_t)nxt.pm * tstep : cA; const char* nB = has_next ? (const char*)g.Bt + (size_t)nxt.pn * tstep : cB;
        for (int t = 0; t < nt; t += 2) {
            const bool last = (t == nt - 2);
            const char* a1 = cA + (size_t)(t + 1) * kstep;
            const char* a2 = last ? nA : cA + (size_t)(t + 2) * kstep; const char* b2 = last ? nB : cB + (size_t)(t + 2) * kstep;
            const char* a3 = a2 + kstep; const char* b3 = b2 + kstep;
            if (last && has_next) S.a_ready(nxt);
            if constexpr (SP2) {
            PG8_LDB(B0, 0, 0); PG8_LDB(B1, 0, 1); PG8_SCHED; PG8_LDA(At, 0, 0); PG8_STAGE(PG8_SA(1, 1), a1 + hstep, voffA);
            PG8_WAIT_V(8); PG8_WAIT_L(0); PG8_BAR; PG8_MMA(0, 0, At, B0); PG8_MMA(0, 1, At, B1); PG8_BAR; PG8_SCHED;
            PG8_LDA(At, 0, 1); PG8_STAGE(PG8_SB(0, 0), b2, voffB); PG8_STAGE(PG8_SB(0, 1), b2 + hstep, voffB); PG8_STAGE(PG8_SA(0, 0), a2, voffA);
            PG8_WAIT_V(8); PG8_WAIT_L(0); PG8_BAR; PG8_MMA(1, 0, At, B0); PG8_MMA(1, 1, At, B1); PG8_BAR; PG8_SCHED;
            PG8_LDB(B0, 1, 0); PG8_LDB(B1, 1, 1); PG8_SCHED; PG8_LDA(At, 1, 0); PG8_STAGE(PG8_SA(0, 1), a2 + hstep, voffA);
            PG8_WAIT_V(8); PG8_WAIT_L(0); PG8_BAR; PG8_MMA(0, 0, At, B0); PG8_MMA(0, 1, At, B1); PG8_BAR; PG8_SCHED;
            PG8_LDA(At, 1, 1); PG8_STAGE(PG8_SB(1, 0), b3, voffB); PG8_STAGE(PG8_SB(1, 1), b3 + hstep, voffB); PG8_STAGE(PG8_SA(1, 0), a3, voffA);
            PG8_WAIT_V(8); PG8_WAIT_L(0); PG8_BAR; PG8_MMA(1, 0, At, B0); PG8_MMA(1, 1, At, B1); PG8_BAR; PG8_SCHED;
            } else {
            PG8_LDB(B0, 0, 0); PG8_SCHED; PG8_LDA(At, 0, 0); PG8_STAGE(PG8_SA(1, 1), a1 + hstep, voffA);
            PG8_WAIT_L(8); PG8_BAR; PG8_WAIT_L(0); PG8_MMA(0, 0, At, B0); PG8_BAR; PG8_SCHED;
            PG8_LDB(B1, 0, 1); PG8_STAGE(PG8_SB(0, 0), b2, voffB);
            PG8_BAR; PG8_WAIT_L(0); PG8_MMA(0, 1, At, B1); PG8_BAR;
            PG8_LDA(At, 0, 1); PG8_STAGE(PG8_SA(0, 0), a2, voffA);
            PG8_BAR; PG8_WAIT_L(0); PG8_MMA(1, 0, At, B0); PG8_BAR; PG8_SCHED;
            PG8_STAGE(PG8_SB(0, 1), b2 + hstep, voffB);
            PG8_WAIT_V(6); PG8_BAR; PG8_MMA(1, 1, At, B1); PG8_BAR;
            PG8_LDB(B0, 1, 0); PG8_SCHED; PG8_LDA(At, 1, 0); PG8_STAGE(PG8_SA(0, 1), a2 + hstep, voffA);
            PG8_WAIT_L(8); PG8_BAR; PG8_WAIT_L(0); PG8_MMA(0, 0, At, B0); PG8_BAR; PG8_SCHED;
            PG8_LDB(B1, 1, 1); PG8_STAGE(PG8_SB(1, 0), b3, voffB);
            PG8_BAR; PG8_WAIT_L(0); PG8_MMA(0, 1, At, B1); PG8_BAR;
            PG8_LDA(At, 1, 1); PG8_STAGE(PG8_SA(1, 0), a3, voffA);
            PG8_BAR; PG8_WAIT_L(0); PG8_MMA(1, 0, At, B0); PG8_BAR; PG8_SCHED;
            PG8_STAGE(PG8_SB(1, 1), b3 + hstep, voffB);
            PG8_WAIT_V(6); PG8_BAR; PG8_MMA(1, 1, At, B1); PG8_BAR;
            }
        }
        if constexpr (ALIGN_EPI) { if (wr == 0) PG8_BAR; }
        if constexpr (!Epi::AFTER_DRAIN) { E(acc, cur, wr, wc, fr, fq); S.done(cur); }
        if (!has_next) break;
#pragma unroll
        for (int a = 0; a < 2; ++a)
#pragma unroll
            for (int b = 0; b < 2; ++b)
#pragma unroll
                for (int m = 0; m < 4; ++m)
#pragma unroll
                    for (int n = 0; n < 2; ++n) acc[a][b][m][n] = (f32x4){0.f, 0.f, 0.f, 0.f};
        cur = nxt; cA = nA; cB = nB; ++ui;
        if constexpr (ALIGN_EPI) { if (wr == 1) PG8_BAR; }
    }
    PG8_WAIT_V(0);
    if constexpr (!ALIGN_EPI) { if (wr == 0) PG8_BAR; }
    PG8_BAR;
    if constexpr (Epi::AFTER_DRAIN) { E.fused(acc, cur, wr, wc, fr, fq, lds, wid, lane); S.done(cur); }
#undef PG8_SA
#undef PG8_SB
#undef PG8_STAGE
#undef PG8_LDA
#undef PG8_LDB
#undef PG8_MMA
#undef PG8_WAIT_V
#undef PG8_WAIT_L
#undef PG8_BAR
#undef PG8_SCHED
}
}

#define GAS __attribute__((address_space(1)))
#define LAS __attribute__((address_space(3)))
typedef unsigned short bf16;
typedef unsigned v4u __attribute__((ext_vector_type(4)));
typedef unsigned v2u __attribute__((ext_vector_type(2)));
typedef float f32x4 __attribute__((ext_vector_type(4)));
typedef float f32x2 __attribute__((ext_vector_type(2)));
typedef short bf16x8 __attribute__((ext_vector_type(8)));
#define XB_TMO      128
#define XB_XCNT(j)  (256  + 64 * (j))
#define XB_XSUB(j)  (1280 + 64 * (j))
#define XB_XGEN(j)  (2304 + 64 * (j))
#define XB_TOP      3328
#define XB_TOPGEN   3392
#define XCD_BAR_WORDS 3456
#define XB_SPIN_CAP (1u << 18)

__device__ __forceinline__ unsigned xb_ld(unsigned* p)              { return __hip_atomic_load(p, __ATOMIC_RELAXED, __HIP_MEMORY_SCOPE_AGENT); }
__device__ __forceinline__ unsigned xb_add(unsigned* p, unsigned v) { return __hip_atomic_fetch_add(p, v, __ATOMIC_RELAXED, __HIP_MEMORY_SCOPE_AGENT); }
__device__ __forceinline__ unsigned xb_xcc_id() { return (unsigned)__builtin_amdgcn_s_getreg((3 << 11) | 20) & 0xFu; }
#define XB_SPIN(cond, bar) do { unsigned _sp = 0; while (cond) { __builtin_amdgcn_s_sleep(1); \
    if ((++_sp & 255u) == 0u) { if (xb_ld(&(bar)[XB_TMO])) break; if (_sp > XB_SPIN_CAP) { atomicAdd(&(bar)[XB_TMO], 1u); break; } } } } while (0)

struct XcdBarrier {
    unsigned* bar; unsigned x;
    volatile LAS unsigned* st;
};

__device__ __forceinline__ XcdBarrier xcd_barrier_post(unsigned* bar, volatile LAS unsigned* st) {
    XcdBarrier b; b.bar = bar; b.x = xb_xcc_id(); b.st = st;
    if (threadIdx.x == 0) (void)xb_add(&bar[XB_XCNT(b.x)], 1u);
    return b;
}
__device__ __forceinline__ void xcd_barrier_complete(unsigned* bar, unsigned x, unsigned& nloc, unsigned& nx) {
    const unsigned G = gridDim.x * gridDim.y * gridDim.z;
    unsigned sum, cnt, mine, sp = 0u;
    for (;;) {
        sum = 0u; cnt = 0u; mine = 0u;
#pragma unroll
        for (unsigned j = 0; j < 16; ++j) { const unsigned c = xb_ld(&bar[XB_XCNT(j)]); sum += c; cnt += (c > 0u) ? 1u : 0u; mine = (j == x) ? c : mine; }
        if (sum == G) break;
        __builtin_amdgcn_s_sleep(1);
        if ((++sp & 255u) == 0u) { if (xb_ld(&bar[XB_TMO])) break; if (sp > XB_SPIN_CAP) { atomicAdd(&bar[XB_TMO], 1u); break; } }
    }
    nloc = mine > 0u ? mine : 1u; nx = cnt > 0u ? cnt : 1u;
}

__device__ __forceinline__ void xcd_barrier(const XcdBarrier& b) {
    asm volatile("s_waitcnt vmcnt(0)" ::: "memory");
    __syncthreads();
    if (threadIdx.x == 0) {
        unsigned* bar = b.bar;
        __builtin_amdgcn_s_waitcnt(0);
        unsigned nloc = b.st[0], nx = b.st[1];
        if (nloc == 0u) { xcd_barrier_complete(bar, b.x, nloc, nx); b.st[0] = nloc; b.st[1] = nx; }
        const unsigned old = xb_add(&bar[XB_XSUB(b.x)], 1u);
        const unsigned gen = old / nloc;
        if (old + 1u == (gen + 1u) * nloc) {
            __builtin_amdgcn_fence(__ATOMIC_RELEASE, "agent");
            asm volatile("s_waitcnt vmcnt(0)" ::: "memory");
            const unsigned og = xb_add(&bar[XB_TOP], 1u);
            const unsigned tg = og / nx;
            if (og + 1u == (tg + 1u) * nx) xb_add(&bar[XB_TOPGEN], 1u);
            else XB_SPIN(xb_ld(&bar[XB_TOPGEN]) == tg, bar);
            __builtin_amdgcn_fence(__ATOMIC_ACQUIRE, "agent");
            xb_add(&bar[XB_XGEN(b.x)], 1u);
            asm volatile("s_waitcnt vmcnt(0)" ::: "memory");
        } else {
            XB_SPIN(xb_ld(&bar[XB_XGEN(b.x)]) == gen, bar);
            __builtin_amdgcn_fence(__ATOMIC_ACQUIRE, "agent");
            asm volatile("s_waitcnt vmcnt(0)" ::: "memory");
        }
    }
    __syncthreads();
}

constexpr int MP = 8192, MS = 128, MT = MP + MS, D = 2048, NIN = 6144, NUP = 11264, DFF = 5632, PLE = 256, SEQ = 2048, NH = 8;
constexpr float EPS = 1e-6f;
constexpr int NPHASE = 10;
constexpr size_t MiB = 1u << 20;
constexpr size_t WS_BAR = 0, BAR_BYTES = 16384;
constexpr size_t WS_SS1 = 64 * 1024, WS_SS2 = 128 * 1024, WS_SS3 = 192 * 1024, WS_STATS = 256 * 1024;
constexpr size_t WS_ROPE = 1 * MiB, WS_ROPES = 2 * MiB;
constexpr size_t WS_WIN = 4 * MiB, WS_WO = 28 * MiB, WS_WUP = 36 * MiB, WS_WDN = 80 * MiB, WS_WG = 102 * MiB, WS_WP = 110 * MiB;
constexpr size_t WS_AB = 112 * MiB, WS_PB = 145 * MiB, WS_MIX = 150 * MiB, WS_Z = 183 * MiB, WS_ACT = 183 * MiB, WS_KV = 281 * MiB, WS_PP = 281 * MiB;
constexpr size_t WS_RAW = 313 * MiB, WS_AS = 335 * MiB, WS_END = 346 * MiB;
static_assert(WS_AB + (size_t)MT * D * 2 <= WS_PB && WS_PB + (size_t)MT * PLE * 2 <= WS_MIX && WS_MIX + (size_t)MT * D * 2 <= WS_Z, "ws map 1");
static_assert(WS_Z + (size_t)MT * NIN * 2 <= WS_KV && WS_ACT + (size_t)MT * DFF * 2 <= WS_KV && WS_KV + (size_t)512 * 16384 * 4 <= WS_RAW, "ws map 2");
static_assert(WS_RAW + (size_t)128 * 4 * NUP * 4 <= WS_AS && WS_AS + (size_t)MS * NUP * 4 <= WS_END && WS_PP + (size_t)MT * D * 4 <= WS_END, "ws map 3");
constexpr size_t O_RETP = 17039360, O_CONVP = 17563648, O_RETS = 17653760, O_CONVS = 34430976, O_GMV = 37314560, O_END = 37445632;
constexpr int LDS_BYTES = 147456, MISC_OFF = LDS_BYTES - 256;
constexpr int LDP = 136;
constexpr int TILE_B = 128 * LDP * 2;

struct Params { const float* in[22]; float* out; unsigned char* ws; float log2g[8]; float invf[64]; int ph_lo, ph_hi, use_cg, pad; };

#define LDS_WAIT() asm volatile("s_waitcnt lgkmcnt(0)" ::: "memory")
__device__ __forceinline__ float lo16(unsigned u) { return __uint_as_float(u << 16); }
__device__ __forceinline__ float hi16(unsigned u) { return __uint_as_float(u & 0xffff0000u); }
__device__ __forceinline__ float bf2f(bf16 b) { return __uint_as_float((unsigned)b << 16); }
__device__ __forceinline__ unsigned pk2(float lo, float hi) { return pg8::cvt_pk_bf16(lo, hi); }
__device__ __forceinline__ bf16 f2bf(float f) { return (bf16)(pg8::cvt_pk_bf16(f, 0.f) & 0xffffu); }
__device__ __forceinline__ float sigmoid_(float x) { return __builtin_amdgcn_rcpf(1.0f + __builtin_amdgcn_exp2f(-1.44269504089f * x)); }
__device__ __forceinline__ float silu_(float x) { return x * sigmoid_(x); }
__device__ __forceinline__ float gelu_(float x) { return x * sigmoid_(1.5957691216f * (x + 0.044715f * x * x * x)); }
__device__ __forceinline__ float wave_sum(float v) {
#pragma unroll
    for (int o = 1; o < 64; o <<= 1) v += __shfl_xor(v, o);
    return v;
}
__device__ __forceinline__ void atomic_addf(float* p, float v) { (void)__hip_atomic_fetch_add(p, v, __ATOMIC_RELAXED, __HIP_MEMORY_SCOPE_AGENT); }
template <int CTRL> __device__ __forceinline__ float dppf(float x) { return __int_as_float(__builtin_amdgcn_mov_dpp(__float_as_int(x), CTRL, 0xf, 0xf, false)); }

using pg8::Unit;
struct EpiZ {
    static constexpr bool PERM = true, AFTER_DRAIN = false;
    bf16* Z;
    __device__ __forceinline__ void operator()(const f32x4 (&acc)[2][2][4][2], const Unit& u, int wr, int wc, int fr, int fq) const {
        const int row0 = u.pm * 256 + wr * 64 + fr, col0 = u.pn * 256 + wc * 32 + 8 * fq;
        const int mode = u.pn < 12 ? 0 : (u.pn < 16 ? 1 : 2);
#pragma unroll
        for (int ai = 0; ai < 2; ++ai)
#pragma unroll
            for (int m = 0; m < 4; ++m) { bf16* rowp = Z + (size_t)(row0 + ai * 128 + m * 16) * NIN + col0;
#pragma unroll
                for (int bj = 0; bj < 2; ++bj) { f32x4 v0 = acc[ai][bj][m][0], v1 = acc[ai][bj][m][1];
                    if (mode == 1) {
#pragma unroll
                        for (int j = 0; j < 4; ++j) { v0[j] = silu_(v0[j]); v1[j] = silu_(v1[j]); } }
                    else if (mode == 2) {
#pragma unroll
                        for (int j = 0; j < 4; ++j) { v0[j] = gelu_(v0[j]); v1[j] = gelu_(v1[j]); } }
                    v4u w; w.x = pk2(v0[0], v0[1]); w.y = pk2(v0[2], v0[3]); w.z = pk2(v1[0], v1[1]); w.w = pk2(v1[2], v1[3]);
                    *(v4u*)(rowp + bj * 128) = w; } }
    }
};
template <bool BASE_BF16> struct EpiRes {
    static constexpr bool PERM = true, AFTER_DRAIN = false;
    const float* base; bf16* hb; float* ss;
    __device__ __forceinline__ void operator()(const f32x4 (&acc)[2][2][4][2], const Unit& u, int wr, int wc, int fr, int fq) const {
        const int row0 = u.pm * 256 + wr * 64 + fr, col0 = u.pn * 256 + wc * 32 + 8 * fq;
        float sacc[2][4];
#pragma unroll
        for (int ai = 0; ai < 2; ++ai) {
            f32x4 bs[4][2][2];
#pragma unroll
            for (int m = 0; m < 4; ++m)
#pragma unroll
                for (int bj = 0; bj < 2; ++bj) { const size_t o_ = (size_t)(row0 + ai * 128 + m * 16) * D + col0 + bj * 128;
                    if (BASE_BF16) { const v4u w = *(const v4u*)(hb + o_); bs[m][bj][0] = (f32x4){lo16(w.x), hi16(w.x), lo16(w.y), hi16(w.y)}; bs[m][bj][1] = (f32x4){lo16(w.z), hi16(w.z), lo16(w.w), hi16(w.w)}; }
                    else { bs[m][bj][0] = *(const f32x4*)(base + o_); bs[m][bj][1] = *(const f32x4*)(base + o_ + 4); } }
#pragma unroll
            for (int m = 0; m < 4; ++m) { const size_t off = (size_t)(row0 + ai * 128 + m * 16) * D + col0; float s = 0.f;
#pragma unroll
                for (int bj = 0; bj < 2; ++bj) { const f32x4 o0 = bs[m][bj][0] + acc[ai][bj][m][0], o1 = bs[m][bj][1] + acc[ai][bj][m][1];
                    v4u w; w.x = pk2(o0[0], o0[1]); w.y = pk2(o0[2], o0[3]); w.z = pk2(o1[0], o1[1]); w.w = pk2(o1[2], o1[3]); *(v4u*)(hb + off + bj * 128) = w;
                    s += ((o0[0] * o0[0] + o0[1] * o0[1]) + (o0[2] * o0[2] + o0[3] * o0[3])) + ((o1[0] * o1[0] + o1[1] * o1[1]) + (o1[2] * o1[2] + o1[3] * o1[3])); }
                s += __shfl_xor(s, 16); s += __shfl_xor(s, 32); sacc[ai][m] = s; }
            asm volatile("" ::: "memory"); }
        if (fq == 0) {
#pragma unroll
            for (int ai = 0; ai < 2; ++ai)
#pragma unroll
                for (int m = 0; m < 4; ++m) atomic_addf(ss + row0 + ai * 128 + m * 16, sacc[ai][m]); }
    }
};
struct EpiPP {
    static constexpr bool PERM = true, AFTER_DRAIN = false;
    bf16* pp;
    __device__ __forceinline__ void operator()(const f32x4 (&acc)[2][2][4][2], const Unit& u, int wr, int wc, int fr, int fq) const {
        const int row0 = u.pm * 256 + wr * 64 + fr, col0 = u.pn * 256 + wc * 32 + 8 * fq;
#pragma unroll
        for (int ai = 0; ai < 2; ++ai)
#pragma unroll
            for (int m = 0; m < 4; ++m) { if (row0 + ai * 128 + m * 16 >= MT) continue; bf16* rowp = pp + (size_t)(row0 + ai * 128 + m * 16) * D + col0;
#pragma unroll
                for (int bj = 0; bj < 2; ++bj) { const f32x4 v0 = acc[ai][bj][m][0], v1 = acc[ai][bj][m][1]; v4u w; w.x = pk2(v0[0], v0[1]); w.y = pk2(v0[2], v0[3]); w.z = pk2(v1[0], v1[1]); w.w = pk2(v1[2], v1[3]); *(v4u*)(rowp + bj * 128) = w; } }
    }
};
struct EpiGate {
    static constexpr bool PERM = true, AFTER_DRAIN = false;
    const bf16* pp; const bf16* hb; float* h; const float* ss2; float* ss3;
    __device__ __forceinline__ void operator()(const f32x4 (&acc)[2][2][4][2], const Unit& u, int wr, int wc, int fr, int fq) const {
        const int row0 = u.pm * 256 + wr * 64 + fr, col0 = u.pn * 256 + wc * 32 + 8 * fq;
        float sacc[2][4];
#pragma unroll
        for (int ai = 0; ai < 2; ++ai) {
            v4u hw[4][2], pw[4][2]; float r2[4];
#pragma unroll
            for (int m = 0; m < 4; ++m) { const int row = row0 + ai * 128 + m * 16; r2[m] = ss2[row];
#pragma unroll
                for (int bj = 0; bj < 2; ++bj) { hw[m][bj] = *(const v4u*)(hb + (size_t)row * D + col0 + bj * 128); pw[m][bj] = *(const v4u*)(pp + (size_t)row * D + col0 + bj * 128); } }
#pragma unroll
            for (int m = 0; m < 4; ++m) { const size_t off = (size_t)(row0 + ai * 128 + m * 16) * D + col0; float s = 0.f;
                const float rr = __builtin_amdgcn_rsqf(r2[m] * (1.0f / D) + EPS);
#pragma unroll
                for (int bj = 0; bj < 2; ++bj) { const v4u h4 = hw[m][bj], p4 = pw[m][bj];
                    const f32x4 hv0 = {lo16(h4.x), hi16(h4.x), lo16(h4.y), hi16(h4.y)}, hv1 = {lo16(h4.z), hi16(h4.z), lo16(h4.w), hi16(h4.w)};
                    const f32x4 pv0 = {lo16(p4.x), hi16(p4.x), lo16(p4.y), hi16(p4.y)}, pv1 = {lo16(p4.z), hi16(p4.z), lo16(p4.w), hi16(p4.w)};
                    const f32x4 a0 = acc[ai][bj][m][0], a1 = acc[ai][bj][m][1]; f32x4 o0, o1;
#pragma unroll
                    for (int j = 0; j < 4; ++j) { o0[j] = hv0[j] + pv0[j] * sigmoid_(rr * a0[j]); o1[j] = hv1[j] + pv1[j] * sigmoid_(rr * a1[j]); }
                    *(f32x4*)(h + off + bj * 128) = o0; *(f32x4*)(h + off + bj * 128 + 4) = o1;
                    s += ((o0[0] * o0[0] + o0[1] * o0[1]) + (o0[2] * o0[2] + o0[3] * o0[3])) + ((o1[0] * o1[0] + o1[1] * o1[1]) + (o1[2] * o1[2] + o1[3] * o1[3])); }
                s += __shfl_xor(s, 16); s += __shfl_xor(s, 32); sacc[ai][m] = s; }
            asm volatile("" ::: "memory"); }
        if (fq == 0) {
#pragma unroll
            for (int ai = 0; ai < 2; ++ai)
#pragma unroll
                for (int m = 0; m < 4; ++m) atomic_addf(ss3 + row0 + ai * 128 + m * 16, sacc[ai][m]); }
    }
};
struct EpiUp {
    static constexpr bool PERM = false, AFTER_DRAIN = false;
    bf16* act; float* raw; const float* ss1; const float* cw; const float* cb; LAS float* wl;
    __device__ __forceinline__ void operator()(const f32x4 (&acc)[2][2][4][2], const Unit& u, int wr, int wc, int fr, int fq) const {
        const int row0 = u.pm * 256 + wr * 64 + fr;
        LAS float* wb = wl + (wr * 4 + wc) * 256;
        { const int l = fq * 16 + fr, v = l >> 3, c4 = l & 7;
          const float* src = ((v & 3) == 3 ? cb : cw + (v & 3) * NUP) + (v >> 2) * DFF + u.pn * 128 + wc * 32 + 4 * c4;
          *(LAS f32x4*)(wb + v * 32 + 4 * c4) = *(const f32x4*)src; }
        float rs[2][4];
#pragma unroll
        for (int ai = 0; ai < 2; ++ai)
#pragma unroll
            for (int m = 0; m < 4; ++m) rs[ai][m] = __builtin_amdgcn_rsqf(ss1[row0 + ai * 128 + m * 16] * (1.0f / D) + EPS);
#pragma unroll
        for (int n = 0; n < 2; ++n) {
            const int cg_ = u.pn * 128 + wc * 32 + 16 * n + 4 * fq;
            const volatile LAS f32x4* wv = (const volatile LAS f32x4*)(wb + 16 * n + 4 * fq);
#pragma unroll
            for (int ai = 0; ai < 2; ++ai) {
                f32x4 l1g = {0.f, 0.f, 0.f, 0.f}, l2g = l1g, l1u = l1g, l2u = l1g;
#pragma unroll
                for (int m = 0; m < 4; ++m) {
                    const int row = row0 + ai * 128 + m * 16;
                    f32x4 sg;
                    { const f32x4 g = acc[ai][0][m][n] * rs[ai][m];
                      if (m == 0 && fr < 2) *(f32x4*)(raw + ((size_t)(row >> 6) * 4 + 2 + fr) * NUP + cg_) = g;
                      if (m == 3 && fr >= 14) *(f32x4*)(raw + ((size_t)(row >> 6) * 4 + (fr - 14)) * NUP + cg_) = g;
                      f32x4 r1, r2, x1, x2;
#pragma unroll
                      for (int j = 0; j < 4; ++j) { r1[j] = dppf<0x121>(g[j]); r2[j] = dppf<0x122>(g[j]); }
#pragma unroll
                      for (int j = 0; j < 4; ++j) { x1[j] = fr == 0 ? l1g[j] : r1[j]; x2[j] = fr < 2 ? l2g[j] : r2[j]; }
                      l1g = r1; l2g = r2;
                      const f32x4 w0 = wv[0], w1 = wv[8], w2 = wv[16], bb = wv[24];
                      const f32x4 ag = w0 * x2 + w1 * x1 + w2 * g + bb;
#pragma unroll
                      for (int j = 0; j < 4; ++j) sg[j] = silu_(ag[j]);
                      asm volatile("" : "+v"(sg)); }
                    f32x4 o;
                    { const f32x4 up = acc[ai][1][m][n] * rs[ai][m];
                      if (m == 0 && fr < 2) *(f32x4*)(raw + ((size_t)(row >> 6) * 4 + 2 + fr) * NUP + DFF + cg_) = up;
                      if (m == 3 && fr >= 14) *(f32x4*)(raw + ((size_t)(row >> 6) * 4 + (fr - 14)) * NUP + DFF + cg_) = up;
                      f32x4 r1, r2, x1, x2;
#pragma unroll
                      for (int j = 0; j < 4; ++j) { r1[j] = dppf<0x121>(up[j]); r2[j] = dppf<0x122>(up[j]); }
#pragma unroll
                      for (int j = 0; j < 4; ++j) { x1[j] = fr == 0 ? l1u[j] : r1[j]; x2[j] = fr < 2 ? l2u[j] : r2[j]; }
                      l1u = r1; l2u = r2;
                      const f32x4 w0 = wv[32], w1 = wv[40], w2 = wv[48], bb = wv[56];
                      o = (w0 * x2 + w1 * x1 + w2 * up + bb) * sg; }
                    v2u w; w.x = pk2(o[0], o[1]); w.y = pk2(o[2], o[3]);
                    *(v2u*)(act + (size_t)row * DFF + cg_) = w; } } }
    }
};

struct EpiAS {
    static constexpr bool PERM = false, AFTER_DRAIN = false;
    float* as; const float* ss1;
    __device__ __forceinline__ void operator()(const f32x4 (&acc)[2][2][4][2], const Unit& u, int wr, int wc, int fr, int fq) const {
#pragma unroll
        for (int m = 0; m < 4; ++m) { const int s_ = wr * 64 + m * 16 + fr; const float r = __builtin_amdgcn_rsqf(ss1[MP + s_] * (1.0f / D) + EPS);
#pragma unroll
            for (int n = 0; n < 2; ++n) { const int cg_ = u.pn * 128 + wc * 32 + 16 * n + 4 * fq;
                *(f32x4*)(as + (size_t)s_ * NUP + cg_) = acc[0][0][m][n] * r; *(f32x4*)(as + (size_t)s_ * NUP + DFF + cg_) = acc[0][1][m][n] * r; } }
    }
};
struct SampleOrder {
    int idx;
    __device__ __forceinline__ bool next(int i, Unit& u) const { if (i != 0 || idx < 0) return false; u.pm = MP / 256; u.pn = idx; return true; }
    __device__ __forceinline__ void a_ready(const Unit&) const {}
    __device__ __forceinline__ void done(const Unit&) const {}
};

struct ProjOrder {
    int first, nw;
    __device__ __forceinline__ bool next(int i, Unit& u) const { if (first < 0) return false; const int j = first + i * nw; if (j >= (MP / 256 + 1) * (D / 256)) return false; u.pm = j >> 3; u.pn = j & 7; return true; }
    __device__ __forceinline__ void a_ready(const Unit&) const {}
    __device__ __forceinline__ void done(const Unit&) const {}
};
template <int RT, int NK>
__device__ __forceinline__ void skinny_batch(f32x4 (&acc)[RT][2], const bf16* ap, const bf16* bp, int K) {
    bf16x8 bq[NK][2], aq[NK][RT];
#pragma unroll
    for (int kk = 0; kk < NK; ++kk) { bq[kk][0] = *(const bf16x8*)(bp + 32 * kk); bq[kk][1] = *(const bf16x8*)(bp + (size_t)16 * K + 32 * kk);
#pragma unroll
        for (int rt = 0; rt < RT; ++rt) aq[kk][rt] = *(const bf16x8*)(ap + (size_t)rt * 16 * K + 32 * kk); }
#pragma unroll
    for (int kk = 0; kk < NK; ++kk)
#pragma unroll
        for (int rt = 0; rt < RT; ++rt) { acc[rt][0] = __builtin_amdgcn_mfma_f32_16x16x32_bf16(bq[kk][0], aq[kk][rt], acc[rt][0], 0, 0, 0); acc[rt][1] = __builtin_amdgcn_mfma_f32_16x16x32_bf16(bq[kk][1], aq[kk][rt], acc[rt][1], 0, 0, 0); }
}
template <int RT, class F>
__device__ __forceinline__ void skinny_gemm(LAS unsigned char* lds, const bf16* A, const bf16* Bt, int N, int K, int u0, int ustride, const F& f) {
    const int tid = threadIdx.x, lane = tid & 63, w = tid >> 6, fr = lane & 15, fq = lane >> 4;
    constexpr int nrb = 8 / RT, ROWS = 16 * RT;
    const int nunits = nrb * (N / 32), kw = K / 8;
    LAS float* red = (LAS float*)lds;
    for (int u = u0; u < nunits; u += ustride) {
        const int rb = u % nrb, cb = u / nrb, row0 = rb * ROWS, col0 = cb * 32;
        f32x4 acc[RT][2];
#pragma unroll
        for (int rt = 0; rt < RT; ++rt) { acc[rt][0] = (f32x4){0.f, 0.f, 0.f, 0.f}; acc[rt][1] = (f32x4){0.f, 0.f, 0.f, 0.f}; }
        const bf16* ap = A + (size_t)(row0 + fr) * K + w * kw + 8 * fq;
        const bf16* bp = Bt + (size_t)(col0 + fr) * K + w * kw + 8 * fq;
        if constexpr (RT <= 2) {
            int k = 0;
            if (kw == 704) { skinny_batch<RT, 11>(acc, ap, bp, K); skinny_batch<RT, 11>(acc, ap + 352, bp + 352, K); k = 704; }
            for (; k + 256 <= kw; k += 256) skinny_batch<RT, 8>(acc, ap + k, bp + k, K);
            for (; k < kw; k += 32) skinny_batch<RT, 1>(acc, ap + k, bp + k, K);
        } else {
#pragma unroll 2
        for (int k = 0; k < kw; k += 32) {
            const bf16x8 b0 = *(const bf16x8*)(bp + k), b1 = *(const bf16x8*)(bp + (size_t)16 * K + k);
#pragma unroll
            for (int rt = 0; rt < RT; ++rt) { const bf16x8 av = *(const bf16x8*)(ap + (size_t)rt * 16 * K + k);
                acc[rt][0] = __builtin_amdgcn_mfma_f32_16x16x32_bf16(b0, av, acc[rt][0], 0, 0, 0);
                acc[rt][1] = __builtin_amdgcn_mfma_f32_16x16x32_bf16(b1, av, acc[rt][1], 0, 0, 0); }
        }
        }
#pragma unroll
        for (int rt = 0; rt < RT; ++rt)
#pragma unroll
            for (int ct = 0; ct < 2; ++ct) *(LAS f32x4*)(red + (w * ROWS + 16 * rt + fr) * 32 + 16 * ct + 4 * fq) = acc[rt][ct];
        __syncthreads();
#pragma unroll
        for (int it = 0; it < RT; ++it) { const int e = tid + 512 * it, r = e >> 5, c = e & 31; float v = 0.f;
#pragma unroll
            for (int ww = 0; ww < 8; ++ww) v += red[(ww * ROWS + r) * 32 + c];
            f(row0 + r, col0 + c, v); }
        __syncthreads();
    }
}
__device__ __forceinline__ float half_wave_sum(float v) {
#pragma unroll
    for (int o = 1; o < 32; o <<= 1) v += __shfl_xor(v, o);
    return v;
}

__device__ __forceinline__ void transpose_item(const float* W, int K, int N, const float* g, bf16* WT, bool upmap, LAS float* scr, int item, int lane) {
    const int nblk = N / 64, kb = item / nblk, nb = item % nblk, k0 = 64 * kb, n0 = 64 * nb;
    const float* src = W + (size_t)k0 * N + n0 + lane;
#pragma unroll
    for (int h = 0; h < 2; ++h) {
        float v[32];
#pragma unroll
        for (int i = 0; i < 32; ++i) v[i] = __builtin_nontemporal_load(src + (size_t)(32 * h + i) * N);
#pragma unroll
        for (int i = 0; i < 32; ++i) { float x = v[i]; if (g) x *= g[k0 + 32 * h + i]; scr[(32 * h + i) * 65 + lane] = x; }
    }
    LDS_WAIT(); asm volatile("" ::: "memory");
    const int c = lane & 7;
#pragma unroll
    for (int j = 0; j < 8; ++j) { const int n = (lane >> 3) + 8 * j; const LAS float* s = scr + (8 * c) * 65 + n;
        v4u o; o.x = pk2(s[0 * 65], s[1 * 65]); o.y = pk2(s[2 * 65], s[3 * 65]); o.z = pk2(s[4 * 65], s[5 * 65]); o.w = pk2(s[6 * 65], s[7 * 65]);
        int R = n0 + n; if (upmap) { const int half = R >= DFF ? 1 : 0, jj = R - half * DFF; R = 256 * (jj >> 7) + 128 * half + (jj & 127); }
        *(v4u*)(WT + (size_t)R * K + k0 + 8 * c) = o; }
    LDS_WAIT(); asm volatile("" ::: "memory");
}
__device__ __forceinline__ void rms_row_to_bf16(const float* xrow, bf16* orow, int lane) {
    const f32x4* xr = (const f32x4*)xrow + lane;
    f32x4 v[8]; float s = 0.f;
#pragma unroll
    for (int j = 0; j < 8; ++j) { v[j] = xr[64 * j]; s += (v[j][0] * v[j][0] + v[j][1] * v[j][1]) + (v[j][2] * v[j][2] + v[j][3] * v[j][3]); }
    const float r = __builtin_amdgcn_rsqf(wave_sum(s) * (1.0f / D) + EPS);
    v2u* o8 = (v2u*)orow + lane;
#pragma unroll
    for (int j = 0; j < 8; ++j) { v2u w; w.x = pk2(v[j][0] * r, v[j][1] * r); w.y = pk2(v[j][2] * r, v[j][3] * r); o8[64 * j] = w; }
}

__device__ __forceinline__ void mm128(f32x4 (&acc)[8], const LAS bf16* A, const LAS bf16* B, int wave, int fr, int fq) {
#pragma unroll
    for (int ks = 0; ks < 4; ++ks) {
        const bf16x8 a = *(const LAS bf16x8*)(A + (16 * wave + fr) * LDP + 32 * ks + 8 * fq);
#pragma unroll
        for (int ct = 0; ct < 8; ++ct) { const bf16x8 b = *(const LAS bf16x8*)(B + (16 * ct + fr) * LDP + 32 * ks + 8 * fq);
            acc[ct] = __builtin_amdgcn_mfma_f32_16x16x32_bf16(b, a, acc[ct], 0, 0, 0); }
    }
}
template <bool TRANS, bool DEC>
__device__ __forceinline__ void stage_rope(LAS bf16* dst, const bf16* zb, const float* rope, float scale, float l2g, int tid) {
#pragma unroll
    for (int it = 0; it < 2; ++it) { const int idx = tid + 512 * it, j = idx >> 3, d8 = idx & 7;
        const v4u x1 = *(const v4u*)(zb + (size_t)j * NIN + 8 * d8), x2 = *(const v4u*)(zb + (size_t)j * NIN + 64 + 8 * d8);
        const f32x4* rp = (const f32x4*)(rope + (size_t)(j * 64 + 8 * d8) * 2);
        float sc = scale; if (DEC) sc *= __builtin_amdgcn_exp2f(l2g * (float)(127 - j));
        float o1[8], o2[8];
#pragma unroll
        for (int p = 0; p < 4; ++p) { const f32x4 cs = rp[p]; const float a0 = lo16(x1[p]), a1 = hi16(x1[p]), b0 = lo16(x2[p]), b1 = hi16(x2[p]);
            o1[2 * p] = (a0 * cs[0] - b0 * cs[1]) * sc; o2[2 * p] = (b0 * cs[0] + a0 * cs[1]) * sc;
            o1[2 * p + 1] = (a1 * cs[2] - b1 * cs[3]) * sc; o2[2 * p + 1] = (b1 * cs[2] + a1 * cs[3]) * sc; }
        if (!TRANS) { v4u w1, w2;
#pragma unroll
            for (int p = 0; p < 4; ++p) { w1[p] = pk2(o1[2 * p], o1[2 * p + 1]); w2[p] = pk2(o2[2 * p], o2[2 * p + 1]); }
            *(LAS v4u*)(dst + j * LDP + 8 * d8) = w1; *(LAS v4u*)(dst + j * LDP + 64 + 8 * d8) = w2; }
        else {
#pragma unroll
            for (int i = 0; i < 8; ++i) { dst[(8 * d8 + i) * LDP + j] = f2bf(o1[i]); dst[(64 + 8 * d8 + i) * LDP + j] = f2bf(o2[i]); } }
    }
}
__device__ __forceinline__ void stage_T(LAS bf16* dst, const bf16* zb, int tid) {
#pragma unroll
    for (int it = 0; it < 4; ++it) { const int idx = tid + 512 * it, j = idx >> 4, c8 = idx & 15;
        const v4u x = *(const v4u*)(zb + (size_t)j * NIN + 8 * c8);
#pragma unroll
        for (int p = 0; p < 4; ++p) { dst[(8 * c8 + 2 * p) * LDP + j] = (bf16)(x[p] & 0xffffu); dst[(8 * c8 + 2 * p + 1) * LDP + j] = (bf16)(x[p] >> 16); } }
}


struct RopeX { v4u x1[2], x2[2]; };
struct RopeCS { f32x4 cs[2][4]; };
struct TileX { v4u x[4]; };
__device__ __forceinline__ void rope_load(RopeX& r, const bf16* zb, int tid) {
#pragma unroll
    for (int it = 0; it < 2; ++it) { const int idx = tid + 512 * it, j = idx >> 3, d8 = idx & 7; r.x1[it] = *(const v4u*)(zb + (size_t)j * NIN + 8 * d8); r.x2[it] = *(const v4u*)(zb + (size_t)j * NIN + 64 + 8 * d8); }
}
__device__ __forceinline__ void rope_cs_load(RopeCS& c, const float* rope, int tid) {
#pragma unroll
    for (int it = 0; it < 2; ++it) { const int idx = tid + 512 * it, j = idx >> 3, d8 = idx & 7; const f32x4* rp = (const f32x4*)(rope + (size_t)(j * 64 + 8 * d8) * 2);
#pragma unroll
        for (int p = 0; p < 4; ++p) c.cs[it][p] = rp[p]; }
}
template <bool TRANS, bool DEC>
__device__ __forceinline__ void rope_commit(LAS bf16* dst, const RopeX& r, const RopeCS& c, float scale, float l2g, int tid) {
#pragma unroll
    for (int it = 0; it < 2; ++it) { const int idx = tid + 512 * it, j = idx >> 3, d8 = idx & 7;
        float sc = scale; if (DEC) sc *= __builtin_amdgcn_exp2f(l2g * (float)(127 - j));
        float o1[8], o2[8];
#pragma unroll
        for (int p = 0; p < 4; ++p) { const f32x4 cs = c.cs[it][p]; const float a0 = lo16(r.x1[it][p]), a1 = hi16(r.x1[it][p]), b0 = lo16(r.x2[it][p]), b1 = hi16(r.x2[it][p]);
            o1[2 * p] = (a0 * cs[0] - b0 * cs[1]) * sc; o2[2 * p] = (b0 * cs[0] + a0 * cs[1]) * sc;
            o1[2 * p + 1] = (a1 * cs[2] - b1 * cs[3]) * sc; o2[2 * p + 1] = (b1 * cs[2] + a1 * cs[3]) * sc; }
        if (!TRANS) { v4u w1, w2;
#pragma unroll
            for (int p = 0; p < 4; ++p) { w1[p] = pk2(o1[2 * p], o1[2 * p + 1]); w2[p] = pk2(o2[2 * p], o2[2 * p + 1]); }
            *(LAS v4u*)(dst + j * LDP + 8 * d8) = w1; *(LAS v4u*)(dst + j * LDP + 64 + 8 * d8) = w2; }
        else {
#pragma unroll
            for (int i = 0; i < 8; ++i) { dst[(8 * d8 + i) * LDP + j] = f2bf(o1[i]); dst[(64 + 8 * d8 + i) * LDP + j] = f2bf(o2[i]); } }
    }
}
__device__ __forceinline__ void tile_load(TileX& t, const bf16* zb, int tid) {
#pragma unroll
    for (int it = 0; it < 4; ++it) { const int idx = tid + 512 * it, j = idx >> 4, c8 = idx & 15; t.x[it] = *(const v4u*)(zb + (size_t)j * NIN + 8 * c8); }
}
__device__ __forceinline__ void tile_commit_T(LAS bf16* dst, const TileX& t, int tid) {
#pragma unroll
    for (int it = 0; it < 4; ++it) { const int idx = tid + 512 * it, j = idx >> 4, c8 = idx & 15;
#pragma unroll
        for (int p = 0; p < 4; ++p) { dst[(8 * c8 + 2 * p) * LDP + j] = (bf16)(t.x[it][p] & 0xffffu); dst[(8 * c8 + 2 * p + 1) * LDP + j] = (bf16)(t.x[it][p] >> 16); } }
}

__global__ void __launch_bounds__(512, 2) mk_fwd(Params a) {
    extern __shared__ __attribute__((aligned(16))) unsigned char lds_raw[];
    LAS unsigned char* lds = (LAS unsigned char*)lds_raw;
    const int tid = threadIdx.x, lane = tid & 63, wave = __builtin_amdgcn_readfirstlane(tid >> 6), fr = lane & 15, fq = lane >> 4;
    const int G = gridDim.x, blk = blockIdx.x;
    const int gw = blk * 8 + wave, NGW = G * 8;
    const int gt = blk * 512 + tid, NGT = G * 512;
    unsigned char* ws = a.ws;
#define x_p (a.in[0])
#define x_s (a.in[1])
#define p_p (a.in[2])
#define p_s (a.in[3])
#define state_ret (a.in[4])
#define state_conv (a.in[5])
#define gm_ln_g (a.in[8])
#define gm_ln_b (a.in[9])
#define gm_ws (a.in[10])
#define gm_bs (a.in[11])
#define conv_w (a.in[15])
#define conv_b (a.in[16])
#define g_final (a.in[21])
#define out (a.out)
#define SS1 ((float*)(ws + WS_SS1))
#define SS2 ((float*)(ws + WS_SS2))
#define SS3 ((float*)(ws + WS_SS3))
#define STATS ((float*)(ws + WS_STATS))
#define ROPE ((float*)(ws + WS_ROPE))
#define ROPES ((float*)(ws + WS_ROPES))
#define Win_t ((bf16*)(ws + WS_WIN))
#define Wo_t ((bf16*)(ws + WS_WO))
#define Wup_t ((bf16*)(ws + WS_WUP))
#define Wdn_t ((bf16*)(ws + WS_WDN))
#define Wg_t ((bf16*)(ws + WS_WG))
#define Wp_t ((bf16*)(ws + WS_WP))
#define AB ((bf16*)(ws + WS_AB))
#define PB ((bf16*)(ws + WS_PB))
#define MIX ((bf16*)(ws + WS_MIX))
#define Z ((bf16*)(ws + WS_Z))
#define ACT ((bf16*)(ws + WS_ACT))
#define KV ((float*)(ws + WS_KV))
#define PP ((bf16*)(ws + WS_MIX))
#define RAW ((float*)(ws + WS_RAW))
#define AS ((float*)(ws + WS_AS))

    volatile LAS unsigned* MISC = (volatile LAS unsigned*)(lds + MISC_OFF);
    if (tid < 64) MISC[tid] = 0u;
    __syncthreads();
    XcdBarrier bar; bar.bar = (unsigned*)(ws + WS_BAR); bar.x = 0; bar.st = nullptr;
    if (MK_N_LAUNCHES == 1) bar = xcd_barrier_post((unsigned*)(ws + WS_BAR), MISC + 8);
    const int lo = a.ph_lo, hi = a.ph_hi;
#ifndef PHMASK
#define PHMASK 0xffff
#endif
#define IN(k) (((PHMASK >> (k)) & 1) && lo <= (k) && (k) < hi)
#define SEAM(k) do { if (IN(k) && IN((k) + 1)) { if (a.use_cg) cg::this_grid().sync(); else xcd_barrier(bar); } } while (0)

    if (IN(0)) {
        LAS float* scr = (LAS float*)(lds + wave * 16640);
        constexpr int I_IN = (D / 64) * (NIN / 64), I_O = (D / 64) * (D / 64), I_UP = (D / 64) * (NUP / 64), I_DN = (DFF / 64) * (D / 64), I_G = I_O, I_P = (PLE / 64) * (D / 64);
        constexpr int NITEMS = I_IN + I_O + I_UP + I_DN + I_G + I_P;
        for (int it = gw; it < NITEMS; it += NGW) {
            int r = it;
            if (r < I_UP) { transpose_item(a.in[14], D, NUP, a.in[13], Wup_t, true, scr, r, lane); continue; } r -= I_UP;
            if (r < I_IN) { transpose_item(a.in[7], D, NIN, a.in[6], Win_t, false, scr, r, lane); continue; } r -= I_IN;
            if (r < I_DN) { transpose_item(a.in[17], DFF, D, nullptr, Wdn_t, false, scr, r, lane); continue; } r -= I_DN;
            if (r < I_O) { transpose_item(a.in[12], D, D, nullptr, Wo_t, false, scr, r, lane); continue; } r -= I_O;
            if (r < I_G) { transpose_item(a.in[19], D, D, a.in[18], Wg_t, false, scr, r, lane); continue; } r -= I_G;
            transpose_item(a.in[20], PLE, D, nullptr, Wp_t, false, scr, r, lane);
        }
        for (int m = gw; m < MT; m += NGW) rms_row_to_bf16(m < MP ? x_p + (size_t)m * D : x_s + (size_t)(m - MP) * D, AB + (size_t)m * D, lane);
        for (int i = gt; i < MT * PLE / 4; i += NGT) { const f32x4 v = i < MP * PLE / 4 ? ((const f32x4*)p_p)[i] : ((const f32x4*)p_s)[i - MP * PLE / 4]; v2u w; w.x = pk2(v[0], v[1]); w.y = pk2(v[2], v[3]); ((v2u*)PB)[i] = w; }
        for (int i = gt; i < SEQ * 64 + 64; i += NGT) { const int pos = i < SEQ * 64 ? (i >> 6) : 16384, fi = i & 63;
            const float ang = (float)pos * a.invf[fi]; double t = (double)ang * 0.15915494309189535; t -= __builtin_rint(t); const float rev = (float)t;
            float* dst = i < SEQ * 64 ? ROPE + 2 * (size_t)i : ROPES + 2 * fi; dst[0] = __builtin_amdgcn_cosf(rev); dst[1] = __builtin_amdgcn_sinf(rev); }
        for (int i = gt; i < MT; i += NGT) { SS1[i] = 0.f; SS2[i] = 0.f; SS3[i] = 0.f; }
    }
    SEAM(0);

    if (IN(1)) {
        { pg8::Gemm g{AB, Win_t, MP, NIN, D}; pg8::StaticOrder S; S.init(MP, NIN, G, blk); EpiZ E{Z};
          pg8::gemm_phase<EpiZ, pg8::StaticOrder, true, true>(lds, g, S, E); }
        auto f = [&](int s, int n, float v) { const float o = n < 3072 ? v : (n < 4096 ? silu_(v) : gelu_(v)); Z[(size_t)(MP + s) * NIN + n] = f2bf(o); };
        skinny_gemm<8>(lds, AB + (size_t)MP * D, Win_t, NIN, D, blk, G, f);
    }
    SEAM(1);

    if (IN(2)) {
        for (int pass = 0; pass < 2; ++pass) {
        if ((pass ^ (blk & 1)) == 0) {
        { LAS float* qs = (LAS float*)lds; LAS float* ks = qs + 128; LAS float* vs = ks + 128; LAS float* red = vs + 128;
          const int e4 = tid & 31, dg = tid >> 5;
          for (int u = blk; u < MS * NH; u += G) { const int s = u >> 3, h = u & 7; const bf16* zr = Z + (size_t)(MP + s) * NIN;
            const float* S0 = state_ret + (size_t)u * 16384 + 4 * e4; float* S1 = out + O_RETS + (size_t)u * 16384 + 4 * e4;
            f32x4 s0[8];
#pragma unroll
            for (int i = 0; i < 8; ++i) s0[i] = __builtin_nontemporal_load((const f32x4*)(S0 + (dg + 16 * i) * 128));
            if (tid < 64) { const float c = ROPES[2 * tid], sn = ROPES[2 * tid + 1];
                const float q1 = bf2f(zr[128 * h + tid]), q2 = bf2f(zr[128 * h + 64 + tid]), k1 = bf2f(zr[1024 + 128 * h + tid]), k2 = bf2f(zr[1024 + 128 * h + 64 + tid]);
                qs[tid] = q1 * c - q2 * sn; qs[tid + 64] = q2 * c + q1 * sn; ks[tid] = (k1 * c - k2 * sn) * 0.08838834764831845f; ks[tid + 64] = (k2 * c + k1 * sn) * 0.08838834764831845f; }
            else if (tid < 192) vs[tid - 64] = bf2f(zr[2048 + 128 * h + tid - 64]);
            unsigned gg = 0u; if (tid < 64) gg = *(const unsigned*)(zr + 3072 + 128 * h + 2 * tid);
            __syncthreads();
            const float gamma = 1.0f - __builtin_amdgcn_exp2f((float)(-5 - h));
            const f32x4 vv = *(const LAS f32x4*)(vs + 4 * e4); f32x4 o = {0.f, 0.f, 0.f, 0.f};
#pragma unroll
            for (int i = 0; i < 8; ++i) { const int d = dg + 16 * i; const f32x4 sn = s0[i] * gamma + vv * ks[d]; __builtin_nontemporal_store(sn, (f32x4*)(S1 + d * 128)); o += sn * qs[d]; }
            *(LAS f32x4*)(red + dg * 128 + 4 * e4) = o;
            __syncthreads();
            if (tid < 64) { float o0 = 0.f, o1 = 0.f;
#pragma unroll
                for (int i = 0; i < 16; ++i) { o0 += red[i * 128 + 2 * tid]; o1 += red[i * 128 + 2 * tid + 1]; }
                const float r = __builtin_amdgcn_rsqf(wave_sum(o0 * o0 + o1 * o1) * (1.0f / 128.0f) + EPS);
                *(unsigned*)(MIX + (size_t)(MP + s) * D + 128 * h + 2 * tid) = pk2(o0 * r * lo16(gg), o1 * r * hi16(gg)); }
            __syncthreads(); } }
        } else {
        { LAS bf16* Kt = (LAS bf16*)lds; LAS bf16* Vt = (LAS bf16*)(lds + TILE_B);
          for (int u = blk; u < 512; u += G) { const int b = u >> 7, h = (u >> 4) & 7, c = u & 15; const size_t R0 = (size_t)b * SEQ + 128 * c;
            RopeX kx; RopeCS cs; TileX vx;
            rope_load(kx, Z + R0 * NIN + 1024 + 128 * h, tid); rope_cs_load(cs, ROPE + (size_t)(128 * c) * 128, tid); tile_load(vx, Z + R0 * NIN + 2048 + 128 * h, tid);
            rope_commit<true, true>(Kt, kx, cs, 0.08838834764831845f, a.log2g[h], tid);
            tile_commit_T(Vt, vx, tid);
            __syncthreads();
            f32x4 acc[8];
#pragma unroll
            for (int ct = 0; ct < 8; ++ct) acc[ct] = (f32x4){0.f, 0.f, 0.f, 0.f};
            mm128(acc, Kt, Vt, wave, fr, fq);
            float* kv = KV + (size_t)u * 16384 + (16 * wave + fr) * 128 + 4 * fq;
#pragma unroll
            for (int ct = 0; ct < 8; ++ct) *(f32x4*)(kv + 16 * ct) = acc[ct];
            __syncthreads(); } }
        for (int r0 = gw; r0 < MP; r0 += 2 * NGW) { const int r1 = r0 + NGW;
            const bf16* p0 = Z + (size_t)r0 * NIN + 5120 + 16 * lane; const bf16* p1 = Z + (size_t)(r1 < MP ? r1 : r0) * NIN + 5120 + 16 * lane;
            const v4u xa0 = *(const v4u*)p0, xa1 = *(const v4u*)(p0 + 8), xb0 = *(const v4u*)p1, xb1 = *(const v4u*)(p1 + 8);
            float va[16], vb[16];
#pragma unroll
            for (int j = 0; j < 4; ++j) { va[2 * j] = lo16(xa0[j]); va[2 * j + 1] = hi16(xa0[j]); va[8 + 2 * j] = lo16(xa1[j]); va[8 + 2 * j + 1] = hi16(xa1[j]);
                                          vb[2 * j] = lo16(xb0[j]); vb[2 * j + 1] = hi16(xb0[j]); vb[8 + 2 * j] = lo16(xb1[j]); vb[8 + 2 * j + 1] = hi16(xb1[j]); }
            float sa = 0.f, sb = 0.f;
#pragma unroll
            for (int j = 0; j < 16; ++j) { sa += va[j]; sb += vb[j]; }
            const float ma = wave_sum(sa) * (1.0f / 1024.0f), mb = wave_sum(sb) * (1.0f / 1024.0f); float qa = 0.f, qb = 0.f;
#pragma unroll
            for (int j = 0; j < 16; ++j) { const float da = va[j] - ma, db = vb[j] - mb; qa += da * da; qb += db * db; }
            const float ra = __builtin_amdgcn_rsqf(wave_sum(qa) * (1.0f / 1024.0f) + EPS), rb = __builtin_amdgcn_rsqf(wave_sum(qb) * (1.0f / 1024.0f) + EPS);
            if (lane == 0) { STATS[2 * r0] = ma; STATS[2 * r0 + 1] = ra; if (r1 < MP) { STATS[2 * r1] = mb; STATS[2 * r1 + 1] = rb; } } }
        for (int row = MP + gw; row < MT; row += NGW) { const bf16* p = Z + (size_t)row * NIN + 5120 + 16 * lane; const v4u x0 = *(const v4u*)p, x1 = *(const v4u*)(p + 8);
            const int s_ = row - MP, c0 = 16 * lane, grp = lane >> 3; const float w00 = gm_ws[grp * 16384], b0 = gm_bs[grp * 128];
            const bf16* up = Z + (size_t)row * NIN + 4096 + c0; const v4u u0 = *(const v4u*)up, u1 = *(const v4u*)(up + 8);
            float v[16];
#pragma unroll
            for (int j = 0; j < 4; ++j) { v[2 * j] = lo16(x0[j]); v[2 * j + 1] = hi16(x0[j]); v[8 + 2 * j] = lo16(x1[j]); v[8 + 2 * j + 1] = hi16(x1[j]); }
            float s = 0.f;
#pragma unroll
            for (int j = 0; j < 16; ++j) s += v[j];
            const float mean = wave_sum(s) * (1.0f / 1024.0f); float q = 0.f;
#pragma unroll
            for (int j = 0; j < 16; ++j) { v[j] -= mean; q += v[j] * v[j]; }
            const float rstd = __builtin_amdgcn_rsqf(wave_sum(q) * (1.0f / 1024.0f) + EPS);
            float uu[16];
#pragma unroll
            for (int j = 0; j < 4; ++j) { uu[2 * j] = lo16(u0[j]); uu[2 * j + 1] = hi16(u0[j]); uu[8 + 2 * j] = lo16(u1[j]); uu[8 + 2 * j + 1] = hi16(u1[j]); }
            float vn[16], mo[16];
#pragma unroll
            for (int j = 0; j < 16; ++j) { vn[j] = v[j] * rstd * gm_ln_g[c0 + j] + gm_ln_b[c0 + j]; mo[j] = uu[j] * (w00 * vn[j] + b0); }
            float* gv = out + O_GMV + (size_t)s_ * 1024 + c0;
#pragma unroll
            for (int j = 0; j < 4; ++j) *(f32x4*)(gv + 4 * j) = (f32x4){vn[4 * j], vn[4 * j + 1], vn[4 * j + 2], vn[4 * j + 3]};
            v4u w0, w1;
#pragma unroll
            for (int j = 0; j < 4; ++j) { w0[j] = pk2(mo[2 * j], mo[2 * j + 1]); w1[j] = pk2(mo[8 + 2 * j], mo[8 + 2 * j + 1]); }
            bf16* mp = MIX + (size_t)row * D + 1024 + c0; *(v4u*)mp = w0; *(v4u*)(mp + 8) = w1; }
        } }
    }
    SEAM(2);

    if (IN(3)) {
        LAS bf16* T0 = (LAS bf16*)lds; LAS bf16* T1 = (LAS bf16*)(lds + TILE_B); LAS bf16* T2 = (LAS bf16*)(lds + 2 * TILE_B); LAS bf16* T3 = (LAS bf16*)(lds + 3 * TILE_B);
        for (int u = blk; u < 512; u += G) { const int bh = u >> 4, b = bh >> 3, h = bh & 7, c = u < 256 ? (u & 15) : 15 - (u & 15); const size_t R0 = (size_t)b * SEQ + 128 * c; const float l2g = a.log2g[h];
            const int i_ = 16 * wave + fr;
            RopeX qx, kx; RopeCS cs; TileX vx; v2u gg[8];
            const float* kvb = KV + (size_t)bh * 16 * 16384;
            f32x4 tc[8];
#pragma unroll
            for (int i = 0; i < 8; ++i) tc[i] = *(const f32x4*)(kvb + 4 * (tid + 512 * i));
            rope_load(qx, Z + R0 * NIN + 128 * h, tid); rope_load(kx, Z + R0 * NIN + 1024 + 128 * h, tid); rope_cs_load(cs, ROPE + (size_t)(128 * c) * 128, tid); tile_load(vx, Z + R0 * NIN + 2048 + 128 * h, tid);
            rope_commit<false, false>(T0, qx, cs, 1.0f, 0.f, tid);
            rope_commit<false, false>(T1, kx, cs, 0.08838834764831845f, 0.f, tid);
            asm volatile("" ::: "memory");
            { const float Gc = __builtin_amdgcn_exp2f(l2g * 128.0f);
              f32x4 sp[8];
#pragma unroll
              for (int i = 0; i < 8; ++i) sp[i] = (f32x4){0.f, 0.f, 0.f, 0.f};
              for (int j = 0; j < c; ++j) { f32x4 tn[8];
#pragma unroll
                  for (int i = 0; i < 8; ++i) tn[i] = *(const f32x4*)(kvb + (size_t)(j + 1) * 16384 + 4 * (tid + 512 * i));
#pragma unroll
                  for (int i = 0; i < 8; ++i) { sp[i] = sp[i] * Gc + tc[i]; tc[i] = tn[i]; } }
              if (c == 15) {
#pragma unroll
                  for (int i = 0; i < 8; ++i) *(f32x4*)(out + O_RETP + (size_t)bh * 16384 + 4 * (tid + 512 * i)) = sp[i] * Gc + tc[i]; }
#pragma unroll
              for (int i = 0; i < 8; ++i) { const int ch = tid + 512 * i, d = ch >> 5, e4 = ch & 31;
#pragma unroll
                  for (int t = 0; t < 4; ++t) T3[(4 * e4 + t) * LDP + d] = f2bf(sp[i][t]); } }
            tile_commit_T(T2, vx, tid);
            __syncthreads();
            { const bf16* gp = Z + (R0 + i_) * NIN + 3072 + 128 * h + 4 * fq;
#pragma unroll
              for (int ct = 0; ct < 8; ++ct) gg[ct] = *(const v2u*)(gp + 16 * ct); }
            f32x4 acc2[8], acc1[8];
#pragma unroll
            for (int ct = 0; ct < 8; ++ct) { acc2[ct] = (f32x4){0.f, 0.f, 0.f, 0.f}; acc1[ct] = (f32x4){0.f, 0.f, 0.f, 0.f}; }
            mm128(acc2, T0, T3, wave, fr, fq);
            mm128(acc1, T0, T1, wave, fr, fq);
            __syncthreads();
#pragma unroll
            for (int ct = 0; ct < 8; ++ct) { float sv[4];
#pragma unroll
                for (int t = 0; t < 4; ++t) { const int j = 16 * ct + 4 * fq + t; sv[t] = i_ >= j ? acc1[ct][t] * __builtin_amdgcn_exp2f(l2g * (float)(i_ - j)) : 0.f; }
                v2u w; w.x = pk2(sv[0], sv[1]); w.y = pk2(sv[2], sv[3]); *(LAS v2u*)(T1 + i_ * LDP + 16 * ct + 4 * fq) = w; }
            __syncthreads();
#pragma unroll
            for (int ct = 0; ct < 8; ++ct) acc1[ct] = (f32x4){0.f, 0.f, 0.f, 0.f};
            mm128(acc1, T1, T2, wave, fr, fq);
            const float qd = __builtin_amdgcn_exp2f(l2g * (float)(i_ + 1)); float ssq = 0.f;
#pragma unroll
            for (int ct = 0; ct < 8; ++ct) { acc1[ct] = acc1[ct] + acc2[ct] * qd; ssq += (acc1[ct][0] * acc1[ct][0] + acc1[ct][1] * acc1[ct][1]) + (acc1[ct][2] * acc1[ct][2] + acc1[ct][3] * acc1[ct][3]); }
            ssq += __shfl_xor(ssq, 16); ssq += __shfl_xor(ssq, 32);
            const float rn = __builtin_amdgcn_rsqf(ssq * (1.0f / 128.0f) + EPS);
            bf16* mp = MIX + (R0 + i_) * D + 128 * h + 4 * fq;
#pragma unroll
            for (int ct = 0; ct < 8; ++ct) { v2u w;
                w.x = pk2(acc1[ct][0] * rn * lo16(gg[ct].x), acc1[ct][1] * rn * hi16(gg[ct].x)); w.y = pk2(acc1[ct][2] * rn * lo16(gg[ct].y), acc1[ct][3] * rn * hi16(gg[ct].y)); *(v2u*)(mp + 16 * ct) = w; }
            __syncthreads(); }
        for (int u = blk; u < 512; u += G) { const int b = u >> 7, c = (u >> 3) & 15, grp = u & 7; const size_t R0 = (size_t)b * SEQ + 128 * c;
            const int t_ = 16 * wave + fr, d8 = tid & 15;
            f32x4 wl[4][2]; v4u xv[4]; float st[4][2]; v2u uu[8]; float lg[8], lb[8];
#pragma unroll
            for (int it = 0; it < 4; ++it) { const int idx = tid + 512 * it, t = idx >> 4; const float* wp = gm_ws + (size_t)grp * 16384 + t * 128 + 8 * d8;
                wl[it][0] = *(const f32x4*)wp; wl[it][1] = *(const f32x4*)(wp + 4);
                xv[it] = *(const v4u*)(Z + (R0 + t) * NIN + 5120 + 128 * grp + 8 * d8); st[it][0] = STATS[2 * (R0 + t)]; st[it][1] = STATS[2 * (R0 + t) + 1]; }
#pragma unroll
            for (int j = 0; j < 8; ++j) { lg[j] = gm_ln_g[128 * grp + 8 * d8 + j]; lb[j] = gm_ln_b[128 * grp + 8 * d8 + j]; }
            const float bsv = gm_bs[grp * 128 + t_];
#pragma unroll
            for (int it = 0; it < 4; ++it) { const int idx = tid + 512 * it, t = idx >> 4;
                float wv[8] = {wl[it][0][0], wl[it][0][1], wl[it][0][2], wl[it][0][3], wl[it][1][0], wl[it][1][1], wl[it][1][2], wl[it][1][3]};
#pragma unroll
                for (int j = 0; j < 8; ++j) if (8 * d8 + j > t) wv[j] = 0.f;
                v4u w; w.x = pk2(wv[0], wv[1]); w.y = pk2(wv[2], wv[3]); w.z = pk2(wv[4], wv[5]); w.w = pk2(wv[6], wv[7]); *(LAS v4u*)(T0 + t * LDP + 8 * d8) = w;
                const float mean = st[it][0], rstd = st[it][1];
#pragma unroll
                for (int p = 0; p < 4; ++p) { T1[(8 * d8 + 2 * p) * LDP + t] = f2bf((lo16(xv[it][p]) - mean) * rstd * lg[2 * p] + lb[2 * p]); T1[(8 * d8 + 2 * p + 1) * LDP + t] = f2bf((hi16(xv[it][p]) - mean) * rstd * lg[2 * p + 1] + lb[2 * p + 1]); } }
            __syncthreads();
            { const bf16* up = Z + (R0 + t_) * NIN + 4096 + 128 * grp + 4 * fq;
#pragma unroll
              for (int ct = 0; ct < 8; ++ct) uu[ct] = *(const v2u*)(up + 16 * ct); }
            f32x4 acc[8];
#pragma unroll
            for (int ct = 0; ct < 8; ++ct) acc[ct] = (f32x4){0.f, 0.f, 0.f, 0.f};
            mm128(acc, T0, T1, wave, fr, fq);
            bf16* mp = MIX + (R0 + t_) * D + 1024 + 128 * grp + 4 * fq;
#pragma unroll
            for (int ct = 0; ct < 8; ++ct) { v2u w;
                w.x = pk2((acc[ct][0] + bsv) * lo16(uu[ct].x), (acc[ct][1] + bsv) * hi16(uu[ct].x)); w.y = pk2((acc[ct][2] + bsv) * lo16(uu[ct].y), (acc[ct][3] + bsv) * hi16(uu[ct].y)); *(v2u*)(mp + 16 * ct) = w; }
            __syncthreads(); }
    }
    SEAM(3);

    if (IN(4)) {
        { pg8::Gemm g{MIX, Wo_t, MP, D, D}; pg8::StaticOrder S; S.init(MP, D, G, blk); EpiRes<false> E{x_p, AB, SS1};
          pg8::gemm_phase<EpiRes<false>, pg8::StaticOrder, true, true>(lds, g, S, E); }
        auto f = [&](int s, int n, float v) { const float o = x_s[(size_t)s * D + n] + v; AB[(size_t)(MP + s) * D + n] = f2bf(o);
            const float q = half_wave_sum(o * o); if ((lane & 31) == 0) atomic_addf(SS1 + MP + s, q); };
        skinny_gemm<2>(lds, MIX + (size_t)MP * D, Wo_t, D, D, blk, G, f);
    }
    SEAM(4);

    if (IN(5)) {
        { pg8::Gemm g{AB, Wup_t, MP, NUP, D}; pg8::StaticOrder S; S.init(MP, NUP, G, blk); EpiUp E{ACT, RAW, SS1, conv_w, conv_b, (LAS float*)(lds + 131072)};
          pg8::gemm_phase<EpiUp, pg8::StaticOrder, true, true>(lds, g, S, E); }
        { pg8::Gemm g{AB, Wup_t, MP + 256, NUP, D}; SampleOrder S{(blk >= 128 && blk - 128 < NUP / 256) ? blk - 128 : -1}; EpiAS E{AS, SS1};
          pg8::gemm_phase<EpiAS, SampleOrder, true, true>(lds, g, S, E); }
        { int Kp = PLE; asm volatile("" : "+s"(Kp));
          constexpr int nbusy = (MP / 256 * (NUP / 256) + NUP / 256) - 5 * 256;
          pg8::Gemm g{PB, Wp_t, MP + 256, D, Kp}; ProjOrder S{blk >= nbusy ? blk - nbusy : -1, 256 - nbusy}; EpiPP E{PP};
          pg8::gemm_phase<EpiPP, ProjOrder, true, true>(lds, g, S, E); }
    }
    SEAM(5);

    if (IN(6)) {
        for (int i = gt; i < 128 * 2 * (DFF / 4); i += NGT) { const int c4 = i % (DFF / 4), gr = i / (DFF / 4), rr = gr & 1, Gp = gr >> 1, c = 4 * c4; const bool first = (Gp & 31) == 0;
            const float* rg = RAW + (size_t)Gp * 4 * NUP; const float* rp = rg - 4 * NUP; const f32x4 z4 = {0.f, 0.f, 0.f, 0.f};
            f32x4 a0g, a0u, a1g, a1u, a2g, a2u;
            a0g = *(const f32x4*)(rg + (2 + rr) * NUP + c); a0u = *(const f32x4*)(rg + (2 + rr) * NUP + DFF + c);
            if (rr) { a1g = *(const f32x4*)(rg + 2 * NUP + c); a1u = *(const f32x4*)(rg + 2 * NUP + DFF + c); a2g = first ? z4 : *(const f32x4*)(rp + NUP + c); a2u = first ? z4 : *(const f32x4*)(rp + NUP + DFF + c); }
            else { a1g = first ? z4 : *(const f32x4*)(rp + NUP + c); a1u = first ? z4 : *(const f32x4*)(rp + NUP + DFF + c); a2g = first ? z4 : *(const f32x4*)(rp + c); a2u = first ? z4 : *(const f32x4*)(rp + DFF + c); }
            const f32x4 ag = *(const f32x4*)(conv_w + c) * a2g + *(const f32x4*)(conv_w + NUP + c) * a1g + *(const f32x4*)(conv_w + 2 * NUP + c) * a0g + *(const f32x4*)(conv_b + c);
            const f32x4 au = *(const f32x4*)(conv_w + DFF + c) * a2u + *(const f32x4*)(conv_w + NUP + DFF + c) * a1u + *(const f32x4*)(conv_w + 2 * NUP + DFF + c) * a0u + *(const f32x4*)(conv_b + DFF + c);
            v2u w; w.x = pk2(silu_(ag[0]) * au[0], silu_(ag[1]) * au[1]); w.y = pk2(silu_(ag[2]) * au[2], silu_(ag[3]) * au[3]);
            *(v2u*)(ACT + (size_t)(64 * Gp + rr) * DFF + c) = w; }
        for (int i = gt; i < MS * (DFF / 4); i += NGT) { const int c4 = i % (DFF / 4), s = i / (DFF / 4), c = 4 * c4;
            const float* sc0 = state_conv + (size_t)s * 2 * NUP; const float* sc1 = sc0 + NUP; const float* as = AS + (size_t)s * NUP;
            const f32x4 a0g = *(const f32x4*)(as + c), a0u = *(const f32x4*)(as + DFF + c), a1g = *(const f32x4*)(sc1 + c), a1u = *(const f32x4*)(sc1 + DFF + c), a2g = *(const f32x4*)(sc0 + c), a2u = *(const f32x4*)(sc0 + DFF + c);
            const f32x4 ag = *(const f32x4*)(conv_w + c) * a2g + *(const f32x4*)(conv_w + NUP + c) * a1g + *(const f32x4*)(conv_w + 2 * NUP + c) * a0g + *(const f32x4*)(conv_b + c);
            const f32x4 au = *(const f32x4*)(conv_w + DFF + c) * a2u + *(const f32x4*)(conv_w + NUP + DFF + c) * a1u + *(const f32x4*)(conv_w + 2 * NUP + DFF + c) * a0u + *(const f32x4*)(conv_b + DFF + c);
            v2u w; w.x = pk2(silu_(ag[0]) * au[0], silu_(ag[1]) * au[1]); w.y = pk2(silu_(ag[2]) * au[2], silu_(ag[3]) * au[3]);
            *(v2u*)(ACT + (size_t)(MP + s) * DFF + c) = w;
            float* cs = out + O_CONVS + (size_t)s * 2 * NUP; *(f32x4*)(cs + c) = a1g; *(f32x4*)(cs + DFF + c) = a1u; *(f32x4*)(cs + NUP + c) = a0g; *(f32x4*)(cs + NUP + DFF + c) = a0u; }
        for (int i = gt; i < 4 * 2 * (NUP / 4); i += NGT) { const int c4 = i % (NUP / 4), bk = i / (NUP / 4), b = bk >> 1, k = bk & 1;
            *(f32x4*)(out + O_CONVP + (size_t)bk * NUP + 4 * c4) = *(const f32x4*)(RAW + ((size_t)(32 * b + 31) * 4 + k) * NUP + 4 * c4); }
    }
    SEAM(6);

    if (IN(7)) {
        { pg8::Gemm g{ACT, Wdn_t, MP, D, DFF}; pg8::StaticOrder S; S.init(MP, D, G, blk); EpiRes<true> E{nullptr, AB, SS2};
          pg8::gemm_phase<EpiRes<true>, pg8::StaticOrder, true, true>(lds, g, S, E); }
        auto f = [&](int s, int n, float v) { const size_t o_ = (size_t)(MP + s) * D + n; const float o = bf2f(AB[o_]) + v; AB[o_] = f2bf(o);
            const float q = half_wave_sum(o * o); if ((lane & 31) == 0) atomic_addf(SS2 + MP + s, q); };
        skinny_gemm<2>(lds, ACT + (size_t)MP * DFF, Wdn_t, D, DFF, blk, G, f);
    }
    SEAM(7);

    if (IN(8)) {
#ifndef T_B
        { pg8::Gemm g{AB, Wg_t, MP, D, D}; pg8::StaticOrder S; S.init(MP, D, G, blk); EpiGate E{PP, AB, out, SS2, SS3};
          pg8::gemm_phase<EpiGate, pg8::StaticOrder, true, true>(lds, g, S, E); }
#endif
#ifndef T_D
        auto f2 = [&](int s, int n, float v) { const size_t o_ = (size_t)(MP + s) * D + n; const float r2 = __builtin_amdgcn_rsqf(SS2[MP + s] * (1.0f / D) + EPS);
            const float o = bf2f(AB[o_]) + bf2f(PP[o_]) * sigmoid_(r2 * v); out[o_] = o; const float q = half_wave_sum(o * o); if ((lane & 31) == 0) atomic_addf(SS3 + MP + s, q); };
        skinny_gemm<2>(lds, AB + (size_t)MP * D, Wg_t, D, D, blk, G, f2);
#endif
    }
    SEAM(8);

    if (IN(9)) {
        { const f32x4* gr = (const f32x4*)g_final + lane; f32x4 gv[8];
#pragma unroll
          for (int j = 0; j < 8; ++j) gv[j] = gr[64 * j];
          for (int m0 = gw; m0 < MT; m0 += 2 * NGW) { const int m1 = m0 + NGW; const bool two = m1 < MT;
            f32x4* h0 = (f32x4*)(out + (size_t)m0 * D) + lane; f32x4* h1 = (f32x4*)(out + (size_t)(two ? m1 : m0) * D) + lane;
            f32x4 a0[8], a1[8];
#pragma unroll
            for (int j = 0; j < 8; ++j) { a0[j] = h0[64 * j]; a1[j] = h1[64 * j]; }
            const float r0 = __builtin_amdgcn_rsqf(SS3[m0] * (1.0f / D) + EPS), r1 = __builtin_amdgcn_rsqf(SS3[two ? m1 : m0] * (1.0f / D) + EPS);
#pragma unroll
            for (int j = 0; j < 8; ++j) h0[64 * j] = a0[j] * gv[j] * r0;
            if (two) {
#pragma unroll
                for (int j = 0; j < 8; ++j) h1[64 * j] = a1[j] * gv[j] * r1; } } }
    }
#undef IN
#undef SEAM
}
#undef x_p
#undef x_s
#undef p_p
#undef p_s
#undef state_ret
#undef state_conv
#undef gm_ln_g
#undef gm_ln_b
#undef gm_ws
#undef gm_bs
#undef conv_w
#undef conv_b
#undef g_final
#undef out
#undef SS1
#undef SS2
#undef SS3
#undef STATS
#undef ROPE
#undef ROPES
#undef Win_t
#undef Wo_t
#undef Wup_t
#undef Wdn_t
#undef Wg_t
#undef Wp_t
#undef AB
#undef PB
#undef MIX
#undef Z
#undef ACT
#undef KV
#undef PP
#undef RAW
#undef AS

extern "C" void kernel_launch(void* const* d_in, const int* in_sizes, int n_in, void* d_out, int out_size, void* d_ws, size_t ws_size, hipStream_t stream) {
    static int grid = 0;
    if (grid == 0) {
        if (n_in != 22 || out_size != (int)O_END || ws_size < WS_END) { fprintf(stderr, "kernel_launch: unexpected shapes: n_in %d out %d ws %zu\n", n_in, out_size, ws_size); grid = -1; return; }
        int dev = 0, cus = 0, per_cu = 0;
        if (hipGetDevice(&dev) != hipSuccess || hipDeviceGetAttribute(&cus, hipDeviceAttributeMultiprocessorCount, dev) != hipSuccess) { grid = -1; return; }
        if (hipFuncSetAttribute((const void*)mk_fwd, hipFuncAttributeMaxDynamicSharedMemorySize, LDS_BYTES) != hipSuccess) { fprintf(stderr, "kernel_launch: hipFuncSetAttribute failed\n"); grid = -1; return; }
        if (hipOccupancyMaxActiveBlocksPerMultiprocessor(&per_cu, (const void*)mk_fwd, 512, LDS_BYTES) != hipSuccess || per_cu < 1) fprintf(stderr, "kernel_launch: occupancy query says %d\n", per_cu);
        (void)hipGetLastError();
        grid = cus;
        if (grid != 256) fprintf(stderr, "kernel_launch: %d CUs (built for 256)\n", grid);
    }
    if (grid < 0) return;
    if (hipMemsetAsync((char*)d_ws + WS_BAR, 0, BAR_BYTES, stream) != hipSuccess) { fprintf(stderr, "kernel_launch: memset failed\n"); return; }
    Params p{};
    for (int i = 0; i < 22; ++i) p.in[i] = (const float*)d_in[i];
    p.out = (float*)d_out; p.ws = (unsigned char*)d_ws;
    for (int h = 0; h < 8; ++h) p.log2g[h] = (float)std::log2(1.0 - std::exp2(-5.0 - (double)h));
    for (int i = 0; i < 64; ++i) p.invf[i] = powf(10000.0f, -(float)i / 64.0f);
    p.use_cg = 0; p.pad = 0;
#if MK_N_LAUNCHES == 1
    void* args[] = {&p};
#ifdef PROBE_K
    p.ph_lo = 0; p.ph_hi = PROBE_K + 1;
    (void)hipLaunchCooperativeKernel((const void*)mk_fwd, dim3(grid), dim3(512), args, LDS_BYTES, stream);
    if (hipMemsetAsync((char*)d_ws + WS_BAR, 0, BAR_BYTES, stream) != hipSuccess) return;
#endif
    p.ph_lo = 0; p.ph_hi = NPHASE;
    hipError_t e = hipLaunchCooperativeKernel((const void*)mk_fwd, dim3(grid), dim3(512), args, LDS_BYTES, stream);
    if (e != hipSuccess) fprintf(stderr, "kernel_launch: cooperative launch failed: %s\n", hipGetErrorString(e));
#else
    for (int ph = 0; ph < NPHASE; ++ph) { p.ph_lo = ph; p.ph_hi = ph + 1; hipLaunchKernelGGL(mk_fwd, dim3(grid), dim3(512), LDS_BYTES, stream, p); }
#endif
}
```

```cpp
#include <hip/hip_runtime.h>
#include <hip/hip_cooperative_groups.h>
#include <cstdio>
#include <cstdint>
#include <cmath>
namespace cg = cooperative_groups;

#ifndef MK_N_LAUNCHES
#define MK_N_LAUNCHES 1
#endif

namespace pg8 {
#define PG8_LAS __attribute__((address_space(3)))
typedef unsigned short bf16_t;
typedef short bf16x8 __attribute__((ext_vector_type(8)));
typedef float f32x4 __attribute__((ext_vector_type(4)));
typedef unsigned u32x4 __attribute__((ext_vector_type(4)));
constexpr int BM = 256, BK = 64, HALF = 128, HTB = HALF * BK * 2  , STAGE_BYTES = 8 * HTB, NXCD = 8, WGM = 8;

__host__ __device__ __forceinline__ int lds_byte(int r, int c) { const int st = (r >> 4) * 2 + (c >> 5), rr = r & 15, cc = c & 31, ob = rr * 64 + cc * 2; return st * 1024 + (ob ^ (((ob >> 9) & 1) << 5)); }
__host__ __device__ __forceinline__ void stage_rc(int b, int& R, int& C) { const int st = b / 1024, sb = b % 1024, swz = sb ^ (((sb >> 9) & 1) << 5); R = (st >> 1) * 16 + swz / 64; C = (st & 1) * 32 + (swz % 64) / 2; }
__host__ __device__ __forceinline__ int perm32(int rho) { const int n = rho >> 4, i = rho & 15; return 8 * (i >> 2) + 4 * n + (i & 3); }

struct Unit { int pm, pn; };
struct Gemm { const bf16_t* A; const bf16_t* Bt; int M, N, K; };

struct StaticOrder {
    int nM, nN, nwg, G, c;
    __host__ __device__ void init(int M, int N, int G_, int c_) { nM = M / BM; nN = N / BM; nwg = nM * nN; G = G_; c = c_; }
    __host__ __device__ bool next(int i, Unit& u) const {
        const long L = (long)i * G + c; if (L >= nwg) return false;
        int wgid = (int)L; { const int q = nwg / NXCD, r = nwg % NXCD, xcd = wgid % NXCD, off = wgid / NXCD; wgid = (xcd < r ? xcd * (q + 1) : r * (q + 1) + (xcd - r) * q) + off; }
        const int nig = WGM * nN, gid = wgid / nig, fm = gid * WGM, gsz = (nM - fm) < WGM ? (nM - fm) : WGM;
        u.pm = fm + ((wgid % nig) % gsz); u.pn = (wgid % nig) / gsz; return true;
    }
    __device__ __forceinline__ void a_ready(const Unit&) const {}
    __device__ __forceinline__ void done(const Unit&) const {}
};

__device__ __forceinline__ unsigned cvt_pk_bf16(float lo, float hi) { unsigned r; asm volatile("v_cvt_pk_bf16_f32 %0, %1, %2" : "=v"(r) : "v"(lo), "v"(hi)); return r; }
typedef float f32x2 __attribute__((ext_vector_type(2)));

template <class Epi, class Sched, bool ALIGN_EPI = false, bool SP2 = false>
__device__ __forceinline__ void gemm_phase(PG8_LAS unsigned char* lds, const Gemm g, const Sched& S, const Epi& E) {
    const int tid = threadIdx.x, wid = __builtin_amdgcn_readfirstlane(tid >> 6), lane = tid & 63, wr = wid >> 2, wc = wid & 3, fr = lane & 15, fq = lane >> 4;
    const int K = g.K, nt = K / BK;
    unsigned voffA[2], voffB[2];
#pragma unroll
    for (int i = 0; i < 2; ++i) { int R, C; stage_rc(tid * 16 + i * 8192, R, C); const int Rb = Epi::PERM ? ((R & ~31) + perm32(R & 31)) : R;
        voffA[i] = (unsigned)(R * K + C) * 2u; voffB[i] = (unsigned)(Rb * K + C) * 2u; }
    const size_t kstep = (size_t)(BK * 2);
    const size_t hstep = (size_t)HALF * K * 2;
    const size_t tstep = 2 * hstep;
    const unsigned ldsw = (unsigned)wid * 1024u;
    const int aoff = lds_byte(wr * 64 + fr, fq * 8), boff = lds_byte(wc * 32 + fr, fq * 8);
#define PG8_SA(b, h) (((b) * 2 + (h)) * HTB)
#define PG8_SB(b, h) ((4 + (b) * 2 + (h)) * HTB)
#define PG8_STAGE(bufoff, gbase, voff) do { _Pragma("unroll") for (int _i = 0; _i < 2; ++_i) \
        __builtin_amdgcn_global_load_lds((const unsigned*)((const char*)(gbase) + (voff)[_i]), (PG8_LAS unsigned*)(lds + (bufoff) + ldsw + _i * 8192), 16, 0, 0); } while (0)
#define PG8_LDA(dst, b, h) do { _Pragma("unroll") for (int m = 0; m < 4; ++m) _Pragma("unroll") for (int k = 0; k < 2; ++k) dst[m][k] = *(const PG8_LAS bf16x8*)(lds + PG8_SA(b, h) + aoff + m * 2048 + k * 1024); } while (0)
#define PG8_LDB(dst, b, h) do { _Pragma("unroll") for (int n = 0; n < 2; ++n) _Pragma("unroll") for (int k = 0; k < 2; ++k) dst[n][k] = *(const PG8_LAS bf16x8*)(lds + PG8_SB(b, h) + boff + n * 2048 + k * 1024); } while (0)
#define PG8_MMA(ai, bj, At, Bt) do { __builtin_amdgcn_s_setprio(1); _Pragma("unroll") for (int m = 0; m < 4; ++m) _Pragma("unroll") for (int n = 0; n < 2; ++n) _Pragma("unroll") for (int k = 0; k < 2; ++k) \
        acc[ai][bj][m][n] = __builtin_amdgcn_mfma_f32_16x16x32_bf16(Bt[n][k], At[m][k], acc[ai][bj][m][n], 0, 0, 0); __builtin_amdgcn_s_setprio(0); } while (0)
#define PG8_WAIT_V(n) asm volatile("s_waitcnt vmcnt(" #n ")" ::: "memory")
#define PG8_WAIT_L(n) asm volatile("s_waitcnt lgkmcnt(" #n ")" ::: "memory")
#define PG8_BAR __builtin_amdgcn_s_barrier()
#define PG8_SCHED __builtin_amdgcn_sched_barrier(0)
    Unit cur, nxt; int ui = 0;
    if (!S.next(0, cur)) return;
    f32x4 acc[2][2][4][2];
#pragma unroll
    for (int a = 0; a < 2; ++a)
#pragma unroll
        for (int b = 0; b < 2; ++b)
#pragma unroll
            for (int m = 0; m < 4; ++m)
#pragma unroll
                for (int n = 0; n < 2; ++n) acc[a][b][m][n] = (f32x4){0.f, 0.f, 0.f, 0.f};
    bf16x8 At[4][2], B0[2][2], B1[2][2];
    const char* cA = (const char*)g.A + (size_t)cur.pm * tstep; const char* cB = (const char*)g.Bt + (size_t)cur.pn * tstep;
    S.a_ready(cur);
    if constexpr (SP2) {
        PG8_STAGE(PG8_SB(0, 0), cB, voffB); PG8_STAGE(PG8_SB(0, 1), cB + hstep, voffB); PG8_STAGE(PG8_SA(0, 0), cA, voffA); PG8_STAGE(PG8_SA(0, 1), cA + hstep, voffA);
        if (wr == 1) PG8_BAR;
        PG8_WAIT_V(2); PG8_BAR;
        PG8_STAGE(PG8_SB(1, 0), cB + kstep, voffB); PG8_STAGE(PG8_SA(1, 0), cA + kstep, voffA); PG8_STAGE(PG8_SB(1, 1), cB + hstep + kstep, voffB);
        PG8_WAIT_V(6); PG8_BAR;
    } else {
        PG8_STAGE(PG8_SB(0, 0), cB, voffB); PG8_STAGE(PG8_SA(0, 0), cA, voffA); PG8_STAGE(PG8_SB(0, 1), cB + hstep, voffB); PG8_STAGE(PG8_SA(0, 1), cA + hstep, voffA);
        if (wr == 1) PG8_BAR;
        PG8_WAIT_V(4); PG8_BAR;
        PG8_STAGE(PG8_SB(1, 0), cB + kstep, voffB); PG8_STAGE(PG8_SA(1, 0), cA + kstep, voffA); PG8_STAGE(PG8_SB(1, 1), cB + hstep + kstep, voffB);
        PG8_WAIT_V(6); PG8_BAR;
    }
    for (;;) {
        const bool has_next = S.next(ui + 1, nxt);
        const char* nA = has_next ? (const char*)g.A + (size_t)nxt.pm * tstep : cA; const char* nB = has_next ? (const char*)g.Bt + (size_t)nxt.pn * tstep : cB;
        for (int t = 0; t < nt; t += 2) {
            const bool last = (t == nt - 2);
            const char* a1 = cA + (size_t)(t + 1) * kstep;
            const char* a2 = last ? nA : cA + (size_t)(t + 2) * kstep; const char* b2 = last ? nB : cB + (size_t)(t + 2) * kstep;
            const char* a3 = a2 + kstep; const char* b3 = b2 + kstep;
            if (last && has_next) S.a_ready(nxt);
            if constexpr (SP2) {
            PG8_LDB(B0, 0, 0); PG8_LDB(B1, 0, 1); PG8_SCHED; PG8_LDA(At, 0, 0); PG8_STAGE(PG8_SA(1, 1), a1 + hstep, voffA);
            PG8_WAIT_V(8); PG8_WAIT_L(0); PG8_BAR; PG8_MMA(0, 0, At, B0); PG8_MMA(0, 1, At, B1); PG8_BAR; PG8_SCHED;
            PG8_LDA(At, 0, 1); PG8_STAGE(PG8_SB(0, 0), b2, voffB); PG8_STAGE(PG8_SB(0, 1), b2 + hstep, voffB); PG8_STAGE(PG8_SA(0, 0), a2, voffA);
            PG8_WAIT_V(8); PG8_WAIT_L(0); PG8_BAR; PG8_MMA(1, 0, At, B0); PG8_MMA(1, 1, At, B1); PG8_BAR; PG8_SCHED;
            PG8_LDB(B0, 1, 0); PG8_LDB(B1, 1, 1); PG8_SCHED; PG8_LDA(At, 1, 0); PG8_STAGE(PG8_SA(0, 1), a2 + hstep, voffA);
            PG8_WAIT_V(8); PG8_WAIT_L(0); PG8_BAR; PG8_MMA(0, 0, At, B0); PG8_MMA(0, 1, At, B1); PG8_BAR; PG8_SCHED;
            PG8_LDA(At, 1, 1); PG8_STAGE(PG8_SB(1, 0), b3, voffB); PG8_STAGE(PG8_SB(1, 1), b3 + hstep, voffB); PG8_STAGE(PG8_SA(1, 0), a3, voffA);
            PG8_WAIT_V(8); PG8_WAIT_L(0); PG8_BAR; PG8_MMA(1, 0, At, B0); PG8_MMA(1, 1, At, B1); PG8_BAR; PG8_SCHED;
            } else {
            PG8_LDB(B0, 0, 0); PG8_SCHED; PG8_LDA(At, 0, 0); PG8_STAGE(PG8_SA(1, 1), a1 + hstep, voffA);
            PG8_WAIT_L(8); PG8_BAR; PG8_WAIT_L(0); PG8_MMA(0, 0, At, B0); PG8_BAR; PG8_SCHED;
            PG8_LDB(B1, 0, 1); PG8_STAGE(PG8_SB(0, 0), b2, voffB);
            PG8_BAR; PG8_WAIT_L(0); PG8_MMA(0, 1, At, B1); PG8_BAR;
            PG8_LDA(At, 0, 1); PG8_STAGE(PG8_SA(0, 0), a2, voffA);
            PG8_BAR; PG8_WAIT_L(0); PG8_MMA(1, 0, At, B0); PG8_BAR; PG8_SCHED;
            PG8_STAGE(PG8_SB(0, 1), b2 + hstep, voffB);
            PG8_WAIT_V(6); PG8_BAR; PG8_MMA(1, 1, At, B1); PG8_BAR;
            PG8_LDB(B0, 1, 0); PG8_SCHED; PG8_LDA(At, 1, 0); PG8_STAGE(PG8_SA(0, 1), a2 + hstep, voffA);
            PG8_WAIT_L(8); PG8_BAR; PG8_WAIT_L(0); PG8_MMA(0, 0, At, B0); PG8_BAR; PG8_SCHED;
            PG8_LDB(B1, 1, 1); PG8_STAGE(PG8_SB(1, 0), b3, voffB);
            PG8_BAR; PG8_WAIT_L(0); PG8_MMA(0, 1, At, B1); PG8_BAR;
            PG8_LDA(At, 1, 1); PG8_STAGE(PG8_SA(1, 0), a3, voffA);
            PG8_BAR; PG8_WAIT_L(0); PG8_MMA(1, 0, At, B0); PG8_BAR; PG8_SCHED;
            PG8_STAGE(PG8_SB(1, 1), b3 + hstep, voffB);
            PG8_WAIT_V(6); PG8_BAR; PG8_MMA(1, 1, At, B1); PG8_BAR;
            }
        }
        if constexpr (ALIGN_EPI) { if (wr == 0) PG8_BAR; }
        if constexpr (!Epi::AFTER_DRAIN) { E(acc, cur, wr, wc, fr, fq); S.done(cur); }
        if (!has_next) break;
#pragma unroll
        for (int a = 0; a < 2; ++a)
#pragma unroll
            for (int b = 0; b < 2; ++b)
#pragma unroll
                for (int m = 0; m < 4; ++m)
#pragma unroll
                    for (int n = 0; n < 2; ++n) acc[a][b][m][n] = (f32x4){0.f, 0.f, 0.f, 0.f};
        cur = nxt; cA = nA; cB = nB; ++ui;
        if constexpr (ALIGN_EPI) { if (wr == 1) PG8_BAR; }
    }
    PG8_WAIT_V(0);
    if constexpr (!ALIGN_EPI) { if (wr == 0) PG8_BAR; }
    PG8_BAR;
    if constexpr (Epi::AFTER_DRAIN) { E.fused(acc, cur, wr, wc, fr, fq, lds, wid, lane); S.done(cur); }
#undef PG8_SA
#undef PG8_SB
#undef PG8_STAGE
#undef PG8_LDA
#undef PG8_LDB
#undef PG8_MMA
#undef PG8_WAIT_V
#undef PG8_WAIT_L
#undef PG8_BAR
#undef PG8_SCHED
}
}

#define GAS __attribute__((address_space(1)))
#define LAS __attribute__((address_space(3)))
typedef unsigned short bf16;
typedef unsigned v4u __attribute__((ext_vector_type(4)));
typedef unsigned v2u __attribute__((ext_vector_type(2)));
typedef float f32x4 __attribute__((ext_vector_type(4)));
typedef float f32x2 __attribute__((ext_vector_type(2)));
typedef short bf16x8 __attribute__((ext_vector_type(8)));
#define XB_TMO      128
#define XB_XCNT(j)  (256  + 64 * (j))
#define XB_XSUB(j)  (1280 + 64 * (j))
#define XB_XGEN(j)  (2304 + 64 * (j))
#define XB_TOP      3328
#define XB_TOPGEN   3392
#define XCD_BAR_WORDS 3456
#define XB_SPIN_CAP (1u << 18)

__device__ __forceinline__ unsigned xb_ld(unsigned* p)              { return __hip_atomic_load(p, __ATOMIC_RELAXED, __HIP_MEMORY_SCOPE_AGENT); }
__device__ __forceinline__ unsigned xb_add(unsigned* p, unsigned v) { return __hip_atomic_fetch_add(p, v, __ATOMIC_RELAXED, __HIP_MEMORY_SCOPE_AGENT); }
__device__ __forceinline__ unsigned xb_xcc_id() { return (unsigned)__builtin_amdgcn_s_getreg((3 << 11) | 20) & 0xFu; }
#define XB_SPIN(cond, bar) do { unsigned _sp = 0; while (cond) { __builtin_amdgcn_s_sleep(1); \
    if ((++_sp & 255u) == 0u) { if (xb_ld(&(bar)[XB_TMO])) break; if (_sp > XB_SPIN_CAP) { atomicAdd(&(bar)[XB_TMO], 1u); break; } } } } while (0)

struct XcdBarrier {
    unsigned* bar; unsigned x;
    volatile LAS unsigned* st;
};

__device__ __forceinline__ XcdBarrier xcd_barrier_post(unsigned* bar, volatile LAS unsigned* st) {
    XcdBarrier b; b.bar = bar; b.x = xb_xcc_id(); b.st = st;
    if (threadIdx.x == 0) (void)xb_add(&bar[XB_XCNT(b.x)], 1u);
    return b;
}
__device__ __forceinline__ void xcd_barrier_complete(unsigned* bar, unsigned x, unsigned& nloc, unsigned& nx) {
    const unsigned G = gridDim.x * gridDim.y * gridDim.z;
    unsigned sum, cnt, mine, sp = 0u;
    for (;;) {
        sum = 0u; cnt = 0u; mine = 0u;
#pragma unroll
        for (unsigned j = 0; j < 16; ++j) { const unsigned c = xb_ld(&bar[XB_XCNT(j)]); sum += c; cnt += (c > 0u) ? 1u : 0u; mine = (j == x) ? c : mine; }
        if (sum == G) break;
        __builtin_amdgcn_s_sleep(1);
        if ((++sp & 255u) == 0u) { if (xb_ld(&bar[XB_TMO])) break; if (sp > XB_SPIN_CAP) { atomicAdd(&bar[XB_TMO], 1u); break; } }
    }
    nloc = mine > 0u ? mine : 1u; nx = cnt > 0u ? cnt : 1u;
}

__device__ __forceinline__ void xcd_barrier(const XcdBarrier& b) {
    asm volatile("s_waitcnt vmcnt(0)" ::: "memory");
    __syncthreads();
    if (threadIdx.x == 0) {
        unsigned* bar = b.bar;
        __builtin_amdgcn_s_waitcnt(0);
        unsigned nloc = b.st[0], nx = b.st[1];
        if (nloc == 0u) { xcd_barrier_complete(bar, b.x, nloc, nx); b.st[0] = nloc; b.st[1] = nx; }
        const unsigned old = xb_add(&bar[XB_XSUB(b.x)], 1u);
        const unsigned gen = old / nloc;
        if (old + 1u == (gen + 1u) * nloc) {
            __builtin_amdgcn_fence(__ATOMIC_RELEASE, "agent");
            asm volatile("s_waitcnt vmcnt(0)" ::: "memory");
            const unsigned og = xb_add(&bar[XB_TOP], 1u);
            const unsigned tg = og / nx;
            if (og + 1u == (tg + 1u) * nx) xb_add(&bar[XB_TOPGEN], 1u);
            else XB_SPIN(xb_ld(&bar[XB_TOPGEN]) == tg, bar);
            __builtin_amdgcn_fence(__ATOMIC_ACQUIRE, "agent");
            xb_add(&bar[XB_XGEN(b.x)], 1u);
            asm volatile("s_waitcnt vmcnt(0)" ::: "memory");
        } else {
            XB_SPIN(xb_ld(&bar[XB_XGEN(b.x)]) == gen, bar);
            __builtin_amdgcn_fence(__ATOMIC_ACQUIRE, "agent");
            asm volatile("s_waitcnt vmcnt(0)" ::: "memory");
        }
    }
    __syncthreads();
}

constexpr int MP = 8192, MS = 128, MT = MP + MS, D = 2048, NIN = 6144, NUP = 11264, DFF = 5632, PLE = 256, SEQ = 2048, NH = 8;
constexpr float EPS = 1e-6f;
constexpr int NPHASE = 10;
constexpr size_t MiB = 1u << 20;
constexpr size_t WS_BAR = 0, BAR_BYTES = 16384;
constexpr size_t WS_SS1 = 64 * 1024, WS_SS2 = 128 * 1024, WS_SS3 = 192 * 1024, WS_STATS = 256 * 1024;
constexpr size_t WS_ROPE = 1 * MiB, WS_ROPES = 2 * MiB;
constexpr size_t WS_WIN = 4 * MiB, WS_WO = 28 * MiB, WS_WUP = 36 * MiB, WS_WDN = 80 * MiB, WS_WG = 102 * MiB, WS_WP = 110 * MiB;
constexpr size_t WS_AB = 112 * MiB, WS_PB = 145 * MiB, WS_MIX = 150 * MiB, WS_Z = 183 * MiB, WS_ACT = 183 * MiB, WS_KV = 281 * MiB, WS_PP = 281 * MiB;
constexpr size_t WS_RAW = 313 * MiB, WS_AS = 335 * MiB, WS_END = 346 * MiB;
static_assert(WS_AB + (size_t)MT * D * 2 <= WS_PB && WS_PB + (size_t)MT * PLE * 2 <= WS_MIX && WS_MIX + (size_t)MT * D * 2 <= WS_Z, "ws map 1");
static_assert(WS_Z + (size_t)MT * NIN * 2 <= WS_KV && WS_ACT + (size_t)MT * DFF * 2 <= WS_KV && WS_KV + (size_t)512 * 16384 * 4 <= WS_RAW, "ws map 2");
static_assert(WS_RAW + (size_t)128 * 4 * NUP * 4 <= WS_AS && WS_AS + (size_t)MS * NUP * 4 <= WS_END && WS_PP + (size_t)MT * D * 4 <= WS_END, "ws map 3");
constexpr size_t O_RETP = 17039360, O_CONVP = 17563648, O_RETS = 17653760, O_CONVS = 34430976, O_GMV = 37314560, O_END = 37445632;
constexpr int LDS_BYTES = 147456, MISC_OFF = LDS_BYTES - 256;
constexpr int LDP = 136;
constexpr int TILE_B = 128 * LDP * 2;

struct Params { const float* in[22]; float* out; unsigned char* ws; float log2g[8]; float invf[64]; int ph_lo, ph_hi, use_cg, pad; };

#define LDS_WAIT() asm volatile("s_waitcnt lgkmcnt(0)" ::: "memory")
__device__ __forceinline__ float lo16(unsigned u) { return __uint_as_float(u << 16); }
__device__ __forceinline__ float hi16(unsigned u) { return __uint_as_float(u & 0xffff0000u); }
__device__ __forceinline__ float bf2f(bf16 b) { return __uint_as_float((unsigned)b << 16); }
__device__ __forceinline__ unsigned pk2(float lo, float hi) { return pg8::cvt_pk_bf16(lo, hi); }
__device__ __forceinline__ bf16 f2bf(float f) { return (bf16)(pg8::cvt_pk_bf16(f, 0.f) & 0xffffu); }
__device__ __forceinline__ float sigmoid_(float x) { return __builtin_amdgcn_rcpf(1.0f + __builtin_amdgcn_exp2f(-1.44269504089f * x)); }
__device__ __forceinline__ float silu_(float x) { return x * sigmoid_(x); }
__device__ __forceinline__ float gelu_(float x) { return x * sigmoid_(1.5957691216f * (x + 0.044715f * x * x * x)); }
__device__ __forceinline__ float wave_sum(float v) {
#pragma unroll
    for (int o = 1; o < 64; o <<= 1) v += __shfl_xor(v, o);
    return v;
}
__device__ __forceinline__ void atomic_addf(float* p, float v) { (void)__hip_atomic_fetch_add(p, v, __ATOMIC_RELAXED, __HIP_MEMORY_SCOPE_AGENT); }
template <int CTRL> __device__ __forceinline__ float dppf(float x) { return __int_as_float(__builtin_amdgcn_mov_dpp(__float_as_int(x), CTRL, 0xf, 0xf, false)); }

using pg8::Unit;
struct EpiZ {
    static constexpr bool PERM = true, AFTER_DRAIN = false;
    bf16* Z;
    __device__ __forceinline__ void operator()(const f32x4 (&acc)[2][2][4][2], const Unit& u, int wr, int wc, int fr, int fq) const {
        const int row0 = u.pm * 256 + wr * 64 + fr, col0 = u.pn * 256 + wc * 32 + 8 * fq;
        const int mode = u.pn < 12 ? 0 : (u.pn < 16 ? 1 : 2);
#pragma unroll
        for (int ai = 0; ai < 2; ++ai)
#pragma unroll
            for (int m = 0; m < 4; ++m) { bf16* rowp = Z + (size_t)(row0 + ai * 128 + m * 16) * NIN + col0;
#pragma unroll
                for (int bj = 0; bj < 2; ++bj) { f32x4 v0 = acc[ai][bj][m][0], v1 = acc[ai][bj][m][1];
                    if (mode == 1) {
#pragma unroll
                        for (int j = 0; j < 4; ++j) { v0[j] = silu_(v0[j]); v1[j] = silu_(v1[j]); } }
                    else if (mode == 2) {
#pragma unroll
                        for (int j = 0; j < 4; ++j) { v0[j] = gelu_(v0[j]); v1[j] = gelu_(v1[j]); } }
                    v4u w; w.x = pk2(v0[0], v0[1]); w.y = pk2(v0[2], v0[3]); w.z = pk2(v1[0], v1[1]); w.w = pk2(v1[2], v1[3]);
                    *(v4u*)(rowp + bj * 128) = w; } }
    }
};
template <bool BASE_BF16> struct EpiRes {
    static constexpr bool PERM = true, AFTER_DRAIN = false;
    const float* base; bf16* hb; float* ss;
    __device__ __forceinline__ void operator()(const f32x4 (&acc)[2][2][4][2], const Unit& u, int wr, int wc, int fr, int fq) const {
        const int row0 = u.pm * 256 + wr * 64 + fr, col0 = u.pn * 256 + wc * 32 + 8 * fq;
        float sacc[2][4];
#pragma unroll
        for (int ai = 0; ai < 2; ++ai) {
            f32x4 bs[4][2][2];
#pragma unroll
            for (int m = 0; m < 4; ++m)
#pragma unroll
                for (int bj = 0; bj < 2; ++bj) { const size_t o_ = (size_t)(row0 + ai * 128 + m * 16) * D + col0 + bj * 128;
                    if (BASE_BF16) { const v4u w = *(const v4u*)(hb + o_); bs[m][bj][0] = (f32x4){lo16(w.x), hi16(w.x), lo16(w.y), hi16(w.y)}; bs[m][bj][1] = (f32x4){lo16(w.z), hi16(w.z), lo16(w.w), hi16(w.w)}; }
                    else { bs[m][bj][0] = *(const f32x4*)(base + o_); bs[m][bj][1] = *(const f32x4*)(base + o_ + 4); } }
#pragma unroll
            for (int m = 0; m < 4; ++m) { const size_t off = (size_t)(row0 + ai * 128 + m * 16) * D + col0; float s = 0.f;
#pragma unroll
                for (int bj = 0; bj < 2; ++bj) { const f32x4 o0 = bs[m][bj][0] + acc[ai][bj][m][0], o1 = bs[m][bj][1] + acc[ai][bj][m][1];
                    v4u w; w.x = pk2(o0[0], o0[1]); w.y = pk2(o0[2], o0[3]); w.z = pk2(o1[0], o1[1]); w.w = pk2(o1[2], o1[3]); *(v4u*)(hb + off + bj * 128) = w;
                    s += ((o0[0] * o0[0] + o0[1] * o0[1]) + (o0[2] * o0[2] + o0[3] * o0[3])) + ((o1[0] * o1[0] + o1[1] * o1[1]) + (o1[2] * o1[2] + o1[3] * o1[3])); }
                s += __shfl_xor(s, 16); s += __shfl_xor(s, 32); sacc[ai][m] = s; }
            asm volatile("" ::: "memory"); }
        if (fq == 0) {
#pragma unroll
            for (int ai = 0; ai < 2; ++ai)
#pragma unroll
                for (int m = 0; m < 4; ++m) atomic_addf(ss + row0 + ai * 128 + m * 16, sacc[ai][m]); }
    }
};
struct EpiPP {
    static constexpr bool PERM = true, AFTER_DRAIN = false;
    bf16* pp;
    __device__ __forceinline__ void operator()(const f32x4 (&acc)[2][2][4][2], const Unit& u, int wr, int wc, int fr, int fq) const {
        const int row0 = u.pm * 256 + wr * 64 + fr, col0 = u.pn * 256 + wc * 32 + 8 * fq;
#pragma unroll
        for (int ai = 0; ai < 2; ++ai)
#pragma unroll
            for (int m = 0; m < 4; ++m) { if (row0 + ai * 128 + m * 16 >= MT) continue; bf16* rowp = pp + (size_t)(row0 + ai * 128 + m * 16) * D + col0;
#pragma unroll
                for (int bj = 0; bj < 2; ++bj) { const f32x4 v0 = acc[ai][bj][m][0], v1 = acc[ai][bj][m][1]; v4u w; w.x = pk2(v0[0], v0[1]); w.y = pk2(v0[2], v0[3]); w.z = pk2(v1[0], v1[1]); w.w = pk2(v1[2], v1[3]); *(v4u*)(rowp + bj * 128) = w; } }
    }
};
struct EpiGate {
    static constexpr bool PERM = true, AFTER_DRAIN = false;
    const bf16* pp; const bf16* hb; float* h; const float* ss2; float* ss3;
    __device__ __forceinline__ void operator()(const f32x4 (&acc)[2][2][4][2], const Unit& u, int wr, int wc, int fr, int fq) const {
        const int row0 = u.pm * 256 + wr * 64 + fr, col0 = u.pn * 256 + wc * 32 + 8 * fq;
        float sacc[2][4];
#pragma unroll
        for (int ai = 0; ai < 2; ++ai) {
            v4u hw[4][2], pw[4][2]; float r2[4];
#pragma unroll
            for (int m = 0; m < 4; ++m) { const int row = row0 + ai * 128 + m * 16; r2[m] = ss2[row];
#pragma unroll
                for (int bj = 0; bj < 2; ++bj) { hw[m][bj] = *(const v4u*)(hb + (size_t)row * D + col0 + bj * 128); pw[m][bj] = *(const v4u*)(pp + (size_t)row * D + col0 + bj * 128); } }
#pragma unroll
            for (int m = 0; m < 4; ++m) { const size_t off = (size_t)(row0 + ai * 128 + m * 16) * D + col0; float s = 0.f;
                const float rr = __builtin_amdgcn_rsqf(r2[m] * (1.0f / D) + EPS);
#pragma unroll
                for (int bj = 0; bj < 2; ++bj) { const v4u h4 = hw[m][bj], p4 = pw[m][bj];
                    const f32x4 hv0 = {lo16(h4.x), hi16(h4.x), lo16(h4.y), hi16(h4.y)}, hv1 = {lo16(h4.z), hi16(h4.z), lo16(h4.w), hi16(h4.w)};
                    const f32x4 pv0 = {lo16(p4.x), hi16(p4.x), lo16(p4.y), hi16(p4.y)}, pv1 = {lo16(p4.z), hi16(p4.z), lo16(p4.w), hi16(p4.w)};
                    const f32x4 a0 = acc[ai][bj][m][0], a1 = acc[ai][bj][m][1]; f32x4 o0, o1;
#pragma unroll
                    for (int j = 0; j < 4; ++j) { o0[j] = hv0[j] + pv0[j] * sigmoid_(rr * a0[j]); o1[j] = hv1[j] + pv1[j] * sigmoid_(rr * a1[j]); }
                    *(f32x4*)(h + off + bj * 128) = o0; *(f32x4*)(h + off + bj * 128 + 4) = o1;
                    s += ((o0[0] * o0[0] + o0[1] * o0[1]) + (o0[2] * o0[2] + o0[3] * o0[3])) + ((o1[0] * o1[0] + o1[1] * o1[1]) + (o1[2] * o1[2] + o1[3] * o1[3])); }
                s += __shfl_xor(s, 16); s += __shfl_xor(s, 32); sacc[ai][m] = s; }
            asm volatile("" ::: "memory"); }
        if (fq == 0) {
#pragma unroll
            for (int ai = 0; ai < 2; ++ai)
#pragma unroll
                for (int m = 0; m < 4; ++m) atomic_addf(ss3 + row0 + ai * 128 + m * 16, sacc[ai][m]); }
    }
};
struct EpiUp {
    static constexpr bool PERM = false, AFTER_DRAIN = false;
    bf16* act; float* raw; const float* ss1; const float* cw; const float* cb; LAS float* wl;
    __device__ __forceinline__ void operator()(const f32x4 (&acc)[2][2][4][2], const Unit& u, int wr, int wc, int fr, int fq) const {
        const int row0 = u.pm * 256 + wr * 64 + fr;
        LAS float* wb = wl + (wr * 4 + wc) * 256;
        { const int l = fq * 16 + fr, v = l >> 3, c4 = l & 7;
          const float* src = ((v & 3) == 3 ? cb : cw + (v & 3) * NUP) + (v >> 2) * DFF + u.pn * 128 + wc * 32 + 4 * c4;
          *(LAS f32x4*)(wb + v * 32 + 4 * c4) = *(const f32x4*)src; }
        float rs[2][4];
#pragma unroll
        for (int ai = 0; ai < 2; ++ai)
#pragma unroll
            for (int m = 0; m < 4; ++m) rs[ai][m] = __builtin_amdgcn_rsqf(ss1[row0 + ai * 128 + m * 16] * (1.0f / D) + EPS);
#pragma unroll
        for (int n = 0; n < 2; ++n) {
            const int cg_ = u.pn * 128 + wc * 32 + 16 * n + 4 * fq;
            const volatile LAS f32x4* wv = (const volatile LAS f32x4*)(wb + 16 * n + 4 * fq);
#pragma unroll
            for (int ai = 0; ai < 2; ++ai) {
                f32x4 l1g = {0.f, 0.f, 0.f, 0.f}, l2g = l1g, l1u = l1g, l2u = l1g;
#pragma unroll
                for (int m = 0; m < 4; ++m) {
                    const int row = row0 + ai * 128 + m * 16;
                    f32x4 sg;
                    { const f32x4 g = acc[ai][0][m][n] * rs[ai][m];
                      if (m == 0 && fr < 2) *(f32x4*)(raw + ((size_t)(row >> 6) * 4 + 2 + fr) * NUP + cg_) = g;
                      if (m == 3 && fr >= 14) *(f32x4*)(raw + ((size_t)(row >> 6) * 4 + (fr - 14)) * NUP + cg_) = g;
                      f32x4 r1, r2, x1, x2;
#pragma unroll
                      for (int j = 0; j < 4; ++j) { r1[j] = dppf<0x121>(g[j]); r2[j] = dppf<0x122>(g[j]); }
#pragma unroll
                      for (int j = 0; j < 4; ++j) { x1[j] = fr == 0 ? l1g[j] : r1[j]; x2[j] = fr < 2 ? l2g[j] : r2[j]; }
                      l1g = r1; l2g = r2;
                      const f32x4 w0 = wv[0], w1 = wv[8], w2 = wv[16], bb = wv[24];
                      const f32x4 ag = w0 * x2 + w1 * x1 + w2 * g + bb;
#pragma unroll
                      for (int j = 0; j < 4; ++j) sg[j] = silu_(ag[j]);
                      asm volatile("" : "+v"(sg)); }
                    f32x4 o;
                    { const f32x4 up = acc[ai][1][m][n] * rs[ai][m];
                      if (m == 0 && fr < 2) *(f32x4*)(raw + ((size_t)(row >> 6) * 4 + 2 + fr) * NUP + DFF + cg_) = up;
                      if (m == 3 && fr >= 14) *(f32x4*)(raw + ((size_t)(row >> 6) * 4 + (fr - 14)) * NUP + DFF + cg_) = up;
                      f32x4 r1, r2, x1, x2;
#pragma unroll
                      for (int j = 0; j < 4; ++j) { r1[j] = dppf<0x121>(up[j]); r2[j] = dppf<0x122>(up[j]); }
#pragma unroll
                      for (int j = 0; j < 4; ++j) { x1[j] = fr == 0 ? l1u[j] : r1[j]; x2[j] = fr < 2 ? l2u[j] : r2[j]; }
                      l1u = r1; l2u = r2;
                      const f32x4 w0 = wv[32], w1 = wv[40], w2 = wv[48], bb = wv[56];
                      o = (w0 * x2 + w1 * x1 + w2 * up + bb) * sg; }
                    v2u w; w.x = pk2(o[0], o[1]); w.y = pk2(o[2], o[3]);
                    *(v2u*)(act + (size_t)row * DFF + cg_) = w; } } }
    }
};

struct EpiAS {
    static constexpr bool PERM = false, AFTER_DRAIN = false;
    float* as; const float* ss1;
    __device__ __forceinline__ void operator()(const f32x4 (&acc)[2][2][4][2], const Unit& u, int wr, int wc, int fr, int fq) const {
#pragma unroll
        for (int m = 0; m < 4; ++m) { const int s_ = wr * 64 + m * 16 + fr; const float r = __builtin_amdgcn_rsqf(ss1[MP + s_] * (1.0f / D) + EPS);
#pragma unroll
            for (int n = 0; n < 2; ++n) { const int cg_ = u.pn * 128 + wc * 32 + 16 * n + 4 * fq;
                *(f32x4*)(as + (size_t)s_ * NUP + cg_) = acc[0][0][m][n] * r; *(f32x4*)(as + (size_t)s_ * NUP + DFF + cg_) = acc[0][1][m][n] * r; } }
    }
};
struct SampleOrder {
    int idx;
    __device__ __forceinline__ bool next(int i, Unit& u) const { if (i != 0 || idx < 0) return false; u.pm = MP / 256; u.pn = idx; return true; }
    __device__ __forceinline__ void a_ready(const Unit&) const {}
    __device__ __forceinline__ void done(const Unit&) const {}
};

struct ProjOrder {
    int first, nw;
    __device__ __forceinline__ bool next(int i, Unit& u) const { if (first < 0) return false; const int j = first + i * nw; if (j >= (MP / 256 + 1) * (D / 256)) return false; u.pm = j >> 3; u.pn = j & 7; return true; }
    __device__ __forceinline__ void a_ready(const Unit&) const {}
    __device__ __forceinline__ void done(const Unit&) const {}
};
template <int RT, int NK>
__device__ __forceinline__ void skinny_batch(f32x4 (&acc)[RT][2], const bf16* ap, const bf16* bp, int K) {
    bf16x8 bq[NK][2], aq[NK][RT];
#pragma unroll
    for (int kk = 0; kk < NK; ++kk) { bq[kk][0] = *(const bf16x8*)(bp + 32 * kk); bq[kk][1] = *(const bf16x8*)(bp + (size_t)16 * K + 32 * kk);
#pragma unroll
        for (int rt = 0; rt < RT; ++rt) aq[kk][rt] = *(const bf16x8*)(ap + (size_t)rt * 16 * K + 32 * kk); }
#pragma unroll
    for (int kk = 0; kk < NK; ++kk)
#pragma unroll
        for (int rt = 0; rt < RT; ++rt) { acc[rt][0] = __builtin_amdgcn_mfma_f32_16x16x32_bf16(bq[kk][0], aq[kk][rt], acc[rt][0], 0, 0, 0); acc[rt][1] = __builtin_amdgcn_mfma_f32_16x16x32_bf16(bq[kk][1], aq[kk][rt], acc[rt][1], 0, 0, 0); }
}
template <int RT, class F>
__device__ __forceinline__ void skinny_gemm(LAS unsigned char* lds, const bf16* A, const bf16* Bt, int N, int K, int u0, int ustride, const F& f) {
    const int tid = threadIdx.x, lane = tid & 63, w = tid >> 6, fr = lane & 15, fq = lane >> 4;
    constexpr int nrb = 8 / RT, ROWS = 16 * RT;
    const int nunits = nrb * (N / 32), kw = K / 8;
    LAS float* red = (LAS float*)lds;
    for (int u = u0; u < nunits; u += ustride) {
        const int rb = u % nrb, cb = u / nrb, row0 = rb * ROWS, col0 = cb * 32;
        f32x4 acc[RT][2];
#pragma unroll
        for (int rt = 0; rt < RT; ++rt) { acc[rt][0] = (f32x4){0.f, 0.f, 0.f, 0.f}; acc[rt][1] = (f32x4){0.f, 0.f, 0.f, 0.f}; }
        const bf16* ap = A + (size_t)(row0 + fr) * K + w * kw + 8 * fq;
        const bf16* bp = Bt + (size_t)(col0 + fr) * K + w * kw + 8 * fq;
        if constexpr (RT <= 2) {
            int k = 0;
            if (kw == 704) { skinny_batch<RT, 11>(acc, ap, bp, K); skinny_batch<RT, 11>(acc, ap + 352, bp + 352, K); k = 704; }
            for (; k + 256 <= kw; k += 256) skinny_batch<RT, 8>(acc, ap + k, bp + k, K);
            for (; k < kw; k += 32) skinny_batch<RT, 1>(acc, ap + k, bp + k, K);
        } else {
#pragma unroll 2
        for (int k = 0; k < kw; k += 32) {
            const bf16x8 b0 = *(const bf16x8*)(bp + k), b1 = *(const bf16x8*)(bp + (size_t)16 * K + k);
#pragma unroll
            for (int rt = 0; rt < RT; ++rt) { const bf16x8 av = *(const bf16x8*)(ap + (size_t)rt * 16 * K + k);
                acc[rt][0] = __builtin_amdgcn_mfma_f32_16x16x32_bf16(b0, av, acc[rt][0], 0, 0, 0);
                acc[rt][1] = __builtin_amdgcn_mfma_f32_16x16x32_bf16(b1, av, acc[rt][1], 0, 0, 0); }
        }
        }
#pragma unroll
        for (int rt = 0; rt < RT; ++rt)
#pragma unroll
            for (int ct = 0; ct < 2; ++ct) *(LAS f32x4*)(red + (w * ROWS + 16 * rt + fr) * 32 + 16 * ct + 4 * fq) = acc[rt][ct];
        __syncthreads();
#pragma unroll
        for (int it = 0; it < RT; ++it) { const int e = tid + 512 * it, r = e >> 5, c = e & 31; float v = 0.f;
#pragma unroll
            for (int ww = 0; ww < 8; ++ww) v += red[(ww * ROWS + r) * 32 + c];
            f(row0 + r, col0 + c, v); }
        __syncthreads();
    }
}
__device__ __forceinline__ float half_wave_sum(float v) {
#pragma unroll
    for (int o = 1; o < 32; o <<= 1) v += __shfl_xor(v, o);
    return v;
}

__device__ __forceinline__ void transpose_item(const float* W, int K, int N, const float* g, bf16* WT, bool upmap, LAS float* scr, int item, int lane) {
    const int nblk = N / 64, kb = item / nblk, nb = item % nblk, k0 = 64 * kb, n0 = 64 * nb;
    const float* src = W + (size_t)k0 * N + n0 + lane;
#pragma unroll
    for (int h = 0; h < 2; ++h) {
        float v[32];
#pragma unroll
        for (int i = 0; i < 32; ++i) v[i] = __builtin_nontemporal_load(src + (size_t)(32 * h + i) * N);
#pragma unroll
        for (int i = 0; i < 32; ++i) { float x = v[i]; if (g) x *= g[k0 + 32 * h + i]; scr[(32 * h + i) * 65 + lane] = x; }
    }
    LDS_WAIT(); asm volatile("" ::: "memory");
    const int c = lane & 7;
#pragma unroll
    for (int j = 0; j < 8; ++j) { const int n = (lane >> 3) + 8 * j; const LAS float* s = scr + (8 * c) * 65 + n;
        v4u o; o.x = pk2(s[0 * 65], s[1 * 65]); o.y = pk2(s[2 * 65], s[3 * 65]); o.z = pk2(s[4 * 65], s[5 * 65]); o.w = pk2(s[6 * 65], s[7 * 65]);
        int R = n0 + n; if (upmap) { const int half = R >= DFF ? 1 : 0, jj = R - half * DFF; R = 256 * (jj >> 7) + 128 * half + (jj & 127); }
        *(v4u*)(WT + (size_t)R * K + k0 + 8 * c) = o; }
    LDS_WAIT(); asm volatile("" ::: "memory");
}
__device__ __forceinline__ void rms_row_to_bf16(const float* xrow, bf16* orow, int lane) {
    const f32x4* xr = (const f32x4*)xrow + lane;
    f32x4 v[8]; float s = 0.f;
#pragma unroll
    for (int j = 0; j < 8; ++j) { v[j] = xr[64 * j]; s += (v[j][0] * v[j][0] + v[j][1] * v[j][1]) + (v[j][2] * v[j][2] + v[j][3] * v[j][3]); }
    const float r = __builtin_amdgcn_rsqf(wave_sum(s) * (1.0f / D) + EPS);
    v2u* o8 = (v2u*)orow + lane;
#pragma unroll
    for (int j = 0; j < 8; ++j) { v2u w; w.x = pk2(v[j][0] * r, v[j][1] * r); w.y = pk2(v[j][2] * r, v[j][3] * r); o8[64 * j] = w; }
}

__device__ __forceinline__ void mm128(f32x4 (&acc)[8], const LAS bf16* A, const LAS bf16* B, int wave, int fr, int fq) {
#pragma unroll
    for (int ks = 0; ks < 4; ++ks) {
        const bf16x8 a = *(const LAS bf16x8*)(A + (16 * wave + fr) * LDP + 32 * ks + 8 * fq);
#pragma unroll
        for (int ct = 0; ct < 8; ++ct) { const bf16x8 b = *(const LAS bf16x8*)(B + (16 * ct + fr) * LDP + 32 * ks + 8 * fq);
            acc[ct] = __builtin_amdgcn_mfma_f32_16x16x32_bf16(b, a, acc[ct], 0, 0, 0); }
    }
}
template <bool TRANS, bool DEC>
__device__ __forceinline__ void stage_rope(LAS bf16* dst, const bf16* zb, const float* rope, float scale, float l2g, int tid) {
#pragma unroll
    for (int it = 0; it < 2; ++it) { const int idx = tid + 512 * it, j = idx >> 3, d8 = idx & 7;
        const v4u x1 = *(const v4u*)(zb + (size_t)j * NIN + 8 * d8), x2 = *(const v4u*)(zb + (size_t)j * NIN + 64 + 8 * d8);
        const f32x4* rp = (const f32x4*)(rope + (size_t)(j * 64 + 8 * d8) * 2);
        float sc = scale; if (DEC) sc *= __builtin_amdgcn_exp2f(l2g * (float)(127 - j));
        float o1[8], o2[8];
#pragma unroll
        for (int p = 0; p < 4; ++p) { const f32x4 cs = rp[p]; const float a0 = lo16(x1[p]), a1 = hi16(x1[p]), b0 = lo16(x2[p]), b1 = hi16(x2[p]);
            o1[2 * p] = (a0 * cs[0] - b0 * cs[1]) * sc; o2[2 * p] = (b0 * cs[0] + a0 * cs[1]) * sc;
            o1[2 * p + 1] = (a1 * cs[2] - b1 * cs[3]) * sc; o2[2 * p + 1] = (b1 * cs[2] + a1 * cs[3]) * sc; }
        if (!TRANS) { v4u w1, w2;
#pragma unroll
            for (int p = 0; p < 4; ++p) { w1[p] = pk2(o1[2 * p], o1[2 * p + 1]); w2[p] = pk2(o2[2 * p], o2[2 * p + 1]); }
            *(LAS v4u*)(dst + j * LDP + 8 * d8) = w1; *(LAS v4u*)(dst + j * LDP + 64 + 8 * d8) = w2; }
        else {
#pragma unroll
            for (int i = 0; i < 8; ++i) { dst[(8 * d8 + i) * LDP + j] = f2bf(o1[i]); dst[(64 + 8 * d8 + i) * LDP + j] = f2bf(o2[i]); } }
    }
}
__device__ __forceinline__ void stage_T(LAS bf16* dst, const bf16* zb, int tid) {
#pragma unroll
    for (int it = 0; it < 4; ++it) { const int idx = tid + 512 * it, j = idx >> 4, c8 = idx & 15;
        const v4u x = *(const v4u*)(zb + (size_t)j * NIN + 8 * c8);
#pragma unroll
        for (int p = 0; p < 4; ++p) { dst[(8 * c8 + 2 * p) * LDP + j] = (bf16)(x[p] & 0xffffu); dst[(8 * c8 + 2 * p + 1) * LDP + j] = (bf16)(x[p] >> 16); } }
}


struct RopeX { v4u x1[2], x2[2]; };
struct RopeCS { f32x4 cs[2][4]; };
struct TileX { v4u x[4]; };
__device__ __forceinline__ void rope_load(RopeX& r, const bf16* zb, int tid) {
#pragma unroll
    for (int it = 0; it < 2; ++it) { const int idx = tid + 512 * it, j = idx >> 3, d8 = idx & 7; r.x1[it] = *(const v4u*)(zb + (size_t)j * NIN + 8 * d8); r.x2[it] = *(const v4u*)(zb + (size_t)j * NIN + 64 + 8 * d8); }
}
__device__ __forceinline__ void rope_cs_load(RopeCS& c, const float* rope, int tid) {
#pragma unroll
    for (int it = 0; it < 2; ++it) { const int idx = tid + 512 * it, j = idx >> 3, d8 = idx & 7; const f32x4* rp = (const f32x4*)(rope + (size_t)(j * 64 + 8 * d8) * 2);
#pragma unroll
        for (int p = 0; p < 4; ++p) c.cs[it][p] = rp[p]; }
}
template <bool TRANS, bool DEC>
__device__ __forceinline__ void rope_commit(LAS bf16* dst, const RopeX& r, const RopeCS& c, float scale, float l2g, int tid) {
#pragma unroll
    for (int it = 0; it < 2; ++it) { const int idx = tid + 512 * it, j = idx >> 3, d8 = idx & 7;
        float sc = scale; if (DEC) sc *= __builtin_amdgcn_exp2f(l2g * (float)(127 - j));
        float o1[8], o2[8];
#pragma unroll
        for (int p = 0; p < 4; ++p) { const f32x4 cs = c.cs[it][p]; const float a0 = lo16(r.x1[it][p]), a1 = hi16(r.x1[it][p]), b0 = lo16(r.x2[it][p]), b1 = hi16(r.x2[it][p]);
            o1[2 * p] = (a0 * cs[0] - b0 * cs[1]) * sc; o2[2 * p] = (b0 * cs[0] + a0 * cs[1]) * sc;
            o1[2 * p + 1] = (a1 * cs[2] - b1 * cs[3]) * sc; o2[2 * p + 1] = (b1 * cs[2] + a1 * cs[3]) * sc; }
        if (!TRANS) { v4u w1, w2;
#pragma unroll
            for (int p = 0; p < 4; ++p) { w1[p] = pk2(o1[2 * p], o1[2 * p + 1]); w2[p] = pk2(o2[2 * p], o2[2 * p + 1]); }
            *(LAS v4u*)(dst + j * LDP + 8 * d8) = w1; *(LAS v4u*)(dst + j * LDP + 64 + 8 * d8) = w2; }
        else {
#pragma unroll
            for (int i = 0; i < 8; ++i) { dst[(8 * d8 + i) * LDP + j] = f2bf(o1[i]); dst[(64 + 8 * d8 + i) * LDP + j] = f2bf(o2[i]); } }
    }
}
__device__ __forceinline__ void tile_load(TileX& t, const bf16* zb, int tid) {
#pragma unroll
    for (int it = 0; it < 4; ++it) { const int idx = tid + 512 * it, j = idx >> 4, c8 = idx & 15; t.x[it] = *(const v4u*)(zb + (size_t)j * NIN + 8 * c8); }
}
__device__ __forceinline__ void tile_commit_T(LAS bf16* dst, const TileX& t, int tid) {
#pragma unroll
    for (int it = 0; it < 4; ++it) { const int idx = tid + 512 * it, j = idx >> 4, c8 = idx & 15;
#pragma unroll
        for (int p = 0; p < 4; ++p) { dst[(8 * c8 + 2 * p) * LDP + j] = (bf16)(t.x[it][p] & 0xffffu); dst[(8 * c8 + 2 * p + 1) * LDP + j] = (bf16)(t.x[it][p] >> 16); } }
}

__global__ void __launch_bounds__(512, 2) mk_fwd(Params a) {
    extern __shared__ __attribute__((aligned(16))) unsigned char lds_raw[];
    LAS unsigned char* lds = (LAS unsigned char*)lds_raw;
    const int tid = threadIdx.x, lane = tid & 63, wave = __builtin_amdgcn_readfirstlane(tid >> 6), fr = lane & 15, fq = lane >> 4;
    const int G = gridDim.x, blk = blockIdx.x;
    const int gw = blk * 8 + wave, NGW = G * 8;
    const int gt = blk * 512 + tid, NGT = G * 512;
    unsigned char* ws = a.ws;
#define x_p (a.in[0])
#define x_s (a.in[1])
#define p_p (a.in[2])
#define p_s (a.in[3])
#define state_ret (a.in[4])
#define state_conv (a.in[5])
#define gm_ln_g (a.in[8])
#define gm_ln_b (a.in[9])
#define gm_ws (a.in[10])
#define gm_bs (a.in[11])
#define conv_w (a.in[15])
#define conv_b (a.in[16])
#define g_final (a.in[21])
#define out (a.out)
#define SS1 ((float*)(ws + WS_SS1))
#define SS2 ((float*)(ws + WS_SS2))
#define SS3 ((float*)(ws + WS_SS3))
#define STATS ((float*)(ws + WS_STATS))
#define ROPE ((float*)(ws + WS_ROPE))
#define ROPES ((float*)(ws + WS_ROPES))
#define Win_t ((bf16*)(ws + WS_WIN))
#define Wo_t ((bf16*)(ws + WS_WO))
#define Wup_t ((bf16*)(ws + WS_WUP))
#define Wdn_t ((bf16*)(ws + WS_WDN))
#define Wg_t ((bf16*)(ws + WS_WG))
#define Wp_t ((bf16*)(ws + WS_WP))
#define AB ((bf16*)(ws + WS_AB))
#define PB ((bf16*)(ws + WS_PB))
#define MIX ((bf16*)(ws + WS_MIX))
#define Z ((bf16*)(ws + WS_Z))
#define ACT ((bf16*)(ws + WS_ACT))
#define KV ((float*)(ws + WS_KV))
#define PP ((bf16*)(ws + WS_MIX))
#define RAW ((float*)(ws + WS_RAW))
#define AS ((float*)(ws + WS_AS))

    volatile LAS unsigned* MISC = (volatile LAS unsigned*)(lds + MISC_OFF);
    if (tid < 64) MISC[tid] = 0u;
    __syncthreads();
    XcdBarrier bar; bar.bar = (unsigned*)(ws + WS_BAR); bar.x = 0; bar.st = nullptr;
    if (MK_N_LAUNCHES == 1) bar = xcd_barrier_post((unsigned*)(ws + WS_BAR), MISC + 8);
    const int lo = a.ph_lo, hi = a.ph_hi;
#ifndef PHMASK
#define PHMASK 0xffff
#endif
#define IN(k) (((PHMASK >> (k)) & 1) && lo <= (k) && (k) < hi)
#define SEAM(k) do { if (IN(k) && IN((k) + 1)) { if (a.use_cg) cg::this_grid().sync(); else xcd_barrier(bar); } } while (0)

    if (IN(0)) {
        LAS float* scr = (LAS float*)(lds + wave * 16640);
        constexpr int I_IN = (D / 64) * (NIN / 64);
        for (int it = gw; it < I_IN; it += NGW) transpose_item(a.in[7], D, NIN, a.in[6], Win_t, false, scr, it, lane);
        for (int m = gw; m < MT; m += NGW) rms_row_to_bf16(m < MP ? x_p + (size_t)m * D : x_s + (size_t)(m - MP) * D, AB + (size_t)m * D, lane);
        for (int i = gt; i < MT * PLE / 4; i += NGT) { const f32x4 v = i < MP * PLE / 4 ? ((const f32x4*)p_p)[i] : ((const f32x4*)p_s)[i - MP * PLE / 4]; v2u w; w.x = pk2(v[0], v[1]); w.y = pk2(v[2], v[3]); ((v2u*)PB)[i] = w; }
        for (int i = gt; i < SEQ * 64 + 64; i += NGT) { const int pos = i < SEQ * 64 ? (i >> 6) : 16384, fi = i & 63;
            const float ang = (float)pos * a.invf[fi]; double t = (double)ang * 0.15915494309189535; t -= __builtin_rint(t); const float rev = (float)t;
            float* dst = i < SEQ * 64 ? ROPE + 2 * (size_t)i : ROPES + 2 * fi; dst[0] = __builtin_amdgcn_cosf(rev); dst[1] = __builtin_amdgcn_sinf(rev); }
        for (int i = gt; i < MT; i += NGT) { SS1[i] = 0.f; SS2[i] = 0.f; SS3[i] = 0.f; }
    }
    SEAM(0);

    if (IN(1)) {
        { pg8::Gemm g{AB, Win_t, MP, NIN, D}; pg8::StaticOrder S; S.init(MP, NIN, G, blk); EpiZ E{Z};
          pg8::gemm_phase<EpiZ, pg8::StaticOrder, true, true>(lds, g, S, E); }
        auto f = [&](int s, int n, float v) { const float o = n < 3072 ? v : (n < 4096 ? silu_(v) : gelu_(v)); Z[(size_t)(MP + s) * NIN + n] = f2bf(o); };
        skinny_gemm<8>(lds, AB + (size_t)MP * D, Win_t, NIN, D, blk, G, f);
    }
    SEAM(1);

    if (IN(2)) {
        for (int pass = 0; pass < 2; ++pass) {
        if ((pass ^ (blk & 1)) == 0) {
        { LAS float* qs = (LAS float*)lds; LAS float* ks = qs + 128; LAS float* vs = ks + 128; LAS float* red = vs + 128;
          const int e4 = tid & 31, dg = tid >> 5;
          for (int u = blk; u < MS * NH; u += G) { const int s = u >> 3, h = u & 7; const bf16* zr = Z + (size_t)(MP + s) * NIN;
            const float* S0 = state_ret + (size_t)u * 16384 + 4 * e4; float* S1 = out + O_RETS + (size_t)u * 16384 + 4 * e4;
            f32x4 s0[8];
#pragma unroll
            for (int i = 0; i < 8; ++i) s0[i] = __builtin_nontemporal_load((const f32x4*)(S0 + (dg + 16 * i) * 128));
            if (tid < 64) { const float c = ROPES[2 * tid], sn = ROPES[2 * tid + 1];
                const float q1 = bf2f(zr[128 * h + tid]), q2 = bf2f(zr[128 * h + 64 + tid]), k1 = bf2f(zr[1024 + 128 * h + tid]), k2 = bf2f(zr[1024 + 128 * h + 64 + tid]);
                qs[tid] = q1 * c - q2 * sn; qs[tid + 64] = q2 * c + q1 * sn; ks[tid] = (k1 * c - k2 * sn) * 0.08838834764831845f; ks[tid + 64] = (k2 * c + k1 * sn) * 0.08838834764831845f; }
            else if (tid < 192) vs[tid - 64] = bf2f(zr[2048 + 128 * h + tid - 64]);
            unsigned gg = 0u; if (tid < 64) gg = *(const unsigned*)(zr + 3072 + 128 * h + 2 * tid);
            __syncthreads();
            const float gamma = 1.0f - __builtin_amdgcn_exp2f((float)(-5 - h));
            const f32x4 vv = *(const LAS f32x4*)(vs + 4 * e4); f32x4 o = {0.f, 0.f, 0.f, 0.f};
#pragma unroll
            for (int i = 0; i < 8; ++i) { const int d = dg + 16 * i; const f32x4 sn = s0[i] * gamma + vv * ks[d]; __builtin_nontemporal_store(sn, (f32x4*)(S1 + d * 128)); o += sn * qs[d]; }
            *(LAS f32x4*)(red + dg * 128 + 4 * e4) = o;
            __syncthreads();
            if (tid < 64) { float o0 = 0.f, o1 = 0.f;
#pragma unroll
                for (int i = 0; i < 16; ++i) { o0 += red[i * 128 + 2 * tid]; o1 += red[i * 128 + 2 * tid + 1]; }
                const float r = __builtin_amdgcn_rsqf(wave_sum(o0 * o0 + o1 * o1) * (1.0f / 128.0f) + EPS);
                *(unsigned*)(MIX + (size_t)(MP + s) * D + 128 * h + 2 * tid) = pk2(o0 * r * lo16(gg), o1 * r * hi16(gg)); }
            __syncthreads(); } }
        } else {
        { LAS bf16* Kt = (LAS bf16*)lds; LAS bf16* Vt = (LAS bf16*)(lds + TILE_B);
          for (int u = blk; u < 512; u += G) { const int b = u >> 7, h = (u >> 4) & 7, c = u & 15; const size_t R0 = (size_t)b * SEQ + 128 * c;
            RopeX kx; RopeCS cs; TileX vx;
            rope_load(kx, Z + R0 * NIN + 1024 + 128 * h, tid); rope_cs_load(cs, ROPE + (size_t)(128 * c) * 128, tid); tile_load(vx, Z + R0 * NIN + 2048 + 128 * h, tid);
            rope_commit<true, true>(Kt, kx, cs, 0.08838834764831845f, a.log2g[h], tid);
            tile_commit_T(Vt, vx, tid);
            __syncthreads();
            f32x4 acc[8];
#pragma unroll
            for (int ct = 0; ct < 8; ++ct) acc[ct] = (f32x4){0.f, 0.f, 0.f, 0.f};
            mm128(acc, Kt, Vt, wave, fr, fq);
            float* kv = KV + (size_t)u * 16384 + (16 * wave + fr) * 128 + 4 * fq;
#pragma unroll
            for (int ct = 0; ct < 8; ++ct) *(f32x4*)(kv + 16 * ct) = acc[ct];
            __syncthreads(); } }
        for (int r0 = gw; r0 < MP; r0 += 2 * NGW) { const int r1 = r0 + NGW;
            const bf16* p0 = Z + (size_t)r0 * NIN + 5120 + 16 * lane; const bf16* p1 = Z + (size_t)(r1 < MP ? r1 : r0) * NIN + 5120 + 16 * lane;
            const v4u xa0 = *(const v4u*)p0, xa1 = *(const v4u*)(p0 + 8), xb0 = *(const v4u*)p1, xb1 = *(const v4u*)(p1 + 8);
            float va[16], vb[16];
#pragma unroll
            for (int j = 0; j < 4; ++j) { va[2 * j] = lo16(xa0[j]); va[2 * j + 1] = hi16(xa0[j]); va[8 + 2 * j] = lo16(xa1[j]); va[8 + 2 * j + 1] = hi16(xa1[j]);
                                          vb[2 * j] = lo16(xb0[j]); vb[2 * j + 1] = hi16(xb0[j]); vb[8 + 2 * j] = lo16(xb1[j]); vb[8 + 2 * j + 1] = hi16(xb1[j]); }
            float sa = 0.f, sb = 0.f;
#pragma unroll
            for (int j = 0; j < 16; ++j) { sa += va[j]; sb += vb[j]; }
            const float ma = wave_sum(sa) * (1.0f / 1024.0f), mb = wave_sum(sb) * (1.0f / 1024.0f); float qa = 0.f, qb = 0.f;
#pragma unroll
            for (int j = 0; j < 16; ++j) { const float da = va[j] - ma, db = vb[j] - mb; qa += da * da; qb += db * db; }
            const float ra = __builtin_amdgcn_rsqf(wave_sum(qa) * (1.0f / 1024.0f) + EPS), rb = __builtin_amdgcn_rsqf(wave_sum(qb) * (1.0f / 1024.0f) + EPS);
            if (lane == 0) { STATS[2 * r0] = ma; STATS[2 * r0 + 1] = ra; if (r1 < MP) { STATS[2 * r1] = mb; STATS[2 * r1 + 1] = rb; } } }
        for (int row = MP + gw; row < MT; row += NGW) { const bf16* p = Z + (size_t)row * NIN + 5120 + 16 * lane; const v4u x0 = *(const v4u*)p, x1 = *(const v4u*)(p + 8);
            const int s_ = row - MP, c0 = 16 * lane, grp = lane >> 3; const float w00 = gm_ws[grp * 16384], b0 = gm_bs[grp * 128];
            const bf16* up = Z + (size_t)row * NIN + 4096 + c0; const v4u u0 = *(const v4u*)up, u1 = *(const v4u*)(up + 8);
            float v[16];
#pragma unroll
            for (int j = 0; j < 4; ++j) { v[2 * j] = lo16(x0[j]); v[2 * j + 1] = hi16(x0[j]); v[8 + 2 * j] = lo16(x1[j]); v[8 + 2 * j + 1] = hi16(x1[j]); }
            float s = 0.f;
#pragma unroll
            for (int j = 0; j < 16; ++j) s += v[j];
            const float mean = wave_sum(s) * (1.0f / 1024.0f); float q = 0.f;
#pragma unroll
            for (int j = 0; j < 16; ++j) { v[j] -= mean; q += v[j] * v[j]; }
            const float rstd = __builtin_amdgcn_rsqf(wave_sum(q) * (1.0f / 1024.0f) + EPS);
            float uu[16];
#pragma unroll
            for (int j = 0; j < 4; ++j) { uu[2 * j] = lo16(u0[j]); uu[2 * j + 1] = hi16(u0[j]); uu[8 + 2 * j] = lo16(u1[j]); uu[8 + 2 * j + 1] = hi16(u1[j]); }
            float vn[16], mo[16];
#pragma unroll
            for (int j = 0; j < 16; ++j) { vn[j] = v[j] * rstd * gm_ln_g[c0 + j] + gm_ln_b[c0 + j]; mo[j] = uu[j] * (w00 * vn[j] + b0); }
            float* gv = out + O_GMV + (size_t)s_ * 1024 + c0;
#pragma unroll
            for (int j = 0; j < 4; ++j) *(f32x4*)(gv + 4 * j) = (f32x4){vn[4 * j], vn[4 * j + 1], vn[4 * j + 2], vn[4 * j + 3]};
            v4u w0, w1;
#pragma unroll
            for (int j = 0; j < 4; ++j) { w0[j] = pk2(mo[2 * j], mo[2 * j + 1]); w1[j] = pk2(mo[8 + 2 * j], mo[8 + 2 * j + 1]); }
            bf16* mp = MIX + (size_t)row * D + 1024 + c0; *(v4u*)mp = w0; *(v4u*)(mp + 8) = w1; }
        } }
    }
    SEAM(2);

    if (IN(3)) {
        auto convert_rest = [&]() {
            LAS float* scr = (LAS float*)(lds + wave * 16640);
            constexpr int I_O = (D / 64) * (D / 64), I_UP = (D / 64) * (NUP / 64), I_DN = (DFF / 64) * (D / 64), I_G = I_O, I_P = (PLE / 64) * (D / 64);
            constexpr int NITEMS = I_O + I_UP + I_DN + I_G + I_P;
            for (int it = gw; it < NITEMS; it += NGW) {
                int r = it;
                if (r < I_UP) { transpose_item(a.in[14], D, NUP, a.in[13], Wup_t, true, scr, r, lane); continue; } r -= I_UP;
                if (r < I_O) { transpose_item(a.in[12], D, D, nullptr, Wo_t, false, scr, r, lane); continue; } r -= I_O;
                if (r < I_DN) { transpose_item(a.in[17], DFF, D, nullptr, Wdn_t, false, scr, r, lane); continue; } r -= I_DN;
                if (r < I_G) { transpose_item(a.in[19], D, D, a.in[18], Wg_t, false, scr, r, lane); continue; } r -= I_G;
                transpose_item(a.in[20], PLE, D, nullptr, Wp_t, false, scr, r, lane);
            }
            __syncthreads(); };
        if (!(blk & 1)) convert_rest();
        {
        LAS bf16* T0 = (LAS bf16*)lds; LAS bf16* T1 = (LAS bf16*)(lds + TILE_B); LAS bf16* T2 = (LAS bf16*)(lds + 2 * TILE_B); LAS bf16* T3 = (LAS bf16*)(lds + 3 * TILE_B);
        for (int u = blk; u < 512; u += G) { const int bh = u >> 4, b = bh >> 3, h = bh & 7, c = u < 256 ? (u & 15) : 15 - (u & 15); const size_t R0 = (size_t)b * SEQ + 128 * c; const float l2g = a.log2g[h];
            const int i_ = 16 * wave + fr;
            RopeX qx, kx; RopeCS cs; TileX vx; v2u gg[8];
            const float* kvb = KV + (size_t)bh * 16 * 16384;
            f32x4 tc[8];
#pragma unroll
            for (int i = 0; i < 8; ++i) tc[i] = *(const f32x4*)(kvb + 4 * (tid + 512 * i));
            rope_load(qx, Z + R0 * NIN + 128 * h, tid); rope_load(kx, Z + R0 * NIN + 1024 + 128 * h, tid); rope_cs_load(cs, ROPE + (size_t)(128 * c) * 128, tid); tile_load(vx, Z + R0 * NIN + 2048 + 128 * h, tid);
            rope_commit<false, false>(T0, qx, cs, 1.0f, 0.f, tid);
            rope_commit<false, false>(T1, kx, cs, 0.08838834764831845f, 0.f, tid);
            asm volatile("" ::: "memory");
            { const float Gc = __builtin_amdgcn_exp2f(l2g * 128.0f);
              f32x4 sp[8];
#pragma unroll
              for (int i = 0; i < 8; ++i) sp[i] = (f32x4){0.f, 0.f, 0.f, 0.f};
              for (int j = 0; j < c; ++j) { f32x4 tn[8];
#pragma unroll
                  for (int i = 0; i < 8; ++i) tn[i] = *(const f32x4*)(kvb + (size_t)(j + 1) * 16384 + 4 * (tid + 512 * i));
#pragma unroll
                  for (int i = 0; i < 8; ++i) { sp[i] = sp[i] * Gc + tc[i]; tc[i] = tn[i]; } }
              if (c == 15) {
#pragma unroll
                  for (int i = 0; i < 8; ++i) *(f32x4*)(out + O_RETP + (size_t)bh * 16384 + 4 * (tid + 512 * i)) = sp[i] * Gc + tc[i]; }
#pragma unroll
              for (int i = 0; i < 8; ++i) { const int ch = tid + 512 * i, d = ch >> 5, e4 = ch & 31;
#pragma unroll
                  for (int t = 0; t < 4; ++t) T3[(4 * e4 + t) * LDP + d] = f2bf(sp[i][t]); } }
            tile_commit_T(T2, vx, tid);
            __syncthreads();
            { const bf16* gp = Z + (R0 + i_) * NIN + 3072 + 128 * h + 4 * fq;
#pragma unroll
              for (int ct = 0; ct < 8; ++ct) gg[ct] = *(const v2u*)(gp + 16 * ct); }
            f32x4 acc2[8], acc1[8];
#pragma unroll
            for (int ct = 0; ct < 8; ++ct) { acc2[ct] = (f32x4){0.f, 0.f, 0.f, 0.f}; acc1[ct] = (f32x4){0.f, 0.f, 0.f, 0.f}; }
            mm128(acc2, T0, T3, wave, fr, fq);
            mm128(acc1, T0, T1, wave, fr, fq);
            __syncthreads();
#pragma unroll
            for (int ct = 0; ct < 8; ++ct) { float sv[4];
#pragma unroll
                for (int t = 0; t < 4; ++t) { const int j = 16 * ct + 4 * fq + t; sv[t] = i_ >= j ? acc1[ct][t] * __builtin_amdgcn_exp2f(l2g * (float)(i_ - j)) : 0.f; }
                v2u w; w.x = pk2(sv[0], sv[1]); w.y = pk2(sv[2], sv[3]); *(LAS v2u*)(T1 + i_ * LDP + 16 * ct + 4 * fq) = w; }
            __syncthreads();
#pragma unroll
            for (int ct = 0; ct < 8; ++ct) acc1[ct] = (f32x4){0.f, 0.f, 0.f, 0.f};
            mm128(acc1, T1, T2, wave, fr, fq);
            const float qd = __builtin_amdgcn_exp2f(l2g * (float)(i_ + 1)); float ssq = 0.f;
#pragma unroll
            for (int ct = 0; ct < 8; ++ct) { acc1[ct] = acc1[ct] + acc2[ct] * qd; ssq += (acc1[ct][0] * acc1[ct][0] + acc1[ct][1] * acc1[ct][1]) + (acc1[ct][2] * acc1[ct][2] + acc1[ct][3] * acc1[ct][3]); }
            ssq += __shfl_xor(ssq, 16); ssq += __shfl_xor(ssq, 32);
            const float rn = __builtin_amdgcn_rsqf(ssq * (1.0f / 128.0f) + EPS);
            bf16* mp = MIX + (R0 + i_) * D + 128 * h + 4 * fq;
#pragma unroll
            for (int ct = 0; ct < 8; ++ct) { v2u w;
                w.x = pk2(acc1[ct][0] * rn * lo16(gg[ct].x), acc1[ct][1] * rn * hi16(gg[ct].x)); w.y = pk2(acc1[ct][2] * rn * lo16(gg[ct].y), acc1[ct][3] * rn * hi16(gg[ct].y)); *(v2u*)(mp + 16 * ct) = w; }
            __syncthreads(); }
        for (int u = blk; u < 512; u += G) { const int b = u >> 7, c = (u >> 3) & 15, grp = u & 7; const size_t R0 = (size_t)b * SEQ + 128 * c;
            const int t_ = 16 * wave + fr, d8 = tid & 15;
            f32x4 wl[4][2]; v4u xv[4]; float st[4][2]; v2u uu[8]; float lg[8], lb[8];
#pragma unroll
            for (int it = 0; it < 4; ++it) { const int idx = tid + 512 * it, t = idx >> 4; const float* wp = gm_ws + (size_t)grp * 16384 + t * 128 + 8 * d8;
                wl[it][0] = *(const f32x4*)wp; wl[it][1] = *(const f32x4*)(wp + 4);
                xv[it] = *(const v4u*)(Z + (R0 + t) * NIN + 5120 + 128 * grp + 8 * d8); st[it][0] = STATS[2 * (R0 + t)]; st[it][1] = STATS[2 * (R0 + t) + 1]; }
#pragma unroll
            for (int j = 0; j < 8; ++j) { lg[j] = gm_ln_g[128 * grp + 8 * d8 + j]; lb[j] = gm_ln_b[128 * grp + 8 * d8 + j]; }
            const float bsv = gm_bs[grp * 128 + t_];
#pragma unroll
            for (int it = 0; it < 4; ++it) { const int idx = tid + 512 * it, t = idx >> 4;
                float wv[8] = {wl[it][0][0], wl[it][0][1], wl[it][0][2], wl[it][0][3], wl[it][1][0], wl[it][1][1], wl[it][1][2], wl[it][1][3]};
#pragma unroll
                for (int j = 0; j < 8; ++j) if (8 * d8 + j > t) wv[j] = 0.f;
                v4u w; w.x = pk2(wv[0], wv[1]); w.y = pk2(wv[2], wv[3]); w.z = pk2(wv[4], wv[5]); w.w = pk2(wv[6], wv[7]); *(LAS v4u*)(T0 + t * LDP + 8 * d8) = w;
                const float mean = st[it][0], rstd = st[it][1];
#pragma unroll
                for (int p = 0; p < 4; ++p) { T1[(8 * d8 + 2 * p) * LDP + t] = f2bf((lo16(xv[it][p]) - mean) * rstd * lg[2 * p] + lb[2 * p]); T1[(8 * d8 + 2 * p + 1) * LDP + t] = f2bf((hi16(xv[it][p]) - mean) * rstd * lg[2 * p + 1] + lb[2 * p + 1]); } }
            __syncthreads();
            { const bf16* up = Z + (R0 + t_) * NIN + 4096 + 128 * grp + 4 * fq;
#pragma unroll
              for (int ct = 0; ct < 8; ++ct) uu[ct] = *(const v2u*)(up + 16 * ct); }
            f32x4 acc[8];
#pragma unroll
            for (int ct = 0; ct < 8; ++ct) acc[ct] = (f32x4){0.f, 0.f, 0.f, 0.f};
            mm128(acc, T0, T1, wave, fr, fq);
            bf16* mp = MIX + (R0 + t_) * D + 1024 + 128 * grp + 4 * fq;
#pragma unroll
            for (int ct = 0; ct < 8; ++ct) { v2u w;
                w.x = pk2((acc[ct][0] + bsv) * lo16(uu[ct].x), (acc[ct][1] + bsv) * hi16(uu[ct].x)); w.y = pk2((acc[ct][2] + bsv) * lo16(uu[ct].y), (acc[ct][3] + bsv) * hi16(uu[ct].y)); *(v2u*)(mp + 16 * ct) = w; }
            __syncthreads(); }
        }
        if (blk & 1) convert_rest();
    }
    SEAM(3);

    if (IN(4)) {
        { pg8::Gemm g{MIX, Wo_t, MP, D, D}; pg8::StaticOrder S; S.init(MP, D, G, blk); EpiRes<false> E{x_p, AB, SS1};
          pg8::gemm_phase<EpiRes<false>, pg8::StaticOrder, true, true>(lds, g, S, E); }
        auto f = [&](int s, int n, float v) { const float o = x_s[(size_t)s * D + n] + v; AB[(size_t)(MP + s) * D + n] = f2bf(o);
            const float q = half_wave_sum(o * o); if ((lane & 31) == 0) atomic_addf(SS1 + MP + s, q); };
        skinny_gemm<2>(lds, MIX + (size_t)MP * D, Wo_t, D, D, blk, G, f);
    }
    SEAM(4);

    if (IN(5)) {
        { pg8::Gemm g{AB, Wup_t, MP, NUP, D}; pg8::StaticOrder S; S.init(MP, NUP, G, blk); EpiUp E{ACT, RAW, SS1, conv_w, conv_b, (LAS float*)(lds + 131072)};
          pg8::gemm_phase<EpiUp, pg8::StaticOrder, true, true>(lds, g, S, E); }
        { pg8::Gemm g{AB, Wup_t, MP + 256, NUP, D}; SampleOrder S{(blk >= 128 && blk - 128 < NUP / 256) ? blk - 128 : -1}; EpiAS E{AS, SS1};
          pg8::gemm_phase<EpiAS, SampleOrder, true, true>(lds, g, S, E); }
        { int Kp = PLE; asm volatile("" : "+s"(Kp));
          constexpr int nbusy = (MP / 256 * (NUP / 256) + NUP / 256) - 5 * 256;
          pg8::Gemm g{PB, Wp_t, MP + 256, D, Kp}; ProjOrder S{blk >= nbusy ? blk - nbusy : -1, 256 - nbusy}; EpiPP E{PP};
          pg8::gemm_phase<EpiPP, ProjOrder, true, true>(lds, g, S, E); }
    }
    SEAM(5);

    if (IN(6)) {
        for (int i = gt; i < 128 * 2 * (DFF / 4); i += NGT) { const int c4 = i % (DFF / 4), gr = i / (DFF / 4), rr = gr & 1, Gp = gr >> 1, c = 4 * c4; const bool first = (Gp & 31) == 0;
            const float* rg = RAW + (size_t)Gp * 4 * NUP; const float* rp = rg - 4 * NUP; const f32x4 z4 = {0.f, 0.f, 0.f, 0.f};
            f32x4 a0g, a0u, a1g, a1u, a2g, a2u;
            a0g = *(const f32x4*)(rg + (2 + rr) * NUP + c); a0u = *(const f32x4*)(rg + (2 + rr) * NUP + DFF + c);
            if (rr) { a1g = *(const f32x4*)(rg + 2 * NUP + c); a1u = *(const f32x4*)(rg + 2 * NUP + DFF + c); a2g = first ? z4 : *(const f32x4*)(rp + NUP + c); a2u = first ? z4 : *(const f32x4*)(rp + NUP + DFF + c); }
            else { a1g = first ? z4 : *(const f32x4*)(rp + NUP + c); a1u = first ? z4 : *(const f32x4*)(rp + NUP + DFF + c); a2g = first ? z4 : *(const f32x4*)(rp + c); a2u = first ? z4 : *(const f32x4*)(rp + DFF + c); }
            const f32x4 ag = *(const f32x4*)(conv_w + c) * a2g + *(const f32x4*)(conv_w + NUP + c) * a1g + *(const f32x4*)(conv_w + 2 * NUP + c) * a0g + *(const f32x4*)(conv_b + c);
            const f32x4 au = *(const f32x4*)(conv_w + DFF + c) * a2u + *(const f32x4*)(conv_w + NUP + DFF + c) * a1u + *(const f32x4*)(conv_w + 2 * NUP + DFF + c) * a0u + *(const f32x4*)(conv_b + DFF + c);
            v2u w; w.x = pk2(silu_(ag[0]) * au[0], silu_(ag[1]) * au[1]); w.y = pk2(silu_(ag[2]) * au[2], silu_(ag[3]) * au[3]);
            *(v2u*)(ACT + (size_t)(64 * Gp + rr) * DFF + c) = w; }
        for (int i = gt; i < MS * (DFF / 4); i += NGT) { const int c4 = i % (DFF / 4), s = i / (DFF / 4), c = 4 * c4;
            const float* sc0 = state_conv + (size_t)s * 2 * NUP; const float* sc1 = sc0 + NUP; const float* as = AS + (size_t)s * NUP;
            const f32x4 a0g = *(const f32x4*)(as + c), a0u = *(const f32x4*)(as + DFF + c), a1g = *(const f32x4*)(sc1 + c), a1u = *(const f32x4*)(sc1 + DFF + c), a2g = *(const f32x4*)(sc0 + c), a2u = *(const f32x4*)(sc0 + DFF + c);
            const f32x4 ag = *(const f32x4*)(conv_w + c) * a2g + *(const f32x4*)(conv_w + NUP + c) * a1g + *(const f32x4*)(conv_w + 2 * NUP + c) * a0g + *(const f32x4*)(conv_b + c);
            const f32x4 au = *(const f32x4*)(conv_w + DFF + c) * a2u + *(const f32x4*)(conv_w + NUP + DFF + c) * a1u + *(const f32x4*)(conv_w + 2 * NUP + DFF + c) * a0u + *(const f32x4*)(conv_b + DFF + c);
            v2u w; w.x = pk2(silu_(ag[0]) * au[0], silu_(ag[1]) * au[1]); w.y = pk2(silu_(ag[2]) * au[2], silu_(ag[3]) * au[3]);
            *(v2u*)(ACT + (size_t)(MP + s) * DFF + c) = w;
            float* cs = out + O_CONVS + (size_t)s * 2 * NUP; *(f32x4*)(cs + c) = a1g; *(f32x4*)(cs + DFF + c) = a1u; *(f32x4*)(cs + NUP + c) = a0g; *(f32x4*)(cs + NUP + DFF + c) = a0u; }
        for (int i = gt; i < 4 * 2 * (NUP / 4); i += NGT) { const int c4 = i % (NUP / 4), bk = i / (NUP / 4), b = bk >> 1, k = bk & 1;
            *(f32x4*)(out + O_CONVP + (size_t)bk * NUP + 4 * c4) = *(const f32x4*)(RAW + ((size_t)(32 * b + 31) * 4 + k) * NUP + 4 * c4); }
    }
    SEAM(6);

    if (IN(7)) {
        { pg8::Gemm g{ACT, Wdn_t, MP, D, DFF}; pg8::StaticOrder S; S.init(MP, D, G, blk); EpiRes<true> E{nullptr, AB, SS2};
          pg8::gemm_phase<EpiRes<true>, pg8::StaticOrder, true, true>(lds, g, S, E); }
        auto f = [&](int s, int n, float v) { const size_t o_ = (size_t)(MP + s) * D + n; const float o = bf2f(AB[o_]) + v; AB[o_] = f2bf(o);
            const float q = half_wave_sum(o * o); if ((lane & 31) == 0) atomic_addf(SS2 + MP + s, q); };
        skinny_gemm<2>(lds, ACT + (size_t)MP * DFF, Wdn_t, D, DFF, blk, G, f);
    }
    SEAM(7);

    if (IN(8)) {
#ifndef T_B
        { pg8::Gemm g{AB, Wg_t, MP, D, D}; pg8::StaticOrder S; S.init(MP, D, G, blk); EpiGate E{PP, AB, out, SS2, SS3};
          pg8::gemm_phase<EpiGate, pg8::StaticOrder, true, true>(lds, g, S, E); }
#endif
#ifndef T_D
        auto f2 = [&](int s, int n, float v) { const size_t o_ = (size_t)(MP + s) * D + n; const float r2 = __builtin_amdgcn_rsqf(SS2[MP + s] * (1.0f / D) + EPS);
            const float o = bf2f(AB[o_]) + bf2f(PP[o_]) * sigmoid_(r2 * v); out[o_] = o; const float q = half_wave_sum(o * o); if ((lane & 31) == 0) atomic_addf(SS3 + MP + s, q); };
        skinny_gemm<2>(lds, AB + (size_t)MP * D, Wg_t, D, D, blk, G, f2);
#endif
    }
    SEAM(8);

    if (IN(9)) {
        { const f32x4* gr = (const f32x4*)g_final + lane; f32x4 gv[8];
#pragma unroll
          for (int j = 0; j < 8; ++j) gv[j] = gr[64 * j];
          for (int m0 = gw; m0 < MT; m0 += 2 * NGW) { const int m1 = m0 + NGW; const bool two = m1 < MT;
            f32x4* h0 = (f32x4*)(out + (size_t)m0 * D) + lane; f32x4* h1 = (f32x4*)(out + (size_t)(two ? m1 : m0) * D) + lane;
            f32x4 a0[8], a1[8];
#pragma unroll
            for (int j = 0; j < 8; ++j) { a0[j] = h0[64 * j]; a1[j] = h1[64 * j]; }
            const float r0 = __builtin_amdgcn_rsqf(SS3[m0] * (1.0f / D) + EPS), r1 = __builtin_amdgcn_rsqf(SS3[two ? m1 : m0] * (1.0f / D) + EPS);
#pragma unroll
            for (int j = 0; j < 8; ++j) h0[64 * j] = a0[j] * gv[j] * r0;
            if (two) {
#pragma unroll
                for (int j = 0; j < 8; ++j) h1[64 * j] = a1[j] * gv[j] * r1; } } }
    }
#undef IN
#undef SEAM
}
#undef x_p
#undef x_s
#undef p_p
#undef p_s
#undef state_ret
#undef state_conv
#undef gm_ln_g
#undef gm_ln_b
#undef gm_ws
#undef gm_bs
#undef conv_w
#undef conv_b
#undef g_final
#undef out
#undef SS1
#undef SS2
#undef SS3
#undef STATS
#undef ROPE
#undef ROPES
#undef Win_t
#undef Wo_t
#undef Wup_t
#undef Wdn_t
#undef Wg_t
#undef Wp_t
#undef AB
#undef PB
#undef MIX
#undef Z
#undef ACT
#undef KV
#undef PP
#undef RAW
#undef AS

extern "C" void kernel_launch(void* const* d_in, const int* in_sizes, int n_in, void* d_out, int out_size, void* d_ws, size_t ws_size, hipStream_t stream) {
    static int grid = 0;
    if (grid == 0) {
        if (n_in != 22 || out_size != (int)O_END || ws_size < WS_END) { fprintf(stderr, "kernel_launch: unexpected shapes: n_in %d out %d ws %zu\n", n_in, out_size, ws_size); grid = -1; return; }
        int dev = 0, cus = 0, per_cu = 0;
        if (hipGetDevice(&dev) != hipSuccess || hipDeviceGetAttribute(&cus, hipDeviceAttributeMultiprocessorCount, dev) != hipSuccess) { grid = -1; return; }
        if (hipFuncSetAttribute((const void*)mk_fwd, hipFuncAttributeMaxDynamicSharedMemorySize, LDS_BYTES) != hipSuccess) { fprintf(stderr, "kernel_launch: hipFuncSetAttribute failed\n"); grid = -1; return; }
        if (hipOccupancyMaxActiveBlocksPerMultiprocessor(&per_cu, (const void*)mk_fwd, 512, LDS_BYTES) != hipSuccess || per_cu < 1) fprintf(stderr, "kernel_launch: occupancy query says %d\n", per_cu);
        (void)hipGetLastError();
        grid = cus;
        if (grid != 256) fprintf(stderr, "kernel_launch: %d CUs (built for 256)\n", grid);
    }
    if (grid < 0) return;
    if (hipMemsetAsync((char*)d_ws + WS_BAR, 0, BAR_BYTES, stream) != hipSuccess) { fprintf(stderr, "kernel_launch: memset failed\n"); return; }
    Params p{};
    for (int i = 0; i < 22; ++i) p.in[i] = (const float*)d_in[i];
    p.out = (float*)d_out; p.ws = (unsigned char*)d_ws;
    for (int h = 0; h < 8; ++h) p.log2g[h] = (float)std::log2(1.0 - std::exp2(-5.0 - (double)h));
    for (int i = 0; i < 64; ++i) p.invf[i] = powf(10000.0f, -(float)i / 64.0f);
    p.use_cg = 0; p.pad = 0;
#if MK_N_LAUNCHES == 1
    void* args[] = {&p};
#ifdef PROBE_K
    p.ph_lo = 0; p.ph_hi = PROBE_K + 1;
    (void)hipLaunchCooperativeKernel((const void*)mk_fwd, dim3(grid), dim3(512), args, LDS_BYTES, stream);
    if (hipMemsetAsync((char*)d_ws + WS_BAR, 0, BAR_BYTES, stream) != hipSuccess) return;
#endif
    p.ph_lo = 0; p.ph_hi = NPHASE;
    hipError_t e = hipLaunchCooperativeKernel((const void*)mk_fwd, dim3(grid), dim3(512), args, LDS_BYTES, stream);
    if (e != hipSuccess) fprintf(stderr, "kernel_launch: cooperative launch failed: %s\n", hipGetErrorString(e));
#else
    for (int ph = 0; ph < NPHASE; ++ph) { p.ph_lo = ph; p.ph_hi = ph + 1; hipLaunchKernelGGL(mk_fwd, dim3(grid), dim3(512), LDS_BYTES, stream, p); }
#endif
}
```

```cpp
#include <hip/hip_runtime.h>
#include <hip/hip_cooperative_groups.h>
#include <cstdio>
#include <cstdint>
#include <cmath>
namespace cg = cooperative_groups;

#ifndef MK_N_LAUNCHES
#define MK_N_LAUNCHES 1
#endif

namespace pg8 {
#define PG8_LAS __attribute__((address_space(3)))
typedef unsigned short bf16_t;
typedef short bf16x8 __attribute__((ext_vector_type(8)));
typedef float f32x4 __attribute__((ext_vector_type(4)));
typedef unsigned u32x4 __attribute__((ext_vector_type(4)));
constexpr int BM = 256, BK = 64, HALF = 128, HTB = HALF * BK * 2  , STAGE_BYTES = 8 * HTB, NXCD = 8, WGM = 8;

__host__ __device__ __forceinline__ int lds_byte(int r, int c) { const int st = (r >> 4) * 2 + (c >> 5), rr = r & 15, cc = c & 31, ob = rr * 64 + cc * 2; return st * 1024 + (ob ^ (((ob >> 9) & 1) << 5)); }
__host__ __device__ __forceinline__ void stage_rc(int b, int& R, int& C) { const int st = b / 1024, sb = b % 1024, swz = sb ^ (((sb >> 9) & 1) << 5); R = (st >> 1) * 16 + swz / 64; C = (st & 1) * 32 + (swz % 64) / 2; }
__host__ __device__ __forceinline__ int perm32(int rho) { const int n = rho >> 4, i = rho & 15; return 8 * (i >> 2) + 4 * n + (i & 3); }

struct Unit { int pm, pn; };
struct Gemm { const bf16_t* A; const bf16_t* Bt; int M, N, K; };

struct StaticOrder {
    int nM, nN, nwg, G, c;
    __host__ __device__ void init(int M, int N, int G_, int c_) { nM = M / BM; nN = N / BM; nwg = nM * nN; G = G_; c = c_; }
    __host__ __device__ bool next(int i, Unit& u) const {
        const long L = (long)i * G + c; if (L >= nwg) return false;
        int wgid = (int)L; { const int q = nwg / NXCD, r = nwg % NXCD, xcd = wgid % NXCD, off = wgid / NXCD; wgid = (xcd < r ? xcd * (q + 1) : r * (q + 1) + (xcd - r) * q) + off; }
        const int nig = WGM * nN, gid = wgid / nig, fm = gid * WGM, gsz = (nM - fm) < WGM ? (nM - fm) : WGM;
        u.pm = fm + ((wgid % nig) % gsz); u.pn = (wgid % nig) / gsz; return true;
    }
    __device__ __forceinline__ void a_ready(const Unit&) const {}
    __device__ __forceinline__ void done(const Unit&) const {}
};

__device__ __forceinline__ unsigned cvt_pk_bf16(float lo, float hi) { unsigned r; asm volatile("v_cvt_pk_bf16_f32 %0, %1, %2" : "=v"(r) : "v"(lo), "v"(hi)); return r; }
typedef float f32x2 __attribute__((ext_vector_type(2)));

template <class Epi, class Sched, bool ALIGN_EPI = false, bool SP2 = false>
__device__ __forceinline__ void gemm_phase(PG8_LAS unsigned char* lds, const Gemm g, const Sched& S, const Epi& E) {
    const int tid = threadIdx.x, wid = __builtin_amdgcn_readfirstlane(tid >> 6), lane = tid & 63, wr = wid >> 2, wc = wid & 3, fr = lane & 15, fq = lane >> 4;
    const int K = g.K, nt = K / BK;
    unsigned voffA[2], voffB[2];
#pragma unroll
    for (int i = 0; i < 2; ++i) { int R, C; stage_rc(tid * 16 + i * 8192, R, C); const int Rb = Epi::PERM ? ((R & ~31) + perm32(R & 31)) : R;
        voffA[i] = (unsigned)(R * K + C) * 2u; voffB[i] = (unsigned)(Rb * K + C) * 2u; }
    const size_t kstep = (size_t)(BK * 2);
    const size_t hstep = (size_t)HALF * K * 2;
    const size_t tstep = 2 * hstep;
    const unsigned ldsw = (unsigned)wid * 1024u;
    const int aoff = lds_byte(wr * 64 + fr, fq * 8), boff = lds_byte(wc * 32 + fr, fq * 8);
#define PG8_SA(b, h) (((b) * 2 + (h)) * HTB)
#define PG8_SB(b, h) ((4 + (b) * 2 + (h)) * HTB)
#define PG8_STAGE(bufoff, gbase, voff) do { _Pragma("unroll") for (int _i = 0; _i < 2; ++_i) \
        __builtin_amdgcn_global_load_lds((const unsigned*)((const char*)(gbase) + (voff)[_i]), (PG8_LAS unsigned*)(lds + (bufoff) + ldsw + _i * 8192), 16, 0, 0); } while (0)
#define PG8_LDA(dst, b, h) do { _Pragma("unroll") for (int m = 0; m < 4; ++m) _Pragma("unroll") for (int k = 0; k < 2; ++k) dst[m][k] = *(const PG8_LAS bf16x8*)(lds + PG8_SA(b, h) + aoff + m * 2048 + k * 1024); } while (0)
#define PG8_LDB(dst, b, h) do { _Pragma("unroll") for (int n = 0; n < 2; ++n) _Pragma("unroll") for (int k = 0; k < 2; ++k) dst[n][k] = *(const PG8_LAS bf16x8*)(lds + PG8_SB(b, h) + boff + n * 2048 + k * 1024); } while (0)
#define PG8_MMA(ai, bj, At, Bt) do { __builtin_amdgcn_s_setprio(1); _Pragma("unroll") for (int m = 0; m < 4; ++m) _Pragma("unroll") for (int n = 0; n < 2; ++n) _Pragma("unroll") for (int k = 0; k < 2; ++k) \
        acc[ai][bj][m][n] = __builtin_amdgcn_mfma_f32_16x16x32_bf16(Bt[n][k], At[m][k], acc[ai][bj][m][n], 0, 0, 0); __builtin_amdgcn_s_setprio(0); } while (0)
#define PG8_WAIT_V(n) asm volatile("s_waitcnt vmcnt(" #n ")" ::: "memory")
#define PG8_WAIT_L(n) asm volatile("s_waitcnt lgkmcnt(" #n ")" ::: "memory")
#define PG8_BAR __builtin_amdgcn_s_barrier()
#define PG8_SCHED __builtin_amdgcn_sched_barrier(0)
    Unit cur, nxt; int ui = 0;
    if (!S.next(0, cur)) return;
    f32x4 acc[2][2][4][2];
#pragma unroll
    for (int a = 0; a < 2; ++a)
#pragma unroll
        for (int b = 0; b < 2; ++b)
#pragma unroll
            for (int m = 0; m < 4; ++m)
#pragma unroll
                for (int n = 0; n < 2; ++n) acc[a][b][m][n] = (f32x4){0.f, 0.f, 0.f, 0.f};
    bf16x8 At[4][2], B0[2][2], B1[2][2];
    const char* cA = (const char*)g.A + (size_t)cur.pm * tstep; const char* cB = (const char*)g.Bt + (size_t)cur.pn * tstep;
    S.a_ready(cur);
    if constexpr (SP2) {
        PG8_STAGE(PG8_SB(0, 0), cB, voffB); PG8_STAGE(PG8_SB(0, 1), cB + hstep, voffB); PG8_STAGE(PG8_SA(0, 0), cA, voffA); PG8_STAGE(PG8_SA(0, 1), cA + hstep, voffA);
        if (wr == 1) PG8_BAR;
        PG8_WAIT_V(2); PG8_BAR;
        PG8_STAGE(PG8_SB(1, 0), cB + kstep, voffB); PG8_STAGE(PG8_SA(1, 0), cA + kstep, voffA); PG8_STAGE(PG8_SB(1, 1), cB + hstep + kstep, voffB);
        PG8_WAIT_V(6); PG8_BAR;
    } else {
        PG8_STAGE(PG8_SB(0, 0), cB, voffB); PG8_STAGE(PG8_SA(0, 0), cA, voffA); PG8_STAGE(PG8_SB(0, 1), cB + hstep, voffB); PG8_STAGE(PG8_SA(0, 1), cA + hstep, voffA);
        if (wr == 1) PG8_BAR;
        PG8_WAIT_V(4); PG8_BAR;
        PG8_STAGE(PG8_SB(1, 0), cB + kstep, voffB); PG8_STAGE(PG8_SA(1, 0), cA + kstep, voffA); PG8_STAGE(PG8_SB(1, 1), cB + hstep + kstep, voffB);
        PG8_WAIT_V(6); PG8_BAR;
    }
    for (;;) {
        const bool has_next = S.next(ui + 1, nxt);
        const char* nA = has_next ? (const char*)g.A + (size_t)nxt.pm * tstep : cA; const char* nB = has_next ? (const char*)g.Bt + (size_t)nxt.pn * tstep : cB;
        for (int t = 0; t < nt; t += 2) {
            const bool last = (t == nt - 2);
            const char* a1 = cA + (size_t)(t + 1) * kstep;
            const char* a2 = last ? nA : cA + (size_t)(t + 2) * kstep; const char* b2 = last ? nB : cB + (size_t)(t + 2) * kstep;
            const char* a3 = a2 + kstep; const char* b3 = b2 + kstep;
            if (last && has_next) S.a_ready(nxt);
            if constexpr (SP2) {
            PG8_LDB(B0, 0, 0); PG8_LDB(B1, 0, 1); PG8_SCHED; PG8_LDA(At, 0, 0); PG8_STAGE(PG8_SA(1, 1), a1 + hstep, voffA);
            PG8_WAIT_V(8); PG8_WAIT_L(0); PG8_BAR; PG8_MMA(0, 0, At, B0); PG8_MMA(0, 1, At, B1); PG8_BAR; PG8_SCHED;
            PG8_LDA(At, 0, 1); PG8_STAGE(PG8_SB(0, 0), b2, voffB); PG8_STAGE(PG8_SB(0, 1), b2 + hstep, voffB); PG8_STAGE(PG8_SA(0, 0), a2, voffA);
            PG8_WAIT_V(8); PG8_WAIT_L(0); PG8_BAR; PG8_MMA(1, 0, At, B0); PG8_MMA(1, 1, At, B1); PG8_BAR; PG8_SCHED;
            PG8_LDB(B0, 1, 0); PG8_LDB(B1, 1, 1); PG8_SCHED; PG8_LDA(At, 1, 0); PG8_STAGE(PG8_SA(0, 1), a2 + hstep, voffA);
            PG8_WAIT_V(8); PG8_WAIT_L(0); PG8_BAR; PG8_MMA(0, 0, At, B0); PG8_MMA(0, 1, At, B1); PG8_BAR; PG8_SCHED;
            PG8_LDA(At, 1, 1); PG8_STAGE(PG8_SB(1, 0), b3, voffB); PG8_STAGE(PG8_SB(1, 1), b3 + hstep, voffB); PG8_STAGE(PG8_SA(1, 0), a3, voffA);
            PG8_WAIT_V(8); PG8_WAIT_L(0); PG8_BAR; PG8_MMA(1, 0, At, B0); PG8_MMA(1, 1, At, B1); PG8_BAR; PG8_SCHED;
            } else {
            PG8_LDB(B0, 0, 0); PG8_SCHED; PG8_LDA(At, 0, 0); PG8_STAGE(PG8_SA(1, 1), a1 + hstep, voffA);
            PG8_WAIT_L(8); PG8_BAR; PG8_WAIT_L(0); PG8_MMA(0, 0, At, B0); PG8_BAR; PG8_SCHED;
            PG8_LDB(B1, 0, 1); PG8_STAGE(PG8_SB(0, 0), b2, voffB);
            PG8_BAR; PG8_WAIT_L(0); PG8_MMA(0, 1, At, B1); PG8_BAR;
            PG8_LDA(At, 0, 1); PG8_STAGE(PG8_SA(0, 0), a2, voffA);
            PG8_BAR; PG8_WAIT_L(0); PG8_MMA(1, 0, At, B0); PG8_BAR; PG8_SCHED;
            PG8_STAGE(PG8_SB(0, 1), b2 + hstep, voffB);
            PG8_WAIT_V(6); PG8_BAR; PG8_MMA(1, 1, At, B1); PG8_BAR;
            PG8_LDB(B0, 1, 0); PG8_SCHED; PG8_LDA(At, 1, 0); PG8_STAGE(PG8_SA(0, 1), a2 + hstep, voffA);
            PG8_WAIT_L(8); PG8_BAR; PG8_WAIT_L(0); PG8_MMA(0, 0, At, B0); PG8_BAR; PG8_SCHED;
            PG8_LDB(B1, 1, 1); PG8_STAGE(PG8_SB(1, 0), b3, voffB);
            PG8_BAR; PG8_WAIT_L(0); PG8_MMA(0, 1, At, B1); PG8_BAR;
            PG8_LDA(At, 1, 1); PG8_STAGE(PG8_SA(1, 0), a3, voffA);
            PG8_BAR; PG8_WAIT_L(0); PG8_MMA(1, 0, At, B0); PG8_BAR; PG8_SCHED;
            PG8_STAGE(PG8_SB(1, 1), b3 + hstep, voffB);
            PG8_WAIT_V(6); PG8_BAR; PG8_MMA(1, 1, At, B1); PG8_BAR;
            }
        }
        if constexpr (ALIGN_EPI) { if (wr == 0) PG8_BAR; }
        if constexpr (!Epi::AFTER_DRAIN) { E(acc, cur, wr, wc, fr, fq); S.done(cur); }
        if (!has_next) break;
#pragma unroll
        for (int a = 0; a < 2; ++a)
#pragma unroll
            for (int b = 0; b < 2; ++b)
#pragma unroll
                for (int m = 0; m < 4; ++m)
#pragma unroll
                    for (int n = 0; n < 2; ++n) acc[a][b][m][n] = (f32x4){0.f, 0.f, 0.f, 0.f};
        cur = nxt; cA = nA; cB = nB; ++ui;
        if constexpr (ALIGN_EPI) { if (wr == 1) PG8_BAR; }
    }
    PG8_WAIT_V(0);
    if constexpr (!ALIGN_EPI) { if (wr == 0) PG8_BAR; }
    PG8_BAR;
    if constexpr (Epi::AFTER_DRAIN) { E.fused(acc, cur, wr, wc, fr, fq, lds, wid, lane); S.done(cur); }
#undef PG8_SA
#undef PG8_SB
#undef PG8_STAGE
#undef PG8_LDA
#undef PG8_LDB
#undef PG8_MMA
#undef PG8_WAIT_V
#undef PG8_WAIT_L
#undef PG8_BAR
#undef PG8_SCHED
}
}

#define GAS __attribute__((address_space(1)))
#define LAS __attribute__((address_space(3)))
typedef unsigned short bf16;
typedef unsigned v4u __attribute__((ext_vector_type(4)));
typedef unsigned v2u __attribute__((ext_vector_type(2)));
typedef float f32x4 __attribute__((ext_vector_type(4)));
typedef float f32x2 __attribute__((ext_vector_type(2)));
typedef short bf16x8 __attribute__((ext_vector_type(8)));
#define XB_TMO      128
#define XB_XCNT(j)  (256  + 64 * (j))
#define XB_XSUB(j)  (1280 + 64 * (j))
#define XB_XGEN(j)  (2304 + 64 * (j))
#define XB_TOP      3328
#define XB_TOPGEN   3392
#define XCD_BAR_WORDS 3456
#define XB_SPIN_CAP (1u << 18)

__device__ __forceinline__ unsigned xb_ld(unsigned* p)              { return __hip_atomic_load(p, __ATOMIC_RELAXED, __HIP_MEMORY_SCOPE_AGENT); }
__device__ __forceinline__ unsigned xb_add(unsigned* p, unsigned v) { return __hip_atomic_fetch_add(p, v, __ATOMIC_RELAXED, __HIP_MEMORY_SCOPE_AGENT); }
__device__ __forceinline__ unsigned xb_xcc_id() { return (unsigned)__builtin_amdgcn_s_getreg((3 << 11) | 20) & 0xFu; }
#define XB_SPIN(cond, bar) do { unsigned _sp = 0; while (cond) { __builtin_amdgcn_s_sleep(1); \
    if ((++_sp & 255u) == 0u) { if (xb_ld(&(bar)[XB_TMO])) break; if (_sp > XB_SPIN_CAP) { atomicAdd(&(bar)[XB_TMO], 1u); break; } } } } while (0)

struct XcdBarrier {
    unsigned* bar; unsigned x;
    volatile LAS unsigned* st;
};

__device__ __forceinline__ XcdBarrier xcd_barrier_post(unsigned* bar, volatile LAS unsigned* st) {
    XcdBarrier b; b.bar = bar; b.x = xb_xcc_id(); b.st = st;
    if (threadIdx.x == 0) (void)xb_add(&bar[XB_XCNT(b.x)], 1u);
    return b;
}
__device__ __forceinline__ void xcd_barrier_complete(unsigned* bar, unsigned x, unsigned& nloc, unsigned& nx) {
    const unsigned G = gridDim.x * gridDim.y * gridDim.z;
    unsigned sum, cnt, mine, sp = 0u;
    for (;;) {
        sum = 0u; cnt = 0u; mine = 0u;
#pragma unroll
        for (unsigned j = 0; j < 16; ++j) { const unsigned c = xb_ld(&bar[XB_XCNT(j)]); sum += c; cnt += (c > 0u) ? 1u : 0u; mine = (j == x) ? c : mine; }
        if (sum == G) break;
        __builtin_amdgcn_s_sleep(1);
        if ((++sp & 255u) == 0u) { if (xb_ld(&bar[XB_TMO])) break; if (sp > XB_SPIN_CAP) { atomicAdd(&bar[XB_TMO], 1u); break; } }
    }
    nloc = mine > 0u ? mine : 1u; nx = cnt > 0u ? cnt : 1u;
}

__device__ __forceinline__ void xcd_barrier(const XcdBarrier& b) {
    asm volatile("s_waitcnt vmcnt(0)" ::: "memory");
    __syncthreads();
    if (threadIdx.x == 0) {
        unsigned* bar = b.bar;
        __builtin_amdgcn_s_waitcnt(0);
        unsigned nloc = b.st[0], nx = b.st[1];
        if (nloc == 0u) { xcd_barrier_complete(bar, b.x, nloc, nx); b.st[0] = nloc; b.st[1] = nx; }
        const unsigned old = xb_add(&bar[XB_XSUB(b.x)], 1u);
        const unsigned gen = old / nloc;
        if (old + 1u == (gen + 1u) * nloc) {
            __builtin_amdgcn_fence(__ATOMIC_RELEASE, "agent");
            asm volatile("s_waitcnt vmcnt(0)" ::: "memory");
            const unsigned og = xb_add(&bar[XB_TOP], 1u);
            const unsigned tg = og / nx;
            if (og + 1u == (tg + 1u) * nx) xb_add(&bar[XB_TOPGEN], 1u);
            else XB_SPIN(xb_ld(&bar[XB_TOPGEN]) == tg, bar);
            __builtin_amdgcn_fence(__ATOMIC_ACQUIRE, "agent");
            xb_add(&bar[XB_XGEN(b.x)], 1u);
            asm volatile("s_waitcnt vmcnt(0)" ::: "memory");
        } else {
            XB_SPIN(xb_ld(&bar[XB_XGEN(b.x)]) == gen, bar);
            __builtin_amdgcn_fence(__ATOMIC_ACQUIRE, "agent");
            asm volatile("s_waitcnt vmcnt(0)" ::: "memory");
        }
    }
    __syncthreads();
}

constexpr int MP = 8192, MS = 128, MT = MP + MS, D = 2048, NIN = 6144, NUP = 11264, DFF = 5632, PLE = 256, SEQ = 2048, NH = 8;
constexpr float EPS = 1e-6f;
constexpr int NPHASE = 10;
constexpr size_t MiB = 1u << 20;
constexpr size_t WS_BAR = 0, BAR_BYTES = 16384;
constexpr size_t WS_SS1 = 64 * 1024, WS_SS2 = 128 * 1024, WS_SS3 = 192 * 1024, WS_STATS = 256 * 1024;
constexpr size_t WS_ROPE = 1 * MiB, WS_ROPES = 2 * MiB;
constexpr size_t WS_WIN = 4 * MiB, WS_WO = 28 * MiB, WS_WUP = 36 * MiB, WS_WDN = 80 * MiB, WS_WG = 102 * MiB, WS_WP = 110 * MiB;
constexpr size_t WS_AB = 112 * MiB, WS_PB = 145 * MiB, WS_MIX = 150 * MiB, WS_Z = 183 * MiB, WS_ACT = 183 * MiB, WS_KV = 281 * MiB, WS_PP = 281 * MiB;
constexpr size_t WS_RAW = 313 * MiB, WS_AS = 335 * MiB, WS_END = 346 * MiB;
static_assert(WS_AB + (size_t)MT * D * 2 <= WS_PB && WS_PB + (size_t)MT * PLE * 2 <= WS_MIX && WS_MIX + (size_t)MT * D * 2 <= WS_Z, "ws map 1");
static_assert(WS_Z + (size_t)MT * NIN * 2 <= WS_KV && WS_ACT + (size_t)MT * DFF * 2 <= WS_KV && WS_KV + (size_t)512 * 16384 * 4 <= WS_RAW, "ws map 2");
static_assert(WS_RAW + (size_t)128 * 4 * NUP * 4 <= WS_AS && WS_AS + (size_t)MS * NUP * 4 <= WS_END && WS_PP + (size_t)MT * D * 4 <= WS_END, "ws map 3");
constexpr size_t O_RETP = 17039360, O_CONVP = 17563648, O_RETS = 17653760, O_CONVS = 34430976, O_GMV = 37314560, O_END = 37445632;
constexpr int LDS_BYTES = 147456, MISC_OFF = LDS_BYTES - 256;
constexpr int LDP = 136;
constexpr int TILE_B = 128 * LDP * 2;

struct Params { const float* in[22]; float* out; unsigned char* ws; float log2g[8]; float invf[64]; int ph_lo, ph_hi, use_cg, pad; };

#define LDS_WAIT() asm volatile("s_waitcnt lgkmcnt(0)" ::: "memory")
__device__ __forceinline__ float lo16(unsigned u) { return __uint_as_float(u << 16); }
__device__ __forceinline__ float hi16(unsigned u) { return __uint_as_float(u & 0xffff0000u); }
__device__ __forceinline__ float bf2f(bf16 b) { return __uint_as_float((unsigned)b << 16); }
__device__ __forceinline__ unsigned pk2(float lo, float hi) { return pg8::cvt_pk_bf16(lo, hi); }
__device__ __forceinline__ bf16 f2bf(float f) { return (bf16)(pg8::cvt_pk_bf16(f, 0.f) & 0xffffu); }
__device__ __forceinline__ float sigmoid_(float x) { return __builtin_amdgcn_rcpf(1.0f + __builtin_amdgcn_exp2f(-1.44269504089f * x)); }
__device__ __forceinline__ float silu_(float x) { return x * sigmoid_(x); }
__device__ __forceinline__ float gelu_(float x) { return x * sigmoid_(1.5957691216f * (x + 0.044715f * x * x * x)); }
__device__ __forceinline__ float wave_sum(float v) {
#pragma unroll
    for (int o = 1; o < 64; o <<= 1) v += __shfl_xor(v, o);
    return v;
}
__device__ __forceinline__ void atomic_addf(float* p, float v) { (void)__hip_atomic_fetch_add(p, v, __ATOMIC_RELAXED, __HIP_MEMORY_SCOPE_AGENT); }
template <int CTRL> __device__ __forceinline__ float dppf(float x) { return __int_as_float(__builtin_amdgcn_mov_dpp(__float_as_int(x), CTRL, 0xf, 0xf, false)); }

using pg8::Unit;
struct EpiZ {
    static constexpr bool PERM = true, AFTER_DRAIN = false;
    bf16* Z;
    __device__ __forceinline__ void operator()(const f32x4 (&acc)[2][2][4][2], const Unit& u, int wr, int wc, int fr, int fq) const {
        const int row0 = u.pm * 256 + wr * 64 + fr, col0 = u.pn * 256 + wc * 32 + 8 * fq;
        const int mode = u.pn < 12 ? 0 : (u.pn < 16 ? 1 : 2);
#pragma unroll
        for (int ai = 0; ai < 2; ++ai)
#pragma unroll
            for (int m = 0; m < 4; ++m) { bf16* rowp = Z + (size_t)(row0 + ai * 128 + m * 16) * NIN + col0;
#pragma unroll
                for (int bj = 0; bj < 2; ++bj) { f32x4 v0 = acc[ai][bj][m][0], v1 = acc[ai][bj][m][1];
                    if (mode == 1) {
#pragma unroll
                        for (int j = 0; j < 4; ++j) { v0[j] = silu_(v0[j]); v1[j] = silu_(v1[j]); } }
                    else if (mode == 2) {
#pragma unroll
                        for (int j = 0; j < 4; ++j) { v0[j] = gelu_(v0[j]); v1[j] = gelu_(v1[j]); } }
                    v4u w; w.x = pk2(v0[0], v0[1]); w.y = pk2(v0[2], v0[3]); w.z = pk2(v1[0], v1[1]); w.w = pk2(v1[2], v1[3]);
                    *(v4u*)(rowp + bj * 128) = w; } }
    }
};
template <bool BASE_BF16> struct EpiRes {
    static constexpr bool PERM = true, AFTER_DRAIN = false;
    const float* base; bf16* hb; float* ss;
    __device__ __forceinline__ void operator()(const f32x4 (&acc)[2][2][4][2], const Unit& u, int wr, int wc, int fr, int fq) const {
        const int row0 = u.pm * 256 + wr * 64 + fr, col0 = u.pn * 256 + wc * 32 + 8 * fq;
        float sacc[2][4];
#pragma unroll
        for (int ai = 0; ai < 2; ++ai) {
            f32x4 bs[4][2][2];
#pragma unroll
            for (int m = 0; m < 4; ++m)
#pragma unroll
                for (int bj = 0; bj < 2; ++bj) { const size_t o_ = (size_t)(row0 + ai * 128 + m * 16) * D + col0 + bj * 128;
                    if (BASE_BF16) { const v4u w = *(const v4u*)(hb + o_); bs[m][bj][0] = (f32x4){lo16(w.x), hi16(w.x), lo16(w.y), hi16(w.y)}; bs[m][bj][1] = (f32x4){lo16(w.z), hi16(w.z), lo16(w.w), hi16(w.w)}; }
                    else { bs[m][bj][0] = *(const f32x4*)(base + o_); bs[m][bj][1] = *(const f32x4*)(base + o_ + 4); } }
#pragma unroll
            for (int m = 0; m < 4; ++m) { const size_t off = (size_t)(row0 + ai * 128 + m * 16) * D + col0; float s = 0.f;
#pragma unroll
                for (int bj = 0; bj < 2; ++bj) { const f32x4 o0 = bs[m][bj][0] + acc[ai][bj][m][0], o1 = bs[m][bj][1] + acc[ai][bj][m][1];
                    v4u w; w.x = pk2(o0[0], o0[1]); w.y = pk2(o0[2], o0[3]); w.z = pk2(o1[0], o1[1]); w.w = pk2(o1[2], o1[3]); *(v4u*)(hb + off + bj * 128) = w;
                    s += ((o0[0] * o0[0] + o0[1] * o0[1]) + (o0[2] * o0[2] + o0[3] * o0[3])) + ((o1[0] * o1[0] + o1[1] * o1[1]) + (o1[2] * o1[2] + o1[3] * o1[3])); }
                s += __shfl_xor(s, 16); s += __shfl_xor(s, 32); sacc[ai][m] = s; }
            asm volatile("" ::: "memory"); }
        if (fq == 0) {
#pragma unroll
            for (int ai = 0; ai < 2; ++ai)
#pragma unroll
                for (int m = 0; m < 4; ++m) atomic_addf(ss + row0 + ai * 128 + m * 16, sacc[ai][m]); }
    }
};
struct EpiPP {
    static constexpr bool PERM = true, AFTER_DRAIN = false;
    bf16* pp;
    __device__ __forceinline__ void operator()(const f32x4 (&acc)[2][2][4][2], const Unit& u, int wr, int wc, int fr, int fq) const {
        const int row0 = u.pm * 256 + wr * 64 + fr, col0 = u.pn * 256 + wc * 32 + 8 * fq;
#pragma unroll
        for (int ai = 0; ai < 2; ++ai)
#pragma unroll
            for (int m = 0; m < 4; ++m) { if (row0 + ai * 128 + m * 16 >= MT) continue; bf16* rowp = pp + (size_t)(row0 + ai * 128 + m * 16) * D + col0;
#pragma unroll
                for (int bj = 0; bj < 2; ++bj) { const f32x4 v0 = acc[ai][bj][m][0], v1 = acc[ai][bj][m][1]; v4u w; w.x = pk2(v0[0], v0[1]); w.y = pk2(v0[2], v0[3]); w.z = pk2(v1[0], v1[1]); w.w = pk2(v1[2], v1[3]); *(v4u*)(rowp + bj * 128) = w; } }
    }
};
struct EpiGate {
    static constexpr bool PERM = true, AFTER_DRAIN = false;
    const bf16* pp; const bf16* hb; float* h; const float* ss2; float* ss3;
    __device__ __forceinline__ void operator()(const f32x4 (&acc)[2][2][4][2], const Unit& u, int wr, int wc, int fr, int fq) const {
        const int row0 = u.pm * 256 + wr * 64 + fr, col0 = u.pn * 256 + wc * 32 + 8 * fq;
        float sacc[2][4];
#pragma unroll
        for (int ai = 0; ai < 2; ++ai) {
            v4u hw[4][2], pw[4][2]; float r2[4];
#pragma unroll
            for (int m = 0; m < 4; ++m) { const int row = row0 + ai * 128 + m * 16; r2[m] = ss2[row];
#pragma unroll
                for (int bj = 0; bj < 2; ++bj) { hw[m][bj] = *(const v4u*)(hb + (size_t)row * D + col0 + bj * 128); pw[m][bj] = *(const v4u*)(pp + (size_t)row * D + col0 + bj * 128); } }
#pragma unroll
            for (int m = 0; m < 4; ++m) { const size_t off = (size_t)(row0 + ai * 128 + m * 16) * D + col0; float s = 0.f;
                const float rr = __builtin_amdgcn_rsqf(r2[m] * (1.0f / D) + EPS);
#pragma unroll
                for (int bj = 0; bj < 2; ++bj) { const v4u h4 = hw[m][bj], p4 = pw[m][bj];
                    const f32x4 hv0 = {lo16(h4.x), hi16(h4.x), lo16(h4.y), hi16(h4.y)}, hv1 = {lo16(h4.z), hi16(h4.z), lo16(h4.w), hi16(h4.w)};
                    const f32x4 pv0 = {lo16(p4.x), hi16(p4.x), lo16(p4.y), hi16(p4.y)}, pv1 = {lo16(p4.z), hi16(p4.z), lo16(p4.w), hi16(p4.w)};
                    const f32x4 a0 = acc[ai][bj][m][0], a1 = acc[ai][bj][m][1]; f32x4 o0, o1;
#pragma unroll
                    for (int j = 0; j < 4; ++j) { o0[j] = hv0[j] + pv0[j] * sigmoid_(rr * a0[j]); o1[j] = hv1[j] + pv1[j] * sigmoid_(rr * a1[j]); }
                    *(f32x4*)(h + off + bj * 128) = o0; *(f32x4*)(h + off + bj * 128 + 4) = o1;
                    s += ((o0[0] * o0[0] + o0[1] * o0[1]) + (o0[2] * o0[2] + o0[3] * o0[3])) + ((o1[0] * o1[0] + o1[1] * o1[1]) + (o1[2] * o1[2] + o1[3] * o1[3])); }
                s += __shfl_xor(s, 16); s += __shfl_xor(s, 32); sacc[ai][m] = s; }
            asm volatile("" ::: "memory"); }
        if (fq == 0) {
#pragma unroll
            for (int ai = 0; ai < 2; ++ai)
#pragma unroll
                for (int m = 0; m < 4; ++m) atomic_addf(ss3 + row0 + ai * 128 + m * 16, sacc[ai][m]); }
    }
};
struct EpiUp {
    static constexpr bool PERM = false, AFTER_DRAIN = false;
    bf16* act; float* raw; const float* ss1; const float* cw; const float* cb; LAS float* wl;
    __device__ __forceinline__ void operator()(const f32x4 (&acc)[2][2][4][2], const Unit& u, int wr, int wc, int fr, int fq) const {
        const int row0 = u.pm * 256 + wr * 64 + fr;
        LAS float* wb = wl + (wr * 4 + wc) * 256;
        { const int l = fq * 16 + fr, v = l >> 3, c4 = l & 7;
          const float* src = ((v & 3) == 3 ? cb : cw + (v & 3) * NUP) + (v >> 2) * DFF + u.pn * 128 + wc * 32 + 4 * c4;
          *(LAS f32x4*)(wb + v * 32 + 4 * c4) = *(const f32x4*)src; }
        float rs[2][4];
#pragma unroll
        for (int ai = 0; ai < 2; ++ai)
#pragma unroll
            for (int m = 0; m < 4; ++m) rs[ai][m] = __builtin_amdgcn_rsqf(ss1[row0 + ai * 128 + m * 16] * (1.0f / D) + EPS);
#pragma unroll
        for (int n = 0; n < 2; ++n) {
            const int cg_ = u.pn * 128 + wc * 32 + 16 * n + 4 * fq;
            const volatile LAS f32x4* wv = (const volatile LAS f32x4*)(wb + 16 * n + 4 * fq);
#pragma unroll
            for (int ai = 0; ai < 2; ++ai) {
                f32x4 l1g = {0.f, 0.f, 0.f, 0.f}, l2g = l1g, l1u = l1g, l2u = l1g;
#pragma unroll
                for (int m = 0; m < 4; ++m) {
                    const int row = row0 + ai * 128 + m * 16;
                    f32x4 sg;
                    { const f32x4 g = acc[ai][0][m][n] * rs[ai][m];
                      if (m == 0 && fr < 2) *(f32x4*)(raw + ((size_t)(row >> 6) * 4 + 2 + fr) * NUP + cg_) = g;
                      if (m == 3 && fr >= 14) *(f32x4*)(raw + ((size_t)(row >> 6) * 4 + (fr - 14)) * NUP + cg_) = g;
                      f32x4 r1, r2, x1, x2;
#pragma unroll
                      for (int j = 0; j < 4; ++j) { r1[j] = dppf<0x121>(g[j]); r2[j] = dppf<0x122>(g[j]); }
#pragma unroll
                      for (int j = 0; j < 4; ++j) { x1[j] = fr == 0 ? l1g[j] : r1[j]; x2[j] = fr < 2 ? l2g[j] : r2[j]; }
                      l1g = r1; l2g = r2;
                      const f32x4 w0 = wv[0], w1 = wv[8], w2 = wv[16], bb = wv[24];
                      const f32x4 ag = w0 * x2 + w1 * x1 + w2 * g + bb;
#pragma unroll
                      for (int j = 0; j < 4; ++j) sg[j] = silu_(ag[j]);
                      asm volatile("" : "+v"(sg)); }
                    f32x4 o;
                    { const f32x4 up = acc[ai][1][m][n] * rs[ai][m];
                      if (m == 0 && fr < 2) *(f32x4*)(raw + ((size_t)(row >> 6) * 4 + 2 + fr) * NUP + DFF + cg_) = up;
                      if (m == 3 && fr >= 14) *(f32x4*)(raw + ((size_t)(row >> 6) * 4 + (fr - 14)) * NUP + DFF + cg_) = up;
                      f32x4 r1, r2, x1, x2;
#pragma unroll
                      for (int j = 0; j < 4; ++j) { r1[j] = dppf<0x121>(up[j]); r2[j] = dppf<0x122>(up[j]); }
#pragma unroll
                      for (int j = 0; j < 4; ++j) { x1[j] = fr == 0 ? l1u[j] : r1[j]; x2[j] = fr < 2 ? l2u[j] : r2[j]; }
                      l1u = r1; l2u = r2;
                      const f32x4 w0 = wv[32], w1 = wv[40], w2 = wv[48], bb = wv[56];
                      o = (w0 * x2 + w1 * x1 + w2 * up + bb) * sg; }
                    v2u w; w.x = pk2(o[0], o[1]); w.y = pk2(o[2], o[3]);
                    *(v2u*)(act + (size_t)row * DFF + cg_) = w; } } }
    }
};

struct EpiAS {
    static constexpr bool PERM = false, AFTER_DRAIN = false;
    float* as; const float* ss1;
    __device__ __forceinline__ void operator()(const f32x4 (&acc)[2][2][4][2], const Unit& u, int wr, int wc, int fr, int fq) const {
#pragma unroll
        for (int m = 0; m < 4; ++m) { const int s_ = wr * 64 + m * 16 + fr; const float r = __builtin_amdgcn_rsqf(ss1[MP + s_] * (1.0f / D) + EPS);
#pragma unroll
            for (int n = 0; n < 2; ++n) { const int cg_ = u.pn * 128 + wc * 32 + 16 * n + 4 * fq;
                *(f32x4*)(as + (size_t)s_ * NUP + cg_) = acc[0][0][m][n] * r; *(f32x4*)(as + (size_t)s_ * NUP + DFF + cg_) = acc[0][1][m][n] * r; } }
    }
};
struct SampleOrder {
    int idx;
    __device__ __forceinline__ bool next(int i, Unit& u) const { if (i != 0 || idx < 0) return false; u.pm = MP / 256; u.pn = idx; return true; }
    __device__ __forceinline__ void a_ready(const Unit&) const {}
    __device__ __forceinline__ void done(const Unit&) const {}
};

struct ProjOrder {
    int first, nw;
    __device__ __forceinline__ bool next(int i, Unit& u) const { if (first < 0) return false; const int j = first + i * nw; if (j >= (MP / 256 + 1) * (D / 256)) return false; u.pm = j >> 3; u.pn = j & 7; return true; }
    __device__ __forceinline__ void a_ready(const Unit&) const {}
    __device__ __forceinline__ void done(const Unit&) const {}
};
template <int RT, int NK>
__device__ __forceinline__ void skinny_batch(f32x4 (&acc)[RT][2], const bf16* ap, const bf16* bp, int K) {
    bf16x8 bq[NK][2], aq[NK][RT];
#pragma unroll
    for (int kk = 0; kk < NK; ++kk) { bq[kk][0] = *(const bf16x8*)(bp + 32 * kk); bq[kk][1] = *(const bf16x8*)(bp + (size_t)16 * K + 32 * kk);
#pragma unroll
        for (int rt = 0; rt < RT; ++rt) aq[kk][rt] = *(const bf16x8*)(ap + (size_t)rt * 16 * K + 32 * kk); }
#pragma unroll
    for (int kk = 0; kk < NK; ++kk)
#pragma unroll
        for (int rt = 0; rt < RT; ++rt) { acc[rt][0] = __builtin_amdgcn_mfma_f32_16x16x32_bf16(bq[kk][0], aq[kk][rt], acc[rt][0], 0, 0, 0); acc[rt][1] = __builtin_amdgcn_mfma_f32_16x16x32_bf16(bq[kk][1], aq[kk][rt], acc[rt][1], 0, 0, 0); }
}
template <int RT, class F>
__device__ __forceinline__ void skinny_gemm(LAS unsigned char* lds, const bf16* A, const bf16* Bt, int N, int K, int u0, int ustride, const F& f) {
    const int tid = threadIdx.x, lane = tid & 63, w = tid >> 6, fr = lane & 15, fq = lane >> 4;
    constexpr int nrb = 8 / RT, ROWS = 16 * RT;
    const int nunits = nrb * (N / 32), kw = K / 8;
    LAS float* red = (LAS float*)lds;
    for (int u = u0; u < nunits; u += ustride) {
        const int rb = u % nrb, cb = u / nrb, row0 = rb * ROWS, col0 = cb * 32;
        f32x4 acc[RT][2];
#pragma unroll
        for (int rt = 0; rt < RT; ++rt) { acc[rt][0] = (f32x4){0.f, 0.f, 0.f, 0.f}; acc[rt][1] = (f32x4){0.f, 0.f, 0.f, 0.f}; }
        const bf16* ap = A + (size_t)(row0 + fr) * K + w * kw + 8 * fq;
        const bf16* bp = Bt + (size_t)(col0 + fr) * K + w * kw + 8 * fq;
        if constexpr (RT <= 2) {
            int k = 0;
            if (kw == 704) { skinny_batch<RT, 11>(acc, ap, bp, K); skinny_batch<RT, 11>(acc, ap + 352, bp + 352, K); k = 704; }
            for (; k + 256 <= kw; k += 256) skinny_batch<RT, 8>(acc, ap + k, bp + k, K);
            for (; k < kw; k += 32) skinny_batch<RT, 1>(acc, ap + k, bp + k, K);
        } else {
#pragma unroll 2
        for (int k = 0; k < kw; k += 32) {
            const bf16x8 b0 = *(const bf16x8*)(bp + k), b1 = *(const bf16x8*)(bp + (size_t)16 * K + k);
#pragma unroll
            for (int rt = 0; rt < RT; ++rt) { const bf16x8 av = *(const bf16x8*)(ap + (size_t)rt * 16 * K + k);
                acc[rt][0] = __builtin_amdgcn_mfma_f32_16x16x32_bf16(b0, av, acc[rt][0], 0, 0, 0);
                acc[rt][1] = __builtin_amdgcn_mfma_f32_16x16x32_bf16(b1, av, acc[rt][1], 0, 0, 0); }
        }
        }
#pragma unroll
        for (int rt = 0; rt < RT; ++rt)
#pragma unroll
            for (int ct = 0; ct < 2; ++ct) *(LAS f32x4*)(red + (w * ROWS + 16 * rt + fr) * 32 + 16 * ct + 4 * fq) = acc[rt][ct];
        __syncthreads();
#pragma unroll
        for (int it = 0; it < RT; ++it) { const int e = tid + 512 * it, r = e >> 5, c = e & 31; float v = 0.f;
#pragma unroll
            for (int ww = 0; ww < 8; ++ww) v += red[(ww * ROWS + r) * 32 + c];
            f(row0 + r, col0 + c, v); }
        __syncthreads();
    }
}
__device__ __forceinline__ float half_wave_sum(float v) {
#pragma unroll
    for (int o = 1; o < 32; o <<= 1) v += __shfl_xor(v, o);
    return v;
}

__device__ __forceinline__ void transpose_item(const float* W, int K, int N, const float* g, bf16* WT, bool upmap, LAS float* scr, int item, int lane) {
    const int nblk = N / 64, kb = item / nblk, nb = item % nblk, k0 = 64 * kb, n0 = 64 * nb;
    const float* src = W + (size_t)k0 * N + n0 + lane;
#pragma unroll
    for (int h = 0; h < 2; ++h) {
        float v[32];
#pragma unroll
        for (int i = 0; i < 32; ++i) v[i] = __builtin_nontemporal_load(src + (size_t)(32 * h + i) * N);
#pragma unroll
        for (int i = 0; i < 32; ++i) { float x = v[i]; if (g) x *= g[k0 + 32 * h + i]; scr[(32 * h + i) * 65 + lane] = x; }
    }
    LDS_WAIT(); asm volatile("" ::: "memory");
    const int c = lane & 7;
#pragma unroll
    for (int j = 0; j < 8; ++j) { const int n = (lane >> 3) + 8 * j; const LAS float* s = scr + (8 * c) * 65 + n;
        v4u o; o.x = pk2(s[0 * 65], s[1 * 65]); o.y = pk2(s[2 * 65], s[3 * 65]); o.z = pk2(s[4 * 65], s[5 * 65]); o.w = pk2(s[6 * 65], s[7 * 65]);
        int R = n0 + n; if (upmap) { const int half = R >= DFF ? 1 : 0, jj = R - half * DFF; R = 256 * (jj >> 7) + 128 * half + (jj & 127); }
        *(v4u*)(WT + (size_t)R * K + k0 + 8 * c) = o; }
    LDS_WAIT(); asm volatile("" ::: "memory");
}
__device__ __forceinline__ void rms_row_to_bf16(const float* xrow, bf16* orow, int lane) {
    const f32x4* xr = (const f32x4*)xrow + lane;
    f32x4 v[8]; float s = 0.f;
#pragma unroll
    for (int j = 0; j < 8; ++j) { v[j] = xr[64 * j]; s += (v[j][0] * v[j][0] + v[j][1] * v[j][1]) + (v[j][2] * v[j][2] + v[j][3] * v[j][3]); }
    const float r = __builtin_amdgcn_rsqf(wave_sum(s) * (1.0f / D) + EPS);
    v2u* o8 = (v2u*)orow + lane;
#pragma unroll
    for (int j = 0; j < 8; ++j) { v2u w; w.x = pk2(v[j][0] * r, v[j][1] * r); w.y = pk2(v[j][2] * r, v[j][3] * r); o8[64 * j] = w; }
}

__device__ __forceinline__ void mm128(f32x4 (&acc)[8], const LAS bf16* A, const LAS bf16* B, int wave, int fr, int fq) {
#pragma unroll
    for (int ks = 0; ks < 4; ++ks) {
        const bf16x8 a = *(const LAS bf16x8*)(A + (16 * wave + fr) * LDP + 32 * ks + 8 * fq);
#pragma unroll
        for (int ct = 0; ct < 8; ++ct) { const bf16x8 b = *(const LAS bf16x8*)(B + (16 * ct + fr) * LDP + 32 * ks + 8 * fq);
            acc[ct] = __builtin_amdgcn_mfma_f32_16x16x32_bf16(b, a, acc[ct], 0, 0, 0); }
    }
}
template <bool TRANS, bool DEC>
__device__ __forceinline__ void stage_rope(LAS bf16* dst, const bf16* zb, const float* rope, float scale, float l2g, int tid) {
#pragma unroll
    for (int it = 0; it < 2; ++it) { const int idx = tid + 512 * it, j = idx >> 3, d8 = idx & 7;
        const v4u x1 = *(const v4u*)(zb + (size_t)j * NIN + 8 * d8), x2 = *(const v4u*)(zb + (size_t)j * NIN + 64 + 8 * d8);
        const f32x4* rp = (const f32x4*)(rope + (size_t)(j * 64 + 8 * d8) * 2);
        float sc = scale; if (DEC) sc *= __builtin_amdgcn_exp2f(l2g * (float)(127 - j));
        float o1[8], o2[8];
#pragma unroll
        for (int p = 0; p < 4; ++p) { const f32x4 cs = rp[p]; const float a0 = lo16(x1[p]), a1 = hi16(x1[p]), b0 = lo16(x2[p]), b1 = hi16(x2[p]);
            o1[2 * p] = (a0 * cs[0] - b0 * cs[1]) * sc; o2[2 * p] = (b0 * cs[0] + a0 * cs[1]) * sc;
            o1[2 * p + 1] = (a1 * cs[2] - b1 * cs[3]) * sc; o2[2 * p + 1] = (b1 * cs[2] + a1 * cs[3]) * sc; }
        if (!TRANS) { v4u w1, w2;
#pragma unroll
            for (int p = 0; p < 4; ++p) { w1[p] = pk2(o1[2 * p], o1[2 * p + 1]); w2[p] = pk2(o2[2 * p], o2[2 * p + 1]); }
            *(LAS v4u*)(dst + j * LDP + 8 * d8) = w1; *(LAS v4u*)(dst + j * LDP + 64 + 8 * d8) = w2; }
        else {
#pragma unroll
            for (int i = 0; i < 8; ++i) { dst[(8 * d8 + i) * LDP + j] = f2bf(o1[i]); dst[(64 + 8 * d8 + i) * LDP + j] = f2bf(o2[i]); } }
    }
}
__device__ __forceinline__ void stage_T(LAS bf16* dst, const bf16* zb, int tid) {
#pragma unroll
    for (int it = 0; it < 4; ++it) { const int idx = tid + 512 * it, j = idx >> 4, c8 = idx & 15;
        const v4u x = *(const v4u*)(zb + (size_t)j * NIN + 8 * c8);
#pragma unroll
        for (int p = 0; p < 4; ++p) { dst[(8 * c8 + 2 * p) * LDP + j] = (bf16)(x[p] & 0xffffu); dst[(8 * c8 + 2 * p + 1) * LDP + j] = (bf16)(x[p] >> 16); } }
}


struct RopeX { v4u x1[2], x2[2]; };
struct RopeCS { f32x4 cs[2][4]; };
struct TileX { v4u x[4]; };
__device__ __forceinline__ void rope_load(RopeX& r, const bf16* zb, int tid) {
#pragma unroll
    for (int it = 0; it < 2; ++it) { const int idx = tid + 512 * it, j = idx >> 3, d8 = idx & 7; r.x1[it] = *(const v4u*)(zb + (size_t)j * NIN + 8 * d8); r.x2[it] = *(const v4u*)(zb + (size_t)j * NIN + 64 + 8 * d8); }
}
__device__ __forceinline__ void rope_cs_load(RopeCS& c, const float* rope, int tid) {
#pragma unroll
    for (int it = 0; it < 2; ++it) { const int idx = tid + 512 * it, j = idx >> 3, d8 = idx & 7; const f32x4* rp = (const f32x4*)(rope + (size_t)(j * 64 + 8 * d8) * 2);
#pragma unroll
        for (int p = 0; p < 4; ++p) c.cs[it][p] = rp[p]; }
}
template <bool TRANS, bool DEC>
__device__ __forceinline__ void rope_commit(LAS bf16* dst, const RopeX& r, const RopeCS& c, float scale, float l2g, int tid) {
#pragma unroll
    for (int it = 0; it < 2; ++it) { const int idx = tid + 512 * it, j = idx >> 3, d8 = idx & 7;
        float sc = scale; if (DEC) sc *= __builtin_amdgcn_exp2f(l2g * (float)(127 - j));
        float o1[8], o2[8];
#pragma unroll
        for (int p = 0; p < 4; ++p) { const f32x4 cs = c.cs[it][p]; const float a0 = lo16(r.x1[it][p]), a1 = hi16(r.x1[it][p]), b0 = lo16(r.x2[it][p]), b1 = hi16(r.x2[it][p]);
            o1[2 * p] = (a0 * cs[0] - b0 * cs[1]) * sc; o2[2 * p] = (b0 * cs[0] + a0 * cs[1]) * sc;
            o1[2 * p + 1] = (a1 * cs[2] - b1 * cs[3]) * sc; o2[2 * p + 1] = (b1 * cs[2] + a1 * cs[3]) * sc; }
        if (!TRANS) { v4u w1, w2;
#pragma unroll
            for (int p = 0; p < 4; ++p) { w1[p] = pk2(o1[2 * p], o1[2 * p + 1]); w2[p] = pk2(o2[2 * p], o2[2 * p + 1]); }
            *(LAS v4u*)(dst + j * LDP + 8 * d8) = w1; *(LAS v4u*)(dst + j * LDP + 64 + 8 * d8) = w2; }
        else {
#pragma unroll
            for (int i = 0; i < 8; ++i) { dst[(8 * d8 + i) * LDP + j] = f2bf(o1[i]); dst[(64 + 8 * d8 + i) * LDP + j] = f2bf(o2[i]); } }
    }
}
__device__ __forceinline__ void tile_load(TileX& t, const bf16* zb, int tid) {
#pragma unroll
    for (int it = 0; it < 4; ++it) { const int idx = tid + 512 * it, j = idx >> 4, c8 = idx & 15; t.x[it] = *(const v4u*)(zb + (size_t)j * NIN + 8 * c8); }
}
__device__ __forceinline__ void tile_commit_T(LAS bf16* dst, const TileX& t, int tid) {
#pragma unroll
    for (int it = 0; it < 4; ++it) { const int idx = tid + 512 * it, j = idx >> 4, c8 = idx & 15;
#pragma unroll
        for (int p = 0; p < 4; ++p) { dst[(8 * c8 + 2 * p) * LDP + j] = (bf16)(t.x[it][p] & 0xffffu); dst[(8 * c8 + 2 * p + 1) * LDP + j] = (bf16)(t.x[it][p] >> 16); } }
}

typedef short s16x4 __attribute__((ext_vector_type(4)));
__device__ __forceinline__ bf16x8 tr_frag(const LAS bf16* T, int c, int ks, int lane) {
    const int g = lane >> 4, q = (lane & 15) >> 2, p = lane & 3;
    const LAS bf16* a0 = T + (32 * ks + 8 * g + q) * LDP + 16 * c + 4 * p;
    const s16x4 lo = __builtin_amdgcn_ds_read_tr16_b64_v4i16((LAS s16x4*)a0), hi = __builtin_amdgcn_ds_read_tr16_b64_v4i16((LAS s16x4*)(a0 + 4 * LDP));
    return (bf16x8){lo[0], lo[1], lo[2], lo[3], hi[0], hi[1], hi[2], hi[3]};
}
__device__ __forceinline__ void mm128_nt(f32x4 (&acc)[8], const LAS bf16* A, const LAS bf16* B, int wave, int lane) {
    const int fr = lane & 15, fq = lane >> 4;
#pragma unroll
    for (int ks = 0; ks < 4; ++ks) {
        const bf16x8 a = *(const LAS bf16x8*)(A + (16 * wave + fr) * LDP + 32 * ks + 8 * fq);
#pragma unroll
        for (int ct = 0; ct < 8; ++ct) acc[ct] = __builtin_amdgcn_mfma_f32_16x16x32_bf16(tr_frag(B, ct, ks, lane), a, acc[ct], 0, 0, 0);
    }
}
__device__ __forceinline__ void mm128_tt(f32x4 (&acc)[8], const LAS bf16* At, const LAS bf16* Bn, int wave, int lane) {
#pragma unroll
    for (int ks = 0; ks < 4; ++ks) {
        const bf16x8 a = tr_frag(At, wave, ks, lane);
#pragma unroll
        for (int ct = 0; ct < 8; ++ct) acc[ct] = __builtin_amdgcn_mfma_f32_16x16x32_bf16(tr_frag(Bn, ct, ks, lane), a, acc[ct], 0, 0, 0);
    }
}
__device__ __forceinline__ void tile_commit_N(LAS bf16* dst, const TileX& t, int tid) {
#pragma unroll
    for (int it = 0; it < 4; ++it) { const int idx = tid + 512 * it, j = idx >> 4, c8 = idx & 15; *(LAS v4u*)(dst + j * LDP + 8 * c8) = t.x[it]; }
}

__global__ void __launch_bounds__(512, 2) mk_fwd(Params a) {
    extern __shared__ __attribute__((aligned(16))) unsigned char lds_raw[];
    LAS unsigned char* lds = (LAS unsigned char*)lds_raw;
    const int tid = threadIdx.x, lane = tid & 63, wave = __builtin_amdgcn_readfirstlane(tid >> 6), fr = lane & 15, fq = lane >> 4;
    const int G = gridDim.x, blk = blockIdx.x;
    const int gw = blk * 8 + wave, NGW = G * 8;
    const int gt = blk * 512 + tid, NGT = G * 512;
    unsigned char* ws = a.ws;
#define x_p (a.in[0])
#define x_s (a.in[1])
#define p_p (a.in[2])
#define p_s (a.in[3])
#define state_ret (a.in[4])
#define state_conv (a.in[5])
#define gm_ln_g (a.in[8])
#define gm_ln_b (a.in[9])
#define gm_ws (a.in[10])
#define gm_bs (a.in[11])
#define conv_w (a.in[15])
#define conv_b (a.in[16])
#define g_final (a.in[21])
#define out (a.out)
#define SS1 ((float*)(ws + WS_SS1))
#define SS2 ((float*)(ws + WS_SS2))
#define SS3 ((float*)(ws + WS_SS3))
#define STATS ((float*)(ws + WS_STATS))
#define ROPE ((float*)(ws + WS_ROPE))
#define ROPES ((float*)(ws + WS_ROPES))
#define Win_t ((bf16*)(ws + WS_WIN))
#define Wo_t ((bf16*)(ws + WS_WO))
#define Wup_t ((bf16*)(ws + WS_WUP))
#define Wdn_t ((bf16*)(ws + WS_WDN))
#define Wg_t ((bf16*)(ws + WS_WG))
#define Wp_t ((bf16*)(ws + WS_WP))
#define AB ((bf16*)(ws + WS_AB))
#define PB ((bf16*)(ws + WS_PB))
#define MIX ((bf16*)(ws + WS_MIX))
#define Z ((bf16*)(ws + WS_Z))
#define ACT ((bf16*)(ws + WS_ACT))
#define KV ((float*)(ws + WS_KV))
#define PP ((bf16*)(ws + WS_MIX))
#define RAW ((float*)(ws + WS_RAW))
#define AS ((float*)(ws + WS_AS))

    volatile LAS unsigned* MISC = (volatile LAS unsigned*)(lds + MISC_OFF);
    if (tid < 64) MISC[tid] = 0u;
    __syncthreads();
    XcdBarrier bar; bar.bar = (unsigned*)(ws + WS_BAR); bar.x = 0; bar.st = nullptr;
    if (MK_N_LAUNCHES == 1) bar = xcd_barrier_post((unsigned*)(ws + WS_BAR), MISC + 8);
    const int lo = a.ph_lo, hi = a.ph_hi;
#ifndef PHMASK
#define PHMASK 0xffff
#endif
#define IN(k) (((PHMASK >> (k)) & 1) && lo <= (k) && (k) < hi)
#define SEAM(k) do { if (IN(k) && IN((k) + 1)) { if (a.use_cg) cg::this_grid().sync(); else xcd_barrier(bar); } } while (0)

    if (IN(0)) {
        LAS float* scr = (LAS float*)(lds + wave * 16640);
        constexpr int I_IN = (D / 64) * (NIN / 64);
        for (int it = gw; it < I_IN; it += NGW) transpose_item(a.in[7], D, NIN, a.in[6], Win_t, false, scr, it, lane);
        for (int m = gw; m < MT; m += NGW) rms_row_to_bf16(m < MP ? x_p + (size_t)m * D : x_s + (size_t)(m - MP) * D, AB + (size_t)m * D, lane);
        for (int i = gt; i < MT * PLE / 4; i += NGT) { const f32x4 v = i < MP * PLE / 4 ? ((const f32x4*)p_p)[i] : ((const f32x4*)p_s)[i - MP * PLE / 4]; v2u w; w.x = pk2(v[0], v[1]); w.y = pk2(v[2], v[3]); ((v2u*)PB)[i] = w; }
        for (int i = gt; i < SEQ * 64 + 64; i += NGT) { const int pos = i < SEQ * 64 ? (i >> 6) : 16384, fi = i & 63;
            const float ang = (float)pos * a.invf[fi]; double t = (double)ang * 0.15915494309189535; t -= __builtin_rint(t); const float rev = (float)t;
            float* dst = i < SEQ * 64 ? ROPE + 2 * (size_t)i : ROPES + 2 * fi; dst[0] = __builtin_amdgcn_cosf(rev); dst[1] = __builtin_amdgcn_sinf(rev); }
        for (int i = gt; i < MT; i += NGT) { SS1[i] = 0.f; SS2[i] = 0.f; SS3[i] = 0.f; }
    }
    SEAM(0);

    if (IN(1)) {
        { pg8::Gemm g{AB, Win_t, MP, NIN, D}; pg8::StaticOrder S; S.init(MP, NIN, G, blk); EpiZ E{Z};
          pg8::gemm_phase<EpiZ, pg8::StaticOrder, true, true>(lds, g, S, E); }
        auto f = [&](int s, int n, float v) { const float o = n < 3072 ? v : (n < 4096 ? silu_(v) : gelu_(v)); Z[(size_t)(MP + s) * NIN + n] = f2bf(o); };
        skinny_gemm<8>(lds, AB + (size_t)MP * D, Win_t, NIN, D, blk, G, f);
    }
    SEAM(1);

    if (IN(2)) {
        for (int pass = 0; pass < 2; ++pass) {
        if ((pass ^ (blk & 1)) == 0) {
        { LAS float* qs = (LAS float*)lds; LAS float* ks = qs + 128; LAS float* vs = ks + 128; LAS float* red = vs + 128;
          const int e4 = tid & 31, dg = tid >> 5;
          for (int u = blk; u < MS * NH; u += G) { const int s = u >> 3, h = u & 7; const bf16* zr = Z + (size_t)(MP + s) * NIN;
            const float* S0 = state_ret + (size_t)u * 16384 + 4 * e4; float* S1 = out + O_RETS + (size_t)u * 16384 + 4 * e4;
            f32x4 s0[8];
#pragma unroll
            for (int i = 0; i < 8; ++i) s0[i] = __builtin_nontemporal_load((const f32x4*)(S0 + (dg + 16 * i) * 128));
            if (tid < 64) { const float c = ROPES[2 * tid], sn = ROPES[2 * tid + 1];
                const float q1 = bf2f(zr[128 * h + tid]), q2 = bf2f(zr[128 * h + 64 + tid]), k1 = bf2f(zr[1024 + 128 * h + tid]), k2 = bf2f(zr[1024 + 128 * h + 64 + tid]);
                qs[tid] = q1 * c - q2 * sn; qs[tid + 64] = q2 * c + q1 * sn; ks[tid] = (k1 * c - k2 * sn) * 0.08838834764831845f; ks[tid + 64] = (k2 * c + k1 * sn) * 0.08838834764831845f; }
            else if (tid < 192) vs[tid - 64] = bf2f(zr[2048 + 128 * h + tid - 64]);
            unsigned gg = 0u; if (tid < 64) gg = *(const unsigned*)(zr + 3072 + 128 * h + 2 * tid);
            __syncthreads();
            const float gamma = 1.0f - __builtin_amdgcn_exp2f((float)(-5 - h));
            const f32x4 vv = *(const LAS f32x4*)(vs + 4 * e4); f32x4 o = {0.f, 0.f, 0.f, 0.f};
#pragma unroll
            for (int i = 0; i < 8; ++i) { const int d = dg + 16 * i; const f32x4 sn = s0[i] * gamma + vv * ks[d]; __builtin_nontemporal_store(sn, (f32x4*)(S1 + d * 128)); o += sn * qs[d]; }
            *(LAS f32x4*)(red + dg * 128 + 4 * e4) = o;
            __syncthreads();
            if (tid < 64) { float o0 = 0.f, o1 = 0.f;
#pragma unroll
                for (int i = 0; i < 16; ++i) { o0 += red[i * 128 + 2 * tid]; o1 += red[i * 128 + 2 * tid + 1]; }
                const float r = __builtin_amdgcn_rsqf(wave_sum(o0 * o0 + o1 * o1) * (1.0f / 128.0f) + EPS);
                *(unsigned*)(MIX + (size_t)(MP + s) * D + 128 * h + 2 * tid) = pk2(o0 * r * lo16(gg), o1 * r * hi16(gg)); }
            __syncthreads(); } }
        } else {
        { LAS bf16* Kt = (LAS bf16*)lds; LAS bf16* Vt = (LAS bf16*)(lds + TILE_B);
          for (int u = blk; u < 512; u += G) { const int b = u >> 7, h = (u >> 4) & 7, c = u & 15; const size_t R0 = (size_t)b * SEQ + 128 * c;
            RopeX kx; RopeCS cs; TileX vx;
            rope_load(kx, Z + R0 * NIN + 1024 + 128 * h, tid); rope_cs_load(cs, ROPE + (size_t)(128 * c) * 128, tid); tile_load(vx, Z + R0 * NIN + 2048 + 128 * h, tid);
            rope_commit<false, true>(Kt, kx, cs, 0.08838834764831845f, a.log2g[h], tid);
            tile_commit_N(Vt, vx, tid);
            __syncthreads();
            f32x4 acc[8];
#pragma unroll
            for (int ct = 0; ct < 8; ++ct) acc[ct] = (f32x4){0.f, 0.f, 0.f, 0.f};
            mm128_tt(acc, Kt, Vt, wave, lane);
            float* kv = KV + (size_t)u * 16384 + (16 * wave + fr) * 128 + 4 * fq;
#pragma unroll
            for (int ct = 0; ct < 8; ++ct) *(f32x4*)(kv + 16 * ct) = acc[ct];
            __syncthreads(); } }
        for (int r0 = gw; r0 < MP; r0 += 2 * NGW) { const int r1 = r0 + NGW;
            const bf16* p0 = Z + (size_t)r0 * NIN + 5120 + 16 * lane; const bf16* p1 = Z + (size_t)(r1 < MP ? r1 : r0) * NIN + 5120 + 16 * lane;
            const v4u xa0 = *(const v4u*)p0, xa1 = *(const v4u*)(p0 + 8), xb0 = *(const v4u*)p1, xb1 = *(const v4u*)(p1 + 8);
            float va[16], vb[16];
#pragma unroll
            for (int j = 0; j < 4; ++j) { va[2 * j] = lo16(xa0[j]); va[2 * j + 1] = hi16(xa0[j]); va[8 + 2 * j] = lo16(xa1[j]); va[8 + 2 * j + 1] = hi16(xa1[j]);
                                          vb[2 * j] = lo16(xb0[j]); vb[2 * j + 1] = hi16(xb0[j]); vb[8 + 2 * j] = lo16(xb1[j]); vb[8 + 2 * j + 1] = hi16(xb1[j]); }
            float sa = 0.f, sb = 0.f;
#pragma unroll
            for (int j = 0; j < 16; ++j) { sa += va[j]; sb += vb[j]; }
            const float ma = wave_sum(sa) * (1.0f / 1024.0f), mb = wave_sum(sb) * (1.0f / 1024.0f); float qa = 0.f, qb = 0.f;
#pragma unroll
            for (int j = 0; j < 16; ++j) { const float da = va[j] - ma, db = vb[j] - mb; qa += da * da; qb += db * db; }
            const float ra = __builtin_amdgcn_rsqf(wave_sum(qa) * (1.0f / 1024.0f) + EPS), rb = __builtin_amdgcn_rsqf(wave_sum(qb) * (1.0f / 1024.0f) + EPS);
            if (lane == 0) { STATS[2 * r0] = ma; STATS[2 * r0 + 1] = ra; if (r1 < MP) { STATS[2 * r1] = mb; STATS[2 * r1 + 1] = rb; } } }
        for (int row = MP + gw; row < MT; row += NGW) { const bf16* p = Z + (size_t)row * NIN + 5120 + 16 * lane; const v4u x0 = *(const v4u*)p, x1 = *(const v4u*)(p + 8);
            const int s_ = row - MP, c0 = 16 * lane, grp = lane >> 3; const float w00 = gm_ws[grp * 16384], b0 = gm_bs[grp * 128];
            const bf16* up = Z + (size_t)row * NIN + 4096 + c0; const v4u u0 = *(const v4u*)up, u1 = *(const v4u*)(up + 8);
            float v[16];
#pragma unroll
            for (int j = 0; j < 4; ++j) { v[2 * j] = lo16(x0[j]); v[2 * j + 1] = hi16(x0[j]); v[8 + 2 * j] = lo16(x1[j]); v[8 + 2 * j + 1] = hi16(x1[j]); }
            float s = 0.f;
#pragma unroll
            for (int j = 0; j < 16; ++j) s += v[j];
            const float mean = wave_sum(s) * (1.0f / 1024.0f); float q = 0.f;
#pragma unroll
            for (int j = 0; j < 16; ++j) { v[j] -= mean; q += v[j] * v[j]; }
            const float rstd = __builtin_amdgcn_rsqf(wave_sum(q) * (1.0f / 1024.0f) + EPS);
            float uu[16];
#pragma unroll
            for (int j = 0; j < 4; ++j) { uu[2 * j] = lo16(u0[j]); uu[2 * j + 1] = hi16(u0[j]); uu[8 + 2 * j] = lo16(u1[j]); uu[8 + 2 * j + 1] = hi16(u1[j]); }
            float vn[16], mo[16];
#pragma unroll
            for (int j = 0; j < 16; ++j) { vn[j] = v[j] * rstd * gm_ln_g[c0 + j] + gm_ln_b[c0 + j]; mo[j] = uu[j] * (w00 * vn[j] + b0); }
            float* gv = out + O_GMV + (size_t)s_ * 1024 + c0;
#pragma unroll
            for (int j = 0; j < 4; ++j) *(f32x4*)(gv + 4 * j) = (f32x4){vn[4 * j], vn[4 * j + 1], vn[4 * j + 2], vn[4 * j + 3]};
            v4u w0, w1;
#pragma unroll
            for (int j = 0; j < 4; ++j) { w0[j] = pk2(mo[2 * j], mo[2 * j + 1]); w1[j] = pk2(mo[8 + 2 * j], mo[8 + 2 * j + 1]); }
            bf16* mp = MIX + (size_t)row * D + 1024 + c0; *(v4u*)mp = w0; *(v4u*)(mp + 8) = w1; }
        } }
    }
    SEAM(2);

    if (IN(3)) {
        auto convert_rest = [&]() {
            LAS float* scr = (LAS float*)(lds + wave * 16640);
            constexpr int I_O = (D / 64) * (D / 64), I_UP = (D / 64) * (NUP / 64), I_DN = (DFF / 64) * (D / 64), I_G = I_O, I_P = (PLE / 64) * (D / 64);
            constexpr int NITEMS = I_O + I_UP + I_DN + I_G + I_P;
            for (int it = gw; it < NITEMS; it += NGW) {
                int r = it;
                if (r < I_UP) { transpose_item(a.in[14], D, NUP, a.in[13], Wup_t, true, scr, r, lane); continue; } r -= I_UP;
                if (r < I_O) { transpose_item(a.in[12], D, D, nullptr, Wo_t, false, scr, r, lane); continue; } r -= I_O;
                if (r < I_DN) { transpose_item(a.in[17], DFF, D, nullptr, Wdn_t, false, scr, r, lane); continue; } r -= I_DN;
                if (r < I_G) { transpose_item(a.in[19], D, D, a.in[18], Wg_t, false, scr, r, lane); continue; } r -= I_G;
                transpose_item(a.in[20], PLE, D, nullptr, Wp_t, false, scr, r, lane);
            }
            __syncthreads(); };
        if (!(blk & 1)) convert_rest();
        {
        LAS bf16* T0 = (LAS bf16*)lds; LAS bf16* T1 = (LAS bf16*)(lds + TILE_B); LAS bf16* T2 = (LAS bf16*)(lds + 2 * TILE_B); LAS bf16* T3 = (LAS bf16*)(lds + 3 * TILE_B);
        for (int u = blk; u < 512; u += G) { const int bh = u >> 4, b = bh >> 3, h = bh & 7, c = u < 256 ? (u & 15) : 15 - (u & 15); const size_t R0 = (size_t)b * SEQ + 128 * c; const float l2g = a.log2g[h];
            const int i_ = 16 * wave + fr;
            RopeX qx, kx; RopeCS cs; TileX vx; v2u gg[8];
            const float* kvb = KV + (size_t)bh * 16 * 16384;
            f32x4 tc[8];
#pragma unroll
            for (int i = 0; i < 8; ++i) tc[i] = *(const f32x4*)(kvb + 4 * (tid + 512 * i));
            rope_load(qx, Z + R0 * NIN + 128 * h, tid); rope_load(kx, Z + R0 * NIN + 1024 + 128 * h, tid); rope_cs_load(cs, ROPE + (size_t)(128 * c) * 128, tid); tile_load(vx, Z + R0 * NIN + 2048 + 128 * h, tid);
            rope_commit<false, false>(T0, qx, cs, 1.0f, 0.f, tid);
            rope_commit<false, false>(T1, kx, cs, 0.08838834764831845f, 0.f, tid);
            asm volatile("" ::: "memory");
            { const float Gc = __builtin_amdgcn_exp2f(l2g * 128.0f);
              f32x4 sp[8];
#pragma unroll
              for (int i = 0; i < 8; ++i) sp[i] = (f32x4){0.f, 0.f, 0.f, 0.f};
              for (int j = 0; j < c; ++j) { f32x4 tn[8];
#pragma unroll
                  for (int i = 0; i < 8; ++i) tn[i] = *(const f32x4*)(kvb + (size_t)(j + 1) * 16384 + 4 * (tid + 512 * i));
#pragma unroll
                  for (int i = 0; i < 8; ++i) { sp[i] = sp[i] * Gc + tc[i]; tc[i] = tn[i]; } }
              if (c == 15) {
#pragma unroll
                  for (int i = 0; i < 8; ++i) *(f32x4*)(out + O_RETP + (size_t)bh * 16384 + 4 * (tid + 512 * i)) = sp[i] * Gc + tc[i]; }
#pragma unroll
              for (int i = 0; i < 8; ++i) { const int ch = tid + 512 * i, d = ch >> 5, e4 = ch & 31; v2u w; w.x = pk2(sp[i][0], sp[i][1]); w.y = pk2(sp[i][2], sp[i][3]);
                  *(LAS v2u*)(T3 + d * LDP + 4 * e4) = w; } }
            tile_commit_N(T2, vx, tid);
            __syncthreads();
            { const bf16* gp = Z + (R0 + i_) * NIN + 3072 + 128 * h + 4 * fq;
#pragma unroll
              for (int ct = 0; ct < 8; ++ct) gg[ct] = *(const v2u*)(gp + 16 * ct); }
            f32x4 acc2[8], acc1[8];
#pragma unroll
            for (int ct = 0; ct < 8; ++ct) { acc2[ct] = (f32x4){0.f, 0.f, 0.f, 0.f}; acc1[ct] = (f32x4){0.f, 0.f, 0.f, 0.f}; }
            mm128_nt(acc2, T0, T3, wave, lane);
            mm128(acc1, T0, T1, wave, fr, fq);
            __syncthreads();
#pragma unroll
            for (int ct = 0; ct < 8; ++ct) { float sv[4];
#pragma unroll
                for (int t = 0; t < 4; ++t) { const int j = 16 * ct + 4 * fq + t; sv[t] = i_ >= j ? acc1[ct][t] * __builtin_amdgcn_exp2f(l2g * (float)(i_ - j)) : 0.f; }
                v2u w; w.x = pk2(sv[0], sv[1]); w.y = pk2(sv[2], sv[3]); *(LAS v2u*)(T1 + i_ * LDP + 16 * ct + 4 * fq) = w; }
            __syncthreads();
#pragma unroll
            for (int ct = 0; ct < 8; ++ct) acc1[ct] = (f32x4){0.f, 0.f, 0.f, 0.f};
            mm128_nt(acc1, T1, T2, wave, lane);
            const float qd = __builtin_amdgcn_exp2f(l2g * (float)(i_ + 1)); float ssq = 0.f;
#pragma unroll
            for (int ct = 0; ct < 8; ++ct) { acc1[ct] = acc1[ct] + acc2[ct] * qd; ssq += (acc1[ct][0] * acc1[ct][0] + acc1[ct][1] * acc1[ct][1]) + (acc1[ct][2] * acc1[ct][2] + acc1[ct][3] * acc1[ct][3]); }
            ssq += __shfl_xor(ssq, 16); ssq += __shfl_xor(ssq, 32);
            const float rn = __builtin_amdgcn_rsqf(ssq * (1.0f / 128.0f) + EPS);
            bf16* mp = MIX + (R0 + i_) * D + 128 * h + 4 * fq;
#pragma unroll
            for (int ct = 0; ct < 8; ++ct) { v2u w;
                w.x = pk2(acc1[ct][0] * rn * lo16(gg[ct].x), acc1[ct][1] * rn * hi16(gg[ct].x)); w.y = pk2(acc1[ct][2] * rn * lo16(gg[ct].y), acc1[ct][3] * rn * hi16(gg[ct].y)); *(v2u*)(mp + 16 * ct) = w; }
            __syncthreads(); }
        for (int u = blk; u < 512; u += G) { const int b = u >> 7, c = (u >> 3) & 15, grp = u & 7; const size_t R0 = (size_t)b * SEQ + 128 * c;
            const int t_ = 16 * wave + fr, d8 = tid & 15;
            f32x4 wl[4][2]; v4u xv[4]; float st[4][2]; v2u uu[8]; float lg[8], lb[8];
#pragma unroll
            for (int it = 0; it < 4; ++it) { const int idx = tid + 512 * it, t = idx >> 4; const float* wp = gm_ws + (size_t)grp * 16384 + t * 128 + 8 * d8;
                wl[it][0] = *(const f32x4*)wp; wl[it][1] = *(const f32x4*)(wp + 4);
                xv[it] = *(const v4u*)(Z + (R0 + t) * NIN + 5120 + 128 * grp + 8 * d8); st[it][0] = STATS[2 * (R0 + t)]; st[it][1] = STATS[2 * (R0 + t) + 1]; }
#pragma unroll
            for (int j = 0; j < 8; ++j) { lg[j] = gm_ln_g[128 * grp + 8 * d8 + j]; lb[j] = gm_ln_b[128 * grp + 8 * d8 + j]; }
            const float bsv = gm_bs[grp * 128 + t_];
#pragma unroll
            for (int it = 0; it < 4; ++it) { const int idx = tid + 512 * it, t = idx >> 4;
                float wv[8] = {wl[it][0][0], wl[it][0][1], wl[it][0][2], wl[it][0][3], wl[it][1][0], wl[it][1][1], wl[it][1][2], wl[it][1][3]};
#pragma unroll
                for (int j = 0; j < 8; ++j) if (8 * d8 + j > t) wv[j] = 0.f;
                v4u w; w.x = pk2(wv[0], wv[1]); w.y = pk2(wv[2], wv[3]); w.z = pk2(wv[4], wv[5]); w.w = pk2(wv[6], wv[7]); *(LAS v4u*)(T0 + t * LDP + 8 * d8) = w;
                const float mean = st[it][0], rstd = st[it][1];
                v4u vw;
#pragma unroll
                for (int p = 0; p < 4; ++p) vw[p] = pk2((lo16(xv[it][p]) - mean) * rstd * lg[2 * p] + lb[2 * p], (hi16(xv[it][p]) - mean) * rstd * lg[2 * p + 1] + lb[2 * p + 1]);
                *(LAS v4u*)(T1 + t * LDP + 8 * d8) = vw; }
            __syncthreads();
            { const bf16* up = Z + (R0 + t_) * NIN + 4096 + 128 * grp + 4 * fq;
#pragma unroll
              for (int ct = 0; ct < 8; ++ct) uu[ct] = *(const v2u*)(up + 16 * ct); }
            f32x4 acc[8];
#pragma unroll
            for (int ct = 0; ct < 8; ++ct) acc[ct] = (f32x4){0.f, 0.f, 0.f, 0.f};
            mm128_nt(acc, T0, T1, wave, lane);
            bf16* mp = MIX + (R0 + t_) * D + 1024 + 128 * grp + 4 * fq;
#pragma unroll
            for (int ct = 0; ct < 8; ++ct) { v2u w;
                w.x = pk2((acc[ct][0] + bsv) * lo16(uu[ct].x), (acc[ct][1] + bsv) * hi16(uu[ct].x)); w.y = pk2((acc[ct][2] + bsv) * lo16(uu[ct].y), (acc[ct][3] + bsv) * hi16(uu[ct].y)); *(v2u*)(mp + 16 * ct) = w; }
            __syncthreads(); }
        }
        if (blk & 1) convert_rest();
    }
    SEAM(3);

    if (IN(4)) {
        { pg8::Gemm g{MIX, Wo_t, MP, D, D}; pg8::StaticOrder S; S.init(MP, D, G, blk); EpiRes<false> E{x_p, AB, SS1};
          pg8::gemm_phase<EpiRes<false>, pg8::StaticOrder, true, true>(lds, g, S, E); }
        auto f = [&](int s, int n, float v) { const float o = x_s[(size_t)s * D + n] + v; AB[(size_t)(MP + s) * D + n] = f2bf(o);
            const float q = half_wave_sum(o * o); if ((lane & 31) == 0) atomic_addf(SS1 + MP + s, q); };
        skinny_gemm<2>(lds, MIX + (size_t)MP * D, Wo_t, D, D, blk, G, f);
    }
    SEAM(4);

    if (IN(5)) {
        { pg8::Gemm g{AB, Wup_t, MP, NUP, D}; pg8::StaticOrder S; S.init(MP, NUP, G, blk); EpiUp E{ACT, RAW, SS1, conv_w, conv_b, (LAS float*)(lds + 131072)};
          pg8::gemm_phase<EpiUp, pg8::StaticOrder, true, true>(lds, g, S, E); }
        { pg8::Gemm g{AB, Wup_t, MP + 256, NUP, D}; SampleOrder S{(blk >= 128 && blk - 128 < NUP / 256) ? blk - 128 : -1}; EpiAS E{AS, SS1};
          pg8::gemm_phase<EpiAS, SampleOrder, true, true>(lds, g, S, E); }
        { int Kp = PLE; asm volatile("" : "+s"(Kp));
          constexpr int nbusy = (MP / 256 * (NUP / 256) + NUP / 256) - 5 * 256;
          pg8::Gemm g{PB, Wp_t, MP + 256, D, Kp}; ProjOrder S{blk >= nbusy ? blk - nbusy : -1, 256 - nbusy}; EpiPP E{PP};
          pg8::gemm_phase<EpiPP, ProjOrder, true, true>(lds, g, S, E); }
    }
    SEAM(5);

    if (IN(6)) {
        for (int i = gt; i < 128 * 2 * (DFF / 4); i += NGT) { const int c4 = i % (DFF / 4), gr = i / (DFF / 4), rr = gr & 1, Gp = gr >> 1, c = 4 * c4; const bool first = (Gp & 31) == 0;
            const float* rg = RAW + (size_t)Gp * 4 * NUP; const float* rp = rg - 4 * NUP; const f32x4 z4 = {0.f, 0.f, 0.f, 0.f};
            f32x4 a0g, a0u, a1g, a1u, a2g, a2u;
            a0g = *(const f32x4*)(rg + (2 + rr) * NUP + c); a0u = *(const f32x4*)(rg + (2 + rr) * NUP + DFF + c);
            if (rr) { a1g = *(const f32x4*)(rg + 2 * NUP + c); a1u = *(const f32x4*)(rg + 2 * NUP + DFF + c); a2g = first ? z4 : *(const f32x4*)(rp + NUP + c); a2u = first ? z4 : *(const f32x4*)(rp + NUP + DFF + c); }
            else { a1g = first ? z4 : *(const f32x4*)(rp + NUP + c); a1u = first ? z4 : *(const f32x4*)(rp + NUP + DFF + c); a2g = first ? z4 : *(const f32x4*)(rp + c); a2u = first ? z4 : *(const f32x4*)(rp + DFF + c); }
            const f32x4 ag = *(const f32x4*)(conv_w + c) * a2g + *(const f32x4*)(conv_w + NUP + c) * a1g + *(const f32x4*)(conv_w + 2 * NUP + c) * a0g + *(const f32x4*)(conv_b + c);
            const f32x4 au = *(const f32x4*)(conv_w + DFF + c) * a2u + *(const f32x4*)(conv_w + NUP + DFF + c) * a1u + *(const f32x4*)(conv_w + 2 * NUP + DFF + c) * a0u + *(const f32x4*)(conv_b + DFF + c);
            v2u w; w.x = pk2(silu_(ag[0]) * au[0], silu_(ag[1]) * au[1]); w.y = pk2(silu_(ag[2]) * au[2], silu_(ag[3]) * au[3]);
            *(v2u*)(ACT + (size_t)(64 * Gp + rr) * DFF + c) = w; }
        for (int i = gt; i < MS * (DFF / 4); i += NGT) { const int c4 = i % (DFF / 4), s = i / (DFF / 4), c = 4 * c4;
            const float* sc0 = state_conv + (size_t)s * 2 * NUP; const float* sc1 = sc0 + NUP; const float* as = AS + (size_t)s * NUP;
            const f32x4 a0g = *(const f32x4*)(as + c), a0u = *(const f32x4*)(as + DFF + c), a1g = *(const f32x4*)(sc1 + c), a1u = *(const f32x4*)(sc1 + DFF + c), a2g = *(const f32x4*)(sc0 + c), a2u = *(const f32x4*)(sc0 + DFF + c);
            const f32x4 ag = *(const f32x4*)(conv_w + c) * a2g + *(const f32x4*)(conv_w + NUP + c) * a1g + *(const f32x4*)(conv_w + 2 * NUP + c) * a0g + *(const f32x4*)(conv_b + c);
            const f32x4 au = *(const f32x4*)(conv_w + DFF + c) * a2u + *(const f32x4*)(conv_w + NUP + DFF + c) * a1u + *(const f32x4*)(conv_w + 2 * NUP + DFF + c) * a0u + *(const f32x4*)(conv_b + DFF + c);
            v2u w; w.x = pk2(silu_(ag[0]) * au[0], silu_(ag[1]) * au[1]); w.y = pk2(silu_(ag[2]) * au[2], silu_(ag[3]) * au[3]);
            *(v2u*)(ACT + (size_t)(MP + s) * DFF + c) = w;
            float* cs = out + O_CONVS + (size_t)s * 2 * NUP; *(f32x4*)(cs + c) = a1g; *(f32x4*)(cs + DFF + c) = a1u; *(f32x4*)(cs + NUP + c) = a0g; *(f32x4*)(cs + NUP + DFF + c) = a0u; }
        for (int i = gt; i < 4 * 2 * (NUP / 4); i += NGT) { const int c4 = i % (NUP / 4), bk = i / (NUP / 4), b = bk >> 1, k = bk & 1;
            *(f32x4*)(out + O_CONVP + (size_t)bk * NUP + 4 * c4) = *(const f32x4*)(RAW + ((size_t)(32 * b + 31) * 4 + k) * NUP + 4 * c4); }
    }
    SEAM(6);

    if (IN(7)) {
        { pg8::Gemm g{ACT, Wdn_t, MP, D, DFF}; pg8::StaticOrder S; S.init(MP, D, G, blk); EpiRes<true> E{nullptr, AB, SS2};
          pg8::gemm_phase<EpiRes<true>, pg8::StaticOrder, true, true>(lds, g, S, E); }
        auto f = [&](int s, int n, float v) { const size_t o_ = (size_t)(MP + s) * D + n; const float o = bf2f(AB[o_]) + v; AB[o_] = f2bf(o);
            const float q = half_wave_sum(o * o); if ((lane & 31) == 0) atomic_addf(SS2 + MP + s, q); };
        skinny_gemm<2>(lds, ACT + (size_t)MP * DFF, Wdn_t, D, DFF, blk, G, f);
    }
    SEAM(7);

    if (IN(8)) {
#ifndef T_B
        { pg8::Gemm g{AB, Wg_t, MP, D, D}; pg8::StaticOrder S; S.init(MP, D, G, blk); EpiGate E{PP, AB, out, SS2, SS3};
          pg8::gemm_phase<EpiGate, pg8::StaticOrder, true, true>(lds, g, S, E); }
#endif
#ifndef T_D
        auto f2 = [&](int s, int n, float v) { const size_t o_ = (size_t)(MP + s) * D + n; const float r2 = __builtin_amdgcn_rsqf(SS2[MP + s] * (1.0f / D) + EPS);
            const float o = bf2f(AB[o_]) + bf2f(PP[o_]) * sigmoid_(r2 * v); out[o_] = o; const float q = half_wave_sum(o * o); if ((lane & 31) == 0) atomic_addf(SS3 + MP + s, q); };
        skinny_gemm<2>(lds, AB + (size_t)MP * D, Wg_t, D, D, blk, G, f2);
#endif
    }
    SEAM(8);

    if (IN(9)) {
        { const f32x4* gr = (const f32x4*)g_final + lane; f32x4 gv[8];
#pragma unroll
          for (int j = 0; j < 8; ++j) gv[j] = gr[64 * j];
          for (int m0 = gw; m0 < MT; m0 += 2 * NGW) { const int m1 = m0 + NGW; const bool two = m1 < MT;
            f32x4* h0 = (f32x4*)(out + (size_t)m0 * D) + lane; f32x4* h1 = (f32x4*)(out + (size_t)(two ? m1 : m0) * D) + lane;
            f32x4 a0[8], a1[8];
#pragma unroll
            for (int j = 0; j < 8; ++j) { a0[j] = h0[64 * j]; a1[j] = h1[64 * j]; }
            const float r0 = __builtin_amdgcn_rsqf(SS3[m0] * (1.0f / D) + EPS), r1 = __builtin_amdgcn_rsqf(SS3[two ? m1 : m0] * (1.0f / D) + EPS);
#pragma unroll
            for (int j = 0; j < 8; ++j) h0[64 * j] = a0[j] * gv[j] * r0;
            if (two) {
#pragma unroll
                for (int j = 0; j < 8; ++j) h1[64 * j] = a1[j] * gv[j] * r1; } } }
    }
#undef IN
#undef SEAM
}
#undef x_p
#undef x_s
#undef p_p
#undef p_s
#undef state_ret
#undef state_conv
#undef gm_ln_g
#undef gm_ln_b
#undef gm_ws
#undef gm_bs
#undef conv_w
#undef conv_b
#undef g_final
#undef out
#undef SS1
#undef SS2
#undef SS3
#undef STATS
#undef ROPE
#undef ROPES
#undef Win_t
#undef Wo_t
#undef Wup_t
#undef Wdn_t
#undef Wg_t
#undef Wp_t
#undef AB
#undef PB
#undef MIX
#undef Z
#undef ACT
#undef KV
#undef PP
#undef RAW
#undef AS

extern "C" void kernel_launch(void* const* d_in, const int* in_sizes, int n_in, void* d_out, int out_size, void* d_ws, size_t ws_size, hipStream_t stream) {
    static int grid = 0;
    if (grid == 0) {
        if (n_in != 22 || out_size != (int)O_END || ws_size < WS_END) { fprintf(stderr, "kernel_launch: unexpected shapes: n_in %d out %d ws %zu\n", n_in, out_size, ws_size); grid = -1; return; }
        int dev = 0, cus = 0, per_cu = 0;
        if (hipGetDevice(&dev) != hipSuccess || hipDeviceGetAttribute(&cus, hipDeviceAttributeMultiprocessorCount, dev) != hipSuccess) { grid = -1; return; }
        if (hipFuncSetAttribute((const void*)mk_fwd, hipFuncAttributeMaxDynamicSharedMemorySize, LDS_BYTES) != hipSuccess) { fprintf(stderr, "kernel_launch: hipFuncSetAttribute failed\n"); grid = -1; return; }
        if (hipOccupancyMaxActiveBlocksPerMultiprocessor(&per_cu, (const void*)mk_fwd, 512, LDS_BYTES) != hipSuccess || per_cu < 1) fprintf(stderr, "kernel_launch: occupancy query says %d\n", per_cu);
        (void)hipGetLastError();
        grid = cus;
        if (grid != 256) fprintf(stderr, "kernel_launch: %d CUs (built for 256)\n", grid);
    }
    if (grid < 0) return;
    if (hipMemsetAsync((char*)d_ws + WS_BAR, 0, BAR_BYTES, stream) != hipSuccess) { fprintf(stderr, "kernel_launch: memset failed\n"); return; }
    Params p{};
    for (int i = 0; i < 22; ++i) p.in[i] = (const float*)d_in[i];
    p.out = (float*)d_out; p.ws = (unsigned char*)d_ws;
    for (int h = 0; h < 8; ++h) p.log2g[h] = (float)std::log2(1.0 - std::exp2(-5.0 - (double)h));
    for (int i = 0; i < 64; ++i) p.invf[i] = powf(10000.0f, -(float)i / 64.0f);
    p.use_cg = 0; p.pad = 0;
#if MK_N_LAUNCHES == 1
    void* args[] = {&p};
#ifdef PROBE_K
    p.ph_lo = 0; p.ph_hi = PROBE_K + 1;
    (void)hipLaunchCooperativeKernel((const void*)mk_fwd, dim3(grid), dim3(512), args, LDS_BYTES, stream);
    if (hipMemsetAsync((char*)d_ws + WS_BAR, 0, BAR_BYTES, stream) != hipSuccess) return;
#endif
    p.ph_lo = 0; p.ph_hi = NPHASE;
    hipError_t e = hipLaunchCooperativeKernel((const void*)mk_fwd, dim3(grid), dim3(512), args, LDS_BYTES, stream);
    if (e != hipSuccess) fprintf(stderr, "kernel_launch: cooperative launch failed: %s\n", hipGetErrorString(e));
#else
    for (int ph = 0; ph < NPHASE; ++ph) { p.ph_lo = ph; p.ph_hi = ph + 1; hipLaunchKernelGGL(mk_fwd, dim3(grid), dim3(512), LDS_BYTES, stream, p); }
#endif
}
```

```cpp
#include <hip/hip_runtime.h>
#include <hip/hip_cooperative_groups.h>
#include <cstdio>
#include <cstdint>
#include <cmath>
namespace cg = cooperative_groups;

#ifndef MK_N_LAUNCHES
#define MK_N_LAUNCHES 1
#endif

namespace pg8 {
#define PG8_LAS __attribute__((address_space(3)))
typedef unsigned short bf16_t;
typedef short bf16x8 __attribute__((ext_vector_type(8)));
typedef float f32x4 __attribute__((ext_vector_type(4)));
typedef unsigned u32x4 __attribute__((ext_vector_type(4)));
constexpr int BM = 256, BK = 64, HALF = 128, HTB = HALF * BK * 2  , STAGE_BYTES = 8 * HTB, NXCD = 8, WGM = 8;

__host__ __device__ __forceinline__ int lds_byte(int r, int c) { const int st = (r >> 4) * 2 + (c >> 5), rr = r & 15, cc = c & 31, ob = rr * 64 + cc * 2; return st * 1024 + (ob ^ (((ob >> 9) & 1) << 5)); }
__host__ __device__ __forceinline__ void stage_rc(int b, int& R, int& C) { const int st = b / 1024, sb = b % 1024, swz = sb ^ (((sb >> 9) & 1) << 5); R = (st >> 1) * 16 + swz / 64; C = (st & 1) * 32 + (swz % 64) / 2; }
__host__ __device__ __forceinline__ int perm32(int rho) { const int n = rho >> 4, i = rho & 15; return 8 * (i >> 2) + 4 * n + (i & 3); }

struct Unit { int pm, pn; };
struct Gemm { const bf16_t* A; const bf16_t* Bt; int M, N, K; };

struct StaticOrder {
    int nM, nN, nwg, G, c;
    __host__ __device__ void init(int M, int N, int G_, int c_) { nM = M / BM; nN = N / BM; nwg = nM * nN; G = G_; c = c_; }
    __host__ __device__ bool next(int i, Unit& u) const {
        const long L = (long)i * G + c; if (L >= nwg) return false;
        int wgid = (int)L; { const int q = nwg / NXCD, r = nwg % NXCD, xcd = wgid % NXCD, off = wgid / NXCD; wgid = (xcd < r ? xcd * (q + 1) : r * (q + 1) + (xcd - r) * q) + off; }
        const int nig = WGM * nN, gid = wgid / nig, fm = gid * WGM, gsz = (nM - fm) < WGM ? (nM - fm) : WGM;
        u.pm = fm + ((wgid % nig) % gsz); u.pn = (wgid % nig) / gsz; return true;
    }
    __device__ __forceinline__ void a_ready(const Unit&) const {}
    __device__ __forceinline__ void done(const Unit&) const {}
};

__device__ __forceinline__ unsigned cvt_pk_bf16(float lo, float hi) { unsigned r; asm volatile("v_cvt_pk_bf16_f32 %0, %1, %2" : "=v"(r) : "v"(lo), "v"(hi)); return r; }
typedef float f32x2 __attribute__((ext_vector_type(2)));

template <class Epi, class Sched, bool ALIGN_EPI = false, bool SP2 = false>
__device__ __forceinline__ void gemm_phase(PG8_LAS unsigned char* lds, const Gemm g, const Sched& S, const Epi& E) {
    const int tid = threadIdx.x, wid = __builtin_amdgcn_readfirstlane(tid >> 6), lane = tid & 63, wr = wid >> 2, wc = wid & 3, fr = lane & 15, fq = lane >> 4;
    const int K = g.K, nt = K / BK;
    unsigned voffA[2], voffB[2];
#pragma unroll
    for (int i = 0; i < 2; ++i) { int R, C; stage_rc(tid * 16 + i * 8192, R, C); const int Rb = Epi::PERM ? ((R & ~31) + perm32(R & 31)) : R;
        voffA[i] = (unsigned)(R * K + C) * 2u; voffB[i] = (unsigned)(Rb * K + C) * 2u; }
    const size_t kstep = (size_t)(BK * 2);
    const size_t hstep = (size_t)HALF * K * 2;
    const size_t tstep = 2 * hstep;
    const unsigned ldsw = (unsigned)wid * 1024u;
    const int aoff = lds_byte(wr * 64 + fr, fq * 8), boff = lds_byte(wc * 32 + fr, fq * 8);
#define PG8_SA(b, h) (((b) * 2 + (h)) * HTB)
#define PG8_SB(b, h) ((4 + (b) * 2 + (h)) * HTB)
#define PG8_STAGE(bufoff, gbase, voff) do { _Pragma("unroll") for (int _i = 0; _i < 2; ++_i) \
        __builtin_amdgcn_global_load_lds((const unsigned*)((const char*)(gbase) + (voff)[_i]), (PG8_LAS unsigned*)(lds + (bufoff) + ldsw + _i * 8192), 16, 0, 0); } while (0)
#define PG8_LDA(dst, b, h) do { _Pragma("unroll") for (int m = 0; m < 4; ++m) _Pragma("unroll") for (int k = 0; k < 2; ++k) dst[m][k] = *(const PG8_LAS bf16x8*)(lds + PG8_SA(b, h) + aoff + m * 2048 + k * 1024); } while (0)
#define PG8_LDB(dst, b, h) do { _Pragma("unroll") for (int n = 0; n < 2; ++n) _Pragma("unroll") for (int k = 0; k < 2; ++k) dst[n][k] = *(const PG8_LAS bf16x8*)(lds + PG8_SB(b, h) + boff + n * 2048 + k * 1024); } while (0)
#define PG8_MMA(ai, bj, At, Bt) do { __builtin_amdgcn_s_setprio(1); _Pragma("unroll") for (int m = 0; m < 4; ++m) _Pragma("unroll") for (int n = 0; n < 2; ++n) _Pragma("unroll") for (int k = 0; k < 2; ++k) \
        acc[ai][bj][m][n] = __builtin_amdgcn_mfma_f32_16x16x32_bf16(Bt[n][k], At[m][k], acc[ai][bj][m][n], 0, 0, 0); __builtin_amdgcn_s_setprio(0); } while (0)
#define PG8_WAIT_V(n) asm volatile("s_waitcnt vmcnt(" #n ")" ::: "memory")
#define PG8_WAIT_L(n) asm volatile("s_waitcnt lgkmcnt(" #n ")" ::: "memory")
#define PG8_BAR __builtin_amdgcn_s_barrier()
#define PG8_SCHED __builtin_amdgcn_sched_barrier(0)
    Unit cur, nxt; int ui = 0;
    if (!S.next(0, cur)) return;
    f32x4 acc[2][2][4][2];
#pragma unroll
    for (int a = 0; a < 2; ++a)
#pragma unroll
        for (int b = 0; b < 2; ++b)
#pragma unroll
            for (int m = 0; m < 4; ++m)
#pragma unroll
                for (int n = 0; n < 2; ++n) acc[a][b][m][n] = (f32x4){0.f, 0.f, 0.f, 0.f};
    bf16x8 At[4][2], B0[2][2], B1[2][2];
    const char* cA = (const char*)g.A + (size_t)cur.pm * tstep; const char* cB = (const char*)g.Bt + (size_t)cur.pn * tstep;
    S.a_ready(cur);
    if constexpr (SP2) {
        PG8_STAGE(PG8_SB(0, 0), cB, voffB); PG8_STAGE(PG8_SB(0, 1), cB + hstep, voffB); PG8_STAGE(PG8_SA(0, 0), cA, voffA); PG8_STAGE(PG8_SA(0, 1), cA + hstep, voffA);
        if (wr == 1) PG8_BAR;
        PG8_WAIT_V(2); PG8_BAR;
        PG8_STAGE(PG8_SB(1, 0), cB + kstep, voffB); PG8_STAGE(PG8_SA(1, 0), cA + kstep, voffA); PG8_STAGE(PG8_SB(1, 1), cB + hstep + kstep, voffB);
        PG8_WAIT_V(6); PG8_BAR;
    } else {
        PG8_STAGE(PG8_SB(0, 0), cB, voffB); PG8_STAGE(PG8_SA(0, 0), cA, voffA); PG8_STAGE(PG8_SB(0, 1), cB + hstep, voffB); PG8_STAGE(PG8_SA(0, 1), cA + hstep, voffA);
        if (wr == 1) PG8_BAR;
        PG8_WAIT_V(4); PG8_BAR;
        PG8_STAGE(PG8_SB(1, 0), cB + kstep, voffB); PG8_STAGE(PG8_SA(1, 0), cA + kstep, voffA); PG8_STAGE(PG8_SB(1, 1), cB + hstep + kstep, voffB);
        PG8_WAIT_V(6); PG8_BAR;
    }
    for (;;) {
        const bool has_next = S.next(ui + 1, nxt);
        const char* nA = has_next ? (const char*)g.A + (size_t)nxt.pm * tstep : cA; const char* nB = has_next ? (const char*)g.Bt + (size_t)nxt.pn * tstep : cB;
        for (int t = 0; t < nt; t += 2) {
            const bool last = (t == nt - 2);
            const char* a1 = cA + (size_t)(t + 1) * kstep;
            const char* a2 = last ? nA : cA + (size_t)(t + 2) * kstep; const char* b2 = last ? nB : cB + (size_t)(t + 2) * kstep;
            const char* a3 = a2 + kstep; const char* b3 = b2 + kstep;
            if (last && has_next) S.a_ready(nxt);
            if constexpr (SP2) {
            PG8_LDB(B0, 0, 0); PG8_LDB(B1, 0, 1); PG8_SCHED; PG8_LDA(At, 0, 0); PG8_STAGE(PG8_SA(1, 1), a1 + hstep, voffA);
            PG8_WAIT_V(8); PG8_WAIT_L(0); PG8_BAR; PG8_MMA(0, 0, At, B0); PG8_MMA(0, 1, At, B1); PG8_BAR; PG8_SCHED;
            PG8_LDA(At, 0, 1); PG8_STAGE(PG8_SB(0, 0), b2, voffB); PG8_STAGE(PG8_SB(0, 1), b2 + hstep, voffB); PG8_STAGE(PG8_SA(0, 0), a2, voffA);
            PG8_WAIT_V(8); PG8_WAIT_L(0); PG8_BAR; PG8_MMA(1, 0, At, B0); PG8_MMA(1, 1, At, B1); PG8_BAR; PG8_SCHED;
            PG8_LDB(B0, 1, 0); PG8_LDB(B1, 1, 1); PG8_SCHED; PG8_LDA(At, 1, 0); PG8_STAGE(PG8_SA(0, 1), a2 + hstep, voffA);
            PG8_WAIT_V(8); PG8_WAIT_L(0); PG8_BAR; PG8_MMA(0, 0, At, B0); PG8_MMA(0, 1, At, B1); PG8_BAR; PG8_SCHED;
            PG8_LDA(At, 1, 1); PG8_STAGE(PG8_SB(1, 0), b3, voffB); PG8_STAGE(PG8_SB(1, 1), b3 + hstep, voffB); PG8_STAGE(PG8_SA(1, 0), a3, voffA);
            PG8_WAIT_V(8); PG8_WAIT_L(0); PG8_BAR; PG8_MMA(1, 0, At, B0); PG8_MMA(1, 1, At, B1); PG8_BAR; PG8_SCHED;
            } else {
            PG8_LDB(B0, 0, 0); PG8_SCHED; PG8_LDA(At, 0, 0); PG8_STAGE(PG8_SA(1, 1), a1 + hstep, voffA);
            PG8_WAIT_L(8); PG8_BAR; PG8_WAIT_L(0); PG8_MMA(0, 0, At, B0); PG8_BAR; PG8_SCHED;
            PG8_LDB(B1, 0, 1); PG8_STAGE(PG8_SB(0, 0), b2, voffB);
            PG8_BAR; PG8_WAIT_L(0); PG8_MMA(0, 1, At, B1); PG8_BAR;
            PG8_LDA(At, 0, 1); PG8_STAGE(PG8_SA(0, 0), a2, voffA);
            PG8_BAR; PG8_WAIT_L(0); PG8_MMA(1, 0, At, B0); PG8_BAR; PG8_SCHED;
            PG8_STAGE(PG8_SB(0, 1), b2 + hstep, voffB);
            PG8_WAIT_V(6); PG8_BAR; PG8_MMA(1, 1, At, B1); PG8_BAR;
            PG8_LDB(B0, 1, 0); PG8_SCHED; PG8_LDA(At, 1, 0); PG8_STAGE(PG8_SA(0, 1), a2 + hstep, voffA);
            PG8_WAIT_L(8); PG8_BAR; PG8_WAIT_L(0); PG8_MMA(0, 0, At, B0); PG8_BAR; PG8_SCHED;
            PG8_LDB(B1, 1, 1); PG8_STAGE(PG8_SB(1, 0), b3, voffB);
            PG8_BAR; PG8_WAIT_L(0); PG8_MMA(0, 1, At, B1); PG8_BAR;
            PG8_LDA(At, 1, 1); PG8_STAGE(PG8_SA(1, 0), a3, voffA);
            PG8_BAR; PG8_WAIT_L(0); PG8_MMA(1, 0, At, B0); PG8_BAR; PG8_SCHED;
            PG8_STAGE(PG8_SB(1, 1), b3 + hstep, voffB);
            PG8_WAIT_V(6); PG8_BAR; PG8_MMA(1, 1, At, B1); PG8_BAR;
            }
        }
        if constexpr (ALIGN_EPI) { if (wr == 0) PG8_BAR; }
        if constexpr (!Epi::AFTER_DRAIN) { E(acc, cur, wr, wc, fr, fq); S.done(cur); }
        if (!has_next) break;
#pragma unroll
        for (int a = 0; a < 2; ++a)
#pragma unroll
            for (int b = 0; b < 2; ++b)
#pragma unroll
                for (int m = 0; m < 4; ++m)
#pragma unroll
                    for (int n = 0; n < 2; ++n) acc[a][b][m][n] = (f32x4){0.f, 0.f, 0.f, 0.f};
        cur = nxt; cA = nA; cB = nB; ++ui;
        if constexpr (ALIGN_EPI) { if (wr == 1) PG8_BAR; }
    }
    PG8_WAIT_V(0);
    if constexpr (!ALIGN_EPI) { if (wr == 0) PG8_BAR; }
    PG8_BAR;
    if constexpr (Epi::AFTER_DRAIN) { E.fused(acc, cur, wr, wc, fr, fq, lds, wid, lane); S.done(cur); }
#undef PG8_SA
#undef PG8_SB
#undef PG8_STAGE
#undef PG8_LDA
#undef PG8_LDB
#undef PG8_MMA
#undef PG8_WAIT_V
#undef PG8_WAIT_L
#undef PG8_BAR
#undef PG8_SCHED
}
}

#define GAS __attribute__((address_space(1)))
#define LAS __attribute__((address_space(3)))
typedef unsigned short bf16;
typedef unsigned v4u __attribute__((ext_vector_type(4)));
typedef unsigned v2u __attribute__((ext_vector_type(2)));
typedef float f32x4 __attribute__((ext_vector_type(4)));
typedef float f32x2 __attribute__((ext_vector_type(2)));
typedef short bf16x8 __attribute__((ext_vector_type(8)));
#define XB_TMO      128
#define XB_XCNT(j)  (256  + 64 * (j))
#define XB_XSUB(j)  (1280 + 64 * (j))
#define XB_XGEN(j)  (2304 + 64 * (j))
#define XB_TOP      3328
#define XB_TOPGEN   3392
#define XCD_BAR_WORDS 3456
#define XB_SPIN_CAP (1u << 18)

__device__ __forceinline__ unsigned xb_ld(unsigned* p)              { return __hip_atomic_load(p, __ATOMIC_RELAXED, __HIP_MEMORY_SCOPE_AGENT); }
__device__ __forceinline__ unsigned xb_add(unsigned* p, unsigned v) { return __hip_atomic_fetch_add(p, v, __ATOMIC_RELAXED, __HIP_MEMORY_SCOPE_AGENT); }
__device__ __forceinline__ unsigned xb_xcc_id() { return (unsigned)__builtin_amdgcn_s_getreg((3 << 11) | 20) & 0xFu; }
#define XB_SPIN(cond, bar) do { unsigned _sp = 0; while (cond) { __builtin_amdgcn_s_sleep(1); \
    if ((++_sp & 255u) == 0u) { if (xb_ld(&(bar)[XB_TMO])) break; if (_sp > XB_SPIN_CAP) { atomicAdd(&(bar)[XB_TMO], 1u); break; } } } } while (0)

struct XcdBarrier {
    unsigned* bar; unsigned x;
    volatile LAS unsigned* st;
};

__device__ __forceinline__ XcdBarrier xcd_barrier_post(unsigned* bar, volatile LAS unsigned* st) {
    XcdBarrier b; b.bar = bar; b.x = xb_xcc_id(); b.st = st;
    if (threadIdx.x == 0) (void)xb_add(&bar[XB_XCNT(b.x)], 1u);
    return b;
}
__device__ __forceinline__ void xcd_barrier_complete(unsigned* bar, unsigned x, unsigned& nloc, unsigned& nx) {
    const unsigned G = gridDim.x * gridDim.y * gridDim.z;
    unsigned sum, cnt, mine, sp = 0u;
    for (;;) {
        sum = 0u; cnt = 0u; mine = 0u;
#pragma unroll
        for (unsigned j = 0; j < 16; ++j) { const unsigned c = xb_ld(&bar[XB_XCNT(j)]); sum += c; cnt += (c > 0u) ? 1u : 0u; mine = (j == x) ? c : mine; }
        if (sum == G) break;
        __builtin_amdgcn_s_sleep(1);
        if ((++sp & 255u) == 0u) { if (xb_ld(&bar[XB_TMO])) break; if (sp > XB_SPIN_CAP) { atomicAdd(&bar[XB_TMO], 1u); break; } }
    }
    nloc = mine > 0u ? mine : 1u; nx = cnt > 0u ? cnt : 1u;
}

__device__ __forceinline__ void xcd_barrier(const XcdBarrier& b) {
    asm volatile("s_waitcnt vmcnt(0)" ::: "memory");
    __syncthreads();
    if (threadIdx.x == 0) {
        unsigned* bar = b.bar;
        __builtin_amdgcn_s_waitcnt(0);
        unsigned nloc = b.st[0], nx = b.st[1];
        if (nloc == 0u) { xcd_barrier_complete(bar, b.x, nloc, nx); b.st[0] = nloc; b.st[1] = nx; }
        const unsigned old = xb_add(&bar[XB_XSUB(b.x)], 1u);
        const unsigned gen = old / nloc;
        if (old + 1u == (gen + 1u) * nloc) {
            __builtin_amdgcn_fence(__ATOMIC_RELEASE, "agent");
            asm volatile("s_waitcnt vmcnt(0)" ::: "memory");
            const unsigned og = xb_add(&bar[XB_TOP], 1u);
            const unsigned tg = og / nx;
            if (og + 1u == (tg + 1u) * nx) xb_add(&bar[XB_TOPGEN], 1u);
            else XB_SPIN(xb_ld(&bar[XB_TOPGEN]) == tg, bar);
            __builtin_amdgcn_fence(__ATOMIC_ACQUIRE, "agent");
            xb_add(&bar[XB_XGEN(b.x)], 1u);
            asm volatile("s_waitcnt vmcnt(0)" ::: "memory");
        } else {
            XB_SPIN(xb_ld(&bar[XB_XGEN(b.x)]) == gen, bar);
            __builtin_amdgcn_fence(__ATOMIC_ACQUIRE, "agent");
            asm volatile("s_waitcnt vmcnt(0)" ::: "memory");
        }
    }
    __syncthreads();
}

constexpr int MP = 8192, MS = 128, MT = MP + MS, D = 2048, NIN = 6144, NUP = 11264, DFF = 5632, PLE = 256, SEQ = 2048, NH = 8;
constexpr float EPS = 1e-6f;
constexpr int NPHASE = 10;
constexpr size_t MiB = 1u << 20;
constexpr size_t WS_BAR = 0, BAR_BYTES = 16384;
constexpr size_t WS_SS1 = 64 * 1024, WS_SS2 = 128 * 1024, WS_SS3 = 192 * 1024, WS_STATS = 256 * 1024;
constexpr size_t WS_RINV = 384 * 1024;
constexpr size_t WS_ROPE = 1 * MiB, WS_ROPES = 2 * MiB;
constexpr size_t WS_WIN = 4 * MiB, WS_WO = 28 * MiB, WS_WUP = 36 * MiB, WS_WDN = 80 * MiB, WS_WG = 102 * MiB, WS_WP = 110 * MiB;
constexpr size_t WS_AB = 112 * MiB, WS_PB = 145 * MiB, WS_MIX = 150 * MiB, WS_Z = 183 * MiB, WS_ACT = 183 * MiB, WS_KV = 281 * MiB, WS_PP = 281 * MiB;
constexpr size_t WS_RAW = 313 * MiB, WS_AS = 335 * MiB, WS_END = 346 * MiB;
static_assert(WS_AB + (size_t)MT * D * 2 <= WS_PB && WS_PB + (size_t)MT * PLE * 2 <= WS_MIX && WS_MIX + (size_t)MT * D * 2 <= WS_Z, "ws map 1");
static_assert(WS_Z + (size_t)MT * NIN * 2 <= WS_KV && WS_ACT + (size_t)MT * DFF * 2 <= WS_KV && WS_KV + (size_t)512 * 16384 * 4 <= WS_RAW, "ws map 2");
static_assert(WS_RAW + (size_t)128 * 4 * NUP * 4 <= WS_AS && WS_AS + (size_t)MS * NUP * 4 <= WS_END && WS_PP + (size_t)MT * D * 4 <= WS_END, "ws map 3");
constexpr size_t O_RETP = 17039360, O_CONVP = 17563648, O_RETS = 17653760, O_CONVS = 34430976, O_GMV = 37314560, O_END = 37445632;
constexpr int LDS_BYTES = 147456, MISC_OFF = LDS_BYTES - 256;
constexpr int LDP = 136;
constexpr int TILE_B = 128 * LDP * 2;

struct Params { const float* in[22]; float* out; unsigned char* ws; float log2g[8]; float invf[64]; int ph_lo, ph_hi, use_cg, pad; };

#define LDS_WAIT() asm volatile("s_waitcnt lgkmcnt(0)" ::: "memory")
__device__ __forceinline__ float lo16(unsigned u) { return __uint_as_float(u << 16); }
__device__ __forceinline__ float hi16(unsigned u) { return __uint_as_float(u & 0xffff0000u); }
__device__ __forceinline__ float bf2f(bf16 b) { return __uint_as_float((unsigned)b << 16); }
__device__ __forceinline__ unsigned pk2(float lo, float hi) { return pg8::cvt_pk_bf16(lo, hi); }
__device__ __forceinline__ bf16 f2bf(float f) { return (bf16)(pg8::cvt_pk_bf16(f, 0.f) & 0xffffu); }
__device__ __forceinline__ float sigmoid_(float x) { return __builtin_amdgcn_rcpf(1.0f + __builtin_amdgcn_exp2f(-1.44269504089f * x)); }
__device__ __forceinline__ float silu_(float x) { return x * sigmoid_(x); }
__device__ __forceinline__ float gelu_(float x) { return x * sigmoid_(1.5957691216f * (x + 0.044715f * x * x * x)); }
__device__ __forceinline__ float wave_sum(float v) {
#pragma unroll
    for (int o = 1; o < 64; o <<= 1) v += __shfl_xor(v, o);
    return v;
}
__device__ __forceinline__ void atomic_addf(float* p, float v) { (void)__hip_atomic_fetch_add(p, v, __ATOMIC_RELAXED, __HIP_MEMORY_SCOPE_AGENT); }
template <int CTRL> __device__ __forceinline__ float dppf(float x) { return __int_as_float(__builtin_amdgcn_mov_dpp(__float_as_int(x), CTRL, 0xf, 0xf, false)); }

using pg8::Unit;
struct EpiZ {
    static constexpr bool PERM = true, AFTER_DRAIN = false;
    bf16* Z;
    __device__ __forceinline__ void operator()(const f32x4 (&acc)[2][2][4][2], const Unit& u, int wr, int wc, int fr, int fq) const {
        const int row0 = u.pm * 256 + wr * 64 + fr, col0 = u.pn * 256 + wc * 32 + 8 * fq;
        const int mode = u.pn < 12 ? 0 : (u.pn < 16 ? 1 : 2);
#pragma unroll
        for (int ai = 0; ai < 2; ++ai)
#pragma unroll
            for (int m = 0; m < 4; ++m) { bf16* rowp = Z + (size_t)(row0 + ai * 128 + m * 16) * NIN + col0;
#pragma unroll
                for (int bj = 0; bj < 2; ++bj) { f32x4 v0 = acc[ai][bj][m][0], v1 = acc[ai][bj][m][1];
                    if (mode == 1) {
#pragma unroll
                        for (int j = 0; j < 4; ++j) { v0[j] = silu_(v0[j]); v1[j] = silu_(v1[j]); } }
                    else if (mode == 2) {
#pragma unroll
                        for (int j = 0; j < 4; ++j) { v0[j] = gelu_(v0[j]); v1[j] = gelu_(v1[j]); } }
                    v4u w; w.x = pk2(v0[0], v0[1]); w.y = pk2(v0[2], v0[3]); w.z = pk2(v1[0], v1[1]); w.w = pk2(v1[2], v1[3]);
                    *(v4u*)(rowp + bj * 128) = w; } }
    }
};
template <int BASE_BF16> struct EpiRes {
    const float* rowscale;
    static constexpr bool PERM = true, AFTER_DRAIN = false;
    const float* base; bf16* hb; float* ss;
    __device__ __forceinline__ void operator()(const f32x4 (&acc)[2][2][4][2], const Unit& u, int wr, int wc, int fr, int fq) const {
        const int row0 = u.pm * 256 + wr * 64 + fr, col0 = u.pn * 256 + wc * 32 + 8 * fq;
        float sacc[2][4];
#pragma unroll
        for (int ai = 0; ai < 2; ++ai) {
            f32x4 bs[BASE_BF16 ? 1 : 4][2][2]; v4u bw[4][2]; float rsc[4];
#pragma unroll
            for (int m = 0; m < 4; ++m) { rsc[m] = BASE_BF16 == 2 ? rowscale[row0 + ai * 128 + m * 16] : 1.0f;
#pragma unroll
                for (int bj = 0; bj < 2; ++bj) { const size_t o_ = (size_t)(row0 + ai * 128 + m * 16) * D + col0 + bj * 128;
                    if (BASE_BF16) bw[m][bj] = *(const v4u*)(hb + o_);
                    else { bs[m][bj][0] = *(const f32x4*)(base + o_); bs[m][bj][1] = *(const f32x4*)(base + o_ + 4); } } }
#pragma unroll
            for (int m = 0; m < 4; ++m) { const size_t off = (size_t)(row0 + ai * 128 + m * 16) * D + col0; float s = 0.f;
#pragma unroll
                for (int bj = 0; bj < 2; ++bj) { f32x4 b0, b1;
                    if (BASE_BF16) { const v4u w = bw[m][bj]; b0 = (f32x4){lo16(w.x), hi16(w.x), lo16(w.y), hi16(w.y)}; b1 = (f32x4){lo16(w.z), hi16(w.z), lo16(w.w), hi16(w.w)};
                        if (BASE_BF16 == 2) { b0 *= rsc[m]; b1 *= rsc[m]; } }
                    else { b0 = bs[m][bj][0]; b1 = bs[m][bj][1]; }
                    const f32x4 o0 = b0 + acc[ai][bj][m][0], o1 = b1 + acc[ai][bj][m][1];
                    v4u w; w.x = pk2(o0[0], o0[1]); w.y = pk2(o0[2], o0[3]); w.z = pk2(o1[0], o1[1]); w.w = pk2(o1[2], o1[3]); *(v4u*)(hb + off + bj * 128) = w;
                    s += ((o0[0] * o0[0] + o0[1] * o0[1]) + (o0[2] * o0[2] + o0[3] * o0[3])) + ((o1[0] * o1[0] + o1[1] * o1[1]) + (o1[2] * o1[2] + o1[3] * o1[3])); }
                s += __shfl_xor(s, 16); s += __shfl_xor(s, 32); sacc[ai][m] = s; }
            asm volatile("" ::: "memory"); }
        if (fq == 0) {
#pragma unroll
            for (int ai = 0; ai < 2; ++ai)
#pragma unroll
                for (int m = 0; m < 4; ++m) atomic_addf(ss + row0 + ai * 128 + m * 16, sacc[ai][m]); }
    }
};
struct EpiPP {
    static constexpr bool PERM = true, AFTER_DRAIN = false;
    bf16* pp;
    __device__ __forceinline__ void operator()(const f32x4 (&acc)[2][2][4][2], const Unit& u, int wr, int wc, int fr, int fq) const {
        const int row0 = u.pm * 256 + wr * 64 + fr, col0 = u.pn * 256 + wc * 32 + 8 * fq;
#pragma unroll
        for (int ai = 0; ai < 2; ++ai)
#pragma unroll
            for (int m = 0; m < 4; ++m) { if (row0 + ai * 128 + m * 16 >= MT) continue; bf16* rowp = pp + (size_t)(row0 + ai * 128 + m * 16) * D + col0;
#pragma unroll
                for (int bj = 0; bj < 2; ++bj) { const f32x4 v0 = acc[ai][bj][m][0], v1 = acc[ai][bj][m][1]; v4u w; w.x = pk2(v0[0], v0[1]); w.y = pk2(v0[2], v0[3]); w.z = pk2(v1[0], v1[1]); w.w = pk2(v1[2], v1[3]); *(v4u*)(rowp + bj * 128) = w; } }
    }
};
struct EpiGate {
    static constexpr bool PERM = true, AFTER_DRAIN = false;
    const bf16* pp; const bf16* hb; float* h; const float* ss2; float* ss3;
    __device__ __forceinline__ void operator()(const f32x4 (&acc)[2][2][4][2], const Unit& u, int wr, int wc, int fr, int fq) const {
        const int row0 = u.pm * 256 + wr * 64 + fr, col0 = u.pn * 256 + wc * 32 + 8 * fq;
        float sacc[2][4];
#pragma unroll
        for (int ai = 0; ai < 2; ++ai) {
            v4u hw[4][2], pw[4][2]; float r2[4];
#pragma unroll
            for (int m = 0; m < 4; ++m) { const int row = row0 + ai * 128 + m * 16; r2[m] = ss2[row];
#pragma unroll
                for (int bj = 0; bj < 2; ++bj) { hw[m][bj] = *(const v4u*)(hb + (size_t)row * D + col0 + bj * 128); pw[m][bj] = *(const v4u*)(pp + (size_t)row * D + col0 + bj * 128); } }
#pragma unroll
            for (int m = 0; m < 4; ++m) { const size_t off = (size_t)(row0 + ai * 128 + m * 16) * D + col0; float s = 0.f;
                const float rr = __builtin_amdgcn_rsqf(r2[m] * (1.0f / D) + EPS);
#pragma unroll
                for (int bj = 0; bj < 2; ++bj) { const v4u h4 = hw[m][bj], p4 = pw[m][bj];
                    const f32x4 hv0 = {lo16(h4.x), hi16(h4.x), lo16(h4.y), hi16(h4.y)}, hv1 = {lo16(h4.z), hi16(h4.z), lo16(h4.w), hi16(h4.w)};
                    const f32x4 pv0 = {lo16(p4.x), hi16(p4.x), lo16(p4.y), hi16(p4.y)}, pv1 = {lo16(p4.z), hi16(p4.z), lo16(p4.w), hi16(p4.w)};
                    const f32x4 a0 = acc[ai][bj][m][0], a1 = acc[ai][bj][m][1]; f32x4 o0, o1;
#pragma unroll
                    for (int j = 0; j < 4; ++j) { o0[j] = hv0[j] + pv0[j] * sigmoid_(rr * a0[j]); o1[j] = hv1[j] + pv1[j] * sigmoid_(rr * a1[j]); }
                    *(f32x4*)(h + off + bj * 128) = o0; *(f32x4*)(h + off + bj * 128 + 4) = o1;
                    s += ((o0[0] * o0[0] + o0[1] * o0[1]) + (o0[2] * o0[2] + o0[3] * o0[3])) + ((o1[0] * o1[0] + o1[1] * o1[1]) + (o1[2] * o1[2] + o1[3] * o1[3])); }
                s += __shfl_xor(s, 16); s += __shfl_xor(s, 32); sacc[ai][m] = s; }
            asm volatile("" ::: "memory"); }
        if (fq == 0) {
#pragma unroll
            for (int ai = 0; ai < 2; ++ai)
#pragma unroll
                for (int m = 0; m < 4; ++m) atomic_addf(ss3 + row0 + ai * 128 + m * 16, sacc[ai][m]); }
    }
};
struct EpiUp {
    static constexpr bool PERM = false, AFTER_DRAIN = false;
    bf16* act; float* raw; const float* ss1; const float* cw; const float* cb; LAS float* wl;
    __device__ __forceinline__ void operator()(const f32x4 (&acc)[2][2][4][2], const Unit& u, int wr, int wc, int fr, int fq) const {
        const int row0 = u.pm * 256 + wr * 64 + fr;
        LAS float* wb = wl + (wr * 4 + wc) * 256;
        { const int l = fq * 16 + fr, v = l >> 3, c4 = l & 7;
          const float* src = ((v & 3) == 3 ? cb : cw + (v & 3) * NUP) + (v >> 2) * DFF + u.pn * 128 + wc * 32 + 4 * c4;
          *(LAS f32x4*)(wb + v * 32 + 4 * c4) = *(const f32x4*)src; }
        float rs[2][4];
#pragma unroll
        for (int ai = 0; ai < 2; ++ai)
#pragma unroll
            for (int m = 0; m < 4; ++m) rs[ai][m] = __builtin_amdgcn_rsqf(ss1[row0 + ai * 128 + m * 16] * (1.0f / D) + EPS);
#pragma unroll
        for (int n = 0; n < 2; ++n) {
            const int cg_ = u.pn * 128 + wc * 32 + 16 * n + 4 * fq;
            const volatile LAS f32x4* wv = (const volatile LAS f32x4*)(wb + 16 * n + 4 * fq);
#pragma unroll
            for (int ai = 0; ai < 2; ++ai) {
                f32x4 l1g = {0.f, 0.f, 0.f, 0.f}, l2g = l1g, l1u = l1g, l2u = l1g;
#pragma unroll
                for (int m = 0; m < 4; ++m) {
                    const int row = row0 + ai * 128 + m * 16;
                    f32x4 sg;
                    { const f32x4 g = acc[ai][0][m][n] * rs[ai][m];
                      if (m == 0 && fr < 2) *(f32x4*)(raw + ((size_t)(row >> 6) * 4 + 2 + fr) * NUP + cg_) = g;
                      if (m == 3 && fr >= 14) *(f32x4*)(raw + ((size_t)(row >> 6) * 4 + (fr - 14)) * NUP + cg_) = g;
                      f32x4 r1, r2, x1, x2;
#pragma unroll
                      for (int j = 0; j < 4; ++j) { r1[j] = dppf<0x121>(g[j]); r2[j] = dppf<0x122>(g[j]); }
#pragma unroll
                      for (int j = 0; j < 4; ++j) { x1[j] = fr == 0 ? l1g[j] : r1[j]; x2[j] = fr < 2 ? l2g[j] : r2[j]; }
                      l1g = r1; l2g = r2;
                      const f32x4 w0 = wv[0], w1 = wv[8], w2 = wv[16], bb = wv[24];
                      const f32x4 ag = w0 * x2 + w1 * x1 + w2 * g + bb;
#pragma unroll
                      for (int j = 0; j < 4; ++j) sg[j] = silu_(ag[j]);
                      asm volatile("" : "+v"(sg)); }
                    f32x4 o;
                    { const f32x4 up = acc[ai][1][m][n] * rs[ai][m];
                      if (m == 0 && fr < 2) *(f32x4*)(raw + ((size_t)(row >> 6) * 4 + 2 + fr) * NUP + DFF + cg_) = up;
                      if (m == 3 && fr >= 14) *(f32x4*)(raw + ((size_t)(row >> 6) * 4 + (fr - 14)) * NUP + DFF + cg_) = up;
                      f32x4 r1, r2, x1, x2;
#pragma unroll
                      for (int j = 0; j < 4; ++j) { r1[j] = dppf<0x121>(up[j]); r2[j] = dppf<0x122>(up[j]); }
#pragma unroll
                      for (int j = 0; j < 4; ++j) { x1[j] = fr == 0 ? l1u[j] : r1[j]; x2[j] = fr < 2 ? l2u[j] : r2[j]; }
                      l1u = r1; l2u = r2;
                      const f32x4 w0 = wv[32], w1 = wv[40], w2 = wv[48], bb = wv[56];
                      o = (w0 * x2 + w1 * x1 + w2 * up + bb) * sg; }
                    v2u w; w.x = pk2(o[0], o[1]); w.y = pk2(o[2], o[3]);
                    *(v2u*)(act + (size_t)row * DFF + cg_) = w; } } }
    }
};

struct EpiAS {
    static constexpr bool PERM = false, AFTER_DRAIN = false;
    float* as; const float* ss1;
    __device__ __forceinline__ void operator()(const f32x4 (&acc)[2][2][4][2], const Unit& u, int wr, int wc, int fr, int fq) const {
#pragma unroll
        for (int m = 0; m < 4; ++m) { const int s_ = wr * 64 + m * 16 + fr; const float r = __builtin_amdgcn_rsqf(ss1[MP + s_] * (1.0f / D) + EPS);
#pragma unroll
            for (int n = 0; n < 2; ++n) { const int cg_ = u.pn * 128 + wc * 32 + 16 * n + 4 * fq;
                *(f32x4*)(as + (size_t)s_ * NUP + cg_) = acc[0][0][m][n] * r; *(f32x4*)(as + (size_t)s_ * NUP + DFF + cg_) = acc[0][1][m][n] * r; } }
    }
};
struct SampleOrder {
    int idx;
    __device__ __forceinline__ bool next(int i, Unit& u) const { if (i != 0 || idx < 0) return false; u.pm = MP / 256; u.pn = idx; return true; }
    __device__ __forceinline__ void a_ready(const Unit&) const {}
    __device__ __forceinline__ void done(const Unit&) const {}
};

struct ProjOrder {
    int first, nw;
    __device__ __forceinline__ bool next(int i, Unit& u) const { if (first < 0) return false; const int j = first + i * nw; if (j >= (MP / 256 + 1) * (D / 256)) return false; u.pm = j >> 3; u.pn = j & 7; return true; }
    __device__ __forceinline__ void a_ready(const Unit&) const {}
    __device__ __forceinline__ void done(const Unit&) const {}
};
template <int RT, int NK>
__device__ __forceinline__ void skinny_batch(f32x4 (&acc)[RT][2], const bf16* ap, const bf16* bp, int K) {
    bf16x8 bq[NK][2], aq[NK][RT];
#pragma unroll
    for (int kk = 0; kk < NK; ++kk) { bq[kk][0] = *(const bf16x8*)(bp + 32 * kk); bq[kk][1] = *(const bf16x8*)(bp + (size_t)16 * K + 32 * kk);
#pragma unroll
        for (int rt = 0; rt < RT; ++rt) aq[kk][rt] = *(const bf16x8*)(ap + (size_t)rt * 16 * K + 32 * kk); }
#pragma unroll
    for (int kk = 0; kk < NK; ++kk)
#pragma unroll
        for (int rt = 0; rt < RT; ++rt) { acc[rt][0] = __builtin_amdgcn_mfma_f32_16x16x32_bf16(bq[kk][0], aq[kk][rt], acc[rt][0], 0, 0, 0); acc[rt][1] = __builtin_amdgcn_mfma_f32_16x16x32_bf16(bq[kk][1], aq[kk][rt], acc[rt][1], 0, 0, 0); }
}
template <int RT, class F>
__device__ __forceinline__ void skinny_gemm(LAS unsigned char* lds, const bf16* A, const bf16* Bt, int N, int K, int u0, int ustride, const F& f) {
    const int tid = threadIdx.x, lane = tid & 63, w = tid >> 6, fr = lane & 15, fq = lane >> 4;
    constexpr int nrb = 8 / RT, ROWS = 16 * RT;
    const int nunits = nrb * (N / 32), kw = K / 8;
    LAS float* red = (LAS float*)lds;
    for (int u = u0; u < nunits; u += ustride) {
        const int rb = u % nrb, cb = u / nrb, row0 = rb * ROWS, col0 = cb * 32;
        f32x4 acc[RT][2];
#pragma unroll
        for (int rt = 0; rt < RT; ++rt) { acc[rt][0] = (f32x4){0.f, 0.f, 0.f, 0.f}; acc[rt][1] = (f32x4){0.f, 0.f, 0.f, 0.f}; }
        const bf16* ap = A + (size_t)(row0 + fr) * K + w * kw + 8 * fq;
        const bf16* bp = Bt + (size_t)(col0 + fr) * K + w * kw + 8 * fq;
        if constexpr (RT <= 2) {
            int k = 0;
            if (kw == 704) { skinny_batch<RT, 11>(acc, ap, bp, K); skinny_batch<RT, 11>(acc, ap + 352, bp + 352, K); k = 704; }
            for (; k + 256 <= kw; k += 256) skinny_batch<RT, 8>(acc, ap + k, bp + k, K);
            for (; k < kw; k += 32) skinny_batch<RT, 1>(acc, ap + k, bp + k, K);
        } else {
#pragma unroll 2
        for (int k = 0; k < kw; k += 32) {
            const bf16x8 b0 = *(const bf16x8*)(bp + k), b1 = *(const bf16x8*)(bp + (size_t)16 * K + k);
#pragma unroll
            for (int rt = 0; rt < RT; ++rt) { const bf16x8 av = *(const bf16x8*)(ap + (size_t)rt * 16 * K + k);
                acc[rt][0] = __builtin_amdgcn_mfma_f32_16x16x32_bf16(b0, av, acc[rt][0], 0, 0, 0);
                acc[rt][1] = __builtin_amdgcn_mfma_f32_16x16x32_bf16(b1, av, acc[rt][1], 0, 0, 0); }
        }
        }
#pragma unroll
        for (int rt = 0; rt < RT; ++rt)
#pragma unroll
            for (int ct = 0; ct < 2; ++ct) *(LAS f32x4*)(red + (w * ROWS + 16 * rt + fr) * 32 + 16 * ct + 4 * fq) = acc[rt][ct];
        __syncthreads();
#pragma unroll
        for (int it = 0; it < RT; ++it) { const int e = tid + 512 * it, r = e >> 5, c = e & 31; float v = 0.f;
#pragma unroll
            for (int ww = 0; ww < 8; ++ww) v += red[(ww * ROWS + r) * 32 + c];
            f(row0 + r, col0 + c, v); }
        __syncthreads();
    }
}
__device__ __forceinline__ float half_wave_sum(float v) {
#pragma unroll
    for (int o = 1; o < 32; o <<= 1) v += __shfl_xor(v, o);
    return v;
}

__device__ __forceinline__ void transpose_item(const float* W, int K, int N, const float* g, bf16* WT, bool upmap, LAS float* scr, int item, int lane) {
    const int nblk = N / 64, kb = item / nblk, nb = item % nblk, k0 = 64 * kb, n0 = 64 * nb;
    const float* src = W + (size_t)k0 * N + n0 + lane;
#pragma unroll
    for (int h = 0; h < 2; ++h) {
        float v[32];
#pragma unroll
        for (int i = 0; i < 32; ++i) v[i] = __builtin_nontemporal_load(src + (size_t)(32 * h + i) * N);
#pragma unroll
        for (int i = 0; i < 32; ++i) { float x = v[i]; if (g) x *= g[k0 + 32 * h + i]; scr[(32 * h + i) * 65 + lane] = x; }
    }
    LDS_WAIT(); asm volatile("" ::: "memory");
    const int c = lane & 7;
#pragma unroll
    for (int j = 0; j < 8; ++j) { const int n = (lane >> 3) + 8 * j; const LAS float* s = scr + (8 * c) * 65 + n;
        v4u o; o.x = pk2(s[0 * 65], s[1 * 65]); o.y = pk2(s[2 * 65], s[3 * 65]); o.z = pk2(s[4 * 65], s[5 * 65]); o.w = pk2(s[6 * 65], s[7 * 65]);
        int R = n0 + n; if (upmap) { const int half = R >= DFF ? 1 : 0, jj = R - half * DFF; R = 256 * (jj >> 7) + 128 * half + (jj & 127); }
        *(v4u*)(WT + (size_t)R * K + k0 + 8 * c) = o; }
    LDS_WAIT(); asm volatile("" ::: "memory");
}
__device__ __forceinline__ void rms_row_to_bf16(const float* xrow, bf16* orow, float* rinv, int lane) {
    const f32x4* xr = (const f32x4*)xrow + lane;
    f32x4 v[8]; float s = 0.f;
#pragma unroll
    for (int j = 0; j < 8; ++j) { v[j] = xr[64 * j]; s += (v[j][0] * v[j][0] + v[j][1] * v[j][1]) + (v[j][2] * v[j][2] + v[j][3] * v[j][3]); }
    const float ms = wave_sum(s) * (1.0f / D) + EPS, r = __builtin_amdgcn_rsqf(ms);
    if (lane == 0) *rinv = __builtin_sqrtf(ms);
    v2u* o8 = (v2u*)orow + lane;
#pragma unroll
    for (int j = 0; j < 8; ++j) { v2u w; w.x = pk2(v[j][0] * r, v[j][1] * r); w.y = pk2(v[j][2] * r, v[j][3] * r); o8[64 * j] = w; }
}

__device__ __forceinline__ void mm128(f32x4 (&acc)[8], const LAS bf16* A, const LAS bf16* B, int wave, int fr, int fq) {
#pragma unroll
    for (int ks = 0; ks < 4; ++ks) {
        const bf16x8 a = *(const LAS bf16x8*)(A + (16 * wave + fr) * LDP + 32 * ks + 8 * fq);
#pragma unroll
        for (int ct = 0; ct < 8; ++ct) { const bf16x8 b = *(const LAS bf16x8*)(B + (16 * ct + fr) * LDP + 32 * ks + 8 * fq);
            acc[ct] = __builtin_amdgcn_mfma_f32_16x16x32_bf16(b, a, acc[ct], 0, 0, 0); }
    }
}
template <bool TRANS, bool DEC>
__device__ __forceinline__ void stage_rope(LAS bf16* dst, const bf16* zb, const float* rope, float scale, float l2g, int tid) {
#pragma unroll
    for (int it = 0; it < 2; ++it) { const int idx = tid + 512 * it, j = idx >> 3, d8 = idx & 7;
        const v4u x1 = *(const v4u*)(zb + (size_t)j * NIN + 8 * d8), x2 = *(const v4u*)(zb + (size_t)j * NIN + 64 + 8 * d8);
        const f32x4* rp = (const f32x4*)(rope + (size_t)(j * 64 + 8 * d8) * 2);
        float sc = scale; if (DEC) sc *= __builtin_amdgcn_exp2f(l2g * (float)(127 - j));
        float o1[8], o2[8];
#pragma unroll
        for (int p = 0; p < 4; ++p) { const f32x4 cs = rp[p]; const float a0 = lo16(x1[p]), a1 = hi16(x1[p]), b0 = lo16(x2[p]), b1 = hi16(x2[p]);
            o1[2 * p] = (a0 * cs[0] - b0 * cs[1]) * sc; o2[2 * p] = (b0 * cs[0] + a0 * cs[1]) * sc;
            o1[2 * p + 1] = (a1 * cs[2] - b1 * cs[3]) * sc; o2[2 * p + 1] = (b1 * cs[2] + a1 * cs[3]) * sc; }
        if (!TRANS) { v4u w1, w2;
#pragma unroll
            for (int p = 0; p < 4; ++p) { w1[p] = pk2(o1[2 * p], o1[2 * p + 1]); w2[p] = pk2(o2[2 * p], o2[2 * p + 1]); }
            *(LAS v4u*)(dst + j * LDP + 8 * d8) = w1; *(LAS v4u*)(dst + j * LDP + 64 + 8 * d8) = w2; }
        else {
#pragma unroll
            for (int i = 0; i < 8; ++i) { dst[(8 * d8 + i) * LDP + j] = f2bf(o1[i]); dst[(64 + 8 * d8 + i) * LDP + j] = f2bf(o2[i]); } }
    }
}
__device__ __forceinline__ void stage_T(LAS bf16* dst, const bf16* zb, int tid) {
#pragma unroll
    for (int it = 0; it < 4; ++it) { const int idx = tid + 512 * it, j = idx >> 4, c8 = idx & 15;
        const v4u x = *(const v4u*)(zb + (size_t)j * NIN + 8 * c8);
#pragma unroll
        for (int p = 0; p < 4; ++p) { dst[(8 * c8 + 2 * p) * LDP + j] = (bf16)(x[p] & 0xffffu); dst[(8 * c8 + 2 * p + 1) * LDP + j] = (bf16)(x[p] >> 16); } }
}


struct RopeX { v4u x1[2], x2[2]; };
struct RopeCS { f32x4 cs[2][4]; };
struct TileX { v4u x[4]; };
__device__ __forceinline__ void rope_load(RopeX& r, const bf16* zb, int tid) {
#pragma unroll
    for (int it = 0; it < 2; ++it) { const int idx = tid + 512 * it, j = idx >> 3, d8 = idx & 7; r.x1[it] = *(const v4u*)(zb + (size_t)j * NIN + 8 * d8); r.x2[it] = *(const v4u*)(zb + (size_t)j * NIN + 64 + 8 * d8); }
}
__device__ __forceinline__ void rope_cs_load(RopeCS& c, const float* rope, int tid) {
#pragma unroll
    for (int it = 0; it < 2; ++it) { const int idx = tid + 512 * it, j = idx >> 3, d8 = idx & 7; const f32x4* rp = (const f32x4*)(rope + (size_t)(j * 64 + 8 * d8) * 2);
#pragma unroll
        for (int p = 0; p < 4; ++p) c.cs[it][p] = rp[p]; }
}
template <bool TRANS, bool DEC>
__device__ __forceinline__ void rope_commit(LAS bf16* dst, const RopeX& r, const RopeCS& c, float scale, float l2g, int tid) {
#pragma unroll
    for (int it = 0; it < 2; ++it) { const int idx = tid + 512 * it, j = idx >> 3, d8 = idx & 7;
        float sc = scale; if (DEC) sc *= __builtin_amdgcn_exp2f(l2g * (float)(127 - j));
        float o1[8], o2[8];
#pragma unroll
        for (int p = 0; p < 4; ++p) { const f32x4 cs = c.cs[it][p]; const float a0 = lo16(r.x1[it][p]), a1 = hi16(r.x1[it][p]), b0 = lo16(r.x2[it][p]), b1 = hi16(r.x2[it][p]);
            o1[2 * p] = (a0 * cs[0] - b0 * cs[1]) * sc; o2[2 * p] = (b0 * cs[0] + a0 * cs[1]) * sc;
            o1[2 * p + 1] = (a1 * cs[2] - b1 * cs[3]) * sc; o2[2 * p + 1] = (b1 * cs[2] + a1 * cs[3]) * sc; }
        if (!TRANS) { v4u w1, w2;
#pragma unroll
            for (int p = 0; p < 4; ++p) { w1[p] = pk2(o1[2 * p], o1[2 * p + 1]); w2[p] = pk2(o2[2 * p], o2[2 * p + 1]); }
            *(LAS v4u*)(dst + j * LDP + 8 * d8) = w1; *(LAS v4u*)(dst + j * LDP + 64 + 8 * d8) = w2; }
        else {
#pragma unroll
            for (int i = 0; i < 8; ++i) { dst[(8 * d8 + i) * LDP + j] = f2bf(o1[i]); dst[(64 + 8 * d8 + i) * LDP + j] = f2bf(o2[i]); } }
    }
}
__device__ __forceinline__ void tile_load(TileX& t, const bf16* zb, int tid) {
#pragma unroll
    for (int it = 0; it < 4; ++it) { const int idx = tid + 512 * it, j = idx >> 4, c8 = idx & 15; t.x[it] = *(const v4u*)(zb + (size_t)j * NIN + 8 * c8); }
}
__device__ __forceinline__ void tile_commit_T(LAS bf16* dst, const TileX& t, int tid) {
#pragma unroll
    for (int it = 0; it < 4; ++it) { const int idx = tid + 512 * it, j = idx >> 4, c8 = idx & 15;
#pragma unroll
        for (int p = 0; p < 4; ++p) { dst[(8 * c8 + 2 * p) * LDP + j] = (bf16)(t.x[it][p] & 0xffffu); dst[(8 * c8 + 2 * p + 1) * LDP + j] = (bf16)(t.x[it][p] >> 16); } }
}

typedef short s16x4 __attribute__((ext_vector_type(4)));
__device__ __forceinline__ bf16x8 tr_frag(const LAS bf16* T, int c, int ks, int lane) {
    const int g = lane >> 4, q = (lane & 15) >> 2, p = lane & 3;
    const LAS bf16* a0 = T + (32 * ks + 8 * g + q) * LDP + 16 * c + 4 * p;
    const s16x4 lo = __builtin_amdgcn_ds_read_tr16_b64_v4i16((LAS s16x4*)a0), hi = __builtin_amdgcn_ds_read_tr16_b64_v4i16((LAS s16x4*)(a0 + 4 * LDP));
    return (bf16x8){lo[0], lo[1], lo[2], lo[3], hi[0], hi[1], hi[2], hi[3]};
}
__device__ __forceinline__ void mm128_nt(f32x4 (&acc)[8], const LAS bf16* A, const LAS bf16* B, int wave, int lane) {
    const int fr = lane & 15, fq = lane >> 4;
#pragma unroll
    for (int ks = 0; ks < 4; ++ks) {
        const bf16x8 a = *(const LAS bf16x8*)(A + (16 * wave + fr) * LDP + 32 * ks + 8 * fq);
#pragma unroll
        for (int ct = 0; ct < 8; ++ct) acc[ct] = __builtin_amdgcn_mfma_f32_16x16x32_bf16(tr_frag(B, ct, ks, lane), a, acc[ct], 0, 0, 0);
    }
}
__device__ __forceinline__ void mm128_tt(f32x4 (&acc)[8], const LAS bf16* At, const LAS bf16* Bn, int wave, int lane) {
#pragma unroll
    for (int ks = 0; ks < 4; ++ks) {
        const bf16x8 a = tr_frag(At, wave, ks, lane);
#pragma unroll
        for (int ct = 0; ct < 8; ++ct) acc[ct] = __builtin_amdgcn_mfma_f32_16x16x32_bf16(tr_frag(Bn, ct, ks, lane), a, acc[ct], 0, 0, 0);
    }
}
__device__ __forceinline__ void tile_commit_N(LAS bf16* dst, const TileX& t, int tid) {
#pragma unroll
    for (int it = 0; it < 4; ++it) { const int idx = tid + 512 * it, j = idx >> 4, c8 = idx & 15; *(LAS v4u*)(dst + j * LDP + 8 * c8) = t.x[it]; }
}

__global__ void __launch_bounds__(512, 2) mk_fwd(Params a) {
    extern __shared__ __attribute__((aligned(16))) unsigned char lds_raw[];
    LAS unsigned char* lds = (LAS unsigned char*)lds_raw;
    const int tid = threadIdx.x, lane = tid & 63, wave = __builtin_amdgcn_readfirstlane(tid >> 6), fr = lane & 15, fq = lane >> 4;
    const int G = gridDim.x, blk = blockIdx.x;
    const int gw = blk * 8 + wave, NGW = G * 8;
    const int gt = blk * 512 + tid, NGT = G * 512;
    unsigned char* ws = a.ws;
#define x_p (a.in[0])
#define x_s (a.in[1])
#define p_p (a.in[2])
#define p_s (a.in[3])
#define state_ret (a.in[4])
#define state_conv (a.in[5])
#define gm_ln_g (a.in[8])
#define gm_ln_b (a.in[9])
#define gm_ws (a.in[10])
#define gm_bs (a.in[11])
#define conv_w (a.in[15])
#define conv_b (a.in[16])
#define g_final (a.in[21])
#define out (a.out)
#define SS1 ((float*)(ws + WS_SS1))
#define SS2 ((float*)(ws + WS_SS2))
#define SS3 ((float*)(ws + WS_SS3))
#define STATS ((float*)(ws + WS_STATS))
#define ROPE ((float*)(ws + WS_ROPE))
#define ROPES ((float*)(ws + WS_ROPES))
#define Win_t ((bf16*)(ws + WS_WIN))
#define Wo_t ((bf16*)(ws + WS_WO))
#define Wup_t ((bf16*)(ws + WS_WUP))
#define Wdn_t ((bf16*)(ws + WS_WDN))
#define Wg_t ((bf16*)(ws + WS_WG))
#define Wp_t ((bf16*)(ws + WS_WP))
#define AB ((bf16*)(ws + WS_AB))
#define PB ((bf16*)(ws + WS_PB))
#define MIX ((bf16*)(ws + WS_MIX))
#define Z ((bf16*)(ws + WS_Z))
#define ACT ((bf16*)(ws + WS_ACT))
#define KV ((float*)(ws + WS_KV))
#define PP ((bf16*)(ws + WS_MIX))
#define RAW ((float*)(ws + WS_RAW))
#define AS ((float*)(ws + WS_AS))

    volatile LAS unsigned* MISC = (volatile LAS unsigned*)(lds + MISC_OFF);
    if (tid < 64) MISC[tid] = 0u;
    __syncthreads();
    XcdBarrier bar; bar.bar = (unsigned*)(ws + WS_BAR); bar.x = 0; bar.st = nullptr;
    if (MK_N_LAUNCHES == 1) bar = xcd_barrier_post((unsigned*)(ws + WS_BAR), MISC + 8);
    const int lo = a.ph_lo, hi = a.ph_hi;
#ifndef PHMASK
#define PHMASK 0xffff
#endif
#define IN(k) (((PHMASK >> (k)) & 1) && lo <= (k) && (k) < hi)
#define SEAM(k) do { if (IN(k) && IN((k) + 1)) { if (a.use_cg) cg::this_grid().sync(); else xcd_barrier(bar); } } while (0)

    if (IN(0)) {
        LAS float* scr = (LAS float*)(lds + wave * 16640);
        constexpr int I_IN = (D / 64) * (NIN / 64);
        for (int it = gw; it < I_IN; it += NGW) transpose_item(a.in[7], D, NIN, a.in[6], Win_t, false, scr, it, lane);
        for (int m = gw; m < MT; m += NGW) rms_row_to_bf16(m < MP ? x_p + (size_t)m * D : x_s + (size_t)(m - MP) * D, AB + (size_t)m * D, (float*)(ws + WS_RINV) + m, lane);
        for (int i = gt; i < MT * PLE / 4; i += NGT) { const f32x4 v = i < MP * PLE / 4 ? ((const f32x4*)p_p)[i] : ((const f32x4*)p_s)[i - MP * PLE / 4]; v2u w; w.x = pk2(v[0], v[1]); w.y = pk2(v[2], v[3]); ((v2u*)PB)[i] = w; }
        for (int i = gt; i < SEQ * 64 + 64; i += NGT) { const int pos = i < SEQ * 64 ? (i >> 6) : 16384, fi = i & 63;
            const float ang = (float)pos * a.invf[fi]; double t = (double)ang * 0.15915494309189535; t -= __builtin_rint(t); const float rev = (float)t;
            float* dst = i < SEQ * 64 ? ROPE + 2 * (size_t)i : ROPES + 2 * fi; dst[0] = __builtin_amdgcn_cosf(rev); dst[1] = __builtin_amdgcn_sinf(rev); }
        for (int i = gt; i < MT; i += NGT) { SS1[i] = 0.f; SS2[i] = 0.f; SS3[i] = 0.f; }
    }
    SEAM(0);

    if (IN(1)) {
        { pg8::Gemm g{AB, Win_t, MP, NIN, D}; pg8::StaticOrder S; S.init(MP, NIN, G, blk); EpiZ E{Z};
          pg8::gemm_phase<EpiZ, pg8::StaticOrder, true, true>(lds, g, S, E); }
        auto f = [&](int s, int n, float v) { const float o = n < 3072 ? v : (n < 4096 ? silu_(v) : gelu_(v)); Z[(size_t)(MP + s) * NIN + n] = f2bf(o); };
        skinny_gemm<8>(lds, AB + (size_t)MP * D, Win_t, NIN, D, blk, G, f);
    }
    SEAM(1);

    if (IN(2)) {
        for (int pass = 0; pass < 2; ++pass) {
        if ((pass ^ (blk & 1)) == 0) {
        { LAS float* qs = (LAS float*)lds; LAS float* ks = qs + 128; LAS float* vs = ks + 128; LAS float* red = vs + 128;
          const int e4 = tid & 31, dg = tid >> 5;
          for (int u = blk; u < MS * NH; u += G) { const int s = u >> 3, h = u & 7; const bf16* zr = Z + (size_t)(MP + s) * NIN;
            const float* S0 = state_ret + (size_t)u * 16384 + 4 * e4; float* S1 = out + O_RETS + (size_t)u * 16384 + 4 * e4;
            f32x4 s0[8];
#pragma unroll
            for (int i = 0; i < 8; ++i) s0[i] = __builtin_nontemporal_load((const f32x4*)(S0 + (dg + 16 * i) * 128));
            if (tid < 64) { const float c = ROPES[2 * tid], sn = ROPES[2 * tid + 1];
                const float q1 = bf2f(zr[128 * h + tid]), q2 = bf2f(zr[128 * h + 64 + tid]), k1 = bf2f(zr[1024 + 128 * h + tid]), k2 = bf2f(zr[1024 + 128 * h + 64 + tid]);
                qs[tid] = q1 * c - q2 * sn; qs[tid + 64] = q2 * c + q1 * sn; ks[tid] = (k1 * c - k2 * sn) * 0.08838834764831845f; ks[tid + 64] = (k2 * c + k1 * sn) * 0.08838834764831845f; }
            else if (tid < 192) vs[tid - 64] = bf2f(zr[2048 + 128 * h + tid - 64]);
            unsigned gg = 0u; if (tid < 64) gg = *(const unsigned*)(zr + 3072 + 128 * h + 2 * tid);
            __syncthreads();
            const float gamma = 1.0f - __builtin_amdgcn_exp2f((float)(-5 - h));
            const f32x4 vv = *(const LAS f32x4*)(vs + 4 * e4); f32x4 o = {0.f, 0.f, 0.f, 0.f};
#pragma unroll
            for (int i = 0; i < 8; ++i) { const int d = dg + 16 * i; const f32x4 sn = s0[i] * gamma + vv * ks[d]; __builtin_nontemporal_store(sn, (f32x4*)(S1 + d * 128)); o += sn * qs[d]; }
            *(LAS f32x4*)(red + dg * 128 + 4 * e4) = o;
            __syncthreads();
            if (tid < 64) { float o0 = 0.f, o1 = 0.f;
#pragma unroll
                for (int i = 0; i < 16; ++i) { o0 += red[i * 128 + 2 * tid]; o1 += red[i * 128 + 2 * tid + 1]; }
                const float r = __builtin_amdgcn_rsqf(wave_sum(o0 * o0 + o1 * o1) * (1.0f / 128.0f) + EPS);
                *(unsigned*)(MIX + (size_t)(MP + s) * D + 128 * h + 2 * tid) = pk2(o0 * r * lo16(gg), o1 * r * hi16(gg)); }
            __syncthreads(); } }
        } else {
        { LAS bf16* Kt = (LAS bf16*)lds; LAS bf16* Vt = (LAS bf16*)(lds + TILE_B);
          for (int u = blk; u < 512; u += G) { const int b = u >> 7, h = (u >> 4) & 7, c = u & 15; const size_t R0 = (size_t)b * SEQ + 128 * c;
            RopeX kx; RopeCS cs; TileX vx;
            rope_load(kx, Z + R0 * NIN + 1024 + 128 * h, tid); rope_cs_load(cs, ROPE + (size_t)(128 * c) * 128, tid); tile_load(vx, Z + R0 * NIN + 2048 + 128 * h, tid);
            rope_commit<false, true>(Kt, kx, cs, 0.08838834764831845f, a.log2g[h], tid);
            tile_commit_N(Vt, vx, tid);
            __syncthreads();
            f32x4 acc[8];
#pragma unroll
            for (int ct = 0; ct < 8; ++ct) acc[ct] = (f32x4){0.f, 0.f, 0.f, 0.f};
            mm128_tt(acc, Kt, Vt, wave, lane);
            float* kv = KV + (size_t)u * 16384 + (16 * wave + fr) * 128 + 4 * fq;
#pragma unroll
            for (int ct = 0; ct < 8; ++ct) *(f32x4*)(kv + 16 * ct) = acc[ct];
            __syncthreads(); } }
        for (int r0 = gw; r0 < MP; r0 += 2 * NGW) { const int r1 = r0 + NGW;
            const bf16* p0 = Z + (size_t)r0 * NIN + 5120 + 16 * lane; const bf16* p1 = Z + (size_t)(r1 < MP ? r1 : r0) * NIN + 5120 + 16 * lane;
            const v4u xa0 = *(const v4u*)p0, xa1 = *(const v4u*)(p0 + 8), xb0 = *(const v4u*)p1, xb1 = *(const v4u*)(p1 + 8);
            float va[16], vb[16];
#pragma unroll
            for (int j = 0; j < 4; ++j) { va[2 * j] = lo16(xa0[j]); va[2 * j + 1] = hi16(xa0[j]); va[8 + 2 * j] = lo16(xa1[j]); va[8 + 2 * j + 1] = hi16(xa1[j]);
                                          vb[2 * j] = lo16(xb0[j]); vb[2 * j + 1] = hi16(xb0[j]); vb[8 + 2 * j] = lo16(xb1[j]); vb[8 + 2 * j + 1] = hi16(xb1[j]); }
            float sa = 0.f, sb = 0.f;
#pragma unroll
            for (int j = 0; j < 16; ++j) { sa += va[j]; sb += vb[j]; }
            const float ma = wave_sum(sa) * (1.0f / 1024.0f), mb = wave_sum(sb) * (1.0f / 1024.0f); float qa = 0.f, qb = 0.f;
#pragma unroll
            for (int j = 0; j < 16; ++j) { const float da = va[j] - ma, db = vb[j] - mb; qa += da * da; qb += db * db; }
            const float ra = __builtin_amdgcn_rsqf(wave_sum(qa) * (1.0f / 1024.0f) + EPS), rb = __builtin_amdgcn_rsqf(wave_sum(qb) * (1.0f / 1024.0f) + EPS);
            if (lane == 0) { STATS[2 * r0] = ma; STATS[2 * r0 + 1] = ra; if (r1 < MP) { STATS[2 * r1] = mb; STATS[2 * r1 + 1] = rb; } } }
        for (int row = MP + gw; row < MT; row += NGW) { const bf16* p = Z + (size_t)row * NIN + 5120 + 16 * lane; const v4u x0 = *(const v4u*)p, x1 = *(const v4u*)(p + 8);
            const int s_ = row - MP, c0 = 16 * lane, grp = lane >> 3; const float w00 = gm_ws[grp * 16384], b0 = gm_bs[grp * 128];
            const bf16* up = Z + (size_t)row * NIN + 4096 + c0; const v4u u0 = *(const v4u*)up, u1 = *(const v4u*)(up + 8);
            float v[16];
#pragma unroll
            for (int j = 0; j < 4; ++j) { v[2 * j] = lo16(x0[j]); v[2 * j + 1] = hi16(x0[j]); v[8 + 2 * j] = lo16(x1[j]); v[8 + 2 * j + 1] = hi16(x1[j]); }
            float s = 0.f;
#pragma unroll
            for (int j = 0; j < 16; ++j) s += v[j];
            const float mean = wave_sum(s) * (1.0f / 1024.0f); float q = 0.f;
#pragma unroll
            for (int j = 0; j < 16; ++j) { v[j] -= mean; q += v[j] * v[j]; }
            const float rstd = __builtin_amdgcn_rsqf(wave_sum(q) * (1.0f / 1024.0f) + EPS);
            float uu[16];
#pragma unroll
            for (int j = 0; j < 4; ++j) { uu[2 * j] = lo16(u0[j]); uu[2 * j + 1] = hi16(u0[j]); uu[8 + 2 * j] = lo16(u1[j]); uu[8 + 2 * j + 1] = hi16(u1[j]); }
            float vn[16], mo[16];
#pragma unroll
            for (int j = 0; j < 16; ++j) { vn[j] = v[j] * rstd * gm_ln_g[c0 + j] + gm_ln_b[c0 + j]; mo[j] = uu[j] * (w00 * vn[j] + b0); }
            float* gv = out + O_GMV + (size_t)s_ * 1024 + c0;
#pragma unroll
            for (int j = 0; j < 4; ++j) *(f32x4*)(gv + 4 * j) = (f32x4){vn[4 * j], vn[4 * j + 1], vn[4 * j + 2], vn[4 * j + 3]};
            v4u w0, w1;
#pragma unroll
            for (int j = 0; j < 4; ++j) { w0[j] = pk2(mo[2 * j], mo[2 * j + 1]); w1[j] = pk2(mo[8 + 2 * j], mo[8 + 2 * j + 1]); }
            bf16* mp = MIX + (size_t)row * D + 1024 + c0; *(v4u*)mp = w0; *(v4u*)(mp + 8) = w1; }
        } }
    }
    SEAM(2);

    if (IN(3)) {
        auto convert_rest = [&]() {
            LAS float* scr = (LAS float*)(lds + wave * 16640);
            constexpr int I_O = (D / 64) * (D / 64), I_UP = (D / 64) * (NUP / 64), I_DN = (DFF / 64) * (D / 64), I_G = I_O, I_P = (PLE / 64) * (D / 64);
            constexpr int NITEMS = I_O + I_UP + I_DN + I_G + I_P;
            for (int it = gw; it < NITEMS; it += NGW) {
                int r = it;
                if (r < I_UP) { transpose_item(a.in[14], D, NUP, a.in[13], Wup_t, true, scr, r, lane); continue; } r -= I_UP;
                if (r < I_O) { transpose_item(a.in[12], D, D, nullptr, Wo_t, false, scr, r, lane); continue; } r -= I_O;
                if (r < I_DN) { transpose_item(a.in[17], DFF, D, nullptr, Wdn_t, false, scr, r, lane); continue; } r -= I_DN;
                if (r < I_G) { transpose_item(a.in[19], D, D, a.in[18], Wg_t, false, scr, r, lane); continue; } r -= I_G;
                transpose_item(a.in[20], PLE, D, nullptr, Wp_t, false, scr, r, lane);
            }
            __syncthreads(); };
        if (!(blk & 1)) convert_rest();
        {
        LAS bf16* T0 = (LAS bf16*)lds; LAS bf16* T1 = (LAS bf16*)(lds + TILE_B); LAS bf16* T2 = (LAS bf16*)(lds + 2 * TILE_B); LAS bf16* T3 = (LAS bf16*)(lds + 3 * TILE_B);
        for (int u = blk; u < 512; u += G) { const int bh = u >> 4, b = bh >> 3, h = bh & 7, c = u < 256 ? (u & 15) : 15 - (u & 15); const size_t R0 = (size_t)b * SEQ + 128 * c; const float l2g = a.log2g[h];
            const int i_ = 16 * wave + fr;
            RopeX qx, kx; RopeCS cs; TileX vx; v2u gg[8];
            const float* kvb = KV + (size_t)bh * 16 * 16384;
            f32x4 tc[8];
#pragma unroll
            for (int i = 0; i < 8; ++i) tc[i] = *(const f32x4*)(kvb + 4 * (tid + 512 * i));
            rope_load(qx, Z + R0 * NIN + 128 * h, tid); rope_load(kx, Z + R0 * NIN + 1024 + 128 * h, tid); rope_cs_load(cs, ROPE + (size_t)(128 * c) * 128, tid); tile_load(vx, Z + R0 * NIN + 2048 + 128 * h, tid);
            rope_commit<false, false>(T0, qx, cs, 1.0f, 0.f, tid);
            rope_commit<false, false>(T1, kx, cs, 0.08838834764831845f, 0.f, tid);
            asm volatile("" ::: "memory");
            { const float Gc = __builtin_amdgcn_exp2f(l2g * 128.0f);
              f32x4 sp[8];
#pragma unroll
              for (int i = 0; i < 8; ++i) sp[i] = (f32x4){0.f, 0.f, 0.f, 0.f};
              for (int j = 0; j < c; ++j) { f32x4 tn[8];
#pragma unroll
                  for (int i = 0; i < 8; ++i) tn[i] = *(const f32x4*)(kvb + (size_t)(j + 1) * 16384 + 4 * (tid + 512 * i));
#pragma unroll
                  for (int i = 0; i < 8; ++i) { sp[i] = sp[i] * Gc + tc[i]; tc[i] = tn[i]; } }
              if (c == 15) {
#pragma unroll
                  for (int i = 0; i < 8; ++i) *(f32x4*)(out + O_RETP + (size_t)bh * 16384 + 4 * (tid + 512 * i)) = sp[i] * Gc + tc[i]; }
#pragma unroll
              for (int i = 0; i < 8; ++i) { const int ch = tid + 512 * i, d = ch >> 5, e4 = ch & 31; v2u w; w.x = pk2(sp[i][0], sp[i][1]); w.y = pk2(sp[i][2], sp[i][3]);
                  *(LAS v2u*)(T3 + d * LDP + 4 * e4) = w; } }
            tile_commit_N(T2, vx, tid);
            __syncthreads();
            { const bf16* gp = Z + (R0 + i_) * NIN + 3072 + 128 * h + 4 * fq;
#pragma unroll
              for (int ct = 0; ct < 8; ++ct) gg[ct] = *(const v2u*)(gp + 16 * ct); }
            f32x4 acc2[8], acc1[8];
#pragma unroll
            for (int ct = 0; ct < 8; ++ct) { acc2[ct] = (f32x4){0.f, 0.f, 0.f, 0.f}; acc1[ct] = (f32x4){0.f, 0.f, 0.f, 0.f}; }
            mm128_nt(acc2, T0, T3, wave, lane);
            mm128(acc1, T0, T1, wave, fr, fq);
            __syncthreads();
#pragma unroll
            for (int ct = 0; ct < 8; ++ct) { float sv[4];
#pragma unroll
                for (int t = 0; t < 4; ++t) { const int j = 16 * ct + 4 * fq + t; sv[t] = i_ >= j ? acc1[ct][t] * __builtin_amdgcn_exp2f(l2g * (float)(i_ - j)) : 0.f; }
                v2u w; w.x = pk2(sv[0], sv[1]); w.y = pk2(sv[2], sv[3]); *(LAS v2u*)(T1 + i_ * LDP + 16 * ct + 4 * fq) = w; }
            __syncthreads();
#pragma unroll
            for (int ct = 0; ct < 8; ++ct) acc1[ct] = (f32x4){0.f, 0.f, 0.f, 0.f};
            mm128_nt(acc1, T1, T2, wave, lane);
            const float qd = __builtin_amdgcn_exp2f(l2g * (float)(i_ + 1)); float ssq = 0.f;
#pragma unroll
            for (int ct = 0; ct < 8; ++ct) { acc1[ct] = acc1[ct] + acc2[ct] * qd; ssq += (acc1[ct][0] * acc1[ct][0] + acc1[ct][1] * acc1[ct][1]) + (acc1[ct][2] * acc1[ct][2] + acc1[ct][3] * acc1[ct][3]); }
            ssq += __shfl_xor(ssq, 16); ssq += __shfl_xor(ssq, 32);
            const float rn = __builtin_amdgcn_rsqf(ssq * (1.0f / 128.0f) + EPS);
            bf16* mp = MIX + (R0 + i_) * D + 128 * h + 4 * fq;
#pragma unroll
            for (int ct = 0; ct < 8; ++ct) { v2u w;
                w.x = pk2(acc1[ct][0] * rn * lo16(gg[ct].x), acc1[ct][1] * rn * hi16(gg[ct].x)); w.y = pk2(acc1[ct][2] * rn * lo16(gg[ct].y), acc1[ct][3] * rn * hi16(gg[ct].y)); *(v2u*)(mp + 16 * ct) = w; }
            __syncthreads(); }
        for (int u = blk; u < 512; u += G) { const int b = u >> 7, c = (u >> 3) & 15, grp = u & 7; const size_t R0 = (size_t)b * SEQ + 128 * c;
            const int t_ = 16 * wave + fr, d8 = tid & 15;
            f32x4 wl[4][2]; v4u xv[4]; float st[4][2]; v2u uu[8]; float lg[8], lb[8];
#pragma unroll
            for (int it = 0; it < 4; ++it) { const int idx = tid + 512 * it, t = idx >> 4; const float* wp = gm_ws + (size_t)grp * 16384 + t * 128 + 8 * d8;
                wl[it][0] = *(const f32x4*)wp; wl[it][1] = *(const f32x4*)(wp + 4);
                xv[it] = *(const v4u*)(Z + (R0 + t) * NIN + 5120 + 128 * grp + 8 * d8); st[it][0] = STATS[2 * (R0 + t)]; st[it][1] = STATS[2 * (R0 + t) + 1]; }
#pragma unroll
            for (int j = 0; j < 8; ++j) { lg[j] = gm_ln_g[128 * grp + 8 * d8 + j]; lb[j] = gm_ln_b[128 * grp + 8 * d8 + j]; }
            const float bsv = gm_bs[grp * 128 + t_];
#pragma unroll
            for (int it = 0; it < 4; ++it) { const int idx = tid + 512 * it, t = idx >> 4;
                float wv[8] = {wl[it][0][0], wl[it][0][1], wl[it][0][2], wl[it][0][3], wl[it][1][0], wl[it][1][1], wl[it][1][2], wl[it][1][3]};
#pragma unroll
                for (int j = 0; j < 8; ++j) if (8 * d8 + j > t) wv[j] = 0.f;
                v4u w; w.x = pk2(wv[0], wv[1]); w.y = pk2(wv[2], wv[3]); w.z = pk2(wv[4], wv[5]); w.w = pk2(wv[6], wv[7]); *(LAS v4u*)(T0 + t * LDP + 8 * d8) = w;
                const float mean = st[it][0], rstd = st[it][1];
                v4u vw;
#pragma unroll
                for (int p = 0; p < 4; ++p) vw[p] = pk2((lo16(xv[it][p]) - mean) * rstd * lg[2 * p] + lb[2 * p], (hi16(xv[it][p]) - mean) * rstd * lg[2 * p + 1] + lb[2 * p + 1]);
                *(LAS v4u*)(T1 + t * LDP + 8 * d8) = vw; }
            __syncthreads();
            { const bf16* up = Z + (R0 + t_) * NIN + 4096 + 128 * grp + 4 * fq;
#pragma unroll
              for (int ct = 0; ct < 8; ++ct) uu[ct] = *(const v2u*)(up + 16 * ct); }
            f32x4 acc[8];
#pragma unroll
            for (int ct = 0; ct < 8; ++ct) acc[ct] = (f32x4){0.f, 0.f, 0.f, 0.f};
            mm128_nt(acc, T0, T1, wave, lane);
            bf16* mp = MIX + (R0 + t_) * D + 1024 + 128 * grp + 4 * fq;
#pragma unroll
            for (int ct = 0; ct < 8; ++ct) { v2u w;
                w.x = pk2((acc[ct][0] + bsv) * lo16(uu[ct].x), (acc[ct][1] + bsv) * hi16(uu[ct].x)); w.y = pk2((acc[ct][2] + bsv) * lo16(uu[ct].y), (acc[ct][3] + bsv) * hi16(uu[ct].y)); *(v2u*)(mp + 16 * ct) = w; }
            __syncthreads(); }
        }
        if (blk & 1) convert_rest();
    }
    SEAM(3);

    if (IN(4)) {
        { pg8::Gemm g{MIX, Wo_t, MP, D, D}; pg8::StaticOrder S; S.init(MP, D, G, blk); EpiRes<2> E{(const float*)(ws + WS_RINV), nullptr, AB, SS1};
          pg8::gemm_phase<EpiRes<2>, pg8::StaticOrder, true, true>(lds, g, S, E); }
        auto f = [&](int s, int n, float v) { const float o = x_s[(size_t)s * D + n] + v; AB[(size_t)(MP + s) * D + n] = f2bf(o);
            const float q = half_wave_sum(o * o); if ((lane & 31) == 0) atomic_addf(SS1 + MP + s, q); };
        skinny_gemm<2>(lds, MIX + (size_t)MP * D, Wo_t, D, D, blk, G, f);
    }
    SEAM(4);

    if (IN(5)) {
        { pg8::Gemm g{AB, Wup_t, MP, NUP, D}; pg8::StaticOrder S; S.init(MP, NUP, G, blk); EpiUp E{ACT, RAW, SS1, conv_w, conv_b, (LAS float*)(lds + 131072)};
          pg8::gemm_phase<EpiUp, pg8::StaticOrder, true, true>(lds, g, S, E); }
        { pg8::Gemm g{AB, Wup_t, MP + 256, NUP, D}; SampleOrder S{(blk >= 128 && blk - 128 < NUP / 256) ? blk - 128 : -1}; EpiAS E{AS, SS1};
          pg8::gemm_phase<EpiAS, SampleOrder, true, true>(lds, g, S, E); }
        { int Kp = PLE; asm volatile("" : "+s"(Kp));
          constexpr int nbusy = (MP / 256 * (NUP / 256) + NUP / 256) - 5 * 256;
          pg8::Gemm g{PB, Wp_t, MP + 256, D, Kp}; ProjOrder S{blk >= nbusy ? blk - nbusy : -1, 256 - nbusy}; EpiPP E{PP};
          pg8::gemm_phase<EpiPP, ProjOrder, true, true>(lds, g, S, E); }
    }
    SEAM(5);

    if (IN(6)) {
        for (int i = gt; i < 128 * 2 * (DFF / 4); i += NGT) { const int c4 = i % (DFF / 4), gr = i / (DFF / 4), rr = gr & 1, Gp = gr >> 1, c = 4 * c4; const bool first = (Gp & 31) == 0;
            const float* rg = RAW + (size_t)Gp * 4 * NUP; const float* rp = rg - 4 * NUP; const f32x4 z4 = {0.f, 0.f, 0.f, 0.f};
            f32x4 a0g, a0u, a1g, a1u, a2g, a2u;
            a0g = *(const f32x4*)(rg + (2 + rr) * NUP + c); a0u = *(const f32x4*)(rg + (2 + rr) * NUP + DFF + c);
            if (rr) { a1g = *(const f32x4*)(rg + 2 * NUP + c); a1u = *(const f32x4*)(rg + 2 * NUP + DFF + c); a2g = first ? z4 : *(const f32x4*)(rp + NUP + c); a2u = first ? z4 : *(const f32x4*)(rp + NUP + DFF + c); }
            else { a1g = first ? z4 : *(const f32x4*)(rp + NUP + c); a1u = first ? z4 : *(const f32x4*)(rp + NUP + DFF + c); a2g = first ? z4 : *(const f32x4*)(rp + c); a2u = first ? z4 : *(const f32x4*)(rp + DFF + c); }
            const f32x4 ag = *(const f32x4*)(conv_w + c) * a2g + *(const f32x4*)(conv_w + NUP + c) * a1g + *(const f32x4*)(conv_w + 2 * NUP + c) * a0g + *(const f32x4*)(conv_b + c);
            const f32x4 au = *(const f32x4*)(conv_w + DFF + c) * a2u + *(const f32x4*)(conv_w + NUP + DFF + c) * a1u + *(const f32x4*)(conv_w + 2 * NUP + DFF + c) * a0u + *(const f32x4*)(conv_b + DFF + c);
            v2u w; w.x = pk2(silu_(ag[0]) * au[0], silu_(ag[1]) * au[1]); w.y = pk2(silu_(ag[2]) * au[2], silu_(ag[3]) * au[3]);
            *(v2u*)(ACT + (size_t)(64 * Gp + rr) * DFF + c) = w; }
        for (int i = gt; i < MS * (DFF / 4); i += NGT) { const int c4 = i % (DFF / 4), s = i / (DFF / 4), c = 4 * c4;
            const float* sc0 = state_conv + (size_t)s * 2 * NUP; const float* sc1 = sc0 + NUP; const float* as = AS + (size_t)s * NUP;
            const f32x4 a0g = *(const f32x4*)(as + c), a0u = *(const f32x4*)(as + DFF + c), a1g = *(const f32x4*)(sc1 + c), a1u = *(const f32x4*)(sc1 + DFF + c), a2g = *(const f32x4*)(sc0 + c), a2u = *(const f32x4*)(sc0 + DFF + c);
            const f32x4 ag = *(const f32x4*)(conv_w + c) * a2g + *(const f32x4*)(conv_w + NUP + c) * a1g + *(const f32x4*)(conv_w + 2 * NUP + c) * a0g + *(const f32x4*)(conv_b + c);
            const f32x4 au = *(const f32x4*)(conv_w + DFF + c) * a2u + *(const f32x4*)(conv_w + NUP + DFF + c) * a1u + *(const f32x4*)(conv_w + 2 * NUP + DFF + c) * a0u + *(const f32x4*)(conv_b + DFF + c);
            v2u w; w.x = pk2(silu_(ag[0]) * au[0], silu_(ag[1]) * au[1]); w.y = pk2(silu_(ag[2]) * au[2], silu_(ag[3]) * au[3]);
            *(v2u*)(ACT + (size_t)(MP + s) * DFF + c) = w;
            float* cs = out + O_CONVS + (size_t)s * 2 * NUP; *(f32x4*)(cs + c) = a1g; *(f32x4*)(cs + DFF + c) = a1u; *(f32x4*)(cs + NUP + c) = a0g; *(f32x4*)(cs + NUP + DFF + c) = a0u; }
        for (int i = gt; i < 4 * 2 * (NUP / 4); i += NGT) { const int c4 = i % (NUP / 4), bk = i / (NUP / 4), b = bk >> 1, k = bk & 1;
            *(f32x4*)(out + O_CONVP + (size_t)bk * NUP + 4 * c4) = *(const f32x4*)(RAW + ((size_t)(32 * b + 31) * 4 + k) * NUP + 4 * c4); }
    }
    SEAM(6);

    if (IN(7)) {
        { pg8::Gemm g{ACT, Wdn_t, MP, D, DFF}; pg8::StaticOrder S; S.init(MP, D, G, blk); EpiRes<1> E{nullptr, nullptr, AB, SS2};
          pg8::gemm_phase<EpiRes<1>, pg8::StaticOrder, true, true>(lds, g, S, E); }
        auto f = [&](int s, int n, float v) { const size_t o_ = (size_t)(MP + s) * D + n; const float o = bf2f(AB[o_]) + v; AB[o_] = f2bf(o);
            const float q = half_wave_sum(o * o); if ((lane & 31) == 0) atomic_addf(SS2 + MP + s, q); };
        skinny_gemm<2>(lds, ACT + (size_t)MP * DFF, Wdn_t, D, DFF, blk, G, f);
    }
    SEAM(7);

    if (IN(8)) {
#ifndef T_B
        { pg8::Gemm g{AB, Wg_t, MP, D, D}; pg8::StaticOrder S; S.init(MP, D, G, blk); EpiGate E{PP, AB, out, SS2, SS3};
          pg8::gemm_phase<EpiGate, pg8::StaticOrder, true, true>(lds, g, S, E); }
#endif
#ifndef T_D
        auto f2 = [&](int s, int n, float v) { const size_t o_ = (size_t)(MP + s) * D + n; const float r2 = __builtin_amdgcn_rsqf(SS2[MP + s] * (1.0f / D) + EPS);
            const float o = bf2f(AB[o_]) + bf2f(PP[o_]) * sigmoid_(r2 * v); out[o_] = o; const float q = half_wave_sum(o * o); if ((lane & 31) == 0) atomic_addf(SS3 + MP + s, q); };
        skinny_gemm<2>(lds, AB + (size_t)MP * D, Wg_t, D, D, blk, G, f2);
#endif
    }
    SEAM(8);

    if (IN(9)) {
        { const f32x4* gr = (const f32x4*)g_final + lane; f32x4 gv[8];
#pragma unroll
          for (int j = 0; j < 8; ++j) gv[j] = gr[64 * j];
          for (int m0 = gw; m0 < MT; m0 += 2 * NGW) { const int m1 = m0 + NGW; const bool two = m1 < MT;
            f32x4* h0 = (f32x4*)(out + (size_t)m0 * D) + lane; f32x4* h1 = (f32x4*)(out + (size_t)(two ? m1 : m0) * D) + lane;
            f32x4 a0[8], a1[8];
#pragma unroll
            for (int j = 0; j < 8; ++j) { a0[j] = h0[64 * j]; a1[j] = h1[64 * j]; }
            const float r0 = __builtin_amdgcn_rsqf(SS3[m0] * (1.0f / D) + EPS), r1 = __builtin_amdgcn_rsqf(SS3[two ? m1 : m0] * (1.0f / D) + EPS);
#pragma unroll
            for (int j = 0; j < 8; ++j) h0[64 * j] = a0[j] * gv[j] * r0;
            if (two) {
#pragma unroll
                for (int j = 0; j < 8; ++j) h1[64 * j] = a1[j] * gv[j] * r1; } } }
    }
#undef IN
#undef SEAM
}
#undef x_p
#undef x_s
#undef p_p
#undef p_s
#undef state_ret
#undef state_conv
#undef gm_ln_g
#undef gm_ln_b
#undef gm_ws
#undef gm_bs
#undef conv_w
#undef conv_b
#undef g_final
#undef out
#undef SS1
#undef SS2
#undef SS3
#undef STATS
#undef ROPE
#undef ROPES
#undef Win_t
#undef Wo_t
#undef Wup_t
#undef Wdn_t
#undef Wg_t
#undef Wp_t
#undef AB
#undef PB
#undef MIX
#undef Z
#undef ACT
#undef KV
#undef PP
#undef RAW
#undef AS

extern "C" void kernel_launch(void* const* d_in, const int* in_sizes, int n_in, void* d_out, int out_size, void* d_ws, size_t ws_size, hipStream_t stream) {
    static int grid = 0;
    if (grid == 0) {
        if (n_in != 22 || out_size != (int)O_END || ws_size < WS_END) { fprintf(stderr, "kernel_launch: unexpected shapes: n_in %d out %d ws %zu\n", n_in, out_size, ws_size); grid = -1; return; }
        int dev = 0, cus = 0, per_cu = 0;
        if (hipGetDevice(&dev) != hipSuccess || hipDeviceGetAttribute(&cus, hipDeviceAttributeMultiprocessorCount, dev) != hipSuccess) { grid = -1; return; }
        if (hipFuncSetAttribute((const void*)mk_fwd, hipFuncAttributeMaxDynamicSharedMemorySize, LDS_BYTES) != hipSuccess) { fprintf(stderr, "kernel_launch: hipFuncSetAttribute failed\n"); grid = -1; return; }
        if (hipOccupancyMaxActiveBlocksPerMultiprocessor(&per_cu, (const void*)mk_fwd, 512, LDS_BYTES) != hipSuccess || per_cu < 1) fprintf(stderr, "kernel_launch: occupancy query says %d\n", per_cu);
        (void)hipGetLastError();
        grid = cus;
        if (grid != 256) fprintf(stderr, "kernel_launch: %d CUs (built for 256)\n", grid);
    }
    if (grid < 0) return;
    if (hipMemsetAsync((char*)d_ws + WS_BAR, 0, BAR_BYTES, stream) != hipSuccess) { fprintf(stderr, "kernel_launch: memset failed\n"); return; }
    Params p{};
    for (int i = 0; i < 22; ++i) p.in[i] = (const float*)d_in[i];
    p.out = (float*)d_out; p.ws = (unsigned char*)d_ws;
    for (int h = 0; h < 8; ++h) p.log2g[h] = (float)std::log2(1.0 - std::exp2(-5.0 - (double)h));
    for (int i = 0; i < 64; ++i) p.invf[i] = powf(10000.0f, -(float)i / 64.0f);
    p.use_cg = 0; p.pad = 0;
#if MK_N_LAUNCHES == 1
    void* args[] = {&p};
#ifdef PROBE_K
    p.ph_lo = 0; p.ph_hi = PROBE_K + 1;
    (void)hipLaunchCooperativeKernel((const void*)mk_fwd, dim3(grid), dim3(512), args, LDS_BYTES, stream);
    if (hipMemsetAsync((char*)d_ws + WS_BAR, 0, BAR_BYTES, stream) != hipSuccess) return;
#endif
    p.ph_lo = 0; p.ph_hi = NPHASE;
    hipError_t e = hipLaunchCooperativeKernel((const void*)mk_fwd, dim3(grid), dim3(512), args, LDS_BYTES, stream);
    if (e != hipSuccess) fprintf(stderr, "kernel_launch: cooperative launch failed: %s\n", hipGetErrorString(e));
#else
    for (int ph = 0; ph < NPHASE; ++ph) { p.ph_lo = ph; p.ph_hi = ph + 1; hipLaunchKernelGGL(mk_fwd, dim3(grid), dim3(512), LDS_BYTES, stream, p); }
#endif
}
```

```cpp
#include <hip/hip_runtime.h>
#include <hip/hip_cooperative_groups.h>
#include <cstdio>
#include <cstdint>
#include <cmath>
namespace cg = cooperative_groups;

#ifndef MK_N_LAUNCHES
#define MK_N_LAUNCHES 1
#endif

namespace pg8 {
#define PG8_LAS __attribute__((address_space(3)))
typedef unsigned short bf16_t;
typedef short bf16x8 __attribute__((ext_vector_type(8)));
typedef float f32x4 __attribute__((ext_vector_type(4)));
typedef unsigned u32x4 __attribute__((ext_vector_type(4)));
constexpr int BM = 256, BK = 64, HALF = 128, HTB = HALF * BK * 2  , STAGE_BYTES = 8 * HTB, NXCD = 8, WGM = 8;

__host__ __device__ __forceinline__ int lds_byte(int r, int c) { const int st = (r >> 4) * 2 + (c >> 5), rr = r & 15, cc = c & 31, ob = rr * 64 + cc * 2; return st * 1024 + (ob ^ (((ob >> 9) & 1) << 5)); }
__host__ __device__ __forceinline__ void stage_rc(int b, int& R, int& C) { const int st = b / 1024, sb = b % 1024, swz = sb ^ (((sb >> 9) & 1) << 5); R = (st >> 1) * 16 + swz / 64; C = (st & 1) * 32 + (swz % 64) / 2; }
__host__ __device__ __forceinline__ int perm32(int rho) { const int n = rho >> 4, i = rho & 15; return 8 * (i >> 2) + 4 * n + (i & 3); }

struct Unit { int pm, pn; };
struct Gemm { const bf16_t* A; const bf16_t* Bt; int M, N, K; };

struct StaticOrder {
    int nM, nN, nwg, G, c;
    __host__ __device__ void init(int M, int N, int G_, int c_) { nM = M / BM; nN = N / BM; nwg = nM * nN; G = G_; c = c_; }
    __host__ __device__ bool next(int i, Unit& u) const {
        const long L = (long)i * G + c; if (L >= nwg) return false;
        int wgid = (int)L; { const int q = nwg / NXCD, r = nwg % NXCD, xcd = wgid % NXCD, off = wgid / NXCD; wgid = (xcd < r ? xcd * (q + 1) : r * (q + 1) + (xcd - r) * q) + off; }
        const int nig = WGM * nN, gid = wgid / nig, fm = gid * WGM, gsz = (nM - fm) < WGM ? (nM - fm) : WGM;
        u.pm = fm + ((wgid % nig) % gsz); u.pn = (wgid % nig) / gsz; return true;
    }
    __device__ __forceinline__ void a_ready(const Unit&) const {}
    __device__ __forceinline__ void done(const Unit&) const {}
};

__device__ __forceinline__ unsigned cvt_pk_bf16(float lo, float hi) { unsigned r; asm volatile("v_cvt_pk_bf16_f32 %0, %1, %2" : "=v"(r) : "v"(lo), "v"(hi)); return r; }
typedef float f32x2 __attribute__((ext_vector_type(2)));

template <class Epi, class Sched, bool ALIGN_EPI = false, bool SP2 = false>
__device__ __forceinline__ void gemm_phase(PG8_LAS unsigned char* lds, const Gemm g, const Sched& S, const Epi& E) {
    const int tid = threadIdx.x, wid = __builtin_amdgcn_readfirstlane(tid >> 6), lane = tid & 63, wr = wid >> 2, wc = wid & 3, fr = lane & 15, fq = lane >> 4;
    const int K = g.K, nt = K / BK;
    unsigned voffA[2], voffB[2];
#pragma unroll
    for (int i = 0; i < 2; ++i) { int R, C; stage_rc(tid * 16 + i * 8192, R, C); const int Rb = Epi::PERM ? ((R & ~31) + perm32(R & 31)) : R;
        voffA[i] = (unsigned)(R * K + C) * 2u; voffB[i] = (unsigned)(Rb * K + C) * 2u; }
    const size_t kstep = (size_t)(BK * 2);
    const size_t hstep = (size_t)HALF * K * 2;
    const size_t tstep = 2 * hstep;
    const unsigned ldsw = (unsigned)wid * 1024u;
    const int aoff = lds_byte(wr * 64 + fr, fq * 8), boff = lds_byte(wc * 32 + fr, fq * 8);
#define PG8_SA(b, h) (((b) * 2 + (h)) * HTB)
#define PG8_SB(b, h) ((4 + (b) * 2 + (h)) * HTB)
#define PG8_STAGE(bufoff, gbase, voff) do { _Pragma("unroll") for (int _i = 0; _i < 2; ++_i) \
        __builtin_amdgcn_global_load_lds((const unsigned*)((const char*)(gbase) + (voff)[_i]), (PG8_LAS unsigned*)(lds + (bufoff) + ldsw + _i * 8192), 16, 0, 0); } while (0)
#define PG8_LDA(dst, b, h) do { _Pragma("unroll") for (int m = 0; m < 4; ++m) _Pragma("unroll") for (int k = 0; k < 2; ++k) dst[m][k] = *(const PG8_LAS bf16x8*)(lds + PG8_SA(b, h) + aoff + m * 2048 + k * 1024); } while (0)
#define PG8_LDB(dst, b, h) do { _Pragma("unroll") for (int n = 0; n < 2; ++n) _Pragma("unroll") for (int k = 0; k < 2; ++k) dst[n][k] = *(const PG8_LAS bf16x8*)(lds + PG8_SB(b, h) + boff + n * 2048 + k * 1024); } while (0)
#define PG8_MMA(ai, bj, At, Bt) do { __builtin_amdgcn_s_setprio(1); _Pragma("unroll") for (int m = 0; m < 4; ++m) _Pragma("unroll") for (int n = 0; n < 2; ++n) _Pragma("unroll") for (int k = 0; k < 2; ++k) \
        acc[ai][bj][m][n] = __builtin_amdgcn_mfma_f32_16x16x32_bf16(Bt[n][k], At[m][k], acc[ai][bj][m][n], 0, 0, 0); __builtin_amdgcn_s_setprio(0); } while (0)
#define PG8_WAIT_V(n) asm volatile("s_waitcnt vmcnt(" #n ")" ::: "memory")
#define PG8_WAIT_L(n) asm volatile("s_waitcnt lgkmcnt(" #n ")" ::: "memory")
#define PG8_BAR __builtin_amdgcn_s_barrier()
#define PG8_SCHED __builtin_amdgcn_sched_barrier(0)
    Unit cur, nxt; int ui = 0;
    if (!S.next(0, cur)) return;
    f32x4 acc[2][2][4][2];
#pragma unroll
    for (int a = 0; a < 2; ++a)
#pragma unroll
        for (int b = 0; b < 2; ++b)
#pragma unroll
            for (int m = 0; m < 4; ++m)
#pragma unroll
                for (int n = 0; n < 2; ++n) acc[a][b][m][n] = (f32x4){0.f, 0.f, 0.f, 0.f};
    bf16x8 At[4][2], B0[2][2], B1[2][2];
    const char* cA = (const char*)g.A + (size_t)cur.pm * tstep; const char* cB = (const char*)g.Bt + (size_t)cur.pn * tstep;
    S.a_ready(cur);
    if constexpr (SP2) {
        PG8_STAGE(PG8_SB(0, 0), cB, voffB); PG8_STAGE(PG8_SB(0, 1), cB + hstep, voffB); PG8_STAGE(PG8_SA(0, 0), cA, voffA); PG8_STAGE(PG8_SA(0, 1), cA + hstep, voffA);
        if (wr == 1) PG8_BAR;
        PG8_WAIT_V(2); PG8_BAR;
        PG8_STAGE(PG8_SB(1, 0), cB + kstep, voffB); PG8_STAGE(PG8_SA(1, 0), cA + kstep, voffA); PG8_STAGE(PG8_SB(1, 1), cB + hstep + kstep, voffB);
        PG8_WAIT_V(6); PG8_BAR;
    } else {
        PG8_STAGE(PG8_SB(0, 0), cB, voffB); PG8_STAGE(PG8_SA(0, 0), cA, voffA); PG8_STAGE(PG8_SB(0, 1), cB + hstep, voffB); PG8_STAGE(PG8_SA(0, 1), cA + hstep, voffA);
        if (wr == 1) PG8_BAR;
        PG8_WAIT_V(4); PG8_BAR;
        PG8_STAGE(PG8_SB(1, 0), cB + kstep, voffB); PG8_STAGE(PG8_SA(1, 0), cA + kstep, voffA); PG8_STAGE(PG8_SB(1, 1), cB + hstep + kstep, voffB);
        PG8_WAIT_V(6); PG8_BAR;
    }
    for (;;) {
        const bool has_next = S.next(ui + 1, nxt);
        const char* nA = has_next ? (const char*)g.A + (size_t)nxt.pm * tstep : cA; const char* nB = has_next ? (const char*)g.Bt + (size_t)nxt.pn * tstep : cB;
        for (int t = 0; t < nt; t += 2) {
            const bool last = (t == nt - 2);
            const char* a1 = cA + (size_t)(t + 1) * kstep;
            const char* a2 = last ? nA : cA + (size_t)(t + 2) * kstep; const char* b2 = last ? nB : cB + (size_t)(t + 2) * kstep;
            const char* a3 = a2 + kstep; const char* b3 = b2 + kstep;
            if (last && has_next) S.a_ready(nxt);
            if constexpr (SP2) {
            PG8_LDB(B0, 0, 0); PG8_LDB(B1, 0, 1); PG8_SCHED; PG8_LDA(At, 0, 0); PG8_STAGE(PG8_SA(1, 1), a1 + hstep, voffA);
            PG8_WAIT_V(8); PG8_WAIT_L(0); PG8_BAR; PG8_MMA(0, 0, At, B0); PG8_MMA(0, 1, At, B1); PG8_BAR; PG8_SCHED;
            PG8_LDA(At, 0, 1); PG8_STAGE(PG8_SB(0, 0), b2, voffB); PG8_STAGE(PG8_SB(0, 1), b2 + hstep, voffB); PG8_STAGE(PG8_SA(0, 0), a2, voffA);
            PG8_WAIT_V(8); PG8_WAIT_L(0); PG8_BAR; PG8_MMA(1, 0, At, B0); PG8_MMA(1, 1, At, B1); PG8_BAR; PG8_SCHED;
            PG8_LDB(B0, 1, 0); PG8_LDB(B1, 1, 1); PG8_SCHED; PG8_LDA(At, 1, 0); PG8_STAGE(PG8_SA(0, 1), a2 + hstep, voffA);
            PG8_WAIT_V(8); PG8_WAIT_L(0); PG8_BAR; PG8_MMA(0, 0, At, B0); PG8_MMA(0, 1, At, B1); PG8_BAR; PG8_SCHED;
            PG8_LDA(At, 1, 1); PG8_STAGE(PG8_SB(1, 0), b3, voffB); PG8_STAGE(PG8_SB(1, 1), b3 + hstep, voffB); PG8_STAGE(PG8_SA(1, 0), a3, voffA);
            PG8_WAIT_V(8); PG8_WAIT_L(0); PG8_BAR; PG8_MMA(1, 0, At, B0); PG8_MMA(1, 1, At, B1); PG8_BAR; PG8_SCHED;
            } else {
            PG8_LDB(B0, 0, 0); PG8_SCHED; PG8_LDA(At, 0, 0); PG8_STAGE(PG8_SA(1, 1), a1 + hstep, voffA);
            PG8_WAIT_L(8); PG8_BAR; PG8_WAIT_L(0); PG8_MMA(0, 0, At, B0); PG8_BAR; PG8_SCHED;
            PG8_LDB(B1, 0, 1); PG8_STAGE(PG8_SB(0, 0), b2, voffB);
            PG8_BAR; PG8_WAIT_L(0); PG8_MMA(0, 1, At, B1); PG8_BAR;
            PG8_LDA(At, 0, 1); PG8_STAGE(PG8_SA(0, 0), a2, voffA);
            PG8_BAR; PG8_WAIT_L(0); PG8_MMA(1, 0, At, B0); PG8_BAR; PG8_SCHED;
            PG8_STAGE(PG8_SB(0, 1), b2 + hstep, voffB);
            PG8_WAIT_V(6); PG8_BAR; PG8_MMA(1, 1, At, B1); PG8_BAR;
            PG8_LDB(B0, 1, 0); PG8_SCHED; PG8_LDA(At, 1, 0); PG8_STAGE(PG8_SA(0, 1), a2 + hstep, voffA);
            PG8_WAIT_L(8); PG8_BAR; PG8_WAIT_L(0); PG8_MMA(0, 0, At, B0); PG8_BAR; PG8_SCHED;
            PG8_LDB(B1, 1, 1); PG8_STAGE(PG8_SB(1, 0), b3, voffB);
            PG8_BAR; PG8_WAIT_L(0); PG8_MMA(0, 1, At, B1); PG8_BAR;
            PG8_LDA(At, 1, 1); PG8_STAGE(PG8_SA(1, 0), a3, voffA);
            PG8_BAR; PG8_WAIT_L(0); PG8_MMA(1, 0, At, B0); PG8_BAR; PG8_SCHED;
            PG8_STAGE(PG8_SB(1, 1), b3 + hstep, voffB);
            PG8_WAIT_V(6); PG8_BAR; PG8_MMA(1, 1, At, B1); PG8_BAR;
            }
        }
        if constexpr (ALIGN_EPI) { if (wr == 0) PG8_BAR; }
        if constexpr (!Epi::AFTER_DRAIN) { E(acc, cur, wr, wc, fr, fq); S.done(cur); }
        if (!has_next) break;
#pragma unroll
        for (int a = 0; a < 2; ++a)
#pragma unroll
            for (int b = 0; b < 2; ++b)
#pragma unroll
                for (int m = 0; m < 4; ++m)
#pragma unroll
                    for (int n = 0; n < 2; ++n) acc[a][b][m][n] = (f32x4){0.f, 0.f, 0.f, 0.f};
        cur = nxt; cA = nA; cB = nB; ++ui;
        if constexpr (ALIGN_EPI) { if (wr == 1) PG8_BAR; }
    }
    PG8_WAIT_V(0);
    if constexpr (!ALIGN_EPI) { if (wr == 0) PG8_BAR; }
    PG8_BAR;
    if constexpr (Epi::AFTER_DRAIN) { E.fused(acc, cur, wr, wc, fr, fq, lds, wid, lane); S.done(cur); }
#undef PG8_SA
#undef PG8_SB
#undef PG8_STAGE
#undef PG8_LDA
#undef PG8_LDB
#undef PG8_MMA
#undef PG8_WAIT_V
#undef PG8_WAIT_L
#undef PG8_BAR
#undef PG8_SCHED
}
}

#define GAS __attribute__((address_space(1)))
#define LAS __attribute__((address_space(3)))
typedef unsigned short bf16;
typedef unsigned v4u __attribute__((ext_vector_type(4)));
typedef unsigned v2u __attribute__((ext_vector_type(2)));
typedef float f32x4 __attribute__((ext_vector_type(4)));
typedef float f32x2 __attribute__((ext_vector_type(2)));
typedef short bf16x8 __attribute__((ext_vector_type(8)));
#define XB_TMO      128
#define XB_XCNT(j)  (256  + 64 * (j))
#define XB_XSUB(j)  (1280 + 64 * (j))
#define XB_XGEN(j)  (2304 + 64 * (j))
#define XB_TOP      3328
#define XB_TOPGEN   3392
#define XCD_BAR_WORDS 3456
#define XB_SPIN_CAP (1u << 18)

__device__ __forceinline__ unsigned xb_ld(unsigned* p)              { return __hip_atomic_load(p, __ATOMIC_RELAXED, __HIP_MEMORY_SCOPE_AGENT); }
__device__ __forceinline__ unsigned xb_add(unsigned* p, unsigned v) { return __hip_atomic_fetch_add(p, v, __ATOMIC_RELAXED, __HIP_MEMORY_SCOPE_AGENT); }
__device__ __forceinline__ unsigned xb_xcc_id() { return (unsigned)__builtin_amdgcn_s_getreg((3 << 11) | 20) & 0xFu; }
#define XB_SPIN(cond, bar) do { unsigned _sp = 0; while (cond) { __builtin_amdgcn_s_sleep(1); \
    if ((++_sp & 255u) == 0u) { if (xb_ld(&(bar)[XB_TMO])) break; if (_sp > XB_SPIN_CAP) { atomicAdd(&(bar)[XB_TMO], 1u); break; } } } } while (0)

struct XcdBarrier {
    unsigned* bar; unsigned x;
    volatile LAS unsigned* st;
};

__device__ __forceinline__ XcdBarrier xcd_barrier_post(unsigned* bar, volatile LAS unsigned* st) {
    XcdBarrier b; b.bar = bar; b.x = xb_xcc_id(); b.st = st;
    if (threadIdx.x == 0) (void)xb_add(&bar[XB_XCNT(b.x)], 1u);
    return b;
}
__device__ __forceinline__ void xcd_barrier_complete(unsigned* bar, unsigned x, unsigned& nloc, unsigned& nx) {
    const unsigned G = gridDim.x * gridDim.y * gridDim.z;
    unsigned sum, cnt, mine, sp = 0u;
    for (;;) {
        sum = 0u; cnt = 0u; mine = 0u;
#pragma unroll
        for (unsigned j = 0; j < 16; ++j) { const unsigned c = xb_ld(&bar[XB_XCNT(j)]); sum += c; cnt += (c > 0u) ? 1u : 0u; mine = (j == x) ? c : mine; }
        if (sum == G) break;
        __builtin_amdgcn_s_sleep(1);
        if ((++sp & 255u) == 0u) { if (xb_ld(&bar[XB_TMO])) break; if (sp > XB_SPIN_CAP) { atomicAdd(&bar[XB_TMO], 1u); break; } }
    }
    nloc = mine > 0u ? mine : 1u; nx = cnt > 0u ? cnt : 1u;
}

__device__ __forceinline__ void xcd_barrier(const XcdBarrier& b) {
    asm volatile("s_waitcnt vmcnt(0)" ::: "memory");
    __syncthreads();
    if (threadIdx.x == 0) {
        unsigned* bar = b.bar;
        __builtin_amdgcn_s_waitcnt(0);
        unsigned nloc = b.st[0], nx = b.st[1];
        if (nloc == 0u) { xcd_barrier_complete(bar, b.x, nloc, nx); b.st[0] = nloc; b.st[1] = nx; }
        const unsigned old = xb_add(&bar[XB_XSUB(b.x)], 1u);
        const unsigned gen = old / nloc;
        if (old + 1u == (gen + 1u) * nloc) {
            __builtin_amdgcn_fence(__ATOMIC_RELEASE, "agent");
            asm volatile("s_waitcnt vmcnt(0)" ::: "memory");
            const unsigned og = xb_add(&bar[XB_TOP], 1u);
            const unsigned tg = og / nx;
            if (og + 1u == (tg + 1u) * nx) xb_add(&bar[XB_TOPGEN], 1u);
            else XB_SPIN(xb_ld(&bar[XB_TOPGEN]) == tg, bar);
            __builtin_amdgcn_fence(__ATOMIC_ACQUIRE, "agent");
            xb_add(&bar[XB_XGEN(b.x)], 1u);
            asm volatile("s_waitcnt vmcnt(0)" ::: "memory");
        } else {
            XB_SPIN(xb_ld(&bar[XB_XGEN(b.x)]) == gen, bar);
            __builtin_amdgcn_fence(__ATOMIC_ACQUIRE, "agent");
            asm volatile("s_waitcnt vmcnt(0)" ::: "memory");
        }
    }
    __syncthreads();
}

constexpr int MP = 8192, MS = 128, MT = MP + MS, D = 2048, NIN = 6144, NUP = 11264, DFF = 5632, PLE = 256, SEQ = 2048, NH = 8;
constexpr float EPS = 1e-6f;
constexpr int NPHASE = 10;
constexpr size_t MiB = 1u << 20;
constexpr size_t WS_BAR = 0, BAR_BYTES = 16384;
constexpr size_t WS_SS1 = 64 * 1024, WS_SS2 = 128 * 1024, WS_SS3 = 192 * 1024, WS_STATS = 256 * 1024;
constexpr size_t WS_RINV = 384 * 1024;
constexpr size_t WS_ROPE = 1 * MiB, WS_ROPES = 2 * MiB;
constexpr size_t WS_WIN = 4 * MiB, WS_WO = 28 * MiB, WS_WUP = 36 * MiB, WS_WDN = 80 * MiB, WS_WG = 102 * MiB, WS_WP = 110 * MiB;
constexpr size_t WS_AB = 112 * MiB, WS_PB = 145 * MiB, WS_MIX = 150 * MiB, WS_Z = 183 * MiB, WS_ACT = 183 * MiB, WS_KV = 281 * MiB, WS_PP = 281 * MiB;
constexpr size_t WS_RAW = 313 * MiB, WS_AS = 335 * MiB, WS_END = 346 * MiB;
static_assert(WS_AB + (size_t)MT * D * 2 <= WS_PB && WS_PB + (size_t)MT * PLE * 2 <= WS_MIX && WS_MIX + (size_t)MT * D * 2 <= WS_Z, "ws map 1");
static_assert(WS_Z + (size_t)MT * NIN * 2 <= WS_KV && WS_ACT + (size_t)MT * DFF * 2 <= WS_KV && WS_KV + (size_t)512 * 16384 * 4 <= WS_RAW, "ws map 2");
static_assert(WS_RAW + (size_t)128 * 4 * NUP * 4 <= WS_AS && WS_AS + (size_t)MS * NUP * 4 <= WS_END && WS_PP + (size_t)MT * D * 4 <= WS_END, "ws map 3");
constexpr size_t O_RETP = 17039360, O_CONVP = 17563648, O_RETS = 17653760, O_CONVS = 34430976, O_GMV = 37314560, O_END = 37445632;
constexpr int LDS_BYTES = 147456, MISC_OFF = LDS_BYTES - 256;
constexpr int LDP = 136;
constexpr int TILE_B = 128 * LDP * 2;

struct Params { const float* in[22]; float* out; unsigned char* ws; float log2g[8]; float invf[64]; int ph_lo, ph_hi, use_cg, pad; };

#define LDS_WAIT() asm volatile("s_waitcnt lgkmcnt(0)" ::: "memory")
__device__ __forceinline__ float lo16(unsigned u) { return __uint_as_float(u << 16); }
__device__ __forceinline__ float hi16(unsigned u) { return __uint_as_float(u & 0xffff0000u); }
__device__ __forceinline__ float bf2f(bf16 b) { return __uint_as_float((unsigned)b << 16); }
__device__ __forceinline__ unsigned pk2(float lo, float hi) { return pg8::cvt_pk_bf16(lo, hi); }
__device__ __forceinline__ bf16 f2bf(float f) { return (bf16)(pg8::cvt_pk_bf16(f, 0.f) & 0xffffu); }
__device__ __forceinline__ float sigmoid_(float x) { return __builtin_amdgcn_rcpf(1.0f + __builtin_amdgcn_exp2f(-1.44269504089f * x)); }
__device__ __forceinline__ float silu_(float x) { return x * sigmoid_(x); }
__device__ __forceinline__ float gelu_(float x) { return x * sigmoid_(1.5957691216f * (x + 0.044715f * x * x * x)); }
__device__ __forceinline__ float wave_sum(float v) {
#pragma unroll
    for (int o = 1; o < 64; o <<= 1) v += __shfl_xor(v, o);
    return v;
}
__device__ __forceinline__ void atomic_addf(float* p, float v) { (void)__hip_atomic_fetch_add(p, v, __ATOMIC_RELAXED, __HIP_MEMORY_SCOPE_AGENT); }
template <int CTRL> __device__ __forceinline__ float dppf(float x) { return __int_as_float(__builtin_amdgcn_mov_dpp(__float_as_int(x), CTRL, 0xf, 0xf, false)); }

using pg8::Unit;
struct EpiZ {
    static constexpr bool PERM = true, AFTER_DRAIN = false;
    bf16* Z;
    __device__ __forceinline__ void operator()(const f32x4 (&acc)[2][2][4][2], const Unit& u, int wr, int wc, int fr, int fq) const {
        const int row0 = u.pm * 256 + wr * 64 + fr, col0 = u.pn * 256 + wc * 32 + 8 * fq;
        const int mode = u.pn < 12 ? 0 : (u.pn < 16 ? 1 : 2);
#pragma unroll
        for (int ai = 0; ai < 2; ++ai)
#pragma unroll
            for (int m = 0; m < 4; ++m) { bf16* rowp = Z + (size_t)(row0 + ai * 128 + m * 16) * NIN + col0;
#pragma unroll
                for (int bj = 0; bj < 2; ++bj) { f32x4 v0 = acc[ai][bj][m][0], v1 = acc[ai][bj][m][1];
                    if (mode == 1) {
#pragma unroll
                        for (int j = 0; j < 4; ++j) { v0[j] = silu_(v0[j]); v1[j] = silu_(v1[j]); } }
                    else if (mode == 2) {
#pragma unroll
                        for (int j = 0; j < 4; ++j) { v0[j] = gelu_(v0[j]); v1[j] = gelu_(v1[j]); } }
                    v4u w; w.x = pk2(v0[0], v0[1]); w.y = pk2(v0[2], v0[3]); w.z = pk2(v1[0], v1[1]); w.w = pk2(v1[2], v1[3]);
                    *(v4u*)(rowp + bj * 128) = w; } }
    }
};
template <int BASE_BF16> struct EpiRes {
    const float* rowscale;
    static constexpr bool PERM = true, AFTER_DRAIN = false;
    const float* base; bf16* hb; float* ss;
    __device__ __forceinline__ void operator()(const f32x4 (&acc)[2][2][4][2], const Unit& u, int wr, int wc, int fr, int fq) const {
        const int row0 = u.pm * 256 + wr * 64 + fr, col0 = u.pn * 256 + wc * 32 + 8 * fq;
        float sacc[2][4];
#pragma unroll
        for (int ai = 0; ai < 2; ++ai) {
            f32x4 bs[BASE_BF16 ? 1 : 4][2][2]; v4u bw[4][2]; float rsc[4];
#pragma unroll
            for (int m = 0; m < 4; ++m) { rsc[m] = BASE_BF16 == 2 ? rowscale[row0 + ai * 128 + m * 16] : 1.0f;
#pragma unroll
                for (int bj = 0; bj < 2; ++bj) { const size_t o_ = (size_t)(row0 + ai * 128 + m * 16) * D + col0 + bj * 128;
                    if (BASE_BF16) bw[m][bj] = *(const v4u*)(hb + o_);
                    else { bs[m][bj][0] = *(const f32x4*)(base + o_); bs[m][bj][1] = *(const f32x4*)(base + o_ + 4); } } }
#pragma unroll
            for (int m = 0; m < 4; ++m) { const size_t off = (size_t)(row0 + ai * 128 + m * 16) * D + col0; float s = 0.f;
#pragma unroll
                for (int bj = 0; bj < 2; ++bj) { f32x4 b0, b1;
                    if (BASE_BF16) { const v4u w = bw[m][bj]; b0 = (f32x4){lo16(w.x), hi16(w.x), lo16(w.y), hi16(w.y)}; b1 = (f32x4){lo16(w.z), hi16(w.z), lo16(w.w), hi16(w.w)};
                        if (BASE_BF16 == 2) { b0 *= rsc[m]; b1 *= rsc[m]; } }
                    else { b0 = bs[m][bj][0]; b1 = bs[m][bj][1]; }
                    const f32x4 o0 = b0 + acc[ai][bj][m][0], o1 = b1 + acc[ai][bj][m][1];
                    v4u w; w.x = pk2(o0[0], o0[1]); w.y = pk2(o0[2], o0[3]); w.z = pk2(o1[0], o1[1]); w.w = pk2(o1[2], o1[3]); *(v4u*)(hb + off + bj * 128) = w;
                    s += ((o0[0] * o0[0] + o0[1] * o0[1]) + (o0[2] * o0[2] + o0[3] * o0[3])) + ((o1[0] * o1[0] + o1[1] * o1[1]) + (o1[2] * o1[2] + o1[3] * o1[3])); }
                s += __shfl_xor(s, 16); s += __shfl_xor(s, 32); sacc[ai][m] = s; }
            asm volatile("" ::: "memory"); }
        if (fq == 0) {
#pragma unroll
            for (int ai = 0; ai < 2; ++ai)
#pragma unroll
                for (int m = 0; m < 4; ++m) atomic_addf(ss + row0 + ai * 128 + m * 16, sacc[ai][m]); }
    }
};
struct EpiPP {
    static constexpr bool PERM = true, AFTER_DRAIN = false;
    bf16* pp;
    __device__ __forceinline__ void operator()(const f32x4 (&acc)[2][2][4][2], const Unit& u, int wr, int wc, int fr, int fq) const {
        const int row0 = u.pm * 256 + wr * 64 + fr, col0 = u.pn * 256 + wc * 32 + 8 * fq;
#pragma unroll
        for (int ai = 0; ai < 2; ++ai)
#pragma unroll
            for (int m = 0; m < 4; ++m) { if (row0 + ai * 128 + m * 16 >= MT) continue; bf16* rowp = pp + (size_t)(row0 + ai * 128 + m * 16) * D + col0;
#pragma unroll
                for (int bj = 0; bj < 2; ++bj) { const f32x4 v0 = acc[ai][bj][m][0], v1 = acc[ai][bj][m][1]; v4u w; w.x = pk2(v0[0], v0[1]); w.y = pk2(v0[2], v0[3]); w.z = pk2(v1[0], v1[1]); w.w = pk2(v1[2], v1[3]); *(v4u*)(rowp + bj * 128) = w; } }
    }
};
struct EpiGate {
    static constexpr bool PERM = true, AFTER_DRAIN = false;
    const bf16* pp; const bf16* hb; float* h; const float* ss2; float* ss3;
    __device__ __forceinline__ void operator()(const f32x4 (&acc)[2][2][4][2], const Unit& u, int wr, int wc, int fr, int fq) const {
        const int row0 = u.pm * 256 + wr * 64 + fr, col0 = u.pn * 256 + wc * 32 + 8 * fq;
        float sacc[2][4];
#pragma unroll
        for (int ai = 0; ai < 2; ++ai) {
            v4u hw[4][2], pw[4][2]; float r2[4];
#pragma unroll
            for (int m = 0; m < 4; ++m) { const int row = row0 + ai * 128 + m * 16; r2[m] = ss2[row];
#pragma unroll
                for (int bj = 0; bj < 2; ++bj) { hw[m][bj] = *(const v4u*)(hb + (size_t)row * D + col0 + bj * 128); pw[m][bj] = *(const v4u*)(pp + (size_t)row * D + col0 + bj * 128); } }
#pragma unroll
            for (int m = 0; m < 4; ++m) { const size_t off = (size_t)(row0 + ai * 128 + m * 16) * D + col0; float s = 0.f;
                const float rr = __builtin_amdgcn_rsqf(r2[m] * (1.0f / D) + EPS);
#pragma unroll
                for (int bj = 0; bj < 2; ++bj) { const v4u h4 = hw[m][bj], p4 = pw[m][bj];
                    const f32x4 hv0 = {lo16(h4.x), hi16(h4.x), lo16(h4.y), hi16(h4.y)}, hv1 = {lo16(h4.z), hi16(h4.z), lo16(h4.w), hi16(h4.w)};
                    const f32x4 pv0 = {lo16(p4.x), hi16(p4.x), lo16(p4.y), hi16(p4.y)}, pv1 = {lo16(p4.z), hi16(p4.z), lo16(p4.w), hi16(p4.w)};
                    const f32x4 a0 = acc[ai][bj][m][0], a1 = acc[ai][bj][m][1]; f32x4 o0, o1;
#pragma unroll
                    for (int j = 0; j < 4; ++j) { o0[j] = hv0[j] + pv0[j] * sigmoid_(rr * a0[j]); o1[j] = hv1[j] + pv1[j] * sigmoid_(rr * a1[j]); }
                    *(f32x4*)(h + off + bj * 128) = o0; *(f32x4*)(h + off + bj * 128 + 4) = o1;
                    s += ((o0[0] * o0[0] + o0[1] * o0[1]) + (o0[2] * o0[2] + o0[3] * o0[3])) + ((o1[0] * o1[0] + o1[1] * o1[1]) + (o1[2] * o1[2] + o1[3] * o1[3])); }
                s += __shfl_xor(s, 16); s += __shfl_xor(s, 32); sacc[ai][m] = s; }
            asm volatile("" ::: "memory"); }
        if (fq == 0) {
#pragma unroll
            for (int ai = 0; ai < 2; ++ai)
#pragma unroll
                for (int m = 0; m < 4; ++m) atomic_addf(ss3 + row0 + ai * 128 + m * 16, sacc[ai][m]); }
    }
};
struct EpiUp {
    static constexpr bool PERM = false, AFTER_DRAIN = false;
    bf16* act; float* raw; const float* ss1; const float* cw; const float* cb; LAS float* wl;
    __device__ __forceinline__ void operator()(const f32x4 (&acc)[2][2][4][2], const Unit& u, int wr, int wc, int fr, int fq) const {
        const int row0 = u.pm * 256 + wr * 64 + fr;
        LAS float* wb = wl + (wr * 4 + wc) * 256;
        { const int l = fq * 16 + fr, v = l >> 3, c4 = l & 7;
          const float* src = ((v & 3) == 3 ? cb : cw + (v & 3) * NUP) + (v >> 2) * DFF + u.pn * 128 + wc * 32 + 4 * c4;
          *(LAS f32x4*)(wb + v * 32 + 4 * c4) = *(const f32x4*)src; }
        float rs[2][4];
#pragma unroll
        for (int ai = 0; ai < 2; ++ai)
#pragma unroll
            for (int m = 0; m < 4; ++m) rs[ai][m] = __builtin_amdgcn_rsqf(ss1[row0 + ai * 128 + m * 16] * (1.0f / D) + EPS);
#pragma unroll
        for (int n = 0; n < 2; ++n) {
            const int cg_ = u.pn * 128 + wc * 32 + 16 * n + 4 * fq;
            const volatile LAS f32x4* wv = (const volatile LAS f32x4*)(wb + 16 * n + 4 * fq);
#pragma unroll
            for (int ai = 0; ai < 2; ++ai) {
                f32x4 l1g = {0.f, 0.f, 0.f, 0.f}, l2g = l1g, l1u = l1g, l2u = l1g;
#pragma unroll
                for (int m = 0; m < 4; ++m) {
                    const int row = row0 + ai * 128 + m * 16;
                    f32x4 sg;
                    { const f32x4 g = acc[ai][0][m][n] * rs[ai][m];
                      if (m == 0 && fr < 2) *(f32x4*)(raw + ((size_t)(row >> 6) * 4 + 2 + fr) * NUP + cg_) = g;
                      if (m == 3 && fr >= 14) *(f32x4*)(raw + ((size_t)(row >> 6) * 4 + (fr - 14)) * NUP + cg_) = g;
                      f32x4 r1, r2, x1, x2;
#pragma unroll
                      for (int j = 0; j < 4; ++j) { r1[j] = dppf<0x121>(g[j]); r2[j] = dppf<0x122>(g[j]); }
#pragma unroll
                      for (int j = 0; j < 4; ++j) { x1[j] = fr == 0 ? l1g[j] : r1[j]; x2[j] = fr < 2 ? l2g[j] : r2[j]; }
                      l1g = r1; l2g = r2;
                      const f32x4 w0 = wv[0], w1 = wv[8], w2 = wv[16], bb = wv[24];
                      const f32x4 ag = w0 * x2 + w1 * x1 + w2 * g + bb;
#pragma unroll
                      for (int j = 0; j < 4; ++j) sg[j] = silu_(ag[j]);
                      asm volatile("" : "+v"(sg)); }
                    f32x4 o;
                    { const f32x4 up = acc[ai][1][m][n] * rs[ai][m];
                      if (m == 0 && fr < 2) *(f32x4*)(raw + ((size_t)(row >> 6) * 4 + 2 + fr) * NUP + DFF + cg_) = up;
                      if (m == 3 && fr >= 14) *(f32x4*)(raw + ((size_t)(row >> 6) * 4 + (fr - 14)) * NUP + DFF + cg_) = up;
                      f32x4 r1, r2, x1, x2;
#pragma unroll
                      for (int j = 0; j < 4; ++j) { r1[j] = dppf<0x121>(up[j]); r2[j] = dppf<0x122>(up[j]); }
#pragma unroll
                      for (int j = 0; j < 4; ++j) { x1[j] = fr == 0 ? l1u[j] : r1[j]; x2[j] = fr < 2 ? l2u[j] : r2[j]; }
                      l1u = r1; l2u = r2;
                      const f32x4 w0 = wv[32], w1 = wv[40], w2 = wv[48], bb = wv[56];
                      o = (w0 * x2 + w1 * x1 + w2 * up + bb) * sg; }
                    v2u w; w.x = pk2(o[0], o[1]); w.y = pk2(o[2], o[3]);
                    *(v2u*)(act + (size_t)row * DFF + cg_) = w; } } }
    }
};

struct EpiAS {
    static constexpr bool PERM = false, AFTER_DRAIN = false;
    float* as; const float* ss1;
    __device__ __forceinline__ void operator()(const f32x4 (&acc)[2][2][4][2], const Unit& u, int wr, int wc, int fr, int fq) const {
#pragma unroll
        for (int m = 0; m < 4; ++m) { const int s_ = wr * 64 + m * 16 + fr; const float r = __builtin_amdgcn_rsqf(ss1[MP + s_] * (1.0f / D) + EPS);
#pragma unroll
            for (int n = 0; n < 2; ++n) { const int cg_ = u.pn * 128 + wc * 32 + 16 * n + 4 * fq;
                *(f32x4*)(as + (size_t)s_ * NUP + cg_) = acc[0][0][m][n] * r; *(f32x4*)(as + (size_t)s_ * NUP + DFF + cg_) = acc[0][1][m][n] * r; } }
    }
};
struct SampleOrder {
    int idx;
    __device__ __forceinline__ bool next(int i, Unit& u) const { if (i != 0 || idx < 0) return false; u.pm = MP / 256; u.pn = idx; return true; }
    __device__ __forceinline__ void a_ready(const Unit&) const {}
    __device__ __forceinline__ void done(const Unit&) const {}
};

struct ProjOrder {
    int first, nw;
    __device__ __forceinline__ bool next(int i, Unit& u) const { if (first < 0) return false; const int j = first + i * nw; if (j >= (MP / 256 + 1) * (D / 256)) return false; u.pm = j >> 3; u.pn = j & 7; return true; }
    __device__ __forceinline__ void a_ready(const Unit&) const {}
    __device__ __forceinline__ void done(const Unit&) const {}
};
template <int RT, int NK>
__device__ __forceinline__ void skinny_batch(f32x4 (&acc)[RT][2], const bf16* ap, const bf16* bp, int K) {
    bf16x8 bq[NK][2], aq[NK][RT];
#pragma unroll
    for (int kk = 0; kk < NK; ++kk) { bq[kk][0] = *(const bf16x8*)(bp + 32 * kk); bq[kk][1] = *(const bf16x8*)(bp + (size_t)16 * K + 32 * kk);
#pragma unroll
        for (int rt = 0; rt < RT; ++rt) aq[kk][rt] = *(const bf16x8*)(ap + (size_t)rt * 16 * K + 32 * kk); }
#pragma unroll
    for (int kk = 0; kk < NK; ++kk)
#pragma unroll
        for (int rt = 0; rt < RT; ++rt) { acc[rt][0] = __builtin_amdgcn_mfma_f32_16x16x32_bf16(bq[kk][0], aq[kk][rt], acc[rt][0], 0, 0, 0); acc[rt][1] = __builtin_amdgcn_mfma_f32_16x16x32_bf16(bq[kk][1], aq[kk][rt], acc[rt][1], 0, 0, 0); }
}
template <int RT, class F>
__device__ __forceinline__ void skinny_gemm(LAS unsigned char* lds, const bf16* A, const bf16* Bt, int N, int K, int u0, int ustride, const F& f) {
    const int tid = threadIdx.x, lane = tid & 63, w = tid >> 6, fr = lane & 15, fq = lane >> 4;
    constexpr int nrb = 8 / RT, ROWS = 16 * RT;
    const int nunits = nrb * (N / 32), kw = K / 8;
    LAS float* red = (LAS float*)lds;
    for (int u = u0; u < nunits; u += ustride) {
        const int rb = u % nrb, cb = u / nrb, row0 = rb * ROWS, col0 = cb * 32;
        f32x4 acc[RT][2];
#pragma unroll
        for (int rt = 0; rt < RT; ++rt) { acc[rt][0] = (f32x4){0.f, 0.f, 0.f, 0.f}; acc[rt][1] = (f32x4){0.f, 0.f, 0.f, 0.f}; }
        const bf16* ap = A + (size_t)(row0 + fr) * K + w * kw + 8 * fq;
        const bf16* bp = Bt + (size_t)(col0 + fr) * K + w * kw + 8 * fq;
        if constexpr (RT <= 2) {
            int k = 0;
            if (kw == 704) { skinny_batch<RT, 11>(acc, ap, bp, K); skinny_batch<RT, 11>(acc, ap + 352, bp + 352, K); k = 704; }
            for (; k + 256 <= kw; k += 256) skinny_batch<RT, 8>(acc, ap + k, bp + k, K);
            for (; k < kw; k += 32) skinny_batch<RT, 1>(acc, ap + k, bp + k, K);
        } else {
#pragma unroll 2
        for (int k = 0; k < kw; k += 32) {
            const bf16x8 b0 = *(const bf16x8*)(bp + k), b1 = *(const bf16x8*)(bp + (size_t)16 * K + k);
#pragma unroll
            for (int rt = 0; rt < RT; ++rt) { const bf16x8 av = *(const bf16x8*)(ap + (size_t)rt * 16 * K + k);
                acc[rt][0] = __builtin_amdgcn_mfma_f32_16x16x32_bf16(b0, av, acc[rt][0], 0, 0, 0);
                acc[rt][1] = __builtin_amdgcn_mfma_f32_16x16x32_bf16(b1, av, acc[rt][1], 0, 0, 0); }
        }
        }
#pragma unroll
        for (int rt = 0; rt < RT; ++rt)
#pragma unroll
            for (int ct = 0; ct < 2; ++ct) *(LAS f32x4*)(red + (w * ROWS + 16 * rt + fr) * 32 + 16 * ct + 4 * fq) = acc[rt][ct];
        __syncthreads();
#pragma unroll
        for (int it = 0; it < RT; ++it) { const int e = tid + 512 * it, r = e >> 5, c = e & 31; float v = 0.f;
#pragma unroll
            for (int ww = 0; ww < 8; ++ww) v += red[(ww * ROWS + r) * 32 + c];
            f(row0 + r, col0 + c, v); }
        __syncthreads();
    }
}
__device__ __forceinline__ float half_wave_sum(float v) {
#pragma unroll
    for (int o = 1; o < 32; o <<= 1) v += __shfl_xor(v, o);
    return v;
}

__device__ __forceinline__ void transpose_item(const float* W, int K, int N, const float* g, bf16* WT, bool upmap, LAS float* scr, int item, int lane) {
    const int nblk = N / 64, kb = item / nblk, nb = item % nblk, k0 = 64 * kb, n0 = 64 * nb;
    const float* src = W + (size_t)k0 * N + n0 + lane;
#pragma unroll
    for (int h = 0; h < 2; ++h) {
        float v[32];
#pragma unroll
        for (int i = 0; i < 32; ++i) v[i] = __builtin_nontemporal_load(src + (size_t)(32 * h + i) * N);
#pragma unroll
        for (int i = 0; i < 32; ++i) { float x = v[i]; if (g) x *= g[k0 + 32 * h + i]; scr[(32 * h + i) * 65 + lane] = x; }
    }
    LDS_WAIT(); asm volatile("" ::: "memory");
    const int c = lane & 7;
#pragma unroll
    for (int j = 0; j < 8; ++j) { const int n = (lane >> 3) + 8 * j; const LAS float* s = scr + (8 * c) * 65 + n;
        v4u o; o.x = pk2(s[0 * 65], s[1 * 65]); o.y = pk2(s[2 * 65], s[3 * 65]); o.z = pk2(s[4 * 65], s[5 * 65]); o.w = pk2(s[6 * 65], s[7 * 65]);
        int R = n0 + n; if (upmap) { const int half = R >= DFF ? 1 : 0, jj = R - half * DFF; R = 256 * (jj >> 7) + 128 * half + (jj & 127); }
        *(v4u*)(WT + (size_t)R * K + k0 + 8 * c) = o; }
    LDS_WAIT(); asm volatile("" ::: "memory");
}
__device__ __forceinline__ void rms_row_to_bf16(const float* xrow, bf16* orow, float* rinv, int lane) {
    const f32x4* xr = (const f32x4*)xrow + lane;
    f32x4 v[8]; float s = 0.f;
#pragma unroll
    for (int j = 0; j < 8; ++j) { v[j] = __builtin_nontemporal_load(xr + 64 * j);
 s += (v[j][0] * v[j][0] + v[j][1] * v[j][1]) + (v[j][2] * v[j][2] + v[j][3] * v[j][3]); }
    const float ms = wave_sum(s) * (1.0f / D) + EPS, r = __builtin_amdgcn_rsqf(ms);
    if (lane == 0) *rinv = __builtin_sqrtf(ms);
    v2u* o8 = (v2u*)orow + lane;
#pragma unroll
    for (int j = 0; j < 8; ++j) { v2u w; w.x = pk2(v[j][0] * r, v[j][1] * r); w.y = pk2(v[j][2] * r, v[j][3] * r); o8[64 * j] = w; }
}

__device__ __forceinline__ void mm128(f32x4 (&acc)[8], const LAS bf16* A, const LAS bf16* B, int wave, int fr, int fq) {
#pragma unroll
    for (int ks = 0; ks < 4; ++ks) {
        const bf16x8 a = *(const LAS bf16x8*)(A + (16 * wave + fr) * LDP + 32 * ks + 8 * fq);
#pragma unroll
        for (int ct = 0; ct < 8; ++ct) { const bf16x8 b = *(const LAS bf16x8*)(B + (16 * ct + fr) * LDP + 32 * ks + 8 * fq);
            acc[ct] = __builtin_amdgcn_mfma_f32_16x16x32_bf16(b, a, acc[ct], 0, 0, 0); }
    }
}
template <bool TRANS, bool DEC>
__device__ __forceinline__ void stage_rope(LAS bf16* dst, const bf16* zb, const float* rope, float scale, float l2g, int tid) {
#pragma unroll
    for (int it = 0; it < 2; ++it) { const int idx = tid + 512 * it, j = idx >> 3, d8 = idx & 7;
        const v4u x1 = *(const v4u*)(zb + (size_t)j * NIN + 8 * d8), x2 = *(const v4u*)(zb + (size_t)j * NIN + 64 + 8 * d8);
        const f32x4* rp = (const f32x4*)(rope + (size_t)(j * 64 + 8 * d8) * 2);
        float sc = scale; if (DEC) sc *= __builtin_amdgcn_exp2f(l2g * (float)(127 - j));
        float o1[8], o2[8];
#pragma unroll
        for (int p = 0; p < 4; ++p) { const f32x4 cs = rp[p]; const float a0 = lo16(x1[p]), a1 = hi16(x1[p]), b0 = lo16(x2[p]), b1 = hi16(x2[p]);
            o1[2 * p] = (a0 * cs[0] - b0 * cs[1]) * sc; o2[2 * p] = (b0 * cs[0] + a0 * cs[1]) * sc;
            o1[2 * p + 1] = (a1 * cs[2] - b1 * cs[3]) * sc; o2[2 * p + 1] = (b1 * cs[2] + a1 * cs[3]) * sc; }
        if (!TRANS) { v4u w1, w2;
#pragma unroll
            for (int p = 0; p < 4; ++p) { w1[p] = pk2(o1[2 * p], o1[2 * p + 1]); w2[p] = pk2(o2[2 * p], o2[2 * p + 1]); }
            *(LAS v4u*)(dst + j * LDP + 8 * d8) = w1; *(LAS v4u*)(dst + j * LDP + 64 + 8 * d8) = w2; }
        else {
#pragma unroll
            for (int i = 0; i < 8; ++i) { dst[(8 * d8 + i) * LDP + j] = f2bf(o1[i]); dst[(64 + 8 * d8 + i) * LDP + j] = f2bf(o2[i]); } }
    }
}
__device__ __forceinline__ void stage_T(LAS bf16* dst, const bf16* zb, int tid) {
#pragma unroll
    for (int it = 0; it < 4; ++it) { const int idx = tid + 512 * it, j = idx >> 4, c8 = idx & 15;
        const v4u x = *(const v4u*)(zb + (size_t)j * NIN + 8 * c8);
#pragma unroll
        for (int p = 0; p < 4; ++p) { dst[(8 * c8 + 2 * p) * LDP + j] = (bf16)(x[p] & 0xffffu); dst[(8 * c8 + 2 * p + 1) * LDP + j] = (bf16)(x[p] >> 16); } }
}


struct RopeX { v4u x1[2], x2[2]; };
struct RopeCS { f32x4 cs[2][4]; };
struct TileX { v4u x[4]; };
__device__ __forceinline__ void rope_load(RopeX& r, const bf16* zb, int tid) {
#pragma unroll
    for (int it = 0; it < 2; ++it) { const int idx = tid + 512 * it, j = idx >> 3, d8 = idx & 7; r.x1[it] = *(const v4u*)(zb + (size_t)j * NIN + 8 * d8); r.x2[it] = *(const v4u*)(zb + (size_t)j * NIN + 64 + 8 * d8); }
}
__device__ __forceinline__ void rope_cs_load(RopeCS& c, const float* rope, int tid) {
#pragma unroll
    for (int it = 0; it < 2; ++it) { const int idx = tid + 512 * it, j = idx >> 3, d8 = idx & 7; const f32x4* rp = (const f32x4*)(rope + (size_t)(j * 64 + 8 * d8) * 2);
#pragma unroll
        for (int p = 0; p < 4; ++p) c.cs[it][p] = rp[p]; }
}
template <bool TRANS, bool DEC>
__device__ __forceinline__ void rope_commit(LAS bf16* dst, const RopeX& r, const RopeCS& c, float scale, float l2g, int tid) {
#pragma unroll
    for (int it = 0; it < 2; ++it) { const int idx = tid + 512 * it, j = idx >> 3, d8 = idx & 7;
        float sc = scale; if (DEC) sc *= __builtin_amdgcn_exp2f(l2g * (float)(127 - j));
        float o1[8], o2[8];
#pragma unroll
        for (int p = 0; p < 4; ++p) { const f32x4 cs = c.cs[it][p]; const float a0 = lo16(r.x1[it][p]), a1 = hi16(r.x1[it][p]), b0 = lo16(r.x2[it][p]), b1 = hi16(r.x2[it][p]);
            o1[2 * p] = (a0 * cs[0] - b0 * cs[1]) * sc; o2[2 * p] = (b0 * cs[0] + a0 * cs[1]) * sc;
            o1[2 * p + 1] = (a1 * cs[2] - b1 * cs[3]) * sc; o2[2 * p + 1] = (b1 * cs[2] + a1 * cs[3]) * sc; }
        if (!TRANS) { v4u w1, w2;
#pragma unroll
            for (int p = 0; p < 4; ++p) { w1[p] = pk2(o1[2 * p], o1[2 * p + 1]); w2[p] = pk2(o2[2 * p], o2[2 * p + 1]); }
            *(LAS v4u*)(dst + j * LDP + 8 * d8) = w1; *(LAS v4u*)(dst + j * LDP + 64 + 8 * d8) = w2; }
        else {
#pragma unroll
            for (int i = 0; i < 8; ++i) { dst[(8 * d8 + i) * LDP + j] = f2bf(o1[i]); dst[(64 + 8 * d8 + i) * LDP + j] = f2bf(o2[i]); } }
    }
}
__device__ __forceinline__ void tile_load(TileX& t, const bf16* zb, int tid) {
#pragma unroll
    for (int it = 0; it < 4; ++it) { const int idx = tid + 512 * it, j = idx >> 4, c8 = idx & 15; t.x[it] = *(const v4u*)(zb + (size_t)j * NIN + 8 * c8); }
}
__device__ __forceinline__ void tile_commit_T(LAS bf16* dst, const TileX& t, int tid) {
#pragma unroll
    for (int it = 0; it < 4; ++it) { const int idx = tid + 512 * it, j = idx >> 4, c8 = idx & 15;
#pragma unroll
        for (int p = 0; p < 4; ++p) { dst[(8 * c8 + 2 * p) * LDP + j] = (bf16)(t.x[it][p] & 0xffffu); dst[(8 * c8 + 2 * p + 1) * LDP + j] = (bf16)(t.x[it][p] >> 16); } }
}

typedef short s16x4 __attribute__((ext_vector_type(4)));
__device__ __forceinline__ bf16x8 tr_frag(const LAS bf16* T, int c, int ks, int lane) {
    const int g = lane >> 4, q = (lane & 15) >> 2, p = lane & 3;
    const LAS bf16* a0 = T + (32 * ks + 8 * g + q) * LDP + 16 * c + 4 * p;
    const s16x4 lo = __builtin_amdgcn_ds_read_tr16_b64_v4i16((LAS s16x4*)a0), hi = __builtin_amdgcn_ds_read_tr16_b64_v4i16((LAS s16x4*)(a0 + 4 * LDP));
    return (bf16x8){lo[0], lo[1], lo[2], lo[3], hi[0], hi[1], hi[2], hi[3]};
}
__device__ __forceinline__ void mm128_nt(f32x4 (&acc)[8], const LAS bf16* A, const LAS bf16* B, int wave, int lane) {
    const int fr = lane & 15, fq = lane >> 4;
#pragma unroll
    for (int ks = 0; ks < 4; ++ks) {
        const bf16x8 a = *(const LAS bf16x8*)(A + (16 * wave + fr) * LDP + 32 * ks + 8 * fq);
#pragma unroll
        for (int ct = 0; ct < 8; ++ct) acc[ct] = __builtin_amdgcn_mfma_f32_16x16x32_bf16(tr_frag(B, ct, ks, lane), a, acc[ct], 0, 0, 0);
    }
}
__device__ __forceinline__ void mm128_tt(f32x4 (&acc)[8], const LAS bf16* At, const LAS bf16* Bn, int wave, int lane) {
#pragma unroll
    for (int ks = 0; ks < 4; ++ks) {
        const bf16x8 a = tr_frag(At, wave, ks, lane);
#pragma unroll
        for (int ct = 0; ct < 8; ++ct) acc[ct] = __builtin_amdgcn_mfma_f32_16x16x32_bf16(tr_frag(Bn, ct, ks, lane), a, acc[ct], 0, 0, 0);
    }
}
__device__ __forceinline__ void tile_commit_N(LAS bf16* dst, const TileX& t, int tid) {
#pragma unroll
    for (int it = 0; it < 4; ++it) { const int idx = tid + 512 * it, j = idx >> 4, c8 = idx & 15; *(LAS v4u*)(dst + j * LDP + 8 * c8) = t.x[it]; }
}

__global__ void __launch_bounds__(512, 2) mk_fwd(Params a) {
    extern __shared__ __attribute__((aligned(16))) unsigned char lds_raw[];
    LAS unsigned char* lds = (LAS unsigned char*)lds_raw;
    const int tid = threadIdx.x, lane = tid & 63, wave = __builtin_amdgcn_readfirstlane(tid >> 6), fr = lane & 15, fq = lane >> 4;
    const int G = gridDim.x, blk = blockIdx.x;
    const int gw = blk * 8 + wave, NGW = G * 8;
    const int gt = blk * 512 + tid, NGT = G * 512;
    unsigned char* ws = a.ws;
#define x_p (a.in[0])
#define x_s (a.in[1])
#define p_p (a.in[2])
#define p_s (a.in[3])
#define state_ret (a.in[4])
#define state_conv (a.in[5])
#define gm_ln_g (a.in[8])
#define gm_ln_b (a.in[9])
#define gm_ws (a.in[10])
#define gm_bs (a.in[11])
#define conv_w (a.in[15])
#define conv_b (a.in[16])
#define g_final (a.in[21])
#define out (a.out)
#define SS1 ((float*)(ws + WS_SS1))
#define SS2 ((float*)(ws + WS_SS2))
#define SS3 ((float*)(ws + WS_SS3))
#define STATS ((float*)(ws + WS_STATS))
#define ROPE ((float*)(ws + WS_ROPE))
#define ROPES ((float*)(ws + WS_ROPES))
#define Win_t ((bf16*)(ws + WS_WIN))
#define Wo_t ((bf16*)(ws + WS_WO))
#define Wup_t ((bf16*)(ws + WS_WUP))
#define Wdn_t ((bf16*)(ws + WS_WDN))
#define Wg_t ((bf16*)(ws + WS_WG))
#define Wp_t ((bf16*)(ws + WS_WP))
#define AB ((bf16*)(ws + WS_AB))
#define PB ((bf16*)(ws + WS_PB))
#define MIX ((bf16*)(ws + WS_MIX))
#define Z ((bf16*)(ws + WS_Z))
#define ACT ((bf16*)(ws + WS_ACT))
#define KV ((float*)(ws + WS_KV))
#define PP ((bf16*)(ws + WS_MIX))
#define RAW ((float*)(ws + WS_RAW))
#define AS ((float*)(ws + WS_AS))

    volatile LAS unsigned* MISC = (volatile LAS unsigned*)(lds + MISC_OFF);
    if (tid < 64) MISC[tid] = 0u;
    __syncthreads();
    XcdBarrier bar; bar.bar = (unsigned*)(ws + WS_BAR); bar.x = 0; bar.st = nullptr;
    if (MK_N_LAUNCHES == 1) bar = xcd_barrier_post((unsigned*)(ws + WS_BAR), MISC + 8);
    const int lo = a.ph_lo, hi = a.ph_hi;
#ifndef PHMASK
#define PHMASK 0xffff
#endif
#define IN(k) (((PHMASK >> (k)) & 1) && lo <= (k) && (k) < hi)
#define SEAM(k) do { if (IN(k) && IN((k) + 1)) { if (a.use_cg) cg::this_grid().sync(); else xcd_barrier(bar); } } while (0)

    if (IN(0)) {
        LAS float* scr = (LAS float*)(lds + wave * 16640);
        constexpr int I_IN = (D / 64) * (NIN / 64);
        for (int it = gw; it < I_IN; it += NGW) transpose_item(a.in[7], D, NIN, a.in[6], Win_t, false, scr, it, lane);
        for (int m = gw; m < MT; m += NGW) rms_row_to_bf16(m < MP ? x_p + (size_t)m * D : x_s + (size_t)(m - MP) * D, AB + (size_t)m * D, (float*)(ws + WS_RINV) + m, lane);
        for (int i = gt; i < MT * PLE / 4; i += NGT) { const f32x4 v = __builtin_nontemporal_load(i < MP * PLE / 4 ? (const f32x4*)p_p + i : (const f32x4*)p_s + (i - MP * PLE / 4)); v2u w; w.x = pk2(v[0], v[1]); w.y = pk2(v[2], v[3]); ((v2u*)PB)[i] = w; }
        for (int i = gt; i < SEQ * 64 + 64; i += NGT) { const int pos = i < SEQ * 64 ? (i >> 6) : 16384, fi = i & 63;
            const float ang = (float)pos * a.invf[fi]; double t = (double)ang * 0.15915494309189535; t -= __builtin_rint(t); const float rev = (float)t;
            float* dst = i < SEQ * 64 ? ROPE + 2 * (size_t)i : ROPES + 2 * fi; dst[0] = __builtin_amdgcn_cosf(rev); dst[1] = __builtin_amdgcn_sinf(rev); }
        for (int i = gt; i < MT; i += NGT) { SS1[i] = 0.f; SS2[i] = 0.f; SS3[i] = 0.f; }
    }
    SEAM(0);

    if (IN(1)) {
        { pg8::Gemm g{AB, Win_t, MP, NIN, D}; pg8::StaticOrder S; S.init(MP, NIN, G, blk); EpiZ E{Z};
          pg8::gemm_phase<EpiZ, pg8::StaticOrder, true, true>(lds, g, S, E); }
        auto f = [&](int s, int n, float v) { const float o = n < 3072 ? v : (n < 4096 ? silu_(v) : gelu_(v)); Z[(size_t)(MP + s) * NIN + n] = f2bf(o); };
        skinny_gemm<8>(lds, AB + (size_t)MP * D, Win_t, NIN, D, blk, G, f);
    }
    SEAM(1);

    if (IN(2)) {
        for (int pass = 0; pass < 2; ++pass) {
        if ((pass ^ (blk & 1)) == 0) {
        { LAS float* qs = (LAS float*)lds; LAS float* ks = qs + 128; LAS float* vs = ks + 128; LAS float* red = vs + 128;
          const int e4 = tid & 31, dg = tid >> 5;
          for (int u = blk; u < MS * NH; u += G) { const int s = u >> 3, h = u & 7; const bf16* zr = Z + (size_t)(MP + s) * NIN;
            const float* S0 = state_ret + (size_t)u * 16384 + 4 * e4; float* S1 = out + O_RETS + (size_t)u * 16384 + 4 * e4;
            f32x4 s0[8];
#pragma unroll
            for (int i = 0; i < 8; ++i) s0[i] = __builtin_nontemporal_load((const f32x4*)(S0 + (dg + 16 * i) * 128));
            if (tid < 64) { const float c = ROPES[2 * tid], sn = ROPES[2 * tid + 1];
                const float q1 = bf2f(zr[128 * h + tid]), q2 = bf2f(zr[128 * h + 64 + tid]), k1 = bf2f(zr[1024 + 128 * h + tid]), k2 = bf2f(zr[1024 + 128 * h + 64 + tid]);
                qs[tid] = q1 * c - q2 * sn; qs[tid + 64] = q2 * c + q1 * sn; ks[tid] = (k1 * c - k2 * sn) * 0.08838834764831845f; ks[tid + 64] = (k2 * c + k1 * sn) * 0.08838834764831845f; }
            else if (tid < 192) vs[tid - 64] = bf2f(zr[2048 + 128 * h + tid - 64]);
            unsigned gg = 0u; if (tid < 64) gg = *(const unsigned*)(zr + 3072 + 128 * h + 2 * tid);
            __syncthreads();
            const float gamma = 1.0f - __builtin_amdgcn_exp2f((float)(-5 - h));
            const f32x4 vv = *(const LAS f32x4*)(vs + 4 * e4); f32x4 o = {0.f, 0.f, 0.f, 0.f};
#pragma unroll
            for (int i = 0; i < 8; ++i) { const int d = dg + 16 * i; const f32x4 sn = s0[i] * gamma + vv * ks[d]; __builtin_nontemporal_store(sn, (f32x4*)(S1 + d * 128)); o += sn * qs[d]; }
            *(LAS f32x4*)(red + dg * 128 + 4 * e4) = o;
            __syncthreads();
            if (tid < 64) { float o0 = 0.f, o1 = 0.f;
#pragma unroll
                for (int i = 0; i < 16; ++i) { o0 += red[i * 128 + 2 * tid]; o1 += red[i * 128 + 2 * tid + 1]; }
                const float r = __builtin_amdgcn_rsqf(wave_sum(o0 * o0 + o1 * o1) * (1.0f / 128.0f) + EPS);
                *(unsigned*)(MIX + (size_t)(MP + s) * D + 128 * h + 2 * tid) = pk2(o0 * r * lo16(gg), o1 * r * hi16(gg)); }
            __syncthreads(); } }
        } else {
        { LAS bf16* Kt = (LAS bf16*)lds; LAS bf16* Vt = (LAS bf16*)(lds + TILE_B);
          for (int u = blk; u < 512; u += G) { const int b = u >> 7, h = (u >> 4) & 7, c = u & 15; const size_t R0 = (size_t)b * SEQ + 128 * c;
            RopeX kx; RopeCS cs; TileX vx;
            rope_load(kx, Z + R0 * NIN + 1024 + 128 * h, tid); rope_cs_load(cs, ROPE + (size_t)(128 * c) * 128, tid); tile_load(vx, Z + R0 * NIN + 2048 + 128 * h, tid);
            rope_commit<false, true>(Kt, kx, cs, 0.08838834764831845f, a.log2g[h], tid);
            tile_commit_N(Vt, vx, tid);
            __syncthreads();
            f32x4 acc[8];
#pragma unroll
            for (int ct = 0; ct < 8; ++ct) acc[ct] = (f32x4){0.f, 0.f, 0.f, 0.f};
            mm128_tt(acc, Kt, Vt, wave, lane);
            float* kv = KV + (size_t)u * 16384 + (16 * wave + fr) * 128 + 4 * fq;
#pragma unroll
            for (int ct = 0; ct < 8; ++ct) *(f32x4*)(kv + 16 * ct) = acc[ct];
            __syncthreads(); } }
        for (int r0 = gw; r0 < MP; r0 += 2 * NGW) { const int r1 = r0 + NGW;
            const bf16* p0 = Z + (size_t)r0 * NIN + 5120 + 16 * lane; const bf16* p1 = Z + (size_t)(r1 < MP ? r1 : r0) * NIN + 5120 + 16 * lane;
            const v4u xa0 = *(const v4u*)p0, xa1 = *(const v4u*)(p0 + 8), xb0 = *(const v4u*)p1, xb1 = *(const v4u*)(p1 + 8);
            float va[16], vb[16];
#pragma unroll
            for (int j = 0; j < 4; ++j) { va[2 * j] = lo16(xa0[j]); va[2 * j + 1] = hi16(xa0[j]); va[8 + 2 * j] = lo16(xa1[j]); va[8 + 2 * j + 1] = hi16(xa1[j]);
                                          vb[2 * j] = lo16(xb0[j]); vb[2 * j + 1] = hi16(xb0[j]); vb[8 + 2 * j] = lo16(xb1[j]); vb[8 + 2 * j + 1] = hi16(xb1[j]); }
            float sa = 0.f, sb = 0.f;
#pragma unroll
            for (int j = 0; j < 16; ++j) { sa += va[j]; sb += vb[j]; }
            const float ma = wave_sum(sa) * (1.0f / 1024.0f), mb = wave_sum(sb) * (1.0f / 1024.0f); float qa = 0.f, qb = 0.f;
#pragma unroll
            for (int j = 0; j < 16; ++j) { const float da = va[j] - ma, db = vb[j] - mb; qa += da * da; qb += db * db; }
            const float ra = __builtin_amdgcn_rsqf(wave_sum(qa) * (1.0f / 1024.0f) + EPS), rb = __builtin_amdgcn_rsqf(wave_sum(qb) * (1.0f / 1024.0f) + EPS);
            if (lane == 0) { STATS[2 * r0] = ma; STATS[2 * r0 + 1] = ra; if (r1 < MP) { STATS[2 * r1] = mb; STATS[2 * r1 + 1] = rb; } } }
        for (int row = MP + gw; row < MT; row += NGW) { const bf16* p = Z + (size_t)row * NIN + 5120 + 16 * lane; const v4u x0 = *(const v4u*)p, x1 = *(const v4u*)(p + 8);
            const int s_ = row - MP, c0 = 16 * lane, grp = lane >> 3; const float w00 = gm_ws[grp * 16384], b0 = gm_bs[grp * 128];
            const bf16* up = Z + (size_t)row * NIN + 4096 + c0; const v4u u0 = *(const v4u*)up, u1 = *(const v4u*)(up + 8);
            float v[16];
#pragma unroll
            for (int j = 0; j < 4; ++j) { v[2 * j] = lo16(x0[j]); v[2 * j + 1] = hi16(x0[j]); v[8 + 2 * j] = lo16(x1[j]); v[8 + 2 * j + 1] = hi16(x1[j]); }
            float s = 0.f;
#pragma unroll
            for (int j = 0; j < 16; ++j) s += v[j];
            const float mean = wave_sum(s) * (1.0f / 1024.0f); float q = 0.f;
#pragma unroll
            for (int j = 0; j < 16; ++j) { v[j] -= mean; q += v[j] * v[j]; }
            const float rstd = __builtin_amdgcn_rsqf(wave_sum(q) * (1.0f / 1024.0f) + EPS);
            float uu[16];
#pragma unroll
            for (int j = 0; j < 4; ++j) { uu[2 * j] = lo16(u0[j]); uu[2 * j + 1] = hi16(u0[j]); uu[8 + 2 * j] = lo16(u1[j]); uu[8 + 2 * j + 1] = hi16(u1[j]); }
            float vn[16], mo[16];
#pragma unroll
            for (int j = 0; j < 16; ++j) { vn[j] = v[j] * rstd * gm_ln_g[c0 + j] + gm_ln_b[c0 + j]; mo[j] = uu[j] * (w00 * vn[j] + b0); }
            float* gv = out + O_GMV + (size_t)s_ * 1024 + c0;
#pragma unroll
            for (int j = 0; j < 4; ++j) *(f32x4*)(gv + 4 * j) = (f32x4){vn[4 * j], vn[4 * j + 1], vn[4 * j + 2], vn[4 * j + 3]};
            v4u w0, w1;
#pragma unroll
            for (int j = 0; j < 4; ++j) { w0[j] = pk2(mo[2 * j], mo[2 * j + 1]); w1[j] = pk2(mo[8 + 2 * j], mo[8 + 2 * j + 1]); }
            bf16* mp = MIX + (size_t)row * D + 1024 + c0; *(v4u*)mp = w0; *(v4u*)(mp + 8) = w1; }
        } }
    }
    SEAM(2);

    if (IN(3)) {
        auto convert_rest = [&]() {
            LAS float* scr = (LAS float*)(lds + wave * 16640);
            constexpr int I_O = (D / 64) * (D / 64), I_UP = (D / 64) * (NUP / 64), I_DN = (DFF / 64) * (D / 64), I_G = I_O, I_P = (PLE / 64) * (D / 64);
            constexpr int NITEMS = I_O + I_UP + I_DN + I_G + I_P;
            for (int it = gw; it < NITEMS; it += NGW) {
                int r = it;
                if (r < I_UP) { transpose_item(a.in[14], D, NUP, a.in[13], Wup_t, true, scr, r, lane); continue; } r -= I_UP;
                if (r < I_O) { transpose_item(a.in[12], D, D, nullptr, Wo_t, false, scr, r, lane); continue; } r -= I_O;
                if (r < I_DN) { transpose_item(a.in[17], DFF, D, nullptr, Wdn_t, false, scr, r, lane); continue; } r -= I_DN;
                if (r < I_G) { transpose_item(a.in[19], D, D, a.in[18], Wg_t, false, scr, r, lane); continue; } r -= I_G;
                transpose_item(a.in[20], PLE, D, nullptr, Wp_t, false, scr, r, lane);
            }
            __syncthreads(); };
        if (!(blk & 1)) convert_rest();
        {
        LAS bf16* T0 = (LAS bf16*)lds; LAS bf16* T1 = (LAS bf16*)(lds + TILE_B); LAS bf16* T2 = (LAS bf16*)(lds + 2 * TILE_B); LAS bf16* T3 = (LAS bf16*)(lds + 3 * TILE_B);
        for (int u = blk; u < 512; u += G) { const int bh = u >> 4, b = bh >> 3, h = bh & 7, c = u < 256 ? (u & 15) : 15 - (u & 15); const size_t R0 = (size_t)b * SEQ + 128 * c; const float l2g = a.log2g[h];
            const int i_ = 16 * wave + fr;
            RopeX qx, kx; RopeCS cs; TileX vx; v2u gg[8];
            const float* kvb = KV + (size_t)bh * 16 * 16384;
            f32x4 tc[8];
#pragma unroll
            for (int i = 0; i < 8; ++i) tc[i] = *(const f32x4*)(kvb + 4 * (tid + 512 * i));
            rope_load(qx, Z + R0 * NIN + 128 * h, tid); rope_load(kx, Z + R0 * NIN + 1024 + 128 * h, tid); rope_cs_load(cs, ROPE + (size_t)(128 * c) * 128, tid); tile_load(vx, Z + R0 * NIN + 2048 + 128 * h, tid);
            rope_commit<false, false>(T0, qx, cs, 1.0f, 0.f, tid);
            rope_commit<false, false>(T1, kx, cs, 0.08838834764831845f, 0.f, tid);
            asm volatile("" ::: "memory");
            { const float Gc = __builtin_amdgcn_exp2f(l2g * 128.0f);
              f32x4 sp[8];
#pragma unroll
              for (int i = 0; i < 8; ++i) sp[i] = (f32x4){0.f, 0.f, 0.f, 0.f};
              for (int j = 0; j < c; ++j) { f32x4 tn[8];
#pragma unroll
                  for (int i = 0; i < 8; ++i) tn[i] = *(const f32x4*)(kvb + (size_t)(j + 1) * 16384 + 4 * (tid + 512 * i));
#pragma unroll
                  for (int i = 0; i < 8; ++i) { sp[i] = sp[i] * Gc + tc[i]; tc[i] = tn[i]; } }
              if (c == 15) {
#pragma unroll
                  for (int i = 0; i < 8; ++i) *(f32x4*)(out + O_RETP + (size_t)bh * 16384 + 4 * (tid + 512 * i)) = sp[i] * Gc + tc[i]; }
#pragma unroll
              for (int i = 0; i < 8; ++i) { const int ch = tid + 512 * i, d = ch >> 5, e4 = ch & 31; v2u w; w.x = pk2(sp[i][0], sp[i][1]); w.y = pk2(sp[i][2], sp[i][3]);
                  *(LAS v2u*)(T3 + d * LDP + 4 * e4) = w; } }
            tile_commit_N(T2, vx, tid);
            __syncthreads();
            { const bf16* gp = Z + (R0 + i_) * NIN + 3072 + 128 * h + 4 * fq;
#pragma unroll
              for (int ct = 0; ct < 8; ++ct) gg[ct] = *(const v2u*)(gp + 16 * ct); }
            f32x4 acc2[8], acc1[8];
#pragma unroll
            for (int ct = 0; ct < 8; ++ct) { acc2[ct] = (f32x4){0.f, 0.f, 0.f, 0.f}; acc1[ct] = (f32x4){0.f, 0.f, 0.f, 0.f}; }
            mm128_nt(acc2, T0, T3, wave, lane);
            mm128(acc1, T0, T1, wave, fr, fq);
            __syncthreads();
#pragma unroll
            for (int ct = 0; ct < 8; ++ct) { float sv[4];
#pragma unroll
                for (int t = 0; t < 4; ++t) { const int j = 16 * ct + 4 * fq + t; sv[t] = i_ >= j ? acc1[ct][t] * __builtin_amdgcn_exp2f(l2g * (float)(i_ - j)) : 0.f; }
                v2u w; w.x = pk2(sv[0], sv[1]); w.y = pk2(sv[2], sv[3]); *(LAS v2u*)(T1 + i_ * LDP + 16 * ct + 4 * fq) = w; }
            __syncthreads();
#pragma unroll
            for (int ct = 0; ct < 8; ++ct) acc1[ct] = (f32x4){0.f, 0.f, 0.f, 0.f};
            mm128_nt(acc1, T1, T2, wave, lane);
            const float qd = __builtin_amdgcn_exp2f(l2g * (float)(i_ + 1)); float ssq = 0.f;
#pragma unroll
            for (int ct = 0; ct < 8; ++ct) { acc1[ct] = acc1[ct] + acc2[ct] * qd; ssq += (acc1[ct][0] * acc1[ct][0] + acc1[ct][1] * acc1[ct][1]) + (acc1[ct][2] * acc1[ct][2] + acc1[ct][3] * acc1[ct][3]); }
            ssq += __shfl_xor(ssq, 16); ssq += __shfl_xor(ssq, 32);
            const float rn = __builtin_amdgcn_rsqf(ssq * (1.0f / 128.0f) + EPS);
            bf16* mp = MIX + (R0 + i_) * D + 128 * h + 4 * fq;
#pragma unroll
            for (int ct = 0; ct < 8; ++ct) { v2u w;
                w.x = pk2(acc1[ct][0] * rn * lo16(gg[ct].x), acc1[ct][1] * rn * hi16(gg[ct].x)); w.y = pk2(acc1[ct][2] * rn * lo16(gg[ct].y), acc1[ct][3] * rn * hi16(gg[ct].y)); *(v2u*)(mp + 16 * ct) = w; }
            __syncthreads(); }
        for (int u = blk; u < 512; u += G) { const int b = u >> 7, c = (u >> 3) & 15, grp = u & 7; const size_t R0 = (size_t)b * SEQ + 128 * c;
            const int t_ = 16 * wave + fr, d8 = tid & 15;
            f32x4 wl[4][2]; v4u xv[4]; float st[4][2]; v2u uu[8]; float lg[8], lb[8];
#pragma unroll
            for (int it = 0; it < 4; ++it) { const int idx = tid + 512 * it, t = idx >> 4; const float* wp = gm_ws + (size_t)grp * 16384 + t * 128 + 8 * d8;
                wl[it][0] = *(const f32x4*)wp; wl[it][1] = *(const f32x4*)(wp + 4);
                xv[it] = *(const v4u*)(Z + (R0 + t) * NIN + 5120 + 128 * grp + 8 * d8); st[it][0] = STATS[2 * (R0 + t)]; st[it][1] = STATS[2 * (R0 + t) + 1]; }
#pragma unroll
            for (int j = 0; j < 8; ++j) { lg[j] = gm_ln_g[128 * grp + 8 * d8 + j]; lb[j] = gm_ln_b[128 * grp + 8 * d8 + j]; }
            const float bsv = gm_bs[grp * 128 + t_];
#pragma unroll
            for (int it = 0; it < 4; ++it) { const int idx = tid + 512 * it, t = idx >> 4;
                float wv[8] = {wl[it][0][0], wl[it][0][1], wl[it][0][2], wl[it][0][3], wl[it][1][0], wl[it][1][1], wl[it][1][2], wl[it][1][3]};
#pragma unroll
                for (int j = 0; j < 8; ++j) if (8 * d8 + j > t) wv[j] = 0.f;
                v4u w; w.x = pk2(wv[0], wv[1]); w.y = pk2(wv[2], wv[3]); w.z = pk2(wv[4], wv[5]); w.w = pk2(wv[6], wv[7]); *(LAS v4u*)(T0 + t * LDP + 8 * d8) = w;
                const float mean = st[it][0], rstd = st[it][1];
                v4u vw;
#pragma unroll
                for (int p = 0; p < 4; ++p) vw[p] = pk2((lo16(xv[it][p]) - mean) * rstd * lg[2 * p] + lb[2 * p], (hi16(xv[it][p]) - mean) * rstd * lg[2 * p + 1] + lb[2 * p + 1]);
                *(LAS v4u*)(T1 + t * LDP + 8 * d8) = vw; }
            __syncthreads();
            { const bf16* up = Z + (R0 + t_) * NIN + 4096 + 128 * grp + 4 * fq;
#pragma unroll
              for (int ct = 0; ct < 8; ++ct) uu[ct] = *(const v2u*)(up + 16 * ct); }
            f32x4 acc[8];
#pragma unroll
            for (int ct = 0; ct < 8; ++ct) acc[ct] = (f32x4){0.f, 0.f, 0.f, 0.f};
            mm128_nt(acc, T0, T1, wave, lane);
            bf16* mp = MIX + (R0 + t_) * D + 1024 + 128 * grp + 4 * fq;
#pragma unroll
            for (int ct = 0; ct < 8; ++ct) { v2u w;
                w.x = pk2((acc[ct][0] + bsv) * lo16(uu[ct].x), (acc[ct][1] + bsv) * hi16(uu[ct].x)); w.y = pk2((acc[ct][2] + bsv) * lo16(uu[ct].y), (acc[ct][3] + bsv) * hi16(uu[ct].y)); *(v2u*)(mp + 16 * ct) = w; }
            __syncthreads(); }
        }
        if (blk & 1) convert_rest();
    }
    SEAM(3);

    if (IN(4)) {
        { pg8::Gemm g{MIX, Wo_t, MP, D, D}; pg8::StaticOrder S; S.init(MP, D, G, blk); EpiRes<2> E{(const float*)(ws + WS_RINV), nullptr, AB, SS1};
          pg8::gemm_phase<EpiRes<2>, pg8::StaticOrder, true, true>(lds, g, S, E); }
        auto f = [&](int s, int n, float v) { const float o = x_s[(size_t)s * D + n] + v; AB[(size_t)(MP + s) * D + n] = f2bf(o);
            const float q = half_wave_sum(o * o); if ((lane & 31) == 0) atomic_addf(SS1 + MP + s, q); };
        skinny_gemm<2>(lds, MIX + (size_t)MP * D, Wo_t, D, D, blk, G, f);
    }
    SEAM(4);

    if (IN(5)) {
        { pg8::Gemm g{AB, Wup_t, MP, NUP, D}; pg8::StaticOrder S; S.init(MP, NUP, G, blk); EpiUp E{ACT, RAW, SS1, conv_w, conv_b, (LAS float*)(lds + 131072)};
          pg8::gemm_phase<EpiUp, pg8::StaticOrder, true, true>(lds, g, S, E); }
        { pg8::Gemm g{AB, Wup_t, MP + 256, NUP, D}; SampleOrder S{(blk >= 128 && blk - 128 < NUP / 256) ? blk - 128 : -1}; EpiAS E{AS, SS1};
          pg8::gemm_phase<EpiAS, SampleOrder, true, true>(lds, g, S, E); }
        { int Kp = PLE; asm volatile("" : "+s"(Kp));
          constexpr int nbusy = (MP / 256 * (NUP / 256) + NUP / 256) - 5 * 256;
          pg8::Gemm g{PB, Wp_t, MP + 256, D, Kp}; ProjOrder S{blk >= nbusy ? blk - nbusy : -1, 256 - nbusy}; EpiPP E{PP};
          pg8::gemm_phase<EpiPP, ProjOrder, true, true>(lds, g, S, E); }
    }
    SEAM(5);

    if (IN(6)) {
        for (int i = gt; i < 128 * 2 * (DFF / 4); i += NGT) { const int c4 = i % (DFF / 4), gr = i / (DFF / 4), rr = gr & 1, Gp = gr >> 1, c = 4 * c4; const bool first = (Gp & 31) == 0;
            const float* rg = RAW + (size_t)Gp * 4 * NUP; const float* rp = rg - 4 * NUP; const f32x4 z4 = {0.f, 0.f, 0.f, 0.f};
            f32x4 a0g, a0u, a1g, a1u, a2g, a2u;
            a0g = *(const f32x4*)(rg + (2 + rr) * NUP + c); a0u = *(const f32x4*)(rg + (2 + rr) * NUP + DFF + c);
            if (rr) { a1g = *(const f32x4*)(rg + 2 * NUP + c); a1u = *(const f32x4*)(rg + 2 * NUP + DFF + c); a2g = first ? z4 : *(const f32x4*)(rp + NUP + c); a2u = first ? z4 : *(const f32x4*)(rp + NUP + DFF + c); }
            else { a1g = first ? z4 : *(const f32x4*)(rp + NUP + c); a1u = first ? z4 : *(const f32x4*)(rp + NUP + DFF + c); a2g = first ? z4 : *(const f32x4*)(rp + c); a2u = first ? z4 : *(const f32x4*)(rp + DFF + c); }
            const f32x4 ag = *(const f32x4*)(conv_w + c) * a2g + *(const f32x4*)(conv_w + NUP + c) * a1g + *(const f32x4*)(conv_w + 2 * NUP + c) * a0g + *(const f32x4*)(conv_b + c);
            const f32x4 au = *(const f32x4*)(conv_w + DFF + c) * a2u + *(const f32x4*)(conv_w + NUP + DFF + c) * a1u + *(const f32x4*)(conv_w + 2 * NUP + DFF + c) * a0u + *(const f32x4*)(conv_b + DFF + c);
            v2u w; w.x = pk2(silu_(ag[0]) * au[0], silu_(ag[1]) * au[1]); w.y = pk2(silu_(ag[2]) * au[2], silu_(ag[3]) * au[3]);
            *(v2u*)(ACT + (size_t)(64 * Gp + rr) * DFF + c) = w; }
        for (int i = gt; i < MS * (DFF / 4); i += NGT) { const int c4 = i % (DFF / 4), s = i / (DFF / 4), c = 4 * c4;
            const float* sc0 = state_conv + (size_t)s * 2 * NUP; const float* sc1 = sc0 + NUP; const float* as = AS + (size_t)s * NUP;
            const f32x4 a0g = *(const f32x4*)(as + c), a0u = *(const f32x4*)(as + DFF + c), a1g = *(const f32x4*)(sc1 + c), a1u = *(const f32x4*)(sc1 + DFF + c), a2g = *(const f32x4*)(sc0 + c), a2u = *(const f32x4*)(sc0 + DFF + c);
            const f32x4 ag = *(const f32x4*)(conv_w + c) * a2g + *(const f32x4*)(conv_w + NUP + c) * a1g + *(const f32x4*)(conv_w + 2 * NUP + c) * a0g + *(const f32x4*)(conv_b + c);
            const f32x4 au = *(const f32x4*)(conv_w + DFF + c) * a2u + *(const f32x4*)(conv_w + NUP + DFF + c) * a1u + *(const f32x4*)(conv_w + 2 * NUP + DFF + c) * a0u + *(const f32x4*)(conv_b + DFF + c);
            v2u w; w.x = pk2(silu_(ag[0]) * au[0], silu_(ag[1]) * au[1]); w.y = pk2(silu_(ag[2]) * au[2], silu_(ag[3]) * au[3]);
            *(v2u*)(ACT + (size_t)(MP + s) * DFF + c) = w;
            float* cs = out + O_CONVS + (size_t)s * 2 * NUP; *(f32x4*)(cs + c) = a1g; *(f32x4*)(cs + DFF + c) = a1u; *(f32x4*)(cs + NUP + c) = a0g; *(f32x4*)(cs + NUP + DFF + c) = a0u; }
        for (int i = gt; i < 4 * 2 * (NUP / 4); i += NGT) { const int c4 = i % (NUP / 4), bk = i / (NUP / 4), b = bk >> 1, k = bk & 1;
            *(f32x4*)(out + O_CONVP + (size_t)bk * NUP + 4 * c4) = *(const f32x4*)(RAW + ((size_t)(32 * b + 31) * 4 + k) * NUP + 4 * c4); }
    }
    SEAM(6);

    if (IN(7)) {
        { pg8::Gemm g{ACT, Wdn_t, MP, D, DFF}; pg8::StaticOrder S; S.init(MP, D, G, blk); EpiRes<1> E{nullptr, nullptr, AB, SS2};
          pg8::gemm_phase<EpiRes<1>, pg8::StaticOrder, true, true>(lds, g, S, E); }
        auto f = [&](int s, int n, float v) { const size_t o_ = (size_t)(MP + s) * D + n; const float o = bf2f(AB[o_]) + v; AB[o_] = f2bf(o);
            const float q = half_wave_sum(o * o); if ((lane & 31) == 0) atomic_addf(SS2 + MP + s, q); };
        skinny_gemm<2>(lds, ACT + (size_t)MP * DFF, Wdn_t, D, DFF, blk, G, f);
    }
    SEAM(7);

    if (IN(8)) {
#ifndef T_B
        { pg8::Gemm g{AB, Wg_t, MP, D, D}; pg8::StaticOrder S; S.init(MP, D, G, blk); EpiGate E{PP, AB, out, SS2, SS3};
          pg8::gemm_phase<EpiGate, pg8::StaticOrder, true, true>(lds, g, S, E); }
#endif
#ifndef T_D
        auto f2 = [&](int s, int n, float v) { const size_t o_ = (size_t)(MP + s) * D + n; const float r2 = __builtin_amdgcn_rsqf(SS2[MP + s] * (1.0f / D) + EPS);
            const float o = bf2f(AB[o_]) + bf2f(PP[o_]) * sigmoid_(r2 * v); out[o_] = o; const float q = half_wave_sum(o * o); if ((lane & 31) == 0) atomic_addf(SS3 + MP + s, q); };
        skinny_gemm<2>(lds, AB + (size_t)MP * D, Wg_t, D, D, blk, G, f2);
#endif
    }
    SEAM(8);

    if (IN(9)) {
        { const f32x4* gr = (const f32x4*)g_final + lane; f32x4 gv[8];
#pragma unroll
          for (int j = 0; j < 8; ++j) gv[j] = gr[64 * j];
          for (int m0 = gw; m0 < MT; m0 += 2 * NGW) { const int m1 = m0 + NGW; const bool two = m1 < MT;
            f32x4* h0 = (f32x4*)(out + (size_t)m0 * D) + lane; f32x4* h1 = (f32x4*)(out + (size_t)(two ? m1 : m0) * D) + lane;
            f32x4 a0[8], a1[8];
#pragma unroll
            for (int j = 0; j < 8; ++j) { a0[j] = h0[64 * j]; a1[j] = h1[64 * j]; }
            const float r0 = __builtin_amdgcn_rsqf(SS3[m0] * (1.0f / D) + EPS), r1 = __builtin_amdgcn_rsqf(SS3[two ? m1 : m0] * (1.0f / D) + EPS);
#pragma unroll
            for (int j = 0; j < 8; ++j) __builtin_nontemporal_store(a0[j] * gv[j] * r0, h0 + 64 * j);
            if (two) {
#pragma unroll
                for (int j = 0; j < 8; ++j) __builtin_nontemporal_store(a1[j] * gv[j] * r1, h1 + 64 * j); } } }
    }
#undef IN
#undef SEAM
}
#undef x_p
#undef x_s
#undef p_p
#undef p_s
#undef state_ret
#undef state_conv
#undef gm_ln_g
#undef gm_ln_b
#undef gm_ws
#undef gm_bs
#undef conv_w
#undef conv_b
#undef g_final
#undef out
#undef SS1
#undef SS2
#undef SS3
#undef STATS
#undef ROPE
#undef ROPES
#undef Win_t
#undef Wo_t
#undef Wup_t
#undef Wdn_t
#undef Wg_t
#undef Wp_t
#undef AB
#undef PB
#undef MIX
#undef Z
#undef ACT
#undef KV
#undef PP
#undef RAW
#undef AS

extern "C" void kernel_launch(void* const* d_in, const int* in_sizes, int n_in, void* d_out, int out_size, void* d_ws, size_t ws_size, hipStream_t stream) {
    static int grid = 0;
    if (grid == 0) {
        if (n_in != 22 || out_size != (int)O_END || ws_size < WS_END) { fprintf(stderr, "kernel_launch: unexpected shapes: n_in %d out %d ws %zu\n", n_in, out_size, ws_size); grid = -1; return; }
        int dev = 0, cus = 0, per_cu = 0;
        if (hipGetDevice(&dev) != hipSuccess || hipDeviceGetAttribute(&cus, hipDeviceAttributeMultiprocessorCount, dev) != hipSuccess) { grid = -1; return; }
        if (hipFuncSetAttribute((const void*)mk_fwd, hipFuncAttributeMaxDynamicSharedMemorySize, LDS_BYTES) != hipSuccess) { fprintf(stderr, "kernel_launch: hipFuncSetAttribute failed\n"); grid = -1; return; }
        if (hipOccupancyMaxActiveBlocksPerMultiprocessor(&per_cu, (const void*)mk_fwd, 512, LDS_BYTES) != hipSuccess || per_cu < 1) fprintf(stderr, "kernel_launch: occupancy query says %d\n", per_cu);
        (void)hipGetLastError();
        grid = cus;
        if (grid != 256) fprintf(stderr, "kernel_launch: %d CUs (built for 256)\n", grid);
    }
    if (grid < 0) return;
    if (hipMemsetAsync((char*)d_ws + WS_BAR, 0, BAR_BYTES, stream) != hipSuccess) { fprintf(stderr, "kernel_launch: memset failed\n"); return; }
    Params p{};
    for (int i = 0; i < 22; ++i) p.in[i] = (const float*)d_in[i];
    p.out = (float*)d_out; p.ws = (unsigned char*)d_ws;
    for (int h = 0; h < 8; ++h) p.log2g[h] = (float)std::log2(1.0 - std::exp2(-5.0 - (double)h));
    for (int i = 0; i < 64; ++i) p.invf[i] = powf(10000.0f, -(float)i / 64.0f);
    p.use_cg = 0; p.pad = 0;
#if MK_N_LAUNCHES == 1
    void* args[] = {&p};
#ifdef PROBE_K
    p.ph_lo = 0; p.ph_hi = PROBE_K + 1;
    (void)hipLaunchCooperativeKernel((const void*)mk_fwd, dim3(grid), dim3(512), args, LDS_BYTES, stream);
    if (hipMemsetAsync((char*)d_ws + WS_BAR, 0, BAR_BYTES, stream) != hipSuccess) return;
#endif
    p.ph_lo = 0; p.ph_hi = NPHASE;
    hipError_t e = hipLaunchCooperativeKernel((const void*)mk_fwd, dim3(grid), dim3(512), args, LDS_BYTES, stream);
    if (e != hipSuccess) fprintf(stderr, "kernel_launch: cooperative launch failed: %s\n", hipGetErrorString(e));
#else
    for (int ph = 0; ph < NPHASE; ++ph) { p.ph_lo = ph; p.ph_hi = ph + 1; hipLaunchKernelGGL(mk_fwd, dim3(grid), dim3(512), LDS_BYTES, stream, p); }
#endif
}
```

```cpp
#include <hip/hip_runtime.h>
#include <hip/hip_cooperative_groups.h>
#include <cstdio>
#include <cstdint>
#include <cmath>
namespace cg = cooperative_groups;

#ifndef MK_N_LAUNCHES
#define MK_N_LAUNCHES 1
#endif

namespace pg8 {
#define PG8_LAS __attribute__((address_space(3)))
typedef unsigned short bf16_t;
typedef short bf16x8 __attribute__((ext_vector_type(8)));
typedef float f32x4 __attribute__((ext_vector_type(4)));
typedef unsigned u32x4 __attribute__((ext_vector_type(4)));
constexpr int BM = 256, BK = 64, HALF = 128, HTB = HALF * BK * 2  , STAGE_BYTES = 8 * HTB, NXCD = 8, WGM = 8;

__host__ __device__ __forceinline__ int lds_byte(int r, int c) { const int st = (r >> 4) * 2 + (c >> 5), rr = r & 15, cc = c & 31, ob = rr * 64 + cc * 2; return st * 1024 + (ob ^ (((ob >> 9) & 1) << 5)); }
__host__ __device__ __forceinline__ void stage_rc(int b, int& R, int& C) { const int st = b / 1024, sb = b % 1024, swz = sb ^ (((sb >> 9) & 1) << 5); R = (st >> 1) * 16 + swz / 64; C = (st & 1) * 32 + (swz % 64) / 2; }
__host__ __device__ __forceinline__ int perm32(int rho) { const int n = rho >> 4, i = rho & 15; return 8 * (i >> 2) + 4 * n + (i & 3); }

struct Unit { int pm, pn; };
struct Gemm { const bf16_t* A; const bf16_t* Bt; int M, N, K; };

struct StaticOrder {
    int nM, nN, nwg, G, c;
    __host__ __device__ void init(int M, int N, int G_, int c_) { nM = M / BM; nN = N / BM; nwg = nM * nN; G = G_; c = c_; }
    __host__ __device__ bool next(int i, Unit& u) const {
        const long L = (long)i * G + c; if (L >= nwg) return false;
        int wgid = (int)L; { const int q = nwg / NXCD, r = nwg % NXCD, xcd = wgid % NXCD, off = wgid / NXCD; wgid = (xcd < r ? xcd * (q + 1) : r * (q + 1) + (xcd - r) * q) + off; }
        const int nig = WGM * nN, gid = wgid / nig, fm = gid * WGM, gsz = (nM - fm) < WGM ? (nM - fm) : WGM;
        u.pm = fm + ((wgid % nig) % gsz); u.pn = (wgid % nig) / gsz; return true;
    }
    __device__ __forceinline__ void a_ready(const Unit&) const {}
    __device__ __forceinline__ void done(const Unit&) const {}
};

__device__ __forceinline__ unsigned cvt_pk_bf16(float lo, float hi) { unsigned r; asm volatile("v_cvt_pk_bf16_f32 %0, %1, %2" : "=v"(r) : "v"(lo), "v"(hi)); return r; }
typedef float f32x2 __attribute__((ext_vector_type(2)));

template <class Epi, class Sched, bool ALIGN_EPI = false, bool SP2 = false>
__device__ __forceinline__ void gemm_phase(PG8_LAS unsigned char* lds, const Gemm g, const Sched& S, const Epi& E) {
    const int tid = threadIdx.x, wid = __builtin_amdgcn_readfirstlane(tid >> 6), lane = tid & 63, wr = wid >> 2, wc = wid & 3, fr = lane & 15, fq = lane >> 4;
    const int K = g.K, nt = K / BK;
    unsigned voffA[2], voffB[2];
#pragma unroll
    for (int i = 0; i < 2; ++i) { int R, C; stage_rc(tid * 16 + i * 8192, R, C); const int Rb = Epi::PERM ? ((R & ~31) + perm32(R & 31)) : R;
        voffA[i] = (unsigned)(R * K + C) * 2u; voffB[i] = (unsigned)(Rb * K + C) * 2u; }
    const size_t kstep = (size_t)(BK * 2);
    const size_t hstep = (size_t)HALF * K * 2;
    const size_t tstep = 2 * hstep;
    const unsigned ldsw = (unsigned)wid * 1024u;
    const int aoff = lds_byte(wr * 64 + fr, fq * 8), boff = lds_byte(wc * 32 + fr, fq * 8);
#define PG8_SA(b, h) (((b) * 2 + (h)) * HTB)
#define PG8_SB(b, h) ((4 + (b) * 2 + (h)) * HTB)
#define PG8_STAGE(bufoff, gbase, voff) do { _Pragma("unroll") for (int _i = 0; _i < 2; ++_i) \
        __builtin_amdgcn_global_load_lds((const unsigned*)((const char*)(gbase) + (voff)[_i]), (PG8_LAS unsigned*)(lds + (bufoff) + ldsw + _i * 8192), 16, 0, 0); } while (0)
#define PG8_LDA(dst, b, h) do { _Pragma("unroll") for (int m = 0; m < 4; ++m) _Pragma("unroll") for (int k = 0; k < 2; ++k) dst[m][k] = *(const PG8_LAS bf16x8*)(lds + PG8_SA(b, h) + aoff + m * 2048 + k * 1024); } while (0)
#define PG8_LDB(dst, b, h) do { _Pragma("unroll") for (int n = 0; n < 2; ++n) _Pragma("unroll") for (int k = 0; k < 2; ++k) dst[n][k] = *(const PG8_LAS bf16x8*)(lds + PG8_SB(b, h) + boff + n * 2048 + k * 1024); } while (0)
#define PG8_MMA(ai, bj, At, Bt) do { __builtin_amdgcn_s_setprio(1); _Pragma("unroll") for (int m = 0; m < 4; ++m) _Pragma("unroll") for (int n = 0; n < 2; ++n) _Pragma("unroll") for (int k = 0; k < 2; ++k) \
        acc[ai][bj][m][n] = __builtin_amdgcn_mfma_f32_16x16x32_bf16(Bt[n][k], At[m][k], acc[ai][bj][m][n], 0, 0, 0); __builtin_amdgcn_s_setprio(0); } while (0)
#define PG8_WAIT_V(n) asm volatile("s_waitcnt vmcnt(" #n ")" ::: "memory")
#define PG8_WAIT_L(n) asm volatile("s_waitcnt lgkmcnt(" #n ")" ::: "memory")
#define PG8_BAR __builtin_amdgcn_s_barrier()
#define PG8_SCHED __builtin_amdgcn_sched_barrier(0)
    Unit cur, nxt; int ui = 0;
    if (!S.next(0, cur)) return;
    f32x4 acc[2][2][4][2];
#pragma unroll
    for (int a = 0; a < 2; ++a)
#pragma unroll
        for (int b = 0; b < 2; ++b)
#pragma unroll
            for (int m = 0; m < 4; ++m)
#pragma unroll
                for (int n = 0; n < 2; ++n) acc[a][b][m][n] = (f32x4){0.f, 0.f, 0.f, 0.f};
    bf16x8 At[4][2], B0[2][2], B1[2][2];
    const char* cA = (const char*)g.A + (size_t)cur.pm * tstep; const char* cB = (const char*)g.Bt + (size_t)cur.pn * tstep;
    S.a_ready(cur);
    if constexpr (SP2) {
        PG8_STAGE(PG8_SB(0, 0), cB, voffB); PG8_STAGE(PG8_SB(0, 1), cB + hstep, voffB); PG8_STAGE(PG8_SA(0, 0), cA, voffA); PG8_STAGE(PG8_SA(0, 1), cA + hstep, voffA);
        if (wr == 1) PG8_BAR;
        PG8_WAIT_V(2); PG8_BAR;
        PG8_STAGE(PG8_SB(1, 0), cB + kstep, voffB); PG8_STAGE(PG8_SA(1, 0), cA + kstep, voffA); PG8_STAGE(PG8_SB(1, 1), cB + hstep + kstep, voffB);
        PG8_WAIT_V(6); PG8_BAR;
    } else {
        PG8_STAGE(PG8_SB(0, 0), cB, voffB); PG8_STAGE(PG8_SA(0, 0), cA, voffA); PG8_STAGE(PG8_SB(0, 1), cB + hstep, voffB); PG8_STAGE(PG8_SA(0, 1), cA + hstep, voffA);
        if (wr == 1) PG8_BAR;
        PG8_WAIT_V(4); PG8_BAR;
        PG8_STAGE(PG8_SB(1, 0), cB + kstep, voffB); PG8_STAGE(PG8_SA(1, 0), cA + kstep, voffA); PG8_STAGE(PG8_SB(1, 1), cB + hstep + kstep, voffB);
        PG8_WAIT_V(6); PG8_BAR;
    }
    for (;;) {
        const bool has_next = S.next(ui + 1, nxt);
        const char* nA = has_next ? (const char*)g.A + (size_t)nxt.pm * tstep : cA; const char* nB = has_next ? (const char*)g.Bt + (size_t)nxt.pn * tstep : cB;
        for (int t = 0; t < nt; t += 2) {
            const bool last = (t == nt - 2);
            const char* a1 = cA + (size_t)(t + 1) * kstep;
            const char* a2 = last ? nA : cA + (size_t)(t + 2) * kstep; const char* b2 = last ? nB : cB + (size_t)(t + 2) * kstep;
            const char* a3 = a2 + kstep; const char* b3 = b2 + kstep;
            if (last && has_next) S.a_ready(nxt);
            if constexpr (SP2) {
            PG8_LDB(B0, 0, 0); PG8_LDB(B1, 0, 1); PG8_SCHED; PG8_LDA(At, 0, 0); PG8_STAGE(PG8_SA(1, 1), a1 + hstep, voffA);
            PG8_WAIT_V(8); PG8_WAIT_L(0); PG8_BAR; PG8_MMA(0, 0, At, B0); PG8_MMA(0, 1, At, B1); PG8_BAR; PG8_SCHED;
            PG8_LDA(At, 0, 1); PG8_STAGE(PG8_SB(0, 0), b2, voffB); PG8_STAGE(PG8_SB(0, 1), b2 + hstep, voffB); PG8_STAGE(PG8_SA(0, 0), a2, voffA);
            PG8_WAIT_V(8); PG8_WAIT_L(0); PG8_BAR; PG8_MMA(1, 0, At, B0); PG8_MMA(1, 1, At, B1); PG8_BAR; PG8_SCHED;
            PG8_LDB(B0, 1, 0); PG8_LDB(B1, 1, 1); PG8_SCHED; PG8_LDA(At, 1, 0); PG8_STAGE(PG8_SA(0, 1), a2 + hstep, voffA);
            PG8_WAIT_V(8); PG8_WAIT_L(0); PG8_BAR; PG8_MMA(0, 0, At, B0); PG8_MMA(0, 1, At, B1); PG8_BAR; PG8_SCHED;
            PG8_LDA(At, 1, 1); PG8_STAGE(PG8_SB(1, 0), b3, voffB); PG8_STAGE(PG8_SB(1, 1), b3 + hstep, voffB); PG8_STAGE(PG8_SA(1, 0), a3, voffA);
            PG8_WAIT_V(8); PG8_WAIT_L(0); PG8_BAR; PG8_MMA(1, 0, At, B0); PG8_MMA(1, 1, At, B1); PG8_BAR; PG8_SCHED;
            } else {
            PG8_LDB(B0, 0, 0); PG8_SCHED; PG8_LDA(At, 0, 0); PG8_STAGE(PG8_SA(1, 1), a1 + hstep, voffA);
            PG8_WAIT_L(8); PG8_BAR; PG8_WAIT_L(0); PG8_MMA(0, 0, At, B0); PG8_BAR; PG8_SCHED;
            PG8_LDB(B1, 0, 1); PG8_STAGE(PG8_SB(0, 0), b2, voffB);
            PG8_BAR; PG8_WAIT_L(0); PG8_MMA(0, 1, At, B1); PG8_BAR;
            PG8_LDA(At, 0, 1); PG8_STAGE(PG8_SA(0, 0), a2, voffA);
            PG8_BAR; PG8_WAIT_L(0); PG8_MMA(1, 0, At, B0); PG8_BAR; PG8_SCHED;
            PG8_STAGE(PG8_SB(0, 1), b2 + hstep, voffB);
            PG8_WAIT_V(6); PG8_BAR; PG8_MMA(1, 1, At, B1); PG8_BAR;
            PG8_LDB(B0, 1, 0); PG8_SCHED; PG8_LDA(At, 1, 0); PG8_STAGE(PG8_SA(0, 1), a2 + hstep, voffA);
            PG8_WAIT_L(8); PG8_BAR; PG8_WAIT_L(0); PG8_MMA(0, 0, At, B0); PG8_BAR; PG8_SCHED;
            PG8_LDB(B1, 1, 1); PG8_STAGE(PG8_SB(1, 0), b3, voffB);
            PG8_BAR; PG8_WAIT_L(0); PG8_MMA(0, 1, At, B1); PG8_BAR;
            PG8_LDA(At, 1, 1); PG8_STAGE(PG8_SA(1, 0), a3, voffA);
            PG8_BAR; PG8_WAIT_L(0); PG8_MMA(1, 0, At, B0); PG8_BAR; PG8_SCHED;
            PG8_STAGE(PG8_SB(1, 1), b3 + hstep, voffB);
            PG8_WAIT_V(6); PG8_BAR; PG8_MMA(1, 1, At, B1); PG8_BAR;
            }
        }
        if constexpr (ALIGN_EPI) { if (wr == 0) PG8_BAR; }
        if constexpr (!Epi::AFTER_DRAIN) { E(acc, cur, wr, wc, fr, fq); S.done(cur); }
        if (!has_next) break;
#pragma unroll
        for (int a = 0; a < 2; ++a)
#pragma unroll
            for (int b = 0; b < 2; ++b)
#pragma unroll
                for (int m = 0; m < 4; ++m)
#pragma unroll
                    for (int n = 0; n < 2; ++n) acc[a][b][m][n] = (f32x4){0.f, 0.f, 0.f, 0.f};
        cur = nxt; cA = nA; cB = nB; ++ui;
        if constexpr (ALIGN_EPI) { if (wr == 1) PG8_BAR; }
    }
    PG8_WAIT_V(0);
    if constexpr (!ALIGN_EPI) { if (wr == 0) PG8_BAR; }
    PG8_BAR;
    if constexpr (Epi::AFTER_DRAIN) { E.fused(acc, cur, wr, wc, fr, fq, lds, wid, lane); S.done(cur); }
#undef PG8_SA
#undef PG8_SB
#undef PG8_STAGE
#undef PG8_LDA
#undef PG8_LDB
#undef PG8_MMA
#undef PG8_WAIT_V
#undef PG8_WAIT_L
#undef PG8_BAR
#undef PG8_SCHED
}
}

#define GAS __attribute__((address_space(1)))
#define LAS __attribute__((address_space(3)))
typedef unsigned short bf16;
typedef unsigned v4u __attribute__((ext_vector_type(4)));
typedef unsigned v2u __attribute__((ext_vector_type(2)));
typedef float f32x4 __attribute__((ext_vector_type(4)));
typedef float f32x2 __attribute__((ext_vector_type(2)));
typedef short bf16x8 __attribute__((ext_vector_type(8)));
#define XB_TMO      128
#define XB_XCNT(j)  (256  + 64 * (j))
#define XB_XSUB(j)  (1280 + 64 * (j))
#define XB_XGEN(j)  (2304 + 64 * (j))
#define XB_TOP      3328
#define XB_TOPGEN   3392
#define XCD_BAR_WORDS 3456
#define XB_SPIN_CAP (1u << 18)

__device__ __forceinline__ unsigned xb_ld(unsigned* p)              { return __hip_atomic_load(p, __ATOMIC_RELAXED, __HIP_MEMORY_SCOPE_AGENT); }
__device__ __forceinline__ unsigned xb_add(unsigned* p, unsigned v) { return __hip_atomic_fetch_add(p, v, __ATOMIC_RELAXED, __HIP_MEMORY_SCOPE_AGENT); }
__device__ __forceinline__ unsigned xb_xcc_id() { return (unsigned)__builtin_amdgcn_s_getreg((3 << 11) | 20) & 0xFu; }
#define XB_SPIN(cond, bar) do { unsigned _sp = 0; while (cond) { __builtin_amdgcn_s_sleep(1); \
    if ((++_sp & 255u) == 0u) { if (xb_ld(&(bar)[XB_TMO])) break; if (_sp > XB_SPIN_CAP) { atomicAdd(&(bar)[XB_TMO], 1u); break; } } } } while (0)

struct XcdBarrier {
    unsigned* bar; unsigned x;
    volatile LAS unsigned* st;
};

__device__ __forceinline__ XcdBarrier xcd_barrier_post(unsigned* bar, volatile LAS unsigned* st) {
    XcdBarrier b; b.bar = bar; b.x = xb_xcc_id(); b.st = st;
    if (threadIdx.x == 0) (void)xb_add(&bar[XB_XCNT(b.x)], 1u);
    return b;
}
__device__ __forceinline__ void xcd_barrier_complete(unsigned* bar, unsigned x, unsigned& nloc, unsigned& nx) {
    const unsigned G = gridDim.x * gridDim.y * gridDim.z;
    unsigned sum, cnt, mine, sp = 0u;
    for (;;) {
        sum = 0u; cnt = 0u; mine = 0u;
#pragma unroll
        for (unsigned j = 0; j < 16; ++j) { const unsigned c = xb_ld(&bar[XB_XCNT(j)]); sum += c; cnt += (c > 0u) ? 1u : 0u; mine = (j == x) ? c : mine; }
        if (sum == G) break;
        __builtin_amdgcn_s_sleep(1);
        if ((++sp & 255u) == 0u) { if (xb_ld(&bar[XB_TMO])) break; if (sp > XB_SPIN_CAP) { atomicAdd(&bar[XB_TMO], 1u); break; } }
    }
    nloc = mine > 0u ? mine : 1u; nx = cnt > 0u ? cnt : 1u;
}

__device__ __forceinline__ void xcd_barrier(const XcdBarrier& b) {
    asm volatile("s_waitcnt vmcnt(0)" ::: "memory");
    __syncthreads();
    if (threadIdx.x == 0) {
        unsigned* bar = b.bar;
        __builtin_amdgcn_s_waitcnt(0);
        unsigned nloc = b.st[0], nx = b.st[1];
        if (nloc == 0u) { xcd_barrier_complete(bar, b.x, nloc, nx); b.st[0] = nloc; b.st[1] = nx; }
        const unsigned old = xb_add(&bar[XB_XSUB(b.x)], 1u);
        const unsigned gen = old / nloc;
        if (old + 1u == (gen + 1u) * nloc) {
            __builtin_amdgcn_fence(__ATOMIC_RELEASE, "agent");
            asm volatile("s_waitcnt vmcnt(0)" ::: "memory");
            const unsigned og = xb_add(&bar[XB_TOP], 1u);
            const unsigned tg = og / nx;
            if (og + 1u == (tg + 1u) * nx) xb_add(&bar[XB_TOPGEN], 1u);
            else XB_SPIN(xb_ld(&bar[XB_TOPGEN]) == tg, bar);
            __builtin_amdgcn_fence(__ATOMIC_ACQUIRE, "agent");
            xb_add(&bar[XB_XGEN(b.x)], 1u);
            asm volatile("s_waitcnt vmcnt(0)" ::: "memory");
        } else {
            XB_SPIN(xb_ld(&bar[XB_XGEN(b.x)]) == gen, bar);
            __builtin_amdgcn_fence(__ATOMIC_ACQUIRE, "agent");
            asm volatile("s_waitcnt vmcnt(0)" ::: "memory");
        }
    }
    __syncthreads();
}

constexpr int MP = 8192, MS = 128, MT = MP + MS, D = 2048, NIN = 6144, NUP = 11264, DFF = 5632, PLE = 256, SEQ = 2048, NH = 8;
constexpr float EPS = 1e-6f;
constexpr int NPHASE = 10;
constexpr size_t MiB = 1u << 20;
constexpr size_t WS_BAR = 0, BAR_BYTES = 16384;
constexpr size_t WS_SS1 = 64 * 1024, WS_SS2 = 128 * 1024, WS_SS3 = 192 * 1024, WS_STATS = 256 * 1024;
constexpr size_t WS_RINV = 384 * 1024;
constexpr size_t WS_ROPE = 1 * MiB, WS_ROPES = 2 * MiB;
constexpr size_t WS_WIN = 4 * MiB, WS_WO = 28 * MiB, WS_WUP = 36 * MiB, WS_WDN = 80 * MiB, WS_WG = 102 * MiB, WS_WP = 110 * MiB;
constexpr size_t WS_AB = 112 * MiB, WS_PB = 145 * MiB, WS_MIX = 150 * MiB, WS_Z = 183 * MiB, WS_ACT = 183 * MiB, WS_KV = 281 * MiB, WS_PP = 281 * MiB;
constexpr size_t WS_RAW = 314 * MiB, WS_AS = 336 * MiB, WS_END = 346 * MiB;
static_assert(WS_AB + (size_t)MT * D * 2 <= WS_PB && WS_PB + (size_t)MT * PLE * 2 <= WS_MIX && WS_MIX + (size_t)MT * D * 2 <= WS_Z, "ws map 1");
static_assert(WS_Z + (size_t)MT * NIN * 2 <= WS_KV && WS_ACT + (size_t)MT * DFF * 2 <= WS_KV && WS_KV + (size_t)512 * 16384 * 4 <= WS_RAW, "ws map 2");
static_assert(WS_RAW + (size_t)128 * 4 * NUP * 4 <= WS_AS && WS_AS + (size_t)MS * NUP * 4 <= WS_END && WS_PP + (size_t)MT * D * 2 <= WS_RAW, "ws map 3");
constexpr size_t O_RETP = 17039360, O_CONVP = 17563648, O_RETS = 17653760, O_CONVS = 34430976, O_GMV = 37314560, O_END = 37445632;
constexpr int LDS_BYTES = 147456, MISC_OFF = LDS_BYTES - 256;
constexpr int LDP = 136;
constexpr int TILE_B = 128 * LDP * 2;

struct Params { const float* in[22]; float* out; unsigned char* ws; float log2g[8]; float invf[64]; int ph_lo, ph_hi, use_cg, pad; };

#define LDS_WAIT() asm volatile("s_waitcnt lgkmcnt(0)" ::: "memory")
__device__ __forceinline__ float lo16(unsigned u) { return __uint_as_float(u << 16); }
__device__ __forceinline__ float hi16(unsigned u) { return __uint_as_float(u & 0xffff0000u); }
__device__ __forceinline__ float bf2f(bf16 b) { return __uint_as_float((unsigned)b << 16); }
__device__ __forceinline__ unsigned pk2(float lo, float hi) { return pg8::cvt_pk_bf16(lo, hi); }
__device__ __forceinline__ bf16 f2bf(float f) { return (bf16)(pg8::cvt_pk_bf16(f, 0.f) & 0xffffu); }
__device__ __forceinline__ float sigmoid_(float x) { return __builtin_amdgcn_rcpf(1.0f + __builtin_amdgcn_exp2f(-1.44269504089f * x)); }
__device__ __forceinline__ float silu_(float x) { return x * sigmoid_(x); }
__device__ __forceinline__ float gelu_(float x) { return x * sigmoid_(1.5957691216f * (x + 0.044715f * x * x * x)); }
__device__ __forceinline__ float wave_sum(float v) {
#pragma unroll
    for (int o = 1; o < 64; o <<= 1) v += __shfl_xor(v, o);
    return v;
}
__device__ __forceinline__ void atomic_addf(float* p, float v) { (void)__hip_atomic_fetch_add(p, v, __ATOMIC_RELAXED, __HIP_MEMORY_SCOPE_AGENT); }
template <int CTRL> __device__ __forceinline__ float dppf(float x) { return __int_as_float(__builtin_amdgcn_mov_dpp(__float_as_int(x), CTRL, 0xf, 0xf, false)); }

using pg8::Unit;
struct EpiZ {
    static constexpr bool PERM = true, AFTER_DRAIN = false;
    bf16* Z;
    __device__ __forceinline__ void operator()(const f32x4 (&acc)[2][2][4][2], const Unit& u, int wr, int wc, int fr, int fq) const {
        const int row0 = u.pm * 256 + wr * 64 + fr, col0 = u.pn * 256 + wc * 32 + 8 * fq;
        const int mode = u.pn < 12 ? 0 : (u.pn < 16 ? 1 : 2);
#pragma unroll
        for (int ai = 0; ai < 2; ++ai)
#pragma unroll
            for (int m = 0; m < 4; ++m) { bf16* rowp = Z + (size_t)(row0 + ai * 128 + m * 16) * NIN + col0;
#pragma unroll
                for (int bj = 0; bj < 2; ++bj) { f32x4 v0 = acc[ai][bj][m][0], v1 = acc[ai][bj][m][1];
                    if (mode == 1) {
#pragma unroll
                        for (int j = 0; j < 4; ++j) { v0[j] = silu_(v0[j]); v1[j] = silu_(v1[j]); } }
                    else if (mode == 2) {
#pragma unroll
                        for (int j = 0; j < 4; ++j) { v0[j] = gelu_(v0[j]); v1[j] = gelu_(v1[j]); } }
                    v4u w; w.x = pk2(v0[0], v0[1]); w.y = pk2(v0[2], v0[3]); w.z = pk2(v1[0], v1[1]); w.w = pk2(v1[2], v1[3]);
                    *(v4u*)(rowp + bj * 128) = w; } }
    }
};
template <int BASE_BF16> struct EpiRes {
    const float* rowscale;
    static constexpr bool PERM = true, AFTER_DRAIN = false;
    const float* base; bf16* hb; float* ss;
    __device__ __forceinline__ void operator()(const f32x4 (&acc)[2][2][4][2], const Unit& u, int wr, int wc, int fr, int fq) const {
        const int row0 = u.pm * 256 + wr * 64 + fr, col0 = u.pn * 256 + wc * 32 + 8 * fq;
        float sacc[2][4];
#pragma unroll
        for (int ai = 0; ai < 2; ++ai) {
            f32x4 bs[BASE_BF16 ? 1 : 4][2][2]; v4u bw[4][2]; float rsc[4];
#pragma unroll
            for (int m = 0; m < 4; ++m) { rsc[m] = BASE_BF16 == 2 ? rowscale[row0 + ai * 128 + m * 16] : 1.0f;
#pragma unroll
                for (int bj = 0; bj < 2; ++bj) { const size_t o_ = (size_t)(row0 + ai * 128 + m * 16) * D + col0 + bj * 128;
                    if (BASE_BF16) bw[m][bj] = *(const v4u*)(hb + o_);
                    else { bs[m][bj][0] = *(const f32x4*)(base + o_); bs[m][bj][1] = *(const f32x4*)(base + o_ + 4); } } }
#pragma unroll
            for (int m = 0; m < 4; ++m) { const size_t off = (size_t)(row0 + ai * 128 + m * 16) * D + col0; float s = 0.f;
#pragma unroll
                for (int bj = 0; bj < 2; ++bj) { f32x4 b0, b1;
                    if (BASE_BF16) { const v4u w = bw[m][bj]; b0 = (f32x4){lo16(w.x), hi16(w.x), lo16(w.y), hi16(w.y)}; b1 = (f32x4){lo16(w.z), hi16(w.z), lo16(w.w), hi16(w.w)};
                        if (BASE_BF16 == 2) { b0 *= rsc[m]; b1 *= rsc[m]; } }
                    else { b0 = bs[m][bj][0]; b1 = bs[m][bj][1]; }
                    const f32x4 o0 = b0 + acc[ai][bj][m][0], o1 = b1 + acc[ai][bj][m][1];
                    v4u w; w.x = pk2(o0[0], o0[1]); w.y = pk2(o0[2], o0[3]); w.z = pk2(o1[0], o1[1]); w.w = pk2(o1[2], o1[3]); *(v4u*)(hb + off + bj * 128) = w;
                    s += ((o0[0] * o0[0] + o0[1] * o0[1]) + (o0[2] * o0[2] + o0[3] * o0[3])) + ((o1[0] * o1[0] + o1[1] * o1[1]) + (o1[2] * o1[2] + o1[3] * o1[3])); }
                s += __shfl_xor(s, 16); s += __shfl_xor(s, 32); sacc[ai][m] = s; }
            asm volatile("" ::: "memory"); }
        if (fq == 0) {
#pragma unroll
            for (int ai = 0; ai < 2; ++ai)
#pragma unroll
                for (int m = 0; m < 4; ++m) atomic_addf(ss + row0 + ai * 128 + m * 16, sacc[ai][m]); }
    }
};
struct EpiPP {
    static constexpr bool PERM = true, AFTER_DRAIN = false;
    bf16* pp;
    __device__ __forceinline__ void operator()(const f32x4 (&acc)[2][2][4][2], const Unit& u, int wr, int wc, int fr, int fq) const {
        const int row0 = u.pm * 256 + wr * 64 + fr, col0 = u.pn * 256 + wc * 32 + 8 * fq;
#pragma unroll
        for (int ai = 0; ai < 2; ++ai)
#pragma unroll
            for (int m = 0; m < 4; ++m) { if (row0 + ai * 128 + m * 16 >= MT) continue; bf16* rowp = pp + (size_t)(row0 + ai * 128 + m * 16) * D + col0;
#pragma unroll
                for (int bj = 0; bj < 2; ++bj) { const f32x4 v0 = acc[ai][bj][m][0], v1 = acc[ai][bj][m][1]; v4u w; w.x = pk2(v0[0], v0[1]); w.y = pk2(v0[2], v0[3]); w.z = pk2(v1[0], v1[1]); w.w = pk2(v1[2], v1[3]); *(v4u*)(rowp + bj * 128) = w; } }
    }
};
struct EpiGate {
    static constexpr bool PERM = true, AFTER_DRAIN = false;
    const bf16* pp; const bf16* hb; float* h; const float* ss2; float* ss3;
    __device__ __forceinline__ void operator()(const f32x4 (&acc)[2][2][4][2], const Unit& u, int wr, int wc, int fr, int fq) const {
        const int row0 = u.pm * 256 + wr * 64 + fr, col0 = u.pn * 256 + wc * 32 + 8 * fq;
        float sacc[2][4];
#pragma unroll
        for (int ai = 0; ai < 2; ++ai) {
            v4u hw[4][2], pw[4][2]; float r2[4];
#pragma unroll
            for (int m = 0; m < 4; ++m) { const int row = row0 + ai * 128 + m * 16; r2[m] = ss2[row];
#pragma unroll
                for (int bj = 0; bj < 2; ++bj) { hw[m][bj] = *(const v4u*)(hb + (size_t)row * D + col0 + bj * 128); pw[m][bj] = *(const v4u*)(pp + (size_t)row * D + col0 + bj * 128); } }
#pragma unroll
            for (int m = 0; m < 4; ++m) { const size_t off = (size_t)(row0 + ai * 128 + m * 16) * D + col0; float s = 0.f;
                const float rr = __builtin_amdgcn_rsqf(r2[m] * (1.0f / D) + EPS);
#pragma unroll
                for (int bj = 0; bj < 2; ++bj) { const v4u h4 = hw[m][bj], p4 = pw[m][bj];
                    const f32x4 hv0 = {lo16(h4.x), hi16(h4.x), lo16(h4.y), hi16(h4.y)}, hv1 = {lo16(h4.z), hi16(h4.z), lo16(h4.w), hi16(h4.w)};
                    const f32x4 pv0 = {lo16(p4.x), hi16(p4.x), lo16(p4.y), hi16(p4.y)}, pv1 = {lo16(p4.z), hi16(p4.z), lo16(p4.w), hi16(p4.w)};
                    const f32x4 a0 = acc[ai][bj][m][0], a1 = acc[ai][bj][m][1]; f32x4 o0, o1;
#pragma unroll
                    for (int j = 0; j < 4; ++j) { o0[j] = hv0[j] + pv0[j] * sigmoid_(rr * a0[j]); o1[j] = hv1[j] + pv1[j] * sigmoid_(rr * a1[j]); }
                    *(f32x4*)(h + off + bj * 128) = o0; *(f32x4*)(h + off + bj * 128 + 4) = o1;
                    s += ((o0[0] * o0[0] + o0[1] * o0[1]) + (o0[2] * o0[2] + o0[3] * o0[3])) + ((o1[0] * o1[0] + o1[1] * o1[1]) + (o1[2] * o1[2] + o1[3] * o1[3])); }
                s += __shfl_xor(s, 16); s += __shfl_xor(s, 32); sacc[ai][m] = s; }
            asm volatile("" ::: "memory"); }
        if (fq == 0) {
#pragma unroll
            for (int ai = 0; ai < 2; ++ai)
#pragma unroll
                for (int m = 0; m < 4; ++m) atomic_addf(ss3 + row0 + ai * 128 + m * 16, sacc[ai][m]); }
    }
};
struct EpiUp {
    static constexpr bool PERM = true, AFTER_DRAIN = false;
    bf16* act; float* raw; const float* ss1; const float* cw; const float* cb; LAS float* wl;
    __device__ __forceinline__ void operator()(const f32x4 (&acc)[2][2][4][2], const Unit& u, int wr, int wc, int fr, int fq) const {
        const int row0 = u.pm * 256 + wr * 64 + fr;
        LAS float* wb = wl + (wr * 4 + wc) * 256;
        { const int l = fq * 16 + fr, v = l >> 3, c4 = l & 7;
          const float* src = ((v & 3) == 3 ? cb : cw + (v & 3) * NUP) + (v >> 2) * DFF + u.pn * 128 + wc * 32 + 4 * c4;
          *(LAS f32x4*)(wb + v * 32 + 4 * c4) = *(const f32x4*)src; }
        float rs[2][4];
#pragma unroll
        for (int ai = 0; ai < 2; ++ai)
#pragma unroll
            for (int m = 0; m < 4; ++m) rs[ai][m] = __builtin_amdgcn_rsqf(ss1[row0 + ai * 128 + m * 16] * (1.0f / D) + EPS);
        const int cg0 = u.pn * 128 + wc * 32 + 8 * fq;
        const volatile LAS f32x4* wv = (const volatile LAS f32x4*)(wb + 8 * fq);
#pragma unroll
        for (int ai = 0; ai < 2; ++ai) {
            f32x4 l1g[2], l2g[2], l1u[2], l2u[2];
#pragma unroll
            for (int n = 0; n < 2; ++n) { l1g[n] = (f32x4){0.f, 0.f, 0.f, 0.f}; l2g[n] = l1g[n]; l1u[n] = l1g[n]; l2u[n] = l1g[n]; }
#pragma unroll
            for (int m = 0; m < 4; ++m) {
                const int row = row0 + ai * 128 + m * 16;
                v4u wo;
#pragma unroll
                for (int n = 0; n < 2; ++n) {
                    const int cg_ = cg0 + 4 * n;
                    f32x4 sg;
                    { const f32x4 g = acc[ai][0][m][n] * rs[ai][m];
                      if (m == 0 && fr < 2) *(f32x4*)(raw + ((size_t)(row >> 6) * 4 + 2 + fr) * NUP + cg_) = g;
                      if (m == 3 && fr >= 14) *(f32x4*)(raw + ((size_t)(row >> 6) * 4 + (fr - 14)) * NUP + cg_) = g;
                      f32x4 r1, r2, x1, x2;
#pragma unroll
                      for (int j = 0; j < 4; ++j) { r1[j] = dppf<0x121>(g[j]); r2[j] = dppf<0x122>(g[j]); }
#pragma unroll
                      for (int j = 0; j < 4; ++j) { x1[j] = fr == 0 ? l1g[n][j] : r1[j]; x2[j] = fr < 2 ? l2g[n][j] : r2[j]; }
                      l1g[n] = r1; l2g[n] = r2;
                      const f32x4 w0 = wv[n], w1 = wv[8 + n], w2 = wv[16 + n], bb = wv[24 + n];
                      const f32x4 ag = w0 * x2 + w1 * x1 + w2 * g + bb;
#pragma unroll
                      for (int j = 0; j < 4; ++j) sg[j] = silu_(ag[j]);
                      asm volatile("" : "+v"(sg)); }
                    f32x4 o;
                    { const f32x4 up = acc[ai][1][m][n] * rs[ai][m];
                      if (m == 0 && fr < 2) *(f32x4*)(raw + ((size_t)(row >> 6) * 4 + 2 + fr) * NUP + DFF + cg_) = up;
                      if (m == 3 && fr >= 14) *(f32x4*)(raw + ((size_t)(row >> 6) * 4 + (fr - 14)) * NUP + DFF + cg_) = up;
                      f32x4 r1, r2, x1, x2;
#pragma unroll
                      for (int j = 0; j < 4; ++j) { r1[j] = dppf<0x121>(up[j]); r2[j] = dppf<0x122>(up[j]); }
#pragma unroll
                      for (int j = 0; j < 4; ++j) { x1[j] = fr == 0 ? l1u[n][j] : r1[j]; x2[j] = fr < 2 ? l2u[n][j] : r2[j]; }
                      l1u[n] = r1; l2u[n] = r2;
                      const f32x4 w0 = wv[32 + n], w1 = wv[40 + n], w2 = wv[48 + n], bb = wv[56 + n];
                      o = (w0 * x2 + w1 * x1 + w2 * up + bb) * sg; }
                    wo[2 * n] = pk2(o[0], o[1]); wo[2 * n + 1] = pk2(o[2], o[3]); }
                *(v4u*)(act + (size_t)row * DFF + cg0) = wo; } }
    }
};

struct EpiAS {
    static constexpr bool PERM = false, AFTER_DRAIN = false;
    float* as; const float* ss1;
    __device__ __forceinline__ void operator()(const f32x4 (&acc)[2][2][4][2], const Unit& u, int wr, int wc, int fr, int fq) const {
#pragma unroll
        for (int m = 0; m < 4; ++m) { const int s_ = wr * 64 + m * 16 + fr; const float r = __builtin_amdgcn_rsqf(ss1[MP + s_] * (1.0f / D) + EPS);
#pragma unroll
            for (int n = 0; n < 2; ++n) { const int cg_ = u.pn * 128 + wc * 32 + 16 * n + 4 * fq;
                *(f32x4*)(as + (size_t)s_ * NUP + cg_) = acc[0][0][m][n] * r; *(f32x4*)(as + (size_t)s_ * NUP + DFF + cg_) = acc[0][1][m][n] * r; } }
    }
};
struct SampleOrder {
    int idx;
    __device__ __forceinline__ bool next(int i, Unit& u) const { if (i != 0 || idx < 0) return false; u.pm = MP / 256; u.pn = idx; return true; }
    __device__ __forceinline__ void a_ready(const Unit&) const {}
    __device__ __forceinline__ void done(const Unit&) const {}
};

struct ProjOrder {
    int first, nw;
    __device__ __forceinline__ bool next(int i, Unit& u) const { if (first < 0) return false; const int j = first + i * nw; if (j >= (MP / 256 + 1) * (D / 256)) return false; u.pm = j >> 3; u.pn = j & 7; return true; }
    __device__ __forceinline__ void a_ready(const Unit&) const {}
    __device__ __forceinline__ void done(const Unit&) const {}
};
struct EpiResS {
    static constexpr bool PERM = true, AFTER_DRAIN = false;
    const float* xs; bf16* hb; float* ss;
    __device__ __forceinline__ void operator()(const f32x4 (&acc)[2][2][4][2], const Unit& u, int wr, int wc, int fr, int fq) const {
        const int col0 = u.pn * 256 + wc * 32 + 8 * fq;
#pragma unroll
        for (int m = 0; m < 4; ++m) { const int s_ = wr * 64 + m * 16 + fr; float s = 0.f;
#pragma unroll
            for (int bj = 0; bj < 2; ++bj) { const size_t o_ = (size_t)s_ * D + col0 + bj * 128;
                const f32x4 o0 = *(const f32x4*)(xs + o_) + acc[0][bj][m][0], o1 = *(const f32x4*)(xs + o_ + 4) + acc[0][bj][m][1];
                v4u w; w.x = pk2(o0[0], o0[1]); w.y = pk2(o0[2], o0[3]); w.z = pk2(o1[0], o1[1]); w.w = pk2(o1[2], o1[3]); *(v4u*)(hb + o_) = w;
                s += ((o0[0] * o0[0] + o0[1] * o0[1]) + (o0[2] * o0[2] + o0[3] * o0[3])) + ((o1[0] * o1[0] + o1[1] * o1[1]) + (o1[2] * o1[2] + o1[3] * o1[3])); }
            s += __shfl_xor(s, 16); s += __shfl_xor(s, 32);
            if (fq == 0) atomic_addf(ss + s_, s); }
    }
};
template <int RT, int NK>
__device__ __forceinline__ void skinny_batch(f32x4 (&acc)[RT][2], const bf16* ap, const bf16* bp, int K) {
    bf16x8 bq[NK][2], aq[NK][RT];
#pragma unroll
    for (int kk = 0; kk < NK; ++kk) { bq[kk][0] = *(const bf16x8*)(bp + 32 * kk); bq[kk][1] = *(const bf16x8*)(bp + (size_t)16 * K + 32 * kk);
#pragma unroll
        for (int rt = 0; rt < RT; ++rt) aq[kk][rt] = *(const bf16x8*)(ap + (size_t)rt * 16 * K + 32 * kk); }
#pragma unroll
    for (int kk = 0; kk < NK; ++kk)
#pragma unroll
        for (int rt = 0; rt < RT; ++rt) { acc[rt][0] = __builtin_amdgcn_mfma_f32_16x16x32_bf16(bq[kk][0], aq[kk][rt], acc[rt][0], 0, 0, 0); acc[rt][1] = __builtin_amdgcn_mfma_f32_16x16x32_bf16(bq[kk][1], aq[kk][rt], acc[rt][1], 0, 0, 0); }
}
template <int RT, class F>
__device__ __forceinline__ void skinny_gemm(LAS unsigned char* lds, const bf16* A, const bf16* Bt, int N, int K, int u0, int ustride, const F& f) {
    const int tid = threadIdx.x, lane = tid & 63, w = tid >> 6, fr = lane & 15, fq = lane >> 4;
    constexpr int nrb = 8 / RT, ROWS = 16 * RT;
    const int nunits = nrb * (N / 32), kw = K / 8;
    LAS float* red = (LAS float*)lds;
    for (int u = u0; u < nunits; u += ustride) {
        const int rb = u % nrb, cb = u / nrb, row0 = rb * ROWS, col0 = cb * 32;
        f32x4 acc[RT][2];
#pragma unroll
        for (int rt = 0; rt < RT; ++rt) { acc[rt][0] = (f32x4){0.f, 0.f, 0.f, 0.f}; acc[rt][1] = (f32x4){0.f, 0.f, 0.f, 0.f}; }
        const bf16* ap = A + (size_t)(row0 + fr) * K + w * kw + 8 * fq;
        const bf16* bp = Bt + (size_t)(col0 + fr) * K + w * kw + 8 * fq;
        if constexpr (RT <= 2) {
            int k = 0;
            if (kw == 704) { skinny_batch<RT, 11>(acc, ap, bp, K); skinny_batch<RT, 11>(acc, ap + 352, bp + 352, K); k = 704; }
            for (; k + 256 <= kw; k += 256) skinny_batch<RT, 8>(acc, ap + k, bp + k, K);
            for (; k < kw; k += 32) skinny_batch<RT, 1>(acc, ap + k, bp + k, K);
        } else {
#pragma unroll 2
        for (int k = 0; k < kw; k += 32) {
            const bf16x8 b0 = *(const bf16x8*)(bp + k), b1 = *(const bf16x8*)(bp + (size_t)16 * K + k);
#pragma unroll
            for (int rt = 0; rt < RT; ++rt) { const bf16x8 av = *(const bf16x8*)(ap + (size_t)rt * 16 * K + k);
                acc[rt][0] = __builtin_amdgcn_mfma_f32_16x16x32_bf16(b0, av, acc[rt][0], 0, 0, 0);
                acc[rt][1] = __builtin_amdgcn_mfma_f32_16x16x32_bf16(b1, av, acc[rt][1], 0, 0, 0); }
        }
        }
#pragma unroll
        for (int rt = 0; rt < RT; ++rt)
#pragma unroll
            for (int ct = 0; ct < 2; ++ct) *(LAS f32x4*)(red + (w * ROWS + 16 * rt + fr) * 32 + 16 * ct + 4 * fq) = acc[rt][ct];
        __syncthreads();
#pragma unroll
        for (int it = 0; it < RT; ++it) { const int e = tid + 512 * it, r = e >> 5, c = e & 31; float v = 0.f;
#pragma unroll
            for (int ww = 0; ww < 8; ++ww) v += red[(ww * ROWS + r) * 32 + c];
            f(row0 + r, col0 + c, v); }
        __syncthreads();
    }
}
__device__ __forceinline__ float half_wave_sum(float v) {
#pragma unroll
    for (int o = 1; o < 32; o <<= 1) v += __shfl_xor(v, o);
    return v;
}

__device__ __forceinline__ void transpose_item(const float* W, int K, int N, const float* g, bf16* WT, bool upmap, LAS float* scr, int item, int lane) {
    const int nblk = N / 64, kb = item / nblk, nb = item % nblk, k0 = 64 * kb, n0 = 64 * nb;
    const float* src = W + (size_t)k0 * N + n0 + lane;
#pragma unroll
    for (int h = 0; h < 2; ++h) {
        float v[32];
#pragma unroll
        for (int i = 0; i < 32; ++i) v[i] = __builtin_nontemporal_load(src + (size_t)(32 * h + i) * N);
#pragma unroll
        for (int i = 0; i < 32; ++i) { float x = v[i]; if (g) x *= g[k0 + 32 * h + i]; scr[(32 * h + i) * 65 + lane] = x; }
    }
    LDS_WAIT(); asm volatile("" ::: "memory");
    const int c = lane & 7;
#pragma unroll
    for (int j = 0; j < 8; ++j) { const int n = (lane >> 3) + 8 * j; const LAS float* s = scr + (8 * c) * 65 + n;
        v4u o; o.x = pk2(s[0 * 65], s[1 * 65]); o.y = pk2(s[2 * 65], s[3 * 65]); o.z = pk2(s[4 * 65], s[5 * 65]); o.w = pk2(s[6 * 65], s[7 * 65]);
        int R = n0 + n; if (upmap) { const int half = R >= DFF ? 1 : 0, jj = R - half * DFF; R = 256 * (jj >> 7) + 128 * half + (jj & 127); }
        *(v4u*)(WT + (size_t)R * K + k0 + 8 * c) = o; }
    LDS_WAIT(); asm volatile("" ::: "memory");
}
__device__ __forceinline__ void rms_row_to_bf16(const float* xrow, bf16* orow, float* rinv, int lane) {
    const f32x4* xr = (const f32x4*)xrow + lane;
    f32x4 v[8]; float s = 0.f;
#pragma unroll
    for (int j = 0; j < 8; ++j) { v[j] = __builtin_nontemporal_load(xr + 64 * j);
 s += (v[j][0] * v[j][0] + v[j][1] * v[j][1]) + (v[j][2] * v[j][2] + v[j][3] * v[j][3]); }
    const float ms = wave_sum(s) * (1.0f / D) + EPS, r = __builtin_amdgcn_rsqf(ms);
    if (lane == 0) *rinv = __builtin_sqrtf(ms);
    v2u* o8 = (v2u*)orow + lane;
#pragma unroll
    for (int j = 0; j < 8; ++j) { v2u w; w.x = pk2(v[j][0] * r, v[j][1] * r); w.y = pk2(v[j][2] * r, v[j][3] * r); o8[64 * j] = w; }
}

__device__ __forceinline__ void mm128(f32x4 (&acc)[8], const LAS bf16* A, const LAS bf16* B, int wave, int fr, int fq) {
#pragma unroll
    for (int ks = 0; ks < 4; ++ks) {
        const bf16x8 a = *(const LAS bf16x8*)(A + (16 * wave + fr) * LDP + 32 * ks + 8 * fq);
#pragma unroll
        for (int ct = 0; ct < 8; ++ct) { const bf16x8 b = *(const LAS bf16x8*)(B + (16 * ct + fr) * LDP + 32 * ks + 8 * fq);
            acc[ct] = __builtin_amdgcn_mfma_f32_16x16x32_bf16(b, a, acc[ct], 0, 0, 0); }
    }
}
template <bool TRANS, bool DEC>
__device__ __forceinline__ void stage_rope(LAS bf16* dst, const bf16* zb, const float* rope, float scale, float l2g, int tid) {
#pragma unroll
    for (int it = 0; it < 2; ++it) { const int idx = tid + 512 * it, j = idx >> 3, d8 = idx & 7;
        const v4u x1 = *(const v4u*)(zb + (size_t)j * NIN + 8 * d8), x2 = *(const v4u*)(zb + (size_t)j * NIN + 64 + 8 * d8);
        const f32x4* rp = (const f32x4*)(rope + (size_t)(j * 64 + 8 * d8) * 2);
        float sc = scale; if (DEC) sc *= __builtin_amdgcn_exp2f(l2g * (float)(127 - j));
        float o1[8], o2[8];
#pragma unroll
        for (int p = 0; p < 4; ++p) { const f32x4 cs = rp[p]; const float a0 = lo16(x1[p]), a1 = hi16(x1[p]), b0 = lo16(x2[p]), b1 = hi16(x2[p]);
            o1[2 * p] = (a0 * cs[0] - b0 * cs[1]) * sc; o2[2 * p] = (b0 * cs[0] + a0 * cs[1]) * sc;
            o1[2 * p + 1] = (a1 * cs[2] - b1 * cs[3]) * sc; o2[2 * p + 1] = (b1 * cs[2] + a1 * cs[3]) * sc; }
        if (!TRANS) { v4u w1, w2;
#pragma unroll
            for (int p = 0; p < 4; ++p) { w1[p] = pk2(o1[2 * p], o1[2 * p + 1]); w2[p] = pk2(o2[2 * p], o2[2 * p + 1]); }
            *(LAS v4u*)(dst + j * LDP + 8 * d8) = w1; *(LAS v4u*)(dst + j * LDP + 64 + 8 * d8) = w2; }
        else {
#pragma unroll
            for (int i = 0; i < 8; ++i) { dst[(8 * d8 + i) * LDP + j] = f2bf(o1[i]); dst[(64 + 8 * d8 + i) * LDP + j] = f2bf(o2[i]); } }
    }
}
__device__ __forceinline__ void stage_T(LAS bf16* dst, const bf16* zb, int tid) {
#pragma unroll
    for (int it = 0; it < 4; ++it) { const int idx = tid + 512 * it, j = idx >> 4, c8 = idx & 15;
        const v4u x = *(const v4u*)(zb + (size_t)j * NIN + 8 * c8);
#pragma unroll
        for (int p = 0; p < 4; ++p) { dst[(8 * c8 + 2 * p) * LDP + j] = (bf16)(x[p] & 0xffffu); dst[(8 * c8 + 2 * p + 1) * LDP + j] = (bf16)(x[p] >> 16); } }
}


struct RopeX { v4u x1[2], x2[2]; };
struct RopeCS { f32x4 cs[2][4]; };
struct TileX { v4u x[4]; };
__device__ __forceinline__ void rope_load(RopeX& r, const bf16* zb, int tid) {
#pragma unroll
    for (int it = 0; it < 2; ++it) { const int idx = tid + 512 * it, j = idx >> 3, d8 = idx & 7; r.x1[it] = *(const v4u*)(zb + (size_t)j * NIN + 8 * d8); r.x2[it] = *(const v4u*)(zb + (size_t)j * NIN + 64 + 8 * d8); }
}
__device__ __forceinline__ void rope_cs_load(RopeCS& c, const float* rope, int tid) {
#pragma unroll
    for (int it = 0; it < 2; ++it) { const int idx = tid + 512 * it, j = idx >> 3, d8 = idx & 7; const f32x4* rp = (const f32x4*)(rope + (size_t)(j * 64 + 8 * d8) * 2);
#pragma unroll
        for (int p = 0; p < 4; ++p) c.cs[it][p] = rp[p]; }
}
template <bool TRANS, bool DEC>
__device__ __forceinline__ void rope_commit(LAS bf16* dst, const RopeX& r, const RopeCS& c, float scale, float l2g, int tid) {
#pragma unroll
    for (int it = 0; it < 2; ++it) { const int idx = tid + 512 * it, j = idx >> 3, d8 = idx & 7;
        float sc = scale; if (DEC) sc *= __builtin_amdgcn_exp2f(l2g * (float)(127 - j));
        float o1[8], o2[8];
#pragma unroll
        for (int p = 0; p < 4; ++p) { const f32x4 cs = c.cs[it][p]; const float a0 = lo16(r.x1[it][p]), a1 = hi16(r.x1[it][p]), b0 = lo16(r.x2[it][p]), b1 = hi16(r.x2[it][p]);
            o1[2 * p] = (a0 * cs[0] - b0 * cs[1]) * sc; o2[2 * p] = (b0 * cs[0] + a0 * cs[1]) * sc;
            o1[2 * p + 1] = (a1 * cs[2] - b1 * cs[3]) * sc; o2[2 * p + 1] = (b1 * cs[2] + a1 * cs[3]) * sc; }
        if (!TRANS) { v4u w1, w2;
#pragma unroll
            for (int p = 0; p < 4; ++p) { w1[p] = pk2(o1[2 * p], o1[2 * p + 1]); w2[p] = pk2(o2[2 * p], o2[2 * p + 1]); }
            *(LAS v4u*)(dst + j * LDP + 8 * d8) = w1; *(LAS v4u*)(dst + j * LDP + 64 + 8 * d8) = w2; }
        else {
#pragma unroll
            for (int i = 0; i < 8; ++i) { dst[(8 * d8 + i) * LDP + j] = f2bf(o1[i]); dst[(64 + 8 * d8 + i) * LDP + j] = f2bf(o2[i]); } }
    }
}
__device__ __forceinline__ void tile_load(TileX& t, const bf16* zb, int tid) {
#pragma unroll
    for (int it = 0; it < 4; ++it) { const int idx = tid + 512 * it, j = idx >> 4, c8 = idx & 15; t.x[it] = *(const v4u*)(zb + (size_t)j * NIN + 8 * c8); }
}
__device__ __forceinline__ void tile_commit_T(LAS bf16* dst, const TileX& t, int tid) {
#pragma unroll
    for (int it = 0; it < 4; ++it) { const int idx = tid + 512 * it, j = idx >> 4, c8 = idx & 15;
#pragma unroll
        for (int p = 0; p < 4; ++p) { dst[(8 * c8 + 2 * p) * LDP + j] = (bf16)(t.x[it][p] & 0xffffu); dst[(8 * c8 + 2 * p + 1) * LDP + j] = (bf16)(t.x[it][p] >> 16); } }
}

typedef short s16x4 __attribute__((ext_vector_type(4)));
__device__ __forceinline__ bf16x8 tr_frag(const LAS bf16* T, int c, int ks, int lane) {
    const int g = lane >> 4, q = (lane & 15) >> 2, p = lane & 3;
    const LAS bf16* a0 = T + (32 * ks + 8 * g + q) * LDP + 16 * c + 4 * p;
    const s16x4 lo = __builtin_amdgcn_ds_read_tr16_b64_v4i16((LAS s16x4*)a0), hi = __builtin_amdgcn_ds_read_tr16_b64_v4i16((LAS s16x4*)(a0 + 4 * LDP));
    return (bf16x8){lo[0], lo[1], lo[2], lo[3], hi[0], hi[1], hi[2], hi[3]};
}
__device__ __forceinline__ void mm128_nt(f32x4 (&acc)[8], const LAS bf16* A, const LAS bf16* B, int wave, int lane) {
    const int fr = lane & 15, fq = lane >> 4;
#pragma unroll
    for (int ks = 0; ks < 4; ++ks) {
        const bf16x8 a = *(const LAS bf16x8*)(A + (16 * wave + fr) * LDP + 32 * ks + 8 * fq);
#pragma unroll
        for (int ct = 0; ct < 8; ++ct) acc[ct] = __builtin_amdgcn_mfma_f32_16x16x32_bf16(tr_frag(B, ct, ks, lane), a, acc[ct], 0, 0, 0);
    }
}
__device__ __forceinline__ void mm128_tt(f32x4 (&acc)[8], const LAS bf16* At, const LAS bf16* Bn, int wave, int lane) {
#pragma unroll
    for (int ks = 0; ks < 4; ++ks) {
        const bf16x8 a = tr_frag(At, wave, ks, lane);
#pragma unroll
        for (int ct = 0; ct < 8; ++ct) acc[ct] = __builtin_amdgcn_mfma_f32_16x16x32_bf16(tr_frag(Bn, ct, ks, lane), a, acc[ct], 0, 0, 0);
    }
}
__device__ __forceinline__ void tile_commit_N(LAS bf16* dst, const TileX& t, int tid) {
#pragma unroll
    for (int it = 0; it < 4; ++it) { const int idx = tid + 512 * it, j = idx >> 4, c8 = idx & 15; *(LAS v4u*)(dst + j * LDP + 8 * c8) = t.x[it]; }
}

__global__ void __launch_bounds__(512, 2) mk_fwd(Params a) {
    extern __shared__ __attribute__((aligned(16))) unsigned char lds_raw[];
    LAS unsigned char* lds = (LAS unsigned char*)lds_raw;
    const int tid = threadIdx.x, lane = tid & 63, wave = __builtin_amdgcn_readfirstlane(tid >> 6), fr = lane & 15, fq = lane >> 4;
    const int G = gridDim.x, blk = blockIdx.x;
    const int gw = blk * 8 + wave, NGW = G * 8;
    const int gt = blk * 512 + tid, NGT = G * 512;
    unsigned char* ws = a.ws;
#define x_p (a.in[0])
#define x_s (a.in[1])
#define p_p (a.in[2])
#define p_s (a.in[3])
#define state_ret (a.in[4])
#define state_conv (a.in[5])
#define gm_ln_g (a.in[8])
#define gm_ln_b (a.in[9])
#define gm_ws (a.in[10])
#define gm_bs (a.in[11])
#define conv_w (a.in[15])
#define conv_b (a.in[16])
#define g_final (a.in[21])
#define out (a.out)
#define SS1 ((float*)(ws + WS_SS1))
#define SS2 ((float*)(ws + WS_SS2))
#define SS3 ((float*)(ws + WS_SS3))
#define STATS ((float*)(ws + WS_STATS))
#define ROPE ((float*)(ws + WS_ROPE))
#define ROPES ((float*)(ws + WS_ROPES))
#define Win_t ((bf16*)(ws + WS_WIN))
#define Wo_t ((bf16*)(ws + WS_WO))
#define Wup_t ((bf16*)(ws + WS_WUP))
#define Wdn_t ((bf16*)(ws + WS_WDN))
#define Wg_t ((bf16*)(ws + WS_WG))
#define Wp_t ((bf16*)(ws + WS_WP))
#define AB ((bf16*)(ws + WS_AB))
#define PB ((bf16*)(ws + WS_PB))
#define MIX ((bf16*)(ws + WS_MIX))
#define Z ((bf16*)(ws + WS_Z))
#define ACT ((bf16*)(ws + WS_ACT))
#define KV ((float*)(ws + WS_KV))
#define PP ((bf16*)(ws + WS_PP))
#define RAW ((float*)(ws + WS_RAW))
#define AS ((float*)(ws + WS_AS))

    volatile LAS unsigned* MISC = (volatile LAS unsigned*)(lds + MISC_OFF);
    if (tid < 64) MISC[tid] = 0u;
    __syncthreads();
    XcdBarrier bar; bar.bar = (unsigned*)(ws + WS_BAR); bar.x = 0; bar.st = nullptr;
    if (MK_N_LAUNCHES == 1) bar = xcd_barrier_post((unsigned*)(ws + WS_BAR), MISC + 8);
    const int lo = a.ph_lo, hi = a.ph_hi;
#ifndef PHMASK
#define PHMASK 0xffff
#endif
#define IN(k) (((PHMASK >> (k)) & 1) && lo <= (k) && (k) < hi)
#define SEAM(k) do { if (IN(k) && IN((k) + 1)) { if (a.use_cg) cg::this_grid().sync(); else xcd_barrier(bar); } } while (0)

    if (IN(0)) {
        LAS float* scr = (LAS float*)(lds + wave * 16640);
        constexpr int I_IN = (D / 64) * (NIN / 64);
        for (int it = gw; it < I_IN; it += NGW) transpose_item(a.in[7], D, NIN, a.in[6], Win_t, false, scr, it, lane);
        for (int m = gw; m < MT; m += NGW) rms_row_to_bf16(m < MP ? x_p + (size_t)m * D : x_s + (size_t)(m - MP) * D, AB + (size_t)m * D, (float*)(ws + WS_RINV) + m, lane);
        for (int i = gt; i < MT * PLE / 4; i += NGT) { const f32x4 v = __builtin_nontemporal_load(i < MP * PLE / 4 ? (const f32x4*)p_p + i : (const f32x4*)p_s + (i - MP * PLE / 4)); v2u w; w.x = pk2(v[0], v[1]); w.y = pk2(v[2], v[3]); ((v2u*)PB)[i] = w; }
        for (int i = gt; i < SEQ * 64 + 64; i += NGT) { const int pos = i < SEQ * 64 ? (i >> 6) : 16384, fi = i & 63;
            const float ang = (float)pos * a.invf[fi]; double t = (double)ang * 0.15915494309189535; t -= __builtin_rint(t); const float rev = (float)t;
            float* dst = i < SEQ * 64 ? ROPE + 2 * (size_t)i : ROPES + 2 * fi; dst[0] = __builtin_amdgcn_cosf(rev); dst[1] = __builtin_amdgcn_sinf(rev); }
        for (int i = gt; i < MT; i += NGT) { SS1[i] = 0.f; SS2[i] = 0.f; SS3[i] = 0.f; }
    }
    SEAM(0);

    if (IN(1)) {
        { pg8::Gemm g{AB, Win_t, MP, NIN, D}; pg8::StaticOrder S; S.init(MP, NIN, G, blk); EpiZ E{Z};
          pg8::gemm_phase<EpiZ, pg8::StaticOrder, true, true>(lds, g, S, E); }
        auto f = [&](int s, int n, float v) { const float o = n < 3072 ? v : (n < 4096 ? silu_(v) : gelu_(v)); Z[(size_t)(MP + s) * NIN + n] = f2bf(o); };
        skinny_gemm<8>(lds, AB + (size_t)MP * D, Win_t, NIN, D, blk, G, f);
    }
    SEAM(1);

    if (IN(2)) {
        for (int pass = 0; pass < 2; ++pass) {
        if ((pass ^ (blk & 1)) == 0) {
        { LAS float* qs = (LAS float*)lds; LAS float* ks = qs + 128; LAS float* vs = ks + 128; LAS float* red = vs + 128;
          const int e4 = tid & 31, dg = tid >> 5;
          for (int u = blk; u < MS * NH; u += G) { const int s = u >> 3, h = u & 7; const bf16* zr = Z + (size_t)(MP + s) * NIN;
            const float* S0 = state_ret + (size_t)u * 16384 + 4 * e4; float* S1 = out + O_RETS + (size_t)u * 16384 + 4 * e4;
            f32x4 s0[8];
#pragma unroll
            for (int i = 0; i < 8; ++i) s0[i] = __builtin_nontemporal_load((const f32x4*)(S0 + (dg + 16 * i) * 128));
            if (tid < 64) { const float c = ROPES[2 * tid], sn = ROPES[2 * tid + 1];
                const float q1 = bf2f(zr[128 * h + tid]), q2 = bf2f(zr[128 * h + 64 + tid]), k1 = bf2f(zr[1024 + 128 * h + tid]), k2 = bf2f(zr[1024 + 128 * h + 64 + tid]);
                qs[tid] = q1 * c - q2 * sn; qs[tid + 64] = q2 * c + q1 * sn; ks[tid] = (k1 * c - k2 * sn) * 0.08838834764831845f; ks[tid + 64] = (k2 * c + k1 * sn) * 0.08838834764831845f; }
            else if (tid < 192) vs[tid - 64] = bf2f(zr[2048 + 128 * h + tid - 64]);
            unsigned gg = 0u; if (tid < 64) gg = *(const unsigned*)(zr + 3072 + 128 * h + 2 * tid);
            __syncthreads();
            const float gamma = 1.0f - __builtin_amdgcn_exp2f((float)(-5 - h));
            const f32x4 vv = *(const LAS f32x4*)(vs + 4 * e4); f32x4 o = {0.f, 0.f, 0.f, 0.f};
#pragma unroll
            for (int i = 0; i < 8; ++i) { const int d = dg + 16 * i; const f32x4 sn = s0[i] * gamma + vv * ks[d]; __builtin_nontemporal_store(sn, (f32x4*)(S1 + d * 128)); o += sn * qs[d]; }
            *(LAS f32x4*)(red + dg * 128 + 4 * e4) = o;
            __syncthreads();
            if (tid < 64) { float o0 = 0.f, o1 = 0.f;
#pragma unroll
                for (int i = 0; i < 16; ++i) { o0 += red[i * 128 + 2 * tid]; o1 += red[i * 128 + 2 * tid + 1]; }
                const float r = __builtin_amdgcn_rsqf(wave_sum(o0 * o0 + o1 * o1) * (1.0f / 128.0f) + EPS);
                *(unsigned*)(MIX + (size_t)(MP + s) * D + 128 * h + 2 * tid) = pk2(o0 * r * lo16(gg), o1 * r * hi16(gg)); }
            __syncthreads(); } }
        } else {
        { LAS bf16* Kt = (LAS bf16*)lds; LAS bf16* Vt = (LAS bf16*)(lds + TILE_B);
          for (int u = blk; u < 512; u += G) { const int b = u >> 7, h = (u >> 4) & 7, c = u & 15; const size_t R0 = (size_t)b * SEQ + 128 * c;
            RopeX kx; RopeCS cs; TileX vx;
            rope_load(kx, Z + R0 * NIN + 1024 + 128 * h, tid); rope_cs_load(cs, ROPE + (size_t)(128 * c) * 128, tid); tile_load(vx, Z + R0 * NIN + 2048 + 128 * h, tid);
            rope_commit<false, true>(Kt, kx, cs, 0.08838834764831845f, a.log2g[h], tid);
            tile_commit_N(Vt, vx, tid);
            __syncthreads();
            f32x4 acc[8];
#pragma unroll
            for (int ct = 0; ct < 8; ++ct) acc[ct] = (f32x4){0.f, 0.f, 0.f, 0.f};
            mm128_tt(acc, Kt, Vt, wave, lane);
            float* kv = KV + (size_t)u * 16384 + (16 * wave + fr) * 128 + 4 * fq;
#pragma unroll
            for (int ct = 0; ct < 8; ++ct) *(f32x4*)(kv + 16 * ct) = acc[ct];
            __syncthreads(); } }
        for (int r0 = gw; r0 < MP; r0 += 2 * NGW) { const int r1 = r0 + NGW;
            const bf16* p0 = Z + (size_t)r0 * NIN + 5120 + 16 * lane; const bf16* p1 = Z + (size_t)(r1 < MP ? r1 : r0) * NIN + 5120 + 16 * lane;
            const v4u xa0 = *(const v4u*)p0, xa1 = *(const v4u*)(p0 + 8), xb0 = *(const v4u*)p1, xb1 = *(const v4u*)(p1 + 8);
            float va[16], vb[16];
#pragma unroll
            for (int j = 0; j < 4; ++j) { va[2 * j] = lo16(xa0[j]); va[2 * j + 1] = hi16(xa0[j]); va[8 + 2 * j] = lo16(xa1[j]); va[8 + 2 * j + 1] = hi16(xa1[j]);
                                          vb[2 * j] = lo16(xb0[j]); vb[2 * j + 1] = hi16(xb0[j]); vb[8 + 2 * j] = lo16(xb1[j]); vb[8 + 2 * j + 1] = hi16(xb1[j]); }
            float sa = 0.f, sb = 0.f;
#pragma unroll
            for (int j = 0; j < 16; ++j) { sa += va[j]; sb += vb[j]; }
            const float ma = wave_sum(sa) * (1.0f / 1024.0f), mb = wave_sum(sb) * (1.0f / 1024.0f); float qa = 0.f, qb = 0.f;
#pragma unroll
            for (int j = 0; j < 16; ++j) { const float da = va[j] - ma, db = vb[j] - mb; qa += da * da; qb += db * db; }
            const float ra = __builtin_amdgcn_rsqf(wave_sum(qa) * (1.0f / 1024.0f) + EPS), rb = __builtin_amdgcn_rsqf(wave_sum(qb) * (1.0f / 1024.0f) + EPS);
            if (lane == 0) { STATS[2 * r0] = ma; STATS[2 * r0 + 1] = ra; if (r1 < MP) { STATS[2 * r1] = mb; STATS[2 * r1 + 1] = rb; } } }
        for (int row = MP + gw; row < MT; row += NGW) { const bf16* p = Z + (size_t)row * NIN + 5120 + 16 * lane; const v4u x0 = *(const v4u*)p, x1 = *(const v4u*)(p + 8);
            const int s_ = row - MP, c0 = 16 * lane, grp = lane >> 3; const float w00 = gm_ws[grp * 16384], b0 = gm_bs[grp * 128];
            const bf16* up = Z + (size_t)row * NIN + 4096 + c0; const v4u u0 = *(const v4u*)up, u1 = *(const v4u*)(up + 8);
            float v[16];
#pragma unroll
            for (int j = 0; j < 4; ++j) { v[2 * j] = lo16(x0[j]); v[2 * j + 1] = hi16(x0[j]); v[8 + 2 * j] = lo16(x1[j]); v[8 + 2 * j + 1] = hi16(x1[j]); }
            float s = 0.f;
#pragma unroll
            for (int j = 0; j < 16; ++j) s += v[j];
            const float mean = wave_sum(s) * (1.0f / 1024.0f); float q = 0.f;
#pragma unroll
            for (int j = 0; j < 16; ++j) { v[j] -= mean; q += v[j] * v[j]; }
            const float rstd = __builtin_amdgcn_rsqf(wave_sum(q) * (1.0f / 1024.0f) + EPS);
            float uu[16];
#pragma unroll
            for (int j = 0; j < 4; ++j) { uu[2 * j] = lo16(u0[j]); uu[2 * j + 1] = hi16(u0[j]); uu[8 + 2 * j] = lo16(u1[j]); uu[8 + 2 * j + 1] = hi16(u1[j]); }
            float vn[16], mo[16];
#pragma unroll
            for (int j = 0; j < 16; ++j) { vn[j] = v[j] * rstd * gm_ln_g[c0 + j] + gm_ln_b[c0 + j]; mo[j] = uu[j] * (w00 * vn[j] + b0); }
            float* gv = out + O_GMV + (size_t)s_ * 1024 + c0;
#pragma unroll
            for (int j = 0; j < 4; ++j) *(f32x4*)(gv + 4 * j) = (f32x4){vn[4 * j], vn[4 * j + 1], vn[4 * j + 2], vn[4 * j + 3]};
            v4u w0, w1;
#pragma unroll
            for (int j = 0; j < 4; ++j) { w0[j] = pk2(mo[2 * j], mo[2 * j + 1]); w1[j] = pk2(mo[8 + 2 * j], mo[8 + 2 * j + 1]); }
            bf16* mp = MIX + (size_t)row * D + 1024 + c0; *(v4u*)mp = w0; *(v4u*)(mp + 8) = w1; }
        } }
    }
    SEAM(2);

    if (IN(3)) {
        auto convert_rest = [&]() {
            LAS float* scr = (LAS float*)(lds + wave * 16640);
            constexpr int I_O = (D / 64) * (D / 64), I_UP = (D / 64) * (NUP / 64), I_DN = (DFF / 64) * (D / 64), I_G = I_O, I_P = (PLE / 64) * (D / 64);
            constexpr int NITEMS = I_O + I_UP + I_DN + I_G + I_P;
            for (int it = gw; it < NITEMS; it += NGW) {
                int r = it;
                if (r < I_UP) { transpose_item(a.in[14], D, NUP, a.in[13], Wup_t, true, scr, r, lane); continue; } r -= I_UP;
                if (r < I_O) { transpose_item(a.in[12], D, D, nullptr, Wo_t, false, scr, r, lane); continue; } r -= I_O;
                if (r < I_DN) { transpose_item(a.in[17], DFF, D, nullptr, Wdn_t, false, scr, r, lane); continue; } r -= I_DN;
                if (r < I_G) { transpose_item(a.in[19], D, D, a.in[18], Wg_t, false, scr, r, lane); continue; } r -= I_G;
                transpose_item(a.in[20], PLE, D, nullptr, Wp_t, false, scr, r, lane);
            }
            __syncthreads(); };
        if (!(blk & 1)) convert_rest();
        {
        LAS bf16* T0 = (LAS bf16*)lds; LAS bf16* T1 = (LAS bf16*)(lds + TILE_B); LAS bf16* T2 = (LAS bf16*)(lds + 2 * TILE_B); LAS bf16* T3 = (LAS bf16*)(lds + 3 * TILE_B);
        for (int u = blk; u < 512; u += G) { const int bh = u >> 4, b = bh >> 3, h = bh & 7, c = u < 256 ? (u & 15) : 15 - (u & 15); const size_t R0 = (size_t)b * SEQ + 128 * c; const float l2g = a.log2g[h];
            const int i_ = 16 * wave + fr;
            RopeX qx, kx; RopeCS cs; TileX vx; v2u gg[8];
            const float* kvb = KV + (size_t)bh * 16 * 16384;
            f32x4 tc[8];
#pragma unroll
            for (int i = 0; i < 8; ++i) tc[i] = *(const f32x4*)(kvb + 4 * (tid + 512 * i));
            rope_load(qx, Z + R0 * NIN + 128 * h, tid); rope_load(kx, Z + R0 * NIN + 1024 + 128 * h, tid); rope_cs_load(cs, ROPE + (size_t)(128 * c) * 128, tid); tile_load(vx, Z + R0 * NIN + 2048 + 128 * h, tid);
            rope_commit<false, false>(T0, qx, cs, 1.0f, 0.f, tid);
            rope_commit<false, false>(T1, kx, cs, 0.08838834764831845f, 0.f, tid);
            asm volatile("" ::: "memory");
            { const float Gc = __builtin_amdgcn_exp2f(l2g * 128.0f);
              f32x4 sp[8];
#pragma unroll
              for (int i = 0; i < 8; ++i) sp[i] = (f32x4){0.f, 0.f, 0.f, 0.f};
              for (int j = 0; j < c; ++j) { f32x4 tn[8];
#pragma unroll
                  for (int i = 0; i < 8; ++i) tn[i] = *(const f32x4*)(kvb + (size_t)(j + 1) * 16384 + 4 * (tid + 512 * i));
#pragma unroll
                  for (int i = 0; i < 8; ++i) { sp[i] = sp[i] * Gc + tc[i]; tc[i] = tn[i]; } }
              if (c == 15) {
#pragma unroll
                  for (int i = 0; i < 8; ++i) *(f32x4*)(out + O_RETP + (size_t)bh * 16384 + 4 * (tid + 512 * i)) = sp[i] * Gc + tc[i]; }
#pragma unroll
              for (int i = 0; i < 8; ++i) { const int ch = tid + 512 * i, d = ch >> 5, e4 = ch & 31; v2u w; w.x = pk2(sp[i][0], sp[i][1]); w.y = pk2(sp[i][2], sp[i][3]);
                  *(LAS v2u*)(T3 + d * LDP + 4 * e4) = w; } }
            tile_commit_N(T2, vx, tid);
            __syncthreads();
            { const bf16* gp = Z + (R0 + i_) * NIN + 3072 + 128 * h + 4 * fq;
#pragma unroll
              for (int ct = 0; ct < 8; ++ct) gg[ct] = *(const v2u*)(gp + 16 * ct); }
            f32x4 acc2[8], acc1[8];
#pragma unroll
            for (int ct = 0; ct < 8; ++ct) { acc2[ct] = (f32x4){0.f, 0.f, 0.f, 0.f}; acc1[ct] = (f32x4){0.f, 0.f, 0.f, 0.f}; }
            mm128_nt(acc2, T0, T3, wave, lane);
            mm128(acc1, T0, T1, wave, fr, fq);
            __syncthreads();
#pragma unroll
            for (int ct = 0; ct < 8; ++ct) { float sv[4];
#pragma unroll
                for (int t = 0; t < 4; ++t) { const int j = 16 * ct + 4 * fq + t; sv[t] = i_ >= j ? acc1[ct][t] * __builtin_amdgcn_exp2f(l2g * (float)(i_ - j)) : 0.f; }
                v2u w; w.x = pk2(sv[0], sv[1]); w.y = pk2(sv[2], sv[3]); *(LAS v2u*)(T1 + i_ * LDP + 16 * ct + 4 * fq) = w; }
            __syncthreads();
#pragma unroll
            for (int ct = 0; ct < 8; ++ct) acc1[ct] = (f32x4){0.f, 0.f, 0.f, 0.f};
            mm128_nt(acc1, T1, T2, wave, lane);
            const float qd = __builtin_amdgcn_exp2f(l2g * (float)(i_ + 1)); float ssq = 0.f;
#pragma unroll
            for (int ct = 0; ct < 8; ++ct) { acc1[ct] = acc1[ct] + acc2[ct] * qd; ssq += (acc1[ct][0] * acc1[ct][0] + acc1[ct][1] * acc1[ct][1]) + (acc1[ct][2] * acc1[ct][2] + acc1[ct][3] * acc1[ct][3]); }
            ssq += __shfl_xor(ssq, 16); ssq += __shfl_xor(ssq, 32);
            const float rn = __builtin_amdgcn_rsqf(ssq * (1.0f / 128.0f) + EPS);
            bf16* mp = MIX + (R0 + i_) * D + 128 * h + 4 * fq;
#pragma unroll
            for (int ct = 0; ct < 8; ++ct) { v2u w;
                w.x = pk2(acc1[ct][0] * rn * lo16(gg[ct].x), acc1[ct][1] * rn * hi16(gg[ct].x)); w.y = pk2(acc1[ct][2] * rn * lo16(gg[ct].y), acc1[ct][3] * rn * hi16(gg[ct].y)); *(v2u*)(mp + 16 * ct) = w; }
            __syncthreads(); }
        for (int u = blk; u < 512; u += G) { const int b = u >> 7, c = (u >> 3) & 15, grp = u & 7; const size_t R0 = (size_t)b * SEQ + 128 * c;
            const int t_ = 16 * wave + fr, d8 = tid & 15;
            f32x4 wl[4][2]; v4u xv[4]; float st[4][2]; v2u uu[8]; float lg[8], lb[8];
#pragma unroll
            for (int it = 0; it < 4; ++it) { const int idx = tid + 512 * it, t = idx >> 4; const float* wp = gm_ws + (size_t)grp * 16384 + t * 128 + 8 * d8;
                wl[it][0] = *(const f32x4*)wp; wl[it][1] = *(const f32x4*)(wp + 4);
                xv[it] = *(const v4u*)(Z + (R0 + t) * NIN + 5120 + 128 * grp + 8 * d8); st[it][0] = STATS[2 * (R0 + t)]; st[it][1] = STATS[2 * (R0 + t) + 1]; }
#pragma unroll
            for (int j = 0; j < 8; ++j) { lg[j] = gm_ln_g[128 * grp + 8 * d8 + j]; lb[j] = gm_ln_b[128 * grp + 8 * d8 + j]; }
            const float bsv = gm_bs[grp * 128 + t_];
#pragma unroll
            for (int it = 0; it < 4; ++it) { const int idx = tid + 512 * it, t = idx >> 4;
                float wv[8] = {wl[it][0][0], wl[it][0][1], wl[it][0][2], wl[it][0][3], wl[it][1][0], wl[it][1][1], wl[it][1][2], wl[it][1][3]};
#pragma unroll
                for (int j = 0; j < 8; ++j) if (8 * d8 + j > t) wv[j] = 0.f;
                v4u w; w.x = pk2(wv[0], wv[1]); w.y = pk2(wv[2], wv[3]); w.z = pk2(wv[4], wv[5]); w.w = pk2(wv[6], wv[7]); *(LAS v4u*)(T0 + t * LDP + 8 * d8) = w;
                const float mean = st[it][0], rstd = st[it][1];
                v4u vw;
#pragma unroll
                for (int p = 0; p < 4; ++p) vw[p] = pk2((lo16(xv[it][p]) - mean) * rstd * lg[2 * p] + lb[2 * p], (hi16(xv[it][p]) - mean) * rstd * lg[2 * p + 1] + lb[2 * p + 1]);
                *(LAS v4u*)(T1 + t * LDP + 8 * d8) = vw; }
            __syncthreads();
            { const bf16* up = Z + (R0 + t_) * NIN + 4096 + 128 * grp + 4 * fq;
#pragma unroll
              for (int ct = 0; ct < 8; ++ct) uu[ct] = *(const v2u*)(up + 16 * ct); }
            f32x4 acc[8];
#pragma unroll
            for (int ct = 0; ct < 8; ++ct) acc[ct] = (f32x4){0.f, 0.f, 0.f, 0.f};
            mm128_nt(acc, T0, T1, wave, lane);
            bf16* mp = MIX + (R0 + t_) * D + 1024 + 128 * grp + 4 * fq;
#pragma unroll
            for (int ct = 0; ct < 8; ++ct) { v2u w;
                w.x = pk2((acc[ct][0] + bsv) * lo16(uu[ct].x), (acc[ct][1] + bsv) * hi16(uu[ct].x)); w.y = pk2((acc[ct][2] + bsv) * lo16(uu[ct].y), (acc[ct][3] + bsv) * hi16(uu[ct].y)); *(v2u*)(mp + 16 * ct) = w; }
            __syncthreads(); }
        }
        if (blk & 1) convert_rest();
    }
    SEAM(3);

    if (IN(4)) {
        { pg8::Gemm g{MIX, Wo_t, MP, D, D}; pg8::StaticOrder S; S.init(MP, D, G, blk); EpiRes<2> E{(const float*)(ws + WS_RINV), nullptr, AB, SS1};
          pg8::gemm_phase<EpiRes<2>, pg8::StaticOrder, true, true>(lds, g, S, E); }
    }
    SEAM(4);

    if (IN(5)) {
        unsigned* p3s_cnt = (unsigned*)(ws + WS_BAR) + 3584;
        if (blk >= 248) {
            { pg8::Gemm g{MIX, Wo_t, MP + 256, D, D}; SampleOrder S{blk - 248}; EpiResS E{x_s, AB + (size_t)MP * D, SS1 + MP};
              pg8::gemm_phase<EpiResS, SampleOrder, true, true>(lds, g, S, E); }
            asm volatile("s_waitcnt vmcnt(0)" ::: "memory"); __syncthreads();
            if (tid == 0) { __builtin_amdgcn_fence(__ATOMIC_RELEASE, "agent"); asm volatile("s_waitcnt vmcnt(0)" ::: "memory"); (void)__hip_atomic_fetch_add(p3s_cnt, 1u, __ATOMIC_RELAXED, __HIP_MEMORY_SCOPE_AGENT); }
        }
        { pg8::Gemm g{AB, Wup_t, MP, NUP, D}; pg8::StaticOrder S; S.init(MP, NUP, G, blk); EpiUp E{ACT, RAW, SS1, conv_w, conv_b, (LAS float*)(lds + 131072)};
          pg8::gemm_phase<EpiUp, pg8::StaticOrder, true, true>(lds, g, S, E); }
        if (blk >= 128 && blk - 128 < NUP / 256) {
            if (tid == 0) { unsigned spins = 0; while (__hip_atomic_load(p3s_cnt, __ATOMIC_RELAXED, __HIP_MEMORY_SCOPE_AGENT) < 8u) { __builtin_amdgcn_s_sleep(4); if (++spins > (1u << 22)) break; } }
            __syncthreads();
            __builtin_amdgcn_fence(__ATOMIC_ACQUIRE, "agent"); asm volatile("s_waitcnt vmcnt(0)" ::: "memory"); }
        { pg8::Gemm g{AB, Wup_t, MP + 256, NUP, D}; SampleOrder S{(blk >= 128 && blk - 128 < NUP / 256) ? blk - 128 : -1}; EpiAS E{AS, SS1};
          pg8::gemm_phase<EpiAS, SampleOrder, true, true>(lds, g, S, E); }
        { int Kp = PLE; asm volatile("" : "+s"(Kp));
          constexpr int nbusy = (MP / 256 * (NUP / 256) + NUP / 256) - 5 * 256;
          pg8::Gemm g{PB, Wp_t, MP + 256, D, Kp}; ProjOrder S{(blk >= nbusy && blk < 248) ? blk - nbusy : -1, 248 - nbusy}; EpiPP E{PP};
          pg8::gemm_phase<EpiPP, ProjOrder, true, true>(lds, g, S, E); }
    }
    SEAM(5);

    if (IN(6)) {
        for (int i = gt; i < 128 * 2 * (DFF / 4); i += NGT) { const int c4 = i % (DFF / 4), gr = i / (DFF / 4), rr = gr & 1, Gp = gr >> 1, c = 4 * c4; const bool first = (Gp & 31) == 0;
            const float* rg = RAW + (size_t)Gp * 4 * NUP; const float* rp = rg - 4 * NUP; const f32x4 z4 = {0.f, 0.f, 0.f, 0.f};
            f32x4 a0g, a0u, a1g, a1u, a2g, a2u;
            a0g = *(const f32x4*)(rg + (2 + rr) * NUP + c); a0u = *(const f32x4*)(rg + (2 + rr) * NUP + DFF + c);
            if (rr) { a1g = *(const f32x4*)(rg + 2 * NUP + c); a1u = *(const f32x4*)(rg + 2 * NUP + DFF + c); a2g = first ? z4 : *(const f32x4*)(rp + NUP + c); a2u = first ? z4 : *(const f32x4*)(rp + NUP + DFF + c); }
            else { a1g = first ? z4 : *(const f32x4*)(rp + NUP + c); a1u = first ? z4 : *(const f32x4*)(rp + NUP + DFF + c); a2g = first ? z4 : *(const f32x4*)(rp + c); a2u = first ? z4 : *(const f32x4*)(rp + DFF + c); }
            const f32x4 ag = *(const f32x4*)(conv_w + c) * a2g + *(const f32x4*)(conv_w + NUP + c) * a1g + *(const f32x4*)(conv_w + 2 * NUP + c) * a0g + *(const f32x4*)(conv_b + c);
            const f32x4 au = *(const f32x4*)(conv_w + DFF + c) * a2u + *(const f32x4*)(conv_w + NUP + DFF + c) * a1u + *(const f32x4*)(conv_w + 2 * NUP + DFF + c) * a0u + *(const f32x4*)(conv_b + DFF + c);
            v2u w; w.x = pk2(silu_(ag[0]) * au[0], silu_(ag[1]) * au[1]); w.y = pk2(silu_(ag[2]) * au[2], silu_(ag[3]) * au[3]);
            *(v2u*)(ACT + (size_t)(64 * Gp + rr) * DFF + c) = w; }
        for (int i = gt; i < MS * (DFF / 4); i += NGT) { const int c4 = i % (DFF / 4), s = i / (DFF / 4), c = 4 * c4;
            const float* sc0 = state_conv + (size_t)s * 2 * NUP; const float* sc1 = sc0 + NUP; const float* as = AS + (size_t)s * NUP;
            const f32x4 a0g = *(const f32x4*)(as + c), a0u = *(const f32x4*)(as + DFF + c), a1g = *(const f32x4*)(sc1 + c), a1u = *(const f32x4*)(sc1 + DFF + c), a2g = *(const f32x4*)(sc0 + c), a2u = *(const f32x4*)(sc0 + DFF + c);
            const f32x4 ag = *(const f32x4*)(conv_w + c) * a2g + *(const f32x4*)(conv_w + NUP + c) * a1g + *(const f32x4*)(conv_w + 2 * NUP + c) * a0g + *(const f32x4*)(conv_b + c);
            const f32x4 au = *(const f32x4*)(conv_w + DFF + c) * a2u + *(const f32x4*)(conv_w + NUP + DFF + c) * a1u + *(const f32x4*)(conv_w + 2 * NUP + DFF + c) * a0u + *(const f32x4*)(conv_b + DFF + c);
            v2u w; w.x = pk2(silu_(ag[0]) * au[0], silu_(ag[1]) * au[1]); w.y = pk2(silu_(ag[2]) * au[2], silu_(ag[3]) * au[3]);
            *(v2u*)(ACT + (size_t)(MP + s) * DFF + c) = w;
            float* cs = out + O_CONVS + (size_t)s * 2 * NUP; *(f32x4*)(cs + c) = a1g; *(f32x4*)(cs + DFF + c) = a1u; *(f32x4*)(cs + NUP + c) = a0g; *(f32x4*)(cs + NUP + DFF + c) = a0u; }
        for (int i = gt; i < 4 * 2 * (NUP / 4); i += NGT) { const int c4 = i % (NUP / 4), bk = i / (NUP / 4), b = bk >> 1, k = bk & 1;
            *(f32x4*)(out + O_CONVP + (size_t)bk * NUP + 4 * c4) = *(const f32x4*)(RAW + ((size_t)(32 * b + 31) * 4 + k) * NUP + 4 * c4); }
    }
    SEAM(6);

    if (IN(7)) {
        { pg8::Gemm g{ACT, Wdn_t, MP, D, DFF}; pg8::StaticOrder S; S.init(MP, D, G, blk); EpiRes<1> E{nullptr, nullptr, AB, SS2};
          pg8::gemm_phase<EpiRes<1>, pg8::StaticOrder, true, true>(lds, g, S, E); }
        auto f = [&](int s, int n, float v) { const size_t o_ = (size_t)(MP + s) * D + n; const float o = bf2f(AB[o_]) + v; AB[o_] = f2bf(o);
            const float q = half_wave_sum(o * o); if ((lane & 31) == 0) atomic_addf(SS2 + MP + s, q); };
        skinny_gemm<2>(lds, ACT + (size_t)MP * DFF, Wdn_t, D, DFF, blk, G, f);
    }
    SEAM(7);

    if (IN(8)) {
#ifndef T_B
        { pg8::Gemm g{AB, Wg_t, MP, D, D}; pg8::StaticOrder S; S.init(MP, D, G, blk); EpiGate E{PP, AB, out, SS2, SS3};
          pg8::gemm_phase<EpiGate, pg8::StaticOrder, true, true>(lds, g, S, E); }
#endif
#ifndef T_D
        auto f2 = [&](int s, int n, float v) { const size_t o_ = (size_t)(MP + s) * D + n; const float r2 = __builtin_amdgcn_rsqf(SS2[MP + s] * (1.0f / D) + EPS);
            const float o = bf2f(AB[o_]) + bf2f(PP[o_]) * sigmoid_(r2 * v); out[o_] = o; const float q = half_wave_sum(o * o); if ((lane & 31) == 0) atomic_addf(SS3 + MP + s, q); };
        skinny_gemm<2>(lds, AB + (size_t)MP * D, Wg_t, D, D, blk, G, f2);
#endif
    }
    SEAM(8);

    if (IN(9)) {
        { const f32x4* gr = (const f32x4*)g_final + lane; f32x4 gv[8];
#pragma unroll
          for (int j = 0; j < 8; ++j) gv[j] = gr[64 * j];
          for (int m0 = gw; m0 < MT; m0 += 2 * NGW) { const int m1 = m0 + NGW; const bool two = m1 < MT;
            f32x4* h0 = (f32x4*)(out + (size_t)m0 * D) + lane; f32x4* h1 = (f32x4*)(out + (size_t)(two ? m1 : m0) * D) + lane;
            f32x4 a0[8], a1[8];
#pragma unroll
            for (int j = 0; j < 8; ++j) { a0[j] = h0[64 * j]; a1[j] = h1[64 * j]; }
            const float r0 = __builtin_amdgcn_rsqf(SS3[m0] * (1.0f / D) + EPS), r1 = __builtin_amdgcn_rsqf(SS3[two ? m1 : m0] * (1.0f / D) + EPS);
#pragma unroll
            for (int j = 0; j < 8; ++j) __builtin_nontemporal_store(a0[j] * gv[j] * r0, h0 + 64 * j);
            if (two) {
#pragma unroll
                for (int j = 0; j < 8; ++j) __builtin_nontemporal_store(a1[j] * gv[j] * r1, h1 + 64 * j); } } }
    }
#undef IN
#undef SEAM
}
#undef x_p
#undef x_s
#undef p_p
#undef p_s
#undef state_ret
#undef state_conv
#undef gm_ln_g
#undef gm_ln_b
#undef gm_ws
#undef gm_bs
#undef conv_w
#undef conv_b
#undef g_final
#undef out
#undef SS1
#undef SS2
#undef SS3
#undef STATS
#undef ROPE
#undef ROPES
#undef Win_t
#undef Wo_t
#undef Wup_t
#undef Wdn_t
#undef Wg_t
#undef Wp_t
#undef AB
#undef PB
#undef MIX
#undef Z
#undef ACT
#undef KV
#undef PP
#undef RAW
#undef AS

extern "C" void kernel_launch(void* const* d_in, const int* in_sizes, int n_in, void* d_out, int out_size, void* d_ws, size_t ws_size, hipStream_t stream) {
    static int grid = 0;
    if (grid == 0) {
        if (n_in != 22 || out_size != (int)O_END || ws_size < WS_END) { fprintf(stderr, "kernel_launch: unexpected shapes: n_in %d out %d ws %zu\n", n_in, out_size, ws_size); grid = -1; return; }
        int dev = 0, cus = 0, per_cu = 0;
        if (hipGetDevice(&dev) != hipSuccess || hipDeviceGetAttribute(&cus, hipDeviceAttributeMultiprocessorCount, dev) != hipSuccess) { grid = -1; return; }
        if (hipFuncSetAttribute((const void*)mk_fwd, hipFuncAttributeMaxDynamicSharedMemorySize, LDS_BYTES) != hipSuccess) { fprintf(stderr, "kernel_launch: hipFuncSetAttribute failed\n"); grid = -1; return; }
        if (hipOccupancyMaxActiveBlocksPerMultiprocessor(&per_cu, (const void*)mk_fwd, 512, LDS_BYTES) != hipSuccess || per_cu < 1) fprintf(stderr, "kernel_launch: occupancy query says %d\n", per_cu);
        (void)hipGetLastError();
        grid = cus;
        if (grid != 256) fprintf(stderr, "kernel_launch: %d CUs (built for 256)\n", grid);
    }
    if (grid < 0) return;
    if (hipMemsetAsync((char*)d_ws + WS_BAR, 0, BAR_BYTES, stream) != hipSuccess) { fprintf(stderr, "kernel_launch: memset failed\n"); return; }
    Params p{};
    for (int i = 0; i < 22; ++i) p.in[i] = (const float*)d_in[i];
    p.out = (float*)d_out; p.ws = (unsigned char*)d_ws;
    for (int h = 0; h < 8; ++h) p.log2g[h] = (float)std::log2(1.0 - std::exp2(-5.0 - (double)h));
    for (int i = 0; i < 64; ++i) p.invf[i] = powf(10000.0f, -(float)i / 64.0f);
    p.use_cg = 0; p.pad = 0;
#if MK_N_LAUNCHES == 1
    void* args[] = {&p};
#ifdef PROBE_K
    p.ph_lo = 0; p.ph_hi = PROBE_K + 1;
    (void)hipLaunchCooperativeKernel((const void*)mk_fwd, dim3(grid), dim3(512), args, LDS_BYTES, stream);
    if (hipMemsetAsync((char*)d_ws + WS_BAR, 0, BAR_BYTES, stream) != hipSuccess) return;
#endif
    p.ph_lo = 0; p.ph_hi = NPHASE;
    hipError_t e = hipLaunchCooperativeKernel((const void*)mk_fwd, dim3(grid), dim3(512), args, LDS_BYTES, stream);
    if (e != hipSuccess) fprintf(stderr, "kernel_launch: cooperative launch failed: %s\n", hipGetErrorString(e));
#else
    for (int ph = 0; ph < NPHASE; ++ph) { p.ph_lo = ph; p.ph_hi = ph + 1; hipLaunchKernelGGL(mk_fwd, dim3(grid), dim3(512), LDS_BYTES, stream, p); }
#endif
}
```

```cpp
#include <hip/hip_runtime.h>
#include <hip/hip_cooperative_groups.h>
#include <cstdio>
#include <cstdint>
#include <cmath>
namespace cg = cooperative_groups;

#ifndef MK_N_LAUNCHES
#define MK_N_LAUNCHES 1
#endif

namespace pg8 {
#define PG8_LAS __attribute__((address_space(3)))
typedef unsigned short bf16_t;
typedef short bf16x8 __attribute__((ext_vector_type(8)));
typedef float f32x4 __attribute__((ext_vector_type(4)));
typedef unsigned u32x4 __attribute__((ext_vector_type(4)));
constexpr int BM = 256, BK = 64, HALF = 128, HTB = HALF * BK * 2  , STAGE_BYTES = 8 * HTB, NXCD = 8, WGM = 8;

__host__ __device__ __forceinline__ int lds_byte(int r, int c) { const int st = (r >> 4) * 2 + (c >> 5), rr = r & 15, cc = c & 31, ob = rr * 64 + cc * 2; return st * 1024 + (ob ^ (((ob >> 9) & 1) << 5)); }
__host__ __device__ __forceinline__ void stage_rc(int b, int& R, int& C) { const int st = b / 1024, sb = b % 1024, swz = sb ^ (((sb >> 9) & 1) << 5); R = (st >> 1) * 16 + swz / 64; C = (st & 1) * 32 + (swz % 64) / 2; }
__host__ __device__ __forceinline__ int perm32(int rho) { const int n = rho >> 4, i = rho & 15; return 8 * (i >> 2) + 4 * n + (i & 3); }

struct Unit { int pm, pn; };
struct Gemm { const bf16_t* A; const bf16_t* Bt; int M, N, K; int ld = 0; };

struct StaticOrder {
    int nM, nN, nwg, G, c;
    __host__ __device__ void init(int M, int N, int G_, int c_) { nM = M / BM; nN = N / BM; nwg = nM * nN; G = G_; c = c_; }
    __host__ __device__ bool next(int i, Unit& u) const {
        const long L = (long)i * G + c; if (L >= nwg) return false;
        int wgid = (int)L; { const int q = nwg / NXCD, r = nwg % NXCD, xcd = wgid % NXCD, off = wgid / NXCD; wgid = (xcd < r ? xcd * (q + 1) : r * (q + 1) + (xcd - r) * q) + off; }
        const int nig = WGM * nN, gid = wgid / nig, fm = gid * WGM, gsz = (nM - fm) < WGM ? (nM - fm) : WGM;
        u.pm = fm + ((wgid % nig) % gsz); u.pn = (wgid % nig) / gsz; return true;
    }
    __device__ __forceinline__ void a_ready(const Unit&) const {}
    __device__ __forceinline__ void done(const Unit&) const {}
};

__device__ __forceinline__ unsigned cvt_pk_bf16(float lo, float hi) { unsigned r; asm volatile("v_cvt_pk_bf16_f32 %0, %1, %2" : "=v"(r) : "v"(lo), "v"(hi)); return r; }
typedef float f32x2 __attribute__((ext_vector_type(2)));

template <class Epi, class Sched, bool ALIGN_EPI = false, bool SP2 = false>
__device__ __forceinline__ void gemm_phase(PG8_LAS unsigned char* lds, const Gemm g, const Sched& S, const Epi& E) {
    const int tid = threadIdx.x, wid = __builtin_amdgcn_readfirstlane(tid >> 6), lane = tid & 63, wr = wid >> 2, wc = wid & 3, fr = lane & 15, fq = lane >> 4;
    const int K = g.K, nt = K / BK, LD = g.ld ? g.ld : g.K;
    unsigned voffA[2], voffB[2];
#pragma unroll
    for (int i = 0; i < 2; ++i) { int R, C; stage_rc(tid * 16 + i * 8192, R, C); const int Rb = Epi::PERM ? ((R & ~31) + perm32(R & 31)) : R;
        voffA[i] = (unsigned)(R * LD + C) * 2u; voffB[i] = (unsigned)(Rb * LD + C) * 2u; }
    const size_t kstep = (size_t)(BK * 2);
    const size_t hstep = (size_t)HALF * LD * 2;
    const size_t tstep = 2 * hstep;
    const unsigned ldsw = (unsigned)wid * 1024u;
    const int aoff = lds_byte(wr * 64 + fr, fq * 8), boff = lds_byte(wc * 32 + fr, fq * 8);
#define PG8_SA(b, h) (((b) * 2 + (h)) * HTB)
#define PG8_SB(b, h) ((4 + (b) * 2 + (h)) * HTB)
#define PG8_STAGE(bufoff, gbase, voff) do { _Pragma("unroll") for (int _i = 0; _i < 2; ++_i) \
        __builtin_amdgcn_global_load_lds((const unsigned*)((const char*)(gbase) + (voff)[_i]), (PG8_LAS unsigned*)(lds + (bufoff) + ldsw + _i * 8192), 16, 0, 0); } while (0)
#define PG8_LDA(dst, b, h) do { _Pragma("unroll") for (int m = 0; m < 4; ++m) _Pragma("unroll") for (int k = 0; k < 2; ++k) dst[m][k] = *(const PG8_LAS bf16x8*)(lds + PG8_SA(b, h) + aoff + m * 2048 + k * 1024); } while (0)
#define PG8_LDB(dst, b, h) do { _Pragma("unroll") for (int n = 0; n < 2; ++n) _Pragma("unroll") for (int k = 0; k < 2; ++k) dst[n][k] = *(const PG8_LAS bf16x8*)(lds + PG8_SB(b, h) + boff + n * 2048 + k * 1024); } while (0)
#define PG8_MMA(ai, bj, At, Bt) do { __builtin_amdgcn_s_setprio(1); _Pragma("unroll") for (int m = 0; m < 4; ++m) _Pragma("unroll") for (int n = 0; n < 2; ++n) _Pragma("unroll") for (int k = 0; k < 2; ++k) \
        acc[ai][bj][m][n] = __builtin_amdgcn_mfma_f32_16x16x32_bf16(Bt[n][k], At[m][k], acc[ai][bj][m][n], 0, 0, 0); __builtin_amdgcn_s_setprio(0); } while (0)
#define PG8_WAIT_V(n) asm volatile("s_waitcnt vmcnt(" #n ")" ::: "memory")
#define PG8_WAIT_L(n) asm volatile("s_waitcnt lgkmcnt(" #n ")" ::: "memory")
#define PG8_BAR __builtin_amdgcn_s_barrier()
#define PG8_SCHED __builtin_amdgcn_sched_barrier(0)
    Unit cur, nxt; int ui = 0;
    if (!S.next(0, cur)) return;
    f32x4 acc[2][2][4][2];
#pragma unroll
    for (int a = 0; a < 2; ++a)
#pragma unroll
        for (int b = 0; b < 2; ++b)
#pragma unroll
            for (int m = 0; m < 4; ++m)
#pragma unroll
                for (int n = 0; n < 2; ++n) acc[a][b][m][n] = (f32x4){0.f, 0.f, 0.f, 0.f};
    bf16x8 At[4][2], B0[2][2], B1[2][2];
    const char* cA = (const char*)g.A + (size_t)cur.pm * tstep; const char* cB = (const char*)g.Bt + (size_t)cur.pn * tstep;
    S.a_ready(cur);
    if constexpr (SP2) {
        PG8_STAGE(PG8_SB(0, 0), cB, voffB); PG8_STAGE(PG8_SB(0, 1), cB + hstep, voffB); PG8_STAGE(PG8_SA(0, 0), cA, voffA); PG8_STAGE(PG8_SA(0, 1), cA + hstep, voffA);
        if (wr == 1) PG8_BAR;
        PG8_WAIT_V(2); PG8_BAR;
        PG8_STAGE(PG8_SB(1, 0), cB + kstep, voffB); PG8_STAGE(PG8_SA(1, 0), cA + kstep, voffA); PG8_STAGE(PG8_SB(1, 1), cB + hstep + kstep, voffB);
        PG8_WAIT_V(6); PG8_BAR;
    } else {
        PG8_STAGE(PG8_SB(0, 0), cB, voffB); PG8_STAGE(PG8_SA(0, 0), cA, voffA); PG8_STAGE(PG8_SB(0, 1), cB + hstep, voffB); PG8_STAGE(PG8_SA(0, 1), cA + hstep, voffA);
        if (wr == 1) PG8_BAR;
        PG8_WAIT_V(4); PG8_BAR;
        PG8_STAGE(PG8_SB(1, 0), cB + kstep, voffB); PG8_STAGE(PG8_SA(1, 0), cA + kstep, voffA); PG8_STAGE(PG8_SB(1, 1), cB + hstep + kstep, voffB);
        PG8_WAIT_V(6); PG8_BAR;
    }
    for (;;) {
        const bool has_next = S.next(ui + 1, nxt);
        const char* nA = has_next ? (const char*)g.A + (size_t)nxt.pm * tstep : cA; const char* nB = has_next ? (const char*)g.Bt + (size_t)nxt.pn * tstep : cB;
        for (int t = 0; t < nt; t += 2) {
            const bool last = (t == nt - 2);
            const char* a1 = cA + (size_t)(t + 1) * kstep;
            const char* a2 = last ? nA : cA + (size_t)(t + 2) * kstep; const char* b2 = last ? nB : cB + (size_t)(t + 2) * kstep;
            const char* a3 = a2 + kstep; const char* b3 = b2 + kstep;
            if (last && has_next) S.a_ready(nxt);
            if constexpr (SP2) {
            PG8_LDB(B0, 0, 0); PG8_LDB(B1, 0, 1); PG8_SCHED; PG8_LDA(At, 0, 0); PG8_STAGE(PG8_SA(1, 1), a1 + hstep, voffA);
            PG8_WAIT_V(8); PG8_WAIT_L(0); PG8_BAR; PG8_MMA(0, 0, At, B0); PG8_MMA(0, 1, At, B1); PG8_BAR; PG8_SCHED;
            PG8_LDA(At, 0, 1); PG8_STAGE(PG8_SB(0, 0), b2, voffB); PG8_STAGE(PG8_SB(0, 1), b2 + hstep, voffB); PG8_STAGE(PG8_SA(0, 0), a2, voffA);
            PG8_WAIT_V(8); PG8_WAIT_L(0); PG8_BAR; PG8_MMA(1, 0, At, B0); PG8_MMA(1, 1, At, B1); PG8_BAR; PG8_SCHED;
            PG8_LDB(B0, 1, 0); PG8_LDB(B1, 1, 1); PG8_SCHED; PG8_LDA(At, 1, 0); PG8_STAGE(PG8_SA(0, 1), a2 + hstep, voffA);
            PG8_WAIT_V(8); PG8_WAIT_L(0); PG8_BAR; PG8_MMA(0, 0, At, B0); PG8_MMA(0, 1, At, B1); PG8_BAR; PG8_SCHED;
            PG8_LDA(At, 1, 1); PG8_STAGE(PG8_SB(1, 0), b3, voffB); PG8_STAGE(PG8_SB(1, 1), b3 + hstep, voffB); PG8_STAGE(PG8_SA(1, 0), a3, voffA);
            PG8_WAIT_V(8); PG8_WAIT_L(0); PG8_BAR; PG8_MMA(1, 0, At, B0); PG8_MMA(1, 1, At, B1); PG8_BAR; PG8_SCHED;
            } else {
            PG8_LDB(B0, 0, 0); PG8_SCHED; PG8_LDA(At, 0, 0); PG8_STAGE(PG8_SA(1, 1), a1 + hstep, voffA);
            PG8_WAIT_L(8); PG8_BAR; PG8_WAIT_L(0); PG8_MMA(0, 0, At, B0); PG8_BAR; PG8_SCHED;
            PG8_LDB(B1, 0, 1); PG8_STAGE(PG8_SB(0, 0), b2, voffB);
            PG8_BAR; PG8_WAIT_L(0); PG8_MMA(0, 1, At, B1); PG8_BAR;
            PG8_LDA(At, 0, 1); PG8_STAGE(PG8_SA(0, 0), a2, voffA);
            PG8_BAR; PG8_WAIT_L(0); PG8_MMA(1, 0, At, B0); PG8_BAR; PG8_SCHED;
            PG8_STAGE(PG8_SB(0, 1), b2 + hstep, voffB);
            PG8_WAIT_V(6); PG8_BAR; PG8_MMA(1, 1, At, B1); PG8_BAR;
            PG8_LDB(B0, 1, 0); PG8_SCHED; PG8_LDA(At, 1, 0); PG8_STAGE(PG8_SA(0, 1), a2 + hstep, voffA);
            PG8_WAIT_L(8); PG8_BAR; PG8_WAIT_L(0); PG8_MMA(0, 0, At, B0); PG8_BAR; PG8_SCHED;
            PG8_LDB(B1, 1, 1); PG8_STAGE(PG8_SB(1, 0), b3, voffB);
            PG8_BAR; PG8_WAIT_L(0); PG8_MMA(0, 1, At, B1); PG8_BAR;
            PG8_LDA(At, 1, 1); PG8_STAGE(PG8_SA(1, 0), a3, voffA);
            PG8_BAR; PG8_WAIT_L(0); PG8_MMA(1, 0, At, B0); PG8_BAR; PG8_SCHED;
            PG8_STAGE(PG8_SB(1, 1), b3 + hstep, voffB);
            PG8_WAIT_V(6); PG8_BAR; PG8_MMA(1, 1, At, B1); PG8_BAR;
            }
        }
        if constexpr (ALIGN_EPI) { if (wr == 0) PG8_BAR; }
        if constexpr (!Epi::AFTER_DRAIN) { E(acc, cur, wr, wc, fr, fq); S.done(cur); }
        if (!has_next) break;
#pragma unroll
        for (int a = 0; a < 2; ++a)
#pragma unroll
            for (int b = 0; b < 2; ++b)
#pragma unroll
                for (int m = 0; m < 4; ++m)
#pragma unroll
                    for (int n = 0; n < 2; ++n) acc[a][b][m][n] = (f32x4){0.f, 0.f, 0.f, 0.f};
        cur = nxt; cA = nA; cB = nB; ++ui;
        if constexpr (ALIGN_EPI) { if (wr == 1) PG8_BAR; }
    }
    PG8_WAIT_V(0);
    if constexpr (!ALIGN_EPI) { if (wr == 0) PG8_BAR; }
    PG8_BAR;
    if constexpr (Epi::AFTER_DRAIN) { E.fused(acc, cur, wr, wc, fr, fq, lds, wid, lane); S.done(cur); }
#undef PG8_SA
#undef PG8_SB
#undef PG8_STAGE
#undef PG8_LDA
#undef PG8_LDB
#undef PG8_MMA
#undef PG8_WAIT_V
#undef PG8_WAIT_L
#undef PG8_BAR
#undef PG8_SCHED
}
}

#define GAS __attribute__((address_space(1)))
#define LAS __attribute__((address_space(3)))
typedef unsigned short bf16;
typedef unsigned v4u __attribute__((ext_vector_type(4)));
typedef unsigned v2u __attribute__((ext_vector_type(2)));
typedef float f32x4 __attribute__((ext_vector_type(4)));
typedef float f32x2 __attribute__((ext_vector_type(2)));
typedef short bf16x8 __attribute__((ext_vector_type(8)));
#define XB_TMO      128
#define XB_XCNT(j)  (256  + 64 * (j))
#define XB_XSUB(j)  (1280 + 64 * (j))
#define XB_XGEN(j)  (2304 + 64 * (j))
#define XB_TOP      3328
#define XB_TOPGEN   3392
#define XCD_BAR_WORDS 3456
#define XB_SPIN_CAP (1u << 18)

__device__ __forceinline__ unsigned xb_ld(unsigned* p)              { return __hip_atomic_load(p, __ATOMIC_RELAXED, __HIP_MEMORY_SCOPE_AGENT); }
__device__ __forceinline__ unsigned xb_add(unsigned* p, unsigned v) { return __hip_atomic_fetch_add(p, v, __ATOMIC_RELAXED, __HIP_MEMORY_SCOPE_AGENT); }
__device__ __forceinline__ unsigned xb_xcc_id() { return (unsigned)__builtin_amdgcn_s_getreg((3 << 11) | 20) & 0xFu; }
#define XB_SPIN(cond, bar) do { unsigned _sp = 0; while (cond) { __builtin_amdgcn_s_sleep(1); \
    if ((++_sp & 255u) == 0u) { if (xb_ld(&(bar)[XB_TMO])) break; if (_sp > XB_SPIN_CAP) { atomicAdd(&(bar)[XB_TMO], 1u); break; } } } } while (0)

struct XcdBarrier {
    unsigned* bar; unsigned x;
    volatile LAS unsigned* st;
};

__device__ __forceinline__ XcdBarrier xcd_barrier_post(unsigned* bar, volatile LAS unsigned* st) {
    XcdBarrier b; b.bar = bar; b.x = xb_xcc_id(); b.st = st;
    if (threadIdx.x == 0) (void)xb_add(&bar[XB_XCNT(b.x)], 1u);
    return b;
}
__device__ __forceinline__ void xcd_barrier_complete(unsigned* bar, unsigned x, unsigned& nloc, unsigned& nx) {
    const unsigned G = gridDim.x * gridDim.y * gridDim.z;
    unsigned sum, cnt, mine, sp = 0u;
    for (;;) {
        sum = 0u; cnt = 0u; mine = 0u;
#pragma unroll
        for (unsigned j = 0; j < 16; ++j) { const unsigned c = xb_ld(&bar[XB_XCNT(j)]); sum += c; cnt += (c > 0u) ? 1u : 0u; mine = (j == x) ? c : mine; }
        if (sum == G) break;
        __builtin_amdgcn_s_sleep(1);
        if ((++sp & 255u) == 0u) { if (xb_ld(&bar[XB_TMO])) break; if (sp > XB_SPIN_CAP) { atomicAdd(&bar[XB_TMO], 1u); break; } }
    }
    nloc = mine > 0u ? mine : 1u; nx = cnt > 0u ? cnt : 1u;
}

__device__ __forceinline__ void xcd_barrier(const XcdBarrier& b) {
    asm volatile("s_waitcnt vmcnt(0)" ::: "memory");
    __syncthreads();
    if (threadIdx.x == 0) {
        unsigned* bar = b.bar;
        __builtin_amdgcn_s_waitcnt(0);
        unsigned nloc = b.st[0], nx = b.st[1];
        if (nloc == 0u) { xcd_barrier_complete(bar, b.x, nloc, nx); b.st[0] = nloc; b.st[1] = nx; }
        const unsigned old = xb_add(&bar[XB_XSUB(b.x)], 1u);
        const unsigned gen = old / nloc;
        if (old + 1u == (gen + 1u) * nloc) {
            __builtin_amdgcn_fence(__ATOMIC_RELEASE, "agent");
            asm volatile("s_waitcnt vmcnt(0)" ::: "memory");
            const unsigned og = xb_add(&bar[XB_TOP], 1u);
            const unsigned tg = og / nx;
            if (og + 1u == (tg + 1u) * nx) xb_add(&bar[XB_TOPGEN], 1u);
            else XB_SPIN(xb_ld(&bar[XB_TOPGEN]) == tg, bar);
            __builtin_amdgcn_fence(__ATOMIC_ACQUIRE, "agent");
            xb_add(&bar[XB_XGEN(b.x)], 1u);
            asm volatile("s_waitcnt vmcnt(0)" ::: "memory");
        } else {
            XB_SPIN(xb_ld(&bar[XB_XGEN(b.x)]) == gen, bar);
            __builtin_amdgcn_fence(__ATOMIC_ACQUIRE, "agent");
            asm volatile("s_waitcnt vmcnt(0)" ::: "memory");
        }
    }
    __syncthreads();
}

constexpr int MP = 8192, MS = 128, MT = MP + MS, D = 2048, NIN = 6144, NUP = 11264, DFF = 5632, PLE = 256, SEQ = 2048, NH = 8;
constexpr float EPS = 1e-6f;
constexpr int NPHASE = 10;
constexpr size_t MiB = 1u << 20;
constexpr size_t WS_BAR = 0, BAR_BYTES = 16384;
constexpr size_t WS_SS1 = 64 * 1024, WS_SS2 = 128 * 1024, WS_SS3 = 192 * 1024, WS_STATS = 256 * 1024;
constexpr size_t WS_RINV = 384 * 1024;
constexpr size_t WS_ROPE = 1 * MiB, WS_ROPES = 2 * MiB;
constexpr size_t WS_WIN = 4 * MiB, WS_WO = 28 * MiB, WS_WUP = 36 * MiB, WS_WDN = 80 * MiB, WS_WG = 102 * MiB, WS_WP = 110 * MiB;
constexpr size_t WS_AB = 112 * MiB, WS_PB = 145 * MiB, WS_MIX = 150 * MiB, WS_Z = 183 * MiB, WS_ACT = 183 * MiB, WS_KV = 281 * MiB, WS_PP = 281 * MiB;
constexpr size_t WS_RAW = 314 * MiB, WS_AS = 336 * MiB, WS_END = 346 * MiB;
static_assert(WS_AB + (size_t)MT * D * 2 <= WS_PB && WS_PB + (size_t)MT * PLE * 2 <= WS_MIX && WS_MIX + (size_t)MT * D * 2 <= WS_Z, "ws map 1");
static_assert(WS_Z + (size_t)MT * NIN * 2 <= WS_KV && WS_ACT + (size_t)MT * DFF * 2 <= WS_KV && WS_KV + (size_t)512 * 16384 * 4 <= WS_RAW, "ws map 2");
static_assert(WS_RAW + (size_t)128 * 4 * NUP * 4 <= WS_AS && WS_AS + (size_t)MS * NUP * 4 <= WS_END && WS_PP + (size_t)MT * D * 2 <= WS_RAW, "ws map 3");
constexpr size_t O_RETP = 17039360, O_CONVP = 17563648, O_RETS = 17653760, O_CONVS = 34430976, O_GMV = 37314560, O_END = 37445632;
constexpr int LDS_BYTES = 147456, MISC_OFF = LDS_BYTES - 256;
constexpr int LDP = 136;
constexpr int TILE_B = 128 * LDP * 2;

struct Params { const float* in[22]; float* out; unsigned char* ws; float log2g[8]; float invf[64]; int ph_lo, ph_hi, use_cg, pad; };

#define LDS_WAIT() asm volatile("s_waitcnt lgkmcnt(0)" ::: "memory")
__device__ __forceinline__ float lo16(unsigned u) { return __uint_as_float(u << 16); }
__device__ __forceinline__ float hi16(unsigned u) { return __uint_as_float(u & 0xffff0000u); }
__device__ __forceinline__ float bf2f(bf16 b) { return __uint_as_float((unsigned)b << 16); }
__device__ __forceinline__ unsigned pk2(float lo, float hi) { return pg8::cvt_pk_bf16(lo, hi); }
__device__ __forceinline__ bf16 f2bf(float f) { return (bf16)(pg8::cvt_pk_bf16(f, 0.f) & 0xffffu); }
__device__ __forceinline__ float sigmoid_(float x) { return __builtin_amdgcn_rcpf(1.0f + __builtin_amdgcn_exp2f(-1.44269504089f * x)); }
__device__ __forceinline__ float silu_(float x) { return x * sigmoid_(x); }
__device__ __forceinline__ float gelu_(float x) { return x * sigmoid_(1.5957691216f * (x + 0.044715f * x * x * x)); }
__device__ __forceinline__ float wave_sum(float v) {
#pragma unroll
    for (int o = 1; o < 64; o <<= 1) v += __shfl_xor(v, o);
    return v;
}
__device__ __forceinline__ void atomic_addf(float* p, float v) { (void)__hip_atomic_fetch_add(p, v, __ATOMIC_RELAXED, __HIP_MEMORY_SCOPE_AGENT); }
template <int CTRL> __device__ __forceinline__ float dppf(float x) { return __int_as_float(__builtin_amdgcn_mov_dpp(__float_as_int(x), CTRL, 0xf, 0xf, false)); }

using pg8::Unit;
struct EpiZ {
    static constexpr bool PERM = true, AFTER_DRAIN = false;
    bf16* Z;
    __device__ __forceinline__ void operator()(const f32x4 (&acc)[2][2][4][2], const Unit& u, int wr, int wc, int fr, int fq) const {
        const int row0 = u.pm * 256 + wr * 64 + fr, col0 = u.pn * 256 + wc * 32 + 8 * fq;
        const int mode = u.pn < 12 ? 0 : (u.pn < 16 ? 1 : 2);
#pragma unroll
        for (int ai = 0; ai < 2; ++ai)
#pragma unroll
            for (int m = 0; m < 4; ++m) { bf16* rowp = Z + (size_t)(row0 + ai * 128 + m * 16) * NIN + col0;
#pragma unroll
                for (int bj = 0; bj < 2; ++bj) { f32x4 v0 = acc[ai][bj][m][0], v1 = acc[ai][bj][m][1];
                    if (mode == 1) {
#pragma unroll
                        for (int j = 0; j < 4; ++j) { v0[j] = silu_(v0[j]); v1[j] = silu_(v1[j]); } }
                    else if (mode == 2) {
#pragma unroll
                        for (int j = 0; j < 4; ++j) { v0[j] = gelu_(v0[j]); v1[j] = gelu_(v1[j]); } }
                    v4u w; w.x = pk2(v0[0], v0[1]); w.y = pk2(v0[2], v0[3]); w.z = pk2(v1[0], v1[1]); w.w = pk2(v1[2], v1[3]);
                    *(v4u*)(rowp + bj * 128) = w; } }
    }
};
template <int BASE_BF16> struct EpiRes {
    const float* rowscale;
    static constexpr bool PERM = true, AFTER_DRAIN = false;
    const float* base; bf16* hb; float* ss;
    __device__ __forceinline__ void operator()(const f32x4 (&acc)[2][2][4][2], const Unit& u, int wr, int wc, int fr, int fq) const {
        const int row0 = u.pm * 256 + wr * 64 + fr, col0 = u.pn * 256 + wc * 32 + 8 * fq;
        float sacc[2][4];
#pragma unroll
        for (int ai = 0; ai < 2; ++ai) {
            f32x4 bs[BASE_BF16 ? 1 : 4][2][2]; v4u bw[4][2]; float rsc[4];
#pragma unroll
            for (int m = 0; m < 4; ++m) { rsc[m] = BASE_BF16 == 2 ? rowscale[row0 + ai * 128 + m * 16] : 1.0f;
#pragma unroll
                for (int bj = 0; bj < 2; ++bj) { const size_t o_ = (size_t)(row0 + ai * 128 + m * 16) * D + col0 + bj * 128;
                    if (BASE_BF16) bw[m][bj] = *(const v4u*)(hb + o_);
                    else { bs[m][bj][0] = *(const f32x4*)(base + o_); bs[m][bj][1] = *(const f32x4*)(base + o_ + 4); } } }
#pragma unroll
            for (int m = 0; m < 4; ++m) { const size_t off = (size_t)(row0 + ai * 128 + m * 16) * D + col0; float s = 0.f;
#pragma unroll
                for (int bj = 0; bj < 2; ++bj) { f32x4 b0, b1;
                    if (BASE_BF16) { const v4u w = bw[m][bj]; b0 = (f32x4){lo16(w.x), hi16(w.x), lo16(w.y), hi16(w.y)}; b1 = (f32x4){lo16(w.z), hi16(w.z), lo16(w.w), hi16(w.w)};
                        if (BASE_BF16 == 2) { b0 *= rsc[m]; b1 *= rsc[m]; } }
                    else { b0 = bs[m][bj][0]; b1 = bs[m][bj][1]; }
                    const f32x4 o0 = b0 + acc[ai][bj][m][0], o1 = b1 + acc[ai][bj][m][1];
                    v4u w; w.x = pk2(o0[0], o0[1]); w.y = pk2(o0[2], o0[3]); w.z = pk2(o1[0], o1[1]); w.w = pk2(o1[2], o1[3]); *(v4u*)(hb + off + bj * 128) = w;
                    s += ((o0[0] * o0[0] + o0[1] * o0[1]) + (o0[2] * o0[2] + o0[3] * o0[3])) + ((o1[0] * o1[0] + o1[1] * o1[1]) + (o1[2] * o1[2] + o1[3] * o1[3])); }
                s += __shfl_xor(s, 16); s += __shfl_xor(s, 32); sacc[ai][m] = s; }
            asm volatile("" ::: "memory"); }
        if (fq == 0) {
#pragma unroll
            for (int ai = 0; ai < 2; ++ai)
#pragma unroll
                for (int m = 0; m < 4; ++m) atomic_addf(ss + row0 + ai * 128 + m * 16, sacc[ai][m]); }
    }
};
struct EpiPP {
    static constexpr bool PERM = true, AFTER_DRAIN = false;
    bf16* pp;
    __device__ __forceinline__ void operator()(const f32x4 (&acc)[2][2][4][2], const Unit& u, int wr, int wc, int fr, int fq) const {
        const int row0 = u.pm * 256 + wr * 64 + fr, col0 = u.pn * 256 + wc * 32 + 8 * fq;
#pragma unroll
        for (int ai = 0; ai < 2; ++ai)
#pragma unroll
            for (int m = 0; m < 4; ++m) { if (row0 + ai * 128 + m * 16 >= MT) continue; bf16* rowp = pp + (size_t)(row0 + ai * 128 + m * 16) * D + col0;
#pragma unroll
                for (int bj = 0; bj < 2; ++bj) { const f32x4 v0 = acc[ai][bj][m][0], v1 = acc[ai][bj][m][1]; v4u w; w.x = pk2(v0[0], v0[1]); w.y = pk2(v0[2], v0[3]); w.z = pk2(v1[0], v1[1]); w.w = pk2(v1[2], v1[3]); *(v4u*)(rowp + bj * 128) = w; } }
    }
};
struct EpiGate {
    static constexpr bool PERM = true, AFTER_DRAIN = false;
    const bf16* pp; const bf16* hb; float* h; const float* ss2; float* ss3;
    __device__ __forceinline__ void operator()(const f32x4 (&acc)[2][2][4][2], const Unit& u, int wr, int wc, int fr, int fq) const {
        const int row0 = u.pm * 256 + wr * 64 + fr, col0 = u.pn * 256 + wc * 32 + 8 * fq;
        float sacc[2][4];
#pragma unroll
        for (int ai = 0; ai < 2; ++ai) {
            v4u hw[4][2], pw[4][2]; float r2[4];
#pragma unroll
            for (int m = 0; m < 4; ++m) { const int row = row0 + ai * 128 + m * 16; r2[m] = ss2[row];
#pragma unroll
                for (int bj = 0; bj < 2; ++bj) { hw[m][bj] = *(const v4u*)(hb + (size_t)row * D + col0 + bj * 128); pw[m][bj] = *(const v4u*)(pp + (size_t)row * D + col0 + bj * 128); } }
#pragma unroll
            for (int m = 0; m < 4; ++m) { const size_t off = (size_t)(row0 + ai * 128 + m * 16) * D + col0; float s = 0.f;
                const float rr = __builtin_amdgcn_rsqf(r2[m] * (1.0f / D) + EPS);
#pragma unroll
                for (int bj = 0; bj < 2; ++bj) { const v4u h4 = hw[m][bj], p4 = pw[m][bj];
                    const f32x4 hv0 = {lo16(h4.x), hi16(h4.x), lo16(h4.y), hi16(h4.y)}, hv1 = {lo16(h4.z), hi16(h4.z), lo16(h4.w), hi16(h4.w)};
                    const f32x4 pv0 = {lo16(p4.x), hi16(p4.x), lo16(p4.y), hi16(p4.y)}, pv1 = {lo16(p4.z), hi16(p4.z), lo16(p4.w), hi16(p4.w)};
                    const f32x4 a0 = acc[ai][bj][m][0], a1 = acc[ai][bj][m][1]; f32x4 o0, o1;
#pragma unroll
                    for (int j = 0; j < 4; ++j) { o0[j] = hv0[j] + pv0[j] * sigmoid_(rr * a0[j]); o1[j] = hv1[j] + pv1[j] * sigmoid_(rr * a1[j]); }
                    *(f32x4*)(h + off + bj * 128) = o0; *(f32x4*)(h + off + bj * 128 + 4) = o1;
                    s += ((o0[0] * o0[0] + o0[1] * o0[1]) + (o0[2] * o0[2] + o0[3] * o0[3])) + ((o1[0] * o1[0] + o1[1] * o1[1]) + (o1[2] * o1[2] + o1[3] * o1[3])); }
                s += __shfl_xor(s, 16); s += __shfl_xor(s, 32); sacc[ai][m] = s; }
            asm volatile("" ::: "memory"); }
        if (fq == 0) {
#pragma unroll
            for (int ai = 0; ai < 2; ++ai)
#pragma unroll
                for (int m = 0; m < 4; ++m) atomic_addf(ss3 + row0 + ai * 128 + m * 16, sacc[ai][m]); }
    }
};
struct EpiUp {
    static constexpr bool PERM = true, AFTER_DRAIN = false;
    bf16* act; float* raw; const float* ss1; const float* cw; const float* cb; LAS float* wl;
    __device__ __forceinline__ void operator()(const f32x4 (&acc)[2][2][4][2], const Unit& u, int wr, int wc, int fr, int fq) const {
        const int row0 = u.pm * 256 + wr * 64 + fr;
        LAS float* wb = wl + (wr * 4 + wc) * 256;
        { const int l = fq * 16 + fr, v = l >> 3, c4 = l & 7;
          const float* src = ((v & 3) == 3 ? cb : cw + (v & 3) * NUP) + (v >> 2) * DFF + u.pn * 128 + wc * 32 + 4 * c4;
          *(LAS f32x4*)(wb + v * 32 + 4 * c4) = *(const f32x4*)src; }
        float rs[2][4];
#pragma unroll
        for (int ai = 0; ai < 2; ++ai)
#pragma unroll
            for (int m = 0; m < 4; ++m) rs[ai][m] = __builtin_amdgcn_rsqf(ss1[row0 + ai * 128 + m * 16] * (1.0f / D) + EPS);
        const int cg0 = u.pn * 128 + wc * 32 + 8 * fq;
        const volatile LAS f32x4* wv = (const volatile LAS f32x4*)(wb + 8 * fq);
#pragma unroll
        for (int ai = 0; ai < 2; ++ai) {
            f32x4 l1g[2], l2g[2], l1u[2], l2u[2];
#pragma unroll
            for (int n = 0; n < 2; ++n) { l1g[n] = (f32x4){0.f, 0.f, 0.f, 0.f}; l2g[n] = l1g[n]; l1u[n] = l1g[n]; l2u[n] = l1g[n]; }
#pragma unroll
            for (int m = 0; m < 4; ++m) {
                const int row = row0 + ai * 128 + m * 16;
                v4u wo;
#pragma unroll
                for (int n = 0; n < 2; ++n) {
                    const int cg_ = cg0 + 4 * n;
                    f32x4 sg;
                    { const f32x4 g = acc[ai][0][m][n] * rs[ai][m];
                      if (m == 0 && fr < 2) *(f32x4*)(raw + ((size_t)(row >> 6) * 4 + 2 + fr) * NUP + cg_) = g;
                      if (m == 3 && fr >= 14) *(f32x4*)(raw + ((size_t)(row >> 6) * 4 + (fr - 14)) * NUP + cg_) = g;
                      f32x4 r1, r2, x1, x2;
#pragma unroll
                      for (int j = 0; j < 4; ++j) { r1[j] = dppf<0x121>(g[j]); r2[j] = dppf<0x122>(g[j]); }
#pragma unroll
                      for (int j = 0; j < 4; ++j) { x1[j] = fr == 0 ? l1g[n][j] : r1[j]; x2[j] = fr < 2 ? l2g[n][j] : r2[j]; }
                      l1g[n] = r1; l2g[n] = r2;
                      const f32x4 w0 = wv[n], w1 = wv[8 + n], w2 = wv[16 + n], bb = wv[24 + n];
                      const f32x4 ag = w0 * x2 + w1 * x1 + w2 * g + bb;
#pragma unroll
                      for (int j = 0; j < 4; ++j) sg[j] = silu_(ag[j]);
                      asm volatile("" : "+v"(sg)); }
                    f32x4 o;
                    { const f32x4 up = acc[ai][1][m][n] * rs[ai][m];
                      if (m == 0 && fr < 2) *(f32x4*)(raw + ((size_t)(row >> 6) * 4 + 2 + fr) * NUP + DFF + cg_) = up;
                      if (m == 3 && fr >= 14) *(f32x4*)(raw + ((size_t)(row >> 6) * 4 + (fr - 14)) * NUP + DFF + cg_) = up;
                      f32x4 r1, r2, x1, x2;
#pragma unroll
                      for (int j = 0; j < 4; ++j) { r1[j] = dppf<0x121>(up[j]); r2[j] = dppf<0x122>(up[j]); }
#pragma unroll
                      for (int j = 0; j < 4; ++j) { x1[j] = fr == 0 ? l1u[n][j] : r1[j]; x2[j] = fr < 2 ? l2u[n][j] : r2[j]; }
                      l1u[n] = r1; l2u[n] = r2;
                      const f32x4 w0 = wv[32 + n], w1 = wv[40 + n], w2 = wv[48 + n], bb = wv[56 + n];
                      o = (w0 * x2 + w1 * x1 + w2 * up + bb) * sg; }
                    wo[2 * n] = pk2(o[0], o[1]); wo[2 * n + 1] = pk2(o[2], o[3]); }
                *(v4u*)(act + (size_t)row * DFF + cg0) = wo; } }
    }
};

struct EpiAS {
    static constexpr bool PERM = false, AFTER_DRAIN = false;
    float* as; const float* ss1;
    __device__ __forceinline__ void operator()(const f32x4 (&acc)[2][2][4][2], const Unit& u, int wr, int wc, int fr, int fq) const {
#pragma unroll
        for (int m = 0; m < 4; ++m) { const int s_ = wr * 64 + m * 16 + fr; const float r = __builtin_amdgcn_rsqf(ss1[MP + s_] * (1.0f / D) + EPS);
#pragma unroll
            for (int n = 0; n < 2; ++n) { const int cg_ = u.pn * 128 + wc * 32 + 16 * n + 4 * fq;
                *(f32x4*)(as + (size_t)s_ * NUP + cg_) = acc[0][0][m][n] * r; *(f32x4*)(as + (size_t)s_ * NUP + DFF + cg_) = acc[0][1][m][n] * r; } }
    }
};
struct SampleOrder {
    int idx;
    __device__ __forceinline__ bool next(int i, Unit& u) const { if (i != 0 || idx < 0) return false; u.pm = MP / 256; u.pn = idx; return true; }
    __device__ __forceinline__ void a_ready(const Unit&) const {}
    __device__ __forceinline__ void done(const Unit&) const {}
};

struct ProjOrder {
    int first, nw;
    __device__ __forceinline__ bool next(int i, Unit& u) const { if (first < 0) return false; const int j = first + i * nw; if (j >= (MP / 256 + 1) * (D / 256)) return false; u.pm = j >> 3; u.pn = j & 7; return true; }
    __device__ __forceinline__ void a_ready(const Unit&) const {}
    __device__ __forceinline__ void done(const Unit&) const {}
};
struct EpiResS {
    static constexpr bool PERM = true, AFTER_DRAIN = false;
    const float* xs; bf16* hb; float* ss;
    __device__ __forceinline__ void operator()(const f32x4 (&acc)[2][2][4][2], const Unit& u, int wr, int wc, int fr, int fq) const {
        const int col0 = u.pn * 256 + wc * 32 + 8 * fq;
#pragma unroll
        for (int m = 0; m < 4; ++m) { const int s_ = wr * 64 + m * 16 + fr; float s = 0.f;
#pragma unroll
            for (int bj = 0; bj < 2; ++bj) { const size_t o_ = (size_t)s_ * D + col0 + bj * 128;
                const f32x4 o0 = *(const f32x4*)(xs + o_) + acc[0][bj][m][0], o1 = *(const f32x4*)(xs + o_ + 4) + acc[0][bj][m][1];
                v4u w; w.x = pk2(o0[0], o0[1]); w.y = pk2(o0[2], o0[3]); w.z = pk2(o1[0], o1[1]); w.w = pk2(o1[2], o1[3]); *(v4u*)(hb + o_) = w;
                s += ((o0[0] * o0[0] + o0[1] * o0[1]) + (o0[2] * o0[2] + o0[3] * o0[3])) + ((o1[0] * o1[0] + o1[1] * o1[1]) + (o1[2] * o1[2] + o1[3] * o1[3])); }
            s += __shfl_xor(s, 16); s += __shfl_xor(s, 32);
            if (fq == 0) atomic_addf(ss + s_, s); }
    }
};
template <int RT, int NK>
__device__ __forceinline__ void skinny_batch(f32x4 (&acc)[RT][2], const bf16* ap, const bf16* bp, int K) {
    bf16x8 bq[NK][2], aq[NK][RT];
#pragma unroll
    for (int kk = 0; kk < NK; ++kk) { bq[kk][0] = *(const bf16x8*)(bp + 32 * kk); bq[kk][1] = *(const bf16x8*)(bp + (size_t)16 * K + 32 * kk);
#pragma unroll
        for (int rt = 0; rt < RT; ++rt) aq[kk][rt] = *(const bf16x8*)(ap + (size_t)rt * 16 * K + 32 * kk); }
#pragma unroll
    for (int kk = 0; kk < NK; ++kk)
#pragma unroll
        for (int rt = 0; rt < RT; ++rt) { acc[rt][0] = __builtin_amdgcn_mfma_f32_16x16x32_bf16(bq[kk][0], aq[kk][rt], acc[rt][0], 0, 0, 0); acc[rt][1] = __builtin_amdgcn_mfma_f32_16x16x32_bf16(bq[kk][1], aq[kk][rt], acc[rt][1], 0, 0, 0); }
}
template <int RT, class F>
__device__ __forceinline__ void skinny_gemm(LAS unsigned char* lds, const bf16* A, const bf16* Bt, int N, int K, int u0, int ustride, const F& f) {
    const int tid = threadIdx.x, lane = tid & 63, w = tid >> 6, fr = lane & 15, fq = lane >> 4;
    constexpr int nrb = 8 / RT, ROWS = 16 * RT;
    const int nunits = nrb * (N / 32), kw = K / 8;
    LAS float* red = (LAS float*)lds;
    for (int u = u0; u < nunits; u += ustride) {
        const int rb = u % nrb, cb = u / nrb, row0 = rb * ROWS, col0 = cb * 32;
        f32x4 acc[RT][2];
#pragma unroll
        for (int rt = 0; rt < RT; ++rt) { acc[rt][0] = (f32x4){0.f, 0.f, 0.f, 0.f}; acc[rt][1] = (f32x4){0.f, 0.f, 0.f, 0.f}; }
        const bf16* ap = A + (size_t)(row0 + fr) * K + w * kw + 8 * fq;
        const bf16* bp = Bt + (size_t)(col0 + fr) * K + w * kw + 8 * fq;
        if constexpr (RT <= 2) {
            int k = 0;
            if (kw == 704) { skinny_batch<RT, 11>(acc, ap, bp, K); skinny_batch<RT, 11>(acc, ap + 352, bp + 352, K); k = 704; }
            for (; k + 256 <= kw; k += 256) skinny_batch<RT, 8>(acc, ap + k, bp + k, K);
            for (; k < kw; k += 32) skinny_batch<RT, 1>(acc, ap + k, bp + k, K);
        } else {
#pragma unroll 2
        for (int k = 0; k < kw; k += 32) {
            const bf16x8 b0 = *(const bf16x8*)(bp + k), b1 = *(const bf16x8*)(bp + (size_t)16 * K + k);
#pragma unroll
            for (int rt = 0; rt < RT; ++rt) { const bf16x8 av = *(const bf16x8*)(ap + (size_t)rt * 16 * K + k);
                acc[rt][0] = __builtin_amdgcn_mfma_f32_16x16x32_bf16(b0, av, acc[rt][0], 0, 0, 0);
                acc[rt][1] = __builtin_amdgcn_mfma_f32_16x16x32_bf16(b1, av, acc[rt][1], 0, 0, 0); }
        }
        }
#pragma unroll
        for (int rt = 0; rt < RT; ++rt)
#pragma unroll
            for (int ct = 0; ct < 2; ++ct) *(LAS f32x4*)(red + (w * ROWS + 16 * rt + fr) * 32 + 16 * ct + 4 * fq) = acc[rt][ct];
        __syncthreads();
#pragma unroll
        for (int it = 0; it < RT; ++it) { const int e = tid + 512 * it, r = e >> 5, c = e & 31; float v = 0.f;
#pragma unroll
            for (int ww = 0; ww < 8; ++ww) v += red[(ww * ROWS + r) * 32 + c];
            f(row0 + r, col0 + c, v); }
        __syncthreads();
    }
}
__device__ __forceinline__ float half_wave_sum(float v) {
#pragma unroll
    for (int o = 1; o < 32; o <<= 1) v += __shfl_xor(v, o);
    return v;
}

__device__ __forceinline__ void transpose_item(const float* W, int K, int N, const float* g, bf16* WT, bool upmap, LAS float* scr, int item, int lane) {
    const int nblk = N / 64, kb = item / nblk, nb = item % nblk, k0 = 64 * kb, n0 = 64 * nb;
    const float* src = W + (size_t)k0 * N + n0 + lane;
#pragma unroll
    for (int h = 0; h < 2; ++h) {
        float v[32];
#pragma unroll
        for (int i = 0; i < 32; ++i) v[i] = __builtin_nontemporal_load(src + (size_t)(32 * h + i) * N);
#pragma unroll
        for (int i = 0; i < 32; ++i) { float x = v[i]; if (g) x *= g[k0 + 32 * h + i]; scr[(32 * h + i) * 65 + lane] = x; }
    }
    LDS_WAIT(); asm volatile("" ::: "memory");
    const int c = lane & 7;
#pragma unroll
    for (int j = 0; j < 8; ++j) { const int n = (lane >> 3) + 8 * j; const LAS float* s = scr + (8 * c) * 65 + n;
        v4u o; o.x = pk2(s[0 * 65], s[1 * 65]); o.y = pk2(s[2 * 65], s[3 * 65]); o.z = pk2(s[4 * 65], s[5 * 65]); o.w = pk2(s[6 * 65], s[7 * 65]);
        int R = n0 + n; if (upmap) { const int half = R >= DFF ? 1 : 0, jj = R - half * DFF; R = 256 * (jj >> 7) + 128 * half + (jj & 127); }
        *(v4u*)(WT + (size_t)R * K + k0 + 8 * c) = o; }
    LDS_WAIT(); asm volatile("" ::: "memory");
}
__device__ __forceinline__ void rms_row_to_bf16(const float* xrow, bf16* orow, float* rinv, int lane) {
    const f32x4* xr = (const f32x4*)xrow + lane;
    f32x4 v[8]; float s = 0.f;
#pragma unroll
    for (int j = 0; j < 8; ++j) { v[j] = __builtin_nontemporal_load(xr + 64 * j);
 s += (v[j][0] * v[j][0] + v[j][1] * v[j][1]) + (v[j][2] * v[j][2] + v[j][3] * v[j][3]); }
    const float ms = wave_sum(s) * (1.0f / D) + EPS, r = __builtin_amdgcn_rsqf(ms);
    if (lane == 0) *rinv = __builtin_sqrtf(ms);
    v2u* o8 = (v2u*)orow + lane;
#pragma unroll
    for (int j = 0; j < 8; ++j) { v2u w; w.x = pk2(v[j][0] * r, v[j][1] * r); w.y = pk2(v[j][2] * r, v[j][3] * r); o8[64 * j] = w; }
}

__device__ __forceinline__ void mm128(f32x4 (&acc)[8], const LAS bf16* A, const LAS bf16* B, int wave, int fr, int fq) {
#pragma unroll
    for (int ks = 0; ks < 4; ++ks) {
        const bf16x8 a = *(const LAS bf16x8*)(A + (16 * wave + fr) * LDP + 32 * ks + 8 * fq);
#pragma unroll
        for (int ct = 0; ct < 8; ++ct) { const bf16x8 b = *(const LAS bf16x8*)(B + (16 * ct + fr) * LDP + 32 * ks + 8 * fq);
            acc[ct] = __builtin_amdgcn_mfma_f32_16x16x32_bf16(b, a, acc[ct], 0, 0, 0); }
    }
}
template <bool TRANS, bool DEC>
__device__ __forceinline__ void stage_rope(LAS bf16* dst, const bf16* zb, const float* rope, float scale, float l2g, int tid) {
#pragma unroll
    for (int it = 0; it < 2; ++it) { const int idx = tid + 512 * it, j = idx >> 3, d8 = idx & 7;
        const v4u x1 = *(const v4u*)(zb + (size_t)j * NIN + 8 * d8), x2 = *(const v4u*)(zb + (size_t)j * NIN + 64 + 8 * d8);
        const f32x4* rp = (const f32x4*)(rope + (size_t)(j * 64 + 8 * d8) * 2);
        float sc = scale; if (DEC) sc *= __builtin_amdgcn_exp2f(l2g * (float)(127 - j));
        float o1[8], o2[8];
#pragma unroll
        for (int p = 0; p < 4; ++p) { const f32x4 cs = rp[p]; const float a0 = lo16(x1[p]), a1 = hi16(x1[p]), b0 = lo16(x2[p]), b1 = hi16(x2[p]);
            o1[2 * p] = (a0 * cs[0] - b0 * cs[1]) * sc; o2[2 * p] = (b0 * cs[0] + a0 * cs[1]) * sc;
            o1[2 * p + 1] = (a1 * cs[2] - b1 * cs[3]) * sc; o2[2 * p + 1] = (b1 * cs[2] + a1 * cs[3]) * sc; }
        if (!TRANS) { v4u w1, w2;
#pragma unroll
            for (int p = 0; p < 4; ++p) { w1[p] = pk2(o1[2 * p], o1[2 * p + 1]); w2[p] = pk2(o2[2 * p], o2[2 * p + 1]); }
            *(LAS v4u*)(dst + j * LDP + 8 * d8) = w1; *(LAS v4u*)(dst + j * LDP + 64 + 8 * d8) = w2; }
        else {
#pragma unroll
            for (int i = 0; i < 8; ++i) { dst[(8 * d8 + i) * LDP + j] = f2bf(o1[i]); dst[(64 + 8 * d8 + i) * LDP + j] = f2bf(o2[i]); } }
    }
}
__device__ __forceinline__ void stage_T(LAS bf16* dst, const bf16* zb, int tid) {
#pragma unroll
    for (int it = 0; it < 4; ++it) { const int idx = tid + 512 * it, j = idx >> 4, c8 = idx & 15;
        const v4u x = *(const v4u*)(zb + (size_t)j * NIN + 8 * c8);
#pragma unroll
        for (int p = 0; p < 4; ++p) { dst[(8 * c8 + 2 * p) * LDP + j] = (bf16)(x[p] & 0xffffu); dst[(8 * c8 + 2 * p + 1) * LDP + j] = (bf16)(x[p] >> 16); } }
}


struct RopeX { v4u x1[2], x2[2]; };
struct RopeCS { f32x4 cs[2][4]; };
struct TileX { v4u x[4]; };
template <bool NT = false> __device__ __forceinline__ void rope_load(RopeX& r, const bf16* zb, int tid) {
#pragma unroll
    for (int it = 0; it < 2; ++it) { const int idx = tid + 512 * it, j = idx >> 3, d8 = idx & 7; const v4u* p1 = (const v4u*)(zb + (size_t)j * NIN + 8 * d8); const v4u* p2 = (const v4u*)(zb + (size_t)j * NIN + 64 + 8 * d8);
        r.x1[it] = NT ? __builtin_nontemporal_load(p1) : *p1; r.x2[it] = NT ? __builtin_nontemporal_load(p2) : *p2; }
}
__device__ __forceinline__ void rope_cs_load(RopeCS& c, const float* rope, int tid) {
#pragma unroll
    for (int it = 0; it < 2; ++it) { const int idx = tid + 512 * it, j = idx >> 3, d8 = idx & 7; const f32x4* rp = (const f32x4*)(rope + (size_t)(j * 64 + 8 * d8) * 2);
#pragma unroll
        for (int p = 0; p < 4; ++p) c.cs[it][p] = rp[p]; }
}
template <bool TRANS, bool DEC>
__device__ __forceinline__ void rope_commit(LAS bf16* dst, const RopeX& r, const RopeCS& c, float scale, float l2g, int tid) {
#pragma unroll
    for (int it = 0; it < 2; ++it) { const int idx = tid + 512 * it, j = idx >> 3, d8 = idx & 7;
        float sc = scale; if (DEC) sc *= __builtin_amdgcn_exp2f(l2g * (float)(127 - j));
        float o1[8], o2[8];
#pragma unroll
        for (int p = 0; p < 4; ++p) { const f32x4 cs = c.cs[it][p]; const float a0 = lo16(r.x1[it][p]), a1 = hi16(r.x1[it][p]), b0 = lo16(r.x2[it][p]), b1 = hi16(r.x2[it][p]);
            o1[2 * p] = (a0 * cs[0] - b0 * cs[1]) * sc; o2[2 * p] = (b0 * cs[0] + a0 * cs[1]) * sc;
            o1[2 * p + 1] = (a1 * cs[2] - b1 * cs[3]) * sc; o2[2 * p + 1] = (b1 * cs[2] + a1 * cs[3]) * sc; }
        if (!TRANS) { v4u w1, w2;
#pragma unroll
            for (int p = 0; p < 4; ++p) { w1[p] = pk2(o1[2 * p], o1[2 * p + 1]); w2[p] = pk2(o2[2 * p], o2[2 * p + 1]); }
            *(LAS v4u*)(dst + j * LDP + 8 * d8) = w1; *(LAS v4u*)(dst + j * LDP + 64 + 8 * d8) = w2; }
        else {
#pragma unroll
            for (int i = 0; i < 8; ++i) { dst[(8 * d8 + i) * LDP + j] = f2bf(o1[i]); dst[(64 + 8 * d8 + i) * LDP + j] = f2bf(o2[i]); } }
    }
}
template <bool NT = false> __device__ __forceinline__ void tile_load(TileX& t, const bf16* zb, int tid) {
#pragma unroll
    for (int it = 0; it < 4; ++it) { const int idx = tid + 512 * it, j = idx >> 4, c8 = idx & 15; const v4u* p = (const v4u*)(zb + (size_t)j * NIN + 8 * c8); t.x[it] = NT ? __builtin_nontemporal_load(p) : *p; }
}
__device__ __forceinline__ void tile_commit_T(LAS bf16* dst, const TileX& t, int tid) {
#pragma unroll
    for (int it = 0; it < 4; ++it) { const int idx = tid + 512 * it, j = idx >> 4, c8 = idx & 15;
#pragma unroll
        for (int p = 0; p < 4; ++p) { dst[(8 * c8 + 2 * p) * LDP + j] = (bf16)(t.x[it][p] & 0xffffu); dst[(8 * c8 + 2 * p + 1) * LDP + j] = (bf16)(t.x[it][p] >> 16); } }
}

typedef short s16x4 __attribute__((ext_vector_type(4)));
__device__ __forceinline__ bf16x8 tr_frag(const LAS bf16* T, int c, int ks, int lane) {
    const int g = lane >> 4, q = (lane & 15) >> 2, p = lane & 3;
    const LAS bf16* a0 = T + (32 * ks + 8 * g + q) * LDP + 16 * c + 4 * p;
    const s16x4 lo = __builtin_amdgcn_ds_read_tr16_b64_v4i16((LAS s16x4*)a0), hi = __builtin_amdgcn_ds_read_tr16_b64_v4i16((LAS s16x4*)(a0 + 4 * LDP));
    return (bf16x8){lo[0], lo[1], lo[2], lo[3], hi[0], hi[1], hi[2], hi[3]};
}
__device__ __forceinline__ void mm128_nt(f32x4 (&acc)[8], const LAS bf16* A, const LAS bf16* B, int wave, int lane) {
    const int fr = lane & 15, fq = lane >> 4;
#pragma unroll
    for (int ks = 0; ks < 4; ++ks) {
        const bf16x8 a = *(const LAS bf16x8*)(A + (16 * wave + fr) * LDP + 32 * ks + 8 * fq);
#pragma unroll
        for (int ct = 0; ct < 8; ++ct) acc[ct] = __builtin_amdgcn_mfma_f32_16x16x32_bf16(tr_frag(B, ct, ks, lane), a, acc[ct], 0, 0, 0);
    }
}
__device__ __forceinline__ void mm128_tt(f32x4 (&acc)[8], const LAS bf16* At, const LAS bf16* Bn, int wave, int lane) {
#pragma unroll
    for (int ks = 0; ks < 4; ++ks) {
        const bf16x8 a = tr_frag(At, wave, ks, lane);
#pragma unroll
        for (int ct = 0; ct < 8; ++ct) acc[ct] = __builtin_amdgcn_mfma_f32_16x16x32_bf16(tr_frag(Bn, ct, ks, lane), a, acc[ct], 0, 0, 0);
    }
}
__device__ __forceinline__ void tile_commit_N(LAS bf16* dst, const TileX& t, int tid) {
#pragma unroll
    for (int it = 0; it < 4; ++it) { const int idx = tid + 512 * it, j = idx >> 4, c8 = idx & 15; *(LAS v4u*)(dst + j * LDP + 8 * c8) = t.x[it]; }
}

__global__ void __launch_bounds__(512, 2) mk_fwd(Params a) {
    extern __shared__ __attribute__((aligned(16))) unsigned char lds_raw[];
    LAS unsigned char* lds = (LAS unsigned char*)lds_raw;
    const int tid = threadIdx.x, lane = tid & 63, wave = __builtin_amdgcn_readfirstlane(tid >> 6), fr = lane & 15, fq = lane >> 4;
    const int G = gridDim.x, blk = blockIdx.x;
    const int gw = blk * 8 + wave, NGW = G * 8;
    const int gt = blk * 512 + tid, NGT = G * 512;
    unsigned char* ws = a.ws;
#define x_p (a.in[0])
#define x_s (a.in[1])
#define p_p (a.in[2])
#define p_s (a.in[3])
#define state_ret (a.in[4])
#define state_conv (a.in[5])
#define gm_ln_g (a.in[8])
#define gm_ln_b (a.in[9])
#define gm_ws (a.in[10])
#define gm_bs (a.in[11])
#define conv_w (a.in[15])
#define conv_b (a.in[16])
#define g_final (a.in[21])
#define out (a.out)
#define SS1 ((float*)(ws + WS_SS1))
#define SS2 ((float*)(ws + WS_SS2))
#define SS3 ((float*)(ws + WS_SS3))
#define STATS ((float*)(ws + WS_STATS))
#define ROPE ((float*)(ws + WS_ROPE))
#define ROPES ((float*)(ws + WS_ROPES))
#define Win_t ((bf16*)(ws + WS_WIN))
#define Wo_t ((bf16*)(ws + WS_WO))
#define Wup_t ((bf16*)(ws + WS_WUP))
#define Wdn_t ((bf16*)(ws + WS_WDN))
#define Wg_t ((bf16*)(ws + WS_WG))
#define Wp_t ((bf16*)(ws + WS_WP))
#define AB ((bf16*)(ws + WS_AB))
#define PB ((bf16*)(ws + WS_PB))
#define MIX ((bf16*)(ws + WS_MIX))
#define Z ((bf16*)(ws + WS_Z))
#define ACT ((bf16*)(ws + WS_ACT))
#define KV ((float*)(ws + WS_KV))
#define PP ((bf16*)(ws + WS_PP))
#define RAW ((float*)(ws + WS_RAW))
#define AS ((float*)(ws + WS_AS))

    volatile LAS unsigned* MISC = (volatile LAS unsigned*)(lds + MISC_OFF);
    if (tid < 64) MISC[tid] = 0u;
    __syncthreads();
    XcdBarrier bar; bar.bar = (unsigned*)(ws + WS_BAR); bar.x = 0; bar.st = nullptr;
    if (MK_N_LAUNCHES == 1) bar = xcd_barrier_post((unsigned*)(ws + WS_BAR), MISC + 8);
    const int lo = a.ph_lo, hi = a.ph_hi;
#ifndef PHMASK
#define PHMASK 0xffff
#endif
#define IN(k) (((PHMASK >> (k)) & 1) && lo <= (k) && (k) < hi)
#define SEAM(k) do { if (IN(k) && IN((k) + 1)) { if (a.use_cg) cg::this_grid().sync(); else xcd_barrier(bar); } } while (0)

    if (IN(0)) {
        LAS float* scr = (LAS float*)(lds + wave * 16640);
        constexpr int I_IN = (D / 64) * (NIN / 64);
        for (int it = gw; it < I_IN; it += NGW) transpose_item(a.in[7], D, NIN, a.in[6], Win_t, false, scr, it, lane);
        for (int m = gw; m < MT; m += NGW) rms_row_to_bf16(m < MP ? x_p + (size_t)m * D : x_s + (size_t)(m - MP) * D, AB + (size_t)m * D, (float*)(ws + WS_RINV) + m, lane);
        for (int i = gt; i < MT * PLE / 4; i += NGT) { const f32x4 v = __builtin_nontemporal_load(i < MP * PLE / 4 ? (const f32x4*)p_p + i : (const f32x4*)p_s + (i - MP * PLE / 4)); v2u w; w.x = pk2(v[0], v[1]); w.y = pk2(v[2], v[3]); ((v2u*)PB)[i] = w; }
        for (int i = gt; i < SEQ * 64 + 64; i += NGT) { const int pos = i < SEQ * 64 ? (i >> 6) : 16384, fi = i & 63;
            const float ang = (float)pos * a.invf[fi]; double t = (double)ang * 0.15915494309189535; t -= __builtin_rint(t); const float rev = (float)t;
            float* dst = i < SEQ * 64 ? ROPE + 2 * (size_t)i : ROPES + 2 * fi; dst[0] = __builtin_amdgcn_cosf(rev); dst[1] = __builtin_amdgcn_sinf(rev); }
        for (int i = gt; i < MT; i += NGT) { SS1[i] = 0.f; SS2[i] = 0.f; SS3[i] = 0.f; }
    }
    SEAM(0);

    if (IN(1)) {
        { pg8::Gemm g{AB, Win_t, MP, NIN, D}; pg8::StaticOrder S; S.init(MP, NIN, G, blk); EpiZ E{Z};
          pg8::gemm_phase<EpiZ, pg8::StaticOrder, true, true>(lds, g, S, E); }
        auto f = [&](int s, int n, float v) { const float o = n < 3072 ? v : (n < 4096 ? silu_(v) : gelu_(v)); Z[(size_t)(MP + s) * NIN + n] = f2bf(o); };
        skinny_gemm<8>(lds, AB + (size_t)MP * D, Win_t, NIN, D, blk, G, f);
    }
    SEAM(1);

    if (IN(2)) {
        for (int pass = 0; pass < 2; ++pass) {
        if ((pass ^ (blk & 1)) == 0) {
        { LAS float* qs = (LAS float*)lds; LAS float* ks = qs + 128; LAS float* vs = ks + 128; LAS float* red = vs + 128;
          const int e4 = tid & 31, dg = tid >> 5;
          for (int u = blk; u < MS * NH; u += G) { const int s = u >> 3, h = u & 7; const bf16* zr = Z + (size_t)(MP + s) * NIN;
            const float* S0 = state_ret + (size_t)u * 16384 + 4 * e4; float* S1 = out + O_RETS + (size_t)u * 16384 + 4 * e4;
            f32x4 s0[8];
#pragma unroll
            for (int i = 0; i < 8; ++i) s0[i] = __builtin_nontemporal_load((const f32x4*)(S0 + (dg + 16 * i) * 128));
            if (tid < 64) { const float c = ROPES[2 * tid], sn = ROPES[2 * tid + 1];
                const float q1 = bf2f(zr[128 * h + tid]), q2 = bf2f(zr[128 * h + 64 + tid]), k1 = bf2f(zr[1024 + 128 * h + tid]), k2 = bf2f(zr[1024 + 128 * h + 64 + tid]);
                qs[tid] = q1 * c - q2 * sn; qs[tid + 64] = q2 * c + q1 * sn; ks[tid] = (k1 * c - k2 * sn) * 0.08838834764831845f; ks[tid + 64] = (k2 * c + k1 * sn) * 0.08838834764831845f; }
            else if (tid < 192) vs[tid - 64] = bf2f(zr[2048 + 128 * h + tid - 64]);
            unsigned gg = 0u; if (tid < 64) gg = *(const unsigned*)(zr + 3072 + 128 * h + 2 * tid);
            __syncthreads();
            const float gamma = 1.0f - __builtin_amdgcn_exp2f((float)(-5 - h));
            const f32x4 vv = *(const LAS f32x4*)(vs + 4 * e4); f32x4 o = {0.f, 0.f, 0.f, 0.f};
#pragma unroll
            for (int i = 0; i < 8; ++i) { const int d = dg + 16 * i; const f32x4 sn = s0[i] * gamma + vv * ks[d]; __builtin_nontemporal_store(sn, (f32x4*)(S1 + d * 128)); o += sn * qs[d]; }
            *(LAS f32x4*)(red + dg * 128 + 4 * e4) = o;
            __syncthreads();
            if (tid < 64) { float o0 = 0.f, o1 = 0.f;
#pragma unroll
                for (int i = 0; i < 16; ++i) { o0 += red[i * 128 + 2 * tid]; o1 += red[i * 128 + 2 * tid + 1]; }
                const float r = __builtin_amdgcn_rsqf(wave_sum(o0 * o0 + o1 * o1) * (1.0f / 128.0f) + EPS);
                *(unsigned*)(MIX + (size_t)(MP + s) * D + 128 * h + 2 * tid) = pk2(o0 * r * lo16(gg), o1 * r * hi16(gg)); }
            __syncthreads(); } }
        } else {
        { LAS bf16* Kt = (LAS bf16*)lds; LAS bf16* Vt = (LAS bf16*)(lds + TILE_B);
          for (int u = blk; u < 512; u += G) { const int b = u >> 7, h = (u >> 4) & 7, c = u & 15; const size_t R0 = (size_t)b * SEQ + 128 * c;
            RopeX kx; RopeCS cs; TileX vx;
            rope_load(kx, Z + R0 * NIN + 1024 + 128 * h, tid); rope_cs_load(cs, ROPE + (size_t)(128 * c) * 128, tid); tile_load(vx, Z + R0 * NIN + 2048 + 128 * h, tid);
            rope_commit<false, true>(Kt, kx, cs, 0.08838834764831845f, a.log2g[h], tid);
            tile_commit_N(Vt, vx, tid);
            __syncthreads();
            f32x4 acc[8];
#pragma unroll
            for (int ct = 0; ct < 8; ++ct) acc[ct] = (f32x4){0.f, 0.f, 0.f, 0.f};
            mm128_tt(acc, Kt, Vt, wave, lane);
            float* kv = KV + (size_t)u * 16384 + (16 * wave + fr) * 128 + 4 * fq;
#pragma unroll
            for (int ct = 0; ct < 8; ++ct) *(f32x4*)(kv + 16 * ct) = acc[ct];
            __syncthreads(); } }
        for (int r0 = gw; r0 < MP; r0 += 2 * NGW) { const int r1 = r0 + NGW;
            const bf16* p0 = Z + (size_t)r0 * NIN + 5120 + 16 * lane; const bf16* p1 = Z + (size_t)(r1 < MP ? r1 : r0) * NIN + 5120 + 16 * lane;
            const v4u xa0 = *(const v4u*)p0, xa1 = *(const v4u*)(p0 + 8), xb0 = *(const v4u*)p1, xb1 = *(const v4u*)(p1 + 8);
            float va[16], vb[16];
#pragma unroll
            for (int j = 0; j < 4; ++j) { va[2 * j] = lo16(xa0[j]); va[2 * j + 1] = hi16(xa0[j]); va[8 + 2 * j] = lo16(xa1[j]); va[8 + 2 * j + 1] = hi16(xa1[j]);
                                          vb[2 * j] = lo16(xb0[j]); vb[2 * j + 1] = hi16(xb0[j]); vb[8 + 2 * j] = lo16(xb1[j]); vb[8 + 2 * j + 1] = hi16(xb1[j]); }
            float sa = 0.f, sb = 0.f;
#pragma unroll
            for (int j = 0; j < 16; ++j) { sa += va[j]; sb += vb[j]; }
            const float ma = wave_sum(sa) * (1.0f / 1024.0f), mb = wave_sum(sb) * (1.0f / 1024.0f); float qa = 0.f, qb = 0.f;
#pragma unroll
            for (int j = 0; j < 16; ++j) { const float da = va[j] - ma, db = vb[j] - mb; qa += da * da; qb += db * db; }
            const float ra = __builtin_amdgcn_rsqf(wave_sum(qa) * (1.0f / 1024.0f) + EPS), rb = __builtin_amdgcn_rsqf(wave_sum(qb) * (1.0f / 1024.0f) + EPS);
            if (lane == 0) { STATS[2 * r0] = ma; STATS[2 * r0 + 1] = ra; if (r1 < MP) { STATS[2 * r1] = mb; STATS[2 * r1 + 1] = rb; } } }
        for (int row = MP + gw; row < MT; row += NGW) { const bf16* p = Z + (size_t)row * NIN + 5120 + 16 * lane; const v4u x0 = *(const v4u*)p, x1 = *(const v4u*)(p + 8);
            const int s_ = row - MP, c0 = 16 * lane, grp = lane >> 3; const float w00 = gm_ws[grp * 16384], b0 = gm_bs[grp * 128];
            const bf16* up = Z + (size_t)row * NIN + 4096 + c0; const v4u u0 = *(const v4u*)up, u1 = *(const v4u*)(up + 8);
            float v[16];
#pragma unroll
            for (int j = 0; j < 4; ++j) { v[2 * j] = lo16(x0[j]); v[2 * j + 1] = hi16(x0[j]); v[8 + 2 * j] = lo16(x1[j]); v[8 + 2 * j + 1] = hi16(x1[j]); }
            float s = 0.f;
#pragma unroll
            for (int j = 0; j < 16; ++j) s += v[j];
            const float mean = wave_sum(s) * (1.0f / 1024.0f); float q = 0.f;
#pragma unroll
            for (int j = 0; j < 16; ++j) { v[j] -= mean; q += v[j] * v[j]; }
            const float rstd = __builtin_amdgcn_rsqf(wave_sum(q) * (1.0f / 1024.0f) + EPS);
            float uu[16];
#pragma unroll
            for (int j = 0; j < 4; ++j) { uu[2 * j] = lo16(u0[j]); uu[2 * j + 1] = hi16(u0[j]); uu[8 + 2 * j] = lo16(u1[j]); uu[8 + 2 * j + 1] = hi16(u1[j]); }
            float vn[16], mo[16];
#pragma unroll
            for (int j = 0; j < 16; ++j) { vn[j] = v[j] * rstd * gm_ln_g[c0 + j] + gm_ln_b[c0 + j]; mo[j] = uu[j] * (w00 * vn[j] + b0); }
            float* gv = out + O_GMV + (size_t)s_ * 1024 + c0;
#pragma unroll
            for (int j = 0; j < 4; ++j) *(f32x4*)(gv + 4 * j) = (f32x4){vn[4 * j], vn[4 * j + 1], vn[4 * j + 2], vn[4 * j + 3]};
            v4u w0, w1;
#pragma unroll
            for (int j = 0; j < 4; ++j) { w0[j] = pk2(mo[2 * j], mo[2 * j + 1]); w1[j] = pk2(mo[8 + 2 * j], mo[8 + 2 * j + 1]); }
            bf16* mp = MIX + (size_t)row * D + 1024 + c0; *(v4u*)mp = w0; *(v4u*)(mp + 8) = w1; }
        } }
    }
    SEAM(2);

    if (IN(3)) {
        auto convert_rest = [&]() {
            LAS float* scr = (LAS float*)(lds + wave * 16640);
            constexpr int I_O = (D / 64) * (D / 64), I_UP = (D / 64) * (NUP / 64), I_DN = (DFF / 64) * (D / 64), I_G = I_O, I_P = (PLE / 64) * (D / 64);
            constexpr int NITEMS = I_O + I_UP + I_DN + I_G + I_P;
            for (int it = gw; it < NITEMS; it += NGW) {
                int r = it;
                if (r < I_UP) { transpose_item(a.in[14], D, NUP, a.in[13], Wup_t, true, scr, r, lane); continue; } r -= I_UP;
                if (r < I_O) { transpose_item(a.in[12], D, D, nullptr, Wo_t, false, scr, r, lane); continue; } r -= I_O;
                if (r < I_DN) { transpose_item(a.in[17], DFF, D, nullptr, Wdn_t, false, scr, r, lane); continue; } r -= I_DN;
                if (r < I_G) { transpose_item(a.in[19], D, D, a.in[18], Wg_t, false, scr, r, lane); continue; } r -= I_G;
                transpose_item(a.in[20], PLE, D, nullptr, Wp_t, false, scr, r, lane);
            }
            __syncthreads(); };
        if (!(blk & 1)) convert_rest();
        {
        LAS bf16* T0 = (LAS bf16*)lds; LAS bf16* T1 = (LAS bf16*)(lds + TILE_B); LAS bf16* T2 = (LAS bf16*)(lds + 2 * TILE_B); LAS bf16* T3 = (LAS bf16*)(lds + 3 * TILE_B);
        for (int u = blk; u < 512; u += G) { const int bh = u >> 4, b = bh >> 3, h = bh & 7, c = u < 256 ? (u & 15) : 15 - (u & 15); const size_t R0 = (size_t)b * SEQ + 128 * c; const float l2g = a.log2g[h];
            const int i_ = 16 * wave + fr;
            RopeX qx, kx; RopeCS cs; TileX vx; v2u gg[8];
            const float* kvb = KV + (size_t)bh * 16 * 16384;
            f32x4 tc[8];
#pragma unroll
            for (int i = 0; i < 8; ++i) tc[i] = *(const f32x4*)(kvb + 4 * (tid + 512 * i));
            rope_load<true>(qx, Z + R0 * NIN + 128 * h, tid); rope_load<true>(kx, Z + R0 * NIN + 1024 + 128 * h, tid); rope_cs_load(cs, ROPE + (size_t)(128 * c) * 128, tid); tile_load<true>(vx, Z + R0 * NIN + 2048 + 128 * h, tid);
            rope_commit<false, false>(T0, qx, cs, 1.0f, 0.f, tid);
            rope_commit<false, false>(T1, kx, cs, 0.08838834764831845f, 0.f, tid);
            asm volatile("" ::: "memory");
            { const float Gc = __builtin_amdgcn_exp2f(l2g * 128.0f);
              f32x4 sp[8];
#pragma unroll
              for (int i = 0; i < 8; ++i) sp[i] = (f32x4){0.f, 0.f, 0.f, 0.f};
              for (int j = 0; j < c; ++j) { f32x4 tn[8];
#pragma unroll
                  for (int i = 0; i < 8; ++i) tn[i] = *(const f32x4*)(kvb + (size_t)(j + 1) * 16384 + 4 * (tid + 512 * i));
#pragma unroll
                  for (int i = 0; i < 8; ++i) { sp[i] = sp[i] * Gc + tc[i]; tc[i] = tn[i]; } }
              if (c == 15) {
#pragma unroll
                  for (int i = 0; i < 8; ++i) *(f32x4*)(out + O_RETP + (size_t)bh * 16384 + 4 * (tid + 512 * i)) = sp[i] * Gc + tc[i]; }
#pragma unroll
              for (int i = 0; i < 8; ++i) { const int ch = tid + 512 * i, d = ch >> 5, e4 = ch & 31; v2u w; w.x = pk2(sp[i][0], sp[i][1]); w.y = pk2(sp[i][2], sp[i][3]);
                  *(LAS v2u*)(T3 + d * LDP + 4 * e4) = w; } }
            tile_commit_N(T2, vx, tid);
            __syncthreads();
            { const bf16* gp = Z + (R0 + i_) * NIN + 3072 + 128 * h + 4 * fq;
#pragma unroll
              for (int ct = 0; ct < 8; ++ct) gg[ct] = __builtin_nontemporal_load((const v2u*)(gp + 16 * ct)); }
            f32x4 acc2[8], acc1[8];
#pragma unroll
            for (int ct = 0; ct < 8; ++ct) { acc2[ct] = (f32x4){0.f, 0.f, 0.f, 0.f}; acc1[ct] = (f32x4){0.f, 0.f, 0.f, 0.f}; }
            mm128_nt(acc2, T0, T3, wave, lane);
            mm128(acc1, T0, T1, wave, fr, fq);
            __syncthreads();
#pragma unroll
            for (int ct = 0; ct < 8; ++ct) { float sv[4];
#pragma unroll
                for (int t = 0; t < 4; ++t) { const int j = 16 * ct + 4 * fq + t; sv[t] = i_ >= j ? acc1[ct][t] * __builtin_amdgcn_exp2f(l2g * (float)(i_ - j)) : 0.f; }
                v2u w; w.x = pk2(sv[0], sv[1]); w.y = pk2(sv[2], sv[3]); *(LAS v2u*)(T1 + i_ * LDP + 16 * ct + 4 * fq) = w; }
            __syncthreads();
#pragma unroll
            for (int ct = 0; ct < 8; ++ct) acc1[ct] = (f32x4){0.f, 0.f, 0.f, 0.f};
            mm128_nt(acc1, T1, T2, wave, lane);
            const float qd = __builtin_amdgcn_exp2f(l2g * (float)(i_ + 1)); float ssq = 0.f;
#pragma unroll
            for (int ct = 0; ct < 8; ++ct) { acc1[ct] = acc1[ct] + acc2[ct] * qd; ssq += (acc1[ct][0] * acc1[ct][0] + acc1[ct][1] * acc1[ct][1]) + (acc1[ct][2] * acc1[ct][2] + acc1[ct][3] * acc1[ct][3]); }
            ssq += __shfl_xor(ssq, 16); ssq += __shfl_xor(ssq, 32);
            const float rn = __builtin_amdgcn_rsqf(ssq * (1.0f / 128.0f) + EPS);
            bf16* mp = MIX + (R0 + i_) * D + 128 * h + 4 * fq;
#pragma unroll
            for (int ct = 0; ct < 8; ++ct) { v2u w;
                w.x = pk2(acc1[ct][0] * rn * lo16(gg[ct].x), acc1[ct][1] * rn * hi16(gg[ct].x)); w.y = pk2(acc1[ct][2] * rn * lo16(gg[ct].y), acc1[ct][3] * rn * hi16(gg[ct].y)); *(v2u*)(mp + 16 * ct) = w; }
            __syncthreads(); }
        for (int u = blk; u < 512; u += G) { const int b = u >> 7, c = (u >> 3) & 15, grp = u & 7; const size_t R0 = (size_t)b * SEQ + 128 * c;
            const int t_ = 16 * wave + fr, d8 = tid & 15;
            f32x4 wl[4][2]; v4u xv[4]; float st[4][2]; v2u uu[8]; float lg[8], lb[8];
#pragma unroll
            for (int it = 0; it < 4; ++it) { const int idx = tid + 512 * it, t = idx >> 4; const float* wp = gm_ws + (size_t)grp * 16384 + t * 128 + 8 * d8;
                wl[it][0] = *(const f32x4*)wp; wl[it][1] = *(const f32x4*)(wp + 4);
                xv[it] = __builtin_nontemporal_load((const v4u*)(Z + (R0 + t) * NIN + 5120 + 128 * grp + 8 * d8)); st[it][0] = STATS[2 * (R0 + t)]; st[it][1] = STATS[2 * (R0 + t) + 1]; }
#pragma unroll
            for (int j = 0; j < 8; ++j) { lg[j] = gm_ln_g[128 * grp + 8 * d8 + j]; lb[j] = gm_ln_b[128 * grp + 8 * d8 + j]; }
            const float bsv = gm_bs[grp * 128 + t_];
#pragma unroll
            for (int it = 0; it < 4; ++it) { const int idx = tid + 512 * it, t = idx >> 4;
                float wv[8] = {wl[it][0][0], wl[it][0][1], wl[it][0][2], wl[it][0][3], wl[it][1][0], wl[it][1][1], wl[it][1][2], wl[it][1][3]};
#pragma unroll
                for (int j = 0; j < 8; ++j) if (8 * d8 + j > t) wv[j] = 0.f;
                v4u w; w.x = pk2(wv[0], wv[1]); w.y = pk2(wv[2], wv[3]); w.z = pk2(wv[4], wv[5]); w.w = pk2(wv[6], wv[7]); *(LAS v4u*)(T0 + t * LDP + 8 * d8) = w;
                const float mean = st[it][0], rstd = st[it][1];
                v4u vw;
#pragma unroll
                for (int p = 0; p < 4; ++p) vw[p] = pk2((lo16(xv[it][p]) - mean) * rstd * lg[2 * p] + lb[2 * p], (hi16(xv[it][p]) - mean) * rstd * lg[2 * p + 1] + lb[2 * p + 1]);
                *(LAS v4u*)(T1 + t * LDP + 8 * d8) = vw; }
            __syncthreads();
            { const bf16* up = Z + (R0 + t_) * NIN + 4096 + 128 * grp + 4 * fq;
#pragma unroll
              for (int ct = 0; ct < 8; ++ct) uu[ct] = __builtin_nontemporal_load((const v2u*)(up + 16 * ct)); }
            f32x4 acc[8];
#pragma unroll
            for (int ct = 0; ct < 8; ++ct) acc[ct] = (f32x4){0.f, 0.f, 0.f, 0.f};
            mm128_nt(acc, T0, T1, wave, lane);
            bf16* mp = MIX + (R0 + t_) * D + 1024 + 128 * grp + 4 * fq;
#pragma unroll
            for (int ct = 0; ct < 8; ++ct) { v2u w;
                w.x = pk2((acc[ct][0] + bsv) * lo16(uu[ct].x), (acc[ct][1] + bsv) * hi16(uu[ct].x)); w.y = pk2((acc[ct][2] + bsv) * lo16(uu[ct].y), (acc[ct][3] + bsv) * hi16(uu[ct].y)); *(v2u*)(mp + 16 * ct) = w; }
            __syncthreads(); }
        }
        if (blk & 1) convert_rest();
    }
    SEAM(3);

    if (IN(4)) {
        { pg8::Gemm g{MIX, Wo_t, MP, D, D}; pg8::StaticOrder S; S.init(MP, D, G, blk); EpiRes<2> E{(const float*)(ws + WS_RINV), nullptr, AB, SS1};
          pg8::gemm_phase<EpiRes<2>, pg8::StaticOrder, true, true>(lds, g, S, E); }
    }
    SEAM(4);

    if (IN(5)) {
        unsigned* p3s_cnt = (unsigned*)(ws + WS_BAR) + 3584;
        if (blk >= 248) {
            { pg8::Gemm g{MIX, Wo_t, MP + 256, D, D}; SampleOrder S{blk - 248}; EpiResS E{x_s, AB + (size_t)MP * D, SS1 + MP};
              pg8::gemm_phase<EpiResS, SampleOrder, true, true>(lds, g, S, E); }
            asm volatile("s_waitcnt vmcnt(0)" ::: "memory"); __syncthreads();
            if (tid == 0) { __builtin_amdgcn_fence(__ATOMIC_RELEASE, "agent"); asm volatile("s_waitcnt vmcnt(0)" ::: "memory"); (void)__hip_atomic_fetch_add(p3s_cnt, 1u, __ATOMIC_RELAXED, __HIP_MEMORY_SCOPE_AGENT); }
        }
        { pg8::Gemm g{AB, Wup_t, MP, NUP, D}; pg8::StaticOrder S; S.init(MP, NUP, G, blk); EpiUp E{ACT, RAW, SS1, conv_w, conv_b, (LAS float*)(lds + 131072)};
          pg8::gemm_phase<EpiUp, pg8::StaticOrder, true, true>(lds, g, S, E); }
        if (blk >= 128 && blk - 128 < NUP / 256) {
            if (tid == 0) { unsigned spins = 0; while (__hip_atomic_load(p3s_cnt, __ATOMIC_RELAXED, __HIP_MEMORY_SCOPE_AGENT) < 8u) { __builtin_amdgcn_s_sleep(4); if (++spins > (1u << 22)) break; } }
            __syncthreads();
            __builtin_amdgcn_fence(__ATOMIC_ACQUIRE, "agent"); asm volatile("s_waitcnt vmcnt(0)" ::: "memory"); }
        { pg8::Gemm g{AB, Wup_t, MP + 256, NUP, D}; SampleOrder S{(blk >= 128 && blk - 128 < NUP / 256) ? blk - 128 : -1}; EpiAS E{AS, SS1};
          pg8::gemm_phase<EpiAS, SampleOrder, true, true>(lds, g, S, E); }
        { int Kp = PLE; asm volatile("" : "+s"(Kp));
          constexpr int nbusy = (MP / 256 * (NUP / 256) + NUP / 256) - 5 * 256;
          pg8::Gemm g{PB, Wp_t, MP + 256, D, Kp}; ProjOrder S{(blk >= nbusy && blk < 248) ? blk - nbusy : -1, 248 - nbusy}; EpiPP E{PP};
          pg8::gemm_phase<EpiPP, ProjOrder, true, true>(lds, g, S, E); }
    }
    SEAM(5);

    if (IN(6)) {
        for (int i = gt; i < 128 * 2 * (DFF / 4); i += NGT) { const int c4 = i % (DFF / 4), gr = i / (DFF / 4), rr = gr & 1, Gp = gr >> 1, c = 4 * c4; const bool first = (Gp & 31) == 0;
            const float* rg = RAW + (size_t)Gp * 4 * NUP; const float* rp = rg - 4 * NUP; const f32x4 z4 = {0.f, 0.f, 0.f, 0.f};
            f32x4 a0g, a0u, a1g, a1u, a2g, a2u;
            a0g = *(const f32x4*)(rg + (2 + rr) * NUP + c); a0u = *(const f32x4*)(rg + (2 + rr) * NUP + DFF + c);
            if (rr) { a1g = *(const f32x4*)(rg + 2 * NUP + c); a1u = *(const f32x4*)(rg + 2 * NUP + DFF + c); a2g = first ? z4 : *(const f32x4*)(rp + NUP + c); a2u = first ? z4 : *(const f32x4*)(rp + NUP + DFF + c); }
            else { a1g = first ? z4 : *(const f32x4*)(rp + NUP + c); a1u = first ? z4 : *(const f32x4*)(rp + NUP + DFF + c); a2g = first ? z4 : *(const f32x4*)(rp + c); a2u = first ? z4 : *(const f32x4*)(rp + DFF + c); }
            const f32x4 ag = *(const f32x4*)(conv_w + c) * a2g + *(const f32x4*)(conv_w + NUP + c) * a1g + *(const f32x4*)(conv_w + 2 * NUP + c) * a0g + *(const f32x4*)(conv_b + c);
            const f32x4 au = *(const f32x4*)(conv_w + DFF + c) * a2u + *(const f32x4*)(conv_w + NUP + DFF + c) * a1u + *(const f32x4*)(conv_w + 2 * NUP + DFF + c) * a0u + *(const f32x4*)(conv_b + DFF + c);
            v2u w; w.x = pk2(silu_(ag[0]) * au[0], silu_(ag[1]) * au[1]); w.y = pk2(silu_(ag[2]) * au[2], silu_(ag[3]) * au[3]);
            *(v2u*)(ACT + (size_t)(64 * Gp + rr) * DFF + c) = w; }
        for (int i = gt; i < MS * (DFF / 4); i += NGT) { const int c4 = i % (DFF / 4), s = i / (DFF / 4), c = 4 * c4;
            const float* sc0 = state_conv + (size_t)s * 2 * NUP; const float* sc1 = sc0 + NUP; const float* as = AS + (size_t)s * NUP;
            const f32x4 a0g = *(const f32x4*)(as + c), a0u = *(const f32x4*)(as + DFF + c), a1g = *(const f32x4*)(sc1 + c), a1u = *(const f32x4*)(sc1 + DFF + c), a2g = *(const f32x4*)(sc0 + c), a2u = *(const f32x4*)(sc0 + DFF + c);
            const f32x4 ag = *(const f32x4*)(conv_w + c) * a2g + *(const f32x4*)(conv_w + NUP + c) * a1g + *(const f32x4*)(conv_w + 2 * NUP + c) * a0g + *(const f32x4*)(conv_b + c);
            const f32x4 au = *(const f32x4*)(conv_w + DFF + c) * a2u + *(const f32x4*)(conv_w + NUP + DFF + c) * a1u + *(const f32x4*)(conv_w + 2 * NUP + DFF + c) * a0u + *(const f32x4*)(conv_b + DFF + c);
            v2u w; w.x = pk2(silu_(ag[0]) * au[0], silu_(ag[1]) * au[1]); w.y = pk2(silu_(ag[2]) * au[2], silu_(ag[3]) * au[3]);
            *(v2u*)(ACT + (size_t)(MP + s) * DFF + c) = w;
            float* cs = out + O_CONVS + (size_t)s * 2 * NUP; *(f32x4*)(cs + c) = a1g; *(f32x4*)(cs + DFF + c) = a1u; *(f32x4*)(cs + NUP + c) = a0g; *(f32x4*)(cs + NUP + DFF + c) = a0u; }
        for (int i = gt; i < 4 * 2 * (NUP / 4); i += NGT) { const int c4 = i % (NUP / 4), bk = i / (NUP / 4), b = bk >> 1, k = bk & 1;
            *(f32x4*)(out + O_CONVP + (size_t)bk * NUP + 4 * c4) = *(const f32x4*)(RAW + ((size_t)(32 * b + 31) * 4 + k) * NUP + 4 * c4); }
    }
    SEAM(6);

    if (IN(7)) {
        { pg8::Gemm g{ACT, Wdn_t, MP, D, DFF}; pg8::StaticOrder S; S.init(MP, D, G, blk); EpiRes<1> E{nullptr, nullptr, AB, SS2};
          pg8::gemm_phase<EpiRes<1>, pg8::StaticOrder, true, true>(lds, g, S, E); }
        auto f = [&](int s, int n, float v) { const size_t o_ = (size_t)(MP + s) * D + n; const float o = bf2f(AB[o_]) + v; AB[o_] = f2bf(o);
            const float q = half_wave_sum(o * o); if ((lane & 31) == 0) atomic_addf(SS2 + MP + s, q); };
        skinny_gemm<2>(lds, ACT + (size_t)MP * DFF, Wdn_t, D, DFF, blk, G, f);
    }
    SEAM(7);

    if (IN(8)) {
#ifndef T_B
        { pg8::Gemm g{AB, Wg_t, MP, D, D}; pg8::StaticOrder S; S.init(MP, D, G, blk); EpiGate E{PP, AB, out, SS2, SS3};
          pg8::gemm_phase<EpiGate, pg8::StaticOrder, true, true>(lds, g, S, E); }
#endif
#ifndef T_D
        auto f2 = [&](int s, int n, float v) { const size_t o_ = (size_t)(MP + s) * D + n; const float r2 = __builtin_amdgcn_rsqf(SS2[MP + s] * (1.0f / D) + EPS);
            const float o = bf2f(AB[o_]) + bf2f(PP[o_]) * sigmoid_(r2 * v); out[o_] = o; const float q = half_wave_sum(o * o); if ((lane & 31) == 0) atomic_addf(SS3 + MP + s, q); };
        skinny_gemm<2>(lds, AB + (size_t)MP * D, Wg_t, D, D, blk, G, f2);
#endif
    }
    SEAM(8);

    if (IN(9)) {
        { const f32x4* gr = (const f32x4*)g_final + lane; f32x4 gv[8];
#pragma unroll
          for (int j = 0; j < 8; ++j) gv[j] = gr[64 * j];
          for (int m0 = gw; m0 < MT; m0 += 2 * NGW) { const int m1 = m0 + NGW; const bool two = m1 < MT;
            f32x4* h0 = (f32x4*)(out + (size_t)m0 * D) + lane; f32x4* h1 = (f32x4*)(out + (size_t)(two ? m1 : m0) * D) + lane;
            f32x4 a0[8], a1[8];
#pragma unroll
            for (int j = 0; j < 8; ++j) { a0[j] = h0[64 * j]; a1[j] = h1[64 * j]; }
            const float r0 = __builtin_amdgcn_rsqf(SS3[m0] * (1.0f / D) + EPS), r1 = __builtin_amdgcn_rsqf(SS3[two ? m1 : m0] * (1.0f / D) + EPS);
#pragma unroll
            for (int j = 0; j < 8; ++j) __builtin_nontemporal_store(a0[j] * gv[j] * r0, h0 + 64 * j);
            if (two) {
#pragma unroll
                for (int j = 0; j < 8; ++j) __builtin_nontemporal_store(a1[j] * gv[j] * r1, h1 + 64 * j); } } }
    }
#undef IN
#undef SEAM
}
#undef x_p
#undef x_s
#undef p_p
#undef p_s
#undef state_ret
#undef state_conv
#undef gm_ln_g
#undef gm_ln_b
#undef gm_ws
#undef gm_bs
#undef conv_w
#undef conv_b
#undef g_final
#undef out
#undef SS1
#undef SS2
#undef SS3
#undef STATS
#undef ROPE
#undef ROPES
#undef Win_t
#undef Wo_t
#undef Wup_t
#undef Wdn_t
#undef Wg_t
#undef Wp_t
#undef AB
#undef PB
#undef MIX
#undef Z
#undef ACT
#undef KV
#undef PP
#undef RAW
#undef AS

extern "C" void kernel_launch(void* const* d_in, const int* in_sizes, int n_in, void* d_out, int out_size, void* d_ws, size_t ws_size, hipStream_t stream) {
    static int grid = 0;
    if (grid == 0) {
        if (n_in != 22 || out_size != (int)O_END || ws_size < WS_END) { fprintf(stderr, "kernel_launch: unexpected shapes: n_in %d out %d ws %zu\n", n_in, out_size, ws_size); grid = -1; return; }
        int dev = 0, cus = 0, per_cu = 0;
        if (hipGetDevice(&dev) != hipSuccess || hipDeviceGetAttribute(&cus, hipDeviceAttributeMultiprocessorCount, dev) != hipSuccess) { grid = -1; return; }
        if (hipFuncSetAttribute((const void*)mk_fwd, hipFuncAttributeMaxDynamicSharedMemorySize, LDS_BYTES) != hipSuccess) { fprintf(stderr, "kernel_launch: hipFuncSetAttribute failed\n"); grid = -1; return; }
        if (hipOccupancyMaxActiveBlocksPerMultiprocessor(&per_cu, (const void*)mk_fwd, 512, LDS_BYTES) != hipSuccess || per_cu < 1) fprintf(stderr, "kernel_launch: occupancy query says %d\n", per_cu);
        (void)hipGetLastError();
        grid = cus;
        if (grid != 256) fprintf(stderr, "kernel_launch: %d CUs (built for 256)\n", grid);
    }
    if (grid < 0) return;
    if (hipMemsetAsync((char*)d_ws + WS_BAR, 0, BAR_BYTES, stream) != hipSuccess) { fprintf(stderr, "kernel_launch: memset failed\n"); return; }
    Params p{};
    for (int i = 0; i < 22; ++i) p.in[i] = (const float*)d_in[i];
    p.out = (float*)d_out; p.ws = (unsigned char*)d_ws;
    for (int h = 0; h < 8; ++h) p.log2g[h] = (float)std::log2(1.0 - std::exp2(-5.0 - (double)h));
    for (int i = 0; i < 64; ++i) p.invf[i] = powf(10000.0f, -(float)i / 64.0f);
    p.use_cg = 0; p.pad = 0;
#if MK_N_LAUNCHES == 1
    void* args[] = {&p};
#ifdef PROBE_K
    p.ph_lo = 0; p.ph_hi = PROBE_K + 1;
    (void)hipLaunchCooperativeKernel((const void*)mk_fwd, dim3(grid), dim3(512), args, LDS_BYTES, stream);
    if (hipMemsetAsync((char*)d_ws + WS_BAR, 0, BAR_BYTES, stream) != hipSuccess) return;
#endif
    p.ph_lo = 0; p.ph_hi = NPHASE;
    hipError_t e = hipLaunchCooperativeKernel((const void*)mk_fwd, dim3(grid), dim3(512), args, LDS_BYTES, stream);
    if (e != hipSuccess) fprintf(stderr, "kernel_launch: cooperative launch failed: %s\n", hipGetErrorString(e));
#else
    for (int ph = 0; ph < NPHASE; ++ph) { p.ph_lo = ph; p.ph_hi = ph + 1; hipLaunchKernelGGL(mk_fwd, dim3(grid), dim3(512), LDS_BYTES, stream, p); }
#endif
}
```

```cpp
#include <hip/hip_runtime.h>
#include <hip/hip_cooperative_groups.h>
#include <cstdio>
#include <cstdint>
#include <cmath>
namespace cg = cooperative_groups;

#ifndef MK_N_LAUNCHES
#define MK_N_LAUNCHES 1
#endif

namespace pg8 {
#define PG8_LAS __attribute__((address_space(3)))
typedef unsigned short bf16_t;
typedef short bf16x8 __attribute__((ext_vector_type(8)));
typedef float f32x4 __attribute__((ext_vector_type(4)));
typedef unsigned u32x4 __attribute__((ext_vector_type(4)));
constexpr int BM = 256, BK = 64, HALF = 128, HTB = HALF * BK * 2  , STAGE_BYTES = 8 * HTB, NXCD = 8, WGM = 8;

__host__ __device__ __forceinline__ int lds_byte(int r, int c) { const int st = (r >> 4) * 2 + (c >> 5), rr = r & 15, cc = c & 31, ob = rr * 64 + cc * 2; return st * 1024 + (ob ^ (((ob >> 9) & 1) << 5)); }
__host__ __device__ __forceinline__ void stage_rc(int b, int& R, int& C) { const int st = b / 1024, sb = b % 1024, swz = sb ^ (((sb >> 9) & 1) << 5); R = (st >> 1) * 16 + swz / 64; C = (st & 1) * 32 + (swz % 64) / 2; }
__host__ __device__ __forceinline__ int perm32(int rho) { const int n = rho >> 4, i = rho & 15; return 8 * (i >> 2) + 4 * n + (i & 3); }

struct Unit { int pm, pn; };
struct Gemm { const bf16_t* A; const bf16_t* Bt; int M, N, K; int ld = 0; };

struct StaticOrder {
    int nM, nN, nwg, G, c;
    __host__ __device__ void init(int M, int N, int G_, int c_) { nM = M / BM; nN = N / BM; nwg = nM * nN; G = G_; c = c_; }
    __host__ __device__ bool next(int i, Unit& u) const {
        const long L = (long)i * G + c; if (L >= nwg) return false;
        int wgid = (int)L; { const int q = nwg / NXCD, r = nwg % NXCD, xcd = wgid % NXCD, off = wgid / NXCD; wgid = (xcd < r ? xcd * (q + 1) : r * (q + 1) + (xcd - r) * q) + off; }
        const int nig = WGM * nN, gid = wgid / nig, fm = gid * WGM, gsz = (nM - fm) < WGM ? (nM - fm) : WGM;
        u.pm = fm + ((wgid % nig) % gsz); u.pn = (wgid % nig) / gsz; return true;
    }
    __device__ __forceinline__ void a_ready(const Unit&) const {}
    __device__ __forceinline__ void done(const Unit&) const {}
};

__device__ __forceinline__ unsigned cvt_pk_bf16(float lo, float hi) { unsigned r; asm volatile("v_cvt_pk_bf16_f32 %0, %1, %2" : "=v"(r) : "v"(lo), "v"(hi)); return r; }
typedef float f32x2 __attribute__((ext_vector_type(2)));

template <class Epi, class Sched, bool ALIGN_EPI = false, bool SP2 = false>
__device__ __forceinline__ void gemm_phase(PG8_LAS unsigned char* lds, const Gemm g, const Sched& S, const Epi& E) {
    const int tid = threadIdx.x, wid = __builtin_amdgcn_readfirstlane(tid >> 6), lane = tid & 63, wr = wid >> 2, wc = wid & 3, fr = lane & 15, fq = lane >> 4;
    const int K = g.K, nt = K / BK, LD = g.ld ? g.ld : g.K;
    unsigned voffA[2], voffB[2];
#pragma unroll
    for (int i = 0; i < 2; ++i) { int R, C; stage_rc(tid * 16 + i * 8192, R, C); const int Rb = Epi::PERM ? ((R & ~31) + perm32(R & 31)) : R;
        voffA[i] = (unsigned)(R * LD + C) * 2u; voffB[i] = (unsigned)(Rb * LD + C) * 2u; }
    const size_t kstep = (size_t)(BK * 2);
    const size_t hstep = (size_t)HALF * LD * 2;
    const size_t tstep = 2 * hstep;
    const unsigned ldsw = (unsigned)wid * 1024u;
    const int aoff = lds_byte(wr * 64 + fr, fq * 8), boff = lds_byte(wc * 32 + fr, fq * 8);
#define PG8_SA(b, h) (((b) * 2 + (h)) * HTB)
#define PG8_SB(b, h) ((4 + (b) * 2 + (h)) * HTB)
#define PG8_STAGE(bufoff, gbase, voff) do { _Pragma("unroll") for (int _i = 0; _i < 2; ++_i) \
        __builtin_amdgcn_global_load_lds((const unsigned*)((const char*)(gbase) + (voff)[_i]), (PG8_LAS unsigned*)(lds + (bufoff) + ldsw + _i * 8192), 16, 0, 0); } while (0)
#define PG8_LDA(dst, b, h) do { _Pragma("unroll") for (int m = 0; m < 4; ++m) _Pragma("unroll") for (int k = 0; k < 2; ++k) dst[m][k] = *(const PG8_LAS bf16x8*)(lds + PG8_SA(b, h) + aoff + m * 2048 + k * 1024); } while (0)
#define PG8_LDB(dst, b, h) do { _Pragma("unroll") for (int n = 0; n < 2; ++n) _Pragma("unroll") for (int k = 0; k < 2; ++k) dst[n][k] = *(const PG8_LAS bf16x8*)(lds + PG8_SB(b, h) + boff + n * 2048 + k * 1024); } while (0)
#define PG8_MMA(ai, bj, At, Bt) do { __builtin_amdgcn_s_setprio(1); _Pragma("unroll") for (int m = 0; m < 4; ++m) _Pragma("unroll") for (int n = 0; n < 2; ++n) _Pragma("unroll") for (int k = 0; k < 2; ++k) \
        acc[ai][bj][m][n] = __builtin_amdgcn_mfma_f32_16x16x32_bf16(Bt[n][k], At[m][k], acc[ai][bj][m][n], 0, 0, 0); __builtin_amdgcn_s_setprio(0); } while (0)
#define PG8_WAIT_V(n) asm volatile("s_waitcnt vmcnt(" #n ")" ::: "memory")
#define PG8_WAIT_L(n) asm volatile("s_waitcnt lgkmcnt(" #n ")" ::: "memory")
#define PG8_BAR __builtin_amdgcn_s_barrier()
#define PG8_SCHED __builtin_amdgcn_sched_barrier(0)
    Unit cur, nxt; int ui = 0;
    if (!S.next(0, cur)) return;
    f32x4 acc[2][2][4][2];
#pragma unroll
    for (int a = 0; a < 2; ++a)
#pragma unroll
        for (int b = 0; b < 2; ++b)
#pragma unroll
            for (int m = 0; m < 4; ++m)
#pragma unroll
                for (int n = 0; n < 2; ++n) acc[a][b][m][n] = (f32x4){0.f, 0.f, 0.f, 0.f};
    bf16x8 At[4][2], B0[2][2], B1[2][2];
    const char* cA = (const char*)g.A + (size_t)cur.pm * tstep; const char* cB = (const char*)g.Bt + (size_t)cur.pn * tstep;
    S.a_ready(cur);
    if constexpr (SP2) {
        PG8_STAGE(PG8_SB(0, 0), cB, voffB); PG8_STAGE(PG8_SB(0, 1), cB + hstep, voffB); PG8_STAGE(PG8_SA(0, 0), cA, voffA); PG8_STAGE(PG8_SA(0, 1), cA + hstep, voffA);
        if (wr == 1) PG8_BAR;
        PG8_WAIT_V(2); PG8_BAR;
        PG8_STAGE(PG8_SB(1, 0), cB + kstep, voffB); PG8_STAGE(PG8_SA(1, 0), cA + kstep, voffA); PG8_STAGE(PG8_SB(1, 1), cB + hstep + kstep, voffB);
        PG8_WAIT_V(6); PG8_BAR;
    } else {
        PG8_STAGE(PG8_SB(0, 0), cB, voffB); PG8_STAGE(PG8_SA(0, 0), cA, voffA); PG8_STAGE(PG8_SB(0, 1), cB + hstep, voffB); PG8_STAGE(PG8_SA(0, 1), cA + hstep, voffA);
        if (wr == 1) PG8_BAR;
        PG8_WAIT_V(4); PG8_BAR;
        PG8_STAGE(PG8_SB(1, 0), cB + kstep, voffB); PG8_STAGE(PG8_SA(1, 0), cA + kstep, voffA); PG8_STAGE(PG8_SB(1, 1), cB + hstep + kstep, voffB);
        PG8_WAIT_V(6); PG8_BAR;
    }
    for (;;) {
        const bool has_next = S.next(ui + 1, nxt);
        const char* nA = has_next ? (const char*)g.A + (size_t)nxt.pm * tstep : cA; const char* nB = has_next ? (const char*)g.Bt + (size_t)nxt.pn * tstep : cB;
        for (int t = 0; t < nt; t += 2) {
            const bool last = (t == nt - 2);
            const char* a1 = cA + (size_t)(t + 1) * kstep;
            const char* a2 = last ? nA : cA + (size_t)(t + 2) * kstep; const char* b2 = last ? nB : cB + (size_t)(t + 2) * kstep;
            const char* a3 = a2 + kstep; const char* b3 = b2 + kstep;
            if (last && has_next) S.a_ready(nxt);
            if constexpr (SP2) {
            PG8_LDB(B0, 0, 0); PG8_LDB(B1, 0, 1); PG8_SCHED; PG8_LDA(At, 0, 0); PG8_STAGE(PG8_SA(1, 1), a1 + hstep, voffA);
            PG8_WAIT_V(8); PG8_WAIT_L(0); PG8_BAR; PG8_MMA(0, 0, At, B0); PG8_MMA(0, 1, At, B1); PG8_BAR; PG8_SCHED;
            PG8_LDA(At, 0, 1); PG8_STAGE(PG8_SB(0, 0), b2, voffB); PG8_STAGE(PG8_SB(0, 1), b2 + hstep, voffB); PG8_STAGE(PG8_SA(0, 0), a2, voffA);
            PG8_WAIT_V(8); PG8_WAIT_L(0); PG8_BAR; PG8_MMA(1, 0, At, B0); PG8_MMA(1, 1, At, B1); PG8_BAR; PG8_SCHED;
            PG8_LDB(B0, 1, 0); PG8_LDB(B1, 1, 1); PG8_SCHED; PG8_LDA(At, 1, 0); PG8_STAGE(PG8_SA(0, 1), a2 + hstep, voffA);
            PG8_WAIT_V(8); PG8_WAIT_L(0); PG8_BAR; PG8_MMA(0, 0, At, B0); PG8_MMA(0, 1, At, B1); PG8_BAR; PG8_SCHED;
            PG8_LDA(At, 1, 1); PG8_STAGE(PG8_SB(1, 0), b3, voffB); PG8_STAGE(PG8_SB(1, 1), b3 + hstep, voffB); PG8_STAGE(PG8_SA(1, 0), a3, voffA);
            PG8_WAIT_V(8); PG8_WAIT_L(0); PG8_BAR; PG8_MMA(1, 0, At, B0); PG8_MMA(1, 1, At, B1); PG8_BAR; PG8_SCHED;
            } else {
            PG8_LDB(B0, 0, 0); PG8_SCHED; PG8_LDA(At, 0, 0); PG8_STAGE(PG8_SA(1, 1), a1 + hstep, voffA);
            PG8_WAIT_L(8); PG8_BAR; PG8_WAIT_L(0); PG8_MMA(0, 0, At, B0); PG8_BAR; PG8_SCHED;
            PG8_LDB(B1, 0, 1); PG8_STAGE(PG8_SB(0, 0), b2, voffB);
            PG8_BAR; PG8_WAIT_L(0); PG8_MMA(0, 1, At, B1); PG8_BAR;
            PG8_LDA(At, 0, 1); PG8_STAGE(PG8_SA(0, 0), a2, voffA);
            PG8_BAR; PG8_WAIT_L(0); PG8_MMA(1, 0, At, B0); PG8_BAR; PG8_SCHED;
            PG8_STAGE(PG8_SB(0, 1), b2 + hstep, voffB);
            PG8_WAIT_V(6); PG8_BAR; PG8_MMA(1, 1, At, B1); PG8_BAR;
            PG8_LDB(B0, 1, 0); PG8_SCHED; PG8_LDA(At, 1, 0); PG8_STAGE(PG8_SA(0, 1), a2 + hstep, voffA);
            PG8_WAIT_L(8); PG8_BAR; PG8_WAIT_L(0); PG8_MMA(0, 0, At, B0); PG8_BAR; PG8_SCHED;
            PG8_LDB(B1, 1, 1); PG8_STAGE(PG8_SB(1, 0), b3, voffB);
            PG8_BAR; PG8_WAIT_L(0); PG8_MMA(0, 1, At, B1); PG8_BAR;
            PG8_LDA(At, 1, 1); PG8_STAGE(PG8_SA(1, 0), a3, voffA);
            PG8_BAR; PG8_WAIT_L(0); PG8_MMA(1, 0, At, B0); PG8_BAR; PG8_SCHED;
            PG8_STAGE(PG8_SB(1, 1), b3 + hstep, voffB);
            PG8_WAIT_V(6); PG8_BAR; PG8_MMA(1, 1, At, B1); PG8_BAR;
            }
        }
        if constexpr (ALIGN_EPI) { if (wr == 0) PG8_BAR; }
        if constexpr (!Epi::AFTER_DRAIN) { E(acc, cur, wr, wc, fr, fq); S.done(cur); }
        if (!has_next) break;
#pragma unroll
        for (int a = 0; a < 2; ++a)
#pragma unroll
            for (int b = 0; b < 2; ++b)
#pragma unroll
                for (int m = 0; m < 4; ++m)
#pragma unroll
                    for (int n = 0; n < 2; ++n) acc[a][b][m][n] = (f32x4){0.f, 0.f, 0.f, 0.f};
        cur = nxt; cA = nA; cB = nB; ++ui;
        if constexpr (ALIGN_EPI) { if (wr == 1) PG8_BAR; }
    }
    PG8_WAIT_V(0);
    if constexpr (!ALIGN_EPI) { if (wr == 0) PG8_BAR; }
    PG8_BAR;
    if constexpr (Epi::AFTER_DRAIN) { E.fused(acc, cur, wr, wc, fr, fq, lds, wid, lane); S.done(cur); }
#undef PG8_SA
#undef PG8_SB
#undef PG8_STAGE
#undef PG8_LDA
#undef PG8_LDB
#undef PG8_MMA
#undef PG8_WAIT_V
#undef PG8_WAIT_L
#undef PG8_BAR
#undef PG8_SCHED
}
}

#define GAS __attribute__((address_space(1)))
#define LAS __attribute__((address_space(3)))
typedef unsigned short bf16;
typedef unsigned v4u __attribute__((ext_vector_type(4)));
typedef unsigned v2u __attribute__((ext_vector_type(2)));
typedef float f32x4 __attribute__((ext_vector_type(4)));
typedef float f32x2 __attribute__((ext_vector_type(2)));
typedef short bf16x8 __attribute__((ext_vector_type(8)));
#define XB_TMO      128
#define XB_XCNT(j)  (256  + 64 * (j))
#define XB_XSUB(j)  (1280 + 64 * (j))
#define XB_XGEN(j)  (2304 + 64 * (j))
#define XB_TOP      3328
#define XB_TOPGEN   3392
#define XCD_BAR_WORDS 3456
#define XB_SPIN_CAP (1u << 18)

__device__ __forceinline__ unsigned xb_ld(unsigned* p)              { return __hip_atomic_load(p, __ATOMIC_RELAXED, __HIP_MEMORY_SCOPE_AGENT); }
__device__ __forceinline__ unsigned xb_add(unsigned* p, unsigned v) { return __hip_atomic_fetch_add(p, v, __ATOMIC_RELAXED, __HIP_MEMORY_SCOPE_AGENT); }
__device__ __forceinline__ unsigned xb_xcc_id() { return (unsigned)__builtin_amdgcn_s_getreg((3 << 11) | 20) & 0xFu; }
#define XB_SPIN(cond, bar) do { unsigned _sp = 0; while (cond) { __builtin_amdgcn_s_sleep(1); \
    if ((++_sp & 255u) == 0u) { if (xb_ld(&(bar)[XB_TMO])) break; if (_sp > XB_SPIN_CAP) { atomicAdd(&(bar)[XB_TMO], 1u); break; } } } } while (0)

struct XcdBarrier {
    unsigned* bar; unsigned x;
    volatile LAS unsigned* st;
};

__device__ __forceinline__ XcdBarrier xcd_barrier_post(unsigned* bar, volatile LAS unsigned* st) {
    XcdBarrier b; b.bar = bar; b.x = xb_xcc_id(); b.st = st;
    if (threadIdx.x == 0) (void)xb_add(&bar[XB_XCNT(b.x)], 1u);
    return b;
}
__device__ __forceinline__ void xcd_barrier_complete(unsigned* bar, unsigned x, unsigned& nloc, unsigned& nx) {
    const unsigned G = gridDim.x * gridDim.y * gridDim.z;
    unsigned sum, cnt, mine, sp = 0u;
    for (;;) {
        sum = 0u; cnt = 0u; mine = 0u;
#pragma unroll
        for (unsigned j = 0; j < 16; ++j) { const unsigned c = xb_ld(&bar[XB_XCNT(j)]); sum += c; cnt += (c > 0u) ? 1u : 0u; mine = (j == x) ? c : mine; }
        if (sum == G) break;
        __builtin_amdgcn_s_sleep(1);
        if ((++sp & 255u) == 0u) { if (xb_ld(&bar[XB_TMO])) break; if (sp > XB_SPIN_CAP) { atomicAdd(&bar[XB_TMO], 1u); break; } }
    }
    nloc = mine > 0u ? mine : 1u; nx = cnt > 0u ? cnt : 1u;
}

__device__ __forceinline__ void xcd_barrier(const XcdBarrier& b) {
    asm volatile("s_waitcnt vmcnt(0)" ::: "memory");
    __syncthreads();
    if (threadIdx.x == 0) {
        unsigned* bar = b.bar;
        __builtin_amdgcn_s_waitcnt(0);
        unsigned nloc = b.st[0], nx = b.st[1];
        if (nloc == 0u) { xcd_barrier_complete(bar, b.x, nloc, nx); b.st[0] = nloc; b.st[1] = nx; }
        const unsigned old = xb_add(&bar[XB_XSUB(b.x)], 1u);
        const unsigned gen = old / nloc;
        if (old + 1u == (gen + 1u) * nloc) {
            __builtin_amdgcn_fence(__ATOMIC_RELEASE, "agent");
            asm volatile("s_waitcnt vmcnt(0)" ::: "memory");
            const unsigned og = xb_add(&bar[XB_TOP], 1u);
            const unsigned tg = og / nx;
            if (og + 1u == (tg + 1u) * nx) xb_add(&bar[XB_TOPGEN], 1u);
            else XB_SPIN(xb_ld(&bar[XB_TOPGEN]) == tg, bar);
            __builtin_amdgcn_fence(__ATOMIC_ACQUIRE, "agent");
            xb_add(&bar[XB_XGEN(b.x)], 1u);
            asm volatile("s_waitcnt vmcnt(0)" ::: "memory");
        } else {
            XB_SPIN(xb_ld(&bar[XB_XGEN(b.x)]) == gen, bar);
            __builtin_amdgcn_fence(__ATOMIC_ACQUIRE, "agent");
            asm volatile("s_waitcnt vmcnt(0)" ::: "memory");
        }
    }
    __syncthreads();
}

constexpr int MP = 8192, MS = 128, MT = MP + MS, D = 2048, NIN = 6144, NUP = 11264, DFF = 5632, PLE = 256, SEQ = 2048, NH = 8;
constexpr float EPS = 1e-6f;
constexpr int NPHASE = 10;
constexpr size_t MiB = 1u << 20;
constexpr size_t WS_BAR = 0, BAR_BYTES = 16384;
constexpr size_t WS_SS1 = 64 * 1024, WS_SS2 = 128 * 1024, WS_SS3 = 192 * 1024, WS_STATS = 256 * 1024;
constexpr size_t WS_RINV = 384 * 1024;
constexpr size_t WS_ROPE = 1 * MiB, WS_ROPES = 2 * MiB;
constexpr size_t WS_WIN = 4 * MiB, WS_WO = 28 * MiB, WS_WUP = 36 * MiB, WS_WDN = 80 * MiB, WS_WG = 102 * MiB, WS_WP = 110 * MiB;
constexpr size_t WS_AB = 112 * MiB, WS_PB = 145 * MiB, WS_MIX = 150 * MiB, WS_Z = 183 * MiB, WS_ACT = 183 * MiB, WS_KV = 281 * MiB, WS_PP = 281 * MiB;
constexpr size_t WS_RAW = 314 * MiB, WS_AS = 336 * MiB, WS_AF1 = 342 * MiB, WS_AF6 = 343 * MiB, WS_AF7 = 345 * MiB, WS_END = 346 * MiB;
static_assert(WS_AB + (size_t)MT * D * 2 <= WS_PB && WS_PB + (size_t)MT * PLE * 2 <= WS_MIX && WS_MIX + (size_t)MT * D * 2 <= WS_Z, "ws map 1");
static_assert(WS_Z + (size_t)MT * NIN * 2 <= WS_KV && WS_ACT + (size_t)MT * DFF * 2 <= WS_KV && WS_KV + (size_t)512 * 16384 * 4 <= WS_RAW, "ws map 2");
static_assert(WS_RAW + (size_t)128 * 4 * NUP * 4 <= WS_AS && WS_AS + (size_t)MS * NUP * 4 <= WS_END && WS_PP + (size_t)MT * D * 2 <= WS_RAW, "ws map 3");
constexpr size_t O_RETP = 17039360, O_CONVP = 17563648, O_RETS = 17653760, O_CONVS = 34430976, O_GMV = 37314560, O_END = 37445632;
constexpr int LDS_BYTES = 147456, MISC_OFF = LDS_BYTES - 256;
constexpr int LDP = 136;
constexpr int TILE_B = 128 * LDP * 2;

struct Params { const float* in[22]; float* out; unsigned char* ws; float log2g[8]; float invf[64]; int ph_lo, ph_hi, use_cg, pad; };

#define LDS_WAIT() asm volatile("s_waitcnt lgkmcnt(0)" ::: "memory")
__device__ __forceinline__ float lo16(unsigned u) { return __uint_as_float(u << 16); }
__device__ __forceinline__ float hi16(unsigned u) { return __uint_as_float(u & 0xffff0000u); }
__device__ __forceinline__ float bf2f(bf16 b) { return __uint_as_float((unsigned)b << 16); }
__device__ __forceinline__ unsigned pk2(float lo, float hi) { return pg8::cvt_pk_bf16(lo, hi); }
__device__ __forceinline__ bf16 f2bf(float f) { return (bf16)(pg8::cvt_pk_bf16(f, 0.f) & 0xffffu); }
__device__ __forceinline__ float sigmoid_(float x) { return __builtin_amdgcn_rcpf(1.0f + __builtin_amdgcn_exp2f(-1.44269504089f * x)); }
__device__ __forceinline__ float silu_(float x) { return x * sigmoid_(x); }
__device__ __forceinline__ float gelu_(float x) { return x * sigmoid_(1.5957691216f * (x + 0.044715f * x * x * x)); }
__device__ __forceinline__ float wave_sum(float v) {
#pragma unroll
    for (int o = 1; o < 64; o <<= 1) v += __shfl_xor(v, o);
    return v;
}
__device__ __forceinline__ void atomic_addf(float* p, float v) { (void)__hip_atomic_fetch_add(p, v, __ATOMIC_RELAXED, __HIP_MEMORY_SCOPE_AGENT); }
template <int CTRL> __device__ __forceinline__ float dppf(float x) { return __int_as_float(__builtin_amdgcn_mov_dpp(__float_as_int(x), CTRL, 0xf, 0xf, false)); }

using pg8::Unit;
struct EpiZ {
    static constexpr bool PERM = true, AFTER_DRAIN = false;
    bf16* Z;
    __device__ __forceinline__ void operator()(const f32x4 (&acc)[2][2][4][2], const Unit& u, int wr, int wc, int fr, int fq) const {
        const int row0 = u.pm * 256 + wr * 64 + fr, col0 = u.pn * 256 + wc * 32 + 8 * fq;
        const int mode = u.pn < 12 ? 0 : (u.pn < 16 ? 1 : 2);
#pragma unroll
        for (int ai = 0; ai < 2; ++ai)
#pragma unroll
            for (int m = 0; m < 4; ++m) { bf16* rowp = Z + (size_t)(row0 + ai * 128 + m * 16) * NIN + col0;
#pragma unroll
                for (int bj = 0; bj < 2; ++bj) { f32x4 v0 = acc[ai][bj][m][0], v1 = acc[ai][bj][m][1];
                    if (mode == 1) {
#pragma unroll
                        for (int j = 0; j < 4; ++j) { v0[j] = silu_(v0[j]); v1[j] = silu_(v1[j]); } }
                    else if (mode == 2) {
#pragma unroll
                        for (int j = 0; j < 4; ++j) { v0[j] = gelu_(v0[j]); v1[j] = gelu_(v1[j]); } }
                    v4u w; w.x = pk2(v0[0], v0[1]); w.y = pk2(v0[2], v0[3]); w.z = pk2(v1[0], v1[1]); w.w = pk2(v1[2], v1[3]);
                    *(v4u*)(rowp + bj * 128) = w; } }
    }
};
template <int BASE_BF16> struct EpiRes {
    const float* rowscale;
    static constexpr bool PERM = true, AFTER_DRAIN = false;
    const float* base; bf16* hb; float* ss;
    __device__ __forceinline__ void operator()(const f32x4 (&acc)[2][2][4][2], const Unit& u, int wr, int wc, int fr, int fq) const {
        const int row0 = u.pm * 256 + wr * 64 + fr, col0 = u.pn * 256 + wc * 32 + 8 * fq;
        float sacc[2][4];
#pragma unroll
        for (int ai = 0; ai < 2; ++ai) {
            f32x4 bs[BASE_BF16 ? 1 : 4][2][2]; v4u bw[4][2]; float rsc[4];
#pragma unroll
            for (int m = 0; m < 4; ++m) { rsc[m] = BASE_BF16 == 2 ? rowscale[row0 + ai * 128 + m * 16] : 1.0f;
#pragma unroll
                for (int bj = 0; bj < 2; ++bj) { const size_t o_ = (size_t)(row0 + ai * 128 + m * 16) * D + col0 + bj * 128;
                    if (BASE_BF16) bw[m][bj] = *(const v4u*)(hb + o_);
                    else { bs[m][bj][0] = *(const f32x4*)(base + o_); bs[m][bj][1] = *(const f32x4*)(base + o_ + 4); } } }
#pragma unroll
            for (int m = 0; m < 4; ++m) { const size_t off = (size_t)(row0 + ai * 128 + m * 16) * D + col0; float s = 0.f;
#pragma unroll
                for (int bj = 0; bj < 2; ++bj) { f32x4 b0, b1;
                    if (BASE_BF16) { const v4u w = bw[m][bj]; b0 = (f32x4){lo16(w.x), hi16(w.x), lo16(w.y), hi16(w.y)}; b1 = (f32x4){lo16(w.z), hi16(w.z), lo16(w.w), hi16(w.w)};
                        if (BASE_BF16 == 2) { b0 *= rsc[m]; b1 *= rsc[m]; } }
                    else { b0 = bs[m][bj][0]; b1 = bs[m][bj][1]; }
                    const f32x4 o0 = b0 + acc[ai][bj][m][0], o1 = b1 + acc[ai][bj][m][1];
                    v4u w; w.x = pk2(o0[0], o0[1]); w.y = pk2(o0[2], o0[3]); w.z = pk2(o1[0], o1[1]); w.w = pk2(o1[2], o1[3]); *(v4u*)(hb + off + bj * 128) = w;
                    s += ((o0[0] * o0[0] + o0[1] * o0[1]) + (o0[2] * o0[2] + o0[3] * o0[3])) + ((o1[0] * o1[0] + o1[1] * o1[1]) + (o1[2] * o1[2] + o1[3] * o1[3])); }
                s += __shfl_xor(s, 16); s += __shfl_xor(s, 32); sacc[ai][m] = s; }
            asm volatile("" ::: "memory"); }
        if (fq == 0) {
#pragma unroll
            for (int ai = 0; ai < 2; ++ai)
#pragma unroll
                for (int m = 0; m < 4; ++m) atomic_addf(ss + row0 + ai * 128 + m * 16, sacc[ai][m]); }
    }
};
struct EpiPP {
    static constexpr bool PERM = true, AFTER_DRAIN = false;
    bf16* pp;
    __device__ __forceinline__ void operator()(const f32x4 (&acc)[2][2][4][2], const Unit& u, int wr, int wc, int fr, int fq) const {
        const int row0 = u.pm * 256 + wr * 64 + fr, col0 = u.pn * 256 + wc * 32 + 8 * fq;
#pragma unroll
        for (int ai = 0; ai < 2; ++ai)
#pragma unroll
            for (int m = 0; m < 4; ++m) { if (row0 + ai * 128 + m * 16 >= MT) continue; bf16* rowp = pp + (size_t)(row0 + ai * 128 + m * 16) * D + col0;
#pragma unroll
                for (int bj = 0; bj < 2; ++bj) { const f32x4 v0 = acc[ai][bj][m][0], v1 = acc[ai][bj][m][1]; v4u w; w.x = pk2(v0[0], v0[1]); w.y = pk2(v0[2], v0[3]); w.z = pk2(v1[0], v1[1]); w.w = pk2(v1[2], v1[3]); *(v4u*)(rowp + bj * 128) = w; } }
    }
};
struct EpiGate {
    static constexpr bool PERM = true, AFTER_DRAIN = false;
    const bf16* pp; const bf16* hb; float* h; const float* ss2; float* ss3;
    __device__ __forceinline__ void operator()(const f32x4 (&acc)[2][2][4][2], const Unit& u, int wr, int wc, int fr, int fq) const {
        const int row0 = u.pm * 256 + wr * 64 + fr, col0 = u.pn * 256 + wc * 32 + 8 * fq;
        float sacc[2][4];
#pragma unroll
        for (int ai = 0; ai < 2; ++ai) {
            v4u hw[4][2], pw[4][2]; float r2[4];
#pragma unroll
            for (int m = 0; m < 4; ++m) { const int row = row0 + ai * 128 + m * 16; r2[m] = ss2[row];
#pragma unroll
                for (int bj = 0; bj < 2; ++bj) { hw[m][bj] = *(const v4u*)(hb + (size_t)row * D + col0 + bj * 128); pw[m][bj] = *(const v4u*)(pp + (size_t)row * D + col0 + bj * 128); } }
#pragma unroll
            for (int m = 0; m < 4; ++m) { const size_t off = (size_t)(row0 + ai * 128 + m * 16) * D + col0; float s = 0.f;
                const float rr = __builtin_amdgcn_rsqf(r2[m] * (1.0f / D) + EPS);
#pragma unroll
                for (int bj = 0; bj < 2; ++bj) { const v4u h4 = hw[m][bj], p4 = pw[m][bj];
                    const f32x4 hv0 = {lo16(h4.x), hi16(h4.x), lo16(h4.y), hi16(h4.y)}, hv1 = {lo16(h4.z), hi16(h4.z), lo16(h4.w), hi16(h4.w)};
                    const f32x4 pv0 = {lo16(p4.x), hi16(p4.x), lo16(p4.y), hi16(p4.y)}, pv1 = {lo16(p4.z), hi16(p4.z), lo16(p4.w), hi16(p4.w)};
                    const f32x4 a0 = acc[ai][bj][m][0], a1 = acc[ai][bj][m][1]; f32x4 o0, o1;
#pragma unroll
                    for (int j = 0; j < 4; ++j) { o0[j] = hv0[j] + pv0[j] * sigmoid_(rr * a0[j]); o1[j] = hv1[j] + pv1[j] * sigmoid_(rr * a1[j]); }
                    *(f32x4*)(h + off + bj * 128) = o0; *(f32x4*)(h + off + bj * 128 + 4) = o1;
                    s += ((o0[0] * o0[0] + o0[1] * o0[1]) + (o0[2] * o0[2] + o0[3] * o0[3])) + ((o1[0] * o1[0] + o1[1] * o1[1]) + (o1[2] * o1[2] + o1[3] * o1[3])); }
                s += __shfl_xor(s, 16); s += __shfl_xor(s, 32); sacc[ai][m] = s; }
            asm volatile("" ::: "memory"); }
        if (fq == 0) {
#pragma unroll
            for (int ai = 0; ai < 2; ++ai)
#pragma unroll
                for (int m = 0; m < 4; ++m) atomic_addf(ss3 + row0 + ai * 128 + m * 16, sacc[ai][m]); }
    }
};
struct EpiUp {
    static constexpr bool PERM = true, AFTER_DRAIN = false;
    bf16* act; float* raw; const float* ss1; const float* cw; const float* cb; LAS float* wl;
    __device__ __forceinline__ void operator()(const f32x4 (&acc)[2][2][4][2], const Unit& u, int wr, int wc, int fr, int fq) const {
        const int row0 = u.pm * 256 + wr * 64 + fr;
        LAS float* wb = wl + (wr * 4 + wc) * 256;
        { const int l = fq * 16 + fr, v = l >> 3, c4 = l & 7;
          const float* src = ((v & 3) == 3 ? cb : cw + (v & 3) * NUP) + (v >> 2) * DFF + u.pn * 128 + wc * 32 + 4 * c4;
          *(LAS f32x4*)(wb + v * 32 + 4 * c4) = *(const f32x4*)src; }
        float rs[2][4];
#pragma unroll
        for (int ai = 0; ai < 2; ++ai)
#pragma unroll
            for (int m = 0; m < 4; ++m) rs[ai][m] = __builtin_amdgcn_rsqf(ss1[row0 + ai * 128 + m * 16] * (1.0f / D) + EPS);
        const int cg0 = u.pn * 128 + wc * 32 + 8 * fq;
        const volatile LAS f32x4* wv = (const volatile LAS f32x4*)(wb + 8 * fq);
#pragma unroll
        for (int ai = 0; ai < 2; ++ai) {
            f32x4 l1g[2], l2g[2], l1u[2], l2u[2];
#pragma unroll
            for (int n = 0; n < 2; ++n) { l1g[n] = (f32x4){0.f, 0.f, 0.f, 0.f}; l2g[n] = l1g[n]; l1u[n] = l1g[n]; l2u[n] = l1g[n]; }
#pragma unroll
            for (int m = 0; m < 4; ++m) {
                const int row = row0 + ai * 128 + m * 16;
                v4u wo;
#pragma unroll
                for (int n = 0; n < 2; ++n) {
                    const int cg_ = cg0 + 4 * n;
                    f32x4 sg;
                    { const f32x4 g = acc[ai][0][m][n] * rs[ai][m];
                      if (m == 0 && fr < 2) *(f32x4*)(raw + ((size_t)(row >> 6) * 4 + 2 + fr) * NUP + cg_) = g;
                      if (m == 3 && fr >= 14) *(f32x4*)(raw + ((size_t)(row >> 6) * 4 + (fr - 14)) * NUP + cg_) = g;
                      f32x4 r1, r2, x1, x2;
#pragma unroll
                      for (int j = 0; j < 4; ++j) { r1[j] = dppf<0x121>(g[j]); r2[j] = dppf<0x122>(g[j]); }
#pragma unroll
                      for (int j = 0; j < 4; ++j) { x1[j] = fr == 0 ? l1g[n][j] : r1[j]; x2[j] = fr < 2 ? l2g[n][j] : r2[j]; }
                      l1g[n] = r1; l2g[n] = r2;
                      const f32x4 w0 = wv[n], w1 = wv[8 + n], w2 = wv[16 + n], bb = wv[24 + n];
                      const f32x4 ag = w0 * x2 + w1 * x1 + w2 * g + bb;
#pragma unroll
                      for (int j = 0; j < 4; ++j) sg[j] = silu_(ag[j]);
                      asm volatile("" : "+v"(sg)); }
                    f32x4 o;
                    { const f32x4 up = acc[ai][1][m][n] * rs[ai][m];
                      if (m == 0 && fr < 2) *(f32x4*)(raw + ((size_t)(row >> 6) * 4 + 2 + fr) * NUP + DFF + cg_) = up;
                      if (m == 3 && fr >= 14) *(f32x4*)(raw + ((size_t)(row >> 6) * 4 + (fr - 14)) * NUP + DFF + cg_) = up;
                      f32x4 r1, r2, x1, x2;
#pragma unroll
                      for (int j = 0; j < 4; ++j) { r1[j] = dppf<0x121>(up[j]); r2[j] = dppf<0x122>(up[j]); }
#pragma unroll
                      for (int j = 0; j < 4; ++j) { x1[j] = fr == 0 ? l1u[n][j] : r1[j]; x2[j] = fr < 2 ? l2u[n][j] : r2[j]; }
                      l1u[n] = r1; l2u[n] = r2;
                      const f32x4 w0 = wv[32 + n], w1 = wv[40 + n], w2 = wv[48 + n], bb = wv[56 + n];
                      o = (w0 * x2 + w1 * x1 + w2 * up + bb) * sg; }
                    wo[2 * n] = pk2(o[0], o[1]); wo[2 * n + 1] = pk2(o[2], o[3]); }
                *(v4u*)(act + (size_t)row * DFF + cg0) = wo; } }
    }
};

struct EpiAS {
    static constexpr bool PERM = false, AFTER_DRAIN = false;
    float* as; const float* ss1;
    __device__ __forceinline__ void operator()(const f32x4 (&acc)[2][2][4][2], const Unit& u, int wr, int wc, int fr, int fq) const {
#pragma unroll
        for (int m = 0; m < 4; ++m) { const int s_ = wr * 64 + m * 16 + fr; const float r = __builtin_amdgcn_rsqf(ss1[MP + s_] * (1.0f / D) + EPS);
#pragma unroll
            for (int n = 0; n < 2; ++n) { const int cg_ = u.pn * 128 + wc * 32 + 16 * n + 4 * fq;
                *(f32x4*)(as + (size_t)s_ * NUP + cg_) = acc[0][0][m][n] * r; *(f32x4*)(as + (size_t)s_ * NUP + DFF + cg_) = acc[0][1][m][n] * r; } }
    }
};
struct SampleOrder {
    int idx;
    __device__ __forceinline__ bool next(int i, Unit& u) const { if (i != 0 || idx < 0) return false; u.pm = MP / 256; u.pn = idx; return true; }
    __device__ __forceinline__ void a_ready(const Unit&) const {}
    __device__ __forceinline__ void done(const Unit&) const {}
};

struct ProjOrder {
    int first, nw;
    __device__ __forceinline__ bool next(int i, Unit& u) const { if (first < 0) return false; const int j = first + i * nw; if (j >= (MP / 256 + 1) * (D / 256)) return false; u.pm = j >> 3; u.pn = j & 7; return true; }
    __device__ __forceinline__ void a_ready(const Unit&) const {}
    __device__ __forceinline__ void done(const Unit&) const {}
};
struct EpiResS {
    static constexpr bool PERM = true, AFTER_DRAIN = false;
    const float* xs; bf16* hb; float* ss;
    __device__ __forceinline__ void operator()(const f32x4 (&acc)[2][2][4][2], const Unit& u, int wr, int wc, int fr, int fq) const {
        const int col0 = u.pn * 256 + wc * 32 + 8 * fq;
#pragma unroll
        for (int m = 0; m < 4; ++m) { const int s_ = wr * 64 + m * 16 + fr; float s = 0.f;
#pragma unroll
            for (int bj = 0; bj < 2; ++bj) { const size_t o_ = (size_t)s_ * D + col0 + bj * 128;
                const f32x4 o0 = *(const f32x4*)(xs + o_) + acc[0][bj][m][0], o1 = *(const f32x4*)(xs + o_ + 4) + acc[0][bj][m][1];
                v4u w; w.x = pk2(o0[0], o0[1]); w.y = pk2(o0[2], o0[3]); w.z = pk2(o1[0], o1[1]); w.w = pk2(o1[2], o1[3]); *(v4u*)(hb + o_) = w;
                s += ((o0[0] * o0[0] + o0[1] * o0[1]) + (o0[2] * o0[2] + o0[3] * o0[3])) + ((o1[0] * o1[0] + o1[1] * o1[1]) + (o1[2] * o1[2] + o1[3] * o1[3])); }
            s += __shfl_xor(s, 16); s += __shfl_xor(s, 32);
            if (fq == 0) atomic_addf(ss + s_, s); }
    }
};
template <int RT, int NK>
__device__ __forceinline__ void skinny_batch(f32x4 (&acc)[RT][2], const bf16* ap, const bf16* bp, int K, int as_rt, int as_k) {
    bf16x8 bq[NK][2], aq[NK][RT];
#pragma unroll
    for (int kk = 0; kk < NK; ++kk) { bq[kk][0] = *(const bf16x8*)(bp + 32 * kk); bq[kk][1] = *(const bf16x8*)(bp + (size_t)16 * K + 32 * kk);
#pragma unroll
        for (int rt = 0; rt < RT; ++rt) aq[kk][rt] = *(const bf16x8*)(ap + (size_t)rt * as_rt + (size_t)kk * as_k); }
#pragma unroll
    for (int kk = 0; kk < NK; ++kk)
#pragma unroll
        for (int rt = 0; rt < RT; ++rt) { acc[rt][0] = __builtin_amdgcn_mfma_f32_16x16x32_bf16(bq[kk][0], aq[kk][rt], acc[rt][0], 0, 0, 0); acc[rt][1] = __builtin_amdgcn_mfma_f32_16x16x32_bf16(bq[kk][1], aq[kk][rt], acc[rt][1], 0, 0, 0); }
}
template <int RT, class F>
__device__ __forceinline__ void skinny_gemm(LAS unsigned char* lds, const bf16* A, const bf16* Bt, int N, int K, int u0, int ustride, const F& f) {
    const int tid = threadIdx.x, lane = tid & 63, w = tid >> 6, fr = lane & 15, fq = lane >> 4;
    constexpr int nrb = 8 / RT, ROWS = 16 * RT;
    const int nunits = nrb * (N / 32), kw = K / 8;
    LAS float* red = (LAS float*)lds;
    for (int u = u0; u < nunits; u += ustride) {
        const int rb = u % nrb, cb = u / nrb, row0 = rb * ROWS, col0 = cb * 32;
        f32x4 acc[RT][2];
#pragma unroll
        for (int rt = 0; rt < RT; ++rt) { acc[rt][0] = (f32x4){0.f, 0.f, 0.f, 0.f}; acc[rt][1] = (f32x4){0.f, 0.f, 0.f, 0.f}; }
        const bf16* ap = A + ((size_t)(w * (kw >> 5)) * 128 + row0 + fr) * 32 + 8 * fq; constexpr int as_rt = 512, as_k = 4096;
        const bf16* bp = Bt + (size_t)(col0 + fr) * K + w * kw + 8 * fq;
        if constexpr (RT <= 2) {
            int k = 0;
            if (kw == 704) { skinny_batch<RT, 11>(acc, ap, bp, K, as_rt, as_k); skinny_batch<RT, 11>(acc, ap + (size_t)11 * as_k, bp + 352, K, as_rt, as_k); k = 704; }
            for (; k + 256 <= kw; k += 256) skinny_batch<RT, 8>(acc, ap + (size_t)(k >> 5) * as_k, bp + k, K, as_rt, as_k);
            for (; k < kw; k += 32) skinny_batch<RT, 1>(acc, ap + (size_t)(k >> 5) * as_k, bp + k, K, as_rt, as_k);
        } else {
#pragma unroll 2
        for (int k = 0; k < kw; k += 32) {
            const bf16x8 b0 = *(const bf16x8*)(bp + k), b1 = *(const bf16x8*)(bp + (size_t)16 * K + k);
#pragma unroll
            for (int rt = 0; rt < RT; ++rt) { const bf16x8 av = *(const bf16x8*)(ap + (size_t)rt * as_rt + (size_t)(k >> 5) * as_k);
                acc[rt][0] = __builtin_amdgcn_mfma_f32_16x16x32_bf16(b0, av, acc[rt][0], 0, 0, 0);
                acc[rt][1] = __builtin_amdgcn_mfma_f32_16x16x32_bf16(b1, av, acc[rt][1], 0, 0, 0); }
        }
        }
#pragma unroll
        for (int rt = 0; rt < RT; ++rt)
#pragma unroll
            for (int ct = 0; ct < 2; ++ct) *(LAS f32x4*)(red + (w * ROWS + 16 * rt + fr) * 32 + 16 * ct + 4 * fq) = acc[rt][ct];
        __syncthreads();
#pragma unroll
        for (int it = 0; it < RT; ++it) { const int e = tid + 512 * it, r = e >> 5, c = e & 31; float v = 0.f;
#pragma unroll
            for (int ww = 0; ww < 8; ++ww) v += red[(ww * ROWS + r) * 32 + c];
            f(row0 + r, col0 + c, v); }
        __syncthreads();
    }
}
__device__ __forceinline__ float half_wave_sum(float v) {
#pragma unroll
    for (int o = 1; o < 32; o <<= 1) v += __shfl_xor(v, o);
    return v;
}

__device__ __forceinline__ void transpose_item(const float* W, int K, int N, const float* g, bf16* WT, bool upmap, LAS float* scr, int item, int lane) {
    const int nblk = N / 64, kb = item / nblk, nb = item % nblk, k0 = 64 * kb, n0 = 64 * nb;
    const float* src = W + (size_t)k0 * N + n0 + lane;
#pragma unroll
    for (int h = 0; h < 2; ++h) {
        float v[32];
#pragma unroll
        for (int i = 0; i < 32; ++i) v[i] = __builtin_nontemporal_load(src + (size_t)(32 * h + i) * N);
#pragma unroll
        for (int i = 0; i < 32; ++i) { float x = v[i]; if (g) x *= g[k0 + 32 * h + i]; scr[(32 * h + i) * 65 + lane] = x; }
    }
    LDS_WAIT(); asm volatile("" ::: "memory");
    const int c = lane & 7;
#pragma unroll
    for (int j = 0; j < 8; ++j) { const int n = (lane >> 3) + 8 * j; const LAS float* s = scr + (8 * c) * 65 + n;
        v4u o; o.x = pk2(s[0 * 65], s[1 * 65]); o.y = pk2(s[2 * 65], s[3 * 65]); o.z = pk2(s[4 * 65], s[5 * 65]); o.w = pk2(s[6 * 65], s[7 * 65]);
        int R = n0 + n; if (upmap) { const int half = R >= DFF ? 1 : 0, jj = R - half * DFF; R = 256 * (jj >> 7) + 128 * half + (jj & 127); }
        *(v4u*)(WT + (size_t)R * K + k0 + 8 * c) = o; }
    LDS_WAIT(); asm volatile("" ::: "memory");
}
__device__ __forceinline__ void rms_row_to_bf16(const float* xrow, bf16* orow, float* rinv, int lane) {
    const f32x4* xr = (const f32x4*)xrow + lane;
    f32x4 v[8]; float s = 0.f;
#pragma unroll
    for (int j = 0; j < 8; ++j) { v[j] = __builtin_nontemporal_load(xr + 64 * j);
 s += (v[j][0] * v[j][0] + v[j][1] * v[j][1]) + (v[j][2] * v[j][2] + v[j][3] * v[j][3]); }
    const float ms = wave_sum(s) * (1.0f / D) + EPS, r = __builtin_amdgcn_rsqf(ms);
    if (lane == 0) *rinv = __builtin_sqrtf(ms);
    v2u* o8 = (v2u*)orow + lane;
#pragma unroll
    for (int j = 0; j < 8; ++j) { v2u w; w.x = pk2(v[j][0] * r, v[j][1] * r); w.y = pk2(v[j][2] * r, v[j][3] * r); o8[64 * j] = w; }
}

__device__ __forceinline__ void mm128(f32x4 (&acc)[8], const LAS bf16* A, const LAS bf16* B, int wave, int fr, int fq) {
#pragma unroll
    for (int ks = 0; ks < 4; ++ks) {
        const bf16x8 a = *(const LAS bf16x8*)(A + (16 * wave + fr) * LDP + 32 * ks + 8 * fq);
#pragma unroll
        for (int ct = 0; ct < 8; ++ct) { const bf16x8 b = *(const LAS bf16x8*)(B + (16 * ct + fr) * LDP + 32 * ks + 8 * fq);
            acc[ct] = __builtin_amdgcn_mfma_f32_16x16x32_bf16(b, a, acc[ct], 0, 0, 0); }
    }
}
template <bool TRANS, bool DEC>
__device__ __forceinline__ void stage_rope(LAS bf16* dst, const bf16* zb, const float* rope, float scale, float l2g, int tid) {
#pragma unroll
    for (int it = 0; it < 2; ++it) { const int idx = tid + 512 * it, j = idx >> 3, d8 = idx & 7;
        const v4u x1 = *(const v4u*)(zb + (size_t)j * NIN + 8 * d8), x2 = *(const v4u*)(zb + (size_t)j * NIN + 64 + 8 * d8);
        const f32x4* rp = (const f32x4*)(rope + (size_t)(j * 64 + 8 * d8) * 2);
        float sc = scale; if (DEC) sc *= __builtin_amdgcn_exp2f(l2g * (float)(127 - j));
        float o1[8], o2[8];
#pragma unroll
        for (int p = 0; p < 4; ++p) { const f32x4 cs = rp[p]; const float a0 = lo16(x1[p]), a1 = hi16(x1[p]), b0 = lo16(x2[p]), b1 = hi16(x2[p]);
            o1[2 * p] = (a0 * cs[0] - b0 * cs[1]) * sc; o2[2 * p] = (b0 * cs[0] + a0 * cs[1]) * sc;
            o1[2 * p + 1] = (a1 * cs[2] - b1 * cs[3]) * sc; o2[2 * p + 1] = (b1 * cs[2] + a1 * cs[3]) * sc; }
        if (!TRANS) { v4u w1, w2;
#pragma unroll
            for (int p = 0; p < 4; ++p) { w1[p] = pk2(o1[2 * p], o1[2 * p + 1]); w2[p] = pk2(o2[2 * p], o2[2 * p + 1]); }
            *(LAS v4u*)(dst + j * LDP + 8 * d8) = w1; *(LAS v4u*)(dst + j * LDP + 64 + 8 * d8) = w2; }
        else {
#pragma unroll
            for (int i = 0; i < 8; ++i) { dst[(8 * d8 + i) * LDP + j] = f2bf(o1[i]); dst[(64 + 8 * d8 + i) * LDP + j] = f2bf(o2[i]); } }
    }
}
__device__ __forceinline__ void stage_T(LAS bf16* dst, const bf16* zb, int tid) {
#pragma unroll
    for (int it = 0; it < 4; ++it) { const int idx = tid + 512 * it, j = idx >> 4, c8 = idx & 15;
        const v4u x = *(const v4u*)(zb + (size_t)j * NIN + 8 * c8);
#pragma unroll
        for (int p = 0; p < 4; ++p) { dst[(8 * c8 + 2 * p) * LDP + j] = (bf16)(x[p] & 0xffffu); dst[(8 * c8 + 2 * p + 1) * LDP + j] = (bf16)(x[p] >> 16); } }
}


struct RopeX { v4u x1[2], x2[2]; };
struct RopeCS { f32x4 cs[2][4]; };
struct TileX { v4u x[4]; };
template <bool NT = false> __device__ __forceinline__ void rope_load(RopeX& r, const bf16* zb, int tid) {
#pragma unroll
    for (int it = 0; it < 2; ++it) { const int idx = tid + 512 * it, j = idx >> 3, d8 = idx & 7; const v4u* p1 = (const v4u*)(zb + (size_t)j * NIN + 8 * d8); const v4u* p2 = (const v4u*)(zb + (size_t)j * NIN + 64 + 8 * d8);
        r.x1[it] = NT ? __builtin_nontemporal_load(p1) : *p1; r.x2[it] = NT ? __builtin_nontemporal_load(p2) : *p2; }
}
__device__ __forceinline__ void rope_cs_load(RopeCS& c, const float* rope, int tid) {
#pragma unroll
    for (int it = 0; it < 2; ++it) { const int idx = tid + 512 * it, j = idx >> 3, d8 = idx & 7; const f32x4* rp = (const f32x4*)(rope + (size_t)(j * 64 + 8 * d8) * 2);
#pragma unroll
        for (int p = 0; p < 4; ++p) c.cs[it][p] = rp[p]; }
}
template <bool TRANS, bool DEC>
__device__ __forceinline__ void rope_commit(LAS bf16* dst, const RopeX& r, const RopeCS& c, float scale, float l2g, int tid) {
#pragma unroll
    for (int it = 0; it < 2; ++it) { const int idx = tid + 512 * it, j = idx >> 3, d8 = idx & 7;
        float sc = scale; if (DEC) sc *= __builtin_amdgcn_exp2f(l2g * (float)(127 - j));
        float o1[8], o2[8];
#pragma unroll
        for (int p = 0; p < 4; ++p) { const f32x4 cs = c.cs[it][p]; const float a0 = lo16(r.x1[it][p]), a1 = hi16(r.x1[it][p]), b0 = lo16(r.x2[it][p]), b1 = hi16(r.x2[it][p]);
            o1[2 * p] = (a0 * cs[0] - b0 * cs[1]) * sc; o2[2 * p] = (b0 * cs[0] + a0 * cs[1]) * sc;
            o1[2 * p + 1] = (a1 * cs[2] - b1 * cs[3]) * sc; o2[2 * p + 1] = (b1 * cs[2] + a1 * cs[3]) * sc; }
        if (!TRANS) { v4u w1, w2;
#pragma unroll
            for (int p = 0; p < 4; ++p) { w1[p] = pk2(o1[2 * p], o1[2 * p + 1]); w2[p] = pk2(o2[2 * p], o2[2 * p + 1]); }
            *(LAS v4u*)(dst + j * LDP + 8 * d8) = w1; *(LAS v4u*)(dst + j * LDP + 64 + 8 * d8) = w2; }
        else {
#pragma unroll
            for (int i = 0; i < 8; ++i) { dst[(8 * d8 + i) * LDP + j] = f2bf(o1[i]); dst[(64 + 8 * d8 + i) * LDP + j] = f2bf(o2[i]); } }
    }
}
template <bool NT = false> __device__ __forceinline__ void tile_load(TileX& t, const bf16* zb, int tid) {
#pragma unroll
    for (int it = 0; it < 4; ++it) { const int idx = tid + 512 * it, j = idx >> 4, c8 = idx & 15; const v4u* p = (const v4u*)(zb + (size_t)j * NIN + 8 * c8); t.x[it] = NT ? __builtin_nontemporal_load(p) : *p; }
}
__device__ __forceinline__ void tile_commit_T(LAS bf16* dst, const TileX& t, int tid) {
#pragma unroll
    for (int it = 0; it < 4; ++it) { const int idx = tid + 512 * it, j = idx >> 4, c8 = idx & 15;
#pragma unroll
        for (int p = 0; p < 4; ++p) { dst[(8 * c8 + 2 * p) * LDP + j] = (bf16)(t.x[it][p] & 0xffffu); dst[(8 * c8 + 2 * p + 1) * LDP + j] = (bf16)(t.x[it][p] >> 16); } }
}

typedef short s16x4 __attribute__((ext_vector_type(4)));
__device__ __forceinline__ bf16x8 tr_frag(const LAS bf16* T, int c, int ks, int lane) {
    const int g = lane >> 4, q = (lane & 15) >> 2, p = lane & 3;
    const LAS bf16* a0 = T + (32 * ks + 8 * g + q) * LDP + 16 * c + 4 * p;
    const s16x4 lo = __builtin_amdgcn_ds_read_tr16_b64_v4i16((LAS s16x4*)a0), hi = __builtin_amdgcn_ds_read_tr16_b64_v4i16((LAS s16x4*)(a0 + 4 * LDP));
    return (bf16x8){lo[0], lo[1], lo[2], lo[3], hi[0], hi[1], hi[2], hi[3]};
}
__device__ __forceinline__ void mm128_nt(f32x4 (&acc)[8], const LAS bf16* A, const LAS bf16* B, int wave, int lane) {
    const int fr = lane & 15, fq = lane >> 4;
#pragma unroll
    for (int ks = 0; ks < 4; ++ks) {
        const bf16x8 a = *(const LAS bf16x8*)(A + (16 * wave + fr) * LDP + 32 * ks + 8 * fq);
#pragma unroll
        for (int ct = 0; ct < 8; ++ct) acc[ct] = __builtin_amdgcn_mfma_f32_16x16x32_bf16(tr_frag(B, ct, ks, lane), a, acc[ct], 0, 0, 0);
    }
}
__device__ __forceinline__ void mm128_tt(f32x4 (&acc)[8], const LAS bf16* At, const LAS bf16* Bn, int wave, int lane) {
#pragma unroll
    for (int ks = 0; ks < 4; ++ks) {
        const bf16x8 a = tr_frag(At, wave, ks, lane);
#pragma unroll
        for (int ct = 0; ct < 8; ++ct) acc[ct] = __builtin_amdgcn_mfma_f32_16x16x32_bf16(tr_frag(Bn, ct, ks, lane), a, acc[ct], 0, 0, 0);
    }
}
__device__ __forceinline__ void tile_commit_N(LAS bf16* dst, const TileX& t, int tid) {
#pragma unroll
    for (int it = 0; it < 4; ++it) { const int idx = tid + 512 * it, j = idx >> 4, c8 = idx & 15; *(LAS v4u*)(dst + j * LDP + 8 * c8) = t.x[it]; }
}

__global__ void __launch_bounds__(512, 2) mk_fwd(Params a) {
    extern __shared__ __attribute__((aligned(16))) unsigned char lds_raw[];
    LAS unsigned char* lds = (LAS unsigned char*)lds_raw;
    const int tid = threadIdx.x, lane = tid & 63, wave = __builtin_amdgcn_readfirstlane(tid >> 6), fr = lane & 15, fq = lane >> 4;
    const int G = gridDim.x, blk = blockIdx.x;
    const int gw = blk * 8 + wave, NGW = G * 8;
    const int gt = blk * 512 + tid, NGT = G * 512;
    unsigned char* ws = a.ws;
#define x_p (a.in[0])
#define x_s (a.in[1])
#define p_p (a.in[2])
#define p_s (a.in[3])
#define state_ret (a.in[4])
#define state_conv (a.in[5])
#define gm_ln_g (a.in[8])
#define gm_ln_b (a.in[9])
#define gm_ws (a.in[10])
#define gm_bs (a.in[11])
#define conv_w (a.in[15])
#define conv_b (a.in[16])
#define g_final (a.in[21])
#define out (a.out)
#define SS1 ((float*)(ws + WS_SS1))
#define SS2 ((float*)(ws + WS_SS2))
#define SS3 ((float*)(ws + WS_SS3))
#define STATS ((float*)(ws + WS_STATS))
#define ROPE ((float*)(ws + WS_ROPE))
#define ROPES ((float*)(ws + WS_ROPES))
#define Win_t ((bf16*)(ws + WS_WIN))
#define Wo_t ((bf16*)(ws + WS_WO))
#define Wup_t ((bf16*)(ws + WS_WUP))
#define Wdn_t ((bf16*)(ws + WS_WDN))
#define Wg_t ((bf16*)(ws + WS_WG))
#define Wp_t ((bf16*)(ws + WS_WP))
#define AB ((bf16*)(ws + WS_AB))
#define PB ((bf16*)(ws + WS_PB))
#define MIX ((bf16*)(ws + WS_MIX))
#define Z ((bf16*)(ws + WS_Z))
#define ACT ((bf16*)(ws + WS_ACT))
#define KV ((float*)(ws + WS_KV))
#define PP ((bf16*)(ws + WS_PP))
#define RAW ((float*)(ws + WS_RAW))
#define AS ((float*)(ws + WS_AS))

    volatile LAS unsigned* MISC = (volatile LAS unsigned*)(lds + MISC_OFF);
    if (tid < 64) MISC[tid] = 0u;
    __syncthreads();
    XcdBarrier bar; bar.bar = (unsigned*)(ws + WS_BAR); bar.x = 0; bar.st = nullptr;
    if (MK_N_LAUNCHES == 1) bar = xcd_barrier_post((unsigned*)(ws + WS_BAR), MISC + 8);
    const int lo = a.ph_lo, hi = a.ph_hi;
#ifndef PHMASK
#define PHMASK 0xffff
#endif
#define IN(k) (((PHMASK >> (k)) & 1) && lo <= (k) && (k) < hi)
#define SEAM(k) do { if (IN(k) && IN((k) + 1)) { if (a.use_cg) cg::this_grid().sync(); else xcd_barrier(bar); } } while (0)

    if (IN(0)) {
        LAS float* scr = (LAS float*)(lds + wave * 16640);
        constexpr int I_IN = (D / 64) * (NIN / 64);
        for (int it = gw; it < I_IN; it += NGW) transpose_item(a.in[7], D, NIN, a.in[6], Win_t, false, scr, it, lane);
        for (int m = gw; m < MP; m += NGW) rms_row_to_bf16(x_p + (size_t)m * D, AB + (size_t)m * D, (float*)(ws + WS_RINV) + m, lane);
        for (int sr = gw; sr < MS; sr += NGW) {
            const f32x4* xr = (const f32x4*)(x_s + (size_t)sr * D) + lane; f32x4 v[8]; float ssum = 0.f;
#pragma unroll
            for (int j = 0; j < 8; ++j) { v[j] = xr[64 * j]; ssum += (v[j][0] * v[j][0] + v[j][1] * v[j][1]) + (v[j][2] * v[j][2] + v[j][3] * v[j][3]); }
            const float r = __builtin_amdgcn_rsqf(wave_sum(ssum) * (1.0f / D) + EPS); bf16* af = (bf16*)(ws + WS_AF1);
#pragma unroll
            for (int j = 0; j < 8; ++j) { const int k = 4 * lane + 256 * j; v2u w; w.x = pk2(v[j][0] * r, v[j][1] * r); w.y = pk2(v[j][2] * r, v[j][3] * r); *(v2u*)(af + ((size_t)(k >> 5) * 128 + sr) * 32 + (k & 31)) = w; } }
        for (int i = gt; i < MT * PLE / 4; i += NGT) { const f32x4 v = __builtin_nontemporal_load(i < MP * PLE / 4 ? (const f32x4*)p_p + i : (const f32x4*)p_s + (i - MP * PLE / 4)); v2u w; w.x = pk2(v[0], v[1]); w.y = pk2(v[2], v[3]); ((v2u*)PB)[i] = w; }
        for (int i = gt; i < SEQ * 64 + 64; i += NGT) { const int pos = i < SEQ * 64 ? (i >> 6) : 16384, fi = i & 63;
            const float ang = (float)pos * a.invf[fi]; double t = (double)ang * 0.15915494309189535; t -= __builtin_rint(t); const float rev = (float)t;
            float* dst = i < SEQ * 64 ? ROPE + 2 * (size_t)i : ROPES + 2 * fi; dst[0] = __builtin_amdgcn_cosf(rev); dst[1] = __builtin_amdgcn_sinf(rev); }
        for (int i = gt; i < MT; i += NGT) { SS1[i] = 0.f; SS2[i] = 0.f; SS3[i] = 0.f; }
    }
    SEAM(0);

    if (IN(1)) {
        { pg8::Gemm g{AB, Win_t, MP, NIN, D}; pg8::StaticOrder S; S.init(MP, NIN, G, blk); EpiZ E{Z};
          pg8::gemm_phase<EpiZ, pg8::StaticOrder, true, true>(lds, g, S, E); }
        auto f = [&](int s, int n, float v) { const float o = n < 3072 ? v : (n < 4096 ? silu_(v) : gelu_(v)); Z[(size_t)(MP + s) * NIN + n] = f2bf(o); };
        skinny_gemm<8>(lds, (const bf16*)(ws + WS_AF1), Win_t, NIN, D, blk, G, f);
    }
    SEAM(1);

    if (IN(2)) {
        for (int pass = 0; pass < 2; ++pass) {
        if ((pass ^ (blk & 1)) == 0) {
        { LAS float* qs = (LAS float*)lds; LAS float* ks = qs + 128; LAS float* vs = ks + 128; LAS float* red = vs + 128;
          const int e4 = tid & 31, dg = tid >> 5;
          for (int u = blk; u < MS * NH; u += G) { const int s = u >> 3, h = u & 7; const bf16* zr = Z + (size_t)(MP + s) * NIN;
            const float* S0 = state_ret + (size_t)u * 16384 + 4 * e4; float* S1 = out + O_RETS + (size_t)u * 16384 + 4 * e4;
            f32x4 s0[8];
#pragma unroll
            for (int i = 0; i < 8; ++i) s0[i] = __builtin_nontemporal_load((const f32x4*)(S0 + (dg + 16 * i) * 128));
            if (tid < 64) { const float c = ROPES[2 * tid], sn = ROPES[2 * tid + 1];
                const float q1 = bf2f(zr[128 * h + tid]), q2 = bf2f(zr[128 * h + 64 + tid]), k1 = bf2f(zr[1024 + 128 * h + tid]), k2 = bf2f(zr[1024 + 128 * h + 64 + tid]);
                qs[tid] = q1 * c - q2 * sn; qs[tid + 64] = q2 * c + q1 * sn; ks[tid] = (k1 * c - k2 * sn) * 0.08838834764831845f; ks[tid + 64] = (k2 * c + k1 * sn) * 0.08838834764831845f; }
            else if (tid < 192) vs[tid - 64] = bf2f(zr[2048 + 128 * h + tid - 64]);
            unsigned gg = 0u; if (tid < 64) gg = *(const unsigned*)(zr + 3072 + 128 * h + 2 * tid);
            __syncthreads();
            const float gamma = 1.0f - __builtin_amdgcn_exp2f((float)(-5 - h));
            const f32x4 vv = *(const LAS f32x4*)(vs + 4 * e4); f32x4 o = {0.f, 0.f, 0.f, 0.f};
#pragma unroll
            for (int i = 0; i < 8; ++i) { const int d = dg + 16 * i; const f32x4 sn = s0[i] * gamma + vv * ks[d]; __builtin_nontemporal_store(sn, (f32x4*)(S1 + d * 128)); o += sn * qs[d]; }
            *(LAS f32x4*)(red + dg * 128 + 4 * e4) = o;
            __syncthreads();
            if (tid < 64) { float o0 = 0.f, o1 = 0.f;
#pragma unroll
                for (int i = 0; i < 16; ++i) { o0 += red[i * 128 + 2 * tid]; o1 += red[i * 128 + 2 * tid + 1]; }
                const float r = __builtin_amdgcn_rsqf(wave_sum(o0 * o0 + o1 * o1) * (1.0f / 128.0f) + EPS);
                *(unsigned*)(MIX + (size_t)(MP + s) * D + 128 * h + 2 * tid) = pk2(o0 * r * lo16(gg), o1 * r * hi16(gg)); }
            __syncthreads(); } }
        } else {
        { LAS bf16* Kt = (LAS bf16*)lds; LAS bf16* Vt = (LAS bf16*)(lds + TILE_B);
          for (int u = blk; u < 512; u += G) { const int b = u >> 7, h = (u >> 4) & 7, c = u & 15; const size_t R0 = (size_t)b * SEQ + 128 * c;
            RopeX kx; RopeCS cs; TileX vx;
            rope_load(kx, Z + R0 * NIN + 1024 + 128 * h, tid); rope_cs_load(cs, ROPE + (size_t)(128 * c) * 128, tid); tile_load(vx, Z + R0 * NIN + 2048 + 128 * h, tid);
            rope_commit<false, true>(Kt, kx, cs, 0.08838834764831845f, a.log2g[h], tid);
            tile_commit_N(Vt, vx, tid);
            __syncthreads();
            f32x4 acc[8];
#pragma unroll
            for (int ct = 0; ct < 8; ++ct) acc[ct] = (f32x4){0.f, 0.f, 0.f, 0.f};
            mm128_tt(acc, Kt, Vt, wave, lane);
            float* kv = KV + (size_t)u * 16384 + (16 * wave + fr) * 128 + 4 * fq;
#pragma unroll
            for (int ct = 0; ct < 8; ++ct) *(f32x4*)(kv + 16 * ct) = acc[ct];
            __syncthreads(); } }
        for (int r0 = gw; r0 < MP; r0 += 2 * NGW) { const int r1 = r0 + NGW;
            const bf16* p0 = Z + (size_t)r0 * NIN + 5120 + 16 * lane; const bf16* p1 = Z + (size_t)(r1 < MP ? r1 : r0) * NIN + 5120 + 16 * lane;
            const v4u xa0 = *(const v4u*)p0, xa1 = *(const v4u*)(p0 + 8), xb0 = *(const v4u*)p1, xb1 = *(const v4u*)(p1 + 8);
            float va[16], vb[16];
#pragma unroll
            for (int j = 0; j < 4; ++j) { va[2 * j] = lo16(xa0[j]); va[2 * j + 1] = hi16(xa0[j]); va[8 + 2 * j] = lo16(xa1[j]); va[8 + 2 * j + 1] = hi16(xa1[j]);
                                          vb[2 * j] = lo16(xb0[j]); vb[2 * j + 1] = hi16(xb0[j]); vb[8 + 2 * j] = lo16(xb1[j]); vb[8 + 2 * j + 1] = hi16(xb1[j]); }
            float sa = 0.f, sb = 0.f;
#pragma unroll
            for (int j = 0; j < 16; ++j) { sa += va[j]; sb += vb[j]; }
            const float ma = wave_sum(sa) * (1.0f / 1024.0f), mb = wave_sum(sb) * (1.0f / 1024.0f); float qa = 0.f, qb = 0.f;
#pragma unroll
            for (int j = 0; j < 16; ++j) { const float da = va[j] - ma, db = vb[j] - mb; qa += da * da; qb += db * db; }
            const float ra = __builtin_amdgcn_rsqf(wave_sum(qa) * (1.0f / 1024.0f) + EPS), rb = __builtin_amdgcn_rsqf(wave_sum(qb) * (1.0f / 1024.0f) + EPS);
            if (lane == 0) { STATS[2 * r0] = ma; STATS[2 * r0 + 1] = ra; if (r1 < MP) { STATS[2 * r1] = mb; STATS[2 * r1 + 1] = rb; } } }
        for (int row = MP + gw; row < MT; row += NGW) { const bf16* p = Z + (size_t)row * NIN + 5120 + 16 * lane; const v4u x0 = *(const v4u*)p, x1 = *(const v4u*)(p + 8);
            const int s_ = row - MP, c0 = 16 * lane, grp = lane >> 3; const float w00 = gm_ws[grp * 16384], b0 = gm_bs[grp * 128];
            const bf16* up = Z + (size_t)row * NIN + 4096 + c0; const v4u u0 = *(const v4u*)up, u1 = *(const v4u*)(up + 8);
            float v[16];
#pragma unroll
            for (int j = 0; j < 4; ++j) { v[2 * j] = lo16(x0[j]); v[2 * j + 1] = hi16(x0[j]); v[8 + 2 * j] = lo16(x1[j]); v[8 + 2 * j + 1] = hi16(x1[j]); }
            float s = 0.f;
#pragma unroll
            for (int j = 0; j < 16; ++j) s += v[j];
            const float mean = wave_sum(s) * (1.0f / 1024.0f); float q = 0.f;
#pragma unroll
            for (int j = 0; j < 16; ++j) { v[j] -= mean; q += v[j] * v[j]; }
            const float rstd = __builtin_amdgcn_rsqf(wave_sum(q) * (1.0f / 1024.0f) + EPS);
            float uu[16];
#pragma unroll
            for (int j = 0; j < 4; ++j) { uu[2 * j] = lo16(u0[j]); uu[2 * j + 1] = hi16(u0[j]); uu[8 + 2 * j] = lo16(u1[j]); uu[8 + 2 * j + 1] = hi16(u1[j]); }
            float vn[16], mo[16];
#pragma unroll
            for (int j = 0; j < 16; ++j) { vn[j] = v[j] * rstd * gm_ln_g[c0 + j] + gm_ln_b[c0 + j]; mo[j] = uu[j] * (w00 * vn[j] + b0); }
            float* gv = out + O_GMV + (size_t)s_ * 1024 + c0;
#pragma unroll
            for (int j = 0; j < 4; ++j) *(f32x4*)(gv + 4 * j) = (f32x4){vn[4 * j], vn[4 * j + 1], vn[4 * j + 2], vn[4 * j + 3]};
            v4u w0, w1;
#pragma unroll
            for (int j = 0; j < 4; ++j) { w0[j] = pk2(mo[2 * j], mo[2 * j + 1]); w1[j] = pk2(mo[8 + 2 * j], mo[8 + 2 * j + 1]); }
            bf16* mp = MIX + (size_t)row * D + 1024 + c0; *(v4u*)mp = w0; *(v4u*)(mp + 8) = w1; }
        } }
    }
    SEAM(2);

    if (IN(3)) {
        auto convert_rest = [&]() {
            LAS float* scr = (LAS float*)(lds + wave * 16640);
            constexpr int I_O = (D / 64) * (D / 64), I_UP = (D / 64) * (NUP / 64), I_DN = (DFF / 64) * (D / 64), I_G = I_O, I_P = (PLE / 64) * (D / 64);
            constexpr int NITEMS = I_O + I_UP + I_DN + I_G + I_P;
            for (int it = gw; it < NITEMS; it += NGW) {
                int r = it;
                if (r < I_UP) { transpose_item(a.in[14], D, NUP, a.in[13], Wup_t, true, scr, r, lane); continue; } r -= I_UP;
                if (r < I_O) { transpose_item(a.in[12], D, D, nullptr, Wo_t, false, scr, r, lane); continue; } r -= I_O;
                if (r < I_DN) { transpose_item(a.in[17], DFF, D, nullptr, Wdn_t, false, scr, r, lane); continue; } r -= I_DN;
                if (r < I_G) { transpose_item(a.in[19], D, D, a.in[18], Wg_t, false, scr, r, lane); continue; } r -= I_G;
                transpose_item(a.in[20], PLE, D, nullptr, Wp_t, false, scr, r, lane);
            }
            __syncthreads(); };
        if (!(blk & 1)) convert_rest();
        {
        LAS bf16* T0 = (LAS bf16*)lds; LAS bf16* T1 = (LAS bf16*)(lds + TILE_B); LAS bf16* T2 = (LAS bf16*)(lds + 2 * TILE_B); LAS bf16* T3 = (LAS bf16*)(lds + 3 * TILE_B);
        for (int u = blk; u < 512; u += G) { const int bh = u >> 4, b = bh >> 3, h = bh & 7, c = u < 256 ? (u & 15) : 15 - (u & 15); const size_t R0 = (size_t)b * SEQ + 128 * c; const float l2g = a.log2g[h];
            const int i_ = 16 * wave + fr;
            RopeX qx, kx; RopeCS cs; TileX vx; v2u gg[8];
            const float* kvb = KV + (size_t)bh * 16 * 16384;
            f32x4 tc[8];
#pragma unroll
            for (int i = 0; i < 8; ++i) tc[i] = *(const f32x4*)(kvb + 4 * (tid + 512 * i));
            rope_load<true>(qx, Z + R0 * NIN + 128 * h, tid); rope_load<true>(kx, Z + R0 * NIN + 1024 + 128 * h, tid); rope_cs_load(cs, ROPE + (size_t)(128 * c) * 128, tid); tile_load<true>(vx, Z + R0 * NIN + 2048 + 128 * h, tid);
            rope_commit<false, false>(T0, qx, cs, 1.0f, 0.f, tid);
            rope_commit<false, false>(T1, kx, cs, 0.08838834764831845f, 0.f, tid);
            asm volatile("" ::: "memory");
            { const float Gc = __builtin_amdgcn_exp2f(l2g * 128.0f);
              f32x4 sp[8];
#pragma unroll
              for (int i = 0; i < 8; ++i) sp[i] = (f32x4){0.f, 0.f, 0.f, 0.f};
              for (int j = 0; j < c; ++j) { f32x4 tn[8];
#pragma unroll
                  for (int i = 0; i < 8; ++i) tn[i] = *(const f32x4*)(kvb + (size_t)(j + 1) * 16384 + 4 * (tid + 512 * i));
#pragma unroll
                  for (int i = 0; i < 8; ++i) { sp[i] = sp[i] * Gc + tc[i]; tc[i] = tn[i]; } }
              if (c == 15) {
#pragma unroll
                  for (int i = 0; i < 8; ++i) *(f32x4*)(out + O_RETP + (size_t)bh * 16384 + 4 * (tid + 512 * i)) = sp[i] * Gc + tc[i]; }
#pragma unroll
              for (int i = 0; i < 8; ++i) { const int ch = tid + 512 * i, d = ch >> 5, e4 = ch & 31; v2u w; w.x = pk2(sp[i][0], sp[i][1]); w.y = pk2(sp[i][2], sp[i][3]);
                  *(LAS v2u*)(T3 + d * LDP + 4 * e4) = w; } }
            tile_commit_N(T2, vx, tid);
            __syncthreads();
            { const bf16* gp = Z + (R0 + i_) * NIN + 3072 + 128 * h + 4 * fq;
#pragma unroll
              for (int ct = 0; ct < 8; ++ct) gg[ct] = __builtin_nontemporal_load((const v2u*)(gp + 16 * ct)); }
            f32x4 acc2[8], acc1[8];
#pragma unroll
            for (int ct = 0; ct < 8; ++ct) { acc2[ct] = (f32x4){0.f, 0.f, 0.f, 0.f}; acc1[ct] = (f32x4){0.f, 0.f, 0.f, 0.f}; }
            mm128_nt(acc2, T0, T3, wave, lane);
            mm128(acc1, T0, T1, wave, fr, fq);
            __syncthreads();
#pragma unroll
            for (int ct = 0; ct < 8; ++ct) { float sv[4];
#pragma unroll
                for (int t = 0; t < 4; ++t) { const int j = 16 * ct + 4 * fq + t; sv[t] = i_ >= j ? acc1[ct][t] * __builtin_amdgcn_exp2f(l2g * (float)(i_ - j)) : 0.f; }
                v2u w; w.x = pk2(sv[0], sv[1]); w.y = pk2(sv[2], sv[3]); *(LAS v2u*)(T1 + i_ * LDP + 16 * ct + 4 * fq) = w; }
            __syncthreads();
#pragma unroll
            for (int ct = 0; ct < 8; ++ct) acc1[ct] = (f32x4){0.f, 0.f, 0.f, 0.f};
            mm128_nt(acc1, T1, T2, wave, lane);
            const float qd = __builtin_amdgcn_exp2f(l2g * (float)(i_ + 1)); float ssq = 0.f;
#pragma unroll
            for (int ct = 0; ct < 8; ++ct) { acc1[ct] = acc1[ct] + acc2[ct] * qd; ssq += (acc1[ct][0] * acc1[ct][0] + acc1[ct][1] * acc1[ct][1]) + (acc1[ct][2] * acc1[ct][2] + acc1[ct][3] * acc1[ct][3]); }
            ssq += __shfl_xor(ssq, 16); ssq += __shfl_xor(ssq, 32);
            const float rn = __builtin_amdgcn_rsqf(ssq * (1.0f / 128.0f) + EPS);
            bf16* mp = MIX + (R0 + i_) * D + 128 * h + 4 * fq;
#pragma unroll
            for (int ct = 0; ct < 8; ++ct) { v2u w;
                w.x = pk2(acc1[ct][0] * rn * lo16(gg[ct].x), acc1[ct][1] * rn * hi16(gg[ct].x)); w.y = pk2(acc1[ct][2] * rn * lo16(gg[ct].y), acc1[ct][3] * rn * hi16(gg[ct].y)); *(v2u*)(mp + 16 * ct) = w; }
            __syncthreads(); }
        for (int u = blk; u < 512; u += G) { const int b = u >> 7, c = (u >> 3) & 15, grp = u & 7; const size_t R0 = (size_t)b * SEQ + 128 * c;
            const int t_ = 16 * wave + fr, d8 = tid & 15;
            f32x4 wl[4][2]; v4u xv[4]; float st[4][2]; v2u uu[8]; float lg[8], lb[8];
#pragma unroll
            for (int it = 0; it < 4; ++it) { const int idx = tid + 512 * it, t = idx >> 4; const float* wp = gm_ws + (size_t)grp * 16384 + t * 128 + 8 * d8;
                wl[it][0] = *(const f32x4*)wp; wl[it][1] = *(const f32x4*)(wp + 4);
                xv[it] = __builtin_nontemporal_load((const v4u*)(Z + (R0 + t) * NIN + 5120 + 128 * grp + 8 * d8)); st[it][0] = STATS[2 * (R0 + t)]; st[it][1] = STATS[2 * (R0 + t) + 1]; }
#pragma unroll
            for (int j = 0; j < 8; ++j) { lg[j] = gm_ln_g[128 * grp + 8 * d8 + j]; lb[j] = gm_ln_b[128 * grp + 8 * d8 + j]; }
            const float bsv = gm_bs[grp * 128 + t_];
#pragma unroll
            for (int it = 0; it < 4; ++it) { const int idx = tid + 512 * it, t = idx >> 4;
                float wv[8] = {wl[it][0][0], wl[it][0][1], wl[it][0][2], wl[it][0][3], wl[it][1][0], wl[it][1][1], wl[it][1][2], wl[it][1][3]};
#pragma unroll
                for (int j = 0; j < 8; ++j) if (8 * d8 + j > t) wv[j] = 0.f;
                v4u w; w.x = pk2(wv[0], wv[1]); w.y = pk2(wv[2], wv[3]); w.z = pk2(wv[4], wv[5]); w.w = pk2(wv[6], wv[7]); *(LAS v4u*)(T0 + t * LDP + 8 * d8) = w;
                const float mean = st[it][0], rstd = st[it][1];
                v4u vw;
#pragma unroll
                for (int p = 0; p < 4; ++p) vw[p] = pk2((lo16(xv[it][p]) - mean) * rstd * lg[2 * p] + lb[2 * p], (hi16(xv[it][p]) - mean) * rstd * lg[2 * p + 1] + lb[2 * p + 1]);
                *(LAS v4u*)(T1 + t * LDP + 8 * d8) = vw; }
            __syncthreads();
            { const bf16* up = Z + (R0 + t_) * NIN + 4096 + 128 * grp + 4 * fq;
#pragma unroll
              for (int ct = 0; ct < 8; ++ct) uu[ct] = __builtin_nontemporal_load((const v2u*)(up + 16 * ct)); }
            f32x4 acc[8];
#pragma unroll
            for (int ct = 0; ct < 8; ++ct) acc[ct] = (f32x4){0.f, 0.f, 0.f, 0.f};
            mm128_nt(acc, T0, T1, wave, lane);
            bf16* mp = MIX + (R0 + t_) * D + 1024 + 128 * grp + 4 * fq;
#pragma unroll
            for (int ct = 0; ct < 8; ++ct) { v2u w;
                w.x = pk2((acc[ct][0] + bsv) * lo16(uu[ct].x), (acc[ct][1] + bsv) * hi16(uu[ct].x)); w.y = pk2((acc[ct][2] + bsv) * lo16(uu[ct].y), (acc[ct][3] + bsv) * hi16(uu[ct].y)); *(v2u*)(mp + 16 * ct) = w; }
            __syncthreads(); }
        }
        if (blk & 1) convert_rest();
    }
    SEAM(3);

    if (IN(4)) {
        { pg8::Gemm g{MIX, Wo_t, MP, D, D}; pg8::StaticOrder S; S.init(MP, D, G, blk); EpiRes<2> E{(const float*)(ws + WS_RINV), nullptr, AB, SS1};
          pg8::gemm_phase<EpiRes<2>, pg8::StaticOrder, true, true>(lds, g, S, E); }
    }
    SEAM(4);

    if (IN(5)) {
        unsigned* p3s_cnt = (unsigned*)(ws + WS_BAR) + 3584;
        if (blk >= 248) {
            { pg8::Gemm g{MIX, Wo_t, MP + 256, D, D}; SampleOrder S{blk - 248}; EpiResS E{x_s, AB + (size_t)MP * D, SS1 + MP};
              pg8::gemm_phase<EpiResS, SampleOrder, true, true>(lds, g, S, E); }
            asm volatile("s_waitcnt vmcnt(0)" ::: "memory"); __syncthreads();
            if (tid == 0) { __builtin_amdgcn_fence(__ATOMIC_RELEASE, "agent"); asm volatile("s_waitcnt vmcnt(0)" ::: "memory"); (void)__hip_atomic_fetch_add(p3s_cnt, 1u, __ATOMIC_RELAXED, __HIP_MEMORY_SCOPE_AGENT); }
        }
        { pg8::Gemm g{AB, Wup_t, MP, NUP, D}; pg8::StaticOrder S; S.init(MP, NUP, G, blk); EpiUp E{ACT, RAW, SS1, conv_w, conv_b, (LAS float*)(lds + 131072)};
          pg8::gemm_phase<EpiUp, pg8::StaticOrder, true, true>(lds, g, S, E); }
        if (blk >= 128 && blk - 128 < NUP / 256) {
            if (tid == 0) { unsigned spins = 0; while (__hip_atomic_load(p3s_cnt, __ATOMIC_RELAXED, __HIP_MEMORY_SCOPE_AGENT) < 8u) { __builtin_amdgcn_s_sleep(4); if (++spins > (1u << 22)) break; } }
            __syncthreads();
            __builtin_amdgcn_fence(__ATOMIC_ACQUIRE, "agent"); asm volatile("s_waitcnt vmcnt(0)" ::: "memory"); }
        { pg8::Gemm g{AB, Wup_t, MP + 256, NUP, D}; SampleOrder S{(blk >= 128 && blk - 128 < NUP / 256) ? blk - 128 : -1}; EpiAS E{AS, SS1};
          pg8::gemm_phase<EpiAS, SampleOrder, true, true>(lds, g, S, E); }
        { int Kp = PLE; asm volatile("" : "+s"(Kp));
          constexpr int nbusy = (MP / 256 * (NUP / 256) + NUP / 256) - 5 * 256;
          pg8::Gemm g{PB, Wp_t, MP + 256, D, Kp}; ProjOrder S{(blk >= nbusy && blk < 248) ? blk - nbusy : -1, 248 - nbusy}; EpiPP E{PP};
          pg8::gemm_phase<EpiPP, ProjOrder, true, true>(lds, g, S, E); }
    }
    SEAM(5);

    if (IN(6)) {
        for (int i = gt; i < 128 * 2 * (DFF / 4); i += NGT) { const int c4 = i % (DFF / 4), gr = i / (DFF / 4), rr = gr & 1, Gp = gr >> 1, c = 4 * c4; const bool first = (Gp & 31) == 0;
            const float* rg = RAW + (size_t)Gp * 4 * NUP; const float* rp = rg - 4 * NUP; const f32x4 z4 = {0.f, 0.f, 0.f, 0.f};
            f32x4 a0g, a0u, a1g, a1u, a2g, a2u;
            a0g = *(const f32x4*)(rg + (2 + rr) * NUP + c); a0u = *(const f32x4*)(rg + (2 + rr) * NUP + DFF + c);
            if (rr) { a1g = *(const f32x4*)(rg + 2 * NUP + c); a1u = *(const f32x4*)(rg + 2 * NUP + DFF + c); a2g = first ? z4 : *(const f32x4*)(rp + NUP + c); a2u = first ? z4 : *(const f32x4*)(rp + NUP + DFF + c); }
            else { a1g = first ? z4 : *(const f32x4*)(rp + NUP + c); a1u = first ? z4 : *(const f32x4*)(rp + NUP + DFF + c); a2g = first ? z4 : *(const f32x4*)(rp + c); a2u = first ? z4 : *(const f32x4*)(rp + DFF + c); }
            const f32x4 ag = *(const f32x4*)(conv_w + c) * a2g + *(const f32x4*)(conv_w + NUP + c) * a1g + *(const f32x4*)(conv_w + 2 * NUP + c) * a0g + *(const f32x4*)(conv_b + c);
            const f32x4 au = *(const f32x4*)(conv_w + DFF + c) * a2u + *(const f32x4*)(conv_w + NUP + DFF + c) * a1u + *(const f32x4*)(conv_w + 2 * NUP + DFF + c) * a0u + *(const f32x4*)(conv_b + DFF + c);
            v2u w; w.x = pk2(silu_(ag[0]) * au[0], silu_(ag[1]) * au[1]); w.y = pk2(silu_(ag[2]) * au[2], silu_(ag[3]) * au[3]);
            *(v2u*)(ACT + (size_t)(64 * Gp + rr) * DFF + c) = w; }
        for (int i = gt; i < MS * (DFF / 4); i += NGT) { const int c4 = i % (DFF / 4), s = i / (DFF / 4), c = 4 * c4;
            const float* sc0 = state_conv + (size_t)s * 2 * NUP; const float* sc1 = sc0 + NUP; const float* as = AS + (size_t)s * NUP;
            const f32x4 a0g = *(const f32x4*)(as + c), a0u = *(const f32x4*)(as + DFF + c), a1g = *(const f32x4*)(sc1 + c), a1u = *(const f32x4*)(sc1 + DFF + c), a2g = *(const f32x4*)(sc0 + c), a2u = *(const f32x4*)(sc0 + DFF + c);
            const f32x4 ag = *(const f32x4*)(conv_w + c) * a2g + *(const f32x4*)(conv_w + NUP + c) * a1g + *(const f32x4*)(conv_w + 2 * NUP + c) * a0g + *(const f32x4*)(conv_b + c);
            const f32x4 au = *(const f32x4*)(conv_w + DFF + c) * a2u + *(const f32x4*)(conv_w + NUP + DFF + c) * a1u + *(const f32x4*)(conv_w + 2 * NUP + DFF + c) * a0u + *(const f32x4*)(conv_b + DFF + c);
            v2u w; w.x = pk2(silu_(ag[0]) * au[0], silu_(ag[1]) * au[1]); w.y = pk2(silu_(ag[2]) * au[2], silu_(ag[3]) * au[3]);
            *(v2u*)((bf16*)(ws + WS_AF6) + ((size_t)(c >> 5) * 128 + s) * 32 + (c & 31)) = w;
            float* cs = out + O_CONVS + (size_t)s * 2 * NUP; *(f32x4*)(cs + c) = a1g; *(f32x4*)(cs + DFF + c) = a1u; *(f32x4*)(cs + NUP + c) = a0g; *(f32x4*)(cs + NUP + DFF + c) = a0u; }
        for (int i = gt; i < 4 * 2 * (NUP / 4); i += NGT) { const int c4 = i % (NUP / 4), bk = i / (NUP / 4), b = bk >> 1, k = bk & 1;
            *(f32x4*)(out + O_CONVP + (size_t)bk * NUP + 4 * c4) = *(const f32x4*)(RAW + ((size_t)(32 * b + 31) * 4 + k) * NUP + 4 * c4); }
    }
    SEAM(6);

    if (IN(7)) {
        { pg8::Gemm g{ACT, Wdn_t, MP, D, DFF}; pg8::StaticOrder S; S.init(MP, D, G, blk); EpiRes<1> E{nullptr, nullptr, AB, SS2};
          pg8::gemm_phase<EpiRes<1>, pg8::StaticOrder, true, true>(lds, g, S, E); }
        auto f = [&](int s, int n, float v) { const size_t o_ = (size_t)(MP + s) * D + n; const float o = bf2f(AB[o_]) + v; ((bf16*)(ws + WS_AF7))[((size_t)(n >> 5) * 128 + s) * 32 + (n & 31)] = f2bf(o);
            const float q = half_wave_sum(o * o); if ((lane & 31) == 0) atomic_addf(SS2 + MP + s, q); };
        skinny_gemm<2>(lds, (const bf16*)(ws + WS_AF6), Wdn_t, D, DFF, blk, G, f);
    }
    SEAM(7);

    if (IN(8)) {
#ifndef T_B
        { pg8::Gemm g{AB, Wg_t, MP, D, D}; pg8::StaticOrder S; S.init(MP, D, G, blk); EpiGate E{PP, AB, out, SS2, SS3};
          pg8::gemm_phase<EpiGate, pg8::StaticOrder, true, true>(lds, g, S, E); }
#endif
#ifndef T_D
        auto f2 = [&](int s, int n, float v) { const size_t o_ = (size_t)(MP + s) * D + n; const float r2 = __builtin_amdgcn_rsqf(SS2[MP + s] * (1.0f / D) + EPS);
            const float o = bf2f(((const bf16*)(ws + WS_AF7))[((size_t)(n >> 5) * 128 + s) * 32 + (n & 31)]) + bf2f(PP[o_]) * sigmoid_(r2 * v); out[o_] = o; const float q = half_wave_sum(o * o); if ((lane & 31) == 0) atomic_addf(SS3 + MP + s, q); };
        skinny_gemm<2>(lds, (const bf16*)(ws + WS_AF7), Wg_t, D, D, blk, G, f2);
#endif
    }
    SEAM(8);

    if (IN(9)) {
        { const f32x4* gr = (const f32x4*)g_final + lane; f32x4 gv[8];
#pragma unroll
          for (int j = 0; j < 8; ++j) gv[j] = gr[64 * j];
          for (int m0 = gw; m0 < MT; m0 += 2 * NGW) { const int m1 = m0 + NGW; const bool two = m1 < MT;
            f32x4* h0 = (f32x4*)(out + (size_t)m0 * D) + lane; f32x4* h1 = (f32x4*)(out + (size_t)(two ? m1 : m0) * D) + lane;
            f32x4 a0[8], a1[8];
#pragma unroll
            for (int j = 0; j < 8; ++j) { a0[j] = h0[64 * j]; a1[j] = h1[64 * j]; }
            const float r0 = __builtin_amdgcn_rsqf(SS3[m0] * (1.0f / D) + EPS), r1 = __builtin_amdgcn_rsqf(SS3[two ? m1 : m0] * (1.0f / D) + EPS);
#pragma unroll
            for (int j = 0; j < 8; ++j) __builtin_nontemporal_store(a0[j] * gv[j] * r0, h0 + 64 * j);
            if (two) {
#pragma unroll
                for (int j = 0; j < 8; ++j) __builtin_nontemporal_store(a1[j] * gv[j] * r1, h1 + 64 * j); } } }
    }
#undef IN
#undef SEAM
}
#undef x_p
#undef x_s
#undef p_p
#undef p_s
#undef state_ret
#undef state_conv
#undef gm_ln_g
#undef gm_ln_b
#undef gm_ws
#undef gm_bs
#undef conv_w
#undef conv_b
#undef g_final
#undef out
#undef SS1
#undef SS2
#undef SS3
#undef STATS
#undef ROPE
#undef ROPES
#undef Win_t
#undef Wo_t
#undef Wup_t
#undef Wdn_t
#undef Wg_t
#undef Wp_t
#undef AB
#undef PB
#undef MIX
#undef Z
#undef ACT
#undef KV
#undef PP
#undef RAW
#undef AS

extern "C" void kernel_launch(void* const* d_in, const int* in_sizes, int n_in, void* d_out, int out_size, void* d_ws, size_t ws_size, hipStream_t stream) {
    static int grid = 0;
    if (grid == 0) {
        if (n_in != 22 || out_size != (int)O_END || ws_size < WS_END) { fprintf(stderr, "kernel_launch: unexpected shapes: n_in %d out %d ws %zu\n", n_in, out_size, ws_size); grid = -1; return; }
        int dev = 0, cus = 0, per_cu = 0;
        if (hipGetDevice(&dev) != hipSuccess || hipDeviceGetAttribute(&cus, hipDeviceAttributeMultiprocessorCount, dev) != hipSuccess) { grid = -1; return; }
        if (hipFuncSetAttribute((const void*)mk_fwd, hipFuncAttributeMaxDynamicSharedMemorySize, LDS_BYTES) != hipSuccess) { fprintf(stderr, "kernel_launch: hipFuncSetAttribute failed\n"); grid = -1; return; }
        if (hipOccupancyMaxActiveBlocksPerMultiprocessor(&per_cu, (const void*)mk_fwd, 512, LDS_BYTES) != hipSuccess || per_cu < 1) fprintf(stderr, "kernel_launch: occupancy query says %d\n", per_cu);
        (void)hipGetLastError();
        grid = cus;
        if (grid != 256) fprintf(stderr, "kernel_launch: %d CUs (built for 256)\n", grid);
    }
    if (grid < 0) return;
    if (hipMemsetAsync((char*)d_ws + WS_BAR, 0, BAR_BYTES, stream) != hipSuccess) { fprintf(stderr, "kernel_launch: memset failed\n"); return; }
    Params p{};
    for (int i = 0; i < 22; ++i) p.in[i] = (const float*)d_in[i];
    p.out = (float*)d_out; p.ws = (unsigned char*)d_ws;
    for (int h = 0; h < 8; ++h) p.log2g[h] = (float)std::log2(1.0 - std::exp2(-5.0 - (double)h));
    for (int i = 0; i < 64; ++i) p.invf[i] = powf(10000.0f, -(float)i / 64.0f);
    p.use_cg = 0; p.pad = 0;
#if MK_N_LAUNCHES == 1
    void* args[] = {&p};
#ifdef PROBE_K
    p.ph_lo = 0; p.ph_hi = PROBE_K + 1;
    (void)hipLaunchCooperativeKernel((const void*)mk_fwd, dim3(grid), dim3(512), args, LDS_BYTES, stream);
    if (hipMemsetAsync((char*)d_ws + WS_BAR, 0, BAR_BYTES, stream) != hipSuccess) return;
#endif
    p.ph_lo = 0; p.ph_hi = NPHASE;
    hipError_t e = hipLaunchCooperativeKernel((const void*)mk_fwd, dim3(grid), dim3(512), args, LDS_BYTES, stream);
    if (e != hipSuccess) fprintf(stderr, "kernel_launch: cooperative launch failed: %s\n", hipGetErrorString(e));
#else
    for (int ph = 0; ph < NPHASE; ++ph) { p.ph_lo = ph; p.ph_hi = ph + 1; hipLaunchKernelGGL(mk_fwd, dim3(grid), dim3(512), LDS_BYTES, stream, p); }
#endif
}
```

```cpp
#include <hip/hip_runtime.h>
#include <hip/hip_cooperative_groups.h>
#include <cstdio>
#include <cstdint>
#include <cmath>
namespace cg = cooperative_groups;

#ifndef MK_N_LAUNCHES
#define MK_N_LAUNCHES 1
#endif

namespace pg8 {
#define PG8_LAS __attribute__((address_space(3)))
typedef unsigned short bf16_t;
typedef short bf16x8 __attribute__((ext_vector_type(8)));
typedef float f32x4 __attribute__((ext_vector_type(4)));
typedef unsigned u32x4 __attribute__((ext_vector_type(4)));
constexpr int BM = 256, BK = 64, HALF = 128, HTB = HALF * BK * 2  , STAGE_BYTES = 8 * HTB, NXCD = 8, WGM = 8;

__host__ __device__ __forceinline__ int lds_byte(int r, int c) { const int st = (r >> 4) * 2 + (c >> 5), rr = r & 15, cc = c & 31, ob = rr * 64 + cc * 2; return st * 1024 + (ob ^ (((ob >> 9) & 1) << 5)); }
__host__ __device__ __forceinline__ void stage_rc(int b, int& R, int& C) { const int st = b / 1024, sb = b % 1024, swz = sb ^ (((sb >> 9) & 1) << 5); R = (st >> 1) * 16 + swz / 64; C = (st & 1) * 32 + (swz % 64) / 2; }
__host__ __device__ __forceinline__ int perm32(int rho) { const int n = rho >> 4, i = rho & 15; return 8 * (i >> 2) + 4 * n + (i & 3); }

struct Unit { int pm, pn; };
struct Gemm { const bf16_t* A; const bf16_t* Bt; int M, N, K; int ld = 0; };

struct StaticOrder {
    int nM, nN, nwg, G, c;
    __host__ __device__ void init(int M, int N, int G_, int c_) { nM = M / BM; nN = N / BM; nwg = nM * nN; G = G_; c = c_; }
    __host__ __device__ bool next(int i, Unit& u) const {
        const long L = (long)i * G + c; if (L >= nwg) return false;
        int wgid = (int)L; { const int q = nwg / NXCD, r = nwg % NXCD, xcd = wgid % NXCD, off = wgid / NXCD; wgid = (xcd < r ? xcd * (q + 1) : r * (q + 1) + (xcd - r) * q) + off; }
        const int nig = WGM * nN, gid = wgid / nig, fm = gid * WGM, gsz = (nM - fm) < WGM ? (nM - fm) : WGM;
        u.pm = fm + ((wgid % nig) % gsz); u.pn = (wgid % nig) / gsz; return true;
    }
    __device__ __forceinline__ void a_ready(const Unit&) const {}
    __device__ __forceinline__ void done(const Unit&) const {}
};

__device__ __forceinline__ unsigned cvt_pk_bf16(float lo, float hi) { unsigned r; asm volatile("v_cvt_pk_bf16_f32 %0, %1, %2" : "=v"(r) : "v"(lo), "v"(hi)); return r; }
typedef float f32x2 __attribute__((ext_vector_type(2)));

template <class Epi, class Sched, bool ALIGN_EPI = false, bool SP2 = false>
__device__ __forceinline__ void gemm_phase(PG8_LAS unsigned char* lds, const Gemm g, const Sched& S, const Epi& E) {
    const int tid = threadIdx.x, wid = __builtin_amdgcn_readfirstlane(tid >> 6), lane = tid & 63, wr = wid >> 2, wc = wid & 3, fr = lane & 15, fq = lane >> 4;
    const int K = g.K, nt = K / BK, LD = g.ld ? g.ld : g.K;
    unsigned voffA[2], voffB[2];
#pragma unroll
    for (int i = 0; i < 2; ++i) { int R, C; stage_rc(tid * 16 + i * 8192, R, C); const int Rb = Epi::PERM ? ((R & ~31) + perm32(R & 31)) : R;
        voffA[i] = (unsigned)(R * LD + C) * 2u; voffB[i] = (unsigned)(Rb * LD + C) * 2u; }
    const size_t kstep = (size_t)(BK * 2);
    const size_t hstep = (size_t)HALF * LD * 2;
    const size_t tstep = 2 * hstep;
    const unsigned ldsw = (unsigned)wid * 1024u;
    const int aoff = lds_byte(wr * 64 + fr, fq * 8), boff = lds_byte(wc * 32 + fr, fq * 8);
#define PG8_SA(b, h) (((b) * 2 + (h)) * HTB)
#define PG8_SB(b, h) ((4 + (b) * 2 + (h)) * HTB)
#define PG8_STAGE(bufoff, gbase, voff) do { _Pragma("unroll") for (int _i = 0; _i < 2; ++_i) \
        __builtin_amdgcn_global_load_lds((const unsigned*)((const char*)(gbase) + (voff)[_i]), (PG8_LAS unsigned*)(lds + (bufoff) + ldsw + _i * 8192), 16, 0, 0); } while (0)
#define PG8_LDA(dst, b, h) do { _Pragma("unroll") for (int m = 0; m < 4; ++m) _Pragma("unroll") for (int k = 0; k < 2; ++k) dst[m][k] = *(const PG8_LAS bf16x8*)(lds + PG8_SA(b, h) + aoff + m * 2048 + k * 1024); } while (0)
#define PG8_LDB(dst, b, h) do { _Pragma("unroll") for (int n = 0; n < 2; ++n) _Pragma("unroll") for (int k = 0; k < 2; ++k) dst[n][k] = *(const PG8_LAS bf16x8*)(lds + PG8_SB(b, h) + boff + n * 2048 + k * 1024); } while (0)
#define PG8_MMA(ai, bj, At, Bt) do { __builtin_amdgcn_s_setprio(1); _Pragma("unroll") for (int m = 0; m < 4; ++m) _Pragma("unroll") for (int n = 0; n < 2; ++n) _Pragma("unroll") for (int k = 0; k < 2; ++k) \
        acc[ai][bj][m][n] = __builtin_amdgcn_mfma_f32_16x16x32_bf16(Bt[n][k], At[m][k], acc[ai][bj][m][n], 0, 0, 0); __builtin_amdgcn_s_setprio(0); } while (0)
#define PG8_WAIT_V(n) asm volatile("s_waitcnt vmcnt(" #n ")" ::: "memory")
#define PG8_WAIT_L(n) asm volatile("s_waitcnt lgkmcnt(" #n ")" ::: "memory")
#define PG8_BAR __builtin_amdgcn_s_barrier()
#define PG8_SCHED __builtin_amdgcn_sched_barrier(0)
    Unit cur, nxt; int ui = 0;
    if (!S.next(0, cur)) return;
    f32x4 acc[2][2][4][2];
#pragma unroll
    for (int a = 0; a < 2; ++a)
#pragma unroll
        for (int b = 0; b < 2; ++b)
#pragma unroll
            for (int m = 0; m < 4; ++m)
#pragma unroll
                for (int n = 0; n < 2; ++n) acc[a][b][m][n] = (f32x4){0.f, 0.f, 0.f, 0.f};
    bf16x8 At[4][2], B0[2][2], B1[2][2];
    const char* cA = (const char*)g.A + (size_t)cur.pm * tstep; const char* cB = (const char*)g.Bt + (size_t)cur.pn * tstep;
    S.a_ready(cur);
    if constexpr (SP2) {
        PG8_STAGE(PG8_SB(0, 0), cB, voffB); PG8_STAGE(PG8_SB(0, 1), cB + hstep, voffB); PG8_STAGE(PG8_SA(0, 0), cA, voffA); PG8_STAGE(PG8_SA(0, 1), cA + hstep, voffA);
        if (wr == 1) PG8_BAR;
        PG8_WAIT_V(2); PG8_BAR;
        PG8_STAGE(PG8_SB(1, 0), cB + kstep, voffB); PG8_STAGE(PG8_SA(1, 0), cA + kstep, voffA); PG8_STAGE(PG8_SB(1, 1), cB + hstep + kstep, voffB);
        PG8_WAIT_V(6); PG8_BAR;
    } else {
        PG8_STAGE(PG8_SB(0, 0), cB, voffB); PG8_STAGE(PG8_SA(0, 0), cA, voffA); PG8_STAGE(PG8_SB(0, 1), cB + hstep, voffB); PG8_STAGE(PG8_SA(0, 1), cA + hstep, voffA);
        if (wr == 1) PG8_BAR;
        PG8_WAIT_V(4); PG8_BAR;
        PG8_STAGE(PG8_SB(1, 0), cB + kstep, voffB); PG8_STAGE(PG8_SA(1, 0), cA + kstep, voffA); PG8_STAGE(PG8_SB(1, 1), cB + hstep + kstep, voffB);
        PG8_WAIT_V(6); PG8_BAR;
    }
    for (;;) {
        const bool has_next = S.next(ui + 1, nxt);
        const char* nA = has_next ? (const char*)g.A + (size_t)nxt.pm * tstep : cA; const char* nB = has_next ? (const char*)g.Bt + (size_t)nxt.pn * tstep : cB;
        for (int t = 0; t < nt; t += 2) {
            const bool last = (t == nt - 2);
            const char* a1 = cA + (size_t)(t + 1) * kstep;
            const char* a2 = last ? nA : cA + (size_t)(t + 2) * kstep; const char* b2 = last ? nB : cB + (size_t)(t + 2) * kstep;
            const char* a3 = a2 + kstep; const char* b3 = b2 + kstep;
            if (last && has_next) S.a_ready(nxt);
            if constexpr (SP2) {
            PG8_LDB(B0, 0, 0); PG8_LDB(B1, 0, 1); PG8_SCHED; PG8_LDA(At, 0, 0); PG8_STAGE(PG8_SA(1, 1), a1 + hstep, voffA);
            PG8_WAIT_V(8); PG8_WAIT_L(0); PG8_BAR; PG8_MMA(0, 0, At, B0); PG8_MMA(0, 1, At, B1); PG8_BAR; PG8_SCHED;
            PG8_LDA(At, 0, 1); PG8_STAGE(PG8_SB(0, 0), b2, voffB); PG8_STAGE(PG8_SB(0, 1), b2 + hstep, voffB); PG8_STAGE(PG8_SA(0, 0), a2, voffA);
            PG8_WAIT_V(8); PG8_WAIT_L(0); PG8_BAR; PG8_MMA(1, 0, At, B0); PG8_MMA(1, 1, At, B1); PG8_BAR; PG8_SCHED;
            PG8_LDB(B0, 1, 0); PG8_LDB(B1, 1, 1); PG8_SCHED; PG8_LDA(At, 1, 0); PG8_STAGE(PG8_SA(0, 1), a2 + hstep, voffA);
            PG8_WAIT_V(8); PG8_WAIT_L(0); PG8_BAR; PG8_MMA(0, 0, At, B0); PG8_MMA(0, 1, At, B1); PG8_BAR; PG8_SCHED;
            PG8_LDA(At, 1, 1); PG8_STAGE(PG8_SB(1, 0), b3, voffB); PG8_STAGE(PG8_SB(1, 1), b3 + hstep, voffB); PG8_STAGE(PG8_SA(1, 0), a3, voffA);
            PG8_WAIT_V(8); PG8_WAIT_L(0); PG8_BAR; PG8_MMA(1, 0, At, B0); PG8_MMA(1, 1, At, B1); PG8_BAR; PG8_SCHED;
            } else {
            PG8_LDB(B0, 0, 0); PG8_SCHED; PG8_LDA(At, 0, 0); PG8_STAGE(PG8_SA(1, 1), a1 + hstep, voffA);
            PG8_WAIT_L(8); PG8_BAR; PG8_WAIT_L(0); PG8_MMA(0, 0, At, B0); PG8_BAR; PG8_SCHED;
            PG8_LDB(B1, 0, 1); PG8_STAGE(PG8_SB(0, 0), b2, voffB);
            PG8_BAR; PG8_WAIT_L(0); PG8_MMA(0, 1, At, B1); PG8_BAR;
            PG8_LDA(At, 0, 1); PG8_STAGE(PG8_SA(0, 0), a2, voffA);
            PG8_BAR; PG8_WAIT_L(0); PG8_MMA(1, 0, At, B0); PG8_BAR; PG8_SCHED;
            PG8_STAGE(PG8_SB(0, 1), b2 + hstep, voffB);
            PG8_WAIT_V(6); PG8_BAR; PG8_MMA(1, 1, At, B1); PG8_BAR;
            PG8_LDB(B0, 1, 0); PG8_SCHED; PG8_LDA(At, 1, 0); PG8_STAGE(PG8_SA(0, 1), a2 + hstep, voffA);
            PG8_WAIT_L(8); PG8_BAR; PG8_WAIT_L(0); PG8_MMA(0, 0, At, B0); PG8_BAR; PG8_SCHED;
            PG8_LDB(B1, 1, 1); PG8_STAGE(PG8_SB(1, 0), b3, voffB);
            PG8_BAR; PG8_WAIT_L(0); PG8_MMA(0, 1, At, B1); PG8_BAR;
            PG8_LDA(At, 1, 1); PG8_STAGE(PG8_SA(1, 0), a3, voffA);
            PG8_BAR; PG8_WAIT_L(0); PG8_MMA(1, 0, At, B0); PG8_BAR; PG8_SCHED;
            PG8_STAGE(PG8_SB(1, 1), b3 + hstep, voffB);
            PG8_WAIT_V(6); PG8_BAR; PG8_MMA(1, 1, At, B1); PG8_BAR;
            }
        }
        if constexpr (ALIGN_EPI) { if (wr == 0) PG8_BAR; }
        if constexpr (!Epi::AFTER_DRAIN) { E(acc, cur, wr, wc, fr, fq); S.done(cur); }
        if (!has_next) break;
#pragma unroll
        for (int a = 0; a < 2; ++a)
#pragma unroll
            for (int b = 0; b < 2; ++b)
#pragma unroll
                for (int m = 0; m < 4; ++m)
#pragma unroll
                    for (int n = 0; n < 2; ++n) acc[a][b][m][n] = (f32x4){0.f, 0.f, 0.f, 0.f};
        cur = nxt; cA = nA; cB = nB; ++ui;
        if constexpr (ALIGN_EPI) { if (wr == 1) PG8_BAR; }
    }
    PG8_WAIT_V(0);
    if constexpr (!ALIGN_EPI) { if (wr == 0) PG8_BAR; }
    PG8_BAR;
    if constexpr (Epi::AFTER_DRAIN) { E.fused(acc, cur, wr, wc, fr, fq, lds, wid, lane); S.done(cur); }
#undef PG8_SA
#undef PG8_SB
#undef PG8_STAGE
#undef PG8_LDA
#undef PG8_LDB
#undef PG8_MMA
#undef PG8_WAIT_V
#undef PG8_WAIT_L
#undef PG8_BAR
#undef PG8_SCHED
}
}

#define GAS __attribute__((address_space(1)))
#define LAS __attribute__((address_space(3)))
typedef unsigned short bf16;
typedef unsigned v4u __attribute__((ext_vector_type(4)));
typedef unsigned v2u __attribute__((ext_vector_type(2)));
typedef float f32x4 __attribute__((ext_vector_type(4)));
typedef float f32x2 __attribute__((ext_vector_type(2)));
typedef short bf16x8 __attribute__((ext_vector_type(8)));
#define XB_TMO      128
#define XB_XCNT(j)  (256  + 64 * (j))
#define XB_XSUB(j)  (1280 + 64 * (j))
#define XB_XGEN(j)  (2304 + 64 * (j))
#define XB_TOP      3328
#define XB_TOPGEN   3392
#define XCD_BAR_WORDS 3456
#define XB_SPIN_CAP (1u << 18)

__device__ __forceinline__ unsigned xb_ld(unsigned* p)              { return __hip_atomic_load(p, __ATOMIC_RELAXED, __HIP_MEMORY_SCOPE_AGENT); }
__device__ __forceinline__ unsigned xb_add(unsigned* p, unsigned v) { return __hip_atomic_fetch_add(p, v, __ATOMIC_RELAXED, __HIP_MEMORY_SCOPE_AGENT); }
__device__ __forceinline__ unsigned xb_xcc_id() { return (unsigned)__builtin_amdgcn_s_getreg((3 << 11) | 20) & 0xFu; }
#define XB_SPIN(cond, bar) do { unsigned _sp = 0; while (cond) { __builtin_amdgcn_s_sleep(1); \
    if ((++_sp & 255u) == 0u) { if (xb_ld(&(bar)[XB_TMO])) break; if (_sp > XB_SPIN_CAP) { atomicAdd(&(bar)[XB_TMO], 1u); break; } } } } while (0)

struct XcdBarrier {
    unsigned* bar; unsigned x;
    volatile LAS unsigned* st;
};

__device__ __forceinline__ XcdBarrier xcd_barrier_post(unsigned* bar, volatile LAS unsigned* st) {
    XcdBarrier b; b.bar = bar; b.x = xb_xcc_id(); b.st = st;
    if (threadIdx.x == 0) (void)xb_add(&bar[XB_XCNT(b.x)], 1u);
    return b;
}
__device__ __forceinline__ void xcd_barrier_complete(unsigned* bar, unsigned x, unsigned& nloc, unsigned& nx) {
    const unsigned G = gridDim.x * gridDim.y * gridDim.z;
    unsigned sum, cnt, mine, sp = 0u;
    for (;;) {
        sum = 0u; cnt = 0u; mine = 0u;
#pragma unroll
        for (unsigned j = 0; j < 16; ++j) { const unsigned c = xb_ld(&bar[XB_XCNT(j)]); sum += c; cnt += (c > 0u) ? 1u : 0u; mine = (j == x) ? c : mine; }
        if (sum == G) break;
        __builtin_amdgcn_s_sleep(1);
        if ((++sp & 255u) == 0u) { if (xb_ld(&bar[XB_TMO])) break; if (sp > XB_SPIN_CAP) { atomicAdd(&bar[XB_TMO], 1u); break; } }
    }
    nloc = mine > 0u ? mine : 1u; nx = cnt > 0u ? cnt : 1u;
}

__device__ __forceinline__ void xcd_barrier(const XcdBarrier& b) {
    asm volatile("s_waitcnt vmcnt(0)" ::: "memory");
    __syncthreads();
    if (threadIdx.x == 0) {
        unsigned* bar = b.bar;
        __builtin_amdgcn_s_waitcnt(0);
        unsigned nloc = b.st[0], nx = b.st[1];
        if (nloc == 0u) { xcd_barrier_complete(bar, b.x, nloc, nx); b.st[0] = nloc; b.st[1] = nx; }
        const unsigned old = xb_add(&bar[XB_XSUB(b.x)], 1u);
        const unsigned gen = old / nloc;
        if (old + 1u == (gen + 1u) * nloc) {
            __builtin_amdgcn_fence(__ATOMIC_RELEASE, "agent");
            asm volatile("s_waitcnt vmcnt(0)" ::: "memory");
            const unsigned og = xb_add(&bar[XB_TOP], 1u);
            const unsigned tg = og / nx;
            if (og + 1u == (tg + 1u) * nx) xb_add(&bar[XB_TOPGEN], 1u);
            else XB_SPIN(xb_ld(&bar[XB_TOPGEN]) == tg, bar);
            __builtin_amdgcn_fence(__ATOMIC_ACQUIRE, "agent");
            xb_add(&bar[XB_XGEN(b.x)], 1u);
            asm volatile("s_waitcnt vmcnt(0)" ::: "memory");
        } else {
            XB_SPIN(xb_ld(&bar[XB_XGEN(b.x)]) == gen, bar);
            __builtin_amdgcn_fence(__ATOMIC_ACQUIRE, "agent");
            asm volatile("s_waitcnt vmcnt(0)" ::: "memory");
        }
    }
    __syncthreads();
}

constexpr int MP = 8192, MS = 128, MT = MP + MS, D = 2048, NIN = 6144, NUP = 11264, DFF = 5632, PLE = 256, SEQ = 2048, NH = 8;
constexpr float EPS = 1e-6f;
constexpr int NPHASE = 10;
constexpr size_t MiB = 1u << 20;
constexpr size_t WS_BAR = 0, BAR_BYTES = 16384;
constexpr size_t WS_SS1 = 64 * 1024, WS_SS2 = 128 * 1024, WS_SS3 = 192 * 1024, WS_STATS = 256 * 1024;
constexpr size_t WS_RINV = 384 * 1024;
constexpr size_t WS_ROPE = 1 * MiB, WS_ROPES = 2 * MiB;
constexpr size_t WS_WIN = 4 * MiB, WS_WO = 28 * MiB, WS_WUP = 36 * MiB, WS_WDN = 80 * MiB, WS_WG = 102 * MiB, WS_WP = 110 * MiB;
constexpr size_t WS_AB = 112 * MiB, WS_PB = 145 * MiB, WS_MIX = 150 * MiB, WS_Z = 183 * MiB, WS_ACT = 183 * MiB, WS_KV = 281 * MiB, WS_PP = 281 * MiB;
constexpr size_t WS_RAW = 314 * MiB, WS_AS = 336 * MiB, WS_AF1 = 342 * MiB, WS_AF6 = 343 * MiB, WS_AF7 = 345 * MiB, WS_END = 346 * MiB;
static_assert(WS_AB + (size_t)MT * D * 2 <= WS_PB && WS_PB + (size_t)MT * PLE * 2 <= WS_MIX && WS_MIX + (size_t)MT * D * 2 <= WS_Z, "ws map 1");
static_assert(WS_Z + (size_t)MT * NIN * 2 <= WS_KV && WS_ACT + (size_t)MT * DFF * 2 <= WS_KV && WS_KV + (size_t)512 * 16384 * 4 <= WS_RAW, "ws map 2");
static_assert(WS_RAW + (size_t)128 * 4 * NUP * 4 <= WS_AS && WS_AS + (size_t)MS * NUP * 4 <= WS_END && WS_PP + (size_t)MT * D * 2 <= WS_RAW, "ws map 3");
constexpr size_t O_RETP = 17039360, O_CONVP = 17563648, O_RETS = 17653760, O_CONVS = 34430976, O_GMV = 37314560, O_END = 37445632;
constexpr int LDS_BYTES = 147456, MISC_OFF = LDS_BYTES - 256;
constexpr int LDP = 136;
constexpr int TILE_B = 128 * LDP * 2;

__device__ unsigned g_sync[4096 + 64];
struct Params { const float* in[22]; float* out; unsigned char* ws; float log2g[8]; float invf[64]; int ph_lo, ph_hi, use_cg, pad; };

#define LDS_WAIT() asm volatile("s_waitcnt lgkmcnt(0)" ::: "memory")
__device__ __forceinline__ float lo16(unsigned u) { return __uint_as_float(u << 16); }
__device__ __forceinline__ float hi16(unsigned u) { return __uint_as_float(u & 0xffff0000u); }
__device__ __forceinline__ float bf2f(bf16 b) { return __uint_as_float((unsigned)b << 16); }
__device__ __forceinline__ unsigned pk2(float lo, float hi) { return pg8::cvt_pk_bf16(lo, hi); }
__device__ __forceinline__ bf16 f2bf(float f) { return (bf16)(pg8::cvt_pk_bf16(f, 0.f) & 0xffffu); }
__device__ __forceinline__ float sigmoid_(float x) { return __builtin_amdgcn_rcpf(1.0f + __builtin_amdgcn_exp2f(-1.44269504089f * x)); }
__device__ __forceinline__ float silu_(float x) { return x * sigmoid_(x); }
__device__ __forceinline__ float gelu_(float x) { return x * sigmoid_(1.5957691216f * (x + 0.044715f * x * x * x)); }
__device__ __forceinline__ float wave_sum(float v) {
#pragma unroll
    for (int o = 1; o < 64; o <<= 1) v += __shfl_xor(v, o);
    return v;
}
__device__ __forceinline__ void atomic_addf(float* p, float v) { (void)__hip_atomic_fetch_add(p, v, __ATOMIC_RELAXED, __HIP_MEMORY_SCOPE_AGENT); }
template <int CTRL> __device__ __forceinline__ float dppf(float x) { return __int_as_float(__builtin_amdgcn_mov_dpp(__float_as_int(x), CTRL, 0xf, 0xf, false)); }

using pg8::Unit;
struct EpiZ {
    static constexpr bool PERM = true, AFTER_DRAIN = false;
    bf16* Z;
    __device__ __forceinline__ void operator()(const f32x4 (&acc)[2][2][4][2], const Unit& u, int wr, int wc, int fr, int fq) const {
        const int row0 = u.pm * 256 + wr * 64 + fr, col0 = u.pn * 256 + wc * 32 + 8 * fq;
        const int mode = u.pn < 12 ? 0 : (u.pn < 16 ? 1 : 2);
#pragma unroll
        for (int ai = 0; ai < 2; ++ai)
#pragma unroll
            for (int m = 0; m < 4; ++m) { bf16* rowp = Z + (size_t)(row0 + ai * 128 + m * 16) * NIN + col0;
#pragma unroll
                for (int bj = 0; bj < 2; ++bj) { f32x4 v0 = acc[ai][bj][m][0], v1 = acc[ai][bj][m][1];
                    if (mode == 1) {
#pragma unroll
                        for (int j = 0; j < 4; ++j) { v0[j] = silu_(v0[j]); v1[j] = silu_(v1[j]); } }
                    else if (mode == 2) {
#pragma unroll
                        for (int j = 0; j < 4; ++j) { v0[j] = gelu_(v0[j]); v1[j] = gelu_(v1[j]); } }
                    v4u w; w.x = pk2(v0[0], v0[1]); w.y = pk2(v0[2], v0[3]); w.z = pk2(v1[0], v1[1]); w.w = pk2(v1[2], v1[3]);
                    *(v4u*)(rowp + bj * 128) = w; } }
    }
};
template <int BASE_BF16> struct EpiRes {
    const float* rowscale;
    static constexpr bool PERM = true, AFTER_DRAIN = false;
    const float* base; bf16* hb; float* ss;
    __device__ __forceinline__ void operator()(const f32x4 (&acc)[2][2][4][2], const Unit& u, int wr, int wc, int fr, int fq) const {
        const int row0 = u.pm * 256 + wr * 64 + fr, col0 = u.pn * 256 + wc * 32 + 8 * fq;
        float sacc[2][4];
#pragma unroll
        for (int ai = 0; ai < 2; ++ai) {
            f32x4 bs[BASE_BF16 ? 1 : 4][2][2]; v4u bw[4][2]; float rsc[4];
#pragma unroll
            for (int m = 0; m < 4; ++m) { rsc[m] = BASE_BF16 == 2 ? rowscale[row0 + ai * 128 + m * 16] : 1.0f;
#pragma unroll
                for (int bj = 0; bj < 2; ++bj) { const size_t o_ = (size_t)(row0 + ai * 128 + m * 16) * D + col0 + bj * 128;
                    if (BASE_BF16) bw[m][bj] = *(const v4u*)(hb + o_);
                    else { bs[m][bj][0] = *(const f32x4*)(base + o_); bs[m][bj][1] = *(const f32x4*)(base + o_ + 4); } } }
#pragma unroll
            for (int m = 0; m < 4; ++m) { const size_t off = (size_t)(row0 + ai * 128 + m * 16) * D + col0; float s = 0.f;
#pragma unroll
                for (int bj = 0; bj < 2; ++bj) { f32x4 b0, b1;
                    if (BASE_BF16) { const v4u w = bw[m][bj]; b0 = (f32x4){lo16(w.x), hi16(w.x), lo16(w.y), hi16(w.y)}; b1 = (f32x4){lo16(w.z), hi16(w.z), lo16(w.w), hi16(w.w)};
                        if (BASE_BF16 == 2) { b0 *= rsc[m]; b1 *= rsc[m]; } }
                    else { b0 = bs[m][bj][0]; b1 = bs[m][bj][1]; }
                    const f32x4 o0 = b0 + acc[ai][bj][m][0], o1 = b1 + acc[ai][bj][m][1];
                    v4u w; w.x = pk2(o0[0], o0[1]); w.y = pk2(o0[2], o0[3]); w.z = pk2(o1[0], o1[1]); w.w = pk2(o1[2], o1[3]); *(v4u*)(hb + off + bj * 128) = w;
                    s += ((o0[0] * o0[0] + o0[1] * o0[1]) + (o0[2] * o0[2] + o0[3] * o0[3])) + ((o1[0] * o1[0] + o1[1] * o1[1]) + (o1[2] * o1[2] + o1[3] * o1[3])); }
                s += __shfl_xor(s, 16); s += __shfl_xor(s, 32); sacc[ai][m] = s; }
            asm volatile("" ::: "memory"); }
        if (fq == 0) {
#pragma unroll
            for (int ai = 0; ai < 2; ++ai)
#pragma unroll
                for (int m = 0; m < 4; ++m) atomic_addf(ss + row0 + ai * 128 + m * 16, sacc[ai][m]); }
    }
};
struct EpiPP {
    static constexpr bool PERM = true, AFTER_DRAIN = false;
    bf16* pp;
    __device__ __forceinline__ void operator()(const f32x4 (&acc)[2][2][4][2], const Unit& u, int wr, int wc, int fr, int fq) const {
        const int row0 = u.pm * 256 + wr * 64 + fr, col0 = u.pn * 256 + wc * 32 + 8 * fq;
#pragma unroll
        for (int ai = 0; ai < 2; ++ai)
#pragma unroll
            for (int m = 0; m < 4; ++m) { if (row0 + ai * 128 + m * 16 >= MT) continue; bf16* rowp = pp + (size_t)(row0 + ai * 128 + m * 16) * D + col0;
#pragma unroll
                for (int bj = 0; bj < 2; ++bj) { const f32x4 v0 = acc[ai][bj][m][0], v1 = acc[ai][bj][m][1]; v4u w; w.x = pk2(v0[0], v0[1]); w.y = pk2(v0[2], v0[3]); w.z = pk2(v1[0], v1[1]); w.w = pk2(v1[2], v1[3]); *(v4u*)(rowp + bj * 128) = w; } }
    }
};
struct EpiGate {
    static constexpr bool PERM = true, AFTER_DRAIN = false;
    const bf16* pp; const bf16* hb; float* h; const float* ss2; float* ss3;
    __device__ __forceinline__ void operator()(const f32x4 (&acc)[2][2][4][2], const Unit& u, int wr, int wc, int fr, int fq) const {
        const int row0 = u.pm * 256 + wr * 64 + fr, col0 = u.pn * 256 + wc * 32 + 8 * fq;
        float sacc[2][4];
#pragma unroll
        for (int ai = 0; ai < 2; ++ai) {
            v4u hw[4][2], pw[4][2]; float r2[4];
#pragma unroll
            for (int m = 0; m < 4; ++m) { const int row = row0 + ai * 128 + m * 16; r2[m] = ss2[row];
#pragma unroll
                for (int bj = 0; bj < 2; ++bj) { hw[m][bj] = *(const v4u*)(hb + (size_t)row * D + col0 + bj * 128); pw[m][bj] = *(const v4u*)(pp + (size_t)row * D + col0 + bj * 128); } }
#pragma unroll
            for (int m = 0; m < 4; ++m) { const size_t off = (size_t)(row0 + ai * 128 + m * 16) * D + col0; float s = 0.f;
                const float rr = __builtin_amdgcn_rsqf(r2[m] * (1.0f / D) + EPS);
#pragma unroll
                for (int bj = 0; bj < 2; ++bj) { const v4u h4 = hw[m][bj], p4 = pw[m][bj];
                    const f32x4 hv0 = {lo16(h4.x), hi16(h4.x), lo16(h4.y), hi16(h4.y)}, hv1 = {lo16(h4.z), hi16(h4.z), lo16(h4.w), hi16(h4.w)};
                    const f32x4 pv0 = {lo16(p4.x), hi16(p4.x), lo16(p4.y), hi16(p4.y)}, pv1 = {lo16(p4.z), hi16(p4.z), lo16(p4.w), hi16(p4.w)};
                    const f32x4 a0 = acc[ai][bj][m][0], a1 = acc[ai][bj][m][1]; f32x4 o0, o1;
#pragma unroll
                    for (int j = 0; j < 4; ++j) { o0[j] = hv0[j] + pv0[j] * sigmoid_(rr * a0[j]); o1[j] = hv1[j] + pv1[j] * sigmoid_(rr * a1[j]); }
                    *(f32x4*)(h + off + bj * 128) = o0; *(f32x4*)(h + off + bj * 128 + 4) = o1;
                    s += ((o0[0] * o0[0] + o0[1] * o0[1]) + (o0[2] * o0[2] + o0[3] * o0[3])) + ((o1[0] * o1[0] + o1[1] * o1[1]) + (o1[2] * o1[2] + o1[3] * o1[3])); }
                s += __shfl_xor(s, 16); s += __shfl_xor(s, 32); sacc[ai][m] = s; }
            asm volatile("" ::: "memory"); }
        if (fq == 0) {
#pragma unroll
            for (int ai = 0; ai < 2; ++ai)
#pragma unroll
                for (int m = 0; m < 4; ++m) atomic_addf(ss3 + row0 + ai * 128 + m * 16, sacc[ai][m]); }
    }
};
struct EpiUp {
    static constexpr bool PERM = true, AFTER_DRAIN = false;
    bf16* act; float* raw; const float* ss1; const float* cw; const float* cb; LAS float* wl;
    __device__ __forceinline__ void operator()(const f32x4 (&acc)[2][2][4][2], const Unit& u, int wr, int wc, int fr, int fq) const {
        const int row0 = u.pm * 256 + wr * 64 + fr;
        LAS float* wb = wl + (wr * 4 + wc) * 256;
        { const int l = fq * 16 + fr, v = l >> 3, c4 = l & 7;
          const float* src = ((v & 3) == 3 ? cb : cw + (v & 3) * NUP) + (v >> 2) * DFF + u.pn * 128 + wc * 32 + 4 * c4;
          *(LAS f32x4*)(wb + v * 32 + 4 * c4) = *(const f32x4*)src; }
        float rs[2][4];
#pragma unroll
        for (int ai = 0; ai < 2; ++ai)
#pragma unroll
            for (int m = 0; m < 4; ++m) rs[ai][m] = __builtin_amdgcn_rsqf(ss1[row0 + ai * 128 + m * 16] * (1.0f / D) + EPS);
        const int cg0 = u.pn * 128 + wc * 32 + 8 * fq;
        const volatile LAS f32x4* wv = (const volatile LAS f32x4*)(wb + 8 * fq);
#pragma unroll
        for (int ai = 0; ai < 2; ++ai) {
            f32x4 l1g[2], l2g[2], l1u[2], l2u[2];
#pragma unroll
            for (int n = 0; n < 2; ++n) { l1g[n] = (f32x4){0.f, 0.f, 0.f, 0.f}; l2g[n] = l1g[n]; l1u[n] = l1g[n]; l2u[n] = l1g[n]; }
#pragma unroll
            for (int m = 0; m < 4; ++m) {
                const int row = row0 + ai * 128 + m * 16;
                v4u wo;
#pragma unroll
                for (int n = 0; n < 2; ++n) {
                    const int cg_ = cg0 + 4 * n;
                    f32x4 sg;
                    { const f32x4 g = acc[ai][0][m][n] * rs[ai][m];
                      if (m == 0 && fr < 2) *(f32x4*)(raw + ((size_t)(row >> 6) * 4 + 2 + fr) * NUP + cg_) = g;
                      if (m == 3 && fr >= 14) *(f32x4*)(raw + ((size_t)(row >> 6) * 4 + (fr - 14)) * NUP + cg_) = g;
                      f32x4 r1, r2, x1, x2;
#pragma unroll
                      for (int j = 0; j < 4; ++j) { r1[j] = dppf<0x121>(g[j]); r2[j] = dppf<0x122>(g[j]); }
#pragma unroll
                      for (int j = 0; j < 4; ++j) { x1[j] = fr == 0 ? l1g[n][j] : r1[j]; x2[j] = fr < 2 ? l2g[n][j] : r2[j]; }
                      l1g[n] = r1; l2g[n] = r2;
                      const f32x4 w0 = wv[n], w1 = wv[8 + n], w2 = wv[16 + n], bb = wv[24 + n];
                      const f32x4 ag = w0 * x2 + w1 * x1 + w2 * g + bb;
#pragma unroll
                      for (int j = 0; j < 4; ++j) sg[j] = silu_(ag[j]);
                      asm volatile("" : "+v"(sg)); }
                    f32x4 o;
                    { const f32x4 up = acc[ai][1][m][n] * rs[ai][m];
                      if (m == 0 && fr < 2) *(f32x4*)(raw + ((size_t)(row >> 6) * 4 + 2 + fr) * NUP + DFF + cg_) = up;
                      if (m == 3 && fr >= 14) *(f32x4*)(raw + ((size_t)(row >> 6) * 4 + (fr - 14)) * NUP + DFF + cg_) = up;
                      f32x4 r1, r2, x1, x2;
#pragma unroll
                      for (int j = 0; j < 4; ++j) { r1[j] = dppf<0x121>(up[j]); r2[j] = dppf<0x122>(up[j]); }
#pragma unroll
                      for (int j = 0; j < 4; ++j) { x1[j] = fr == 0 ? l1u[n][j] : r1[j]; x2[j] = fr < 2 ? l2u[n][j] : r2[j]; }
                      l1u[n] = r1; l2u[n] = r2;
                      const f32x4 w0 = wv[32 + n], w1 = wv[40 + n], w2 = wv[48 + n], bb = wv[56 + n];
                      o = (w0 * x2 + w1 * x1 + w2 * up + bb) * sg; }
                    wo[2 * n] = pk2(o[0], o[1]); wo[2 * n + 1] = pk2(o[2], o[3]); }
                *(v4u*)(act + (size_t)row * DFF + cg0) = wo; } }
    }
};

struct EpiAS {
    static constexpr bool PERM = false, AFTER_DRAIN = false;
    float* as; const float* ss1;
    __device__ __forceinline__ void operator()(const f32x4 (&acc)[2][2][4][2], const Unit& u, int wr, int wc, int fr, int fq) const {
#pragma unroll
        for (int m = 0; m < 4; ++m) { const int s_ = wr * 64 + m * 16 + fr; const float r = __builtin_amdgcn_rsqf(ss1[MP + s_] * (1.0f / D) + EPS);
#pragma unroll
            for (int n = 0; n < 2; ++n) { const int cg_ = u.pn * 128 + wc * 32 + 16 * n + 4 * fq;
                *(f32x4*)(as + (size_t)s_ * NUP + cg_) = acc[0][0][m][n] * r; *(f32x4*)(as + (size_t)s_ * NUP + DFF + cg_) = acc[0][1][m][n] * r; } }
    }
};
struct SampleOrder {
    int idx;
    __device__ __forceinline__ bool next(int i, Unit& u) const { if (i != 0 || idx < 0) return false; u.pm = MP / 256; u.pn = idx; return true; }
    __device__ __forceinline__ void a_ready(const Unit&) const {}
    __device__ __forceinline__ void done(const Unit&) const {}
};

struct ProjOrder {
    int first, nw;
    __device__ __forceinline__ bool next(int i, Unit& u) const { if (first < 0) return false; const int j = first + i * nw; if (j >= (MP / 256 + 1) * (D / 256)) return false; u.pm = j >> 3; u.pn = j & 7; return true; }
    __device__ __forceinline__ void a_ready(const Unit&) const {}
    __device__ __forceinline__ void done(const Unit&) const {}
};
struct EpiResS {
    static constexpr bool PERM = true, AFTER_DRAIN = false;
    const float* xs; bf16* hb; float* ss;
    __device__ __forceinline__ void operator()(const f32x4 (&acc)[2][2][4][2], const Unit& u, int wr, int wc, int fr, int fq) const {
        const int col0 = u.pn * 256 + wc * 32 + 8 * fq;
#pragma unroll
        for (int m = 0; m < 4; ++m) { const int s_ = wr * 64 + m * 16 + fr; float s = 0.f;
#pragma unroll
            for (int bj = 0; bj < 2; ++bj) { const size_t o_ = (size_t)s_ * D + col0 + bj * 128;
                const f32x4 o0 = *(const f32x4*)(xs + o_) + acc[0][bj][m][0], o1 = *(const f32x4*)(xs + o_ + 4) + acc[0][bj][m][1];
                v4u w; w.x = pk2(o0[0], o0[1]); w.y = pk2(o0[2], o0[3]); w.z = pk2(o1[0], o1[1]); w.w = pk2(o1[2], o1[3]); *(v4u*)(hb + o_) = w;
                s += ((o0[0] * o0[0] + o0[1] * o0[1]) + (o0[2] * o0[2] + o0[3] * o0[3])) + ((o1[0] * o1[0] + o1[1] * o1[1]) + (o1[2] * o1[2] + o1[3] * o1[3])); }
            s += __shfl_xor(s, 16); s += __shfl_xor(s, 32);
            if (fq == 0) atomic_addf(ss + s_, s); }
    }
};
template <int RT, int NK>
__device__ __forceinline__ void skinny_batch(f32x4 (&acc)[RT][2], const bf16* ap, const bf16* bp, int K, int as_rt, int as_k) {
    bf16x8 bq[NK][2], aq[NK][RT];
#pragma unroll
    for (int kk = 0; kk < NK; ++kk) { bq[kk][0] = *(const bf16x8*)(bp + 32 * kk); bq[kk][1] = *(const bf16x8*)(bp + (size_t)16 * K + 32 * kk);
#pragma unroll
        for (int rt = 0; rt < RT; ++rt) aq[kk][rt] = *(const bf16x8*)(ap + (size_t)rt * as_rt + (size_t)kk * as_k); }
#pragma unroll
    for (int kk = 0; kk < NK; ++kk)
#pragma unroll
        for (int rt = 0; rt < RT; ++rt) { acc[rt][0] = __builtin_amdgcn_mfma_f32_16x16x32_bf16(bq[kk][0], aq[kk][rt], acc[rt][0], 0, 0, 0); acc[rt][1] = __builtin_amdgcn_mfma_f32_16x16x32_bf16(bq[kk][1], aq[kk][rt], acc[rt][1], 0, 0, 0); }
}
template <int RT, class F>
__device__ __forceinline__ void skinny_gemm(LAS unsigned char* lds, const bf16* A, const bf16* Bt, int N, int K, int u0, int ustride, const F& f) {
    const int tid = threadIdx.x, lane = tid & 63, w = tid >> 6, fr = lane & 15, fq = lane >> 4;
    constexpr int nrb = 8 / RT, ROWS = 16 * RT;
    const int nunits = nrb * (N / 32), kw = K / 8;
    LAS float* red = (LAS float*)lds;
    for (int u = u0; u < nunits; u += ustride) {
        const int rb = u % nrb, cb = u / nrb, row0 = rb * ROWS, col0 = cb * 32;
        f32x4 acc[RT][2];
#pragma unroll
        for (int rt = 0; rt < RT; ++rt) { acc[rt][0] = (f32x4){0.f, 0.f, 0.f, 0.f}; acc[rt][1] = (f32x4){0.f, 0.f, 0.f, 0.f}; }
        const bf16* ap = A + ((size_t)(w * (kw >> 5)) * 128 + row0 + fr) * 32 + 8 * fq; constexpr int as_rt = 512, as_k = 4096;
        const bf16* bp = Bt + (size_t)(col0 + fr) * K + w * kw + 8 * fq;
        if constexpr (RT <= 2) {
            int k = 0;
            if (kw == 704) { skinny_batch<RT, 11>(acc, ap, bp, K, as_rt, as_k); skinny_batch<RT, 11>(acc, ap + (size_t)11 * as_k, bp + 352, K, as_rt, as_k); k = 704; }
            for (; k + 256 <= kw; k += 256) skinny_batch<RT, 8>(acc, ap + (size_t)(k >> 5) * as_k, bp + k, K, as_rt, as_k);
            for (; k < kw; k += 32) skinny_batch<RT, 1>(acc, ap + (size_t)(k >> 5) * as_k, bp + k, K, as_rt, as_k);
        } else {
#pragma unroll 2
        for (int k = 0; k < kw; k += 32) {
            const bf16x8 b0 = *(const bf16x8*)(bp + k), b1 = *(const bf16x8*)(bp + (size_t)16 * K + k);
#pragma unroll
            for (int rt = 0; rt < RT; ++rt) { const bf16x8 av = *(const bf16x8*)(ap + (size_t)rt * as_rt + (size_t)(k >> 5) * as_k);
                acc[rt][0] = __builtin_amdgcn_mfma_f32_16x16x32_bf16(b0, av, acc[rt][0], 0, 0, 0);
                acc[rt][1] = __builtin_amdgcn_mfma_f32_16x16x32_bf16(b1, av, acc[rt][1], 0, 0, 0); }
        }
        }
#pragma unroll
        for (int rt = 0; rt < RT; ++rt)
#pragma unroll
            for (int ct = 0; ct < 2; ++ct) *(LAS f32x4*)(red + (w * ROWS + 16 * rt + fr) * 32 + 16 * ct + 4 * fq) = acc[rt][ct];
        __syncthreads();
#pragma unroll
        for (int it = 0; it < RT; ++it) { const int e = tid + 512 * it, r = e >> 5, c = e & 31; float v = 0.f;
#pragma unroll
            for (int ww = 0; ww < 8; ++ww) v += red[(ww * ROWS + r) * 32 + c];
            f(row0 + r, col0 + c, v); }
        __syncthreads();
    }
}
__device__ __forceinline__ float half_wave_sum(float v) {
#pragma unroll
    for (int o = 1; o < 32; o <<= 1) v += __shfl_xor(v, o);
    return v;
}

__device__ __forceinline__ void transpose_item(const float* W, int K, int N, const float* g, bf16* WT, bool upmap, LAS float* scr, int item, int lane) {
    const int nblk = N / 64, kb = item / nblk, nb = item % nblk, k0 = 64 * kb, n0 = 64 * nb;
    const float* src = W + (size_t)k0 * N + n0 + lane;
#pragma unroll
    for (int h = 0; h < 2; ++h) {
        float v[32];
#pragma unroll
        for (int i = 0; i < 32; ++i) v[i] = __builtin_nontemporal_load(src + (size_t)(32 * h + i) * N);
#pragma unroll
        for (int i = 0; i < 32; ++i) { float x = v[i]; if (g) x *= g[k0 + 32 * h + i]; scr[(32 * h + i) * 65 + lane] = x; }
    }
    LDS_WAIT(); asm volatile("" ::: "memory");
    const int c = lane & 7;
#pragma unroll
    for (int j = 0; j < 8; ++j) { const int n = (lane >> 3) + 8 * j; const LAS float* s = scr + (8 * c) * 65 + n;
        v4u o; o.x = pk2(s[0 * 65], s[1 * 65]); o.y = pk2(s[2 * 65], s[3 * 65]); o.z = pk2(s[4 * 65], s[5 * 65]); o.w = pk2(s[6 * 65], s[7 * 65]);
        int R = n0 + n; if (upmap) { const int half = R >= DFF ? 1 : 0, jj = R - half * DFF; R = 256 * (jj >> 7) + 128 * half + (jj & 127); }
        *(v4u*)(WT + (size_t)R * K + k0 + 8 * c) = o; }
    LDS_WAIT(); asm volatile("" ::: "memory");
}
__device__ __forceinline__ void rms_row_to_bf16(const float* xrow, bf16* orow, float* rinv, int lane) {
    const f32x4* xr = (const f32x4*)xrow + lane;
    f32x4 v[8]; float s = 0.f;
#pragma unroll
    for (int j = 0; j < 8; ++j) { v[j] = __builtin_nontemporal_load(xr + 64 * j);
 s += (v[j][0] * v[j][0] + v[j][1] * v[j][1]) + (v[j][2] * v[j][2] + v[j][3] * v[j][3]); }
    const float ms = wave_sum(s) * (1.0f / D) + EPS, r = __builtin_amdgcn_rsqf(ms);
    if (lane == 0) *rinv = __builtin_sqrtf(ms);
    v2u* o8 = (v2u*)orow + lane;
#pragma unroll
    for (int j = 0; j < 8; ++j) { v2u w; w.x = pk2(v[j][0] * r, v[j][1] * r); w.y = pk2(v[j][2] * r, v[j][3] * r); o8[64 * j] = w; }
}

__device__ __forceinline__ void mm128(f32x4 (&acc)[8], const LAS bf16* A, const LAS bf16* B, int wave, int fr, int fq) {
#pragma unroll
    for (int ks = 0; ks < 4; ++ks) {
        const bf16x8 a = *(const LAS bf16x8*)(A + (16 * wave + fr) * LDP + 32 * ks + 8 * fq);
#pragma unroll
        for (int ct = 0; ct < 8; ++ct) { const bf16x8 b = *(const LAS bf16x8*)(B + (16 * ct + fr) * LDP + 32 * ks + 8 * fq);
            acc[ct] = __builtin_amdgcn_mfma_f32_16x16x32_bf16(b, a, acc[ct], 0, 0, 0); }
    }
}
template <bool TRANS, bool DEC>
__device__ __forceinline__ void stage_rope(LAS bf16* dst, const bf16* zb, const float* rope, float scale, float l2g, int tid) {
#pragma unroll
    for (int it = 0; it < 2; ++it) { const int idx = tid + 512 * it, j = idx >> 3, d8 = idx & 7;
        const v4u x1 = *(const v4u*)(zb + (size_t)j * NIN + 8 * d8), x2 = *(const v4u*)(zb + (size_t)j * NIN + 64 + 8 * d8);
        const f32x4* rp = (const f32x4*)(rope + (size_t)(j * 64 + 8 * d8) * 2);
        float sc = scale; if (DEC) sc *= __builtin_amdgcn_exp2f(l2g * (float)(127 - j));
        float o1[8], o2[8];
#pragma unroll
        for (int p = 0; p < 4; ++p) { const f32x4 cs = rp[p]; const float a0 = lo16(x1[p]), a1 = hi16(x1[p]), b0 = lo16(x2[p]), b1 = hi16(x2[p]);
            o1[2 * p] = (a0 * cs[0] - b0 * cs[1]) * sc; o2[2 * p] = (b0 * cs[0] + a0 * cs[1]) * sc;
            o1[2 * p + 1] = (a1 * cs[2] - b1 * cs[3]) * sc; o2[2 * p + 1] = (b1 * cs[2] + a1 * cs[3]) * sc; }
        if (!TRANS) { v4u w1, w2;
#pragma unroll
            for (int p = 0; p < 4; ++p) { w1[p] = pk2(o1[2 * p], o1[2 * p + 1]); w2[p] = pk2(o2[2 * p], o2[2 * p + 1]); }
            *(LAS v4u*)(dst + j * LDP + 8 * d8) = w1; *(LAS v4u*)(dst + j * LDP + 64 + 8 * d8) = w2; }
        else {
#pragma unroll
            for (int i = 0; i < 8; ++i) { dst[(8 * d8 + i) * LDP + j] = f2bf(o1[i]); dst[(64 + 8 * d8 + i) * LDP + j] = f2bf(o2[i]); } }
    }
}
__device__ __forceinline__ void stage_T(LAS bf16* dst, const bf16* zb, int tid) {
#pragma unroll
    for (int it = 0; it < 4; ++it) { const int idx = tid + 512 * it, j = idx >> 4, c8 = idx & 15;
        const v4u x = *(const v4u*)(zb + (size_t)j * NIN + 8 * c8);
#pragma unroll
        for (int p = 0; p < 4; ++p) { dst[(8 * c8 + 2 * p) * LDP + j] = (bf16)(x[p] & 0xffffu); dst[(8 * c8 + 2 * p + 1) * LDP + j] = (bf16)(x[p] >> 16); } }
}


struct RopeX { v4u x1[2], x2[2]; };
struct RopeCS { f32x4 cs[2][4]; };
struct TileX { v4u x[4]; };
template <bool NT = false> __device__ __forceinline__ void rope_load(RopeX& r, const bf16* zb, int tid) {
#pragma unroll
    for (int it = 0; it < 2; ++it) { const int idx = tid + 512 * it, j = idx >> 3, d8 = idx & 7; const v4u* p1 = (const v4u*)(zb + (size_t)j * NIN + 8 * d8); const v4u* p2 = (const v4u*)(zb + (size_t)j * NIN + 64 + 8 * d8);
        r.x1[it] = NT ? __builtin_nontemporal_load(p1) : *p1; r.x2[it] = NT ? __builtin_nontemporal_load(p2) : *p2; }
}
__device__ __forceinline__ void rope_cs_load(RopeCS& c, const float* rope, int tid) {
#pragma unroll
    for (int it = 0; it < 2; ++it) { const int idx = tid + 512 * it, j = idx >> 3, d8 = idx & 7; const f32x4* rp = (const f32x4*)(rope + (size_t)(j * 64 + 8 * d8) * 2);
#pragma unroll
        for (int p = 0; p < 4; ++p) c.cs[it][p] = rp[p]; }
}
template <bool TRANS, bool DEC>
__device__ __forceinline__ void rope_commit(LAS bf16* dst, const RopeX& r, const RopeCS& c, float scale, float l2g, int tid) {
#pragma unroll
    for (int it = 0; it < 2; ++it) { const int idx = tid + 512 * it, j = idx >> 3, d8 = idx & 7;
        float sc = scale; if (DEC) sc *= __builtin_amdgcn_exp2f(l2g * (float)(127 - j));
        float o1[8], o2[8];
#pragma unroll
        for (int p = 0; p < 4; ++p) { const f32x4 cs = c.cs[it][p]; const float a0 = lo16(r.x1[it][p]), a1 = hi16(r.x1[it][p]), b0 = lo16(r.x2[it][p]), b1 = hi16(r.x2[it][p]);
            o1[2 * p] = (a0 * cs[0] - b0 * cs[1]) * sc; o2[2 * p] = (b0 * cs[0] + a0 * cs[1]) * sc;
            o1[2 * p + 1] = (a1 * cs[2] - b1 * cs[3]) * sc; o2[2 * p + 1] = (b1 * cs[2] + a1 * cs[3]) * sc; }
        if (!TRANS) { v4u w1, w2;
#pragma unroll
            for (int p = 0; p < 4; ++p) { w1[p] = pk2(o1[2 * p], o1[2 * p + 1]); w2[p] = pk2(o2[2 * p], o2[2 * p + 1]); }
            *(LAS v4u*)(dst + j * LDP + 8 * d8) = w1; *(LAS v4u*)(dst + j * LDP + 64 + 8 * d8) = w2; }
        else {
#pragma unroll
            for (int i = 0; i < 8; ++i) { dst[(8 * d8 + i) * LDP + j] = f2bf(o1[i]); dst[(64 + 8 * d8 + i) * LDP + j] = f2bf(o2[i]); } }
    }
}
template <bool NT = false> __device__ __forceinline__ void tile_load(TileX& t, const bf16* zb, int tid) {
#pragma unroll
    for (int it = 0; it < 4; ++it) { const int idx = tid + 512 * it, j = idx >> 4, c8 = idx & 15; const v4u* p = (const v4u*)(zb + (size_t)j * NIN + 8 * c8); t.x[it] = NT ? __builtin_nontemporal_load(p) : *p; }
}
__device__ __forceinline__ void tile_commit_T(LAS bf16* dst, const TileX& t, int tid) {
#pragma unroll
    for (int it = 0; it < 4; ++it) { const int idx = tid + 512 * it, j = idx >> 4, c8 = idx & 15;
#pragma unroll
        for (int p = 0; p < 4; ++p) { dst[(8 * c8 + 2 * p) * LDP + j] = (bf16)(t.x[it][p] & 0xffffu); dst[(8 * c8 + 2 * p + 1) * LDP + j] = (bf16)(t.x[it][p] >> 16); } }
}

typedef short s16x4 __attribute__((ext_vector_type(4)));
__device__ __forceinline__ bf16x8 tr_frag(const LAS bf16* T, int c, int ks, int lane) {
    const int g = lane >> 4, q = (lane & 15) >> 2, p = lane & 3;
    const LAS bf16* a0 = T + (32 * ks + 8 * g + q) * LDP + 16 * c + 4 * p;
    const s16x4 lo = __builtin_amdgcn_ds_read_tr16_b64_v4i16((LAS s16x4*)a0), hi = __builtin_amdgcn_ds_read_tr16_b64_v4i16((LAS s16x4*)(a0 + 4 * LDP));
    return (bf16x8){lo[0], lo[1], lo[2], lo[3], hi[0], hi[1], hi[2], hi[3]};
}
__device__ __forceinline__ void mm128_nt(f32x4 (&acc)[8], const LAS bf16* A, const LAS bf16* B, int wave, int lane) {
    const int fr = lane & 15, fq = lane >> 4;
#pragma unroll
    for (int ks = 0; ks < 4; ++ks) {
        const bf16x8 a = *(const LAS bf16x8*)(A + (16 * wave + fr) * LDP + 32 * ks + 8 * fq);
#pragma unroll
        for (int ct = 0; ct < 8; ++ct) acc[ct] = __builtin_amdgcn_mfma_f32_16x16x32_bf16(tr_frag(B, ct, ks, lane), a, acc[ct], 0, 0, 0);
    }
}
__device__ __forceinline__ void mm128_tt(f32x4 (&acc)[8], const LAS bf16* At, const LAS bf16* Bn, int wave, int lane) {
#pragma unroll
    for (int ks = 0; ks < 4; ++ks) {
        const bf16x8 a = tr_frag(At, wave, ks, lane);
#pragma unroll
        for (int ct = 0; ct < 8; ++ct) acc[ct] = __builtin_amdgcn_mfma_f32_16x16x32_bf16(tr_frag(Bn, ct, ks, lane), a, acc[ct], 0, 0, 0);
    }
}
__device__ __forceinline__ void tile_commit_N(LAS bf16* dst, const TileX& t, int tid) {
#pragma unroll
    for (int it = 0; it < 4; ++it) { const int idx = tid + 512 * it, j = idx >> 4, c8 = idx & 15; *(LAS v4u*)(dst + j * LDP + 8 * c8) = t.x[it]; }
}

__global__ void __launch_bounds__(512, 2) mk_fwd(Params a) {
    extern __shared__ __attribute__((aligned(16))) unsigned char lds_raw[];
    LAS unsigned char* lds = (LAS unsigned char*)lds_raw;
    const int tid = threadIdx.x, lane = tid & 63, wave = __builtin_amdgcn_readfirstlane(tid >> 6), fr = lane & 15, fq = lane >> 4;
    const int G = gridDim.x, blk = blockIdx.x;
    const int gw = blk * 8 + wave, NGW = G * 8;
    const int gt = blk * 512 + tid, NGT = G * 512;
    unsigned char* ws = a.ws;
#define x_p (a.in[0])
#define x_s (a.in[1])
#define p_p (a.in[2])
#define p_s (a.in[3])
#define state_ret (a.in[4])
#define state_conv (a.in[5])
#define gm_ln_g (a.in[8])
#define gm_ln_b (a.in[9])
#define gm_ws (a.in[10])
#define gm_bs (a.in[11])
#define conv_w (a.in[15])
#define conv_b (a.in[16])
#define g_final (a.in[21])
#define out (a.out)
#define SS1 ((float*)(ws + WS_SS1))
#define SS2 ((float*)(ws + WS_SS2))
#define SS3 ((float*)(ws + WS_SS3))
#define STATS ((float*)(ws + WS_STATS))
#define ROPE ((float*)(ws + WS_ROPE))
#define ROPES ((float*)(ws + WS_ROPES))
#define Win_t ((bf16*)(ws + WS_WIN))
#define Wo_t ((bf16*)(ws + WS_WO))
#define Wup_t ((bf16*)(ws + WS_WUP))
#define Wdn_t ((bf16*)(ws + WS_WDN))
#define Wg_t ((bf16*)(ws + WS_WG))
#define Wp_t ((bf16*)(ws + WS_WP))
#define AB ((bf16*)(ws + WS_AB))
#define PB ((bf16*)(ws + WS_PB))
#define MIX ((bf16*)(ws + WS_MIX))
#define Z ((bf16*)(ws + WS_Z))
#define ACT ((bf16*)(ws + WS_ACT))
#define KV ((float*)(ws + WS_KV))
#define PP ((bf16*)(ws + WS_PP))
#define RAW ((float*)(ws + WS_RAW))
#define AS ((float*)(ws + WS_AS))

    volatile LAS unsigned* MISC = (volatile LAS unsigned*)(lds + MISC_OFF);
    if (tid < 64) MISC[tid] = 0u;
    __syncthreads();
    XcdBarrier bar; bar.bar = g_sync; bar.x = 0; bar.st = nullptr;
    if (MK_N_LAUNCHES == 1) bar = xcd_barrier_post(g_sync, MISC + 8);
    const int lo = a.ph_lo, hi = a.ph_hi;
#ifndef PHMASK
#define PHMASK 0xffff
#endif
#define IN(k) (((PHMASK >> (k)) & 1) && lo <= (k) && (k) < hi)
#define SEAM(k) do { if (IN(k) && IN((k) + 1)) { if (a.use_cg) cg::this_grid().sync(); else xcd_barrier(bar); } } while (0)

    if (IN(0)) {
        LAS float* scr = (LAS float*)(lds + wave * 16640);
        constexpr int I_IN = (D / 64) * (NIN / 64);
        for (int it = gw; it < I_IN; it += NGW) transpose_item(a.in[7], D, NIN, a.in[6], Win_t, false, scr, it, lane);
        for (int m = gw; m < MP; m += NGW) rms_row_to_bf16(x_p + (size_t)m * D, AB + (size_t)m * D, (float*)(ws + WS_RINV) + m, lane);
        for (int sr = gw; sr < MS; sr += NGW) {
            const f32x4* xr = (const f32x4*)(x_s + (size_t)sr * D) + lane; f32x4 v[8]; float ssum = 0.f;
#pragma unroll
            for (int j = 0; j < 8; ++j) { v[j] = xr[64 * j]; ssum += (v[j][0] * v[j][0] + v[j][1] * v[j][1]) + (v[j][2] * v[j][2] + v[j][3] * v[j][3]); }
            const float r = __builtin_amdgcn_rsqf(wave_sum(ssum) * (1.0f / D) + EPS); bf16* af = (bf16*)(ws + WS_AF1);
#pragma unroll
            for (int j = 0; j < 8; ++j) { const int k = 4 * lane + 256 * j; v2u w; w.x = pk2(v[j][0] * r, v[j][1] * r); w.y = pk2(v[j][2] * r, v[j][3] * r); *(v2u*)(af + ((size_t)(k >> 5) * 128 + sr) * 32 + (k & 31)) = w; } }
        for (int i = gt; i < MT * PLE / 4; i += NGT) { const f32x4 v = __builtin_nontemporal_load(i < MP * PLE / 4 ? (const f32x4*)p_p + i : (const f32x4*)p_s + (i - MP * PLE / 4)); v2u w; w.x = pk2(v[0], v[1]); w.y = pk2(v[2], v[3]); ((v2u*)PB)[i] = w; }
        for (int i = gt; i < SEQ * 64 + 64; i += NGT) { const int pos = i < SEQ * 64 ? (i >> 6) : 16384, fi = i & 63;
            const float ang = (float)pos * a.invf[fi]; double t = (double)ang * 0.15915494309189535; t -= __builtin_rint(t); const float rev = (float)t;
            float* dst = i < SEQ * 64 ? ROPE + 2 * (size_t)i : ROPES + 2 * fi; dst[0] = __builtin_amdgcn_cosf(rev); dst[1] = __builtin_amdgcn_sinf(rev); }
        for (int i = gt; i < MT; i += NGT) { SS1[i] = 0.f; SS2[i] = 0.f; SS3[i] = 0.f; }
    }
    SEAM(0);

    if (IN(1)) {
        { pg8::Gemm g{AB, Win_t, MP, NIN, D}; pg8::StaticOrder S; S.init(MP, NIN, G, blk); EpiZ E{Z};
          pg8::gemm_phase<EpiZ, pg8::StaticOrder, true, true>(lds, g, S, E); }
        auto f = [&](int s, int n, float v) { const float o = n < 3072 ? v : (n < 4096 ? silu_(v) : gelu_(v)); Z[(size_t)(MP + s) * NIN + n] = f2bf(o); };
        skinny_gemm<8>(lds, (const bf16*)(ws + WS_AF1), Win_t, NIN, D, blk, G, f);
    }
    SEAM(1);

    if (IN(2)) {
        for (int pass = 0; pass < 2; ++pass) {
        if ((pass ^ (blk & 1)) == 0) {
        { LAS float* qs = (LAS float*)lds; LAS float* ks = qs + 128; LAS float* vs = ks + 128; LAS float* red = vs + 128;
          const int e4 = tid & 31, dg = tid >> 5;
          for (int u = blk; u < MS * NH; u += G) { const int s = u >> 3, h = u & 7; const bf16* zr = Z + (size_t)(MP + s) * NIN;
            const float* S0 = state_ret + (size_t)u * 16384 + 4 * e4; float* S1 = out + O_RETS + (size_t)u * 16384 + 4 * e4;
            f32x4 s0[8];
#pragma unroll
            for (int i = 0; i < 8; ++i) s0[i] = __builtin_nontemporal_load((const f32x4*)(S0 + (dg + 16 * i) * 128));
            if (tid < 64) { const float c = ROPES[2 * tid], sn = ROPES[2 * tid + 1];
                const float q1 = bf2f(zr[128 * h + tid]), q2 = bf2f(zr[128 * h + 64 + tid]), k1 = bf2f(zr[1024 + 128 * h + tid]), k2 = bf2f(zr[1024 + 128 * h + 64 + tid]);
                qs[tid] = q1 * c - q2 * sn; qs[tid + 64] = q2 * c + q1 * sn; ks[tid] = (k1 * c - k2 * sn) * 0.08838834764831845f; ks[tid + 64] = (k2 * c + k1 * sn) * 0.08838834764831845f; }
            else if (tid < 192) vs[tid - 64] = bf2f(zr[2048 + 128 * h + tid - 64]);
            unsigned gg = 0u; if (tid < 64) gg = *(const unsigned*)(zr + 3072 + 128 * h + 2 * tid);
            __syncthreads();
            const float gamma = 1.0f - __builtin_amdgcn_exp2f((float)(-5 - h));
            const f32x4 vv = *(const LAS f32x4*)(vs + 4 * e4); f32x4 o = {0.f, 0.f, 0.f, 0.f};
#pragma unroll
            for (int i = 0; i < 8; ++i) { const int d = dg + 16 * i; const f32x4 sn = s0[i] * gamma + vv * ks[d]; __builtin_nontemporal_store(sn, (f32x4*)(S1 + d * 128)); o += sn * qs[d]; }
            *(LAS f32x4*)(red + dg * 128 + 4 * e4) = o;
            __syncthreads();
            if (tid < 64) { float o0 = 0.f, o1 = 0.f;
#pragma unroll
                for (int i = 0; i < 16; ++i) { o0 += red[i * 128 + 2 * tid]; o1 += red[i * 128 + 2 * tid + 1]; }
                const float r = __builtin_amdgcn_rsqf(wave_sum(o0 * o0 + o1 * o1) * (1.0f / 128.0f) + EPS);
                *(unsigned*)(MIX + (size_t)(MP + s) * D + 128 * h + 2 * tid) = pk2(o0 * r * lo16(gg), o1 * r * hi16(gg)); }
            __syncthreads(); } }
        } else {
        { LAS bf16* Kt = (LAS bf16*)lds; LAS bf16* Vt = (LAS bf16*)(lds + TILE_B);
          for (int u = blk; u < 512; u += G) { const int b = u >> 7, h = (u >> 4) & 7, c = u & 15; const size_t R0 = (size_t)b * SEQ + 128 * c;
            RopeX kx; RopeCS cs; TileX vx;
            rope_load(kx, Z + R0 * NIN + 1024 + 128 * h, tid); rope_cs_load(cs, ROPE + (size_t)(128 * c) * 128, tid); tile_load(vx, Z + R0 * NIN + 2048 + 128 * h, tid);
            rope_commit<false, true>(Kt, kx, cs, 0.08838834764831845f, a.log2g[h], tid);
            tile_commit_N(Vt, vx, tid);
            __syncthreads();
            f32x4 acc[8];
#pragma unroll
            for (int ct = 0; ct < 8; ++ct) acc[ct] = (f32x4){0.f, 0.f, 0.f, 0.f};
            mm128_tt(acc, Kt, Vt, wave, lane);
            float* kv = KV + (size_t)u * 16384 + (16 * wave + fr) * 128 + 4 * fq;
#pragma unroll
            for (int ct = 0; ct < 8; ++ct) *(f32x4*)(kv + 16 * ct) = acc[ct];
            __syncthreads(); } }
        for (int r0 = gw; r0 < MP; r0 += 2 * NGW) { const int r1 = r0 + NGW;
            const bf16* p0 = Z + (size_t)r0 * NIN + 5120 + 16 * lane; const bf16* p1 = Z + (size_t)(r1 < MP ? r1 : r0) * NIN + 5120 + 16 * lane;
            const v4u xa0 = *(const v4u*)p0, xa1 = *(const v4u*)(p0 + 8), xb0 = *(const v4u*)p1, xb1 = *(const v4u*)(p1 + 8);
            float va[16], vb[16];
#pragma unroll
            for (int j = 0; j < 4; ++j) { va[2 * j] = lo16(xa0[j]); va[2 * j + 1] = hi16(xa0[j]); va[8 + 2 * j] = lo16(xa1[j]); va[8 + 2 * j + 1] = hi16(xa1[j]);
                                          vb[2 * j] = lo16(xb0[j]); vb[2 * j + 1] = hi16(xb0[j]); vb[8 + 2 * j] = lo16(xb1[j]); vb[8 + 2 * j + 1] = hi16(xb1[j]); }
            float sa = 0.f, sb = 0.f;
#pragma unroll
            for (int j = 0; j < 16; ++j) { sa += va[j]; sb += vb[j]; }
            const float ma = wave_sum(sa) * (1.0f / 1024.0f), mb = wave_sum(sb) * (1.0f / 1024.0f); float qa = 0.f, qb = 0.f;
#pragma unroll
            for (int j = 0; j < 16; ++j) { const float da = va[j] - ma, db = vb[j] - mb; qa += da * da; qb += db * db; }
            const float ra = __builtin_amdgcn_rsqf(wave_sum(qa) * (1.0f / 1024.0f) + EPS), rb = __builtin_amdgcn_rsqf(wave_sum(qb) * (1.0f / 1024.0f) + EPS);
            if (lane == 0) { STATS[2 * r0] = ma; STATS[2 * r0 + 1] = ra; if (r1 < MP) { STATS[2 * r1] = mb; STATS[2 * r1 + 1] = rb; } } }
        for (int row = MP + gw; row < MT; row += NGW) { const bf16* p = Z + (size_t)row * NIN + 5120 + 16 * lane; const v4u x0 = *(const v4u*)p, x1 = *(const v4u*)(p + 8);
            const int s_ = row - MP, c0 = 16 * lane, grp = lane >> 3; const float w00 = gm_ws[grp * 16384], b0 = gm_bs[grp * 128];
            const bf16* up = Z + (size_t)row * NIN + 4096 + c0; const v4u u0 = *(const v4u*)up, u1 = *(const v4u*)(up + 8);
            float v[16];
#pragma unroll
            for (int j = 0; j < 4; ++j) { v[2 * j] = lo16(x0[j]); v[2 * j + 1] = hi16(x0[j]); v[8 + 2 * j] = lo16(x1[j]); v[8 + 2 * j + 1] = hi16(x1[j]); }
            float s = 0.f;
#pragma unroll
            for (int j = 0; j < 16; ++j) s += v[j];
            const float mean = wave_sum(s) * (1.0f / 1024.0f); float q = 0.f;
#pragma unroll
            for (int j = 0; j < 16; ++j) { v[j] -= mean; q += v[j] * v[j]; }
            const float rstd = __builtin_amdgcn_rsqf(wave_sum(q) * (1.0f / 1024.0f) + EPS);
            float uu[16];
#pragma unroll
            for (int j = 0; j < 4; ++j) { uu[2 * j] = lo16(u0[j]); uu[2 * j + 1] = hi16(u0[j]); uu[8 + 2 * j] = lo16(u1[j]); uu[8 + 2 * j + 1] = hi16(u1[j]); }
            float vn[16], mo[16];
#pragma unroll
            for (int j = 0; j < 16; ++j) { vn[j] = v[j] * rstd * gm_ln_g[c0 + j] + gm_ln_b[c0 + j]; mo[j] = uu[j] * (w00 * vn[j] + b0); }
            float* gv = out + O_GMV + (size_t)s_ * 1024 + c0;
#pragma unroll
            for (int j = 0; j < 4; ++j) *(f32x4*)(gv + 4 * j) = (f32x4){vn[4 * j], vn[4 * j + 1], vn[4 * j + 2], vn[4 * j + 3]};
            v4u w0, w1;
#pragma unroll
            for (int j = 0; j < 4; ++j) { w0[j] = pk2(mo[2 * j], mo[2 * j + 1]); w1[j] = pk2(mo[8 + 2 * j], mo[8 + 2 * j + 1]); }
            bf16* mp = MIX + (size_t)row * D + 1024 + c0; *(v4u*)mp = w0; *(v4u*)(mp + 8) = w1; }
        } }
    }
    SEAM(2);

    if (IN(3)) {
        auto convert_rest = [&]() {
            LAS float* scr = (LAS float*)(lds + wave * 16640);
            constexpr int I_O = (D / 64) * (D / 64), I_UP = (D / 64) * (NUP / 64), I_DN = (DFF / 64) * (D / 64), I_G = I_O, I_P = (PLE / 64) * (D / 64);
            constexpr int NITEMS = I_O + I_UP + I_DN + I_G + I_P;
            for (int it = gw; it < NITEMS; it += NGW) {
                int r = it;
                if (r < I_UP) { transpose_item(a.in[14], D, NUP, a.in[13], Wup_t, true, scr, r, lane); continue; } r -= I_UP;
                if (r < I_O) { transpose_item(a.in[12], D, D, nullptr, Wo_t, false, scr, r, lane); continue; } r -= I_O;
                if (r < I_DN) { transpose_item(a.in[17], DFF, D, nullptr, Wdn_t, false, scr, r, lane); continue; } r -= I_DN;
                if (r < I_G) { transpose_item(a.in[19], D, D, a.in[18], Wg_t, false, scr, r, lane); continue; } r -= I_G;
                transpose_item(a.in[20], PLE, D, nullptr, Wp_t, false, scr, r, lane);
            }
            __syncthreads(); };
        if (!(blk & 1)) convert_rest();
        {
        LAS bf16* T0 = (LAS bf16*)lds; LAS bf16* T1 = (LAS bf16*)(lds + TILE_B); LAS bf16* T2 = (LAS bf16*)(lds + 2 * TILE_B); LAS bf16* T3 = (LAS bf16*)(lds + 3 * TILE_B);
        for (int u = blk; u < 512; u += G) { const int bh = u >> 4, b = bh >> 3, h = bh & 7, c = u < 256 ? (u & 15) : 15 - (u & 15); const size_t R0 = (size_t)b * SEQ + 128 * c; const float l2g = a.log2g[h];
            const int i_ = 16 * wave + fr;
            RopeX qx, kx; RopeCS cs; TileX vx; v2u gg[8];
            const float* kvb = KV + (size_t)bh * 16 * 16384;
            f32x4 tc[8];
#pragma unroll
            for (int i = 0; i < 8; ++i) tc[i] = *(const f32x4*)(kvb + 4 * (tid + 512 * i));
            rope_load<true>(qx, Z + R0 * NIN + 128 * h, tid); rope_load<true>(kx, Z + R0 * NIN + 1024 + 128 * h, tid); rope_cs_load(cs, ROPE + (size_t)(128 * c) * 128, tid); tile_load<true>(vx, Z + R0 * NIN + 2048 + 128 * h, tid);
            rope_commit<false, false>(T0, qx, cs, 1.0f, 0.f, tid);
            rope_commit<false, false>(T1, kx, cs, 0.08838834764831845f, 0.f, tid);
            asm volatile("" ::: "memory");
            { const float Gc = __builtin_amdgcn_exp2f(l2g * 128.0f);
              f32x4 sp[8];
#pragma unroll
              for (int i = 0; i < 8; ++i) sp[i] = (f32x4){0.f, 0.f, 0.f, 0.f};
              for (int j = 0; j < c; ++j) { f32x4 tn[8];
#pragma unroll
                  for (int i = 0; i < 8; ++i) tn[i] = *(const f32x4*)(kvb + (size_t)(j + 1) * 16384 + 4 * (tid + 512 * i));
#pragma unroll
                  for (int i = 0; i < 8; ++i) { sp[i] = sp[i] * Gc + tc[i]; tc[i] = tn[i]; } }
              if (c == 15) {
#pragma unroll
                  for (int i = 0; i < 8; ++i) *(f32x4*)(out + O_RETP + (size_t)bh * 16384 + 4 * (tid + 512 * i)) = sp[i] * Gc + tc[i]; }
#pragma unroll
              for (int i = 0; i < 8; ++i) { const int ch = tid + 512 * i, d = ch >> 5, e4 = ch & 31; v2u w; w.x = pk2(sp[i][0], sp[i][1]); w.y = pk2(sp[i][2], sp[i][3]);
                  *(LAS v2u*)(T3 + d * LDP + 4 * e4) = w; } }
            tile_commit_N(T2, vx, tid);
            __syncthreads();
            { const bf16* gp = Z + (R0 + i_) * NIN + 3072 + 128 * h + 4 * fq;
#pragma unroll
              for (int ct = 0; ct < 8; ++ct) gg[ct] = __builtin_nontemporal_load((const v2u*)(gp + 16 * ct)); }
            f32x4 acc2[8], acc1[8];
#pragma unroll
            for (int ct = 0; ct < 8; ++ct) { acc2[ct] = (f32x4){0.f, 0.f, 0.f, 0.f}; acc1[ct] = (f32x4){0.f, 0.f, 0.f, 0.f}; }
            mm128_nt(acc2, T0, T3, wave, lane);
            mm128(acc1, T0, T1, wave, fr, fq);
            __syncthreads();
#pragma unroll
            for (int ct = 0; ct < 8; ++ct) { float sv[4];
#pragma unroll
                for (int t = 0; t < 4; ++t) { const int j = 16 * ct + 4 * fq + t; sv[t] = i_ >= j ? acc1[ct][t] * __builtin_amdgcn_exp2f(l2g * (float)(i_ - j)) : 0.f; }
                v2u w; w.x = pk2(sv[0], sv[1]); w.y = pk2(sv[2], sv[3]); *(LAS v2u*)(T1 + i_ * LDP + 16 * ct + 4 * fq) = w; }
            __syncthreads();
#pragma unroll
            for (int ct = 0; ct < 8; ++ct) acc1[ct] = (f32x4){0.f, 0.f, 0.f, 0.f};
            mm128_nt(acc1, T1, T2, wave, lane);
            const float qd = __builtin_amdgcn_exp2f(l2g * (float)(i_ + 1)); float ssq = 0.f;
#pragma unroll
            for (int ct = 0; ct < 8; ++ct) { acc1[ct] = acc1[ct] + acc2[ct] * qd; ssq += (acc1[ct][0] * acc1[ct][0] + acc1[ct][1] * acc1[ct][1]) + (acc1[ct][2] * acc1[ct][2] + acc1[ct][3] * acc1[ct][3]); }
            ssq += __shfl_xor(ssq, 16); ssq += __shfl_xor(ssq, 32);
            const float rn = __builtin_amdgcn_rsqf(ssq * (1.0f / 128.0f) + EPS);
            bf16* mp = MIX + (R0 + i_) * D + 128 * h + 4 * fq;
#pragma unroll
            for (int ct = 0; ct < 8; ++ct) { v2u w;
                w.x = pk2(acc1[ct][0] * rn * lo16(gg[ct].x), acc1[ct][1] * rn * hi16(gg[ct].x)); w.y = pk2(acc1[ct][2] * rn * lo16(gg[ct].y), acc1[ct][3] * rn * hi16(gg[ct].y)); *(v2u*)(mp + 16 * ct) = w; }
            __syncthreads(); }
        for (int u = blk; u < 512; u += G) { const int b = u >> 7, c = (u >> 3) & 15, grp = u & 7; const size_t R0 = (size_t)b * SEQ + 128 * c;
            const int t_ = 16 * wave + fr, d8 = tid & 15;
            f32x4 wl[4][2]; v4u xv[4]; float st[4][2]; v2u uu[8]; float lg[8], lb[8];
#pragma unroll
            for (int it = 0; it < 4; ++it) { const int idx = tid + 512 * it, t = idx >> 4; const float* wp = gm_ws + (size_t)grp * 16384 + t * 128 + 8 * d8;
                wl[it][0] = *(const f32x4*)wp; wl[it][1] = *(const f32x4*)(wp + 4);
                xv[it] = __builtin_nontemporal_load((const v4u*)(Z + (R0 + t) * NIN + 5120 + 128 * grp + 8 * d8)); st[it][0] = STATS[2 * (R0 + t)]; st[it][1] = STATS[2 * (R0 + t) + 1]; }
#pragma unroll
            for (int j = 0; j < 8; ++j) { lg[j] = gm_ln_g[128 * grp + 8 * d8 + j]; lb[j] = gm_ln_b[128 * grp + 8 * d8 + j]; }
            const float bsv = gm_bs[grp * 128 + t_];
#pragma unroll
            for (int it = 0; it < 4; ++it) { const int idx = tid + 512 * it, t = idx >> 4;
                float wv[8] = {wl[it][0][0], wl[it][0][1], wl[it][0][2], wl[it][0][3], wl[it][1][0], wl[it][1][1], wl[it][1][2], wl[it][1][3]};
#pragma unroll
                for (int j = 0; j < 8; ++j) if (8 * d8 + j > t) wv[j] = 0.f;
                v4u w; w.x = pk2(wv[0], wv[1]); w.y = pk2(wv[2], wv[3]); w.z = pk2(wv[4], wv[5]); w.w = pk2(wv[6], wv[7]); *(LAS v4u*)(T0 + t * LDP + 8 * d8) = w;
                const float mean = st[it][0], rstd = st[it][1];
                v4u vw;
#pragma unroll
                for (int p = 0; p < 4; ++p) vw[p] = pk2((lo16(xv[it][p]) - mean) * rstd * lg[2 * p] + lb[2 * p], (hi16(xv[it][p]) - mean) * rstd * lg[2 * p + 1] + lb[2 * p + 1]);
                *(LAS v4u*)(T1 + t * LDP + 8 * d8) = vw; }
            __syncthreads();
            { const bf16* up = Z + (R0 + t_) * NIN + 4096 + 128 * grp + 4 * fq;
#pragma unroll
              for (int ct = 0; ct < 8; ++ct) uu[ct] = __builtin_nontemporal_load((const v2u*)(up + 16 * ct)); }
            f32x4 acc[8];
#pragma unroll
            for (int ct = 0; ct < 8; ++ct) acc[ct] = (f32x4){0.f, 0.f, 0.f, 0.f};
            mm128_nt(acc, T0, T1, wave, lane);
            bf16* mp = MIX + (R0 + t_) * D + 1024 + 128 * grp + 4 * fq;
#pragma unroll
            for (int ct = 0; ct < 8; ++ct) { v2u w;
                w.x = pk2((acc[ct][0] + bsv) * lo16(uu[ct].x), (acc[ct][1] + bsv) * hi16(uu[ct].x)); w.y = pk2((acc[ct][2] + bsv) * lo16(uu[ct].y), (acc[ct][3] + bsv) * hi16(uu[ct].y)); *(v2u*)(mp + 16 * ct) = w; }
            __syncthreads(); }
        }
        if (blk & 1) convert_rest();
    }
    SEAM(3);

    if (IN(4)) {
        { pg8::Gemm g{MIX, Wo_t, MP, D, D}; pg8::StaticOrder S; S.init(MP, D, G, blk); EpiRes<2> E{(const float*)(ws + WS_RINV), nullptr, AB, SS1};
          pg8::gemm_phase<EpiRes<2>, pg8::StaticOrder, true, true>(lds, g, S, E); }
    }
    SEAM(4);

    if (IN(5)) {
        unsigned* p3s_cnt = g_sync + 3584;
        if (blk >= 248) {
            { pg8::Gemm g{MIX, Wo_t, MP + 256, D, D}; SampleOrder S{blk - 248}; EpiResS E{x_s, AB + (size_t)MP * D, SS1 + MP};
              pg8::gemm_phase<EpiResS, SampleOrder, true, true>(lds, g, S, E); }
            asm volatile("s_waitcnt vmcnt(0)" ::: "memory"); __syncthreads();
            if (tid == 0) { __builtin_amdgcn_fence(__ATOMIC_RELEASE, "agent"); asm volatile("s_waitcnt vmcnt(0)" ::: "memory"); (void)__hip_atomic_fetch_add(p3s_cnt, 1u, __ATOMIC_RELAXED, __HIP_MEMORY_SCOPE_AGENT); }
        }
        { pg8::Gemm g{AB, Wup_t, MP, NUP, D}; pg8::StaticOrder S; S.init(MP, NUP, G, blk); EpiUp E{ACT, RAW, SS1, conv_w, conv_b, (LAS float*)(lds + 131072)};
          pg8::gemm_phase<EpiUp, pg8::StaticOrder, true, true>(lds, g, S, E); }
        if (blk >= 128 && blk - 128 < NUP / 256) {
            if (tid == 0) { unsigned spins = 0; while (__hip_atomic_load(p3s_cnt, __ATOMIC_RELAXED, __HIP_MEMORY_SCOPE_AGENT) < 8u) { __builtin_amdgcn_s_sleep(4); if (++spins > (1u << 22)) break; } }
            __syncthreads();
            __builtin_amdgcn_fence(__ATOMIC_ACQUIRE, "agent"); asm volatile("s_waitcnt vmcnt(0)" ::: "memory"); }
        { pg8::Gemm g{AB, Wup_t, MP + 256, NUP, D}; SampleOrder S{(blk >= 128 && blk - 128 < NUP / 256) ? blk - 128 : -1}; EpiAS E{AS, SS1};
          pg8::gemm_phase<EpiAS, SampleOrder, true, true>(lds, g, S, E); }
        { int Kp = PLE; asm volatile("" : "+s"(Kp));
          constexpr int nbusy = (MP / 256 * (NUP / 256) + NUP / 256) - 5 * 256;
          pg8::Gemm g{PB, Wp_t, MP + 256, D, Kp}; ProjOrder S{(blk >= nbusy && blk < 248) ? blk - nbusy : -1, 248 - nbusy}; EpiPP E{PP};
          pg8::gemm_phase<EpiPP, ProjOrder, true, true>(lds, g, S, E); }
    }
    SEAM(5);

    if (IN(6)) {
        for (int i = gt; i < 128 * 2 * (DFF / 4); i += NGT) { const int c4 = i % (DFF / 4), gr = i / (DFF / 4), rr = gr & 1, Gp = gr >> 1, c = 4 * c4; const bool first = (Gp & 31) == 0;
            const float* rg = RAW + (size_t)Gp * 4 * NUP; const float* rp = rg - 4 * NUP; const f32x4 z4 = {0.f, 0.f, 0.f, 0.f};
            f32x4 a0g, a0u, a1g, a1u, a2g, a2u;
            a0g = *(const f32x4*)(rg + (2 + rr) * NUP + c); a0u = *(const f32x4*)(rg + (2 + rr) * NUP + DFF + c);
            if (rr) { a1g = *(const f32x4*)(rg + 2 * NUP + c); a1u = *(const f32x4*)(rg + 2 * NUP + DFF + c); a2g = first ? z4 : *(const f32x4*)(rp + NUP + c); a2u = first ? z4 : *(const f32x4*)(rp + NUP + DFF + c); }
            else { a1g = first ? z4 : *(const f32x4*)(rp + NUP + c); a1u = first ? z4 : *(const f32x4*)(rp + NUP + DFF + c); a2g = first ? z4 : *(const f32x4*)(rp + c); a2u = first ? z4 : *(const f32x4*)(rp + DFF + c); }
            const f32x4 ag = *(const f32x4*)(conv_w + c) * a2g + *(const f32x4*)(conv_w + NUP + c) * a1g + *(const f32x4*)(conv_w + 2 * NUP + c) * a0g + *(const f32x4*)(conv_b + c);
            const f32x4 au = *(const f32x4*)(conv_w + DFF + c) * a2u + *(const f32x4*)(conv_w + NUP + DFF + c) * a1u + *(const f32x4*)(conv_w + 2 * NUP + DFF + c) * a0u + *(const f32x4*)(conv_b + DFF + c);
            v2u w; w.x = pk2(silu_(ag[0]) * au[0], silu_(ag[1]) * au[1]); w.y = pk2(silu_(ag[2]) * au[2], silu_(ag[3]) * au[3]);
            *(v2u*)(ACT + (size_t)(64 * Gp + rr) * DFF + c) = w; }
        for (int i = gt; i < MS * (DFF / 4); i += NGT) { const int c4 = i % (DFF / 4), s = i / (DFF / 4), c = 4 * c4;
            const float* sc0 = state_conv + (size_t)s * 2 * NUP; const float* sc1 = sc0 + NUP; const float* as = AS + (size_t)s * NUP;
            const f32x4 a0g = *(const f32x4*)(as + c), a0u = *(const f32x4*)(as + DFF + c), a1g = *(const f32x4*)(sc1 + c), a1u = *(const f32x4*)(sc1 + DFF + c), a2g = *(const f32x4*)(sc0 + c), a2u = *(const f32x4*)(sc0 + DFF + c);
            const f32x4 ag = *(const f32x4*)(conv_w + c) * a2g + *(const f32x4*)(conv_w + NUP + c) * a1g + *(const f32x4*)(conv_w + 2 * NUP + c) * a0g + *(const f32x4*)(conv_b + c);
            const f32x4 au = *(const f32x4*)(conv_w + DFF + c) * a2u + *(const f32x4*)(conv_w + NUP + DFF + c) * a1u + *(const f32x4*)(conv_w + 2 * NUP + DFF + c) * a0u + *(const f32x4*)(conv_b + DFF + c);
            v2u w; w.x = pk2(silu_(ag[0]) * au[0], silu_(ag[1]) * au[1]); w.y = pk2(silu_(ag[2]) * au[2], silu_(ag[3]) * au[3]);
            *(v2u*)((bf16*)(ws + WS_AF6) + ((size_t)(c >> 5) * 128 + s) * 32 + (c & 31)) = w;
            float* cs = out + O_CONVS + (size_t)s * 2 * NUP; *(f32x4*)(cs + c) = a1g; *(f32x4*)(cs + DFF + c) = a1u; *(f32x4*)(cs + NUP + c) = a0g; *(f32x4*)(cs + NUP + DFF + c) = a0u; }
        for (int i = gt; i < 4 * 2 * (NUP / 4); i += NGT) { const int c4 = i % (NUP / 4), bk = i / (NUP / 4), b = bk >> 1, k = bk & 1;
            *(f32x4*)(out + O_CONVP + (size_t)bk * NUP + 4 * c4) = *(const f32x4*)(RAW + ((size_t)(32 * b + 31) * 4 + k) * NUP + 4 * c4); }
    }
    SEAM(6);

    if (IN(7)) {
        { pg8::Gemm g{ACT, Wdn_t, MP, D, DFF}; pg8::StaticOrder S; S.init(MP, D, G, blk); EpiRes<1> E{nullptr, nullptr, AB, SS2};
          pg8::gemm_phase<EpiRes<1>, pg8::StaticOrder, true, true>(lds, g, S, E); }
        auto f = [&](int s, int n, float v) { const size_t o_ = (size_t)(MP + s) * D + n; const float o = bf2f(AB[o_]) + v; ((bf16*)(ws + WS_AF7))[((size_t)(n >> 5) * 128 + s) * 32 + (n & 31)] = f2bf(o);
            const float q = half_wave_sum(o * o); if ((lane & 31) == 0) atomic_addf(SS2 + MP + s, q); };
        skinny_gemm<2>(lds, (const bf16*)(ws + WS_AF6), Wdn_t, D, DFF, blk, G, f);
    }
    SEAM(7);

    if (IN(8)) {
#ifndef T_B
        { pg8::Gemm g{AB, Wg_t, MP, D, D}; pg8::StaticOrder S; S.init(MP, D, G, blk); EpiGate E{PP, AB, out, SS2, SS3};
          pg8::gemm_phase<EpiGate, pg8::StaticOrder, true, true>(lds, g, S, E); }
#endif
#ifndef T_D
        auto f2 = [&](int s, int n, float v) { const size_t o_ = (size_t)(MP + s) * D + n; const float r2 = __builtin_amdgcn_rsqf(SS2[MP + s] * (1.0f / D) + EPS);
            const float o = bf2f(((const bf16*)(ws + WS_AF7))[((size_t)(n >> 5) * 128 + s) * 32 + (n & 31)]) + bf2f(PP[o_]) * sigmoid_(r2 * v); out[o_] = o; const float q = half_wave_sum(o * o); if ((lane & 31) == 0) atomic_addf(SS3 + MP + s, q); };
        skinny_gemm<2>(lds, (const bf16*)(ws + WS_AF7), Wg_t, D, D, blk, G, f2);
#endif
    }
    SEAM(8);

    if (IN(9)) {
        { const f32x4* gr = (const f32x4*)g_final + lane; f32x4 gv[8];
#pragma unroll
          for (int j = 0; j < 8; ++j) gv[j] = gr[64 * j];
          for (int m0 = gw; m0 < MT; m0 += 2 * NGW) { const int m1 = m0 + NGW; const bool two = m1 < MT;
            f32x4* h0 = (f32x4*)(out + (size_t)m0 * D) + lane; f32x4* h1 = (f32x4*)(out + (size_t)(two ? m1 : m0) * D) + lane;
            f32x4 a0[8], a1[8];
#pragma unroll
            for (int j = 0; j < 8; ++j) { a0[j] = h0[64 * j]; a1[j] = h1[64 * j]; }
            const float r0 = __builtin_amdgcn_rsqf(SS3[m0] * (1.0f / D) + EPS), r1 = __builtin_amdgcn_rsqf(SS3[two ? m1 : m0] * (1.0f / D) + EPS);
#pragma unroll
            for (int j = 0; j < 8; ++j) __builtin_nontemporal_store(a0[j] * gv[j] * r0, h0 + 64 * j);
            if (two) {
#pragma unroll
                for (int j = 0; j < 8; ++j) __builtin_nontemporal_store(a1[j] * gv[j] * r1, h1 + 64 * j); } } }
    }
    { volatile LAS unsigned* flag = (volatile LAS unsigned*)(lds + MISC_OFF + 64);
      __syncthreads();
      if (tid == 0) flag[0] = (__hip_atomic_fetch_add(g_sync + 4096, 1u, __ATOMIC_RELAXED, __HIP_MEMORY_SCOPE_AGENT) == (unsigned)G - 1u) ? 1u : 0u;
      __syncthreads();
      if (flag[0]) { for (int i = tid; i < 4096 + 64; i += 512) __hip_atomic_store(g_sync + i, 0u, __ATOMIC_RELAXED, __HIP_MEMORY_SCOPE_AGENT); } }
#undef IN
#undef SEAM
}
#undef x_p
#undef x_s
#undef p_p
#undef p_s
#undef state_ret
#undef state_conv
#undef gm_ln_g
#undef gm_ln_b
#undef gm_ws
#undef gm_bs
#undef conv_w
#undef conv_b
#undef g_final
#undef out
#undef SS1
#undef SS2
#undef SS3
#undef STATS
#undef ROPE
#undef ROPES
#undef Win_t
#undef Wo_t
#undef Wup_t
#undef Wdn_t
#undef Wg_t
#undef Wp_t
#undef AB
#undef PB
#undef MIX
#undef Z
#undef ACT
#undef KV
#undef PP
#undef RAW
#undef AS

extern "C" void kernel_launch(void* const* d_in, const int* in_sizes, int n_in, void* d_out, int out_size, void* d_ws, size_t ws_size, hipStream_t stream) {
    static int grid = 0;
    if (grid == 0) {
        if (n_in != 22 || out_size != (int)O_END || ws_size < WS_END) { fprintf(stderr, "kernel_launch: unexpected shapes: n_in %d out %d ws %zu\n", n_in, out_size, ws_size); grid = -1; return; }
        int dev = 0, cus = 0, per_cu = 0;
        if (hipGetDevice(&dev) != hipSuccess || hipDeviceGetAttribute(&cus, hipDeviceAttributeMultiprocessorCount, dev) != hipSuccess) { grid = -1; return; }
        if (hipFuncSetAttribute((const void*)mk_fwd, hipFuncAttributeMaxDynamicSharedMemorySize, LDS_BYTES) != hipSuccess) { fprintf(stderr, "kernel_launch: hipFuncSetAttribute failed\n"); grid = -1; return; }
        if (hipOccupancyMaxActiveBlocksPerMultiprocessor(&per_cu, (const void*)mk_fwd, 512, LDS_BYTES) != hipSuccess || per_cu < 1) fprintf(stderr, "kernel_launch: occupancy query says %d\n", per_cu);
        (void)hipGetLastError();
        grid = cus;
        if (grid != 256) fprintf(stderr, "kernel_launch: %d CUs (built for 256)\n", grid);
    }
    if (grid < 0) return;
    Params p{};
    for (int i = 0; i < 22; ++i) p.in[i] = (const float*)d_in[i];
    p.out = (float*)d_out; p.ws = (unsigned char*)d_ws;
    for (int h = 0; h < 8; ++h) p.log2g[h] = (float)std::log2(1.0 - std::exp2(-5.0 - (double)h));
    for (int i = 0; i < 64; ++i) p.invf[i] = powf(10000.0f, -(float)i / 64.0f);
    p.use_cg = 0; p.pad = 0;
#if MK_N_LAUNCHES == 1
    void* args[] = {&p};
#ifdef PROBE_K
    p.ph_lo = 0; p.ph_hi = PROBE_K + 1;
    (void)hipLaunchCooperativeKernel((const void*)mk_fwd, dim3(grid), dim3(512), args, LDS_BYTES, stream);
    if (hipMemsetAsync((char*)d_ws + WS_BAR, 0, BAR_BYTES, stream) != hipSuccess) return;
#endif
    p.ph_lo = 0; p.ph_hi = NPHASE;
    hipError_t e = hipLaunchCooperativeKernel((const void*)mk_fwd, dim3(grid), dim3(512), args, LDS_BYTES, stream);
    if (e != hipSuccess) fprintf(stderr, "kernel_launch: cooperative launch failed: %s\n", hipGetErrorString(e));
#else
    for (int ph = 0; ph < NPHASE; ++ph) { p.ph_lo = ph; p.ph_hi = ph + 1; hipLaunchKernelGGL(mk_fwd, dim3(grid), dim3(512), LDS_BYTES, stream, p); }
#endif
}
```
